# Optimizing an MI355X kernel written in HIP

```python
import math
import jax, jax.numpy as jnp
from jax import lax
import numpy as np

D_MODEL = 1024
BATCH = 4
SEQ = 8192
DEPTH = 2

N_A_LAYERS = DEPTH // 2
N_B_LAYERS = DEPTH - N_A_LAYERS
N_DENSE_LAYERS = (DEPTH + 1) // 2
N_MOE_LAYERS = DEPTH // 2
POOL_WINDOWS = (2, 4, 8, 16)
N_POOL_GROUPS = len(POOL_WINDOWS)
POOL_GROUP_DIM = D_MODEL // N_POOL_GROUPS
HEAD_DIM = 64
N_HEADS = D_MODEL // HEAD_DIM
N_KV_GROUPS = 4
HEADS_PER_GROUP = N_HEADS // N_KV_GROUPS
L_CMP = 32
D_STRIDE = 16
L_SLC = 64
N_SEL = 16
WINDOW = 512
R_CMP = L_CMP // D_STRIDE
R_SLC = L_SLC // D_STRIDE
CMP_HIDDEN = 4 * HEAD_DIM
Q_BLOCK = 128
N_BUCKETS = 32
REL_EXACT = N_BUCKETS // 2
MAX_DISTANCE = 1024
D_FF = 2816
N_EXPERTS = 8
TOP_K = 2
D_FF_EXPERT = 3584
MOE_BLOCK = 512
EPS = 1e-6
NEG_INF = -1e30
SEL_FORCE = 1e6

kernel_name = 'hybrid_pool_nsa_moe_yoco'


def rms_norm(x, g):
    xf = x.astype(jnp.float32)
    y = xf * lax.rsqrt(jnp.mean(xf * xf, axis=-1, keepdims=True) + EPS)
    return (y * g.astype(jnp.float32)).astype(x.dtype)


def modulate(h, shift, scale):
    return h * (1 + scale[:, None, :]) + shift[:, None, :]


def masked_softmax(s, mask):
    s = jnp.where(mask, s, NEG_INF)
    return jnp.where(mask, jax.nn.softmax(s, axis=-1), 0.0)


def rel_bucket(dist):
    d = jnp.maximum(dist, 0)
    ratio = jnp.maximum(d, REL_EXACT).astype(jnp.float32) / REL_EXACT
    large = REL_EXACT + (jnp.log(ratio) / math.log(MAX_DISTANCE / REL_EXACT)
                         * (N_BUCKETS - REL_EXACT)).astype(jnp.int32)
    return jnp.where(d < REL_EXACT, d, jnp.minimum(large, N_BUCKETS - 1))


def swiglu(x, w_gu, w_dn):
    gate, up = jnp.split(x @ w_gu, 2, axis=-1)
    return (jax.nn.silu(gate) * up) @ w_dn


def slc_map_weights():
    w = np.zeros(R_SLC + R_CMP - 1, np.float32)
    for m in range(R_SLC):
        for n in range(R_CMP):
            w[m - n + R_CMP - 1] += 1.0
    return tuple(float(v) for v in w)


def pool_mixer(h, w_grp, scale):
    B, S, _ = h.shape
    hg = h.astype(jnp.float32).reshape(B, S, N_POOL_GROUPS, POOL_GROUP_DIM)
    cs = jnp.pad(jnp.cumsum(hg, axis=1), ((0, 0), (1, 0), (0, 0), (0, 0)))
    t = jnp.arange(S)
    pooled = []
    for gi, w in enumerate(POOL_WINDOWS):
        c_g = cs[:, :, gi]
        lag = jnp.pad(c_g, ((0, 0), (w, 0), (0, 0)))[:, :S + 1]
        cnt = jnp.minimum(t + 1, w).astype(jnp.float32)
        pooled.append((c_g - lag)[:, 1:] / cnt[None, :, None])
    mix = (jnp.stack(pooled, axis=2) - hg).astype(h.dtype)
    y = jnp.einsum('bsgc,gcd->bsgd', mix, w_grp).reshape(B, S, D_MODEL)
    return y * scale


def shared_kv(x, c, kv_ada_w, kv_ada_b, kv_norm_g, kv_w, cmp_pe_k, cmp_pe_v,
              cmp_k_w1, cmp_k_w2, cmp_v_w1, cmp_v_w2, k_gain):
    B, S, _ = x.shape
    shift, scale = jnp.split(jax.nn.silu(c) @ kv_ada_w + kv_ada_b, 2, axis=-1)
    h = modulate(rms_norm(x, kv_norm_g), shift, scale)
    kv = (h @ kv_w).reshape(B, S, 6, N_KV_GROUPS, HEAD_DIM).transpose(2, 0, 3, 1, 4)
    k_c, v_c, k_s, v_s, k_w, v_w = kv[0], kv[1], kv[2], kv[3], kv[4], kv[5]

    def compress(u, pe, w1, w2):
        r = u.reshape(B, N_KV_GROUPS, S // D_STRIDE, D_STRIDE, HEAD_DIM)
        nc = S // D_STRIDE - R_CMP + 1
        blocks = jnp.concatenate([r[:, :, i:i + nc] for i in range(R_CMP)], axis=3) + pe
        flat = blocks.reshape(B, N_KV_GROUPS, nc, L_CMP * HEAD_DIM)
        return jax.nn.gelu(flat @ w1) @ w2

    kc = rms_norm(compress(k_c, cmp_pe_k, cmp_k_w1, cmp_k_w2), k_gain[0])
    vc = compress(v_c, cmp_pe_v, cmp_v_w1, cmp_v_w2)
    ks = rms_norm(k_s, k_gain[1]).reshape(B, N_KV_GROUPS, S // L_SLC, L_SLC, HEAD_DIM)
    vs = v_s.reshape(B, N_KV_GROUPS, S // L_SLC, L_SLC, HEAD_DIM)
    pad = ((0, 0), (0, 0), (WINDOW, 0), (0, 0))
    kw = jnp.pad(rms_norm(k_w, k_gain[2]), pad)
    vw = jnp.pad(v_w, pad)
    return kc, vc, ks, vs, kw, vw


def nsa_mixer(h, kv, w_qg, q_gain, w_o, rel_bias):
    B, S, _ = h.shape
    kc, vc, ks, vs, kw, vw = kv
    G, NH, QB = N_KV_GROUPS, HEADS_PER_GROUP, Q_BLOCK
    NQ = S // QB
    NS = S // L_SLC
    NC = kc.shape[2]
    n_sel = min(N_SEL, NS)
    proj = h @ w_qg
    q = rms_norm(proj[..., :N_HEADS * HEAD_DIM].reshape(B, S, N_HEADS, HEAD_DIM), q_gain) * HEAD_DIM ** -0.5
    gates = jax.nn.sigmoid(proj[..., N_HEADS * HEAD_DIM:]).reshape(B, S, N_HEADS, 3)
    q_blk = q.reshape(B, NQ, QB, G, NH, HEAD_DIM).transpose(0, 1, 3, 4, 2, 5).reshape(B * NQ, G, NH, QB, HEAD_DIM)
    g_blk = gates.reshape(B, NQ, QB, G, NH, 3).transpose(0, 1, 5, 3, 4, 2).reshape(B * NQ, 3, G, NH, QB)
    b_ids = jnp.repeat(jnp.arange(B), NQ)
    q_ids = jnp.tile(jnp.arange(NQ), B)
    cmp_end = jnp.arange(NC) * D_STRIDE + L_CMP - 1
    tab_g = rel_bias.astype(jnp.float32).reshape(N_BUCKETS, G, NH).transpose(1, 0, 2)
    grp = jnp.arange(G)
    map_w = slc_map_weights()
    back = R_SLC * NS + R_CMP + R_SLC - NC - (R_CMP - 1)
    blk = jnp.arange(NS)

    def head_bias(dist):
        return rel_bias.astype(jnp.float32)[rel_bucket(dist)].transpose(2, 0, 1).reshape(G, NH, *dist.shape)

    def block(args):
        qb, gb, b, qi = args
        t = qi * QB + jnp.arange(QB)
        dist_c = t[:, None] - cmp_end[None, :]
        s_c = jnp.einsum('gnqd,gkd->gnqk', qb, kc[b]).astype(jnp.float32) + head_bias(dist_c)
        p_c = masked_softmax(s_c, dist_c >= 0)
        o_c = jnp.einsum('gnqk,gkd->gnqd', p_c.astype(qb.dtype), vc[b])
        imp = jnp.pad(p_c.sum(axis=1), ((0, 0), (0, 0), (R_CMP - 1, back)))
        p_slc = sum(wk * imp[..., k:k + R_SLC * NS:R_SLC] for k, wk in enumerate(map_w))
        cur = t // L_SLC
        forced = (blk[None] == 0) | (blk[None] == cur[:, None]) | (blk[None] == cur[:, None] - 1)
        valid = blk[None] * L_SLC <= t[:, None]
        score = jnp.where(forced, SEL_FORCE, jnp.where(valid, p_slc, -SEL_FORCE))
        _, idx = lax.top_k(score, n_sel)
        k_sel = ks[b][grp[:, None, None], idx]
        v_sel = vs[b][grp[:, None, None], idx]
        pos_s = idx[..., None] * L_SLC + jnp.arange(L_SLC)
        dist_s = t[None, :, None, None] - pos_s
        bias_s = jnp.moveaxis(tab_g[grp[:, None, None, None], rel_bucket(dist_s)], -1, 1)
        s_s = jnp.einsum('gnqd,gqjld->gnqjl', qb, k_sel).astype(jnp.float32) + bias_s
        p_s = masked_softmax(s_s.reshape(G, NH, QB, n_sel * L_SLC),
                             (dist_s >= 0).reshape(G, 1, QB, n_sel * L_SLC)).reshape(G, NH, QB, n_sel, L_SLC)
        o_s = jnp.einsum('gnqjl,gqjld->gnqd', p_s.astype(qb.dtype), v_sel)
        k_win = lax.dynamic_slice_in_dim(kw[b], qi * QB, WINDOW + QB, axis=1)
        v_win = lax.dynamic_slice_in_dim(vw[b], qi * QB, WINDOW + QB, axis=1)
        pos_w = qi * QB - WINDOW + jnp.arange(WINDOW + QB)
        dist_w = t[:, None] - pos_w[None, :]
        mask_w = (dist_w >= 0) & (dist_w < WINDOW) & (pos_w[None, :] >= 0)
        s_w = jnp.einsum('gnqd,gkd->gnqk', qb, k_win).astype(jnp.float32) + head_bias(dist_w)
        p_w = masked_softmax(s_w, mask_w)
        o_w = jnp.einsum('gnqk,gkd->gnqd', p_w.astype(qb.dtype), v_win)
        return gb[0][..., None] * o_c + gb[1][..., None] * o_s + gb[2][..., None] * o_w

    out = lax.map(block, (q_blk, g_blk, b_ids, q_ids))
    out = out.reshape(B, NQ, G, NH, QB, HEAD_DIM).transpose(0, 1, 4, 2, 3, 5).reshape(B, S, N_HEADS * HEAD_DIM)
    return out @ w_o


def moe_ffn(h, w_router, b_router, w_gu, w_dn):
    B, S, D = h.shape
    T = B * S
    xf = h.reshape(T, D)
    logits = (xf @ w_router).astype(jnp.float32) + b_router
    top_logit, top_e = lax.top_k(logits, TOP_K)
    top_w = jax.nn.softmax(top_logit, axis=-1)
    A = T * TOP_K
    flat_e = top_e.reshape(A)
    flat_tok = jnp.repeat(jnp.arange(T), TOP_K)
    flat_w = top_w.reshape(A)
    order = jnp.argsort(flat_e)
    se = flat_e[order]
    counts = jnp.zeros((N_EXPERTS,), jnp.int32).at[flat_e].add(1)
    starts = jnp.cumsum(counts) - counts
    pcounts = (counts + MOE_BLOCK - 1) // MOE_BLOCK * MOE_BLOCK
    pends = jnp.cumsum(pcounts)
    pstarts = pends - pcounts
    dest = pstarts[se] + jnp.arange(A) - starts[se]
    n_blocks = -(-(A + N_EXPERTS * (MOE_BLOCK - 1)) // MOE_BLOCK)
    n_rows = n_blocks * MOE_BLOCK
    row_tok = jnp.zeros((n_rows,), jnp.int32).at[dest].set(flat_tok[order])
    row_w = jnp.zeros((n_rows,), jnp.float32).at[dest].set(flat_w[order])
    blk_e = jnp.minimum(jnp.searchsorted(pends, jnp.arange(n_blocks) * MOE_BLOCK, side='right'), N_EXPERTS - 1)

    def expert_block(args):
        xb, e = args
        return swiglu(xb, w_gu[e], w_dn[e])

    y = lax.map(expert_block, (xf[row_tok].reshape(n_blocks, MOE_BLOCK, D), blk_e)).reshape(n_rows, D)
    out = jnp.zeros((T, D), h.dtype).at[row_tok].add(y * row_w[:, None].astype(y.dtype))
    return out.reshape(B, S, D)


def setup_inputs(seed: int = 0) -> dict:
    key = jax.random.key(seed)
    ks = jax.random.split(key, 28)
    D = D_MODEL
    QD = N_HEADS * HEAD_DIM

    def nrm(k, shape, s):
        return jax.random.normal(k, shape, jnp.float32) * s

    return {
        'x': nrm(ks[0], (BATCH, SEQ, D), 1.0),
        'c': nrm(ks[1], (BATCH, D), 1.0),
        'ada_w': nrm(ks[2], (DEPTH, D, 6 * D), 0.5 * D ** -0.5),
        'ada_b': nrm(ks[3], (DEPTH, 6 * D), 0.02),
        'norm_g': 1.0 + nrm(ks[4], (DEPTH, 2, D), 0.02),
        'pool_w': nrm(ks[5], (N_A_LAYERS, N_POOL_GROUPS, POOL_GROUP_DIM, POOL_GROUP_DIM), POOL_GROUP_DIM ** -0.5),
        'pool_scale': 1.0 + nrm(ks[6], (N_A_LAYERS, D), 0.02),
        'q_w': nrm(ks[7], (N_B_LAYERS, D, QD + 3 * N_HEADS), D ** -0.5),
        'q_gain': 1.0 + nrm(ks[8], (N_B_LAYERS, HEAD_DIM), 0.02),
        'o_w': nrm(ks[9], (N_B_LAYERS, QD, D), QD ** -0.5),
        'kv_ada_w': nrm(ks[10], (D, 2 * D), 0.5 * D ** -0.5),
        'kv_ada_b': nrm(ks[11], (2 * D,), 0.02),
        'kv_norm_g': 1.0 + nrm(ks[12], (D,), 0.02),
        'kv_w': nrm(ks[13], (D, 6 * N_KV_GROUPS * HEAD_DIM), D ** -0.5),
        'cmp_pe_k': nrm(ks[14], (L_CMP, HEAD_DIM), 0.1),
        'cmp_pe_v': nrm(ks[15], (L_CMP, HEAD_DIM), 0.1),
        'cmp_k_w1': nrm(ks[16], (L_CMP * HEAD_DIM, CMP_HIDDEN), (L_CMP * HEAD_DIM) ** -0.5),
        'cmp_k_w2': nrm(ks[17], (CMP_HIDDEN, HEAD_DIM), CMP_HIDDEN ** -0.5),
        'cmp_v_w1': nrm(ks[18], (L_CMP * HEAD_DIM, CMP_HIDDEN), (L_CMP * HEAD_DIM) ** -0.5),
        'cmp_v_w2': nrm(ks[19], (CMP_HIDDEN, HEAD_DIM), CMP_HIDDEN ** -0.5),
        'k_gain': 1.0 + nrm(ks[20], (3, HEAD_DIM), 0.02),
        'rel_bias': nrm(ks[21], (N_BUCKETS, N_HEADS), 0.5),
        'ffn_gu': nrm(ks[22], (N_DENSE_LAYERS, D, 2 * D_FF), D ** -0.5),
        'ffn_dn': nrm(ks[23], (N_DENSE_LAYERS, D_FF, D), D_FF ** -0.5),
        'router_w': nrm(ks[24], (N_MOE_LAYERS, D, N_EXPERTS), D ** -0.5),
        'router_b': nrm(ks[25], (N_MOE_LAYERS, N_EXPERTS), 0.01),
        'exp_gu': nrm(ks[26], (N_MOE_LAYERS, N_EXPERTS, D, 2 * D_FF_EXPERT), D ** -0.5),
        'exp_dn': nrm(ks[27], (N_MOE_LAYERS, N_EXPERTS, D_FF_EXPERT, D), D_FF_EXPERT ** -0.5),
    }


def reference(x, c, ada_w, ada_b, norm_g, pool_w, pool_scale, q_w, q_gain, o_w,
              kv_ada_w, kv_ada_b, kv_norm_g, kv_w, cmp_pe_k, cmp_pe_v,
              cmp_k_w1, cmp_k_w2, cmp_v_w1, cmp_v_w2, k_gain, rel_bias,
              ffn_gu, ffn_dn, router_w, router_b, exp_gu, exp_dn):
    kv = None
    for l in range(DEPTH):
        sh1, sc1, g1, sh2, sc2, g2 = jnp.split(jax.nn.silu(c) @ ada_w[l] + ada_b[l], 6, axis=-1)
        if l >= N_A_LAYERS and kv is None:
            kv = shared_kv(x, c, kv_ada_w, kv_ada_b, kv_norm_g, kv_w, cmp_pe_k, cmp_pe_v,
                           cmp_k_w1, cmp_k_w2, cmp_v_w1, cmp_v_w2, k_gain)
        h = modulate(rms_norm(x, norm_g[l, 0]), sh1, sc1)
        if l < N_A_LAYERS:
            mix = pool_mixer(h, pool_w[l], pool_scale[l])
        else:
            j = l - N_A_LAYERS
            mix = nsa_mixer(h, kv, q_w[j], q_gain[j], o_w[j], rel_bias)
        x = x + g1[:, None, :] * mix
        h = modulate(rms_norm(x, norm_g[l, 1]), sh2, sc2)
        if l % 2 == 0:
            f = swiglu(h, ffn_gu[l // 2], ffn_dn[l // 2])
        else:
            f = moe_ffn(h, router_w[l // 2], router_b[l // 2], exp_gu[l // 2], exp_dn[l // 2])
        x = x + g2[:, None, :] * f
    return x
```

```cpp
#include <hip/hip_runtime.h>
#include <cstdint>
#include <cstdio>

#define LAS __attribute__((address_space(3)))
typedef unsigned short bf16_t;
typedef short bf16x8 __attribute__((ext_vector_type(8)));
typedef float f32x4 __attribute__((ext_vector_type(4)));
typedef float f32x2 __attribute__((ext_vector_type(2)));
typedef unsigned u32x4 __attribute__((ext_vector_type(4)));
typedef unsigned u32x2 __attribute__((ext_vector_type(2)));

constexpr int NB = 4, S = 8192, D = 1024, T = NB * S;
constexpr int FF = 2816, NE = 8, FE = 3584;
constexpr int NKV = 1536, NQP = 1280, NQ = 1072;
constexpr int G = 4, HD = 64, NH = 16;
constexpr int NC = 512;
constexpr int NSB = 128;
constexpr int NSEL = 16;
constexpr int WIN = 512;
constexpr int MOE_ROWS = 69632;
constexpr float EPS = 1e-6f;
constexpr int NTHR = 512, NWAVE = 8;

constexpr size_t MiB = 1u << 20;
constexpr size_t WS_CTL = 0, CTL_BYTES = 1 * MiB;
constexpr size_t WS_MODV = 1 * MiB;
constexpr size_t WS_CMPB = WS_MODV + 14 * 4 * 1024 * 4;
constexpr size_t WS_TOPE = 2 * MiB;
constexpr size_t WS_TOPW = WS_TOPE + (size_t)T * 8;
constexpr size_t WS_RPOS = WS_TOPW + (size_t)T * 8;
constexpr size_t WS_RTOK = WS_RPOS + (size_t)T * 8;
constexpr size_t WS_SMALL_END = WS_RTOK + (size_t)MOE_ROWS * 4;
static_assert(WS_SMALL_END <= 8 * MiB, "small region");
constexpr size_t WS_W = 8 * MiB;
constexpr size_t WO_POOL = WS_W;
constexpr size_t WO_FGU = WO_POOL + (size_t)4 * 256 * 256 * 2;
constexpr size_t WO_FDN = WO_FGU + (size_t)2 * FF * D * 2;
constexpr size_t WO_KV = WO_FDN + (size_t)D * FF * 2;
constexpr size_t WO_Q = WO_KV + (size_t)NKV * D * 2;
constexpr size_t WO_O = WO_Q + (size_t)NQP * D * 2;
constexpr size_t WO_CK = WO_O + (size_t)D * D * 2;
constexpr size_t WO_CV = WO_CK + (size_t)256 * 2048 * 2;
constexpr size_t WO_EGU = WO_CV + (size_t)256 * 2048 * 2;
constexpr size_t WO_EDN = WO_EGU + (size_t)NE * 2 * FE * D * 2;
constexpr size_t WO_END = WO_EDN + (size_t)NE * D * FE * 2;
static_assert(WO_END <= 203 * MiB, "weights region");
constexpr size_t WS_HB = 203 * MiB;
constexpr size_t WS_X1 = 267 * MiB;
constexpr size_t WS_X2 = 395 * MiB;
constexpr size_t WS_HID0 = 523 * MiB;
constexpr size_t WS_Q = 523 * MiB;
constexpr size_t WS_GATE = 587 * MiB;
constexpr size_t WS_CMPH = 593 * MiB;
constexpr size_t WS_KC = 601 * MiB;
constexpr size_t WS_VC = 602 * MiB;
constexpr size_t WS_HA = 699 * MiB;
constexpr size_t WS_KVB = 763 * MiB;
constexpr size_t WS_HIDM = 267 * MiB;
constexpr size_t WS_Y = 743 * MiB;
constexpr size_t WS_END = 880 * MiB;
static_assert(WS_HIDM + (size_t)MOE_ROWS * FE * 2 <= WS_Y && WS_Y + (size_t)MOE_ROWS * D * 2 <= WS_END, "moe map");
static_assert(WS_KVB + (size_t)T * NKV * 2 + 65536 <= WS_END, "kv map");
constexpr int CW_CNT = 64;
constexpr int CW_CUR = 128;
constexpr int CW_BAR = 4096;

struct Params {
    const float *x, *c, *ada_w, *ada_b, *norm_g, *pool_w, *pool_scale, *q_w, *q_gain, *o_w, *kv_ada_w, *kv_ada_b, *kv_norm_g, *kv_w,
        *cmp_pe_k, *cmp_pe_v, *cmp_k_w1, *cmp_k_w2, *cmp_v_w1, *cmp_v_w2, *k_gain, *rel_bias, *ffn_gu, *ffn_dn, *router_w, *router_b, *exp_gu, *exp_dn;
    float* out; unsigned char* ws;
};

__device__ __forceinline__ unsigned cvt_pk_bf16(float lo, float hi) { unsigned r; asm volatile("v_cvt_pk_bf16_f32 %0, %1, %2" : "=v"(r) : "v"(lo), "v"(hi)); return r; }
__device__ __forceinline__ float bf2f(unsigned short v) { return __uint_as_float((unsigned)v << 16); }
__device__ __forceinline__ float bflo(unsigned w) { return __uint_as_float(w << 16); }
__device__ __forceinline__ float bfhi(unsigned w) { return __uint_as_float(w & 0xffff0000u); }
__device__ __forceinline__ float wave_sum(float v) {
#pragma unroll
    for (int o = 1; o < 64; o <<= 1) v += __shfl_xor(v, o);
    return v;
}
__device__ __forceinline__ float wave_max(float v) {
#pragma unroll
    for (int o = 1; o < 64; o <<= 1) v = fmaxf(v, __shfl_xor(v, o));
    return v;
}
__device__ __forceinline__ float silu_f(float v) { return v / (1.f + __expf(-v)); }
__device__ __forceinline__ float sigmoid_f(float v) { return 1.f / (1.f + __expf(-v)); }
__device__ __forceinline__ float gelu_tanh_f(float v) {
    const float u = 0.7978845608028654f * (v + 0.044715f * v * v * v);
    const float e = __expf(-2.f * fabsf(u)); const float th = (1.f - e) / (1.f + e);
    return 0.5f * v * (1.f + (u < 0.f ? -th : th));
}
__device__ __forceinline__ int rel_bucket(int d) {
    if (d < 16) return d;
    int b = 16;
    b += (d >= 21); b += (d >= 27); b += (d >= 35); b += (d >= 46); b += (d >= 59); b += (d >= 77); b += (d >= 99); b += (d >= 128);
    b += (d >= 166); b += (d >= 216); b += (d >= 280); b += (d >= 363); b += (d >= 470); b += (d >= 609); b += (d >= 790);
    return b;
}

__device__ __forceinline__ void transpose_item(const float* W, int K, int N, bf16_t* WT, int k0, int n0, int drow0, LAS float* scr, int lane) {
#pragma unroll 8
    for (int i = 0; i < 32; ++i) { const int kk = 2 * i + (lane >> 5); const int n = n0 + (lane & 31); scr[kk * 33 + (lane & 31)] = (n < N) ? W[(size_t)(k0 + kk) * N + n] : 0.f; }
    asm volatile("s_waitcnt lgkmcnt(0)" ::: "memory");
    const int c = lane & 7;
#pragma unroll
    for (int j = 0; j < 4; ++j) { const int n = (lane >> 3) + 8 * j; const LAS float* s = scr + (8 * c) * 33 + n;
        u32x4 o; o.x = cvt_pk_bf16(s[0 * 33], s[1 * 33]); o.y = cvt_pk_bf16(s[2 * 33], s[3 * 33]); o.z = cvt_pk_bf16(s[4 * 33], s[5 * 33]); o.w = cvt_pk_bf16(s[6 * 33], s[7 * 33]);
        *(u32x4*)(WT + (size_t)(drow0 + n) * K + k0 + 8 * c) = o; }
    asm volatile("s_waitcnt lgkmcnt(0)" ::: "memory");
}
template <int MODE>
__device__ __forceinline__ void transpose_mat(const float* W, int K, int N, int NP, int F, bf16_t* WT, int it, LAS float* scr, int lane) {
    const int nblk = NP / 32, kb = it / nblk, nb = it % nblk, n0 = nb * 32;
    int drow0 = n0;
    if (MODE == 1) { const int up = n0 >= F, j = up ? n0 - F : n0; drow0 = (j >> 7) * 256 + (up ? 128 : 0) + (j & 127); }
    transpose_item(W, K, N, WT, kb * 64, n0, drow0, scr, lane);
}
__device__ __forceinline__ void phase_weights(const Params& p, LAS unsigned char* lds) {
    const int lane = threadIdx.x & 63, wave = threadIdx.x >> 6;
    LAS float* scr = (LAS float*)(lds + wave * 16384);
    const int gw = blockIdx.x * NWAVE + wave, NGW = gridDim.x * NWAVE;
    unsigned char* ws = p.ws;
    constexpr int I_POOL = 4 * 8, I_FGU = 16 * 176, I_FDN = 44 * 32, I_KV = 16 * 48, I_Q = 16 * 40, I_O = 16 * 32, I_C = 32 * 8, I_EGU = 16 * 224, I_EDN = 56 * 32;
    constexpr int TOT = 4 * I_POOL + I_FGU + I_FDN + I_KV + I_Q + I_O + 2 * I_C + NE * I_EGU + NE * I_EDN;
    for (int it = gw; it < TOT; it += NGW) {
        int r = it;
        if (r < 4 * I_POOL) { const int g = r / I_POOL; transpose_mat<0>(p.pool_w + (size_t)g * 65536, 256, 256, 256, 0, (bf16_t*)(ws + WO_POOL) + (size_t)g * 65536, r % I_POOL, scr, lane); continue; } r -= 4 * I_POOL;
        if (r < I_FGU) { transpose_mat<1>(p.ffn_gu, D, 2 * FF, 2 * FF, FF, (bf16_t*)(ws + WO_FGU), r, scr, lane); continue; } r -= I_FGU;
        if (r < I_FDN) { transpose_mat<0>(p.ffn_dn, FF, D, D, 0, (bf16_t*)(ws + WO_FDN), r, scr, lane); continue; } r -= I_FDN;
        if (r < I_KV) { transpose_mat<0>(p.kv_w, D, NKV, NKV, 0, (bf16_t*)(ws + WO_KV), r, scr, lane); continue; } r -= I_KV;
        if (r < I_Q) { transpose_mat<0>(p.q_w, D, NQ, NQP, 0, (bf16_t*)(ws + WO_Q), r, scr, lane); continue; } r -= I_Q;
        if (r < I_O) { transpose_mat<0>(p.o_w, D, D, D, 0, (bf16_t*)(ws + WO_O), r, scr, lane); continue; } r -= I_O;
        if (r < I_C) { transpose_mat<0>(p.cmp_k_w1, 2048, 256, 256, 0, (bf16_t*)(ws + WO_CK), r, scr, lane); continue; } r -= I_C;
        if (r < I_C) { transpose_mat<0>(p.cmp_v_w1, 2048, 256, 256, 0, (bf16_t*)(ws + WO_CV), r, scr, lane); continue; } r -= I_C;
        if (r < NE * I_EGU) { const int e = r / I_EGU; transpose_mat<1>(p.exp_gu + (size_t)e * D * 2 * FE, D, 2 * FE, 2 * FE, FE, (bf16_t*)(ws + WO_EGU) + (size_t)e * 2 * FE * D, r % I_EGU, scr, lane); continue; } r -= NE * I_EGU;
        { const int e = r / I_EDN; transpose_mat<0>(p.exp_dn + (size_t)e * FE * D, FE, D, D, 0, (bf16_t*)(ws + WO_EDN) + (size_t)e * D * FE, r % I_EDN, scr, lane); }
    }
}

__device__ __forceinline__ void phase_modvec(const Params& p, LAS unsigned char* lds) {
    const int tid = threadIdx.x, lane = tid & 63, wave = tid >> 6;
    LAS float* part = (LAS float*)lds;
    float* MODV = (float*)(p.ws + WS_MODV);
    float* CMPB = (float*)(p.ws + WS_CMPB);
    constexpr int NU_MOD = 14336 / 64, NU = NU_MOD + 8;
    for (int u = blockIdx.x; u < NU; u += gridDim.x) {
        float acc[4] = {0.f, 0.f, 0.f, 0.f};
        if (u < NU_MOD) {
            const int gc = u * 64 + lane;
            const float* W; int ldw, col;
            if (gc < 6144) { W = p.ada_w; ldw = 6144; col = gc; } else if (gc < 12288) { W = p.ada_w + (size_t)D * 6144; ldw = 6144; col = gc - 6144; } else { W = p.kv_ada_w; ldw = 2048; col = gc - 12288; }
            for (int k = wave * 128; k < wave * 128 + 128; ++k) {
                const float w = W[(size_t)k * ldw + col];
#pragma unroll
                for (int b = 0; b < 4; ++b) acc[b] += silu_f(p.c[b * D + k]) * w;
            }
        } else {
            const int cu = u - NU_MOD, kv = cu >> 2, col = (cu & 3) * 64 + lane;
            const float* W = kv ? p.cmp_v_w1 : p.cmp_k_w1; const float* pe = kv ? p.cmp_pe_v : p.cmp_pe_k;
            for (int k = wave * 256; k < wave * 256 + 256; ++k) acc[0] += pe[k] * W[(size_t)k * 256 + col];
        }
#pragma unroll
        for (int b = 0; b < 4; ++b) part[(wave * 4 + b) * 64 + lane] = acc[b];
        __syncthreads();
        if (tid < 256) {
            const int b = tid >> 6; float s = 0.f;
#pragma unroll
            for (int w = 0; w < 8; ++w) s += part[(w * 4 + b) * 64 + lane];
            if (u < NU_MOD) {
                const int gc = u * 64 + lane; int which, n; float bias;
                if (gc < 6144) { which = gc >> 10; n = gc & 1023; bias = p.ada_b[gc]; } else if (gc < 12288) { which = 6 + ((gc - 6144) >> 10); n = gc & 1023; bias = p.ada_b[gc]; }
                else { which = 12 + ((gc - 12288) >> 10); n = gc & 1023; bias = p.kv_ada_b[gc - 12288]; }
                MODV[(which * 4 + b) * D + n] = s + bias;
            } else if (b == 0) { const int cu = u - NU_MOD; CMPB[(cu >> 2) * 256 + (cu & 3) * 64 + lane] = s; }
        }
        __syncthreads();
    }
}

template <int W>
__device__ __forceinline__ void pool_rows(const float* xb, int t0, const LAS float* rs, f32x2 gm, f32x2 sh, bf16_t* outb, int c0) {
    f32x2 ring[16];
#pragma unroll
    for (int i = 0; i < 15; ++i) {
        const int t = t0 - 15 + i; f32x2 h = {0.f, 0.f};
        if (t >= 0) { const f32x2 xv = *(const f32x2*)(xb + (size_t)t * D + c0); const float r = rs[i]; h = xv * r * gm + sh; }
        ring[i] = h;
    }
    for (int gi = 0; gi < 8; ++gi) {
#pragma unroll
        for (int j = 0; j < 16; ++j) {
            const int i = 15 + gi * 16 + j, t = t0 + gi * 16 + j;
            const f32x2 xv = *(const f32x2*)(xb + (size_t)t * D + c0); const float r = rs[i];
            const f32x2 h = xv * r * gm + sh;
            ring[(15 + j) & 15] = h;
            f32x2 s = {0.f, 0.f};
#pragma unroll
            for (int k = 0; k < W; ++k) s += ring[(15 + j - k) & 15];
            const int cnt = (t + 1 < W) ? t + 1 : W;
            const f32x2 o = s * (1.f / (float)cnt) - h;
            *(unsigned*)(outb + (size_t)t * D + c0) = cvt_pk_bf16(o.x, o.y);
        }
    }
}
__device__ __forceinline__ void phase_poolmix(const Params& p, LAS unsigned char* lds, bf16_t* mixA) {
    const int tid = threadIdx.x, lane = tid & 63, wave = tid >> 6;
    LAS float* rs = (LAS float*)lds;
    const float* MODV = (const float*)(p.ws + WS_MODV);
    for (int u = blockIdx.x; u < T / 128; u += gridDim.x) {
        const int b = u >> 6, t0 = (u & 63) * 128;
        const float* xb = p.x + (size_t)b * S * D;
        for (int i = wave; i < 143; i += NWAVE) {
            const int t = t0 - 15 + i; float r = 0.f;
            if (t >= 0) { const f32x4* xr = (const f32x4*)(xb + (size_t)t * D) + lane; float s = 0.f;
#pragma unroll
                for (int j = 0; j < 4; ++j) { const f32x4 v = xr[64 * j]; s += (v.x * v.x + v.y * v.y) + (v.z * v.z + v.w * v.w); }
                r = 1.f / sqrtf(wave_sum(s) * (1.f / D) + EPS); }
            if (lane == 0) rs[i] = r;
        }
        __syncthreads();
        const int c0 = 2 * tid;
        const f32x2 g = *(const f32x2*)(p.norm_g + c0), sc = *(const f32x2*)(MODV + (1 * 4 + b) * D + c0), sh = *(const f32x2*)(MODV + (0 * 4 + b) * D + c0);
        const f32x2 gm = g * (sc + 1.f);
        bf16_t* ob = mixA + (size_t)b * S * D;
        const int grp = tid >> 7;
        if (grp == 0) pool_rows<2>(xb, t0, rs, gm, sh, ob, c0);
        else if (grp == 1) pool_rows<4>(xb, t0, rs, gm, sh, ob, c0);
        else if (grp == 2) pool_rows<8>(xb, t0, rs, gm, sh, ob, c0);
        else pool_rows<16>(xb, t0, rs, gm, sh, ob, c0);
        __syncthreads();
    }
}

struct NormOut { const float* g; const float* sc; const float* sh; bf16_t* out; };
template <int NOUT, bool ROUTER>
__device__ __forceinline__ void phase_norm(const Params& p, LAS unsigned char* lds, const float* xin, const NormOut o0, const NormOut o1) {
    const int tid = threadIdx.x, lane = tid & 63, wave = tid >> 6;
    const int gw = blockIdx.x * NWAVE + wave, NGW = gridDim.x * NWAVE;
    LAS float* rw = (LAS float*)lds;
    if (ROUTER) { for (int i = tid; i < D * NE; i += NTHR) rw[i] = p.router_w[i]; __syncthreads(); }
    unsigned* ctl = (unsigned*)(p.ws + WS_CTL);
    int* TOPE = (int*)(p.ws + WS_TOPE); float* TOPW = (float*)(p.ws + WS_TOPW);
    unsigned cnt_local[NE];
#pragma unroll
    for (int e = 0; e < NE; ++e) cnt_local[e] = 0;
    const int rows_per = T / NGW > 0 ? (T + NGW - 1) / NGW : 1;
    const int r0 = gw * rows_per, r1 = (r0 + rows_per < T) ? r0 + rows_per : T;
    int curb = -1; f32x4 gm0[4], sh0[4], gm1[4], sh1[4];
    for (int r = r0; r < r1; ++r) {
        const int b = r >> 13;
        if (b != curb) { curb = b;
#pragma unroll
            for (int j = 0; j < 4; ++j) { const int c = 4 * lane + 256 * j;
                gm0[j] = *(const f32x4*)(o0.g + c) * (*(const f32x4*)(o0.sc + b * D + c) + 1.f); sh0[j] = *(const f32x4*)(o0.sh + b * D + c);
                if (NOUT > 1) { gm1[j] = *(const f32x4*)(o1.g + c) * (*(const f32x4*)(o1.sc + b * D + c) + 1.f); sh1[j] = *(const f32x4*)(o1.sh + b * D + c); } } }
        const f32x4* xr = (const f32x4*)(xin + (size_t)r * D) + lane;
        f32x4 v[4]; float s = 0.f;
#pragma unroll
        for (int j = 0; j < 4; ++j) { v[j] = xr[64 * j]; s += (v[j].x * v[j].x + v[j].y * v[j].y) + (v[j].z * v[j].z + v[j].w * v[j].w); }
        const float rstd = 1.f / sqrtf(wave_sum(s) * (1.f / D) + EPS);
        float lg[NE];
#pragma unroll
        for (int e = 0; e < NE; ++e) lg[e] = 0.f;
#pragma unroll
        for (int j = 0; j < 4; ++j) {
            const f32x4 h = v[j] * rstd * gm0[j] + sh0[j];
            u32x2 w; w.x = cvt_pk_bf16(h.x, h.y); w.y = cvt_pk_bf16(h.z, h.w);
            *(u32x2*)(o0.out + (size_t)r * D + 4 * lane + 256 * j) = w;
            if (NOUT > 1) { const f32x4 h1 = v[j] * rstd * gm1[j] + sh1[j]; u32x2 w1; w1.x = cvt_pk_bf16(h1.x, h1.y); w1.y = cvt_pk_bf16(h1.z, h1.w);
                *(u32x2*)(o1.out + (size_t)r * D + 4 * lane + 256 * j) = w1; }
            if (ROUTER) {
#pragma unroll
                for (int q = 0; q < 4; ++q) { const LAS f32x4* wr = (const LAS f32x4*)(rw + (4 * lane + 256 * j + q) * NE); const f32x4 a = wr[0], c2 = wr[1]; const float hv = h[q];
                    lg[0] += hv * a.x; lg[1] += hv * a.y; lg[2] += hv * a.z; lg[3] += hv * a.w; lg[4] += hv * c2.x; lg[5] += hv * c2.y; lg[6] += hv * c2.z; lg[7] += hv * c2.w; }
            }
        }
        if (ROUTER) {
#pragma unroll
            for (int e = 0; e < NE; ++e) lg[e] = wave_sum(lg[e]) + p.router_b[e];
            int e0 = 0; float v0 = lg[0];
#pragma unroll
            for (int e = 1; e < NE; ++e) if (lg[e] > v0) { v0 = lg[e]; e0 = e; }
            int e1 = -1; float v1 = -3.0e38f;
#pragma unroll
            for (int e = 0; e < NE; ++e) if (e != e0 && lg[e] > v1) { v1 = lg[e]; e1 = e; }
            const float ex = __expf(v1 - v0), w0 = 1.f / (1.f + ex), w1 = ex / (1.f + ex);
            if (lane == 0) { TOPE[2 * r] = e0; TOPE[2 * r + 1] = e1; TOPW[2 * r] = w0; TOPW[2 * r + 1] = w1; }
#pragma unroll
            for (int e = 0; e < NE; ++e) cnt_local[e] += (e == e0) + (e == e1);
        }
    }
    if (ROUTER && lane == 0) {
#pragma unroll
        for (int e = 0; e < NE; ++e) if (cnt_local[e]) atomicAdd(ctl + CW_CNT + e, cnt_local[e]);
    }
}

struct GemmArgs { const bf16_t* A; const bf16_t* Bt; int M, N, K; long lda, ldb; };
template <class Epi, int AMODE, bool PAIR>
__device__ __forceinline__ void gemm_simple(const GemmArgs g, const Epi& E, const int* tok, const int* pst, size_t bstride) {
    const int tid = threadIdx.x, lane = tid & 63, wid = tid >> 6, wr = wid >> 2, wc = wid & 3, fr = lane & 15, fq = lane >> 4;
    const int ntn = g.N / 256, ntm = g.M / 128, ntiles = ntm * ntn;
    for (int tile = blockIdx.x; tile < ntiles; tile += gridDim.x) {
        const int tm = tile / ntn, tn = tile % ntn, m0 = tm * 128, n0 = tn * 256;
        const bf16_t* Bt = g.Bt;
        if (pst) { if (m0 >= pst[NE]) continue; int e = 0;
#pragma unroll
            for (int q = 1; q < NE; ++q) e += (m0 >= pst[q]); Bt += (size_t)e * bstride; }
        const bf16_t* ap[4]; const bf16_t* bp[4];
#pragma unroll
        for (int m = 0; m < 4; ++m) { const int r = m0 + wr * 64 + 16 * m + fr; const long rr = (AMODE == 1) ? (long)tok[r] : (long)r; ap[m] = g.A + rr * g.lda + 8 * fq; }
#pragma unroll
        for (int n = 0; n < 4; ++n) { const int c = n0 + (n >> 1) * 128 + wc * 32 + (n & 1) * 16 + fr; bp[n] = Bt + (long)c * g.ldb + 8 * fq; }
        f32x4 acc[4][4];
#pragma unroll
        for (int m = 0; m < 4; ++m)
#pragma unroll
            for (int n = 0; n < 4; ++n) acc[m][n] = (f32x4){0.f, 0.f, 0.f, 0.f};
        for (int k0 = 0; k0 < g.K; k0 += 32) {
            const long ka = (AMODE == 2) ? (long)(k0 >> 6) * NKV + (k0 & 63) : (long)k0;
            bf16x8 a[4], b[4];
#pragma unroll
            for (int m = 0; m < 4; ++m) a[m] = *(const bf16x8*)(ap[m] + ka);
#pragma unroll
            for (int n = 0; n < 4; ++n) b[n] = *(const bf16x8*)(bp[n] + k0);
#pragma unroll
            for (int m = 0; m < 4; ++m)
#pragma unroll
                for (int n = 0; n < 4; ++n) acc[m][n] = __builtin_amdgcn_mfma_f32_16x16x32_bf16(b[n], a[m], acc[m][n], 0, 0, 0);
        }
#pragma unroll
        for (int m = 0; m < 4; ++m) {
            const int row = m0 + wr * 64 + 16 * m + fr;
            if constexpr (PAIR) {
#pragma unroll
                for (int n = 0; n < 2; ++n) E.pair(row, tn * 128 + wc * 32 + n * 16 + 4 * fq, acc[m][n], acc[m][n + 2]);
            } else {
#pragma unroll
                for (int n = 0; n < 4; ++n) E(row, n0 + (n >> 1) * 128 + wc * 32 + (n & 1) * 16 + 4 * fq, acc[m][n]);
            }
        }
    }
}
struct EpiPool {
    const float* x; float* x1; const float* g1; const float* scale; int coff;
    __device__ __forceinline__ void operator()(int row, int col, f32x4 v) const { const int c = coff + col, b = row >> 13;
        const f32x4 xv = *(const f32x4*)(x + (size_t)row * D + c), gv = *(const f32x4*)(g1 + b * D + c), sv = *(const f32x4*)(scale + c);
        *(f32x4*)(x1 + (size_t)row * D + c) = xv + gv * (v * sv); }
};
struct EpiSwiglu {
    bf16_t* hid; int ldh;
    __device__ __forceinline__ void pair(int row, int hc, f32x4 gt, f32x4 up) const {
        u32x2 w; w.x = cvt_pk_bf16(silu_f(gt.x) * up.x, silu_f(gt.y) * up.y); w.y = cvt_pk_bf16(silu_f(gt.z) * up.z, silu_f(gt.w) * up.w);
        *(u32x2*)(hid + (size_t)row * ldh + hc) = w; }
};
struct EpiResid {
    const float* xin; float* out; const float* gate;
    __device__ __forceinline__ void operator()(int row, int col, f32x4 v) const { const int b = row >> 13;
        const f32x4 xv = *(const f32x4*)(xin + (size_t)row * D + col), gv = *(const f32x4*)(gate + b * D + col);
        *(f32x4*)(out + (size_t)row * D + col) = xv + gv * v; }
};
struct EpiBf16 {
    bf16_t* o; int ldo;
    __device__ __forceinline__ void operator()(int row, int col, f32x4 v) const { u32x2 w; w.x = cvt_pk_bf16(v.x, v.y); w.y = cvt_pk_bf16(v.z, v.w); *(u32x2*)(o + (size_t)row * ldo + col) = w; }
};
struct EpiQ {
    bf16_t* q; float* gates;
    __device__ __forceinline__ void operator()(int row, int col, f32x4 v) const {
        if (col < D) { u32x2 w; w.x = cvt_pk_bf16(v.x, v.y); w.y = cvt_pk_bf16(v.z, v.w); *(u32x2*)(q + (size_t)row * D + col) = w; }
        else if (col < NQ) { f32x4 s; s.x = sigmoid_f(v.x); s.y = sigmoid_f(v.y); s.z = sigmoid_f(v.z); s.w = sigmoid_f(v.w); *(f32x4*)(gates + (size_t)row * 48 + (col - D)) = s; } }
};
struct EpiCmp {
    bf16_t* o; const float* bias;
    __device__ __forceinline__ void operator()(int row, int col, f32x4 v) const { const f32x4 bv = *(const f32x4*)(bias + col);
        u32x2 w; w.x = cvt_pk_bf16(gelu_tanh_f(v.x + bv.x), gelu_tanh_f(v.y + bv.y)); w.y = cvt_pk_bf16(gelu_tanh_f(v.z + bv.z), gelu_tanh_f(v.w + bv.w));
        *(u32x2*)(o + (size_t)row * 256 + col) = w; }
};

__device__ __forceinline__ void phase_headnorm(const Params& p) {
    const int tid = threadIdx.x, lane = tid & 63, wave = tid >> 6;
    const int gw = blockIdx.x * NWAVE + wave, NGW = gridDim.x * NWAVE;
    bf16_t* Q = (bf16_t*)(p.ws + WS_Q); bf16_t* KVB = (bf16_t*)(p.ws + WS_KVB);
    float qg[16], kg[8];
#pragma unroll
    for (int i = 0; i < 16; ++i) qg[i] = p.q_gain[(lane & 3) * 16 + i] * 0.125f;
    const int kr = lane >> 5;
#pragma unroll
    for (int i = 0; i < 8; ++i) kg[i] = p.k_gain[(1 + kr) * 64 + (lane & 7) * 8 + i];
    for (int r = gw; r < T; r += NGW) {
        {
            u32x4* ptr = (u32x4*)(Q + (size_t)r * D + lane * 16); u32x4 w0 = ptr[0], w1 = ptr[1];
            float v[16]; const unsigned ww[8] = {w0.x, w0.y, w0.z, w0.w, w1.x, w1.y, w1.z, w1.w}; float s = 0.f;
#pragma unroll
            for (int i = 0; i < 8; ++i) { v[2 * i] = bflo(ww[i]); v[2 * i + 1] = bfhi(ww[i]); s += v[2 * i] * v[2 * i] + v[2 * i + 1] * v[2 * i + 1]; }
            s += __shfl_xor(s, 1); s += __shfl_xor(s, 2);
            const float rstd = 1.f / sqrtf(s * (1.f / 64.f) + EPS);
            unsigned o[8];
#pragma unroll
            for (int i = 0; i < 8; ++i) o[i] = cvt_pk_bf16(v[2 * i] * rstd * qg[2 * i], v[2 * i + 1] * rstd * qg[2 * i + 1]);
            ptr[0] = (u32x4){o[0], o[1], o[2], o[3]}; ptr[1] = (u32x4){o[4], o[5], o[6], o[7]};
        }
        {
            u32x4* ptr = (u32x4*)(KVB + (size_t)r * NKV + (kr ? 1024 : 512) + (lane & 31) * 8); u32x4 w0 = ptr[0];
            float v[8]; const unsigned ww[4] = {w0.x, w0.y, w0.z, w0.w}; float s = 0.f;
#pragma unroll
            for (int i = 0; i < 4; ++i) { v[2 * i] = bflo(ww[i]); v[2 * i + 1] = bfhi(ww[i]); s += v[2 * i] * v[2 * i] + v[2 * i + 1] * v[2 * i + 1]; }
            s += __shfl_xor(s, 1); s += __shfl_xor(s, 2); s += __shfl_xor(s, 4);
            const float rstd = 1.f / sqrtf(s * (1.f / 64.f) + EPS);
            unsigned o[4];
#pragma unroll
            for (int i = 0; i < 4; ++i) o[i] = cvt_pk_bf16(v[2 * i] * rstd * kg[2 * i], v[2 * i + 1] * rstd * kg[2 * i + 1]);
            ptr[0] = (u32x4){o[0], o[1], o[2], o[3]};
        }
    }
}

__device__ __forceinline__ void phase_cmp2(const Params& p) {
    const int tid = threadIdx.x, lane = tid & 63, wave = tid >> 6;
    const int gw = blockIdx.x * NWAVE + wave, NGW = gridDim.x * NWAVE;
    const bf16_t* CMPH = (const bf16_t*)(p.ws + WS_CMPH);
    for (int it = gw; it < 2 * 4 * 2048; it += NGW) {
        const int kv = it >> 13, g = (it >> 11) & 3, rr = it & 2047, b = rr >> 9, n = rr & 511;
        const bf16_t* hrow = CMPH + (size_t)it * 256;
        const float* w2 = kv ? p.cmp_v_w2 : p.cmp_k_w2;
        float acc = 0.f;
        for (int k = 0; k < 256; ++k) acc += bf2f(hrow[k]) * w2[k * 64 + lane];
        if (kv == 0) { const float ss = wave_sum(acc * acc); acc = acc * (1.f / sqrtf(ss * (1.f / 64.f) + EPS)) * p.k_gain[lane]; }
        bf16_t* o = (bf16_t*)(p.ws + (kv ? WS_VC : WS_KC)) + ((size_t)(b * 4 + g) * NC + n) * 64 + lane;
        *o = (bf16_t)(cvt_pk_bf16(acc, 0.f) & 0xffffu);
    }
}

__device__ __forceinline__ float dot64(const float (&q)[64], const bf16_t* krow) {
    const u32x4* kp = (const u32x4*)krow; float s = 0.f;
#pragma unroll
    for (int i = 0; i < 8; ++i) { const u32x4 w = kp[i];
        s += q[8 * i + 0] * bflo(w.x) + q[8 * i + 1] * bfhi(w.x) + q[8 * i + 2] * bflo(w.y) + q[8 * i + 3] * bfhi(w.y)
           + q[8 * i + 4] * bflo(w.z) + q[8 * i + 5] * bfhi(w.z) + q[8 * i + 6] * bflo(w.w) + q[8 * i + 7] * bfhi(w.w); }
    return s;
}
__device__ __forceinline__ void phase_attn_naive(const Params& p, LAS unsigned char* lds, bf16_t* AO) {
    const int tid = threadIdx.x, lane = tid & 63, wave = tid >> 6, g = wave >> 1;
    LAS float* sc = (LAS float*)lds + wave * 1024;
    LAS float* pc = (LAS float*)(lds + 32768);
    LAS float* hb = (LAS float*)(lds + 65536);
    LAS unsigned char* lut = lds + 65536 + 2048;
    for (int i = tid; i < 512; i += NTHR) hb[i] = p.rel_bias[(i & 31) * NH + (i >> 5)];
    for (int i = tid; i < 1024; i += NTHR) lut[i] = (unsigned char)rel_bucket(i);
    __syncthreads();
    const bf16_t* Q = (const bf16_t*)(p.ws + WS_Q); const bf16_t* KVB = (const bf16_t*)(p.ws + WS_KVB);
    const bf16_t* KC = (const bf16_t*)(p.ws + WS_KC); const bf16_t* VC = (const bf16_t*)(p.ws + WS_VC);
    const float* GATE = (const float*)(p.ws + WS_GATE);
    for (int u = blockIdx.x; u < T; u += gridDim.x) {
        const int b = u >> 13, t = u & (S - 1);
        const int ncv = t >= 31 ? ((t - 31) >> 4) + 1 : 0;
        const bf16_t* kc = KC + (size_t)(b * 4 + g) * NC * 64; const bf16_t* vc = VC + (size_t)(b * 4 + g) * NC * 64;
        float oc[2], os[2], ow[2];
        for (int hh = 0; hh < 2; ++hh) {
            const int head = wave * 2 + hh;
            float q[64];
            { const u32x4* qp = (const u32x4*)(Q + (size_t)u * D + head * 64);
#pragma unroll
                for (int i = 0; i < 8; ++i) { const u32x4 w = qp[i]; q[8 * i] = bflo(w.x); q[8 * i + 1] = bfhi(w.x); q[8 * i + 2] = bflo(w.y); q[8 * i + 3] = bfhi(w.y); q[8 * i + 4] = bflo(w.z); q[8 * i + 5] = bfhi(w.z); q[8 * i + 6] = bflo(w.w); q[8 * i + 7] = bfhi(w.w); } }
            float mx = -3.0e38f;
            for (int kk = lane; kk < ncv; kk += 64) { const int dist = t - (16 * kk + 31); const float s = dot64(q, kc + (size_t)kk * 64) + hb[head * 32 + lut[dist < 1023 ? dist : 1023]]; sc[kk] = s; mx = fmaxf(mx, s); }
            mx = wave_max(mx); float sum = 0.f;
            for (int kk = lane; kk < ncv; kk += 64) { const float e = __expf(sc[kk] - mx); sc[kk] = e; sum += e; }
            sum = wave_sum(sum); const float inv = ncv > 0 ? 1.f / sum : 0.f;
            for (int kk = lane; kk < NC; kk += 64) { const float pv = kk < ncv ? sc[kk] * inv : 0.f; pc[head * 512 + kk] = pv; }
            asm volatile("s_waitcnt lgkmcnt(0)" ::: "memory");
            float o = 0.f;
            for (int kk = 0; kk < ncv; ++kk) o += pc[head * 512 + kk] * bf2f(vc[(size_t)kk * 64 + lane]);
            oc[hh] = o;
        }
        __syncthreads();
        LAS int* sel = (LAS int*)(lds + 65536 + 4096) + wave * NSEL;
        {
            const int cur = t >> 6; float cs[2];
#pragma unroll
            for (int h2 = 0; h2 < 2; ++h2) { const int j = lane + 64 * h2; float ps = 0.f;
#pragma unroll
                for (int k = 0; k < 5; ++k) { const int c = 4 * j + k - 1; if (c >= 0 && c < ncv) { const float wk = (k == 0 || k == 4) ? 1.f : 2.f;
                    ps += wk * (((pc[(4 * g + 0) * 512 + c] + pc[(4 * g + 1) * 512 + c]) + pc[(4 * g + 2) * 512 + c]) + pc[(4 * g + 3) * 512 + c]); } }
                const bool forced = (j == 0) || (j == cur) || (j == cur - 1), valid = j * 64 <= t;
                cs[h2] = forced ? 1.0e6f : (valid ? ps : -1.0e6f); }
#pragma unroll
            for (int i = 0; i < NSEL; ++i) {
                float bv; int bi;
                if (cs[0] >= cs[1]) { bv = cs[0]; bi = lane; } else { bv = cs[1]; bi = lane + 64; }
#pragma unroll
                for (int o = 1; o < 64; o <<= 1) { const float ov = __shfl_xor(bv, o); const int oi = __shfl_xor(bi, o); if (ov > bv || (ov == bv && oi < bi)) { bv = ov; bi = oi; } }
                if (lane == 0) sel[i] = bi;
                if (bi == lane) cs[0] = -3.0e38f;
                if (bi == lane + 64) cs[1] = -3.0e38f;
            }
        }
        for (int hh = 0; hh < 2; ++hh) {
            const int head = wave * 2 + hh;
            float q[64];
            { const u32x4* qp = (const u32x4*)(Q + (size_t)u * D + head * 64);
#pragma unroll
                for (int i = 0; i < 8; ++i) { const u32x4 w = qp[i]; q[8 * i] = bflo(w.x); q[8 * i + 1] = bfhi(w.x); q[8 * i + 2] = bflo(w.y); q[8 * i + 3] = bfhi(w.y); q[8 * i + 4] = bflo(w.z); q[8 * i + 5] = bfhi(w.z); q[8 * i + 6] = bflo(w.w); q[8 * i + 7] = bfhi(w.w); } }
            const bf16_t* kvb = KVB + (size_t)b * S * NKV + g * 64;
            {
                float mx = -3.0e38f;
#pragma unroll
                for (int i = 0; i < NSEL; ++i) { const int pos = sel[i] * 64 + lane; float s = -3.0e38f;
                    if (pos <= t) { const int dist = t - pos; s = dot64(q, kvb + (size_t)pos * NKV + 512) + hb[head * 32 + lut[dist < 1023 ? dist : 1023]]; }
                    sc[i * 64 + lane] = s; mx = fmaxf(mx, s); }
                mx = wave_max(mx); float sum = 0.f;
#pragma unroll
                for (int i = 0; i < NSEL; ++i) { const float s = sc[i * 64 + lane]; const float e = s > -1.0e38f ? __expf(s - mx) : 0.f; sc[i * 64 + lane] = e; sum += e; }
                sum = wave_sum(sum); const float inv = 1.f / sum;
                asm volatile("s_waitcnt lgkmcnt(0)" ::: "memory");
                float o = 0.f;
#pragma unroll 1
                for (int i = 0; i < NSEL; ++i) { const int pos0 = sel[i] * 64; if (pos0 > t) continue; const int nk = (t - pos0 + 1 < 64) ? t - pos0 + 1 : 64;
                    for (int l = 0; l < nk; ++l) o += sc[i * 64 + l] * bf2f(kvb[(size_t)(pos0 + l) * NKV + 768 + lane]); }
                os[hh] = o * inv;
            }
            {
                float mx = -3.0e38f;
#pragma unroll
                for (int i = 0; i < 8; ++i) { const int pos = t - 511 + i * 64 + lane; float s = -3.0e38f;
                    if (pos >= 0) { const int dist = t - pos; s = dot64(q, kvb + (size_t)pos * NKV + 1024) + hb[head * 32 + lut[dist]]; }
                    sc[i * 64 + lane] = s; mx = fmaxf(mx, s); }
                mx = wave_max(mx); float sum = 0.f;
#pragma unroll
                for (int i = 0; i < 8; ++i) { const float s = sc[i * 64 + lane]; const float e = s > -1.0e38f ? __expf(s - mx) : 0.f; sc[i * 64 + lane] = e; sum += e; }
                sum = wave_sum(sum); const float inv = 1.f / sum;
                asm volatile("s_waitcnt lgkmcnt(0)" ::: "memory");
                float o = 0.f; const int p0 = t - 511 > 0 ? t - 511 : 0;
                for (int pos = p0; pos <= t; ++pos) o += sc[pos - (t - 511)] * bf2f(kvb[(size_t)pos * NKV + 1280 + lane]);
                ow[hh] = o * inv;
            }
            const float* gt = GATE + (size_t)u * 48 + head * 3;
            const float r = gt[0] * oc[hh] + gt[1] * os[hh] + gt[2] * ow[hh];
            AO[(size_t)u * D + head * 64 + lane] = (bf16_t)(cvt_pk_bf16(r, 0.f) & 0xffffu);
        }
        __syncthreads();
    }
}

__device__ __forceinline__ void moe_pstarts(const unsigned* ctl, int (&pst)[NE + 1]) {
    int a = 0;
#pragma unroll
    for (int e = 0; e < NE; ++e) { pst[e] = a; const int c = (int)ctl[CW_CNT + e]; a += (c + 511) / 512 * 512; }
    pst[NE] = a;
}
__device__ __forceinline__ void phase_moe_sort(const Params& p) {
    const int tid = threadIdx.x, lane = tid & 63, wave = tid >> 6;
    const int gw = blockIdx.x * NWAVE + wave, NGW = gridDim.x * NWAVE;
    unsigned* ctl = (unsigned*)(p.ws + WS_CTL);
    const int* TOPE = (const int*)(p.ws + WS_TOPE); int* RPOS = (int*)(p.ws + WS_RPOS); int* RTOK = (int*)(p.ws + WS_RTOK);
    int pst[NE + 1]; moe_pstarts(ctl, pst);
    if (blockIdx.x == 0 && tid <= NE) ((int*)(ctl + 256))[tid] = pst[tid];
    for (int base = gw * 64; base < 2 * T; base += NGW * 64) {
        const int a = base + lane, e = TOPE[a];
        int pos = 0;
#pragma unroll
        for (int q = 0; q < NE; ++q) {
            const unsigned long long m = __ballot(e == q);
            if (m) { const int n = __popcll(m); unsigned st = 0; if (lane == 0) st = atomicAdd(ctl + CW_CUR + q, (unsigned)n); st = __shfl(st, 0);
                if (e == q) pos = pst[q] + (int)st + __popcll(m & ((1ull << lane) - 1ull)); }
        }
        RPOS[a] = pos; RTOK[pos] = a >> 1;
    }
}
__device__ __forceinline__ void phase_fill_rtok(const Params& p) {
    int* RTOK = (int*)(p.ws + WS_RTOK);
    for (int i = blockIdx.x * NTHR + threadIdx.x; i < MOE_ROWS; i += gridDim.x * NTHR) RTOK[i] = 0;
}
__device__ __forceinline__ void phase_combine(const Params& p) {
    const int tid = threadIdx.x, lane = tid & 63, wave = tid >> 6;
    const int gw = blockIdx.x * NWAVE + wave, NGW = gridDim.x * NWAVE;
    const float* TOPW = (const float*)(p.ws + WS_TOPW); const int* RPOS = (const int*)(p.ws + WS_RPOS);
    const bf16_t* Y = (const bf16_t*)(p.ws + WS_Y); const float* g2 = (const float*)(p.ws + WS_MODV) + (11 * 4) * D;
    for (int r = gw; r < T; r += NGW) {
        const int b = r >> 13; const int p0 = RPOS[2 * r], p1 = RPOS[2 * r + 1]; const float w0 = TOPW[2 * r], w1 = TOPW[2 * r + 1];
#pragma unroll
        for (int j = 0; j < 4; ++j) { const int c = 4 * lane + 256 * j;
            const u32x2 y0 = *(const u32x2*)(Y + (size_t)p0 * D + c), y1 = *(const u32x2*)(Y + (size_t)p1 * D + c);
            const f32x4 gv = *(const f32x4*)(g2 + b * D + c); f32x4 xv = *(const f32x4*)(p.out + (size_t)r * D + c);
            f32x4 f; f.x = w0 * bflo(y0.x) + w1 * bflo(y1.x); f.y = w0 * bfhi(y0.x) + w1 * bfhi(y1.x); f.z = w0 * bflo(y0.y) + w1 * bflo(y1.y); f.w = w0 * bfhi(y0.y) + w1 * bfhi(y1.y);
            *(f32x4*)(p.out + (size_t)r * D + c) = xv + gv * f; }
    }
}

#define KERNEL(name) __global__ void __launch_bounds__(NTHR, 2) name(Params p)
#define LDSDECL extern __shared__ __attribute__((aligned(16))) unsigned char lds_raw[]; LAS unsigned char* lds = (LAS unsigned char*)lds_raw
#define MODP(which) ((const float*)(p.ws + WS_MODV) + (size_t)(which) * 4 * D)

KERNEL(k_weights) { LDSDECL; phase_weights(p, lds); }
KERNEL(k_modvec) { LDSDECL; phase_modvec(p, lds); phase_fill_rtok(p); }
KERNEL(k_poolmix) { LDSDECL; phase_poolmix(p, lds, (bf16_t*)(p.ws + WS_HA)); }
KERNEL(k_poolgemm) {
    for (int g = 0; g < 4; ++g) {
        GemmArgs a{(const bf16_t*)(p.ws + WS_HA) + g * 256, (const bf16_t*)(p.ws + WO_POOL) + (size_t)g * 65536, T, 256, 256, D, 256};
        EpiPool E{p.x, (float*)(p.ws + WS_X1), MODP(2), p.pool_scale, g * 256};
        gemm_simple<EpiPool, 0, false>(a, E, nullptr, nullptr, 0);
    }
}
KERNEL(k_norm1) { LDSDECL; NormOut o0{p.norm_g + D, MODP(4), MODP(3), (bf16_t*)(p.ws + WS_HB)}; phase_norm<1, false>(p, lds, (const float*)(p.ws + WS_X1), o0, o0); }
KERNEL(k_ffn_gu) {
    GemmArgs a{(const bf16_t*)(p.ws + WS_HB), (const bf16_t*)(p.ws + WO_FGU), T, 2 * FF, D, D, D};
    EpiSwiglu E{(bf16_t*)(p.ws + WS_HID0), FF};
    gemm_simple<EpiSwiglu, 0, true>(a, E, nullptr, nullptr, 0);
}
KERNEL(k_ffn_dn) {
    GemmArgs a{(const bf16_t*)(p.ws + WS_HID0), (const bf16_t*)(p.ws + WO_FDN), T, D, FF, FF, FF};
    EpiResid E{(const float*)(p.ws + WS_X1), (float*)(p.ws + WS_X2), MODP(5)};
    gemm_simple<EpiResid, 0, false>(a, E, nullptr, nullptr, 0);
}
KERNEL(k_norm2) { LDSDECL; NormOut o0{p.kv_norm_g, MODP(13), MODP(12), (bf16_t*)(p.ws + WS_HA)}; NormOut o1{p.norm_g + 2 * D, MODP(7), MODP(6), (bf16_t*)(p.ws + WS_HB)};
    phase_norm<2, false>(p, lds, (const float*)(p.ws + WS_X2), o0, o1); }
KERNEL(k_kvq) {
    { GemmArgs a{(const bf16_t*)(p.ws + WS_HA), (const bf16_t*)(p.ws + WO_KV), T, NKV, D, D, D}; EpiBf16 E{(bf16_t*)(p.ws + WS_KVB), NKV}; gemm_simple<EpiBf16, 0, false>(a, E, nullptr, nullptr, 0); }
    { GemmArgs a{(const bf16_t*)(p.ws + WS_HB), (const bf16_t*)(p.ws + WO_Q), T, NQP, D, D, D}; EpiQ E{(bf16_t*)(p.ws + WS_Q), (float*)(p.ws + WS_GATE)}; gemm_simple<EpiQ, 0, false>(a, E, nullptr, nullptr, 0); }
}
KERNEL(k_post) {
    for (int kv = 0; kv < 2; ++kv)
        for (int g = 0; g < 4; ++g) {
            GemmArgs a{(const bf16_t*)(p.ws + WS_KVB) + kv * 256 + g * 64, (const bf16_t*)(p.ws + (kv ? WO_CV : WO_CK)), 2048, 256, 2048, 16 * NKV, 2048};
            EpiCmp E{(bf16_t*)(p.ws + WS_CMPH) + (size_t)(kv * 4 + g) * 2048 * 256, (const float*)(p.ws + WS_CMPB) + kv * 256};
            gemm_simple<EpiCmp, 2, false>(a, E, nullptr, nullptr, 0);
        }
    phase_headnorm(p);
}
KERNEL(k_cmp2) { phase_cmp2(p); }
KERNEL(k_attn) { LDSDECL; phase_attn_naive(p, lds, (bf16_t*)(p.ws + WS_HA)); }
KERNEL(k_oproj) {
    GemmArgs a{(const bf16_t*)(p.ws + WS_HA), (const bf16_t*)(p.ws + WO_O), T, D, D, D, D};
    EpiResid E{(const float*)(p.ws + WS_X2), p.out, MODP(8)};
    gemm_simple<EpiResid, 0, false>(a, E, nullptr, nullptr, 0);
}
KERNEL(k_norm3) { LDSDECL; NormOut o0{p.norm_g + 3 * D, MODP(10), MODP(9), (bf16_t*)(p.ws + WS_HB)}; phase_norm<1, true>(p, lds, p.out, o0, o0); }
KERNEL(k_sort) { phase_moe_sort(p); }
KERNEL(k_moe_gu) {
    GemmArgs a{(const bf16_t*)(p.ws + WS_HB), (const bf16_t*)(p.ws + WO_EGU), MOE_ROWS, 2 * FE, D, D, D};
    EpiSwiglu E{(bf16_t*)(p.ws + WS_HIDM), FE};
    gemm_simple<EpiSwiglu, 1, true>(a, E, (const int*)(p.ws + WS_RTOK), (const int*)(p.ws + WS_CTL) + 256, (size_t)2 * FE * D);
}
KERNEL(k_moe_dn) {
    GemmArgs a{(const bf16_t*)(p.ws + WS_HIDM), (const bf16_t*)(p.ws + WO_EDN), MOE_ROWS, D, FE, FE, FE};
    EpiBf16 E{(bf16_t*)(p.ws + WS_Y), D};
    gemm_simple<EpiBf16, 0, false>(a, E, nullptr, (const int*)(p.ws + WS_CTL) + 256, (size_t)D * FE);
}
KERNEL(k_combine) { phase_combine(p); }

extern "C" void kernel_launch(void* const* d_in, const int* in_sizes, int n_in, void* d_out, int out_size, void* d_ws, size_t ws_size, hipStream_t stream) {
    if (n_in != 28 || out_size != T * D || ws_size < WS_END) { fprintf(stderr, "kernel_launch: unexpected shapes (n_in %d out %d ws %zu need %zu)\n", n_in, out_size, ws_size, (size_t)WS_END); return; }
    Params p{};
    const float** pp = (const float**)&p;
    for (int i = 0; i < 28; ++i) pp[i] = (const float*)d_in[i];
    p.out = (float*)d_out; p.ws = (unsigned char*)d_ws;
    (void)hipMemsetAsync((char*)d_ws + WS_CTL, 0, CTL_BYTES, stream);
    const dim3 grid(256), blk(NTHR);
    static bool attr = false;
    if (!attr) { attr = true; (void)hipFuncSetAttribute((const void*)k_weights, hipFuncAttributeMaxDynamicSharedMemorySize, 131072); (void)hipFuncSetAttribute((const void*)k_attn, hipFuncAttributeMaxDynamicSharedMemorySize, 131072); }
    k_weights<<<grid, blk, 131072, stream>>>(p);
    k_modvec<<<grid, blk, 8192, stream>>>(p);
    k_poolmix<<<grid, blk, 1024, stream>>>(p);
    k_poolgemm<<<grid, blk, 0, stream>>>(p);
    k_norm1<<<grid, blk, 0, stream>>>(p);
    k_ffn_gu<<<grid, blk, 0, stream>>>(p);
    k_ffn_dn<<<grid, blk, 0, stream>>>(p);
    k_norm2<<<grid, blk, 0, stream>>>(p);
    k_kvq<<<grid, blk, 0, stream>>>(p);
    k_post<<<grid, blk, 0, stream>>>(p);
    k_cmp2<<<grid, blk, 0, stream>>>(p);
    k_attn<<<grid, blk, 131072, stream>>>(p);
    k_oproj<<<grid, blk, 0, stream>>>(p);
    k_norm3<<<grid, blk, 32768, stream>>>(p);
    k_sort<<<grid, blk, 0, stream>>>(p);
    k_moe_gu<<<grid, blk, 0, stream>>>(p);
    k_moe_dn<<<grid, blk, 0, stream>>>(p);
    k_combine<<<grid, blk, 0, stream>>>(p);
}
```

```cpp
#include <hip/hip_runtime.h>
#include <cstdint>
#include <cstdio>

#define LAS __attribute__((address_space(3)))
typedef unsigned short bf16_t;
typedef short bf16x8 __attribute__((ext_vector_type(8)));
typedef float f32x4 __attribute__((ext_vector_type(4)));
typedef float f32x2 __attribute__((ext_vector_type(2)));
typedef unsigned u32x4 __attribute__((ext_vector_type(4)));
typedef unsigned u32x2 __attribute__((ext_vector_type(2)));

constexpr int NB = 4, S = 8192, D = 1024, T = NB * S;
constexpr int FF = 2816, NE = 8, FE = 3584;
constexpr int NKV = 1536, NQP = 1280, NQ = 1072;
constexpr int G = 4, HD = 64, NH = 16;
constexpr int NC = 512;
constexpr int NSB = 128;
constexpr int NSEL = 16;
constexpr int WIN = 512;
constexpr int MOE_ROWS = 69632;
constexpr float EPS = 1e-6f;
constexpr int NTHR = 512, NWAVE = 8;

constexpr size_t MiB = 1u << 20;
constexpr size_t WS_CTL = 0, CTL_BYTES = 1 * MiB;
constexpr size_t WS_MODV = 1 * MiB;
constexpr size_t WS_CMPB = WS_MODV + 14 * 4 * 1024 * 4;
constexpr size_t WS_TOPE = 2 * MiB;
constexpr size_t WS_TOPW = WS_TOPE + (size_t)T * 8;
constexpr size_t WS_RPOS = WS_TOPW + (size_t)T * 8;
constexpr size_t WS_RTOK = WS_RPOS + (size_t)T * 8;
constexpr size_t WS_SMALL_END = WS_RTOK + (size_t)MOE_ROWS * 4;
static_assert(WS_SMALL_END <= 8 * MiB, "small region");
constexpr size_t WS_W = 8 * MiB;
constexpr size_t WO_POOL = WS_W;
constexpr size_t WO_FGU = WO_POOL + (size_t)4 * 256 * 256 * 2;
constexpr size_t WO_FDN = WO_FGU + (size_t)2 * FF * D * 2;
constexpr size_t WO_KV = WO_FDN + (size_t)D * FF * 2;
constexpr size_t WO_Q = WO_KV + (size_t)NKV * D * 2;
constexpr size_t WO_O = WO_Q + (size_t)NQP * D * 2;
constexpr size_t WO_CK = WO_O + (size_t)D * D * 2;
constexpr size_t WO_CV = WO_CK + (size_t)256 * 2048 * 2;
constexpr size_t WO_EGU = WO_CV + (size_t)256 * 2048 * 2;
constexpr size_t WO_EDN = WO_EGU + (size_t)NE * 2 * FE * D * 2;
constexpr size_t WO_END = WO_EDN + (size_t)NE * D * FE * 2;
static_assert(WO_END <= 203 * MiB, "weights region");
constexpr size_t WS_HB = 203 * MiB;
constexpr size_t WS_X1 = 267 * MiB;
constexpr size_t WS_X2 = 395 * MiB;
constexpr size_t WS_HID0 = 523 * MiB;
constexpr size_t WS_Q = 523 * MiB;
constexpr size_t WS_GATE = 587 * MiB;
constexpr size_t WS_CMPH = 593 * MiB;
constexpr size_t WS_KC = 601 * MiB;
constexpr size_t WS_VC = 602 * MiB;
constexpr size_t WS_KSB = 603 * MiB;
constexpr size_t WS_VSB = 619 * MiB;
constexpr size_t WS_KWB = 635 * MiB;
constexpr size_t WS_VWB = 651 * MiB;
constexpr size_t WS_Q8 = 267 * MiB;
constexpr size_t WS_SEL = 667 * MiB;
constexpr size_t WS_HA = 699 * MiB;
constexpr size_t WS_KVB = 763 * MiB;
constexpr size_t WS_HIDM = 267 * MiB;
constexpr size_t WS_Y = 743 * MiB;
constexpr size_t WS_XS = WS_Y;
constexpr size_t WS_END = 880 * MiB;
static_assert(WS_HIDM + (size_t)MOE_ROWS * FE * 2 <= WS_Y && WS_Y + (size_t)MOE_ROWS * D * 2 <= WS_END, "moe map");
static_assert(WS_KVB + (size_t)T * NKV * 2 + 65536 <= WS_END, "kv map");
constexpr int CW_CNT = 512;
constexpr int CW_CUR = 1024;
constexpr int CW_HN = 2048, CW_VT = 2112;
constexpr int CW_BAR = 4096;

struct Params {
    const float *x, *c, *ada_w, *ada_b, *norm_g, *pool_w, *pool_scale, *q_w, *q_gain, *o_w, *kv_ada_w, *kv_ada_b, *kv_norm_g, *kv_w,
        *cmp_pe_k, *cmp_pe_v, *cmp_k_w1, *cmp_k_w2, *cmp_v_w1, *cmp_v_w2, *k_gain, *rel_bias, *ffn_gu, *ffn_dn, *router_w, *router_b, *exp_gu, *exp_dn;
    float* out; unsigned char* ws;
};

__device__ __forceinline__ unsigned cvt_pk_bf16(float lo, float hi) { unsigned r; asm volatile("v_cvt_pk_bf16_f32 %0, %1, %2" : "=v"(r) : "v"(lo), "v"(hi)); return r; }
__device__ __forceinline__ float bf2f(unsigned short v) { return __uint_as_float((unsigned)v << 16); }
__device__ __forceinline__ float bflo(unsigned w) { return __uint_as_float(w << 16); }
__device__ __forceinline__ float bfhi(unsigned w) { return __uint_as_float(w & 0xffff0000u); }
__device__ __forceinline__ int opaque_tid() { int t = threadIdx.x; asm volatile("" : "+v"(t)); return t; }
__device__ __forceinline__ float readlane_f(float v, int l) { return __uint_as_float((unsigned)__builtin_amdgcn_readlane((int)__float_as_uint(v), l)); }
__device__ __forceinline__ unsigned pack_i8x4(float a, float b, float c, float d) {
    const int ia = (int)__builtin_rintf(fminf(fmaxf(a, -127.f), 127.f)), ib = (int)__builtin_rintf(fminf(fmaxf(b, -127.f), 127.f)), ic = (int)__builtin_rintf(fminf(fmaxf(c, -127.f), 127.f)), id = (int)__builtin_rintf(fminf(fmaxf(d, -127.f), 127.f));
    return (unsigned)(ia & 0xff) | ((unsigned)(ib & 0xff) << 8) | ((unsigned)(ic & 0xff) << 16) | ((unsigned)(id & 0xff) << 24);
}
__device__ __forceinline__ float sel_q_scale(const float* q_gain) { float m = 0.f; for (int i = 0; i < 64; ++i) m = fmaxf(m, fabsf(q_gain[i])); return 127.f / (4.f * m * 0.125f * 1.4426950408889634f); }
__device__ __forceinline__ float sel_k_scale(const float* k_gain) { float m = 0.f; for (int i = 0; i < 64; ++i) m = fmaxf(m, fabsf(k_gain[64 + i])); return 127.f / (4.f * m); }
__device__ __forceinline__ float wave_sum(float v) {
#pragma unroll
    for (int o = 1; o < 64; o <<= 1) v += __shfl_xor(v, o);
    return v;
}
__device__ __forceinline__ float wave_max(float v) {
#pragma unroll
    for (int o = 1; o < 64; o <<= 1) v = fmaxf(v, __shfl_xor(v, o));
    return v;
}
__device__ __forceinline__ float silu_f(float v) { return v / (1.f + __expf(-v)); }
__device__ __forceinline__ float sigmoid_f(float v) { return 1.f / (1.f + __expf(-v)); }
__device__ __forceinline__ float gelu_tanh_f(float v) {
    const float u = 0.7978845608028654f * (v + 0.044715f * v * v * v);
    const float e = __expf(-2.f * fabsf(u)); const float th = (1.f - e) / (1.f + e);
    return 0.5f * v * (1.f + (u < 0.f ? -th : th));
}
__device__ __forceinline__ int rel_bucket(int d) {
    if (d < 16) return d;
    int b = 16;
    b += (d >= 21); b += (d >= 27); b += (d >= 35); b += (d >= 46); b += (d >= 59); b += (d >= 77); b += (d >= 99); b += (d >= 128);
    b += (d >= 166); b += (d >= 216); b += (d >= 280); b += (d >= 363); b += (d >= 470); b += (d >= 609); b += (d >= 790);
    return b;
}

template <bool FP8 = false>
__device__ __forceinline__ void transpose_item(const float* W, int K, int N, bf16_t* WT, int k0, int n0, int drow0, LAS float* scr, int lane, float wscale = 1.f) {
    float wv[32];
#pragma unroll
    for (int i = 0; i < 32; ++i) { const int kk = 2 * i + (lane >> 5); const int n = n0 + (lane & 31); wv[i] = (n < N) ? W[(size_t)(k0 + kk) * N + n] : 0.f; }
#pragma unroll
    for (int i = 0; i < 32; ++i) { const int kk = 2 * i + (lane >> 5); scr[kk * 33 + (lane & 31)] = wv[i]; }
    asm volatile("s_waitcnt lgkmcnt(0)" ::: "memory");
    const int c = lane & 7;
#pragma unroll
    for (int j = 0; j < 4; ++j) { const int n = (lane >> 3) + 8 * j; const LAS float* s = scr + (8 * c) * 33 + n;
        if constexpr (FP8) {
            unsigned w0 = 0u, w1 = 0u;
            w0 = __builtin_amdgcn_cvt_pk_fp8_f32(s[0 * 33] * wscale, s[1 * 33] * wscale, w0, false); w0 = __builtin_amdgcn_cvt_pk_fp8_f32(s[2 * 33] * wscale, s[3 * 33] * wscale, w0, true);
            w1 = __builtin_amdgcn_cvt_pk_fp8_f32(s[4 * 33] * wscale, s[5 * 33] * wscale, w1, false); w1 = __builtin_amdgcn_cvt_pk_fp8_f32(s[6 * 33] * wscale, s[7 * 33] * wscale, w1, true);
            *(u32x2*)((unsigned char*)WT + (size_t)(drow0 + n) * K + k0 + 8 * c) = (u32x2){w0, w1};
        } else {
        u32x4 o; o.x = cvt_pk_bf16(s[0 * 33], s[1 * 33]); o.y = cvt_pk_bf16(s[2 * 33], s[3 * 33]); o.z = cvt_pk_bf16(s[4 * 33], s[5 * 33]); o.w = cvt_pk_bf16(s[6 * 33], s[7 * 33]);
        *(u32x4*)(WT + (size_t)(drow0 + n) * K + k0 + 8 * c) = o; } }
    asm volatile("s_waitcnt lgkmcnt(0)" ::: "memory");
}
template <int MODE, bool FP8 = false>
__device__ __forceinline__ void transpose_mat(const float* W, int K, int N, int NP, int F, bf16_t* WT, int it, LAS float* scr, int lane, float wscale = 1.f) {
    const int nblk = NP / 32, kb = it / nblk, nb = it % nblk, n0 = nb * 32;
    int drow0 = n0;
    if (MODE == 1) { const int up = n0 >= F, j = up ? n0 - F : n0; drow0 = (j >> 7) * 256 + (up ? 128 : 0) + (j & 127); }
    transpose_item<FP8>(W, K, N, WT, kb * 64, n0, drow0, scr, lane, wscale);
}
__device__ __forceinline__ void phase_weights(const Params& p, LAS unsigned char* lds) {
    const int tid = opaque_tid(), lane = tid & 63, wave = tid >> 6;
    LAS float* scr = (LAS float*)(lds + wave * 16384);
    const int gw = blockIdx.x * NWAVE + wave, NGW = gridDim.x * NWAVE;
    unsigned char* ws = p.ws;
    constexpr int I_POOL = 4 * 8, I_FGU = 16 * 176, I_FDN = 44 * 32, I_KV = 16 * 48, I_Q = 16 * 40, I_O = 16 * 32, I_C = 32 * 8, I_EGU = 16 * 224, I_EDN = 56 * 32;
    constexpr int TOT = 4 * I_POOL + I_FGU + I_FDN + I_KV + I_Q + I_O + 2 * I_C + NE * I_EGU + NE * I_EDN;
    for (int it = gw; it < TOT; it += NGW) {
        int r = it;
        if (r < 4 * I_POOL) { const int g = r / I_POOL; transpose_mat<0>(p.pool_w + (size_t)g * 65536, 256, 256, 256, 0, (bf16_t*)(ws + WO_POOL) + (size_t)g * 65536, r % I_POOL, scr, lane); continue; } r -= 4 * I_POOL;
        if (r < I_FGU) { transpose_mat<1>(p.ffn_gu, D, 2 * FF, 2 * FF, FF, (bf16_t*)(ws + WO_FGU), r, scr, lane); continue; } r -= I_FGU;
        if (r < I_FDN) { transpose_mat<0>(p.ffn_dn, FF, D, D, 0, (bf16_t*)(ws + WO_FDN), r, scr, lane); continue; } r -= I_FDN;
        if (r < I_KV) { transpose_mat<0>(p.kv_w, D, NKV, NKV, 0, (bf16_t*)(ws + WO_KV), r, scr, lane); continue; } r -= I_KV;
        if (r < I_Q) { transpose_mat<0>(p.q_w, D, NQ, NQP, 0, (bf16_t*)(ws + WO_Q), r, scr, lane); continue; } r -= I_Q;
        if (r < I_O) { transpose_mat<0>(p.o_w, D, D, D, 0, (bf16_t*)(ws + WO_O), r, scr, lane); continue; } r -= I_O;
        if (r < I_C) { transpose_mat<0>(p.cmp_k_w1, 2048, 256, 256, 0, (bf16_t*)(ws + WO_CK), r, scr, lane); continue; } r -= I_C;
        if (r < I_C) { transpose_mat<0>(p.cmp_v_w1, 2048, 256, 256, 0, (bf16_t*)(ws + WO_CV), r, scr, lane); continue; } r -= I_C;
        if (r < NE * I_EGU) { const int e = r / I_EGU; transpose_mat<1, true>(p.exp_gu + (size_t)e * D * 2 * FE, D, 2 * FE, 2 * FE, FE, (bf16_t*)(ws + WO_EGU + (size_t)e * 2 * FE * D), r % I_EGU, scr, lane, 32.f); continue; } r -= NE * I_EGU;
        { const int e = r / I_EDN; transpose_mat<0, true>(p.exp_dn + (size_t)e * FE * D, FE, D, D, 0, (bf16_t*)(ws + WO_EDN + (size_t)e * D * FE), r % I_EDN, scr, lane, 64.f); }
    }
}

__device__ __forceinline__ void phase_modvec(const Params& p, LAS unsigned char* lds) {
    const int tid = opaque_tid(), lane = tid & 63, wave = tid >> 6;
    LAS float* part = (LAS float*)lds;
    LAS float* sc_l = (LAS float*)(lds + 8192);
    for (int i = tid; i < 4 * D; i += NTHR) sc_l[i] = silu_f(p.c[i]);
    __syncthreads();
    float* MODV = (float*)(p.ws + WS_MODV);
    float* CMPB = (float*)(p.ws + WS_CMPB);
    constexpr int NU_MOD = 14336 / 64, NU = NU_MOD + 8;
    for (int u = blockIdx.x; u < NU; u += gridDim.x) {
        float acc[4] = {0.f, 0.f, 0.f, 0.f};
        if (u < NU_MOD) {
            const int gc = u * 64 + lane;
            const float* W; int ldw, col;
            if (gc < 6144) { W = p.ada_w; ldw = 6144; col = gc; } else if (gc < 12288) { W = p.ada_w + (size_t)D * 6144; ldw = 6144; col = gc - 6144; } else { W = p.kv_ada_w; ldw = 2048; col = gc - 12288; }
#pragma unroll 16
            for (int k = wave * 128; k < wave * 128 + 128; ++k) {
                const float w = W[(size_t)k * ldw + col];
#pragma unroll
                for (int b = 0; b < 4; ++b) acc[b] += sc_l[b * D + k] * w;
            }
        } else {
            const int cu = u - NU_MOD, kv = cu >> 2, col = (cu & 3) * 64 + lane;
            const float* W = kv ? p.cmp_v_w1 : p.cmp_k_w1; const float* pe = kv ? p.cmp_pe_v : p.cmp_pe_k;
#pragma unroll 16
            for (int k = wave * 256; k < wave * 256 + 256; ++k) acc[0] += pe[k] * W[(size_t)k * 256 + col];
        }
#pragma unroll
        for (int b = 0; b < 4; ++b) part[(wave * 4 + b) * 64 + lane] = acc[b];
        __syncthreads();
        if (tid < 256) {
            const int b = tid >> 6; float s = 0.f;
#pragma unroll
            for (int w = 0; w < 8; ++w) s += part[(w * 4 + b) * 64 + lane];
            if (u < NU_MOD) {
                const int gc = u * 64 + lane; int which, n; float bias;
                if (gc < 6144) { which = gc >> 10; n = gc & 1023; bias = p.ada_b[gc]; } else if (gc < 12288) { which = 6 + ((gc - 6144) >> 10); n = gc & 1023; bias = p.ada_b[gc]; }
                else { which = 12 + ((gc - 12288) >> 10); n = gc & 1023; bias = p.kv_ada_b[gc - 12288]; }
                MODV[(which * 4 + b) * D + n] = s + bias;
            } else if (b == 0) { const int cu = u - NU_MOD; CMPB[(cu >> 2) * 256 + (cu & 3) * 64 + lane] = s; }
        }
        __syncthreads();
    }
}

template <int W>
__device__ __forceinline__ void pool_rows(const float* xb, int t0, const LAS float* rs, f32x2 gm, f32x2 sh, bf16_t* outb, int c0) {
    f32x2 ring[16];
#pragma unroll
    for (int i = 0; i < 15; ++i) {
        const int t = t0 - 15 + i; f32x2 h = {0.f, 0.f};
        if (t >= 0) { const f32x2 xv = *(const f32x2*)(xb + (size_t)t * D + c0); const float r = rs[i]; h = xv * r * gm + sh; }
        ring[i] = h;
    }
    for (int gi = 0; gi < 8; ++gi) {
#pragma unroll
        for (int j = 0; j < 16; ++j) {
            const int i = 15 + gi * 16 + j, t = t0 + gi * 16 + j;
            const f32x2 xv = *(const f32x2*)(xb + (size_t)t * D + c0); const float r = rs[i];
            const f32x2 h = xv * r * gm + sh;
            ring[(15 + j) & 15] = h;
            f32x2 s = {0.f, 0.f};
#pragma unroll
            for (int k = 0; k < W; ++k) s += ring[(15 + j - k) & 15];
            const int cnt = (t + 1 < W) ? t + 1 : W;
            const f32x2 o = s * (1.f / (float)cnt) - h;
            *(unsigned*)(outb + (size_t)t * D + c0) = cvt_pk_bf16(o.x, o.y);
        }
    }
}
__device__ __forceinline__ void phase_poolmix(const Params& p, LAS unsigned char* lds, bf16_t* mixA) {
    const int tid = opaque_tid(), lane = tid & 63, wave = tid >> 6;
    LAS float* rs = (LAS float*)lds;
    const float* MODV = (const float*)(p.ws + WS_MODV);
    for (int u = blockIdx.x; u < T / 128; u += gridDim.x) {
        const int b = u >> 6, t0 = (u & 63) * 128;
        const float* xb = p.x + (size_t)b * S * D;
        for (int i = wave; i < 143; i += NWAVE) {
            const int t = t0 - 15 + i; float r = 0.f;
            if (t >= 0) { const f32x4* xr = (const f32x4*)(xb + (size_t)t * D) + lane; float s = 0.f;
#pragma unroll
                for (int j = 0; j < 4; ++j) { const f32x4 v = xr[64 * j]; s += (v.x * v.x + v.y * v.y) + (v.z * v.z + v.w * v.w); }
                r = 1.f / sqrtf(wave_sum(s) * (1.f / D) + EPS); }
            if (lane == 0) rs[i] = r;
        }
        __syncthreads();
        const int c0 = 2 * tid;
        const f32x2 g = *(const f32x2*)(p.norm_g + c0), sc = *(const f32x2*)(MODV + (1 * 4 + b) * D + c0), sh = *(const f32x2*)(MODV + (0 * 4 + b) * D + c0);
        const f32x2 gm = g * (sc + 1.f);
        bf16_t* ob = mixA + (size_t)b * S * D;
        const int grp = tid >> 7;
        if (grp == 0) pool_rows<2>(xb, t0, rs, gm, sh, ob, c0);
        else if (grp == 1) pool_rows<4>(xb, t0, rs, gm, sh, ob, c0);
        else if (grp == 2) pool_rows<8>(xb, t0, rs, gm, sh, ob, c0);
        else pool_rows<16>(xb, t0, rs, gm, sh, ob, c0);
        __syncthreads();
    }
}

struct NormOut { const float* g; const float* sc; const float* sh; bf16_t* out; };
template <int NOUT, bool ROUTER, bool OUT8 = false>
__device__ __forceinline__ void phase_norm(const Params& p, LAS unsigned char* lds, const float* xin, const NormOut o0, const NormOut o1) {
    const int tid = opaque_tid(), lane = tid & 63, wave = tid >> 6;
    const int gw = blockIdx.x * NWAVE + wave, NGW = gridDim.x * NWAVE;
    f32x4 rwa[16], rwb[16];
    if (ROUTER) {
#pragma unroll
        for (int j = 0; j < 4; ++j)
#pragma unroll
            for (int q = 0; q < 4; ++q) { const f32x4* wp = (const f32x4*)(p.router_w + (size_t)(4 * lane + 256 * j + q) * NE); rwa[4 * j + q] = wp[0]; rwb[4 * j + q] = wp[1]; }
    }
    unsigned* ctl = (unsigned*)(p.ws + WS_CTL);
    int* TOPE = (int*)(p.ws + WS_TOPE); float* TOPW = (float*)(p.ws + WS_TOPW);
    unsigned cnt_local[NE];
#pragma unroll
    for (int e = 0; e < NE; ++e) cnt_local[e] = 0;
    const int rows_per = T / NGW > 0 ? (T + NGW - 1) / NGW : 1;
    const int r0 = gw * rows_per, r1 = (r0 + rows_per < T) ? r0 + rows_per : T;
    int curb = -1; f32x4 gm0[4], sh0[4], gm1[4], sh1[4];
    for (int r = r0; r < r1; ++r) {
        const int b = r >> 13;
        if (b != curb) { curb = b;
#pragma unroll
            for (int j = 0; j < 4; ++j) { const int c = 4 * lane + 256 * j;
                gm0[j] = *(const f32x4*)(o0.g + c) * (*(const f32x4*)(o0.sc + b * D + c) + 1.f); sh0[j] = *(const f32x4*)(o0.sh + b * D + c);
                if (NOUT > 1) { gm1[j] = *(const f32x4*)(o1.g + c) * (*(const f32x4*)(o1.sc + b * D + c) + 1.f); sh1[j] = *(const f32x4*)(o1.sh + b * D + c); } } }
        const f32x4* xr = (const f32x4*)(xin + (size_t)r * D) + lane;
        f32x4 v[4]; float s = 0.f;
#pragma unroll
        for (int j = 0; j < 4; ++j) { v[j] = xr[64 * j]; s += (v[j].x * v[j].x + v[j].y * v[j].y) + (v[j].z * v[j].z + v[j].w * v[j].w); }
        const float rstd = 1.f / sqrtf(wave_sum(s) * (1.f / D) + EPS);
        float lg[NE];
#pragma unroll
        for (int e = 0; e < NE; ++e) lg[e] = 0.f;
#pragma unroll
        for (int j = 0; j < 4; ++j) {
            const f32x4 h = v[j] * rstd * gm0[j] + sh0[j];
            if constexpr (OUT8) { unsigned w8 = 0u; w8 = __builtin_amdgcn_cvt_pk_fp8_f32(h.x, h.y, w8, false); w8 = __builtin_amdgcn_cvt_pk_fp8_f32(h.z, h.w, w8, true);
                *(unsigned*)((unsigned char*)o0.out + (size_t)r * D + 4 * lane + 256 * j) = w8; }
            else { u32x2 w; w.x = cvt_pk_bf16(h.x, h.y); w.y = cvt_pk_bf16(h.z, h.w);
            *(u32x2*)(o0.out + (size_t)r * D + 4 * lane + 256 * j) = w; }
            if (NOUT > 1) { const f32x4 h1 = v[j] * rstd * gm1[j] + sh1[j]; u32x2 w1; w1.x = cvt_pk_bf16(h1.x, h1.y); w1.y = cvt_pk_bf16(h1.z, h1.w);
                *(u32x2*)(o1.out + (size_t)r * D + 4 * lane + 256 * j) = w1; }
            if (ROUTER) {
#pragma unroll
                for (int q = 0; q < 4; ++q) { const f32x4 a = rwa[4 * j + q], c2 = rwb[4 * j + q]; const float hv = h[q];
                    lg[0] += hv * a.x; lg[1] += hv * a.y; lg[2] += hv * a.z; lg[3] += hv * a.w; lg[4] += hv * c2.x; lg[5] += hv * c2.y; lg[6] += hv * c2.z; lg[7] += hv * c2.w; }
            }
        }
        if (ROUTER) {
            {
                const bool u5 = lane & 32, u4 = lane & 16, u3 = lane & 8; float a4[4], a2[2], a1;
#pragma unroll
                for (int i = 0; i < 4; ++i) a4[i] = (u5 ? lg[4 + i] : lg[i]) + __shfl_xor(u5 ? lg[i] : lg[4 + i], 32);
#pragma unroll
                for (int i = 0; i < 2; ++i) a2[i] = (u4 ? a4[2 + i] : a4[i]) + __shfl_xor(u4 ? a4[i] : a4[2 + i], 16);
                a1 = (u3 ? a2[1] : a2[0]) + __shfl_xor(u3 ? a2[0] : a2[1], 8);
                a1 += __shfl_xor(a1, 4); a1 += __shfl_xor(a1, 2); a1 += __shfl_xor(a1, 1);
#pragma unroll
                for (int e = 0; e < NE; ++e) lg[e] = readlane_f(a1, 8 * e) + p.router_b[e];
            }
            int e0 = 0; float v0 = lg[0];
#pragma unroll
            for (int e = 1; e < NE; ++e) if (lg[e] > v0) { v0 = lg[e]; e0 = e; }
            int e1 = -1; float v1 = -3.0e38f;
#pragma unroll
            for (int e = 0; e < NE; ++e) if (e != e0 && lg[e] > v1) { v1 = lg[e]; e1 = e; }
            const float ex = __expf(v1 - v0), w0 = 1.f / (1.f + ex), w1 = ex / (1.f + ex);
            if (lane == 0) { TOPE[2 * r] = e0; TOPE[2 * r + 1] = e1; TOPW[2 * r] = w0; TOPW[2 * r + 1] = w1; }
#pragma unroll
            for (int e = 0; e < NE; ++e) cnt_local[e] += (e == e0) + (e == e1);
        }
    }
    if (ROUTER) {
        LAS unsigned* lc = (LAS unsigned*)lds;
        if (tid < NE) lc[tid] = 0u;
        __syncthreads();
        if (lane == 0) {
#pragma unroll
            for (int e = 0; e < NE; ++e) if (cnt_local[e]) atomicAdd((unsigned*)(lc + e), cnt_local[e]);
        }
        __syncthreads();
        if (tid < NE && lc[tid]) atomicAdd(ctl + CW_CNT + 64 * tid, lc[tid]);
    }
}

struct GemmArgs { const bf16_t* A; const bf16_t* Bt; int M, N, K; long lda, ldb; };
template <class Epi, int AMODE, bool PAIR>
__device__ __forceinline__ void gemm_simple(const GemmArgs g, const Epi& E, const int* tok, const int* pst, size_t bstride) {
    const int tid = opaque_tid(), lane = tid & 63, wid = tid >> 6, wr = wid >> 2, wc = wid & 3, fr = lane & 15, fq = lane >> 4;
    const int ntn = g.N / 256, ntm = g.M / 128, ntiles = ntm * ntn;
    for (int tile = blockIdx.x; tile < ntiles; tile += gridDim.x) {
        const int tm = tile / ntn, tn = tile % ntn, m0 = tm * 128, n0 = tn * 256;
        const bf16_t* Bt = g.Bt;
        if (pst) { if (m0 >= pst[NE]) continue; int e = 0;
#pragma unroll
            for (int q = 1; q < NE; ++q) e += (m0 >= pst[q]); Bt += (size_t)e * bstride; }
        const bf16_t* ap[4]; const bf16_t* bp[4];
#pragma unroll
        for (int m = 0; m < 4; ++m) { const int r = m0 + wr * 64 + 16 * m + fr; const long rr = (AMODE == 1) ? (long)tok[r] : (long)r; ap[m] = g.A + rr * g.lda + 8 * fq; }
#pragma unroll
        for (int n = 0; n < 4; ++n) { const int c = n0 + (n >> 1) * 128 + wc * 32 + (n & 1) * 16 + fr; bp[n] = Bt + (long)c * g.ldb + 8 * fq; }
        f32x4 acc[4][4];
#pragma unroll
        for (int m = 0; m < 4; ++m)
#pragma unroll
            for (int n = 0; n < 4; ++n) acc[m][n] = (f32x4){0.f, 0.f, 0.f, 0.f};
        for (int k0 = 0; k0 < g.K; k0 += 32) {
            const long ka = (AMODE == 2) ? (long)(k0 >> 6) * NKV + (k0 & 63) : (long)k0;
            bf16x8 a[4], b[4];
#pragma unroll
            for (int m = 0; m < 4; ++m) a[m] = *(const bf16x8*)(ap[m] + ka);
#pragma unroll
            for (int n = 0; n < 4; ++n) b[n] = *(const bf16x8*)(bp[n] + k0);
#pragma unroll
            for (int m = 0; m < 4; ++m)
#pragma unroll
                for (int n = 0; n < 4; ++n) acc[m][n] = __builtin_amdgcn_mfma_f32_16x16x32_bf16(b[n], a[m], acc[m][n], 0, 0, 0);
        }
#pragma unroll
        for (int m = 0; m < 4; ++m) {
            const int row = m0 + wr * 64 + 16 * m + fr;
            if constexpr (PAIR) {
#pragma unroll
                for (int n = 0; n < 2; ++n) E.pair(row, tn * 128 + wc * 32 + n * 16 + 4 * fq, acc[m][n], acc[m][n + 2]);
            } else {
#pragma unroll
                for (int n = 0; n < 4; ++n) E(row, n0 + (n >> 1) * 128 + wc * 32 + (n & 1) * 16 + 4 * fq, acc[m][n]);
            }
        }
    }
}
struct EpiPool {
    const float* x; float* x1; const float* g1; const float* scale; int coff;
    __device__ __forceinline__ void operator()(int row, int col, f32x4 v) const { const int c = coff + col, b = row >> 13;
        const f32x4 xv = *(const f32x4*)(x + (size_t)row * D + c), gv = *(const f32x4*)(g1 + b * D + c), sv = *(const f32x4*)(scale + c);
        *(f32x4*)(x1 + (size_t)row * D + c) = xv + gv * (v * sv); }
};
struct EpiSwiglu {
    bf16_t* hid; int ldh;
    __device__ __forceinline__ void pair(int row, int hc, f32x4 gt, f32x4 up) const {
        u32x2 w; w.x = cvt_pk_bf16(silu_f(gt.x) * up.x, silu_f(gt.y) * up.y); w.y = cvt_pk_bf16(silu_f(gt.z) * up.z, silu_f(gt.w) * up.w);
        *(u32x2*)(hid + (size_t)row * ldh + hc) = w; }
};
struct EpiSwiglu8 {
    unsigned char* hid; int ldh;
    __device__ __forceinline__ void pair(int row, int hc, f32x4 gt, f32x4 up) const {
        unsigned w = 0u; w = __builtin_amdgcn_cvt_pk_fp8_f32(silu_f(gt.x) * up.x, silu_f(gt.y) * up.y, w, false); w = __builtin_amdgcn_cvt_pk_fp8_f32(silu_f(gt.z) * up.z, silu_f(gt.w) * up.w, w, true);
        *(unsigned*)(hid + (size_t)row * ldh + hc) = w; }
};
struct EpiResid {
    const float* xin; float* out; const float* gate;
    __device__ __forceinline__ void operator()(int row, int col, f32x4 v) const { const int b = row >> 13;
        const f32x4 xv = *(const f32x4*)(xin + (size_t)row * D + col), gv = *(const f32x4*)(gate + b * D + col);
        *(f32x4*)(out + (size_t)row * D + col) = xv + gv * v; }
};
struct EpiBf16 {
    bf16_t* o; int ldo;
    __device__ __forceinline__ void operator()(int row, int col, f32x4 v) const { u32x2 w; w.x = cvt_pk_bf16(v.x, v.y); w.y = cvt_pk_bf16(v.z, v.w); *(u32x2*)(o + (size_t)row * ldo + col) = w; }
};
struct EpiQ {
    bf16_t* q; float* gates;
    __device__ __forceinline__ void operator()(int row, int col, f32x4 v) const {
        if (col < D) { u32x2 w; w.x = cvt_pk_bf16(v.x, v.y); w.y = cvt_pk_bf16(v.z, v.w); *(u32x2*)(q + (size_t)row * D + col) = w; }
        else if (col < NQ) { f32x4 s; s.x = sigmoid_f(v.x); s.y = sigmoid_f(v.y); s.z = sigmoid_f(v.z); s.w = sigmoid_f(v.w); *(f32x4*)(gates + (size_t)row * 48 + (col - D)) = s; } }
};
struct EpiCmp {
    bf16_t* o; const float* bias;
    __device__ __forceinline__ void operator()(int row, int col, f32x4 v) const { const int z = col >> 8, c = col & 255; const f32x4 bv = *(const f32x4*)(bias + (z >> 2) * 256 + c);
        u32x2 w; w.x = cvt_pk_bf16(gelu_tanh_f(v.x + bv.x), gelu_tanh_f(v.y + bv.y)); w.y = cvt_pk_bf16(gelu_tanh_f(v.z + bv.z), gelu_tanh_f(v.w + bv.w));
        *(u32x2*)(o + ((size_t)z * 2048 + row) * 256 + c) = w; }
};


namespace pg8 {
#define PG8_LAS __attribute__((address_space(3)))
constexpr int BM = 256, BK = 64, HALF = 128, HTB = HALF * BK * 2, STAGE_BYTES = 8 * HTB, NXCD = 8, WGM = 8;
__host__ __device__ __forceinline__ int lds_byte(int r, int c) { const int st = (r >> 4) * 2 + (c >> 5), rr = r & 15, cc = c & 31, ob = rr * 64 + cc * 2; return st * 1024 + (ob ^ (((ob >> 9) & 1) << 5)); }
__host__ __device__ __forceinline__ void stage_rc(int b, int& R, int& C) { const int st = b / 1024, sb = b % 1024, swz = sb ^ (((sb >> 9) & 1) << 5); R = (st >> 1) * 16 + swz / 64; C = (st & 1) * 32 + (swz % 64) / 2; }
__host__ __device__ __forceinline__ int perm32(int rho) { const int n = rho >> 4, i = rho & 15; return 8 * (i >> 2) + 4 * n + (i & 3); }
struct Unit { int pm, pn; };
template <int SMODE> struct Sched {
    int nM, nN, nwg, G, c; const char* A; const char* Bt; size_t lda2, ldb2; const int* pst; size_t bstride2;
    __device__ __forceinline__ void init(int M, int N, int G_, int c_, const void* A_, const void* Bt_, int lda, int ldb, const int* pst_ = nullptr, size_t bstride = 0) {
        nM = M / BM; nN = N / BM; nwg = nM * nN; G = G_; c = c_; A = (const char*)A_; Bt = (const char*)Bt_; lda2 = (size_t)lda * 2; ldb2 = (size_t)ldb * 2; pst = pst_; bstride2 = bstride * 2; }
    __device__ __forceinline__ bool next(int i, Unit& u) const {
        const long L = (long)i * G + c; if (L >= nwg) return false;
        int wgid = (int)L; { const int q = nwg / NXCD, r = nwg % NXCD, xcd = wgid % NXCD, off = wgid / NXCD; wgid = (xcd < r ? xcd * (q + 1) : r * (q + 1) + (xcd - r) * q) + off; }
        const int nig = WGM * nN, gid = wgid / nig, fm = gid * WGM, gsz = (nM - fm) < WGM ? (nM - fm) : WGM;
        u.pm = fm + ((wgid % nig) % gsz); u.pn = (wgid % nig) / gsz; return true;
    }
    __device__ __forceinline__ const char* a_ptr(const Unit& u) const {
        if (SMODE == 1) return A + (size_t)u.pm * BM * lda2 + (size_t)u.pn * 512;
        if (SMODE == 2) return A + (size_t)u.pm * BM * lda2 + (size_t)((u.pn >> 2) * 256 + (u.pn & 3) * 64) * 2;
        return A + (size_t)u.pm * BM * lda2; }
    __device__ __forceinline__ const char* b_ptr(const Unit& u) const {
        if (SMODE == 2) return Bt + (size_t)(u.pn >> 2) * BM * ldb2;
        if (SMODE == 3) { const int m0 = u.pm * BM; int e = 0;
#pragma unroll
            for (int q = 1; q < NE; ++q) e += (m0 >= pst[q]); return Bt + (size_t)e * bstride2 + (size_t)u.pn * BM * ldb2; }
        return Bt + (size_t)u.pn * BM * ldb2; }
};
template <class F> struct EpiEl { static constexpr bool PERM = false, AFTER_DRAIN = false; F f;
    __device__ __forceinline__ void operator()(const f32x4 (&acc)[2][2][4][2], const Unit& u, int wr, int wc, int fr, int fq) const {
#pragma unroll
        for (int ai = 0; ai < 2; ++ai)
#pragma unroll
            for (int m = 0; m < 4; ++m) { const int row = u.pm * BM + ai * HALF + wr * 64 + m * 16 + fr;
#pragma unroll
                for (int bj = 0; bj < 2; ++bj)
#pragma unroll
                    for (int n = 0; n < 2; ++n) f(row, u.pn * BM + bj * HALF + wc * 32 + n * 16 + 4 * fq, acc[ai][bj][m][n]); } } };
template <class F> struct EpiPairEl { static constexpr bool PERM = false, AFTER_DRAIN = false; F f;
    __device__ __forceinline__ void operator()(const f32x4 (&acc)[2][2][4][2], const Unit& u, int wr, int wc, int fr, int fq) const {
#pragma unroll
        for (int ai = 0; ai < 2; ++ai)
#pragma unroll
            for (int m = 0; m < 4; ++m) { const int row = u.pm * BM + ai * HALF + wr * 64 + m * 16 + fr;
#pragma unroll
                for (int n = 0; n < 2; ++n) f.pair(row, u.pn * HALF + wc * 32 + n * 16 + 4 * fq, acc[ai][0][m][n], acc[ai][1][m][n]); } } };

typedef int i32x8 __attribute__((ext_vector_type(8)));
template <bool F8> __device__ __forceinline__ void mma_block(f32x4 (&acc)[4][2], const bf16x8 (&At)[4][2], const bf16x8 (&Bt)[2][2], const int wsc) {
    __builtin_amdgcn_s_setprio(1);
    if constexpr (F8) {
#pragma unroll
        for (int m = 0; m < 4; ++m) { const u32x4 a0 = __builtin_bit_cast(u32x4, At[m][0]), a1 = __builtin_bit_cast(u32x4, At[m][1]);
            const i32x8 a8 = {(int)a0.x, (int)a0.y, (int)a0.z, (int)a0.w, (int)a1.x, (int)a1.y, (int)a1.z, (int)a1.w};
#pragma unroll
            for (int n = 0; n < 2; ++n) { const u32x4 b0 = __builtin_bit_cast(u32x4, Bt[n][0]), b1 = __builtin_bit_cast(u32x4, Bt[n][1]);
                const i32x8 b8 = {(int)b0.x, (int)b0.y, (int)b0.z, (int)b0.w, (int)b1.x, (int)b1.y, (int)b1.z, (int)b1.w};
                acc[m][n] = __builtin_amdgcn_mfma_scale_f32_16x16x128_f8f6f4(b8, a8, acc[m][n], 0, 0, 0, wsc, 0, 127); } }
#pragma unroll
        for (int m = 0; m < 4; ++m) asm volatile("" : "+v"(acc[m][0]), "+v"(acc[m][1]));
    } else {
#pragma unroll
        for (int m = 0; m < 4; ++m)
#pragma unroll
            for (int n = 0; n < 2; ++n)
#pragma unroll
                for (int k = 0; k < 2; ++k) acc[m][n] = __builtin_amdgcn_mfma_f32_16x16x32_bf16(Bt[n][k], At[m][k], acc[m][n], 0, 0, 0);
    }
    __builtin_amdgcn_s_setprio(0);
}
template <class Epi, class Sched, bool ALIGN_EPI = true, bool SP2 = true, bool F8 = false>
__device__ __forceinline__ void gemm_phase(PG8_LAS unsigned char* lds, const int K, const int lda, const int ldb, const size_t kstepA, const Sched& S, const Epi& E, const int wsc = 127) {
    const int tid_ = opaque_tid();
    const int tid = tid_, wid = __builtin_amdgcn_readfirstlane(tid >> 6), lane = tid & 63, wr = wid >> 2, wc = wid & 3, fr = lane & 15, fq = lane >> 4;
    const int nt = K / BK;
    unsigned voffA[2], voffB[2];
#pragma unroll
    for (int i = 0; i < 2; ++i) { int R, C; stage_rc(tid * 16 + i * 8192, R, C); const int Rb = Epi::PERM ? ((R & ~31) + perm32(R & 31)) : R;
        voffA[i] = (unsigned)(R * lda + C) * 2u; voffB[i] = (unsigned)(Rb * ldb + C) * 2u; }
    const size_t kstepB = (size_t)(BK * 2);
    const size_t hstepA = (size_t)HALF * lda * 2, hstepB = (size_t)HALF * ldb * 2;
    const unsigned ldsw = (unsigned)wid * 1024u;
    int aoffk[2], boffk[2];
#pragma unroll
    for (int k = 0; k < 2; ++k) { const int col = F8 ? ((fq >> 1) * 32 + (fq & 1) * 16 + 8 * k) : (k * 32 + fq * 8); aoffk[k] = lds_byte(wr * 64 + fr, col); boffk[k] = lds_byte(wc * 32 + fr, col); }
#define PG8_SA(b, h) (((b) * 2 + (h)) * HTB)
#define PG8_SB(b, h) ((4 + (b) * 2 + (h)) * HTB)
#define PG8_STAGE(bufoff, gbase, voff) do { _Pragma("unroll") for (int _i = 0; _i < 2; ++_i) \
        __builtin_amdgcn_global_load_lds((const unsigned*)((const char*)(gbase) + (voff)[_i]), (PG8_LAS unsigned*)(lds + (bufoff) + ldsw + _i * 8192), 16, 0, 0); } while (0)
#define PG8_LDA(dst, b, h) do { _Pragma("unroll") for (int m = 0; m < 4; ++m) _Pragma("unroll") for (int k = 0; k < 2; ++k) dst[m][k] = *(const PG8_LAS bf16x8*)(lds + PG8_SA(b, h) + (F8 ? aoffk[k] : aoffk[0] + k * 1024) + m * 2048); } while (0)
#define PG8_LDB(dst, b, h) do { _Pragma("unroll") for (int n = 0; n < 2; ++n) _Pragma("unroll") for (int k = 0; k < 2; ++k) dst[n][k] = *(const PG8_LAS bf16x8*)(lds + PG8_SB(b, h) + (F8 ? boffk[k] : boffk[0] + k * 1024) + n * 2048); } while (0)
#define PG8_MMA(ai, bj, At, Bt) mma_block<F8>(acc[ai][bj], At, Bt, wsc)
#define PG8_WAIT_V(n) asm volatile("s_waitcnt vmcnt(" #n ")" ::: "memory")
#define PG8_WAIT_L(n) asm volatile("s_waitcnt lgkmcnt(" #n ")" ::: "memory")
#define PG8_BAR __builtin_amdgcn_s_barrier()
#define PG8_SCHED __builtin_amdgcn_sched_barrier(0)
    Unit cur, nxt; int ui = 0;
    if (!S.next(0, cur)) return;
    f32x4 acc[2][2][4][2];
#pragma unroll
    for (int a = 0; a < 2; ++a)
#pragma unroll
        for (int b = 0; b < 2; ++b)
#pragma unroll
            for (int m = 0; m < 4; ++m)
#pragma unroll
                for (int n = 0; n < 2; ++n) acc[a][b][m][n] = (f32x4){0.f, 0.f, 0.f, 0.f};
    bf16x8 At[4][2], B0[2][2], B1[2][2];
    const char* cA = S.a_ptr(cur); const char* cB = S.b_ptr(cur);
    if constexpr (SP2) {
        PG8_STAGE(PG8_SB(0, 0), cB, voffB); PG8_STAGE(PG8_SB(0, 1), cB + hstepB, voffB); PG8_STAGE(PG8_SA(0, 0), cA, voffA); PG8_STAGE(PG8_SA(0, 1), cA + hstepA, voffA);
        if (wr == 1) PG8_BAR;
        PG8_WAIT_V(2); PG8_BAR;
        PG8_STAGE(PG8_SB(1, 0), cB + kstepB, voffB); PG8_STAGE(PG8_SA(1, 0), cA + kstepA, voffA); PG8_STAGE(PG8_SB(1, 1), cB + hstepB + kstepB, voffB);
        PG8_WAIT_V(6); PG8_BAR;
    } else {
        PG8_STAGE(PG8_SB(0, 0), cB, voffB); PG8_STAGE(PG8_SA(0, 0), cA, voffA); PG8_STAGE(PG8_SB(0, 1), cB + hstepB, voffB); PG8_STAGE(PG8_SA(0, 1), cA + hstepA, voffA);
        if (wr == 1) PG8_BAR;
        PG8_WAIT_V(4); PG8_BAR;
        PG8_STAGE(PG8_SB(1, 0), cB + kstepB, voffB); PG8_STAGE(PG8_SA(1, 0), cA + kstepA, voffA); PG8_STAGE(PG8_SB(1, 1), cB + hstepB + kstepB, voffB);
        PG8_WAIT_V(6); PG8_BAR;
    }
    for (;;) {
        const bool has_next = S.next(ui + 1, nxt);
        const char* nA = has_next ? S.a_ptr(nxt) : cA; const char* nB = has_next ? S.b_ptr(nxt) : cB;
        for (int t = 0; t < nt; t += 2) {
            const bool last = (t == nt - 2);
            const char* a1 = cA + (size_t)(t + 1) * kstepA;
            const char* a2 = last ? nA : cA + (size_t)(t + 2) * kstepA; const char* b2 = last ? nB : cB + (size_t)(t + 2) * kstepB;
            const char* a3 = a2 + kstepA; const char* b3 = b2 + kstepB;
            if constexpr (SP2) {
            PG8_LDB(B0, 0, 0); PG8_LDB(B1, 0, 1); PG8_SCHED; PG8_LDA(At, 0, 0); PG8_STAGE(PG8_SA(1, 1), a1 + hstepA, voffA);
            PG8_WAIT_V(8); PG8_WAIT_L(0); PG8_BAR; PG8_MMA(0, 0, At, B0); PG8_MMA(0, 1, At, B1); PG8_BAR; PG8_SCHED;
            PG8_LDA(At, 0, 1); PG8_STAGE(PG8_SB(0, 0), b2, voffB); PG8_STAGE(PG8_SB(0, 1), b2 + hstepB, voffB); PG8_STAGE(PG8_SA(0, 0), a2, voffA);
            PG8_WAIT_V(8); PG8_WAIT_L(0); PG8_BAR; PG8_MMA(1, 0, At, B0); PG8_MMA(1, 1, At, B1); PG8_BAR; PG8_SCHED;
            PG8_LDB(B0, 1, 0); PG8_LDB(B1, 1, 1); PG8_SCHED; PG8_LDA(At, 1, 0); PG8_STAGE(PG8_SA(0, 1), a2 + hstepA, voffA);
            PG8_WAIT_V(8); PG8_WAIT_L(0); PG8_BAR; PG8_MMA(0, 0, At, B0); PG8_MMA(0, 1, At, B1); PG8_BAR; PG8_SCHED;
            PG8_LDA(At, 1, 1); PG8_STAGE(PG8_SB(1, 0), b3, voffB); PG8_STAGE(PG8_SB(1, 1), b3 + hstepB, voffB); PG8_STAGE(PG8_SA(1, 0), a3, voffA);
            PG8_WAIT_V(8); PG8_WAIT_L(0); PG8_BAR; PG8_MMA(1, 0, At, B0); PG8_MMA(1, 1, At, B1); PG8_BAR; PG8_SCHED;
            } else {
            PG8_LDB(B0, 0, 0); PG8_SCHED; PG8_LDA(At, 0, 0); PG8_STAGE(PG8_SA(1, 1), a1 + hstepA, voffA);
            PG8_WAIT_L(8); PG8_BAR; PG8_WAIT_L(0); PG8_MMA(0, 0, At, B0); PG8_BAR; PG8_SCHED;
            PG8_LDB(B1, 0, 1); PG8_STAGE(PG8_SB(0, 0), b2, voffB);
            PG8_BAR; PG8_WAIT_L(0); PG8_MMA(0, 1, At, B1); PG8_BAR;
            PG8_LDA(At, 0, 1); PG8_STAGE(PG8_SA(0, 0), a2, voffA);
            PG8_BAR; PG8_WAIT_L(0); PG8_MMA(1, 0, At, B0); PG8_BAR; PG8_SCHED;
            PG8_STAGE(PG8_SB(0, 1), b2 + hstepB, voffB);
            PG8_WAIT_V(6); PG8_BAR; PG8_MMA(1, 1, At, B1); PG8_BAR;
            PG8_LDB(B0, 1, 0); PG8_SCHED; PG8_LDA(At, 1, 0); PG8_STAGE(PG8_SA(0, 1), a2 + hstepA, voffA);
            PG8_WAIT_L(8); PG8_BAR; PG8_WAIT_L(0); PG8_MMA(0, 0, At, B0); PG8_BAR; PG8_SCHED;
            PG8_LDB(B1, 1, 1); PG8_STAGE(PG8_SB(1, 0), b3, voffB);
            PG8_BAR; PG8_WAIT_L(0); PG8_MMA(0, 1, At, B1); PG8_BAR;
            PG8_LDA(At, 1, 1); PG8_STAGE(PG8_SA(1, 0), a3, voffA);
            PG8_BAR; PG8_WAIT_L(0); PG8_MMA(1, 0, At, B0); PG8_BAR; PG8_SCHED;
            PG8_STAGE(PG8_SB(1, 1), b3 + hstepB, voffB);
            PG8_WAIT_V(6); PG8_BAR; PG8_MMA(1, 1, At, B1); PG8_BAR;
            }
        }
        if constexpr (ALIGN_EPI) { if (wr == 0) PG8_BAR; }
        if constexpr (!Epi::AFTER_DRAIN) { E(acc, cur, wr, wc, fr, fq); }
        if (!has_next) break;
#pragma unroll
        for (int a = 0; a < 2; ++a)
#pragma unroll
            for (int b = 0; b < 2; ++b)
#pragma unroll
                for (int m = 0; m < 4; ++m)
#pragma unroll
                    for (int n = 0; n < 2; ++n) acc[a][b][m][n] = (f32x4){0.f, 0.f, 0.f, 0.f};
        cur = nxt; cA = nA; cB = nB; ++ui;
        if constexpr (ALIGN_EPI) { if (wr == 1) PG8_BAR; }
    }
    PG8_WAIT_V(0);
    if constexpr (!ALIGN_EPI) { if (wr == 0) PG8_BAR; }
    PG8_BAR;
    if constexpr (Epi::AFTER_DRAIN) { E.fused(acc, cur, wr, wc, fr, fq, lds, wid, lane); }
#undef PG8_SA
#undef PG8_SB
#undef PG8_STAGE
#undef PG8_LDA
#undef PG8_LDB
#undef PG8_MMA
#undef PG8_WAIT_V
#undef PG8_WAIT_L
#undef PG8_BAR
#undef PG8_SCHED
}
}

__device__ __forceinline__ void phase_headnorm(const Params& p, LAS unsigned char* lds) {
    const int tid = opaque_tid(), lane = tid & 63, wave = tid >> 6;
    LAS int* chunk = (LAS int*)(lds + 131072 - 64);
    bf16_t* Q = (bf16_t*)(p.ws + WS_Q); bf16_t* KVB = (bf16_t*)(p.ws + WS_KVB);
    float qg[16], kg[8];
#pragma unroll
    for (int i = 0; i < 16; ++i) qg[i] = p.q_gain[(lane & 3) * 16 + i] * (0.125f * 1.4426950408889634f);
    const float qs8 = sel_q_scale(p.q_gain), ks8 = sel_k_scale(p.k_gain);
    const int kr = lane >> 5;
#pragma unroll
    for (int i = 0; i < 8; ++i) kg[i] = p.k_gain[(1 + kr) * 64 + (lane & 7) * 8 + i];
    for (;;) {
      if (tid == 0) *chunk = (int)atomicAdd((unsigned*)(p.ws + WS_CTL) + CW_HN, 1u);
      __syncthreads();
      const int c0 = *chunk;
      __syncthreads();
      if (c0 >= T / 128) break;
      for (int r = c0 * 128 + wave * 16; r < c0 * 128 + wave * 16 + 16; ++r) {
        {
            u32x4* ptr = (u32x4*)(Q + (size_t)r * D + lane * 16); u32x4 w0 = ptr[0], w1 = ptr[1];
            float v[16]; const unsigned ww[8] = {w0.x, w0.y, w0.z, w0.w, w1.x, w1.y, w1.z, w1.w}; float s = 0.f;
#pragma unroll
            for (int i = 0; i < 8; ++i) { v[2 * i] = bflo(ww[i]); v[2 * i + 1] = bfhi(ww[i]); s += v[2 * i] * v[2 * i] + v[2 * i + 1] * v[2 * i + 1]; }
            s += __shfl_xor(s, 1); s += __shfl_xor(s, 2);
            const float rstd = 1.f / sqrtf(s * (1.f / 64.f) + EPS);
            unsigned o[8];
#pragma unroll
            for (int i = 0; i < 8; ++i) o[i] = cvt_pk_bf16(v[2 * i] * rstd * qg[2 * i], v[2 * i + 1] * rstd * qg[2 * i + 1]);
            ptr[0] = (u32x4){o[0], o[1], o[2], o[3]}; ptr[1] = (u32x4){o[4], o[5], o[6], o[7]};
            float qv[16];
#pragma unroll
            for (int i = 0; i < 16; ++i) qv[i] = v[i] * rstd * qg[i] * qs8;
            *(u32x4*)(p.ws + WS_Q8 + (size_t)r * D + lane * 16) = (u32x4){pack_i8x4(qv[0], qv[1], qv[2], qv[3]), pack_i8x4(qv[4], qv[5], qv[6], qv[7]), pack_i8x4(qv[8], qv[9], qv[10], qv[11]), pack_i8x4(qv[12], qv[13], qv[14], qv[15])};
        }
        {
            const u32x4* ptr = (const u32x4*)(KVB + (size_t)r * NKV + (kr ? 1024 : 512) + (lane & 31) * 8); const u32x4 w0 = ptr[0];
            float v[8]; const unsigned ww[4] = {w0.x, w0.y, w0.z, w0.w}; float s = 0.f;
#pragma unroll
            for (int i = 0; i < 4; ++i) { v[2 * i] = bflo(ww[i]); v[2 * i + 1] = bfhi(ww[i]); s += v[2 * i] * v[2 * i] + v[2 * i + 1] * v[2 * i + 1]; }
            s += __shfl_xor(s, 1); s += __shfl_xor(s, 2); s += __shfl_xor(s, 4);
            const float rstd = 1.f / sqrtf(s * (1.f / 64.f) + EPS);
            unsigned o[4];
#pragma unroll
            for (int i = 0; i < 4; ++i) o[i] = cvt_pk_bf16(v[2 * i] * rstd * kg[2 * i], v[2 * i + 1] * rstd * kg[2 * i + 1]);
            const int b = r >> 13, t = r & (S - 1), hg = (lane & 31) >> 3, c = lane & 7;
            if (kr) {
                bf16_t* dst = (bf16_t*)(p.ws + WS_KWB) + ((size_t)((b * 4 + hg) * 128 + (t >> 6)) * 8 + c) * 512 + (t & 63) * 8;
                *(u32x4*)dst = (u32x4){o[0], o[1], o[2], o[3]};
            } else {
                const float ksc = rstd * ks8;
                const unsigned w0 = pack_i8x4(v[0] * ksc * kg[0], v[1] * ksc * kg[1], v[2] * ksc * kg[2], v[3] * ksc * kg[3]);
                const unsigned w1 = pack_i8x4(v[4] * ksc * kg[4], v[5] * ksc * kg[5], v[6] * ksc * kg[6], v[7] * ksc * kg[7]);
                unsigned char* dst = p.ws + WS_KSB + ((size_t)((b * 4 + hg) * 128 + (t >> 6)) * 4 + (c >> 1)) * 1024 + (t & 63) * 16 + (c & 1) * 8;
                *(u32x2*)dst = (u32x2){w0, w1};
            }
        }
      }
    }
}

__device__ __forceinline__ void phase_cmp2(const Params& p, LAS unsigned char* lds) {
    const int tid = opaque_tid(), lane = tid & 63, wave = tid >> 6;
    const int gw = blockIdx.x * NWAVE + wave, NGW = gridDim.x * NWAVE;
    const bf16_t* CMPH = (const bf16_t*)(p.ws + WS_CMPH);
    LAS float* w2l = (LAS float*)lds;
    for (int kv = 0; kv < 2; ++kv) {
        const float* w2 = kv ? p.cmp_v_w2 : p.cmp_k_w2;
        for (int i = tid; i < 256 * 64 / 4; i += NTHR) ((LAS f32x4*)w2l)[i] = ((const f32x4*)w2)[i];
        __syncthreads();
        for (int it = gw * 2; it < 4 * 2048; it += NGW * 2) {
            float hv[2][4], acc[2] = {0.f, 0.f};
#pragma unroll
            for (int rr = 0; rr < 2; ++rr) { const u32x2 w = *(const u32x2*)(CMPH + (size_t)(kv * 8192 + it + rr) * 256 + 4 * lane); hv[rr][0] = bflo(w.x); hv[rr][1] = bfhi(w.x); hv[rr][2] = bflo(w.y); hv[rr][3] = bfhi(w.y); }
#pragma unroll 4
            for (int kk = 0; kk < 64; ++kk)
#pragma unroll
                for (int c = 0; c < 4; ++c) { const float wv = w2l[(4 * kk + c) * 64 + lane];
                    acc[0] += readlane_f(hv[0][c], kk) * wv; acc[1] += readlane_f(hv[1][c], kk) * wv; }
#pragma unroll
            for (int rr = 0; rr < 2; ++rr) {
                const int row = it + rr, g = (row >> 11) & 3, r2 = row & 2047, b = r2 >> 9, n = r2 & 511; float a = n == NC - 1 ? 0.f : acc[rr];
                if (kv == 0) { const float ss = wave_sum(a * a); a = a * (1.f / sqrtf(ss * (1.f / 64.f) + EPS)) * p.k_gain[lane]; }
                const size_t blk0 = (size_t)((b * 4 + g) * 8 + (n >> 6)) * 4096;
                bf16_t* o = kv ? (bf16_t*)(p.ws + WS_VC) + blk0 + ((n & 63) >> 3) * 512 + lane * 8 + (n & 7)
                               : (bf16_t*)(p.ws + WS_KC) + blk0 + (lane >> 3) * 512 + (n & 63) * 8 + (lane & 7);
                *o = (bf16_t)(cvt_pk_bf16(a, 0.f) & 0xffffu);
            }
        }
        __syncthreads();
    }
}

__device__ __forceinline__ float dot64(const float (&q)[64], const bf16_t* krow) {
    const u32x4* kp = (const u32x4*)krow; float s = 0.f;
#pragma unroll
    for (int i = 0; i < 8; ++i) { const u32x4 w = kp[i];
        s += q[8 * i + 0] * bflo(w.x) + q[8 * i + 1] * bfhi(w.x) + q[8 * i + 2] * bflo(w.y) + q[8 * i + 3] * bfhi(w.y)
           + q[8 * i + 4] * bflo(w.z) + q[8 * i + 5] * bfhi(w.z) + q[8 * i + 6] * bflo(w.w) + q[8 * i + 7] * bfhi(w.w); }
    return s;
}
__device__ __forceinline__ void phase_attn_naive(const Params& p, LAS unsigned char* lds, bf16_t* AO) {
    const int tid = opaque_tid(), lane = tid & 63, wave = tid >> 6, g = wave >> 1;
    LAS float* sc = (LAS float*)lds + wave * 1024;
    LAS float* pc = (LAS float*)(lds + 32768);
    LAS float* hb = (LAS float*)(lds + 65536);
    LAS unsigned char* lut = lds + 65536 + 2048;
    for (int i = tid; i < 512; i += NTHR) hb[i] = p.rel_bias[(i & 31) * NH + (i >> 5)];
    for (int i = tid; i < 1024; i += NTHR) lut[i] = (unsigned char)rel_bucket(i);
    __syncthreads();
    const bf16_t* Q = (const bf16_t*)(p.ws + WS_Q); const bf16_t* KVB = (const bf16_t*)(p.ws + WS_KVB);
    const bf16_t* KC = (const bf16_t*)(p.ws + WS_KC); const bf16_t* VC = (const bf16_t*)(p.ws + WS_VC);
    const float* GATE = (const float*)(p.ws + WS_GATE);
    for (int u = blockIdx.x; u < T; u += gridDim.x) {
        const int b = u >> 13, t = u & (S - 1);
        const int ncv = t >= 31 ? ((t - 31) >> 4) + 1 : 0;
        const bf16_t* kc = KC + (size_t)(b * 4 + g) * NC * 64; const bf16_t* vc = VC + (size_t)(b * 4 + g) * NC * 64;
        float oc[2], os[2], ow[2];
        for (int hh = 0; hh < 2; ++hh) {
            const int head = wave * 2 + hh;
            float q[64];
            { const u32x4* qp = (const u32x4*)(Q + (size_t)u * D + head * 64);
#pragma unroll
                for (int i = 0; i < 8; ++i) { const u32x4 w = qp[i]; q[8 * i] = bflo(w.x); q[8 * i + 1] = bfhi(w.x); q[8 * i + 2] = bflo(w.y); q[8 * i + 3] = bfhi(w.y); q[8 * i + 4] = bflo(w.z); q[8 * i + 5] = bfhi(w.z); q[8 * i + 6] = bflo(w.w); q[8 * i + 7] = bfhi(w.w); }
#pragma unroll
                for (int i = 0; i < 64; ++i) q[i] *= 0.6931471805599453f; }
            float mx = -3.0e38f;
            for (int kk = lane; kk < ncv; kk += 64) { const int dist = t - (16 * kk + 31); const float s = dot64(q, kc + (size_t)kk * 64) + hb[head * 32 + lut[dist < 1023 ? dist : 1023]]; sc[kk] = s; mx = fmaxf(mx, s); }
            mx = wave_max(mx); float sum = 0.f;
            for (int kk = lane; kk < ncv; kk += 64) { const float e = __expf(sc[kk] - mx); sc[kk] = e; sum += e; }
            sum = wave_sum(sum); const float inv = ncv > 0 ? 1.f / sum : 0.f;
            for (int kk = lane; kk < NC; kk += 64) { const float pv = kk < ncv ? sc[kk] * inv : 0.f; pc[head * 512 + kk] = pv; }
            asm volatile("s_waitcnt lgkmcnt(0)" ::: "memory");
            float o = 0.f;
            for (int kk = 0; kk < ncv; ++kk) o += pc[head * 512 + kk] * bf2f(vc[(size_t)kk * 64 + lane]);
            oc[hh] = o;
        }
        __syncthreads();
        LAS int* sel = (LAS int*)(lds + 65536 + 4096) + wave * NSEL;
        {
            const int cur = t >> 6; float cs[2];
#pragma unroll
            for (int h2 = 0; h2 < 2; ++h2) { const int j = lane + 64 * h2; float ps = 0.f;
#pragma unroll
                for (int k = 0; k < 5; ++k) { const int c = 4 * j + k - 1; if (c >= 0 && c < ncv) { const float wk = (k == 0 || k == 4) ? 1.f : 2.f;
                    ps += wk * (((pc[(4 * g + 0) * 512 + c] + pc[(4 * g + 1) * 512 + c]) + pc[(4 * g + 2) * 512 + c]) + pc[(4 * g + 3) * 512 + c]); } }
                const bool forced = (j == 0) || (j == cur) || (j == cur - 1), valid = j * 64 <= t;
                cs[h2] = forced ? 1.0e6f : (valid ? ps : -1.0e6f); }
#pragma unroll
            for (int i = 0; i < NSEL; ++i) {
                float bv; int bi;
                if (cs[0] >= cs[1]) { bv = cs[0]; bi = lane; } else { bv = cs[1]; bi = lane + 64; }
#pragma unroll
                for (int o = 1; o < 64; o <<= 1) { const float ov = __shfl_xor(bv, o); const int oi = __shfl_xor(bi, o); if (ov > bv || (ov == bv && oi < bi)) { bv = ov; bi = oi; } }
                if (lane == 0) sel[i] = bi;
                if (bi == lane) cs[0] = -3.0e38f;
                if (bi == lane + 64) cs[1] = -3.0e38f;
            }
        }
        for (int hh = 0; hh < 2; ++hh) {
            const int head = wave * 2 + hh;
            float q[64];
            { const u32x4* qp = (const u32x4*)(Q + (size_t)u * D + head * 64);
#pragma unroll
                for (int i = 0; i < 8; ++i) { const u32x4 w = qp[i]; q[8 * i] = bflo(w.x); q[8 * i + 1] = bfhi(w.x); q[8 * i + 2] = bflo(w.y); q[8 * i + 3] = bfhi(w.y); q[8 * i + 4] = bflo(w.z); q[8 * i + 5] = bfhi(w.z); q[8 * i + 6] = bflo(w.w); q[8 * i + 7] = bfhi(w.w); }
#pragma unroll
                for (int i = 0; i < 64; ++i) q[i] *= 0.6931471805599453f; }
            const bf16_t* kvb = KVB + (size_t)b * S * NKV + g * 64;
            {
                float mx = -3.0e38f;
#pragma unroll
                for (int i = 0; i < NSEL; ++i) { const int pos = sel[i] * 64 + lane; float s = -3.0e38f;
                    if (pos <= t) { const int dist = t - pos; s = dot64(q, kvb + (size_t)pos * NKV + 512) + hb[head * 32 + lut[dist < 1023 ? dist : 1023]]; }
                    sc[i * 64 + lane] = s; mx = fmaxf(mx, s); }
                mx = wave_max(mx); float sum = 0.f;
#pragma unroll
                for (int i = 0; i < NSEL; ++i) { const float s = sc[i * 64 + lane]; const float e = s > -1.0e38f ? __expf(s - mx) : 0.f; sc[i * 64 + lane] = e; sum += e; }
                sum = wave_sum(sum); const float inv = 1.f / sum;
                asm volatile("s_waitcnt lgkmcnt(0)" ::: "memory");
                float o = 0.f;
#pragma unroll 1
                for (int i = 0; i < NSEL; ++i) { const int pos0 = sel[i] * 64; if (pos0 > t) continue; const int nk = (t - pos0 + 1 < 64) ? t - pos0 + 1 : 64;
                    for (int l = 0; l < nk; ++l) o += sc[i * 64 + l] * bf2f(kvb[(size_t)(pos0 + l) * NKV + 768 + lane]); }
                os[hh] = o * inv;
            }
            {
                float mx = -3.0e38f;
#pragma unroll
                for (int i = 0; i < 8; ++i) { const int pos = t - 511 + i * 64 + lane; float s = -3.0e38f;
                    if (pos >= 0) { const int dist = t - pos; s = dot64(q, kvb + (size_t)pos * NKV + 1024) + hb[head * 32 + lut[dist]]; }
                    sc[i * 64 + lane] = s; mx = fmaxf(mx, s); }
                mx = wave_max(mx); float sum = 0.f;
#pragma unroll
                for (int i = 0; i < 8; ++i) { const float s = sc[i * 64 + lane]; const float e = s > -1.0e38f ? __expf(s - mx) : 0.f; sc[i * 64 + lane] = e; sum += e; }
                sum = wave_sum(sum); const float inv = 1.f / sum;
                asm volatile("s_waitcnt lgkmcnt(0)" ::: "memory");
                float o = 0.f; const int p0 = t - 511 > 0 ? t - 511 : 0;
                for (int pos = p0; pos <= t; ++pos) o += sc[pos - (t - 511)] * bf2f(kvb[(size_t)pos * NKV + 1280 + lane]);
                ow[hh] = o * inv;
            }
            const float* gt = GATE + (size_t)u * 48 + head * 3;
            const float r = gt[0] * oc[hh] + gt[1] * os[hh] + gt[2] * ow[hh];
            AO[(size_t)u * D + head * 64 + lane] = (bf16_t)(cvt_pk_bf16(r, 0.f) & 0xffffu);
        }
        __syncthreads();
    }
}

__device__ __forceinline__ void phase_vtrans(const Params& p, LAS unsigned char* lds) {
    const int tid = opaque_tid(), lane = tid & 63, wave = tid >> 6;
    const int gw = blockIdx.x * NWAVE + wave, NGW = gridDim.x * NWAVE;
    LAS unsigned short* tile = (LAS unsigned short*)(lds + wave * 8448);
    const bf16_t* KVB = (const bf16_t*)(p.ws + WS_KVB);
    LAS int* chunk = (LAS int*)(lds + 131072 - 64);
    for (;;) {
        if (tid == 0) *chunk = (int)atomicAdd((unsigned*)(p.ws + WS_CTL) + CW_VT, 1u);
        __syncthreads();
        const int c0 = *chunk;
        __syncthreads();
        if (c0 >= 2 * 16 * 128 / NWAVE) break;
        const int u = c0 * NWAVE + wave;
        const int which = u >> 11, bg = (u >> 7) & 15, tt = u & 127, b = bg >> 2, g = bg & 3, t0 = tt * 64;
        const u32x4* src = (const u32x4*)(KVB + (size_t)(b * S + t0 + lane) * NKV + (which ? 1280 : 768) + g * 64);
#pragma unroll
        for (int i = 0; i < 8; ++i) { const u32x4 v = src[i]; LAS unsigned* tp = (LAS unsigned*)(tile + lane * 66 + 8 * i); tp[0] = v.x; tp[1] = v.y; tp[2] = v.z; tp[3] = v.w; }
        asm volatile("s_waitcnt lgkmcnt(0)" ::: "memory");
        if (which) {
            bf16_t* dst = (bf16_t*)(p.ws + WS_VWB) + (size_t)(bg * 128 + tt) * 4096 + lane * 8;
#pragma unroll
            for (int i = 0; i < 8; ++i) { unsigned w[4];
#pragma unroll
                for (int q = 0; q < 4; ++q) { const unsigned lo = tile[(8 * i + 2 * q) * 66 + lane], hi = tile[(8 * i + 2 * q + 1) * 66 + lane]; w[q] = lo | (hi << 16); }
                *(u32x4*)(dst + i * 512) = (u32x4){w[0], w[1], w[2], w[3]}; }
        } else {
            unsigned char* dst = p.ws + WS_VSB + (size_t)(bg * 128 + tt) * 4096 + lane * 16;
#pragma unroll
            for (int i = 0; i < 4; ++i) { unsigned w[4];
#pragma unroll
                for (int q = 0; q < 4; ++q) { const int k0 = 16 * i + 4 * q; unsigned x = 0u;
                    x = __builtin_amdgcn_cvt_pk_fp8_f32(bf2f(tile[(k0 + 0) * 66 + lane]), bf2f(tile[(k0 + 1) * 66 + lane]), x, false);
                    x = __builtin_amdgcn_cvt_pk_fp8_f32(bf2f(tile[(k0 + 2) * 66 + lane]), bf2f(tile[(k0 + 3) * 66 + lane]), x, true); w[q] = x; }
                *(u32x4*)(dst + i * 1024) = (u32x4){w[0], w[1], w[2], w[3]}; }
        }
        asm volatile("s_waitcnt lgkmcnt(0)" ::: "memory");
    }
}

typedef short s16x4 __attribute__((ext_vector_type(4)));
__device__ __forceinline__ f32x4 mfma4(s16x4 a, s16x4 b, f32x4 c) { return __builtin_amdgcn_mfma_f32_4x4x4bf16_1k(a, b, c, 0, 0, 0); }
__device__ __forceinline__ s16x4 mk4(unsigned lo, unsigned hi) { const u32x2 t = {lo, hi}; return __builtin_bit_cast(s16x4, t); }
__device__ __forceinline__ f32x4 qk64(const bf16_t* krow, const s16x4 (&qf)[16]) {
    const u32x4* kp = (const u32x4*)krow; u32x4 kr[8];
#pragma unroll
    for (int i = 0; i < 8; ++i) kr[i] = kp[i];
    f32x4 s = {0.f, 0.f, 0.f, 0.f};
#pragma unroll
    for (int c = 0; c < 8; ++c) { s = mfma4(mk4(kr[c].x, kr[c].y), qf[2 * c], s); s = mfma4(mk4(kr[c].z, kr[c].w), qf[2 * c + 1], s); }
    return s;
}
__device__ __forceinline__ void pv64(f32x4& o, const f32x4 e, const bf16_t* vtrow, LAS u32x2* stage, int lane) {
    const u32x4* vp = (const u32x4*)vtrow; u32x4 vr[8];
#pragma unroll
    for (int i = 0; i < 8; ++i) vr[i] = vp[i];
    u32x2 pk; pk.x = cvt_pk_bf16(e.x, e.y); pk.y = cvt_pk_bf16(e.z, e.w);
    stage[lane] = pk;
#pragma unroll
    for (int st = 0; st < 16; ++st) { const u32x2 a = stage[4 * st + (lane & 3)]; const u32x4 v = vr[st >> 1];
        o = mfma4(mk4(a.x, a.y), (st & 1) ? mk4(v.z, v.w) : mk4(v.x, v.y), o); }
}
__device__ __forceinline__ float quadx_sum(float v) { v += __shfl_xor(v, 4); v += __shfl_xor(v, 8); v += __shfl_xor(v, 16); v += __shfl_xor(v, 32); return v; }

constexpr int HBN = 800;
constexpr int ATT_HBD = 0, ATT_MH = 51200, ATT_PSLC = 53248, ATT_STAGE = 118784;
__device__ __forceinline__ void attn_tables(const Params& p, LAS unsigned char* lds) {
    const int tid = opaque_tid();
    LAS float* hbd = (LAS float*)(lds + ATT_HBD); LAS float* mh = (LAS float*)(lds + ATT_MH);
    for (int i = tid; i < 16 * HBN; i += NTHR) { const int hd = i / HBN, d = i - hd * HBN; hbd[i] = p.rel_bias[rel_bucket(d) * NH + hd] * 1.4426950408889634f; }
    if (tid < 16) { float qg = 0.f, kg = 0.f, bm = -3.0e38f;
        for (int i = 0; i < 64; ++i) qg = fmaxf(qg, fabsf(p.q_gain[i]));
        for (int i = 0; i < 192; ++i) kg = fmaxf(kg, fabsf(p.k_gain[i]));
        for (int i = 0; i < 32; ++i) bm = fmaxf(bm, p.rel_bias[i * NH + tid]);
        mh[tid] = (qg * kg * 8.f * 1.02f + bm) * 1.4426950408889634f; }
    __syncthreads();
}
typedef float f32x16 __attribute__((ext_vector_type(16)));
__device__ __forceinline__ f32x16 mfma32(bf16x8 a, bf16x8 b, f32x16 c) { return __builtin_amdgcn_mfma_f32_32x32x16_bf16(a, b, c, 0, 0, 0); }
struct DFrag { bf16x8 ka[4]; bf16x8 va[2][2]; };
__device__ __forceinline__ void dense_load_k(bf16x8 (&ka)[4], const bf16_t* KB, int kt, int l31, int h) {
    const int blk = kt >> 6, hh = (kt >> 5) & 1;
    const bf16_t* kb = KB + (size_t)blk * 4096 + (32 * hh + l31) * 8;
#pragma unroll
    for (int ks = 0; ks < 4; ++ks) ka[ks] = *(const bf16x8*)(kb + (2 * ks + h) * 512);
}
__device__ __forceinline__ void dense_load_v(bf16x8 (&va)[2][2], const bf16_t* VB, int kt, int l31, int h) {
    const int blk = kt >> 6, hh = (kt >> 5) & 1;
    const bf16_t* vb = VB + (size_t)blk * 4096 + l31 * 8 + 4 * h;
#pragma unroll
    for (int dt = 0; dt < 2; ++dt)
#pragma unroll
        for (int st = 0; st < 2; ++st) { const bf16_t* q0 = vb + (4 * hh + 2 * st) * 512 + dt * 256; const u32x2 lo = *(const u32x2*)q0, hi = *(const u32x2*)(q0 + 512);
            const u32x4 w = {lo.x, lo.y, hi.x, hi.y}; va[dt][st] = __builtin_bit_cast(bf16x8, w); }
}
__device__ __forceinline__ f32x16 dense_scores(const DFrag& f, const bf16x8 (&q)[4]) {
    f32x16 sacc;
#pragma unroll
    for (int i = 0; i < 16; ++i) sacc[i] = 0.f;
#pragma unroll
    for (int ks = 0; ks < 4; ++ks) sacc = mfma32(f.ka[ks], q[ks], sacc);
    return sacc;
}
__device__ __forceinline__ void dense_pv(f32x16 (&O)[2], const DFrag& f, const float (&ev)[16]) {
    bf16x8 pb[2];
#pragma unroll
    for (int st = 0; st < 2; ++st) { const u32x4 w = {cvt_pk_bf16(ev[8 * st], ev[8 * st + 1]), cvt_pk_bf16(ev[8 * st + 2], ev[8 * st + 3]), cvt_pk_bf16(ev[8 * st + 4], ev[8 * st + 5]), cvt_pk_bf16(ev[8 * st + 6], ev[8 * st + 7])};
        pb[st] = __builtin_bit_cast(bf16x8, w); }
#pragma unroll
    for (int dt = 0; dt < 2; ++dt)
#pragma unroll
        for (int st = 0; st < 2; ++st) O[dt] = mfma32(f.va[dt][st], pb[st], O[dt]);
}
__device__ __forceinline__ void phase_dense(const Params& p, LAS unsigned char* lds, bf16_t* OW) {
    const int tid = opaque_tid(), lane0 = tid & 63, wave = tid >> 6;
    const LAS float* hbd = (const LAS float*)(lds + ATT_HBD); const LAS float* mh = (const LAS float*)(lds + ATT_MH);
    LAS float* pslc = (LAS float*)(lds + ATT_PSLC) + wave * 2048;
    const bf16_t* Q = (const bf16_t*)(p.ws + WS_Q); const float* GATE = (const float*)(p.ws + WS_GATE);
    short* SEL = (short*)(p.ws + WS_SEL);
    const int Gn = gridDim.x, vcu = (Gn % 8 == 0) ? (blockIdx.x % 8) * (Gn / 8) + blockIdx.x / 8 : blockIdx.x;
    for (int u = vcu * NWAVE + wave; u < T * G / 16; u += Gn * NWAVE) {
        int lane = lane0; asm volatile("" : "+v"(lane));
        const int l31 = lane & 31, h = lane >> 5;
        const int bg = u >> 9, t0 = (((u & 511) + 128 * (u >> 11)) & 511) * 16, b = bg >> 2, g = bg & 3, head = 4 * g + (lane & 3);
        const LAS float* hb = hbd + head * HBN; const float mhv = mh[head];
        int tok[2]; bf16x8 qf[2][4];
#pragma unroll
        for (int r = 0; r < 2; ++r) { tok[r] = t0 + 8 * r + (l31 >> 2); const bf16_t* qp = Q + (size_t)(b * S + tok[r]) * D + head * 64 + 8 * h;
#pragma unroll
            for (int ks = 0; ks < 4; ++ks) qf[r][ks] = *(const bf16x8*)(qp + 16 * ks); }
        f32x16 O[2][2];
#pragma unroll
        for (int r = 0; r < 2; ++r)
#pragma unroll
            for (int dt = 0; dt < 2; ++dt)
#pragma unroll
                for (int q = 0; q < 16; ++q) O[r][dt][q] = 0.f;
        DFrag cur; bf16x8 nxtk[4];
        {
            const bf16_t* KB = (const bf16_t*)(p.ws + WS_KWB) + (size_t)bg * 128 * 4096; const bf16_t* VB = (const bf16_t*)(p.ws + WS_VWB) + (size_t)bg * 128 * 4096;
            float lw[2] = {0.f, 0.f};
            const int lo = t0 - (WIN - 1) > 0 ? t0 - (WIN - 1) : 0, kt_last = t0 & ~31;
            dense_load_k(cur.ka, KB, lo & ~31, l31, h);
            for (int kt = lo & ~31; kt <= kt_last; kt += 32) {
                dense_load_v(cur.va, VB, kt, l31, h);
                dense_load_k(nxtk, KB, kt + 32 <= kt_last ? kt + 32 : kt_last, l31, h);
                __builtin_amdgcn_sched_barrier(0);
#pragma unroll
                for (int r = 0; r < 2; ++r) {
                    const f32x16 sacc = dense_scores(cur, qf[r]);
                    const int dbase = tok[r] - kt - 4 * h; float ev[16];
                    if (kt + 31 <= t0 + 8 * r && kt >= t0 + 8 * r + 7 - (WIN - 1)) {
                        const LAS float* hbp = hb + dbase;
#pragma unroll
                        for (int q = 0; q < 16; ++q) { const float e = __builtin_amdgcn_exp2f(sacc[q] + hbp[-((q & 3) + 8 * (q >> 2))] - mhv); ev[q] = e; lw[r] += e; }
                    } else {
#pragma unroll
                    for (int q = 0; q < 16; ++q) { const int dist = dbase - ((q & 3) + 8 * (q >> 2)); const bool ok = (unsigned)dist < (unsigned)WIN;
                        const float e0 = __builtin_amdgcn_exp2f(sacc[q] + hb[ok ? dist : 0] - mhv); const float e = ok ? e0 : 0.f; ev[q] = e; lw[r] += e; }
                    }
                    dense_pv(O[r], cur, ev);
                }
#pragma unroll
                for (int ks = 0; ks < 4; ++ks) cur.ka[ks] = nxtk[ks];
            }
#pragma unroll
            for (int r = 0; r < 2; ++r) { const float l = lw[r] + __shfl_xor(lw[r], 32); int tk = tok[r]; asm volatile("" : "+v"(tk)); const float* gp = GATE + (size_t)(b * S + tk) * 48 + head * 3;
                const float sc = gp[2] / (l * gp[0]);
#pragma unroll
                for (int dt = 0; dt < 2; ++dt) O[r][dt] = O[r][dt] * sc; }
        }
        const int ncmax = t0 >> 4;
        {
            int l31c = l31, hc = h; asm volatile("" : "+v"(l31c), "+v"(hc));
            const bf16_t* KB = (const bf16_t*)(p.ws + WS_KC) + (size_t)bg * 8 * 4096; const bf16_t* VB = (const bf16_t*)(p.ws + WS_VC) + (size_t)bg * 8 * 4096;
            float lc[2] = {0.f, 0.f};
            const int kt_last = ncmax > 0 ? ((ncmax - 1) & ~31) : -32;
            if (ncmax > 0) {
                dense_load_k(cur.ka, KB, 0, l31c, hc);
                for (int kt = 0; kt <= kt_last; kt += 32) {
                    dense_load_k(nxtk, KB, kt + 32 <= kt_last ? kt + 32 : kt_last, l31c, hc);
                    __builtin_amdgcn_sched_barrier(0);
#pragma unroll
                    for (int r = 0; r < 2; ++r) {
                        const f32x16 sacc = dense_scores(cur, qf[r]);
                        if (t0 - 31 - 16 * (kt + 31) >= HBN - 1) {
                            const float bfar = hb[HBN - 1] - mhv;
#pragma unroll
                            for (int q = 0; q < 16; ++q) lc[r] += __builtin_amdgcn_exp2f(sacc[q] + bfar);
                        } else {
                        const int dbase = tok[r] - 31 - 16 * (kt + 4 * hc);
#pragma unroll
                        for (int q = 0; q < 16; ++q) { const int dist = dbase - 16 * ((q & 3) + 8 * (q >> 2)); const int di = dist < 0 ? 0 : (dist > HBN - 1 ? HBN - 1 : dist);
                            const float e0 = __builtin_amdgcn_exp2f(sacc[q] + hb[di] - mhv); lc[r] += dist >= 0 ? e0 : 0.f; }
                        }
                    }
#pragma unroll
                    for (int ks = 0; ks < 4; ++ks) cur.ka[ks] = nxtk[ks];
                }
            }
            float linv[2];
#pragma unroll
            for (int r = 0; r < 2; ++r) { const float l = lc[r] + __shfl_xor(lc[r], 32); linv[r] = l > 0.f ? 1.f / l : 0.f; }
            { const f32x4 z = {0.f, 0.f, 0.f, 0.f};
#pragma unroll
              for (int i = 0; i < 8; ++i) *(LAS f32x4*)(pslc + (i * 64 + lane) * 4) = z; }
            if (ncmax > 0) {
                float carry[2] = {0.f, 0.f};
                dense_load_k(cur.ka, KB, 0, l31c, hc);
                for (int kt = 0; kt <= kt_last; kt += 32) {
                    dense_load_v(cur.va, VB, kt, l31c, hc);
                    dense_load_k(nxtk, KB, kt + 32 <= kt_last ? kt + 32 : kt_last, l31c, hc);
                    __builtin_amdgcn_sched_barrier(0);
#pragma unroll
                    for (int r = 0; r < 2; ++r) {
                        const f32x16 sacc = dense_scores(cur, qf[r]);
                        float pv[16];
                        const int dbase = tok[r] - 31 - 16 * (kt + 4 * hc);
#pragma unroll
                        for (int q = 0; q < 16; ++q) { const int dist = dbase - 16 * ((q & 3) + 8 * (q >> 2)); const int di = dist < 0 ? 0 : (dist > HBN - 1 ? HBN - 1 : dist);
                            const float e0 = __builtin_amdgcn_exp2f(sacc[q] + hb[di] - mhv); pv[q] = dist >= 0 ? e0 * linv[r] : 0.f; }
                        dense_pv(O[r], cur, pv);
#pragma unroll
                        for (int q = 0; q < 16; ++q) { pv[q] += __shfl_xor(pv[q], 1); pv[q] += __shfl_xor(pv[q], 2); }
                        float y[4];
#pragma unroll
                        for (int gq = 0; gq < 4; ++gq) y[gq] = __shfl_xor(pv[4 * gq + 3], 32);
#pragma unroll
                        for (int gq = 0; gq < 4; ++gq) { const float prevv = h ? y[gq] : (gq > 0 ? y[gq > 0 ? gq - 1 : 0] : carry[r]);
                            const float val = 2.f * ((pv[4 * gq] + pv[4 * gq + 1]) + pv[4 * gq + 2]) + pv[4 * gq + 3] + prevv;
                            if ((lane & 3) == 0) pslc[(8 * r + (l31c >> 2)) * 128 + (kt >> 2) + 2 * gq + hc] = val; }
                        carry[r] = y[3];
                    }
#pragma unroll
                    for (int ks = 0; ks < 4; ++ks) cur.ka[ks] = nxtk[ks];
                }
            }
        }
#pragma unroll
        for (int r = 0; r < 2; ++r) { int tk = tok[r]; asm volatile("" : "+v"(tk)); bf16_t* op = OW + (size_t)(b * S + tk) * D + head * 64 + 4 * h; const float gc = GATE[(size_t)(b * S + tk) * 48 + head * 3];
#pragma unroll
            for (int dt = 0; dt < 2; ++dt)
#pragma unroll
                for (int gq = 0; gq < 4; ++gq) { u32x2 w; w.x = cvt_pk_bf16(O[r][dt][4 * gq] * gc, O[r][dt][4 * gq + 1] * gc); w.y = cvt_pk_bf16(O[r][dt][4 * gq + 2] * gc, O[r][dt][4 * gq + 3] * gc);
                    *(u32x2*)(op + dt * 32 + 8 * gq) = w; } }
#pragma unroll 1
        for (int tl = 0; tl < 16; ++tl) {
            int ln = lane; asm volatile("" : "+v"(ln));
            const int t = t0 + tl, cur_b = t >> 6, j0 = ln, j1 = ln + 64;
            const float c0 = pslc[tl * 128 + j0], c1 = pslc[tl * 128 + j1];
            const bool f0 = (j0 == 0) || (j0 == cur_b) || (j0 == cur_b - 1), f1 = (j1 == cur_b) || (j1 == cur_b - 1);
            const bool v0 = j0 * 64 <= t, v1 = j1 * 64 <= t;
            const unsigned u0 = (v0 && !f0) ? __float_as_uint(c0) : 0u, u1 = (v1 && !f1) ? __float_as_uint(c1) : 0u;
            unsigned th = 1u;
            if (cur_b + 1 > NSEL) {
                th = 0u;
#pragma unroll 1
                for (int bit = 30; bit >= 0; --bit) {
                    const unsigned trial = th | (1u << bit);
                    const int cnt = __popcll(__ballot(u0 >= trial)) + __popcll(__ballot(u1 >= trial));
                    if (cnt >= NSEL - 3) { th = trial; if (cnt == NSEL - 3) break; }
                }
            }
            const bool s0 = f0 || (u0 >= th && u0 != 0u), s1 = f1 || (u1 >= th && u1 != 0u);
            const unsigned long long m0 = __ballot(s0), m1 = __ballot(s1), lt = (1ull << ln) - 1ull;
            const int p0 = __popcll(m0 & lt), p1 = __popcll(m0) + __popcll(m1 & lt);
            short* so = SEL + ((size_t)(b * S + t) * 4 + g) * NSEL;
            if (s0 && p0 < NSEL) so[p0] = (short)j0;
            if (s1 && p1 < NSEL) so[p1] = (short)j1;
        }
    }
}

struct Row16 { u32x4 r[8]; };
struct Row8 { u32x4 r[4]; };
__device__ __forceinline__ void load_row(Row16& r, const unsigned char* ptr) {
#pragma unroll
    for (int i = 0; i < 8; ++i) r.r[i] = *(const u32x4*)(ptr + i * 1024);
}
__device__ __forceinline__ void load_row(Row8& r, const unsigned char* ptr) {
#pragma unroll
    for (int i = 0; i < 4; ++i) r.r[i] = *(const u32x4*)(ptr + i * 1024);
}
typedef __bf16 bf16x2_t __attribute__((ext_vector_type(2)));
__device__ __forceinline__ s16x4 cvt4_fp8(unsigned w) {
    const bf16x2_t lo = __builtin_amdgcn_cvt_scalef32_pk_bf16_fp8(w, 1.0f, false), hi = __builtin_amdgcn_cvt_scalef32_pk_bf16_fp8(w, 1.0f, true);
    return mk4(__builtin_bit_cast(unsigned, lo), __builtin_bit_cast(unsigned, hi));
}
__device__ __forceinline__ s16x4 frag4(const Row16& k, int c) { const u32x4 v = k.r[c >> 1]; return (c & 1) ? mk4(v.z, v.w) : mk4(v.x, v.y); }
__device__ __forceinline__ s16x4 frag4(const Row8& k, int c) { return cvt4_fp8(k.r[c >> 2][c & 3]); }
typedef int i32x4v __attribute__((ext_vector_type(4)));
__device__ __forceinline__ f32x4 qk_row_i8(const Row8& k, const int (&qi)[16]) {
    i32x4v s0 = {0, 0, 0, 0}, s1 = s0;
#pragma unroll
    for (int c = 0; c < 16; c += 2) { s0 = __builtin_amdgcn_mfma_i32_4x4x4i8((int)k.r[c >> 2][c & 3], qi[c], s0, 0, 0, 0); s1 = __builtin_amdgcn_mfma_i32_4x4x4i8((int)k.r[(c + 1) >> 2][(c + 1) & 3], qi[c + 1], s1, 0, 0, 0); }
    const i32x4v t = s0 + s1; return (f32x4){(float)t.x, (float)t.y, (float)t.z, (float)t.w};
}
template <class Row> __device__ __forceinline__ f32x4 qk_row(const Row& k, const s16x4 (&qf)[16]) {
    f32x4 s = {0.f, 0.f, 0.f, 0.f};
#pragma unroll
    for (int c = 0; c < 16; ++c) s = mfma4(frag4(k, c), qf[c], s);
    return s;
}
template <class Row> __device__ __forceinline__ void pv_row(f32x4& o, const f32x4 e, const Row& v, LAS u32x2* stage, int lane) {
    u32x2 pk; pk.x = cvt_pk_bf16(e.x, e.y); pk.y = cvt_pk_bf16(e.z, e.w);
    stage[lane] = pk;
#pragma unroll
    for (int st = 0; st < 16; ++st) { const u32x2 a = stage[4 * st + (lane & 3)]; o = mfma4(mk4(a.x, a.y), frag4(v, st), o); }
}
#define PIPE_PIN() __builtin_amdgcn_sched_barrier(0)
template <bool HASV, class F>
__device__ __forceinline__ void pipe_blocks(const int n, F& f, const s16x4 (&qf)[16]) {
    if (n <= 0) return;
    typename F::Row kA, kB, vA, vB;
    const int l = n - 1;
    load_row(kA, f.kptr(0)); if (HASV) load_row(vA, f.vptr(0));
    PIPE_PIN();
    for (int i = 0; i < n; i += 2) {
        { const int j = i + 1 < l ? i + 1 : l; load_row(kB, f.kptr(j)); if (HASV) load_row(vB, f.vptr(j)); PIPE_PIN();
          const f32x4 sv = qk_row(kA, qf); f.use(i, sv, vA); PIPE_PIN(); }
        if (i + 1 < n) { const int j = i + 2 < l ? i + 2 : l; load_row(kA, f.kptr(j)); if (HASV) load_row(vA, f.vptr(j)); PIPE_PIN();
          const f32x4 sv = qk_row(kB, qf); f.use(i + 1, sv, vB); PIPE_PIN(); }
    }
}
template <class F>
__device__ __forceinline__ void pipe_blocks3(const int n, F& f) {
    if (n <= 0) return;
    typename F::Row k0, k1, k2, v0, v1, v2;
    const int l = n - 1;
#define PB3_IDX(j) ((j) < l ? (j) : l)
    load_row(k0, f.kptr(0)); load_row(v0, f.vptr(0)); load_row(k1, f.kptr(PB3_IDX(1))); load_row(v1, f.vptr(PB3_IDX(1)));
    PIPE_PIN();
#define PB3_STEP(j, KN, VN, KC, VC) if (i + (j) < n) { load_row(KN, f.kptr(PB3_IDX(i + (j) + 2))); load_row(VN, f.vptr(PB3_IDX(i + (j) + 2))); PIPE_PIN(); \
        const f32x4 sv = f.qk(KC); f.use(i + (j), sv, VC); PIPE_PIN(); }
    for (int i = 0; i < n; i += 3) { PB3_STEP(0, k2, v2, k0, v0) PB3_STEP(1, k0, v0, k1, v1) PB3_STEP(2, k1, v1, k2, v2) }
#undef PB3_STEP
#undef PB3_IDX
}
struct SelCtx {
    typedef Row8 Row;
    const unsigned char* ks; const unsigned char* vs; const LAS float* hb; LAS u32x2* stage; float mhv, dq; int selv, t, lane, qd;
    int qi[16];
    f32x4 os; float ls;
    __device__ __forceinline__ f32x4 qk(const Row8& k) const { return qk_row_i8(k, qi) * dq; }
    __device__ __forceinline__ const unsigned char* kptr(int i) const { return ks + (size_t)__builtin_amdgcn_readlane(selv, i) * 4096; }
    __device__ __forceinline__ const unsigned char* vptr(int i) const { return vs + (size_t)__builtin_amdgcn_readlane(selv, i) * 4096; }
    __device__ __forceinline__ void use(int i, const f32x4 sv, const Row8& vr) {
        const int pos0 = __builtin_amdgcn_readlane(selv, i) * 64;
        f32x4 e;
        if (t - pos0 - 63 >= HBN - 1) {
            const float bfar = hb[HBN - 1] - mhv;
#pragma unroll
            for (int q = 0; q < 4; ++q) e[q] = __builtin_amdgcn_exp2f(sv[q] + bfar);
        } else {
#pragma unroll
        for (int q = 0; q < 4; ++q) { const int dist = t - (pos0 + 4 * qd + q); const int di = dist < 0 ? 0 : (dist > HBN - 1 ? HBN - 1 : dist);
            const float e0 = __builtin_amdgcn_exp2f(sv[q] + hb[di] - mhv); e[q] = dist >= 0 ? e0 : 0.f; }
        }
        ls += (e[0] + e[1]) + (e[2] + e[3]);
        pv_row(os, e, vr, stage, lane);
    }
};

__device__ __forceinline__ void phase_attn_pair(const Params& p, LAS unsigned char* lds, bf16_t* AO, const bf16_t* OW) {
    const int tid = opaque_tid(), lane = tid & 63, wave = tid >> 6, jq = lane & 3, qd = lane >> 2;
    const LAS float* hbd = (const LAS float*)(lds + ATT_HBD); const LAS float* mh = (const LAS float*)(lds + ATT_MH);
    LAS u32x2* stage = (LAS u32x2*)(lds + ATT_STAGE) + wave * 64;
    const float dq8 = 1.f / (sel_q_scale(p.q_gain) * sel_k_scale(p.k_gain));
    const unsigned char* KSB = p.ws + WS_KSB; const unsigned char* VSB = p.ws + WS_VSB;
    const float* GATE = (const float*)(p.ws + WS_GATE); const short* SEL = (const short*)(p.ws + WS_SEL);
    const int Gn = gridDim.x, vcu = (Gn % 8 == 0) ? (blockIdx.x % 8) * (Gn / 8) + blockIdx.x / 8 : blockIdx.x;
    for (int idx = vcu * NWAVE + wave; idx < T * G; idx += Gn * NWAVE) {
        const int bg = idx >> 13, t = idx & (S - 1), b = bg >> 2, g = bg & 3, u = b * S + t;
        const int head = 4 * g + jq;
        const int cur = t >> 6, nv = cur + 1 < NSEL ? cur + 1 : NSEL;
        SelCtx sw;
        { const u32x4* qp = (const u32x4*)(p.ws + WS_Q8 + (size_t)u * D + head * 64);
#pragma unroll
            for (int i = 0; i < 4; ++i) { const u32x4 w = qp[i]; sw.qi[4 * i] = (int)w.x; sw.qi[4 * i + 1] = (int)w.y; sw.qi[4 * i + 2] = (int)w.z; sw.qi[4 * i + 3] = (int)w.w; } }
        sw.dq = dq8; sw.selv = (int)SEL[((size_t)u * 4 + g) * NSEL + (lane & 15)];
        sw.ks = KSB + (size_t)bg * 128 * 4096 + lane * 16; sw.vs = VSB + (size_t)bg * 128 * 4096 + lane * 16; sw.hb = hbd + head * HBN; sw.stage = stage; sw.mhv = mh[head]; sw.t = t; sw.lane = lane; sw.qd = qd;
        sw.os = (f32x4){0.f, 0.f, 0.f, 0.f}; sw.ls = 0.f;
        pipe_blocks3(nv, sw);
        const float lsi = 1.f / quadx_sum(sw.ls);
        const float* gt = GATE + (size_t)u * 48 + g * 12;
#pragma unroll
        for (int i = 0; i < 4; ++i) {
            const float si = __shfl(lsi, (lane & ~3) + i);
            const float r = gt[3 * i + 1] * (sw.os[i] * si) + bf2f(OW[(size_t)u * D + (4 * g + i) * 64 + lane]);
            AO[(size_t)u * D + (4 * g + i) * 64 + lane] = (bf16_t)(cvt_pk_bf16(r, 0.f) & 0xffffu);
        }
    }
}

__device__ __forceinline__ void moe_pstarts(const unsigned* ctl, int (&pst)[NE + 1]) {
    int a = 0;
#pragma unroll
    for (int e = 0; e < NE; ++e) { pst[e] = a; const int c = (int)ctl[CW_CNT + 64 * e]; a += (c + 511) / 512 * 512; }
    pst[NE] = a;
}
__device__ __forceinline__ void phase_moe_sort(const Params& p, LAS unsigned char* lds) {
    const int tid = opaque_tid(), lane = tid & 63, wave = tid >> 6;
    unsigned* ctl = (unsigned*)(p.ws + WS_CTL);
    const int* TOPE = (const int*)(p.ws + WS_TOPE); int* RPOS = (int*)(p.ws + WS_RPOS);
    const bf16_t* HB = (const bf16_t*)(p.ws + WS_HB); bf16_t* XS = (bf16_t*)(p.ws + WS_XS);
    LAS int* wcnt = (LAS int*)lds;
    LAS int* base = (LAS int*)(lds + 128);
    LAS int* posl = (LAS int*)(lds + 256);
    int pst[NE + 1]; moe_pstarts(ctl, pst);
    if (blockIdx.x == 0 && tid <= NE) ((int*)(ctl + 256))[tid] = pst[tid];
    for (int c0 = blockIdx.x * 256; c0 < 2 * T; c0 += gridDim.x * 256) {
        int e = 0, rank = 0;
        if (wave < 4) { e = TOPE[c0 + wave * 64 + lane];
#pragma unroll
            for (int q = 0; q < NE; ++q) { const unsigned long long m = __ballot(e == q); if (e == q) rank = __popcll(m & ((1ull << lane) - 1ull)); if (lane == 0) wcnt[wave * NE + q] = __popcll(m); } }
        __syncthreads();
        if (tid < NE) { const int n = wcnt[tid] + wcnt[NE + tid] + wcnt[2 * NE + tid] + wcnt[3 * NE + tid]; base[tid] = n ? (int)atomicAdd(ctl + CW_CUR + 64 * tid, (unsigned)n) : 0; }
        __syncthreads();
        if (wave < 4) { int off = 0;
            for (int w = 0; w < wave; ++w) off += wcnt[w * NE + e];
            const int pos = pst[e] + base[e] + off + rank; posl[wave * 64 + lane] = pos; RPOS[c0 + wave * 64 + lane] = pos; }
        __syncthreads();
        for (int j = wave * 32; j < wave * 32 + 32; j += 8) {
            u32x4 v0[8]; int ps[8];
#pragma unroll
            for (int q = 0; q < 8; ++q) { const int tk = (c0 + j + q) >> 1; ps[q] = posl[j + q]; v0[q] = *((const u32x4*)((const unsigned char*)HB + (size_t)tk * D) + lane); }
#pragma unroll
            for (int q = 0; q < 8; ++q) *((u32x4*)((unsigned char*)XS + (size_t)ps[q] * D) + lane) = v0[q];
        }
        __syncthreads();
    }
}
__device__ __forceinline__ void phase_fill_rtok(const Params& p) {
    int* RTOK = (int*)(p.ws + WS_RTOK);
    for (int i = blockIdx.x * NTHR + threadIdx.x; i < MOE_ROWS; i += gridDim.x * NTHR) RTOK[i] = 0;
}
__device__ __forceinline__ void phase_combine(const Params& p) {
    const int tid = opaque_tid(), lane = tid & 63, wave = tid >> 6;
    const int gw = blockIdx.x * NWAVE + wave, NGW = gridDim.x * NWAVE;
    const float* TOPW = (const float*)(p.ws + WS_TOPW); const int* RPOS = (const int*)(p.ws + WS_RPOS);
    const bf16_t* Y = (const bf16_t*)(p.ws + WS_Y); const float* g2 = (const float*)(p.ws + WS_MODV) + (11 * 4) * D;
    for (int r = gw; r < T; r += NGW) {
        const int b = r >> 13; const int p0 = RPOS[2 * r], p1 = RPOS[2 * r + 1]; const float w0 = TOPW[2 * r], w1 = TOPW[2 * r + 1];
#pragma unroll
        for (int j = 0; j < 4; ++j) { const int c = 4 * lane + 256 * j;
            const u32x2 y0 = *(const u32x2*)(Y + (size_t)p0 * D + c), y1 = *(const u32x2*)(Y + (size_t)p1 * D + c);
            const f32x4 gv = *(const f32x4*)(g2 + b * D + c); f32x4 xv = *(const f32x4*)(p.out + (size_t)r * D + c);
            f32x4 f; f.x = w0 * bflo(y0.x) + w1 * bflo(y1.x); f.y = w0 * bfhi(y0.x) + w1 * bfhi(y1.x); f.z = w0 * bflo(y0.y) + w1 * bflo(y1.y); f.w = w0 * bfhi(y0.y) + w1 * bfhi(y1.y);
            *(f32x4*)(p.out + (size_t)r * D + c) = xv + gv * f; }
    }
}

#define XB_TMO      128
#define XB_XCNT(j)  (256  + 64 * (j))
#define XB_XSUB(j)  (1280 + 64 * (j))
#define XB_XGEN(j)  (2304 + 64 * (j))
#define XB_TOP      3328
#define XB_TOPGEN   3392
#define XCD_BAR_WORDS 3456
#define XB_SPIN_CAP (1u << 18)
__device__ __forceinline__ unsigned xb_ld(unsigned* p)              { return __hip_atomic_load(p, __ATOMIC_RELAXED, __HIP_MEMORY_SCOPE_AGENT); }
__device__ __forceinline__ unsigned xb_add(unsigned* p, unsigned v) { return __hip_atomic_fetch_add(p, v, __ATOMIC_RELAXED, __HIP_MEMORY_SCOPE_AGENT); }
__device__ __forceinline__ unsigned xb_xcc_id() { return (unsigned)__builtin_amdgcn_s_getreg((3 << 11) | 20) & 0xFu; }
#define XB_SPIN(cond, bar) do { unsigned _sp = 0; while (cond) { __builtin_amdgcn_s_sleep(1); \
    if ((++_sp & 255u) == 0u) { if (xb_ld(&(bar)[XB_TMO])) break; if (_sp > XB_SPIN_CAP) { atomicAdd(&(bar)[XB_TMO], 1u); break; } } } } while (0)
struct XcdBarrier { unsigned* bar; unsigned x; volatile LAS unsigned* st; };
__device__ __forceinline__ XcdBarrier xcd_barrier_post(unsigned* bar, volatile LAS unsigned* st) {
    XcdBarrier b; b.bar = bar; b.x = xb_xcc_id(); b.st = st;
    if (threadIdx.x == 0) (void)xb_add(&bar[XB_XCNT(b.x)], 1u);
    return b;
}
__device__ __forceinline__ void xcd_barrier_complete(unsigned* bar, unsigned x, unsigned& nloc, unsigned& nx) {
    const unsigned G_ = gridDim.x * gridDim.y * gridDim.z;
    unsigned sum, cnt, mine, sp = 0u;
    for (;;) {
        sum = 0u; cnt = 0u; mine = 0u;
#pragma unroll
        for (unsigned j = 0; j < 16; ++j) { const unsigned c = xb_ld(&bar[XB_XCNT(j)]); sum += c; cnt += (c > 0u) ? 1u : 0u; mine = (j == x) ? c : mine; }
        if (sum == G_) break;
        __builtin_amdgcn_s_sleep(1);
        if ((++sp & 255u) == 0u) { if (xb_ld(&bar[XB_TMO])) break; if (sp > XB_SPIN_CAP) { atomicAdd(&bar[XB_TMO], 1u); break; } }
    }
    nloc = mine > 0u ? mine : 1u; nx = cnt > 0u ? cnt : 1u;
}
__device__ __forceinline__ void xcd_barrier(const XcdBarrier& b) {
    asm volatile("s_waitcnt vmcnt(0)" ::: "memory");
    __syncthreads();
    if (threadIdx.x == 0) {
        unsigned* bar = b.bar;
        __builtin_amdgcn_s_waitcnt(0);
        unsigned nloc = b.st[0], nx = b.st[1];
        if (nloc == 0u) { xcd_barrier_complete(bar, b.x, nloc, nx); b.st[0] = nloc; b.st[1] = nx; }
        const unsigned old = xb_add(&bar[XB_XSUB(b.x)], 1u);
        const unsigned gen = old / nloc;
        if (old + 1u == (gen + 1u) * nloc) {
            __builtin_amdgcn_fence(__ATOMIC_RELEASE, "agent");
            asm volatile("s_waitcnt vmcnt(0)" ::: "memory");
            const unsigned og = xb_add(&bar[XB_TOP], 1u);
            const unsigned tg = og / nx;
            if (og + 1u == (tg + 1u) * nx) xb_add(&bar[XB_TOPGEN], 1u);
            else XB_SPIN(xb_ld(&bar[XB_TOPGEN]) == tg, bar);
            __builtin_amdgcn_fence(__ATOMIC_ACQUIRE, "agent");
            xb_add(&bar[XB_XGEN(b.x)], 1u);
            asm volatile("s_waitcnt vmcnt(0)" ::: "memory");
        } else {
            XB_SPIN(xb_ld(&bar[XB_XGEN(b.x)]) == gen, bar);
            __builtin_amdgcn_fence(__ATOMIC_ACQUIRE, "agent");
            asm volatile("s_waitcnt vmcnt(0)" ::: "memory");
        }
    }
    __syncthreads();
}

constexpr int LDS_SCRATCH = 131072, MISC_OFF = LDS_SCRATCH + 320, LDS_BYTES = 147456;
#define MODP(which) ((const float*)(p.ws + WS_MODV) + (size_t)(which) * 4 * D)

__global__ void __launch_bounds__(NTHR, 2) k_fused(Params p) {
    extern __shared__ __attribute__((aligned(16))) unsigned char lds_raw[];
    LAS unsigned char* lds = (LAS unsigned char*)lds_raw;
    for (int u = threadIdx.x; u < (LDS_BYTES - LDS_SCRATCH) / 4; u += NTHR) ((LAS unsigned*)(lds + LDS_SCRATCH))[u] = 0u;
    __syncthreads();
    const XcdBarrier bar = xcd_barrier_post((unsigned*)(p.ws + WS_CTL) + CW_BAR, (volatile LAS unsigned*)(lds + MISC_OFF) + 8);
#define GRID_BAR() xcd_barrier(bar)
    phase_weights(p, lds); __syncthreads(); phase_modvec(p, lds);
    GRID_BAR();
    phase_poolmix(p, lds, (bf16_t*)(p.ws + WS_HA));
    GRID_BAR();
    { pg8::Sched<1> Sc; Sc.init(T, D, gridDim.x, blockIdx.x, p.ws + WS_HA, p.ws + WO_POOL, D, 256);
      pg8::EpiEl<EpiPool> E{{p.x, (float*)(p.ws + WS_X1), MODP(2), p.pool_scale, 0}};
      pg8::gemm_phase(lds, 256, D, 256, 128, Sc, E); }
    GRID_BAR();
    { NormOut o0{p.norm_g + D, MODP(4), MODP(3), (bf16_t*)(p.ws + WS_HB)}; phase_norm<1, false>(p, lds, (const float*)(p.ws + WS_X1), o0, o0); }
    GRID_BAR();
    { pg8::Sched<0> Sc; Sc.init(T, 2 * FF, gridDim.x, blockIdx.x, p.ws + WS_HB, p.ws + WO_FGU, D, D);
      pg8::EpiPairEl<EpiSwiglu> E{{(bf16_t*)(p.ws + WS_HID0), FF}};
      pg8::gemm_phase(lds, D, D, D, 128, Sc, E); }
    GRID_BAR();
    { pg8::Sched<0> Sc; Sc.init(T, D, gridDim.x, blockIdx.x, p.ws + WS_HID0, p.ws + WO_FDN, FF, FF);
      pg8::EpiEl<EpiResid> E{{(const float*)(p.ws + WS_X1), (float*)(p.ws + WS_X2), MODP(5)}};
      pg8::gemm_phase(lds, FF, FF, FF, 128, Sc, E); }
    GRID_BAR();
    { NormOut o0{p.kv_norm_g, MODP(13), MODP(12), (bf16_t*)(p.ws + WS_HA)}; NormOut o1{p.norm_g + 2 * D, MODP(7), MODP(6), (bf16_t*)(p.ws + WS_HB)}; phase_norm<2, false>(p, lds, (const float*)(p.ws + WS_X2), o0, o1); }
    GRID_BAR();
    { pg8::Sched<0> Sc; Sc.init(T, NKV, gridDim.x, blockIdx.x, p.ws + WS_HA, p.ws + WO_KV, D, D);
      pg8::EpiEl<EpiBf16> E{{(bf16_t*)(p.ws + WS_KVB), NKV}};
      pg8::gemm_phase(lds, D, D, D, 128, Sc, E); }
    { pg8::Sched<0> Sc; Sc.init(T, NQP, gridDim.x, blockIdx.x, p.ws + WS_HB, p.ws + WO_Q, D, D);
      pg8::EpiEl<EpiQ> E{{(bf16_t*)(p.ws + WS_Q), (float*)(p.ws + WS_GATE)}};
      pg8::gemm_phase(lds, D, D, D, 128, Sc, E); }
    GRID_BAR();
    { pg8::Sched<2> Sc; Sc.init(2048, 2048, gridDim.x, blockIdx.x, p.ws + WS_KVB, p.ws + WO_CK, 16 * NKV, 2048);
      pg8::EpiEl<EpiCmp> E{{(bf16_t*)(p.ws + WS_CMPH), (const float*)(p.ws + WS_CMPB)}};
      pg8::gemm_phase(lds, 2048, 16 * NKV, 2048, (size_t)NKV * 2, Sc, E); }
    phase_headnorm(p, lds); phase_vtrans(p, lds);
    GRID_BAR();
    phase_cmp2(p, lds);
    GRID_BAR();
    attn_tables(p, lds);
    phase_dense(p, lds, (bf16_t*)(p.ws + WS_HB));
    GRID_BAR();
    phase_attn_pair(p, lds, (bf16_t*)(p.ws + WS_HA), (const bf16_t*)(p.ws + WS_HB));
    GRID_BAR();
    { pg8::Sched<0> Sc; Sc.init(T, D, gridDim.x, blockIdx.x, p.ws + WS_HA, p.ws + WO_O, D, D);
      pg8::EpiEl<EpiResid> E{{(const float*)(p.ws + WS_X2), p.out, MODP(8)}};
      pg8::gemm_phase(lds, D, D, D, 128, Sc, E); }
    GRID_BAR();
    { NormOut o0{p.norm_g + 3 * D, MODP(10), MODP(9), (bf16_t*)(p.ws + WS_HB)}; phase_norm<1, true, true>(p, lds, p.out, o0, o0); }
    GRID_BAR();
    phase_moe_sort(p, lds);
    GRID_BAR();
    { const int* pst = (const int*)(p.ws + WS_CTL) + 256;
      pg8::Sched<3> Sc; Sc.init(pst[NE], 2 * FE, gridDim.x, blockIdx.x, p.ws + WS_XS, p.ws + WO_EGU, D / 2, D / 2, pst, (size_t)FE * D);
      pg8::EpiPairEl<EpiSwiglu8> E{{p.ws + WS_HIDM, FE}};
      pg8::gemm_phase<pg8::EpiPairEl<EpiSwiglu8>, pg8::Sched<3>, true, true, true>(lds, D / 2, D / 2, D / 2, 128, Sc, E, 127 - 5); }
    GRID_BAR();
    { const int* pst = (const int*)(p.ws + WS_CTL) + 256;
      pg8::Sched<3> Sc; Sc.init(pst[NE], D, gridDim.x, blockIdx.x, p.ws + WS_HIDM, p.ws + WO_EDN, FE / 2, FE / 2, pst, (size_t)D * FE / 2);
      pg8::EpiEl<EpiBf16> E{{(bf16_t*)(p.ws + WS_Y), D}};
      pg8::gemm_phase<pg8::EpiEl<EpiBf16>, pg8::Sched<3>, true, true, true>(lds, FE / 2, FE / 2, FE / 2, 128, Sc, E, 127 - 6); }
    GRID_BAR();
    phase_combine(p);
}

extern "C" void kernel_launch(void* const* d_in, const int* in_sizes, int n_in, void* d_out, int out_size, void* d_ws, size_t ws_size, hipStream_t stream) {
    if (n_in != 28 || out_size != T * D || ws_size < WS_END) { fprintf(stderr, "kernel_launch: unexpected shapes (n_in %d out %d ws %zu need %zu)\n", n_in, out_size, ws_size, (size_t)WS_END); return; }
    static int grid = 0;
    if (grid == 0) {
        int dev = 0, cus = 0, per_cu = 0;
        if (hipGetDevice(&dev) != hipSuccess || hipDeviceGetAttribute(&cus, hipDeviceAttributeMultiprocessorCount, dev) != hipSuccess) { grid = -1; return; }
        if (hipFuncSetAttribute((const void*)k_fused, hipFuncAttributeMaxDynamicSharedMemorySize, LDS_BYTES) != hipSuccess) { grid = -1; return; }
        if (hipOccupancyMaxActiveBlocksPerMultiprocessor(&per_cu, (const void*)k_fused, NTHR, LDS_BYTES) != hipSuccess || per_cu < 1) { fprintf(stderr, "kernel_launch: occupancy query says %d\n", per_cu); }
        (void)hipGetLastError();
        grid = cus;
    }
    if (grid < 0) return;
    Params p{};
    const float** pp = (const float**)&p;
    for (int i = 0; i < 28; ++i) pp[i] = (const float*)d_in[i];
    p.out = (float*)d_out; p.ws = (unsigned char*)d_ws;
    (void)hipMemsetAsync((char*)d_ws + WS_CTL, 0, CTL_BYTES, stream);
    k_fused<<<dim3(grid), dim3(NTHR), LDS_BYTES, stream>>>(p);
}
```

```cpp
#include <hip/hip_runtime.h>
#include <cstdint>
#include <cstdio>

#define LAS __attribute__((address_space(3)))
typedef unsigned short bf16_t;
typedef short bf16x8 __attribute__((ext_vector_type(8)));
typedef float f32x4 __attribute__((ext_vector_type(4)));
typedef float f32x2 __attribute__((ext_vector_type(2)));
typedef unsigned u32x4 __attribute__((ext_vector_type(4)));
typedef unsigned u32x2 __attribute__((ext_vector_type(2)));

constexpr int NB = 4, S = 8192, D = 1024, T = NB * S;
constexpr int FF = 2816, NE = 8, FE = 3584;
constexpr int NKV = 1536, NQP = 1280, NQ = 1072;
constexpr int G = 4, HD = 64, NH = 16;
constexpr int NC = 512;
constexpr int NSB = 128;
constexpr int NSEL = 16;
constexpr int WIN = 512;
constexpr int MOE_ROWS = 69632;
constexpr float EPS = 1e-6f;
constexpr int NTHR = 512, NWAVE = 8;

constexpr size_t MiB = 1u << 20;
constexpr size_t WS_CTL = 0, CTL_BYTES = 1 * MiB;
constexpr size_t WS_MODV = 1 * MiB;
constexpr size_t WS_CMPB = WS_MODV + 14 * 4 * 1024 * 4;
constexpr size_t WS_FGMAX = WS_CMPB + 4096;
constexpr size_t WS_ASC = WS_FGMAX + 2 * FF * 4;
constexpr size_t WS_TOPE = 2 * MiB;
constexpr size_t WS_TOPW = WS_TOPE + (size_t)T * 8;
constexpr size_t WS_RPOS = WS_TOPW + (size_t)T * 8;
constexpr size_t WS_RTOK = WS_RPOS + (size_t)T * 8;
constexpr size_t WS_SMALL_END = WS_RTOK + (size_t)MOE_ROWS * 4;
static_assert(WS_SMALL_END <= 8 * MiB && WS_ASC + (size_t)T * 4 <= 2 * MiB, "small region");
constexpr size_t WS_W = 8 * MiB;
constexpr size_t WO_POOL = WS_W;
constexpr size_t WO_FGU = WO_POOL + (size_t)4 * 256 * 256 * 2;
constexpr size_t WO_FDN = WO_FGU + (size_t)2 * FF * D * 2;
constexpr size_t WO_KV = WO_FDN + (size_t)D * FF * 2;
constexpr size_t WO_Q = WO_KV + (size_t)NKV * D * 2;
constexpr size_t WO_O = WO_Q + (size_t)NQP * D * 2;
constexpr size_t WO_CK = WO_O + (size_t)D * D * 2;
constexpr size_t WO_CV = WO_CK + (size_t)256 * 2048 * 2;
constexpr size_t WO_EGU = WO_CV + (size_t)256 * 2048 * 2;
constexpr size_t WO_EDN = WO_EGU + (size_t)NE * 2 * FE * D * 2;
constexpr size_t WO_END = WO_EDN + (size_t)NE * D * FE * 2;
static_assert(WO_END <= 203 * MiB, "weights region");
constexpr size_t WS_HB = 203 * MiB;
constexpr size_t WS_X1 = 267 * MiB;
constexpr size_t WS_X2 = 395 * MiB;
constexpr size_t WS_HID0 = 523 * MiB;
constexpr size_t WS_Q = 523 * MiB;
constexpr size_t WS_GATE = 587 * MiB;
constexpr size_t WS_CMPH = 593 * MiB;
constexpr size_t WS_KC = 601 * MiB;
constexpr size_t WS_VC = 602 * MiB;
constexpr size_t WS_KSB = 603 * MiB;
constexpr size_t WS_VSB = 619 * MiB;
constexpr size_t WS_KWB = 635 * MiB;
constexpr size_t WS_VWB = 651 * MiB;
constexpr size_t WS_Q8 = 267 * MiB;
constexpr size_t WS_SEL = 667 * MiB;
constexpr size_t WS_HA = 699 * MiB;
constexpr size_t WS_KVB = 763 * MiB;
constexpr size_t WS_HIDM = 267 * MiB;
constexpr size_t WS_Y = 743 * MiB;
constexpr size_t WS_XS = WS_Y;
constexpr size_t WS_END = 880 * MiB;
static_assert(WS_HIDM + (size_t)MOE_ROWS * FE * 2 <= WS_Y && WS_Y + (size_t)MOE_ROWS * D * 2 <= WS_END, "moe map");
static_assert(WS_KVB + (size_t)T * NKV * 2 + 65536 <= WS_END, "kv map");
constexpr int CW_CNT = 512;
constexpr int CW_CUR = 1024;
constexpr int CW_HN = 2048, CW_VT = 2112;
constexpr int CW_BAR = 4096;

struct Params {
    const float *x, *c, *ada_w, *ada_b, *norm_g, *pool_w, *pool_scale, *q_w, *q_gain, *o_w, *kv_ada_w, *kv_ada_b, *kv_norm_g, *kv_w,
        *cmp_pe_k, *cmp_pe_v, *cmp_k_w1, *cmp_k_w2, *cmp_v_w1, *cmp_v_w2, *k_gain, *rel_bias, *ffn_gu, *ffn_dn, *router_w, *router_b, *exp_gu, *exp_dn;
    float* out; unsigned char* ws;
};

__device__ __forceinline__ unsigned cvt_pk_bf16(float lo, float hi) { unsigned r; asm volatile("v_cvt_pk_bf16_f32 %0, %1, %2" : "=v"(r) : "v"(lo), "v"(hi)); return r; }
__device__ __forceinline__ float bf2f(unsigned short v) { return __uint_as_float((unsigned)v << 16); }
__device__ __forceinline__ float bflo(unsigned w) { return __uint_as_float(w << 16); }
__device__ __forceinline__ float bfhi(unsigned w) { return __uint_as_float(w & 0xffff0000u); }
__device__ __forceinline__ int opaque_tid() { int t = threadIdx.x; asm volatile("" : "+v"(t)); return t; }
__device__ __forceinline__ float readlane_f(float v, int l) { return __uint_as_float((unsigned)__builtin_amdgcn_readlane((int)__float_as_uint(v), l)); }
__device__ __forceinline__ unsigned pack_i8x4(float a, float b, float c, float d) {
    const int ia = (int)__builtin_rintf(fminf(fmaxf(a, -127.f), 127.f)), ib = (int)__builtin_rintf(fminf(fmaxf(b, -127.f), 127.f)), ic = (int)__builtin_rintf(fminf(fmaxf(c, -127.f), 127.f)), id = (int)__builtin_rintf(fminf(fmaxf(d, -127.f), 127.f));
    return (unsigned)(ia & 0xff) | ((unsigned)(ib & 0xff) << 8) | ((unsigned)(ic & 0xff) << 16) | ((unsigned)(id & 0xff) << 24);
}
__device__ __forceinline__ float sel_q_scale(const float* q_gain) { float m = 0.f; for (int i = 0; i < 64; ++i) m = fmaxf(m, fabsf(q_gain[i])); return 127.f / (4.f * m * 0.125f * 1.4426950408889634f); }
__device__ __forceinline__ float sel_k_scale(const float* k_gain) { float m = 0.f; for (int i = 0; i < 64; ++i) m = fmaxf(m, fabsf(k_gain[64 + i])); return 127.f / (4.f * m); }
__device__ __forceinline__ float wave_sum(float v) {
#pragma unroll
    for (int o = 1; o < 64; o <<= 1) v += __shfl_xor(v, o);
    return v;
}
__device__ __forceinline__ float wave_max(float v) {
#pragma unroll
    for (int o = 1; o < 64; o <<= 1) v = fmaxf(v, __shfl_xor(v, o));
    return v;
}
__device__ __forceinline__ float silu_f(float v) { return v / (1.f + __expf(-v)); }
__device__ __forceinline__ float sigmoid_f(float v) { return 1.f / (1.f + __expf(-v)); }
__device__ __forceinline__ float gelu_tanh_f(float v) {
    const float u = 0.7978845608028654f * (v + 0.044715f * v * v * v);
    const float e = __expf(-2.f * fabsf(u)); const float th = (1.f - e) / (1.f + e);
    return 0.5f * v * (1.f + (u < 0.f ? -th : th));
}
__device__ __forceinline__ int rel_bucket(int d) {
    if (d < 16) return d;
    int b = 16;
    b += (d >= 21); b += (d >= 27); b += (d >= 35); b += (d >= 46); b += (d >= 59); b += (d >= 77); b += (d >= 99); b += (d >= 128);
    b += (d >= 166); b += (d >= 216); b += (d >= 280); b += (d >= 363); b += (d >= 470); b += (d >= 609); b += (d >= 790);
    return b;
}

template <bool FP8 = false>
__device__ __forceinline__ void transpose_item(const float* W, int K, int N, bf16_t* WT, int k0, int n0, int drow0, LAS float* scr, int lane, float wscale = 1.f) {
    float wv[32];
#pragma unroll
    for (int i = 0; i < 32; ++i) { const int kk = 2 * i + (lane >> 5); const int n = n0 + (lane & 31); wv[i] = (n < N) ? W[(size_t)(k0 + kk) * N + n] : 0.f; }
#pragma unroll
    for (int i = 0; i < 32; ++i) { const int kk = 2 * i + (lane >> 5); scr[kk * 33 + (lane & 31)] = wv[i]; }
    asm volatile("s_waitcnt lgkmcnt(0)" ::: "memory");
    const int c = lane & 7;
#pragma unroll
    for (int j = 0; j < 4; ++j) { const int n = (lane >> 3) + 8 * j; const LAS float* s = scr + (8 * c) * 33 + n;
        if constexpr (FP8) {
            unsigned w0 = 0u, w1 = 0u;
            w0 = __builtin_amdgcn_cvt_pk_fp8_f32(s[0 * 33] * wscale, s[1 * 33] * wscale, w0, false); w0 = __builtin_amdgcn_cvt_pk_fp8_f32(s[2 * 33] * wscale, s[3 * 33] * wscale, w0, true);
            w1 = __builtin_amdgcn_cvt_pk_fp8_f32(s[4 * 33] * wscale, s[5 * 33] * wscale, w1, false); w1 = __builtin_amdgcn_cvt_pk_fp8_f32(s[6 * 33] * wscale, s[7 * 33] * wscale, w1, true);
            *(u32x2*)((unsigned char*)WT + (size_t)(drow0 + n) * K + k0 + 8 * c) = (u32x2){w0, w1};
        } else {
        u32x4 o; o.x = cvt_pk_bf16(s[0 * 33], s[1 * 33]); o.y = cvt_pk_bf16(s[2 * 33], s[3 * 33]); o.z = cvt_pk_bf16(s[4 * 33], s[5 * 33]); o.w = cvt_pk_bf16(s[6 * 33], s[7 * 33]);
        *(u32x4*)(WT + (size_t)(drow0 + n) * K + k0 + 8 * c) = o; } }
    asm volatile("s_waitcnt lgkmcnt(0)" ::: "memory");
}
template <int MODE, bool FP8 = false>
__device__ __forceinline__ void transpose_mat(const float* W, int K, int N, int NP, int F, bf16_t* WT, int it, LAS float* scr, int lane, float wscale = 1.f) {
    const int nblk = NP / 32, kb = it / nblk, nb = it % nblk, n0 = nb * 32;
    int drow0 = n0;
    if (MODE == 1) { const int up = n0 >= F, j = up ? n0 - F : n0; drow0 = (j >> 7) * 256 + (up ? 128 : 0) + (j & 127); }
    transpose_item<FP8>(W, K, N, WT, kb * 64, n0, drow0, scr, lane, wscale);
}
__device__ __forceinline__ void phase_convert_fgu(const Params& p, LAS unsigned char* lds) {
    const int tid = opaque_tid(), lane = tid & 63, wave = tid >> 6;
    LAS float* scr = (LAS float*)(lds + wave * 16384);
    const int gw = blockIdx.x * NWAVE + wave, NGW = gridDim.x * NWAVE;
    const float* FGMAX = (const float*)(p.ws + WS_FGMAX); unsigned char* WT = p.ws + WO_FGU;
    for (int it = gw; it < 16 * 176; it += NGW) {
        const int kb = it / 176, nb = it % 176, n0 = nb * 32, k0 = kb * 64;
        const int up = n0 >= FF, j0 = up ? n0 - FF : n0, drow0 = (j0 >> 7) * 256 + (up ? 128 : 0) + (j0 & 127);
        float wv[32];
#pragma unroll
        for (int i = 0; i < 32; ++i) wv[i] = p.ffn_gu[(size_t)(k0 + 2 * i + (lane >> 5)) * (2 * FF) + n0 + (lane & 31)];
#pragma unroll
        for (int i = 0; i < 32; ++i) scr[(2 * i + (lane >> 5)) * 33 + (lane & 31)] = wv[i];
        asm volatile("s_waitcnt lgkmcnt(0)" ::: "memory");
        const int c = lane & 7;
#pragma unroll
        for (int j = 0; j < 4; ++j) { const int n = (lane >> 3) + 8 * j; const LAS float* sp = scr + (8 * c) * 33 + n; const float sc = 127.f / FGMAX[n0 + n];
            const unsigned w0 = pack_i8x4(sp[0 * 33] * sc, sp[1 * 33] * sc, sp[2 * 33] * sc, sp[3 * 33] * sc), w1 = pack_i8x4(sp[4 * 33] * sc, sp[5 * 33] * sc, sp[6 * 33] * sc, sp[7 * 33] * sc);
            *(u32x2*)(WT + (size_t)(drow0 + n) * D + k0 + 8 * c) = (u32x2){w0, w1}; }
        asm volatile("s_waitcnt lgkmcnt(0)" ::: "memory");
    }
}
__device__ __forceinline__ void phase_weights(const Params& p, LAS unsigned char* lds) {
    const int tid = opaque_tid(), lane = tid & 63, wave = tid >> 6;
    LAS float* scr = (LAS float*)(lds + wave * 16384);
    const int gw = blockIdx.x * NWAVE + wave, NGW = gridDim.x * NWAVE;
    unsigned char* ws = p.ws;
    constexpr int I_POOL = 4 * 8, I_FGU = 16 * 176, I_FDN = 44 * 32, I_KV = 16 * 48, I_Q = 16 * 40, I_O = 16 * 32, I_C = 32 * 8, I_EGU = 16 * 224, I_EDN = 56 * 32;
    constexpr int TOT = 4 * I_POOL + I_FGU + I_FDN + I_KV + I_Q + I_O + 2 * I_C + NE * I_EGU + NE * I_EDN;
    for (int it = gw; it < TOT; it += NGW) {
        int r = it;
        if (r < 4 * I_POOL) { const int g = r / I_POOL; transpose_mat<0>(p.pool_w + (size_t)g * 65536, 256, 256, 256, 0, (bf16_t*)(ws + WO_POOL) + (size_t)g * 65536, r % I_POOL, scr, lane); continue; } r -= 4 * I_POOL;
        if (r < I_FGU) continue; r -= I_FGU;
        if (r < I_FDN) { transpose_mat<0>(p.ffn_dn, FF, D, D, 0, (bf16_t*)(ws + WO_FDN), r, scr, lane); continue; } r -= I_FDN;
        if (r < I_KV) { transpose_mat<0>(p.kv_w, D, NKV, NKV, 0, (bf16_t*)(ws + WO_KV), r, scr, lane); continue; } r -= I_KV;
        if (r < I_Q) { transpose_mat<0>(p.q_w, D, NQ, NQP, 0, (bf16_t*)(ws + WO_Q), r, scr, lane); continue; } r -= I_Q;
        if (r < I_O) { transpose_mat<0>(p.o_w, D, D, D, 0, (bf16_t*)(ws + WO_O), r, scr, lane); continue; } r -= I_O;
        if (r < I_C) { transpose_mat<0>(p.cmp_k_w1, 2048, 256, 256, 0, (bf16_t*)(ws + WO_CK), r, scr, lane); continue; } r -= I_C;
        if (r < I_C) { transpose_mat<0>(p.cmp_v_w1, 2048, 256, 256, 0, (bf16_t*)(ws + WO_CV), r, scr, lane); continue; } r -= I_C;
        if (r < NE * I_EGU) { const int e = r / I_EGU; transpose_mat<1, true>(p.exp_gu + (size_t)e * D * 2 * FE, D, 2 * FE, 2 * FE, FE, (bf16_t*)(ws + WO_EGU + (size_t)e * 2 * FE * D), r % I_EGU, scr, lane, 32.f); continue; } r -= NE * I_EGU;
        { const int e = r / I_EDN; transpose_mat<0, true>(p.exp_dn + (size_t)e * FE * D, FE, D, D, 0, (bf16_t*)(ws + WO_EDN + (size_t)e * D * FE), r % I_EDN, scr, lane, 64.f); }
    }
}

__device__ __forceinline__ void phase_modvec(const Params& p, LAS unsigned char* lds) {
    const int tid = opaque_tid(), lane = tid & 63, wave = tid >> 6;
    LAS float* part = (LAS float*)lds;
    LAS float* sc_l = (LAS float*)(lds + 8192);
    for (int i = tid; i < 4 * D; i += NTHR) sc_l[i] = silu_f(p.c[i]);
    __syncthreads();
    float* MODV = (float*)(p.ws + WS_MODV);
    float* CMPB = (float*)(p.ws + WS_CMPB);
    { float* FGMAX = (float*)(p.ws + WS_FGMAX);
      for (int u = blockIdx.x; u < 2 * FF / 64; u += gridDim.x) {
        const int col = u * 64 + lane; float m = 0.f;
#pragma unroll 16
        for (int k = wave * 128; k < wave * 128 + 128; ++k) m = fmaxf(m, fabsf(p.ffn_gu[(size_t)k * (2 * FF) + col]));
        part[wave * 64 + lane] = m;
        __syncthreads();
        if (tid < 64) { float mm = part[lane];
#pragma unroll
            for (int w = 1; w < 8; ++w) mm = fmaxf(mm, part[w * 64 + lane]);
            FGMAX[u * 64 + lane] = fmaxf(mm, 1e-30f); }
        __syncthreads();
      } }
    constexpr int NU_MOD = 14336 / 64, NU = NU_MOD + 8;
    for (int u = blockIdx.x; u < NU; u += gridDim.x) {
        float acc[4] = {0.f, 0.f, 0.f, 0.f};
        if (u < NU_MOD) {
            const int gc = u * 64 + lane;
            const float* W; int ldw, col;
            if (gc < 6144) { W = p.ada_w; ldw = 6144; col = gc; } else if (gc < 12288) { W = p.ada_w + (size_t)D * 6144; ldw = 6144; col = gc - 6144; } else { W = p.kv_ada_w; ldw = 2048; col = gc - 12288; }
#pragma unroll 16
            for (int k = wave * 128; k < wave * 128 + 128; ++k) {
                const float w = W[(size_t)k * ldw + col];
#pragma unroll
                for (int b = 0; b < 4; ++b) acc[b] += sc_l[b * D + k] * w;
            }
        } else {
            const int cu = u - NU_MOD, kv = cu >> 2, col = (cu & 3) * 64 + lane;
            const float* W = kv ? p.cmp_v_w1 : p.cmp_k_w1; const float* pe = kv ? p.cmp_pe_v : p.cmp_pe_k;
#pragma unroll 16
            for (int k = wave * 256; k < wave * 256 + 256; ++k) acc[0] += pe[k] * W[(size_t)k * 256 + col];
        }
#pragma unroll
        for (int b = 0; b < 4; ++b) part[(wave * 4 + b) * 64 + lane] = acc[b];
        __syncthreads();
        if (tid < 256) {
            const int b = tid >> 6; float s = 0.f;
#pragma unroll
            for (int w = 0; w < 8; ++w) s += part[(w * 4 + b) * 64 + lane];
            if (u < NU_MOD) {
                const int gc = u * 64 + lane; int which, n; float bias;
                if (gc < 6144) { which = gc >> 10; n = gc & 1023; bias = p.ada_b[gc]; } else if (gc < 12288) { which = 6 + ((gc - 6144) >> 10); n = gc & 1023; bias = p.ada_b[gc]; }
                else { which = 12 + ((gc - 12288) >> 10); n = gc & 1023; bias = p.kv_ada_b[gc - 12288]; }
                MODV[(which * 4 + b) * D + n] = s + bias;
            } else if (b == 0) { const int cu = u - NU_MOD; CMPB[(cu >> 2) * 256 + (cu & 3) * 64 + lane] = s; }
        }
        __syncthreads();
    }
}

template <int W>
__device__ __forceinline__ void pool_rows(const float* xb, int t0, const LAS float* rs, f32x2 gm, f32x2 sh, bf16_t* outb, int c0) {
    f32x2 ring[16];
#pragma unroll
    for (int i = 0; i < 15; ++i) {
        const int t = t0 - 15 + i; f32x2 h = {0.f, 0.f};
        if (t >= 0) { const f32x2 xv = *(const f32x2*)(xb + (size_t)t * D + c0); const float r = rs[i]; h = xv * r * gm + sh; }
        ring[i] = h;
    }
    for (int gi = 0; gi < 8; ++gi) {
#pragma unroll
        for (int j = 0; j < 16; ++j) {
            const int i = 15 + gi * 16 + j, t = t0 + gi * 16 + j;
            const f32x2 xv = *(const f32x2*)(xb + (size_t)t * D + c0); const float r = rs[i];
            const f32x2 h = xv * r * gm + sh;
            ring[(15 + j) & 15] = h;
            f32x2 s = {0.f, 0.f};
#pragma unroll
            for (int k = 0; k < W; ++k) s += ring[(15 + j - k) & 15];
            const int cnt = (t + 1 < W) ? t + 1 : W;
            const f32x2 o = s * (1.f / (float)cnt) - h;
            *(unsigned*)(outb + (size_t)t * D + c0) = cvt_pk_bf16(o.x, o.y);
        }
    }
}
__device__ __forceinline__ void phase_poolmix(const Params& p, LAS unsigned char* lds, bf16_t* mixA) {
    const int tid = opaque_tid(), lane = tid & 63, wave = tid >> 6;
    LAS float* rs = (LAS float*)lds;
    const float* MODV = (const float*)(p.ws + WS_MODV);
    for (int u = blockIdx.x; u < T / 128; u += gridDim.x) {
        const int b = u >> 6, t0 = (u & 63) * 128;
        const float* xb = p.x + (size_t)b * S * D;
        for (int i = wave; i < 143; i += NWAVE) {
            const int t = t0 - 15 + i; float r = 0.f;
            if (t >= 0) { const f32x4* xr = (const f32x4*)(xb + (size_t)t * D) + lane; float s = 0.f;
#pragma unroll
                for (int j = 0; j < 4; ++j) { const f32x4 v = xr[64 * j]; s += (v.x * v.x + v.y * v.y) + (v.z * v.z + v.w * v.w); }
                r = 1.f / sqrtf(wave_sum(s) * (1.f / D) + EPS); }
            if (lane == 0) rs[i] = r;
        }
        __syncthreads();
        const int c0 = 2 * tid;
        const f32x2 g = *(const f32x2*)(p.norm_g + c0), sc = *(const f32x2*)(MODV + (1 * 4 + b) * D + c0), sh = *(const f32x2*)(MODV + (0 * 4 + b) * D + c0);
        const f32x2 gm = g * (sc + 1.f);
        bf16_t* ob = mixA + (size_t)b * S * D;
        const int grp = tid >> 7;
        if (grp == 0) pool_rows<2>(xb, t0, rs, gm, sh, ob, c0);
        else if (grp == 1) pool_rows<4>(xb, t0, rs, gm, sh, ob, c0);
        else if (grp == 2) pool_rows<8>(xb, t0, rs, gm, sh, ob, c0);
        else pool_rows<16>(xb, t0, rs, gm, sh, ob, c0);
        __syncthreads();
    }
}

struct NormOut { const float* g; const float* sc; const float* sh; bf16_t* out; };
template <int NOUT, bool ROUTER, int OUTQ = 0>
__device__ __forceinline__ void phase_norm(const Params& p, LAS unsigned char* lds, const float* xin, const NormOut o0, const NormOut o1) {
    const int tid = opaque_tid(), lane = tid & 63, wave = tid >> 6;
    const int gw = blockIdx.x * NWAVE + wave, NGW = gridDim.x * NWAVE;
    f32x4 rwa[16], rwb[16];
    if (ROUTER) {
#pragma unroll
        for (int j = 0; j < 4; ++j)
#pragma unroll
            for (int q = 0; q < 4; ++q) { const f32x4* wp = (const f32x4*)(p.router_w + (size_t)(4 * lane + 256 * j + q) * NE); rwa[4 * j + q] = wp[0]; rwb[4 * j + q] = wp[1]; }
    }
    unsigned* ctl = (unsigned*)(p.ws + WS_CTL);
    int* TOPE = (int*)(p.ws + WS_TOPE); float* TOPW = (float*)(p.ws + WS_TOPW);
    unsigned cnt_local[NE];
#pragma unroll
    for (int e = 0; e < NE; ++e) cnt_local[e] = 0;
    const int rows_per = T / NGW > 0 ? (T + NGW - 1) / NGW : 1;
    const int r0 = gw * rows_per, r1 = (r0 + rows_per < T) ? r0 + rows_per : T;
    int curb = -1; f32x4 gm0[4], sh0[4], gm1[4], sh1[4];
    for (int r = r0; r < r1; ++r) {
        const int b = r >> 13;
        if (b != curb) { curb = b;
#pragma unroll
            for (int j = 0; j < 4; ++j) { const int c = 4 * lane + 256 * j;
                gm0[j] = *(const f32x4*)(o0.g + c) * (*(const f32x4*)(o0.sc + b * D + c) + 1.f); sh0[j] = *(const f32x4*)(o0.sh + b * D + c);
                if (NOUT > 1) { gm1[j] = *(const f32x4*)(o1.g + c) * (*(const f32x4*)(o1.sc + b * D + c) + 1.f); sh1[j] = *(const f32x4*)(o1.sh + b * D + c); } } }
        const f32x4* xr = (const f32x4*)(xin + (size_t)r * D) + lane;
        f32x4 v[4]; float s = 0.f;
#pragma unroll
        for (int j = 0; j < 4; ++j) { v[j] = xr[64 * j]; s += (v[j].x * v[j].x + v[j].y * v[j].y) + (v[j].z * v[j].z + v[j].w * v[j].w); }
        const float rstd = 1.f / sqrtf(wave_sum(s) * (1.f / D) + EPS);
        float lg[NE];
#pragma unroll
        for (int e = 0; e < NE; ++e) lg[e] = 0.f;
        float qsc = 1.f;
        if constexpr (OUTQ == 2) { float mx = 0.f;
#pragma unroll
            for (int j = 0; j < 4; ++j) { const f32x4 h = v[j] * rstd * gm0[j] + sh0[j]; mx = fmaxf(mx, fmaxf(fmaxf(fabsf(h.x), fabsf(h.y)), fmaxf(fabsf(h.z), fabsf(h.w)))); }
            mx = fmaxf(wave_max(mx), 1e-30f); qsc = 127.f / mx;
            if (lane == 0) ((float*)(p.ws + WS_ASC))[r] = mx * (1.f / 127.f); }
#pragma unroll
        for (int j = 0; j < 4; ++j) {
            const f32x4 h = v[j] * rstd * gm0[j] + sh0[j];
            if constexpr (OUTQ == 2) { *(unsigned*)((unsigned char*)o0.out + (size_t)r * D + 4 * lane + 256 * j) = pack_i8x4(h.x * qsc, h.y * qsc, h.z * qsc, h.w * qsc); }
            else if constexpr (OUTQ == 1) { unsigned w8 = 0u; w8 = __builtin_amdgcn_cvt_pk_fp8_f32(h.x, h.y, w8, false); w8 = __builtin_amdgcn_cvt_pk_fp8_f32(h.z, h.w, w8, true);
                *(unsigned*)((unsigned char*)o0.out + (size_t)r * D + 4 * lane + 256 * j) = w8; }
            else { u32x2 w; w.x = cvt_pk_bf16(h.x, h.y); w.y = cvt_pk_bf16(h.z, h.w);
            *(u32x2*)(o0.out + (size_t)r * D + 4 * lane + 256 * j) = w; }
            if (NOUT > 1) { const f32x4 h1 = v[j] * rstd * gm1[j] + sh1[j]; u32x2 w1; w1.x = cvt_pk_bf16(h1.x, h1.y); w1.y = cvt_pk_bf16(h1.z, h1.w);
                *(u32x2*)(o1.out + (size_t)r * D + 4 * lane + 256 * j) = w1; }
            if (ROUTER) {
#pragma unroll
                for (int q = 0; q < 4; ++q) { const f32x4 a = rwa[4 * j + q], c2 = rwb[4 * j + q]; const float hv = h[q];
                    lg[0] += hv * a.x; lg[1] += hv * a.y; lg[2] += hv * a.z; lg[3] += hv * a.w; lg[4] += hv * c2.x; lg[5] += hv * c2.y; lg[6] += hv * c2.z; lg[7] += hv * c2.w; }
            }
        }
        if (ROUTER) {
            {
                const bool u5 = lane & 32, u4 = lane & 16, u3 = lane & 8; float a4[4], a2[2], a1;
#pragma unroll
                for (int i = 0; i < 4; ++i) a4[i] = (u5 ? lg[4 + i] : lg[i]) + __shfl_xor(u5 ? lg[i] : lg[4 + i], 32);
#pragma unroll
                for (int i = 0; i < 2; ++i) a2[i] = (u4 ? a4[2 + i] : a4[i]) + __shfl_xor(u4 ? a4[i] : a4[2 + i], 16);
                a1 = (u3 ? a2[1] : a2[0]) + __shfl_xor(u3 ? a2[0] : a2[1], 8);
                a1 += __shfl_xor(a1, 4); a1 += __shfl_xor(a1, 2); a1 += __shfl_xor(a1, 1);
#pragma unroll
                for (int e = 0; e < NE; ++e) lg[e] = readlane_f(a1, 8 * e) + p.router_b[e];
            }
            int e0 = 0; float v0 = lg[0];
#pragma unroll
            for (int e = 1; e < NE; ++e) if (lg[e] > v0) { v0 = lg[e]; e0 = e; }
            int e1 = -1; float v1 = -3.0e38f;
#pragma unroll
            for (int e = 0; e < NE; ++e) if (e != e0 && lg[e] > v1) { v1 = lg[e]; e1 = e; }
            const float ex = __expf(v1 - v0), w0 = 1.f / (1.f + ex), w1 = ex / (1.f + ex);
            if (lane == 0) { TOPE[2 * r] = e0; TOPE[2 * r + 1] = e1; TOPW[2 * r] = w0; TOPW[2 * r + 1] = w1; }
#pragma unroll
            for (int e = 0; e < NE; ++e) cnt_local[e] += (e == e0) + (e == e1);
        }
    }
    if (ROUTER) {
        LAS unsigned* lc = (LAS unsigned*)lds;
        if (tid < NE) lc[tid] = 0u;
        __syncthreads();
        if (lane == 0) {
#pragma unroll
            for (int e = 0; e < NE; ++e) if (cnt_local[e]) atomicAdd((unsigned*)(lc + e), cnt_local[e]);
        }
        __syncthreads();
        if (tid < NE && lc[tid]) atomicAdd(ctl + CW_CNT + 64 * tid, lc[tid]);
    }
}

struct GemmArgs { const bf16_t* A; const bf16_t* Bt; int M, N, K; long lda, ldb; };
template <class Epi, int AMODE, bool PAIR>
__device__ __forceinline__ void gemm_simple(const GemmArgs g, const Epi& E, const int* tok, const int* pst, size_t bstride) {
    const int tid = opaque_tid(), lane = tid & 63, wid = tid >> 6, wr = wid >> 2, wc = wid & 3, fr = lane & 15, fq = lane >> 4;
    const int ntn = g.N / 256, ntm = g.M / 128, ntiles = ntm * ntn;
    for (int tile = blockIdx.x; tile < ntiles; tile += gridDim.x) {
        const int tm = tile / ntn, tn = tile % ntn, m0 = tm * 128, n0 = tn * 256;
        const bf16_t* Bt = g.Bt;
        if (pst) { if (m0 >= pst[NE]) continue; int e = 0;
#pragma unroll
            for (int q = 1; q < NE; ++q) e += (m0 >= pst[q]); Bt += (size_t)e * bstride; }
        const bf16_t* ap[4]; const bf16_t* bp[4];
#pragma unroll
        for (int m = 0; m < 4; ++m) { const int r = m0 + wr * 64 + 16 * m + fr; const long rr = (AMODE == 1) ? (long)tok[r] : (long)r; ap[m] = g.A + rr * g.lda + 8 * fq; }
#pragma unroll
        for (int n = 0; n < 4; ++n) { const int c = n0 + (n >> 1) * 128 + wc * 32 + (n & 1) * 16 + fr; bp[n] = Bt + (long)c * g.ldb + 8 * fq; }
        f32x4 acc[4][4];
#pragma unroll
        for (int m = 0; m < 4; ++m)
#pragma unroll
            for (int n = 0; n < 4; ++n) acc[m][n] = (f32x4){0.f, 0.f, 0.f, 0.f};
        for (int k0 = 0; k0 < g.K; k0 += 32) {
            const long ka = (AMODE == 2) ? (long)(k0 >> 6) * NKV + (k0 & 63) : (long)k0;
            bf16x8 a[4], b[4];
#pragma unroll
            for (int m = 0; m < 4; ++m) a[m] = *(const bf16x8*)(ap[m] + ka);
#pragma unroll
            for (int n = 0; n < 4; ++n) b[n] = *(const bf16x8*)(bp[n] + k0);
#pragma unroll
            for (int m = 0; m < 4; ++m)
#pragma unroll
                for (int n = 0; n < 4; ++n) acc[m][n] = __builtin_amdgcn_mfma_f32_16x16x32_bf16(b[n], a[m], acc[m][n], 0, 0, 0);
        }
#pragma unroll
        for (int m = 0; m < 4; ++m) {
            const int row = m0 + wr * 64 + 16 * m + fr;
            if constexpr (PAIR) {
#pragma unroll
                for (int n = 0; n < 2; ++n) E.pair(row, tn * 128 + wc * 32 + n * 16 + 4 * fq, acc[m][n], acc[m][n + 2]);
            } else {
#pragma unroll
                for (int n = 0; n < 4; ++n) E(row, n0 + (n >> 1) * 128 + wc * 32 + (n & 1) * 16 + 4 * fq, acc[m][n]);
            }
        }
    }
}
struct EpiPool {
    const float* x; float* x1; const float* g1; const float* scale; int coff;
    __device__ __forceinline__ void operator()(int row, int col, f32x4 v) const { const int c = coff + col, b = row >> 13;
        const f32x4 xv = *(const f32x4*)(x + (size_t)row * D + c), gv = *(const f32x4*)(g1 + b * D + c), sv = *(const f32x4*)(scale + c);
        *(f32x4*)(x1 + (size_t)row * D + c) = xv + gv * (v * sv); }
};
struct EpiSwiglu {
    bf16_t* hid; int ldh;
    __device__ __forceinline__ void pair(int row, int hc, f32x4 gt, f32x4 up) const {
        u32x2 w; w.x = cvt_pk_bf16(silu_f(gt.x) * up.x, silu_f(gt.y) * up.y); w.y = cvt_pk_bf16(silu_f(gt.z) * up.z, silu_f(gt.w) * up.w);
        *(u32x2*)(hid + (size_t)row * ldh + hc) = w; }
};
struct EpiSwigluI8 {
    bf16_t* hid; int ldh; const float* asc; const float* wmax;
    __device__ __forceinline__ void pair(int row, int hc, f32x4 gt, f32x4 up) const {
        typedef int i32x4e __attribute__((ext_vector_type(4)));
        const i32x4e gi = __builtin_bit_cast(i32x4e, gt), ui = __builtin_bit_cast(i32x4e, up);
        const float ra = asc[row] * (1.f / 127.f); const f32x4 wg = *(const f32x4*)(wmax + hc) * ra, wu = *(const f32x4*)(wmax + FF + hc) * ra;
        const float g0 = (float)gi.x * wg.x, g1 = (float)gi.y * wg.y, g2 = (float)gi.z * wg.z, g3 = (float)gi.w * wg.w;
        u32x2 w; w.x = cvt_pk_bf16(silu_f(g0) * ((float)ui.x * wu.x), silu_f(g1) * ((float)ui.y * wu.y)); w.y = cvt_pk_bf16(silu_f(g2) * ((float)ui.z * wu.z), silu_f(g3) * ((float)ui.w * wu.w));
        *(u32x2*)(hid + (size_t)row * ldh + hc) = w; }
};
struct EpiSwiglu8 {
    unsigned char* hid; int ldh;
    __device__ __forceinline__ void pair(int row, int hc, f32x4 gt, f32x4 up) const {
        unsigned w = 0u; w = __builtin_amdgcn_cvt_pk_fp8_f32(silu_f(gt.x) * up.x, silu_f(gt.y) * up.y, w, false); w = __builtin_amdgcn_cvt_pk_fp8_f32(silu_f(gt.z) * up.z, silu_f(gt.w) * up.w, w, true);
        *(unsigned*)(hid + (size_t)row * ldh + hc) = w; }
};
struct EpiResid {
    const float* xin; float* out; const float* gate;
    __device__ __forceinline__ void operator()(int row, int col, f32x4 v) const { const int b = row >> 13;
        const f32x4 xv = *(const f32x4*)(xin + (size_t)row * D + col), gv = *(const f32x4*)(gate + b * D + col);
        *(f32x4*)(out + (size_t)row * D + col) = xv + gv * v; }
};
struct EpiBf16 {
    bf16_t* o; int ldo;
    __device__ __forceinline__ void operator()(int row, int col, f32x4 v) const { u32x2 w; w.x = cvt_pk_bf16(v.x, v.y); w.y = cvt_pk_bf16(v.z, v.w); *(u32x2*)(o + (size_t)row * ldo + col) = w; }
};
struct EpiQ {
    bf16_t* q; float* gates; int coff;
    __device__ __forceinline__ void operator()(int row, int col_, f32x4 v) const { const int col = col_ + coff;
        if (col < D) { u32x2 w; w.x = cvt_pk_bf16(v.x, v.y); w.y = cvt_pk_bf16(v.z, v.w); *(u32x2*)(q + (size_t)row * D + col) = w; }
        else if (col < NQ) { f32x4 s; s.x = sigmoid_f(v.x); s.y = sigmoid_f(v.y); s.z = sigmoid_f(v.z); s.w = sigmoid_f(v.w); *(f32x4*)(gates + (size_t)row * 48 + (col - D)) = s; } }
};
struct EpiCmp {
    bf16_t* o; const float* bias;
    __device__ __forceinline__ void operator()(int row, int col, f32x4 v) const { const int z = col >> 8, c = col & 255; const f32x4 bv = *(const f32x4*)(bias + (z >> 2) * 256 + c);
        u32x2 w; w.x = cvt_pk_bf16(gelu_tanh_f(v.x + bv.x), gelu_tanh_f(v.y + bv.y)); w.y = cvt_pk_bf16(gelu_tanh_f(v.z + bv.z), gelu_tanh_f(v.w + bv.w));
        *(u32x2*)(o + ((size_t)z * 2048 + row) * 256 + c) = w; }
};


namespace pg8 {
#define PG8_LAS __attribute__((address_space(3)))
constexpr int BM = 256, BK = 64, HALF = 128, HTB = HALF * BK * 2, STAGE_BYTES = 8 * HTB, NXCD = 8, WGM = 8;
__host__ __device__ __forceinline__ int lds_byte(int r, int c) { const int st = (r >> 4) * 2 + (c >> 5), rr = r & 15, cc = c & 31, ob = rr * 64 + cc * 2; return st * 1024 + (ob ^ (((ob >> 9) & 1) << 5)); }
__host__ __device__ __forceinline__ void stage_rc(int b, int& R, int& C) { const int st = b / 1024, sb = b % 1024, swz = sb ^ (((sb >> 9) & 1) << 5); R = (st >> 1) * 16 + swz / 64; C = (st & 1) * 32 + (swz % 64) / 2; }
__host__ __device__ __forceinline__ int perm32(int rho) { const int n = rho >> 4, i = rho & 15; return 8 * (i >> 2) + 4 * n + (i & 3); }
struct Unit { int pm, pn; };
template <int SMODE> struct Sched {
    int nM, nN, nwg, G, c; const char* A; const char* Bt; size_t lda2, ldb2; const int* pst; size_t bstride2;
    __device__ __forceinline__ void init(int M, int N, int G_, int c_, const void* A_, const void* Bt_, int lda, int ldb, const int* pst_ = nullptr, size_t bstride = 0) {
        nM = M / BM; nN = N / BM; nwg = nM * nN; G = G_; c = c_; A = (const char*)A_; Bt = (const char*)Bt_; lda2 = (size_t)lda * 2; ldb2 = (size_t)ldb * 2; pst = pst_; bstride2 = bstride * 2; }
    __device__ __forceinline__ bool next(int i, Unit& u) const {
        if (c < 0) return false;
        const long L = (long)i * G + c; if (L >= nwg) return false;
        int wgid = (int)L; { const int q = nwg / NXCD, r = nwg % NXCD, xcd = wgid % NXCD, off = wgid / NXCD; wgid = (xcd < r ? xcd * (q + 1) : r * (q + 1) + (xcd - r) * q) + off; }
        const int nig = WGM * nN, gid = wgid / nig, fm = gid * WGM, gsz = (nM - fm) < WGM ? (nM - fm) : WGM;
        u.pm = fm + ((wgid % nig) % gsz); u.pn = (wgid % nig) / gsz; return true;
    }
    __device__ __forceinline__ const char* a_ptr(const Unit& u) const {
        if (SMODE == 1) return A + (size_t)u.pm * BM * lda2 + (size_t)u.pn * 512;
        if (SMODE == 2) return A + (size_t)u.pm * BM * lda2 + (size_t)((u.pn >> 2) * 256 + (u.pn & 3) * 64) * 2;
        return A + (size_t)u.pm * BM * lda2; }
    __device__ __forceinline__ const char* b_ptr(const Unit& u) const {
        if (SMODE == 2) return Bt + (size_t)(u.pn >> 2) * BM * ldb2;
        if (SMODE == 3) { const int m0 = u.pm * BM; int e = 0;
#pragma unroll
            for (int q = 1; q < NE; ++q) e += (m0 >= pst[q]); return Bt + (size_t)e * bstride2 + (size_t)u.pn * BM * ldb2; }
        return Bt + (size_t)u.pn * BM * ldb2; }
};
template <class F> struct EpiEl { static constexpr bool PERM = false, AFTER_DRAIN = false; F f;
    __device__ __forceinline__ void operator()(const f32x4 (&acc)[2][2][4][2], const Unit& u, int wr, int wc, int fr, int fq) const {
#pragma unroll
        for (int ai = 0; ai < 2; ++ai)
#pragma unroll
            for (int m = 0; m < 4; ++m) { const int row = u.pm * BM + ai * HALF + wr * 64 + m * 16 + fr;
#pragma unroll
                for (int bj = 0; bj < 2; ++bj)
#pragma unroll
                    for (int n = 0; n < 2; ++n) f(row, u.pn * BM + bj * HALF + wc * 32 + n * 16 + 4 * fq, acc[ai][bj][m][n]); } } };
template <class F> struct EpiPairEl { static constexpr bool PERM = false, AFTER_DRAIN = false; F f;
    __device__ __forceinline__ void operator()(const f32x4 (&acc)[2][2][4][2], const Unit& u, int wr, int wc, int fr, int fq) const {
#pragma unroll
        for (int ai = 0; ai < 2; ++ai)
#pragma unroll
            for (int m = 0; m < 4; ++m) { const int row = u.pm * BM + ai * HALF + wr * 64 + m * 16 + fr;
#pragma unroll
                for (int n = 0; n < 2; ++n) f.pair(row, u.pn * HALF + wc * 32 + n * 16 + 4 * fq, acc[ai][0][m][n], acc[ai][1][m][n]); } } };

typedef int i32x8 __attribute__((ext_vector_type(8)));
template <int QM> __device__ __forceinline__ void mma_block(f32x4 (&acc)[4][2], const bf16x8 (&At)[4][2], const bf16x8 (&Bt)[2][2], const int wsc) {
    __builtin_amdgcn_s_setprio(1);
    if constexpr (QM == 2) {
        typedef int i32x4m __attribute__((ext_vector_type(4)));
#pragma unroll
        for (int m = 0; m < 4; ++m)
#pragma unroll
            for (int n = 0; n < 2; ++n)
#pragma unroll
                for (int k = 0; k < 2; ++k) acc[m][n] = __builtin_bit_cast(f32x4, __builtin_amdgcn_mfma_i32_16x16x64_i8(__builtin_bit_cast(i32x4m, Bt[n][k]), __builtin_bit_cast(i32x4m, At[m][k]), __builtin_bit_cast(i32x4m, acc[m][n]), 0, 0, 0));
#pragma unroll
        for (int m = 0; m < 4; ++m) asm volatile("" : "+v"(acc[m][0]), "+v"(acc[m][1]));
    } else if constexpr (QM == 1) {
#pragma unroll
        for (int m = 0; m < 4; ++m) { const u32x4 a0 = __builtin_bit_cast(u32x4, At[m][0]), a1 = __builtin_bit_cast(u32x4, At[m][1]);
            const i32x8 a8 = {(int)a0.x, (int)a0.y, (int)a0.z, (int)a0.w, (int)a1.x, (int)a1.y, (int)a1.z, (int)a1.w};
#pragma unroll
            for (int n = 0; n < 2; ++n) { const u32x4 b0 = __builtin_bit_cast(u32x4, Bt[n][0]), b1 = __builtin_bit_cast(u32x4, Bt[n][1]);
                const i32x8 b8 = {(int)b0.x, (int)b0.y, (int)b0.z, (int)b0.w, (int)b1.x, (int)b1.y, (int)b1.z, (int)b1.w};
                acc[m][n] = __builtin_amdgcn_mfma_scale_f32_16x16x128_f8f6f4(b8, a8, acc[m][n], 0, 0, 0, wsc, 0, 127); } }
#pragma unroll
        for (int m = 0; m < 4; ++m) asm volatile("" : "+v"(acc[m][0]), "+v"(acc[m][1]));
    } else {
#pragma unroll
        for (int m = 0; m < 4; ++m)
#pragma unroll
            for (int n = 0; n < 2; ++n)
#pragma unroll
                for (int k = 0; k < 2; ++k) acc[m][n] = __builtin_amdgcn_mfma_f32_16x16x32_bf16(Bt[n][k], At[m][k], acc[m][n], 0, 0, 0);
    }
    __builtin_amdgcn_s_setprio(0);
}
template <class Epi, class Sched, bool ALIGN_EPI = true, bool SP2 = true, int QM = 0>
__device__ __forceinline__ void gemm_phase(PG8_LAS unsigned char* lds, const int K, const int lda, const int ldb, const size_t kstepA, const Sched& S, const Epi& E, const int wsc = 127) {
    const int tid_ = opaque_tid();
    const int tid = tid_, wid = __builtin_amdgcn_readfirstlane(tid >> 6), lane = tid & 63, wr = wid >> 2, wc = wid & 3, fr = lane & 15, fq = lane >> 4;
    const int nt = K / BK;
    unsigned voffA[2], voffB[2];
#pragma unroll
    for (int i = 0; i < 2; ++i) { int R, C; stage_rc(tid * 16 + i * 8192, R, C); const int Rb = Epi::PERM ? ((R & ~31) + perm32(R & 31)) : R;
        voffA[i] = (unsigned)(R * lda + C) * 2u; voffB[i] = (unsigned)(Rb * ldb + C) * 2u; }
    const size_t kstepB = (size_t)(BK * 2);
    const size_t hstepA = (size_t)HALF * lda * 2, hstepB = (size_t)HALF * ldb * 2;
    const unsigned ldsw = (unsigned)wid * 1024u;
    int aoffk[2], boffk[2];
#pragma unroll
    for (int k = 0; k < 2; ++k) { const int col = (QM == 1) ? ((fq >> 1) * 32 + (fq & 1) * 16 + 8 * k) : (k * 32 + fq * 8); aoffk[k] = lds_byte(wr * 64 + fr, col); boffk[k] = lds_byte(wc * 32 + fr, col); }
#define PG8_SA(b, h) (((b) * 2 + (h)) * HTB)
#define PG8_SB(b, h) ((4 + (b) * 2 + (h)) * HTB)
#define PG8_STAGE(bufoff, gbase, voff) do { _Pragma("unroll") for (int _i = 0; _i < 2; ++_i) \
        __builtin_amdgcn_global_load_lds((const unsigned*)((const char*)(gbase) + (voff)[_i]), (PG8_LAS unsigned*)(lds + (bufoff) + ldsw + _i * 8192), 16, 0, 0); } while (0)
#define PG8_LDA(dst, b, h) do { _Pragma("unroll") for (int m = 0; m < 4; ++m) _Pragma("unroll") for (int k = 0; k < 2; ++k) dst[m][k] = *(const PG8_LAS bf16x8*)(lds + PG8_SA(b, h) + ((QM == 1) ? aoffk[k] : aoffk[0] + k * 1024) + m * 2048); } while (0)
#define PG8_LDB(dst, b, h) do { _Pragma("unroll") for (int n = 0; n < 2; ++n) _Pragma("unroll") for (int k = 0; k < 2; ++k) dst[n][k] = *(const PG8_LAS bf16x8*)(lds + PG8_SB(b, h) + ((QM == 1) ? boffk[k] : boffk[0] + k * 1024) + n * 2048); } while (0)
#define PG8_MMA(ai, bj, At, Bt) mma_block<QM>(acc[ai][bj], At, Bt, wsc)
#define PG8_WAIT_V(n) asm volatile("s_waitcnt vmcnt(" #n ")" ::: "memory")
#define PG8_WAIT_L(n) asm volatile("s_waitcnt lgkmcnt(" #n ")" ::: "memory")
#define PG8_BAR __builtin_amdgcn_s_barrier()
#define PG8_SCHED __builtin_amdgcn_sched_barrier(0)
    Unit cur, nxt; int ui = 0;
    if (!S.next(0, cur)) return;
    f32x4 acc[2][2][4][2];
#pragma unroll
    for (int a = 0; a < 2; ++a)
#pragma unroll
        for (int b = 0; b < 2; ++b)
#pragma unroll
            for (int m = 0; m < 4; ++m)
#pragma unroll
                for (int n = 0; n < 2; ++n) acc[a][b][m][n] = (f32x4){0.f, 0.f, 0.f, 0.f};
    bf16x8 At[4][2], B0[2][2], B1[2][2];
    const char* cA = S.a_ptr(cur); const char* cB = S.b_ptr(cur);
    if constexpr (SP2) {
        PG8_STAGE(PG8_SB(0, 0), cB, voffB); PG8_STAGE(PG8_SB(0, 1), cB + hstepB, voffB); PG8_STAGE(PG8_SA(0, 0), cA, voffA); PG8_STAGE(PG8_SA(0, 1), cA + hstepA, voffA);
        if (wr == 1) PG8_BAR;
        PG8_WAIT_V(2); PG8_BAR;
        PG8_STAGE(PG8_SB(1, 0), cB + kstepB, voffB); PG8_STAGE(PG8_SA(1, 0), cA + kstepA, voffA); PG8_STAGE(PG8_SB(1, 1), cB + hstepB + kstepB, voffB);
        PG8_WAIT_V(6); PG8_BAR;
    } else {
        PG8_STAGE(PG8_SB(0, 0), cB, voffB); PG8_STAGE(PG8_SA(0, 0), cA, voffA); PG8_STAGE(PG8_SB(0, 1), cB + hstepB, voffB); PG8_STAGE(PG8_SA(0, 1), cA + hstepA, voffA);
        if (wr == 1) PG8_BAR;
        PG8_WAIT_V(4); PG8_BAR;
        PG8_STAGE(PG8_SB(1, 0), cB + kstepB, voffB); PG8_STAGE(PG8_SA(1, 0), cA + kstepA, voffA); PG8_STAGE(PG8_SB(1, 1), cB + hstepB + kstepB, voffB);
        PG8_WAIT_V(6); PG8_BAR;
    }
    for (;;) {
        const bool has_next = S.next(ui + 1, nxt);
        const char* nA = has_next ? S.a_ptr(nxt) : cA; const char* nB = has_next ? S.b_ptr(nxt) : cB;
        for (int t = 0; t < nt; t += 2) {
            const bool last = (t == nt - 2);
            const char* a1 = cA + (size_t)(t + 1) * kstepA;
            const char* a2 = last ? nA : cA + (size_t)(t + 2) * kstepA; const char* b2 = last ? nB : cB + (size_t)(t + 2) * kstepB;
            const char* a3 = a2 + kstepA; const char* b3 = b2 + kstepB;
            if constexpr (SP2) {
            PG8_LDB(B0, 0, 0); PG8_LDB(B1, 0, 1); PG8_SCHED; PG8_LDA(At, 0, 0); PG8_STAGE(PG8_SA(1, 1), a1 + hstepA, voffA);
            PG8_WAIT_V(8); PG8_WAIT_L(0); PG8_BAR; PG8_MMA(0, 0, At, B0); PG8_MMA(0, 1, At, B1); PG8_BAR; PG8_SCHED;
            PG8_LDA(At, 0, 1); PG8_STAGE(PG8_SB(0, 0), b2, voffB); PG8_STAGE(PG8_SB(0, 1), b2 + hstepB, voffB); PG8_STAGE(PG8_SA(0, 0), a2, voffA);
            PG8_WAIT_V(8); PG8_WAIT_L(0); PG8_BAR; PG8_MMA(1, 0, At, B0); PG8_MMA(1, 1, At, B1); PG8_BAR; PG8_SCHED;
            PG8_LDB(B0, 1, 0); PG8_LDB(B1, 1, 1); PG8_SCHED; PG8_LDA(At, 1, 0); PG8_STAGE(PG8_SA(0, 1), a2 + hstepA, voffA);
            PG8_WAIT_V(8); PG8_WAIT_L(0); PG8_BAR; PG8_MMA(0, 0, At, B0); PG8_MMA(0, 1, At, B1); PG8_BAR; PG8_SCHED;
            PG8_LDA(At, 1, 1); PG8_STAGE(PG8_SB(1, 0), b3, voffB); PG8_STAGE(PG8_SB(1, 1), b3 + hstepB, voffB); PG8_STAGE(PG8_SA(1, 0), a3, voffA);
            PG8_WAIT_V(8); PG8_WAIT_L(0); PG8_BAR; PG8_MMA(1, 0, At, B0); PG8_MMA(1, 1, At, B1); PG8_BAR; PG8_SCHED;
            } else {
            PG8_LDB(B0, 0, 0); PG8_SCHED; PG8_LDA(At, 0, 0); PG8_STAGE(PG8_SA(1, 1), a1 + hstepA, voffA);
            PG8_WAIT_L(8); PG8_BAR; PG8_WAIT_L(0); PG8_MMA(0, 0, At, B0); PG8_BAR; PG8_SCHED;
            PG8_LDB(B1, 0, 1); PG8_STAGE(PG8_SB(0, 0), b2, voffB);
            PG8_BAR; PG8_WAIT_L(0); PG8_MMA(0, 1, At, B1); PG8_BAR;
            PG8_LDA(At, 0, 1); PG8_STAGE(PG8_SA(0, 0), a2, voffA);
            PG8_BAR; PG8_WAIT_L(0); PG8_MMA(1, 0, At, B0); PG8_BAR; PG8_SCHED;
            PG8_STAGE(PG8_SB(0, 1), b2 + hstepB, voffB);
            PG8_WAIT_V(6); PG8_BAR; PG8_MMA(1, 1, At, B1); PG8_BAR;
            PG8_LDB(B0, 1, 0); PG8_SCHED; PG8_LDA(At, 1, 0); PG8_STAGE(PG8_SA(0, 1), a2 + hstepA, voffA);
            PG8_WAIT_L(8); PG8_BAR; PG8_WAIT_L(0); PG8_MMA(0, 0, At, B0); PG8_BAR; PG8_SCHED;
            PG8_LDB(B1, 1, 1); PG8_STAGE(PG8_SB(1, 0), b3, voffB);
            PG8_BAR; PG8_WAIT_L(0); PG8_MMA(0, 1, At, B1); PG8_BAR;
            PG8_LDA(At, 1, 1); PG8_STAGE(PG8_SA(1, 0), a3, voffA);
            PG8_BAR; PG8_WAIT_L(0); PG8_MMA(1, 0, At, B0); PG8_BAR; PG8_SCHED;
            PG8_STAGE(PG8_SB(1, 1), b3 + hstepB, voffB);
            PG8_WAIT_V(6); PG8_BAR; PG8_MMA(1, 1, At, B1); PG8_BAR;
            }
        }
        if constexpr (ALIGN_EPI) { if (wr == 0) PG8_BAR; }
        if constexpr (!Epi::AFTER_DRAIN) { E(acc, cur, wr, wc, fr, fq); }
        if (!has_next) break;
#pragma unroll
        for (int a = 0; a < 2; ++a)
#pragma unroll
            for (int b = 0; b < 2; ++b)
#pragma unroll
                for (int m = 0; m < 4; ++m)
#pragma unroll
                    for (int n = 0; n < 2; ++n) acc[a][b][m][n] = (f32x4){0.f, 0.f, 0.f, 0.f};
        cur = nxt; cA = nA; cB = nB; ++ui;
        if constexpr (ALIGN_EPI) { if (wr == 1) PG8_BAR; }
    }
    PG8_WAIT_V(0);
    if constexpr (!ALIGN_EPI) { if (wr == 0) PG8_BAR; }
    PG8_BAR;
    if constexpr (Epi::AFTER_DRAIN) { E.fused(acc, cur, wr, wc, fr, fq, lds, wid, lane); }
#undef PG8_SA
#undef PG8_SB
#undef PG8_STAGE
#undef PG8_LDA
#undef PG8_LDB
#undef PG8_MMA
#undef PG8_WAIT_V
#undef PG8_WAIT_L
#undef PG8_BAR
#undef PG8_SCHED
}
}

__device__ __forceinline__ void phase_headnorm(const Params& p, LAS unsigned char* lds) {
    const int tid = opaque_tid(), lane = tid & 63, wave = tid >> 6;
    LAS int* chunk = (LAS int*)(lds + 131072 - 64);
    bf16_t* Q = (bf16_t*)(p.ws + WS_Q); bf16_t* KVB = (bf16_t*)(p.ws + WS_KVB);
    float qg[16], kg[8];
#pragma unroll
    for (int i = 0; i < 16; ++i) qg[i] = p.q_gain[(lane & 3) * 16 + i] * (0.125f * 1.4426950408889634f);
    const float qs8 = sel_q_scale(p.q_gain), ks8 = sel_k_scale(p.k_gain);
    const int kr = lane >> 5;
#pragma unroll
    for (int i = 0; i < 8; ++i) kg[i] = p.k_gain[(1 + kr) * 64 + (lane & 7) * 8 + i];
    for (;;) {
      if (tid == 0) *chunk = (int)atomicAdd((unsigned*)(p.ws + WS_CTL) + CW_HN, 1u);
      __syncthreads();
      const int c0 = *chunk;
      __syncthreads();
      if (c0 >= T / 128) break;
      for (int r = c0 * 128 + wave * 16; r < c0 * 128 + wave * 16 + 16; ++r) {
        {
            u32x4* ptr = (u32x4*)(Q + (size_t)r * D + lane * 16); u32x4 w0 = ptr[0], w1 = ptr[1];
            float v[16]; const unsigned ww[8] = {w0.x, w0.y, w0.z, w0.w, w1.x, w1.y, w1.z, w1.w}; float s = 0.f;
#pragma unroll
            for (int i = 0; i < 8; ++i) { v[2 * i] = bflo(ww[i]); v[2 * i + 1] = bfhi(ww[i]); s += v[2 * i] * v[2 * i] + v[2 * i + 1] * v[2 * i + 1]; }
            s += __shfl_xor(s, 1); s += __shfl_xor(s, 2);
            const float rstd = 1.f / sqrtf(s * (1.f / 64.f) + EPS);
            unsigned o[8];
#pragma unroll
            for (int i = 0; i < 8; ++i) o[i] = cvt_pk_bf16(v[2 * i] * rstd * qg[2 * i], v[2 * i + 1] * rstd * qg[2 * i + 1]);
            ptr[0] = (u32x4){o[0], o[1], o[2], o[3]}; ptr[1] = (u32x4){o[4], o[5], o[6], o[7]};
            float qv[16];
#pragma unroll
            for (int i = 0; i < 16; ++i) qv[i] = v[i] * rstd * qg[i] * qs8;
            *(u32x4*)(p.ws + WS_Q8 + (size_t)r * D + lane * 16) = (u32x4){pack_i8x4(qv[0], qv[1], qv[2], qv[3]), pack_i8x4(qv[4], qv[5], qv[6], qv[7]), pack_i8x4(qv[8], qv[9], qv[10], qv[11]), pack_i8x4(qv[12], qv[13], qv[14], qv[15])};
        }
        {
            const u32x4* ptr = (const u32x4*)(KVB + (size_t)r * NKV + (kr ? 1024 : 512) + (lane & 31) * 8); const u32x4 w0 = ptr[0];
            float v[8]; const unsigned ww[4] = {w0.x, w0.y, w0.z, w0.w}; float s = 0.f;
#pragma unroll
            for (int i = 0; i < 4; ++i) { v[2 * i] = bflo(ww[i]); v[2 * i + 1] = bfhi(ww[i]); s += v[2 * i] * v[2 * i] + v[2 * i + 1] * v[2 * i + 1]; }
            s += __shfl_xor(s, 1); s += __shfl_xor(s, 2); s += __shfl_xor(s, 4);
            const float rstd = 1.f / sqrtf(s * (1.f / 64.f) + EPS);
            unsigned o[4];
#pragma unroll
            for (int i = 0; i < 4; ++i) o[i] = cvt_pk_bf16(v[2 * i] * rstd * kg[2 * i], v[2 * i + 1] * rstd * kg[2 * i + 1]);
            const int b = r >> 13, t = r & (S - 1), hg = (lane & 31) >> 3, c = lane & 7;
            if (kr) {
                bf16_t* dst = (bf16_t*)(p.ws + WS_KWB) + ((size_t)((b * 4 + hg) * 128 + (t >> 6)) * 8 + c) * 512 + (t & 63) * 8;
                *(u32x4*)dst = (u32x4){o[0], o[1], o[2], o[3]};
            } else {
                const float ksc = rstd * ks8;
                const unsigned w0 = pack_i8x4(v[0] * ksc * kg[0], v[1] * ksc * kg[1], v[2] * ksc * kg[2], v[3] * ksc * kg[3]);
                const unsigned w1 = pack_i8x4(v[4] * ksc * kg[4], v[5] * ksc * kg[5], v[6] * ksc * kg[6], v[7] * ksc * kg[7]);
                unsigned char* dst = p.ws + WS_KSB + ((size_t)((b * 4 + hg) * 128 + (t >> 6)) * 4 + (c >> 1)) * 1024 + (t & 63) * 16 + (c & 1) * 8;
                *(u32x2*)dst = (u32x2){w0, w1};
            }
        }
      }
    }
}

__device__ __forceinline__ void phase_cmp2(const Params& p, LAS unsigned char* lds) {
    const int tid = opaque_tid(), lane = tid & 63, wave = tid >> 6;
    const int gw = blockIdx.x * NWAVE + wave, NGW = gridDim.x * NWAVE;
    const bf16_t* CMPH = (const bf16_t*)(p.ws + WS_CMPH);
    LAS float* w2l = (LAS float*)lds;
    for (int kv = 0; kv < 2; ++kv) {
        const float* w2 = kv ? p.cmp_v_w2 : p.cmp_k_w2;
        for (int i = tid; i < 256 * 64 / 4; i += NTHR) ((LAS f32x4*)w2l)[i] = ((const f32x4*)w2)[i];
        __syncthreads();
        for (int it = gw * 2; it < 4 * 2048; it += NGW * 2) {
            float hv[2][4], acc[2] = {0.f, 0.f};
#pragma unroll
            for (int rr = 0; rr < 2; ++rr) { const u32x2 w = *(const u32x2*)(CMPH + (size_t)(kv * 8192 + it + rr) * 256 + 4 * lane); hv[rr][0] = bflo(w.x); hv[rr][1] = bfhi(w.x); hv[rr][2] = bflo(w.y); hv[rr][3] = bfhi(w.y); }
#pragma unroll 4
            for (int kk = 0; kk < 64; ++kk)
#pragma unroll
                for (int c = 0; c < 4; ++c) { const float wv = w2l[(4 * kk + c) * 64 + lane];
                    acc[0] += readlane_f(hv[0][c], kk) * wv; acc[1] += readlane_f(hv[1][c], kk) * wv; }
#pragma unroll
            for (int rr = 0; rr < 2; ++rr) {
                const int row = it + rr, g = (row >> 11) & 3, r2 = row & 2047, b = r2 >> 9, n = r2 & 511; float a = n == NC - 1 ? 0.f : acc[rr];
                if (kv == 0) { const float ss = wave_sum(a * a); a = a * (1.f / sqrtf(ss * (1.f / 64.f) + EPS)) * p.k_gain[lane]; }
                const size_t blk0 = (size_t)((b * 4 + g) * 8 + (n >> 6)) * 4096;
                bf16_t* o = kv ? (bf16_t*)(p.ws + WS_VC) + blk0 + ((n & 63) >> 3) * 512 + lane * 8 + (n & 7)
                               : (bf16_t*)(p.ws + WS_KC) + blk0 + (lane >> 3) * 512 + (n & 63) * 8 + (lane & 7);
                *o = (bf16_t)(cvt_pk_bf16(a, 0.f) & 0xffffu);
            }
        }
        __syncthreads();
    }
}

__device__ __forceinline__ float dot64(const float (&q)[64], const bf16_t* krow) {
    const u32x4* kp = (const u32x4*)krow; float s = 0.f;
#pragma unroll
    for (int i = 0; i < 8; ++i) { const u32x4 w = kp[i];
        s += q[8 * i + 0] * bflo(w.x) + q[8 * i + 1] * bfhi(w.x) + q[8 * i + 2] * bflo(w.y) + q[8 * i + 3] * bfhi(w.y)
           + q[8 * i + 4] * bflo(w.z) + q[8 * i + 5] * bfhi(w.z) + q[8 * i + 6] * bflo(w.w) + q[8 * i + 7] * bfhi(w.w); }
    return s;
}
__device__ __forceinline__ void phase_attn_naive(const Params& p, LAS unsigned char* lds, bf16_t* AO) {
    const int tid = opaque_tid(), lane = tid & 63, wave = tid >> 6, g = wave >> 1;
    LAS float* sc = (LAS float*)lds + wave * 1024;
    LAS float* pc = (LAS float*)(lds + 32768);
    LAS float* hb = (LAS float*)(lds + 65536);
    LAS unsigned char* lut = lds + 65536 + 2048;
    for (int i = tid; i < 512; i += NTHR) hb[i] = p.rel_bias[(i & 31) * NH + (i >> 5)];
    for (int i = tid; i < 1024; i += NTHR) lut[i] = (unsigned char)rel_bucket(i);
    __syncthreads();
    const bf16_t* Q = (const bf16_t*)(p.ws + WS_Q); const bf16_t* KVB = (const bf16_t*)(p.ws + WS_KVB);
    const bf16_t* KC = (const bf16_t*)(p.ws + WS_KC); const bf16_t* VC = (const bf16_t*)(p.ws + WS_VC);
    const float* GATE = (const float*)(p.ws + WS_GATE);
    for (int u = blockIdx.x; u < T; u += gridDim.x) {
        const int b = u >> 13, t = u & (S - 1);
        const int ncv = t >= 31 ? ((t - 31) >> 4) + 1 : 0;
        const bf16_t* kc = KC + (size_t)(b * 4 + g) * NC * 64; const bf16_t* vc = VC + (size_t)(b * 4 + g) * NC * 64;
        float oc[2], os[2], ow[2];
        for (int hh = 0; hh < 2; ++hh) {
            const int head = wave * 2 + hh;
            float q[64];
            { const u32x4* qp = (const u32x4*)(Q + (size_t)u * D + head * 64);
#pragma unroll
                for (int i = 0; i < 8; ++i) { const u32x4 w = qp[i]; q[8 * i] = bflo(w.x); q[8 * i + 1] = bfhi(w.x); q[8 * i + 2] = bflo(w.y); q[8 * i + 3] = bfhi(w.y); q[8 * i + 4] = bflo(w.z); q[8 * i + 5] = bfhi(w.z); q[8 * i + 6] = bflo(w.w); q[8 * i + 7] = bfhi(w.w); }
#pragma unroll
                for (int i = 0; i < 64; ++i) q[i] *= 0.6931471805599453f; }
            float mx = -3.0e38f;
            for (int kk = lane; kk < ncv; kk += 64) { const int dist = t - (16 * kk + 31); const float s = dot64(q, kc + (size_t)kk * 64) + hb[head * 32 + lut[dist < 1023 ? dist : 1023]]; sc[kk] = s; mx = fmaxf(mx, s); }
            mx = wave_max(mx); float sum = 0.f;
            for (int kk = lane; kk < ncv; kk += 64) { const float e = __expf(sc[kk] - mx); sc[kk] = e; sum += e; }
            sum = wave_sum(sum); const float inv = ncv > 0 ? 1.f / sum : 0.f;
            for (int kk = lane; kk < NC; kk += 64) { const float pv = kk < ncv ? sc[kk] * inv : 0.f; pc[head * 512 + kk] = pv; }
            asm volatile("s_waitcnt lgkmcnt(0)" ::: "memory");
            float o = 0.f;
            for (int kk = 0; kk < ncv; ++kk) o += pc[head * 512 + kk] * bf2f(vc[(size_t)kk * 64 + lane]);
            oc[hh] = o;
        }
        __syncthreads();
        LAS int* sel = (LAS int*)(lds + 65536 + 4096) + wave * NSEL;
        {
            const int cur = t >> 6; float cs[2];
#pragma unroll
            for (int h2 = 0; h2 < 2; ++h2) { const int j = lane + 64 * h2; float ps = 0.f;
#pragma unroll
                for (int k = 0; k < 5; ++k) { const int c = 4 * j + k - 1; if (c >= 0 && c < ncv) { const float wk = (k == 0 || k == 4) ? 1.f : 2.f;
                    ps += wk * (((pc[(4 * g + 0) * 512 + c] + pc[(4 * g + 1) * 512 + c]) + pc[(4 * g + 2) * 512 + c]) + pc[(4 * g + 3) * 512 + c]); } }
                const bool forced = (j == 0) || (j == cur) || (j == cur - 1), valid = j * 64 <= t;
                cs[h2] = forced ? 1.0e6f : (valid ? ps : -1.0e6f); }
#pragma unroll
            for (int i = 0; i < NSEL; ++i) {
                float bv; int bi;
                if (cs[0] >= cs[1]) { bv = cs[0]; bi = lane; } else { bv = cs[1]; bi = lane + 64; }
#pragma unroll
                for (int o = 1; o < 64; o <<= 1) { const float ov = __shfl_xor(bv, o); const int oi = __shfl_xor(bi, o); if (ov > bv || (ov == bv && oi < bi)) { bv = ov; bi = oi; } }
                if (lane == 0) sel[i] = bi;
                if (bi == lane) cs[0] = -3.0e38f;
                if (bi == lane + 64) cs[1] = -3.0e38f;
            }
        }
        for (int hh = 0; hh < 2; ++hh) {
            const int head = wave * 2 + hh;
            float q[64];
            { const u32x4* qp = (const u32x4*)(Q + (size_t)u * D + head * 64);
#pragma unroll
                for (int i = 0; i < 8; ++i) { const u32x4 w = qp[i]; q[8 * i] = bflo(w.x); q[8 * i + 1] = bfhi(w.x); q[8 * i + 2] = bflo(w.y); q[8 * i + 3] = bfhi(w.y); q[8 * i + 4] = bflo(w.z); q[8 * i + 5] = bfhi(w.z); q[8 * i + 6] = bflo(w.w); q[8 * i + 7] = bfhi(w.w); }
#pragma unroll
                for (int i = 0; i < 64; ++i) q[i] *= 0.6931471805599453f; }
            const bf16_t* kvb = KVB + (size_t)b * S * NKV + g * 64;
            {
                float mx = -3.0e38f;
#pragma unroll
                for (int i = 0; i < NSEL; ++i) { const int pos = sel[i] * 64 + lane; float s = -3.0e38f;
                    if (pos <= t) { const int dist = t - pos; s = dot64(q, kvb + (size_t)pos * NKV + 512) + hb[head * 32 + lut[dist < 1023 ? dist : 1023]]; }
                    sc[i * 64 + lane] = s; mx = fmaxf(mx, s); }
                mx = wave_max(mx); float sum = 0.f;
#pragma unroll
                for (int i = 0; i < NSEL; ++i) { const float s = sc[i * 64 + lane]; const float e = s > -1.0e38f ? __expf(s - mx) : 0.f; sc[i * 64 + lane] = e; sum += e; }
                sum = wave_sum(sum); const float inv = 1.f / sum;
                asm volatile("s_waitcnt lgkmcnt(0)" ::: "memory");
                float o = 0.f;
#pragma unroll 1
                for (int i = 0; i < NSEL; ++i) { const int pos0 = sel[i] * 64; if (pos0 > t) continue; const int nk = (t - pos0 + 1 < 64) ? t - pos0 + 1 : 64;
                    for (int l = 0; l < nk; ++l) o += sc[i * 64 + l] * bf2f(kvb[(size_t)(pos0 + l) * NKV + 768 + lane]); }
                os[hh] = o * inv;
            }
            {
                float mx = -3.0e38f;
#pragma unroll
                for (int i = 0; i < 8; ++i) { const int pos = t - 511 + i * 64 + lane; float s = -3.0e38f;
                    if (pos >= 0) { const int dist = t - pos; s = dot64(q, kvb + (size_t)pos * NKV + 1024) + hb[head * 32 + lut[dist]]; }
                    sc[i * 64 + lane] = s; mx = fmaxf(mx, s); }
                mx = wave_max(mx); float sum = 0.f;
#pragma unroll
                for (int i = 0; i < 8; ++i) { const float s = sc[i * 64 + lane]; const float e = s > -1.0e38f ? __expf(s - mx) : 0.f; sc[i * 64 + lane] = e; sum += e; }
                sum = wave_sum(sum); const float inv = 1.f / sum;
                asm volatile("s_waitcnt lgkmcnt(0)" ::: "memory");
                float o = 0.f; const int p0 = t - 511 > 0 ? t - 511 : 0;
                for (int pos = p0; pos <= t; ++pos) o += sc[pos - (t - 511)] * bf2f(kvb[(size_t)pos * NKV + 1280 + lane]);
                ow[hh] = o * inv;
            }
            const float* gt = GATE + (size_t)u * 48 + head * 3;
            const float r = gt[0] * oc[hh] + gt[1] * os[hh] + gt[2] * ow[hh];
            AO[(size_t)u * D + head * 64 + lane] = (bf16_t)(cvt_pk_bf16(r, 0.f) & 0xffffu);
        }
        __syncthreads();
    }
}

__device__ __forceinline__ void phase_vtrans(const Params& p, LAS unsigned char* lds) {
    const int tid = opaque_tid(), lane = tid & 63, wave = tid >> 6;
    const int gw = blockIdx.x * NWAVE + wave, NGW = gridDim.x * NWAVE;
    LAS unsigned short* tile = (LAS unsigned short*)(lds + wave * 8448);
    const bf16_t* KVB = (const bf16_t*)(p.ws + WS_KVB);
    LAS int* chunk = (LAS int*)(lds + 131072 - 64);
    for (;;) {
        if (tid == 0) *chunk = (int)atomicAdd((unsigned*)(p.ws + WS_CTL) + CW_VT, 1u);
        __syncthreads();
        const int c0 = *chunk;
        __syncthreads();
        if (c0 >= 2 * 16 * 128 / NWAVE) break;
        const int u = c0 * NWAVE + wave;
        const int which = u >> 11, bg = (u >> 7) & 15, tt = u & 127, b = bg >> 2, g = bg & 3, t0 = tt * 64;
        const u32x4* src = (const u32x4*)(KVB + (size_t)(b * S + t0 + lane) * NKV + (which ? 1280 : 768) + g * 64);
#pragma unroll
        for (int i = 0; i < 8; ++i) { const u32x4 v = src[i]; LAS unsigned* tp = (LAS unsigned*)(tile + lane * 66 + 8 * i); tp[0] = v.x; tp[1] = v.y; tp[2] = v.z; tp[3] = v.w; }
        asm volatile("s_waitcnt lgkmcnt(0)" ::: "memory");
        if (which) {
            bf16_t* dst = (bf16_t*)(p.ws + WS_VWB) + (size_t)(bg * 128 + tt) * 4096 + lane * 8;
#pragma unroll
            for (int i = 0; i < 8; ++i) { unsigned w[4];
#pragma unroll
                for (int q = 0; q < 4; ++q) { const unsigned lo = tile[(8 * i + 2 * q) * 66 + lane], hi = tile[(8 * i + 2 * q + 1) * 66 + lane]; w[q] = lo | (hi << 16); }
                *(u32x4*)(dst + i * 512) = (u32x4){w[0], w[1], w[2], w[3]}; }
        } else {
            unsigned char* dst = p.ws + WS_VSB + (size_t)(bg * 128 + tt) * 4096 + lane * 16;
#pragma unroll
            for (int i = 0; i < 4; ++i) { unsigned w[4];
#pragma unroll
                for (int q = 0; q < 4; ++q) { const int k0 = 16 * i + 4 * q; unsigned x = 0u;
                    x = __builtin_amdgcn_cvt_pk_fp8_f32(bf2f(tile[(k0 + 0) * 66 + lane]), bf2f(tile[(k0 + 1) * 66 + lane]), x, false);
                    x = __builtin_amdgcn_cvt_pk_fp8_f32(bf2f(tile[(k0 + 2) * 66 + lane]), bf2f(tile[(k0 + 3) * 66 + lane]), x, true); w[q] = x; }
                *(u32x4*)(dst + i * 1024) = (u32x4){w[0], w[1], w[2], w[3]}; }
        }
        asm volatile("s_waitcnt lgkmcnt(0)" ::: "memory");
    }
}

typedef short s16x4 __attribute__((ext_vector_type(4)));
__device__ __forceinline__ f32x4 mfma4(s16x4 a, s16x4 b, f32x4 c) { return __builtin_amdgcn_mfma_f32_4x4x4bf16_1k(a, b, c, 0, 0, 0); }
__device__ __forceinline__ s16x4 mk4(unsigned lo, unsigned hi) { const u32x2 t = {lo, hi}; return __builtin_bit_cast(s16x4, t); }
__device__ __forceinline__ f32x4 qk64(const bf16_t* krow, const s16x4 (&qf)[16]) {
    const u32x4* kp = (const u32x4*)krow; u32x4 kr[8];
#pragma unroll
    for (int i = 0; i < 8; ++i) kr[i] = kp[i];
    f32x4 s = {0.f, 0.f, 0.f, 0.f};
#pragma unroll
    for (int c = 0; c < 8; ++c) { s = mfma4(mk4(kr[c].x, kr[c].y), qf[2 * c], s); s = mfma4(mk4(kr[c].z, kr[c].w), qf[2 * c + 1], s); }
    return s;
}
__device__ __forceinline__ void pv64(f32x4& o, const f32x4 e, const bf16_t* vtrow, LAS u32x2* stage, int lane) {
    const u32x4* vp = (const u32x4*)vtrow; u32x4 vr[8];
#pragma unroll
    for (int i = 0; i < 8; ++i) vr[i] = vp[i];
    u32x2 pk; pk.x = cvt_pk_bf16(e.x, e.y); pk.y = cvt_pk_bf16(e.z, e.w);
    stage[lane] = pk;
#pragma unroll
    for (int st = 0; st < 16; ++st) { const u32x2 a = stage[4 * st + (lane & 3)]; const u32x4 v = vr[st >> 1];
        o = mfma4(mk4(a.x, a.y), (st & 1) ? mk4(v.z, v.w) : mk4(v.x, v.y), o); }
}
__device__ __forceinline__ float quadx_sum(float v) { v += __shfl_xor(v, 4); v += __shfl_xor(v, 8); v += __shfl_xor(v, 16); v += __shfl_xor(v, 32); return v; }

constexpr int HBN = 800;
constexpr int ATT_HBD = 0, ATT_MH = 51200, ATT_PSLC = 53248, ATT_STAGE = 118784;
__device__ __forceinline__ void attn_tables(const Params& p, LAS unsigned char* lds) {
    const int tid = opaque_tid();
    LAS float* hbd = (LAS float*)(lds + ATT_HBD); LAS float* mh = (LAS float*)(lds + ATT_MH);
    for (int i = tid; i < 16 * HBN; i += NTHR) { const int hd = i / HBN, d = i - hd * HBN; hbd[i] = p.rel_bias[rel_bucket(d) * NH + hd] * 1.4426950408889634f; }
    if (tid < 16) { float qg = 0.f, kg = 0.f, bm = -3.0e38f;
        for (int i = 0; i < 64; ++i) qg = fmaxf(qg, fabsf(p.q_gain[i]));
        for (int i = 0; i < 192; ++i) kg = fmaxf(kg, fabsf(p.k_gain[i]));
        for (int i = 0; i < 32; ++i) bm = fmaxf(bm, p.rel_bias[i * NH + tid]);
        mh[tid] = (qg * kg * 8.f * 1.02f + bm) * 1.4426950408889634f; }
    __syncthreads();
}
typedef float f32x16 __attribute__((ext_vector_type(16)));
__device__ __forceinline__ f32x16 mfma32(bf16x8 a, bf16x8 b, f32x16 c) { return __builtin_amdgcn_mfma_f32_32x32x16_bf16(a, b, c, 0, 0, 0); }
struct DFrag { bf16x8 ka[4]; bf16x8 va[2][2]; };
__device__ __forceinline__ void dense_load_k(bf16x8 (&ka)[4], const bf16_t* KB, int kt, int l31, int h) {
    const int blk = kt >> 6, hh = (kt >> 5) & 1;
    const bf16_t* kb = KB + (size_t)blk * 4096 + (32 * hh + l31) * 8;
#pragma unroll
    for (int ks = 0; ks < 4; ++ks) ka[ks] = *(const bf16x8*)(kb + (2 * ks + h) * 512);
}
__device__ __forceinline__ void dense_load_v(bf16x8 (&va)[2][2], const bf16_t* VB, int kt, int l31, int h) {
    const int blk = kt >> 6, hh = (kt >> 5) & 1;
    const bf16_t* vb = VB + (size_t)blk * 4096 + l31 * 8 + 4 * h;
#pragma unroll
    for (int dt = 0; dt < 2; ++dt)
#pragma unroll
        for (int st = 0; st < 2; ++st) { const bf16_t* q0 = vb + (4 * hh + 2 * st) * 512 + dt * 256; const u32x2 lo = *(const u32x2*)q0, hi = *(const u32x2*)(q0 + 512);
            const u32x4 w = {lo.x, lo.y, hi.x, hi.y}; va[dt][st] = __builtin_bit_cast(bf16x8, w); }
}
__device__ __forceinline__ f32x16 dense_scores(const DFrag& f, const bf16x8 (&q)[4]) {
    f32x16 sacc;
#pragma unroll
    for (int i = 0; i < 16; ++i) sacc[i] = 0.f;
#pragma unroll
    for (int ks = 0; ks < 4; ++ks) sacc = mfma32(f.ka[ks], q[ks], sacc);
    return sacc;
}
__device__ __forceinline__ void dense_pv(f32x16 (&O)[2], const DFrag& f, const float (&ev)[16]) {
    bf16x8 pb[2];
#pragma unroll
    for (int st = 0; st < 2; ++st) { const u32x4 w = {cvt_pk_bf16(ev[8 * st], ev[8 * st + 1]), cvt_pk_bf16(ev[8 * st + 2], ev[8 * st + 3]), cvt_pk_bf16(ev[8 * st + 4], ev[8 * st + 5]), cvt_pk_bf16(ev[8 * st + 6], ev[8 * st + 7])};
        pb[st] = __builtin_bit_cast(bf16x8, w); }
#pragma unroll
    for (int dt = 0; dt < 2; ++dt)
#pragma unroll
        for (int st = 0; st < 2; ++st) O[dt] = mfma32(f.va[dt][st], pb[st], O[dt]);
}
__device__ __forceinline__ void phase_dense(const Params& p, LAS unsigned char* lds, bf16_t* OW) {
    const int tid = opaque_tid(), lane0 = tid & 63, wave = tid >> 6;
    const LAS float* hbd = (const LAS float*)(lds + ATT_HBD); const LAS float* mh = (const LAS float*)(lds + ATT_MH);
    LAS float* pslc = (LAS float*)(lds + ATT_PSLC) + wave * 2048;
    const bf16_t* Q = (const bf16_t*)(p.ws + WS_Q); const float* GATE = (const float*)(p.ws + WS_GATE);
    short* SEL = (short*)(p.ws + WS_SEL);
    const int Gn = gridDim.x, vcu = (Gn % 8 == 0) ? (blockIdx.x % 8) * (Gn / 8) + blockIdx.x / 8 : blockIdx.x;
    for (int u = vcu * NWAVE + wave; u < T * G / 16; u += Gn * NWAVE) {
        int lane = lane0; asm volatile("" : "+v"(lane));
        const int l31 = lane & 31, h = lane >> 5;
        const int bg = u >> 9, t0 = (((u & 511) + 128 * (u >> 11)) & 511) * 16, b = bg >> 2, g = bg & 3, head = 4 * g + (lane & 3);
        const LAS float* hb = hbd + head * HBN; const float mhv = mh[head];
        int tok[2]; bf16x8 qf[2][4];
#pragma unroll
        for (int r = 0; r < 2; ++r) { tok[r] = t0 + 8 * r + (l31 >> 2); const bf16_t* qp = Q + (size_t)(b * S + tok[r]) * D + head * 64 + 8 * h;
#pragma unroll
            for (int ks = 0; ks < 4; ++ks) qf[r][ks] = *(const bf16x8*)(qp + 16 * ks); }
        f32x16 O[2][2];
#pragma unroll
        for (int r = 0; r < 2; ++r)
#pragma unroll
            for (int dt = 0; dt < 2; ++dt)
#pragma unroll
                for (int q = 0; q < 16; ++q) O[r][dt][q] = 0.f;
        DFrag cur; bf16x8 nxtk[4];
        {
            const bf16_t* KB = (const bf16_t*)(p.ws + WS_KWB) + (size_t)bg * 128 * 4096; const bf16_t* VB = (const bf16_t*)(p.ws + WS_VWB) + (size_t)bg * 128 * 4096;
            float lw[2] = {0.f, 0.f};
            const int lo = t0 - (WIN - 1) > 0 ? t0 - (WIN - 1) : 0, kt_last = t0 & ~31;
            dense_load_k(cur.ka, KB, lo & ~31, l31, h);
            for (int kt = lo & ~31; kt <= kt_last; kt += 32) {
                dense_load_v(cur.va, VB, kt, l31, h);
                dense_load_k(nxtk, KB, kt + 32 <= kt_last ? kt + 32 : kt_last, l31, h);
                __builtin_amdgcn_sched_barrier(0);
#pragma unroll
                for (int r = 0; r < 2; ++r) {
                    const f32x16 sacc = dense_scores(cur, qf[r]);
                    const int dbase = tok[r] - kt - 4 * h; float ev[16];
                    if (kt + 31 <= t0 + 8 * r && kt >= t0 + 8 * r + 7 - (WIN - 1)) {
                        const LAS float* hbp = hb + dbase;
#pragma unroll
                        for (int q = 0; q < 16; ++q) { const float e = __builtin_amdgcn_exp2f(sacc[q] + hbp[-((q & 3) + 8 * (q >> 2))] - mhv); ev[q] = e; lw[r] += e; }
                    } else {
#pragma unroll
                    for (int q = 0; q < 16; ++q) { const int dist = dbase - ((q & 3) + 8 * (q >> 2)); const bool ok = (unsigned)dist < (unsigned)WIN;
                        const float e0 = __builtin_amdgcn_exp2f(sacc[q] + hb[ok ? dist : 0] - mhv); const float e = ok ? e0 : 0.f; ev[q] = e; lw[r] += e; }
                    }
                    dense_pv(O[r], cur, ev);
                }
#pragma unroll
                for (int ks = 0; ks < 4; ++ks) cur.ka[ks] = nxtk[ks];
            }
#pragma unroll
            for (int r = 0; r < 2; ++r) { const float l = lw[r] + __shfl_xor(lw[r], 32); int tk = tok[r]; asm volatile("" : "+v"(tk)); const float* gp = GATE + (size_t)(b * S + tk) * 48 + head * 3;
                const float sc = gp[2] / (l * gp[0]);
#pragma unroll
                for (int dt = 0; dt < 2; ++dt) O[r][dt] = O[r][dt] * sc; }
        }
        const int ncmax = t0 >> 4;
        {
            int l31c = l31, hc = h; asm volatile("" : "+v"(l31c), "+v"(hc));
            const bf16_t* KB = (const bf16_t*)(p.ws + WS_KC) + (size_t)bg * 8 * 4096; const bf16_t* VB = (const bf16_t*)(p.ws + WS_VC) + (size_t)bg * 8 * 4096;
            float lc[2] = {0.f, 0.f};
            const int kt_last = ncmax > 0 ? ((ncmax - 1) & ~31) : -32;
            if (ncmax > 0) {
                dense_load_k(cur.ka, KB, 0, l31c, hc);
                for (int kt = 0; kt <= kt_last; kt += 32) {
                    dense_load_k(nxtk, KB, kt + 32 <= kt_last ? kt + 32 : kt_last, l31c, hc);
                    __builtin_amdgcn_sched_barrier(0);
#pragma unroll
                    for (int r = 0; r < 2; ++r) {
                        const f32x16 sacc = dense_scores(cur, qf[r]);
                        if (t0 - 31 - 16 * (kt + 31) >= HBN - 1) {
                            const float bfar = hb[HBN - 1] - mhv;
#pragma unroll
                            for (int q = 0; q < 16; ++q) lc[r] += __builtin_amdgcn_exp2f(sacc[q] + bfar);
                        } else {
                        const int dbase = tok[r] - 31 - 16 * (kt + 4 * hc);
#pragma unroll
                        for (int q = 0; q < 16; ++q) { const int dist = dbase - 16 * ((q & 3) + 8 * (q >> 2)); const int di = dist < 0 ? 0 : (dist > HBN - 1 ? HBN - 1 : dist);
                            const float e0 = __builtin_amdgcn_exp2f(sacc[q] + hb[di] - mhv); lc[r] += dist >= 0 ? e0 : 0.f; }
                        }
                    }
#pragma unroll
                    for (int ks = 0; ks < 4; ++ks) cur.ka[ks] = nxtk[ks];
                }
            }
            float linv[2];
#pragma unroll
            for (int r = 0; r < 2; ++r) { const float l = lc[r] + __shfl_xor(lc[r], 32); linv[r] = l > 0.f ? 1.f / l : 0.f; }
            { const f32x4 z = {0.f, 0.f, 0.f, 0.f};
#pragma unroll
              for (int i = 0; i < 8; ++i) *(LAS f32x4*)(pslc + (i * 64 + lane) * 4) = z; }
            if (ncmax > 0) {
                float carry[2] = {0.f, 0.f};
                dense_load_k(cur.ka, KB, 0, l31c, hc);
                for (int kt = 0; kt <= kt_last; kt += 32) {
                    dense_load_v(cur.va, VB, kt, l31c, hc);
                    dense_load_k(nxtk, KB, kt + 32 <= kt_last ? kt + 32 : kt_last, l31c, hc);
                    __builtin_amdgcn_sched_barrier(0);
#pragma unroll
                    for (int r = 0; r < 2; ++r) {
                        const f32x16 sacc = dense_scores(cur, qf[r]);
                        float pv[16];
                        const int dbase = tok[r] - 31 - 16 * (kt + 4 * hc);
#pragma unroll
                        for (int q = 0; q < 16; ++q) { const int dist = dbase - 16 * ((q & 3) + 8 * (q >> 2)); const int di = dist < 0 ? 0 : (dist > HBN - 1 ? HBN - 1 : dist);
                            const float e0 = __builtin_amdgcn_exp2f(sacc[q] + hb[di] - mhv); pv[q] = dist >= 0 ? e0 * linv[r] : 0.f; }
                        dense_pv(O[r], cur, pv);
#pragma unroll
                        for (int q = 0; q < 16; ++q) { pv[q] += __shfl_xor(pv[q], 1); pv[q] += __shfl_xor(pv[q], 2); }
                        float y[4];
#pragma unroll
                        for (int gq = 0; gq < 4; ++gq) y[gq] = __shfl_xor(pv[4 * gq + 3], 32);
#pragma unroll
                        for (int gq = 0; gq < 4; ++gq) { const float prevv = h ? y[gq] : (gq > 0 ? y[gq > 0 ? gq - 1 : 0] : carry[r]);
                            const float val = 2.f * ((pv[4 * gq] + pv[4 * gq + 1]) + pv[4 * gq + 2]) + pv[4 * gq + 3] + prevv;
                            if ((lane & 3) == 0) pslc[(8 * r + (l31c >> 2)) * 128 + (kt >> 2) + 2 * gq + hc] = val; }
                        carry[r] = y[3];
                    }
#pragma unroll
                    for (int ks = 0; ks < 4; ++ks) cur.ka[ks] = nxtk[ks];
                }
            }
        }
#pragma unroll
        for (int r = 0; r < 2; ++r) { int tk = tok[r]; asm volatile("" : "+v"(tk)); bf16_t* op = OW + (size_t)(b * S + tk) * D + head * 64 + 4 * h; const float gc = GATE[(size_t)(b * S + tk) * 48 + head * 3];
#pragma unroll
            for (int dt = 0; dt < 2; ++dt)
#pragma unroll
                for (int gq = 0; gq < 4; ++gq) { u32x2 w; w.x = cvt_pk_bf16(O[r][dt][4 * gq] * gc, O[r][dt][4 * gq + 1] * gc); w.y = cvt_pk_bf16(O[r][dt][4 * gq + 2] * gc, O[r][dt][4 * gq + 3] * gc);
                    *(u32x2*)(op + dt * 32 + 8 * gq) = w; } }
#pragma unroll 1
        for (int tl = 0; tl < 16; ++tl) {
            int ln = lane; asm volatile("" : "+v"(ln));
            const int t = t0 + tl, cur_b = t >> 6, j0 = ln, j1 = ln + 64;
            const float c0 = pslc[tl * 128 + j0], c1 = pslc[tl * 128 + j1];
            const bool f0 = (j0 == 0) || (j0 == cur_b) || (j0 == cur_b - 1), f1 = (j1 == cur_b) || (j1 == cur_b - 1);
            const bool v0 = j0 * 64 <= t, v1 = j1 * 64 <= t;
            const unsigned u0 = (v0 && !f0) ? __float_as_uint(c0) : 0u, u1 = (v1 && !f1) ? __float_as_uint(c1) : 0u;
            unsigned th = 1u;
            if (cur_b + 1 > NSEL) {
                th = 0u;
#pragma unroll 1
                for (int bit = 30; bit >= 0; --bit) {
                    const unsigned trial = th | (1u << bit);
                    const int cnt = __popcll(__ballot(u0 >= trial)) + __popcll(__ballot(u1 >= trial));
                    if (cnt >= NSEL - 3) { th = trial; if (cnt == NSEL - 3) break; }
                }
            }
            const bool s0 = f0 || (u0 >= th && u0 != 0u), s1 = f1 || (u1 >= th && u1 != 0u);
            const unsigned long long m0 = __ballot(s0), m1 = __ballot(s1), lt = (1ull << ln) - 1ull;
            const int p0 = __popcll(m0 & lt), p1 = __popcll(m0) + __popcll(m1 & lt);
            short* so = SEL + ((size_t)(b * S + t) * 4 + g) * NSEL;
            if (s0 && p0 < NSEL) so[p0] = (short)j0;
            if (s1 && p1 < NSEL) so[p1] = (short)j1;
        }
    }
}

struct Row16 { u32x4 r[8]; };
struct Row8 { u32x4 r[4]; };
__device__ __forceinline__ void load_row(Row16& r, const unsigned char* ptr) {
#pragma unroll
    for (int i = 0; i < 8; ++i) r.r[i] = *(const u32x4*)(ptr + i * 1024);
}
__device__ __forceinline__ void load_row(Row8& r, const unsigned char* ptr) {
#pragma unroll
    for (int i = 0; i < 4; ++i) r.r[i] = *(const u32x4*)(ptr + i * 1024);
}
typedef __bf16 bf16x2_t __attribute__((ext_vector_type(2)));
__device__ __forceinline__ s16x4 cvt4_fp8(unsigned w) {
    const bf16x2_t lo = __builtin_amdgcn_cvt_scalef32_pk_bf16_fp8(w, 1.0f, false), hi = __builtin_amdgcn_cvt_scalef32_pk_bf16_fp8(w, 1.0f, true);
    return mk4(__builtin_bit_cast(unsigned, lo), __builtin_bit_cast(unsigned, hi));
}
__device__ __forceinline__ s16x4 frag4(const Row16& k, int c) { const u32x4 v = k.r[c >> 1]; return (c & 1) ? mk4(v.z, v.w) : mk4(v.x, v.y); }
__device__ __forceinline__ s16x4 frag4(const Row8& k, int c) { return cvt4_fp8(k.r[c >> 2][c & 3]); }
typedef int i32x4v __attribute__((ext_vector_type(4)));
__device__ __forceinline__ f32x4 qk_row_i8(const Row8& k, const int (&qi)[16]) {
    i32x4v s0 = {0, 0, 0, 0}, s1 = s0;
#pragma unroll
    for (int c = 0; c < 16; c += 2) { s0 = __builtin_amdgcn_mfma_i32_4x4x4i8((int)k.r[c >> 2][c & 3], qi[c], s0, 0, 0, 0); s1 = __builtin_amdgcn_mfma_i32_4x4x4i8((int)k.r[(c + 1) >> 2][(c + 1) & 3], qi[c + 1], s1, 0, 0, 0); }
    const i32x4v t = s0 + s1; return (f32x4){(float)t.x, (float)t.y, (float)t.z, (float)t.w};
}
template <class Row> __device__ __forceinline__ f32x4 qk_row(const Row& k, const s16x4 (&qf)[16]) {
    f32x4 s = {0.f, 0.f, 0.f, 0.f};
#pragma unroll
    for (int c = 0; c < 16; ++c) s = mfma4(frag4(k, c), qf[c], s);
    return s;
}
template <class Row> __device__ __forceinline__ void pv_row(f32x4& o, const f32x4 e, const Row& v, LAS u32x2* stage, int lane) {
    u32x2 pk; pk.x = cvt_pk_bf16(e.x, e.y); pk.y = cvt_pk_bf16(e.z, e.w);
    stage[lane] = pk;
#pragma unroll
    for (int st = 0; st < 16; ++st) { const u32x2 a = stage[4 * st + (lane & 3)]; o = mfma4(mk4(a.x, a.y), frag4(v, st), o); }
}
#define PIPE_PIN() __builtin_amdgcn_sched_barrier(0)
template <bool HASV, class F>
__device__ __forceinline__ void pipe_blocks(const int n, F& f, const s16x4 (&qf)[16]) {
    if (n <= 0) return;
    typename F::Row kA, kB, vA, vB;
    const int l = n - 1;
    load_row(kA, f.kptr(0)); if (HASV) load_row(vA, f.vptr(0));
    PIPE_PIN();
    for (int i = 0; i < n; i += 2) {
        { const int j = i + 1 < l ? i + 1 : l; load_row(kB, f.kptr(j)); if (HASV) load_row(vB, f.vptr(j)); PIPE_PIN();
          const f32x4 sv = qk_row(kA, qf); f.use(i, sv, vA); PIPE_PIN(); }
        if (i + 1 < n) { const int j = i + 2 < l ? i + 2 : l; load_row(kA, f.kptr(j)); if (HASV) load_row(vA, f.vptr(j)); PIPE_PIN();
          const f32x4 sv = qk_row(kB, qf); f.use(i + 1, sv, vB); PIPE_PIN(); }
    }
}
template <class F>
__device__ __forceinline__ void pipe_blocks3(const int n, F& f) {
    if (n <= 0) return;
    typename F::Row k0, k1, k2, v0, v1, v2;
    const int l = n - 1;
#define PB3_IDX(j) ((j) < l ? (j) : l)
    load_row(k0, f.kptr(0)); load_row(v0, f.vptr(0)); load_row(k1, f.kptr(PB3_IDX(1))); load_row(v1, f.vptr(PB3_IDX(1)));
    PIPE_PIN();
#define PB3_STEP(j, KN, VN, KC, VC) if (i + (j) < n) { load_row(KN, f.kptr(PB3_IDX(i + (j) + 2))); load_row(VN, f.vptr(PB3_IDX(i + (j) + 2))); PIPE_PIN(); \
        const f32x4 sv = f.qk(KC); f.use(i + (j), sv, VC); PIPE_PIN(); }
    for (int i = 0; i < n; i += 3) { PB3_STEP(0, k2, v2, k0, v0) PB3_STEP(1, k0, v0, k1, v1) PB3_STEP(2, k1, v1, k2, v2) }
#undef PB3_STEP
#undef PB3_IDX
}
struct SelCtx {
    typedef Row8 Row;
    const unsigned char* ks; const unsigned char* vs; const LAS float* hb; LAS u32x2* stage; float mhv, dq; int selv, t, lane, qd;
    int qi[16];
    f32x4 os; float ls;
    __device__ __forceinline__ f32x4 qk(const Row8& k) const { return qk_row_i8(k, qi) * dq; }
    __device__ __forceinline__ const unsigned char* kptr(int i) const { return ks + (size_t)__builtin_amdgcn_readlane(selv, i) * 4096; }
    __device__ __forceinline__ const unsigned char* vptr(int i) const { return vs + (size_t)__builtin_amdgcn_readlane(selv, i) * 4096; }
    __device__ __forceinline__ void use(int i, const f32x4 sv, const Row8& vr) {
        const int pos0 = __builtin_amdgcn_readlane(selv, i) * 64;
        f32x4 e;
        if (t - pos0 - 63 >= HBN - 1) {
            const float bfar = hb[HBN - 1] - mhv;
#pragma unroll
            for (int q = 0; q < 4; ++q) e[q] = __builtin_amdgcn_exp2f(sv[q] + bfar);
        } else {
#pragma unroll
        for (int q = 0; q < 4; ++q) { const int dist = t - (pos0 + 4 * qd + q); const int di = dist < 0 ? 0 : (dist > HBN - 1 ? HBN - 1 : dist);
            const float e0 = __builtin_amdgcn_exp2f(sv[q] + hb[di] - mhv); e[q] = dist >= 0 ? e0 : 0.f; }
        }
        ls += (e[0] + e[1]) + (e[2] + e[3]);
        pv_row(os, e, vr, stage, lane);
    }
};

__device__ __forceinline__ void phase_attn_pair(const Params& p, LAS unsigned char* lds, bf16_t* AO, const bf16_t* OW) {
    const int tid = opaque_tid(), lane = tid & 63, wave = tid >> 6, jq = lane & 3, qd = lane >> 2;
    const LAS float* hbd = (const LAS float*)(lds + ATT_HBD); const LAS float* mh = (const LAS float*)(lds + ATT_MH);
    LAS u32x2* stage = (LAS u32x2*)(lds + ATT_STAGE) + wave * 64;
    const float dq8 = 1.f / (sel_q_scale(p.q_gain) * sel_k_scale(p.k_gain));
    const unsigned char* KSB = p.ws + WS_KSB; const unsigned char* VSB = p.ws + WS_VSB;
    const float* GATE = (const float*)(p.ws + WS_GATE); const short* SEL = (const short*)(p.ws + WS_SEL);
    const int Gn = gridDim.x, vcu = (Gn % 8 == 0) ? (blockIdx.x % 8) * (Gn / 8) + blockIdx.x / 8 : blockIdx.x;
    for (int idx = vcu * NWAVE + wave; idx < T * G; idx += Gn * NWAVE) {
        const int bg = idx >> 13, t = idx & (S - 1), b = bg >> 2, g = bg & 3, u = b * S + t;
        const int head = 4 * g + jq;
        const int cur = t >> 6, nv = cur + 1 < NSEL ? cur + 1 : NSEL;
        SelCtx sw;
        { const u32x4* qp = (const u32x4*)(p.ws + WS_Q8 + (size_t)u * D + head * 64);
#pragma unroll
            for (int i = 0; i < 4; ++i) { const u32x4 w = qp[i]; sw.qi[4 * i] = (int)w.x; sw.qi[4 * i + 1] = (int)w.y; sw.qi[4 * i + 2] = (int)w.z; sw.qi[4 * i + 3] = (int)w.w; } }
        sw.dq = dq8; sw.selv = (int)SEL[((size_t)u * 4 + g) * NSEL + (lane & 15)];
        sw.ks = KSB + (size_t)bg * 128 * 4096 + lane * 16; sw.vs = VSB + (size_t)bg * 128 * 4096 + lane * 16; sw.hb = hbd + head * HBN; sw.stage = stage; sw.mhv = mh[head]; sw.t = t; sw.lane = lane; sw.qd = qd;
        sw.os = (f32x4){0.f, 0.f, 0.f, 0.f}; sw.ls = 0.f;
        pipe_blocks3(nv, sw);
        const float lsi = 1.f / quadx_sum(sw.ls);
        const float* gt = GATE + (size_t)u * 48 + g * 12;
#pragma unroll
        for (int i = 0; i < 4; ++i) {
            const float si = __shfl(lsi, (lane & ~3) + i);
            const float r = gt[3 * i + 1] * (sw.os[i] * si) + bf2f(OW[(size_t)u * D + (4 * g + i) * 64 + lane]);
            AO[(size_t)u * D + (4 * g + i) * 64 + lane] = (bf16_t)(cvt_pk_bf16(r, 0.f) & 0xffffu);
        }
    }
}

__device__ __forceinline__ void moe_pstarts(const unsigned* ctl, int (&pst)[NE + 1]) {
    int a = 0;
#pragma unroll
    for (int e = 0; e < NE; ++e) { pst[e] = a; const int c = (int)ctl[CW_CNT + 64 * e]; a += (c + 511) / 512 * 512; }
    pst[NE] = a;
}
__device__ __forceinline__ void phase_moe_sort(const Params& p, LAS unsigned char* lds) {
    const int tid = opaque_tid(), lane = tid & 63, wave = tid >> 6;
    unsigned* ctl = (unsigned*)(p.ws + WS_CTL);
    const int* TOPE = (const int*)(p.ws + WS_TOPE); int* RPOS = (int*)(p.ws + WS_RPOS);
    const bf16_t* HB = (const bf16_t*)(p.ws + WS_HB); bf16_t* XS = (bf16_t*)(p.ws + WS_XS);
    LAS int* wcnt = (LAS int*)lds;
    LAS int* base = (LAS int*)(lds + 128);
    LAS int* posl = (LAS int*)(lds + 256);
    int pst[NE + 1]; moe_pstarts(ctl, pst);
    if (blockIdx.x == 0 && tid <= NE) ((int*)(ctl + 256))[tid] = pst[tid];
    for (int c0 = blockIdx.x * 256; c0 < 2 * T; c0 += gridDim.x * 256) {
        int e = 0, rank = 0;
        if (wave < 4) { e = TOPE[c0 + wave * 64 + lane];
#pragma unroll
            for (int q = 0; q < NE; ++q) { const unsigned long long m = __ballot(e == q); if (e == q) rank = __popcll(m & ((1ull << lane) - 1ull)); if (lane == 0) wcnt[wave * NE + q] = __popcll(m); } }
        __syncthreads();
        if (tid < NE) { const int n = wcnt[tid] + wcnt[NE + tid] + wcnt[2 * NE + tid] + wcnt[3 * NE + tid]; base[tid] = n ? (int)atomicAdd(ctl + CW_CUR + 64 * tid, (unsigned)n) : 0; }
        __syncthreads();
        if (wave < 4) { int off = 0;
            for (int w = 0; w < wave; ++w) off += wcnt[w * NE + e];
            const int pos = pst[e] + base[e] + off + rank; posl[wave * 64 + lane] = pos; RPOS[c0 + wave * 64 + lane] = pos; }
        __syncthreads();
        for (int j = wave * 32; j < wave * 32 + 32; j += 8) {
            u32x4 v0[8]; int ps[8];
#pragma unroll
            for (int q = 0; q < 8; ++q) { const int tk = (c0 + j + q) >> 1; ps[q] = posl[j + q]; v0[q] = *((const u32x4*)((const unsigned char*)HB + (size_t)tk * D) + lane); }
#pragma unroll
            for (int q = 0; q < 8; ++q) *((u32x4*)((unsigned char*)XS + (size_t)ps[q] * D) + lane) = v0[q];
        }
        __syncthreads();
    }
}
__device__ __forceinline__ void phase_fill_rtok(const Params& p) {
    int* RTOK = (int*)(p.ws + WS_RTOK);
    for (int i = blockIdx.x * NTHR + threadIdx.x; i < MOE_ROWS; i += gridDim.x * NTHR) RTOK[i] = 0;
}
__device__ __forceinline__ void phase_combine(const Params& p) {
    const int tid = opaque_tid(), lane = tid & 63, wave = tid >> 6;
    const int gw = blockIdx.x * NWAVE + wave, NGW = gridDim.x * NWAVE;
    const float* TOPW = (const float*)(p.ws + WS_TOPW); const int* RPOS = (const int*)(p.ws + WS_RPOS);
    const bf16_t* Y = (const bf16_t*)(p.ws + WS_Y); const float* g2 = (const float*)(p.ws + WS_MODV) + (11 * 4) * D;
    for (int r = gw; r < T; r += NGW) {
        const int b = r >> 13; const int p0 = RPOS[2 * r], p1 = RPOS[2 * r + 1]; const float w0 = TOPW[2 * r], w1 = TOPW[2 * r + 1];
#pragma unroll
        for (int j = 0; j < 4; ++j) { const int c = 4 * lane + 256 * j;
            const u32x2 y0 = *(const u32x2*)(Y + (size_t)p0 * D + c), y1 = *(const u32x2*)(Y + (size_t)p1 * D + c);
            const f32x4 gv = *(const f32x4*)(g2 + b * D + c); f32x4 xv = *(const f32x4*)(p.out + (size_t)r * D + c);
            f32x4 f; f.x = w0 * bflo(y0.x) + w1 * bflo(y1.x); f.y = w0 * bfhi(y0.x) + w1 * bfhi(y1.x); f.z = w0 * bflo(y0.y) + w1 * bflo(y1.y); f.w = w0 * bfhi(y0.y) + w1 * bfhi(y1.y);
            *(f32x4*)(p.out + (size_t)r * D + c) = xv + gv * f; }
    }
}

#define XB_TMO      128
#define XB_XCNT(j)  (256  + 64 * (j))
#define XB_XSUB(j)  (1280 + 64 * (j))
#define XB_XGEN(j)  (2304 + 64 * (j))
#define XB_TOP      3328
#define XB_TOPGEN   3392
#define XCD_BAR_WORDS 3456
#define XB_SPIN_CAP (1u << 18)
__device__ __forceinline__ unsigned xb_ld(unsigned* p)              { return __hip_atomic_load(p, __ATOMIC_RELAXED, __HIP_MEMORY_SCOPE_AGENT); }
__device__ __forceinline__ unsigned xb_add(unsigned* p, unsigned v) { return __hip_atomic_fetch_add(p, v, __ATOMIC_RELAXED, __HIP_MEMORY_SCOPE_AGENT); }
__device__ __forceinline__ unsigned xb_xcc_id() { return (unsigned)__builtin_amdgcn_s_getreg((3 << 11) | 20) & 0xFu; }
#define XB_SPIN(cond, bar) do { unsigned _sp = 0; while (cond) { __builtin_amdgcn_s_sleep(1); \
    if ((++_sp & 255u) == 0u) { if (xb_ld(&(bar)[XB_TMO])) break; if (_sp > XB_SPIN_CAP) { atomicAdd(&(bar)[XB_TMO], 1u); break; } } } } while (0)
struct XcdBarrier { unsigned* bar; unsigned x; volatile LAS unsigned* st; };
__device__ __forceinline__ XcdBarrier xcd_barrier_post(unsigned* bar, volatile LAS unsigned* st) {
    XcdBarrier b; b.bar = bar; b.x = xb_xcc_id(); b.st = st;
    if (threadIdx.x == 0) (void)xb_add(&bar[XB_XCNT(b.x)], 1u);
    return b;
}
__device__ __forceinline__ void xcd_barrier_complete(unsigned* bar, unsigned x, unsigned& nloc, unsigned& nx) {
    const unsigned G_ = gridDim.x * gridDim.y * gridDim.z;
    unsigned sum, cnt, mine, sp = 0u;
    for (;;) {
        sum = 0u; cnt = 0u; mine = 0u;
#pragma unroll
        for (unsigned j = 0; j < 16; ++j) { const unsigned c = xb_ld(&bar[XB_XCNT(j)]); sum += c; cnt += (c > 0u) ? 1u : 0u; mine = (j == x) ? c : mine; }
        if (sum == G_) break;
        __builtin_amdgcn_s_sleep(1);
        if ((++sp & 255u) == 0u) { if (xb_ld(&bar[XB_TMO])) break; if (sp > XB_SPIN_CAP) { atomicAdd(&bar[XB_TMO], 1u); break; } }
    }
    nloc = mine > 0u ? mine : 1u; nx = cnt > 0u ? cnt : 1u;
}
__device__ __forceinline__ void xcd_barrier(const XcdBarrier& b) {
    asm volatile("s_waitcnt vmcnt(0)" ::: "memory");
    __syncthreads();
    if (threadIdx.x == 0) {
        unsigned* bar = b.bar;
        __builtin_amdgcn_s_waitcnt(0);
        unsigned nloc = b.st[0], nx = b.st[1];
        if (nloc == 0u) { xcd_barrier_complete(bar, b.x, nloc, nx); b.st[0] = nloc; b.st[1] = nx; }
        const unsigned old = xb_add(&bar[XB_XSUB(b.x)], 1u);
        const unsigned gen = old / nloc;
        if (old + 1u == (gen + 1u) * nloc) {
            __builtin_amdgcn_fence(__ATOMIC_RELEASE, "agent");
            asm volatile("s_waitcnt vmcnt(0)" ::: "memory");
            const unsigned og = xb_add(&bar[XB_TOP], 1u);
            const unsigned tg = og / nx;
            if (og + 1u == (tg + 1u) * nx) xb_add(&bar[XB_TOPGEN], 1u);
            else XB_SPIN(xb_ld(&bar[XB_TOPGEN]) == tg, bar);
            __builtin_amdgcn_fence(__ATOMIC_ACQUIRE, "agent");
            xb_add(&bar[XB_XGEN(b.x)], 1u);
            asm volatile("s_waitcnt vmcnt(0)" ::: "memory");
        } else {
            XB_SPIN(xb_ld(&bar[XB_XGEN(b.x)]) == gen, bar);
            __builtin_amdgcn_fence(__ATOMIC_ACQUIRE, "agent");
            asm volatile("s_waitcnt vmcnt(0)" ::: "memory");
        }
    }
    __syncthreads();
}

constexpr int LDS_SCRATCH = 131072, MISC_OFF = LDS_SCRATCH + 320, LDS_BYTES = 147456;
#define MODP(which) ((const float*)(p.ws + WS_MODV) + (size_t)(which) * 4 * D)

__global__ void __launch_bounds__(NTHR, 2) k_fused(Params p) {
    extern __shared__ __attribute__((aligned(16))) unsigned char lds_raw[];
    LAS unsigned char* lds = (LAS unsigned char*)lds_raw;
    for (int u = threadIdx.x; u < (LDS_BYTES - LDS_SCRATCH) / 4; u += NTHR) ((LAS unsigned*)(lds + LDS_SCRATCH))[u] = 0u;
    __syncthreads();
    const XcdBarrier bar = xcd_barrier_post((unsigned*)(p.ws + WS_CTL) + CW_BAR, (volatile LAS unsigned*)(lds + MISC_OFF) + 8);
#define GRID_BAR() xcd_barrier(bar)
    phase_weights(p, lds); __syncthreads(); phase_modvec(p, lds);
    GRID_BAR();
    phase_convert_fgu(p, lds); __syncthreads();
    phase_poolmix(p, lds, (bf16_t*)(p.ws + WS_HA));
    GRID_BAR();
    { pg8::Sched<1> Sc; Sc.init(T, D, gridDim.x, blockIdx.x, p.ws + WS_HA, p.ws + WO_POOL, D, 256);
      pg8::EpiEl<EpiPool> E{{p.x, (float*)(p.ws + WS_X1), MODP(2), p.pool_scale, 0}};
      pg8::gemm_phase(lds, 256, D, 256, 128, Sc, E); }
    GRID_BAR();
    { NormOut o0{p.norm_g + D, MODP(4), MODP(3), (bf16_t*)(p.ws + WS_HB)}; phase_norm<1, false, 2>(p, lds, (const float*)(p.ws + WS_X1), o0, o0); }
    GRID_BAR();
    { pg8::Sched<0> Sc; Sc.init(T, 2 * FF, gridDim.x, blockIdx.x, p.ws + WS_HB, p.ws + WO_FGU, D / 2, D / 2);
      pg8::EpiPairEl<EpiSwigluI8> E{{(bf16_t*)(p.ws + WS_HID0), FF, (const float*)(p.ws + WS_ASC), (const float*)(p.ws + WS_FGMAX)}};
      pg8::gemm_phase<pg8::EpiPairEl<EpiSwigluI8>, pg8::Sched<0>, true, true, 2>(lds, D / 2, D / 2, D / 2, 128, Sc, E); }
    GRID_BAR();
    { pg8::Sched<0> Sc; Sc.init(T, D, gridDim.x, blockIdx.x, p.ws + WS_HID0, p.ws + WO_FDN, FF, FF);
      pg8::EpiEl<EpiResid> E{{(const float*)(p.ws + WS_X1), (float*)(p.ws + WS_X2), MODP(5)}};
      pg8::gemm_phase(lds, FF, FF, FF, 128, Sc, E); }
    GRID_BAR();
    { NormOut o0{p.kv_norm_g, MODP(13), MODP(12), (bf16_t*)(p.ws + WS_HA)}; NormOut o1{p.norm_g + 2 * D, MODP(7), MODP(6), (bf16_t*)(p.ws + WS_HB)}; phase_norm<2, false>(p, lds, (const float*)(p.ws + WS_X2), o0, o1); }
    GRID_BAR();
    { pg8::Sched<0> Sc; Sc.init(T, NKV, gridDim.x, blockIdx.x, p.ws + WS_HA, p.ws + WO_KV, D, D);
      pg8::EpiEl<EpiBf16> E{{(bf16_t*)(p.ws + WS_KVB), NKV}};
      pg8::gemm_phase(lds, D, D, D, 128, Sc, E); }
    { pg8::Sched<0> Sc; Sc.init(T, D, gridDim.x, blockIdx.x, p.ws + WS_HB, p.ws + WO_Q, D, D);
      pg8::EpiEl<EpiQ> E{{(bf16_t*)(p.ws + WS_Q), (float*)(p.ws + WS_GATE), 0}};
      pg8::gemm_phase(lds, D, D, D, 128, Sc, E); }
    GRID_BAR();
    { pg8::Sched<2> Sc; Sc.init(2048, 2048, gridDim.x, blockIdx.x, p.ws + WS_KVB, p.ws + WO_CK, 16 * NKV, 2048);
      pg8::EpiEl<EpiCmp> E{{(bf16_t*)(p.ws + WS_CMPH), (const float*)(p.ws + WS_CMPB)}};
      pg8::gemm_phase(lds, 2048, 16 * NKV, 2048, (size_t)NKV * 2, Sc, E); }
    { pg8::Sched<0> Sc; Sc.init(T, 256, (int)gridDim.x - 64 > 0 ? (int)gridDim.x - 64 : 1, (int)gridDim.x > 64 ? (int)blockIdx.x - 64 : (int)blockIdx.x, p.ws + WS_HB, p.ws + WO_Q + (size_t)D * D * 2, D, D);
      pg8::EpiEl<EpiQ> E{{(bf16_t*)(p.ws + WS_Q), (float*)(p.ws + WS_GATE), D}};
      pg8::gemm_phase(lds, D, D, D, 128, Sc, E); }
    phase_headnorm(p, lds); phase_vtrans(p, lds);
    GRID_BAR();
    phase_cmp2(p, lds);
    GRID_BAR();
    attn_tables(p, lds);
    phase_dense(p, lds, (bf16_t*)(p.ws + WS_HB));
    GRID_BAR();
    phase_attn_pair(p, lds, (bf16_t*)(p.ws + WS_HA), (const bf16_t*)(p.ws + WS_HB));
    GRID_BAR();
    { pg8::Sched<0> Sc; Sc.init(T, D, gridDim.x, blockIdx.x, p.ws + WS_HA, p.ws + WO_O, D, D);
      pg8::EpiEl<EpiResid> E{{(const float*)(p.ws + WS_X2), p.out, MODP(8)}};
      pg8::gemm_phase(lds, D, D, D, 128, Sc, E); }
    GRID_BAR();
    { NormOut o0{p.norm_g + 3 * D, MODP(10), MODP(9), (bf16_t*)(p.ws + WS_HB)}; phase_norm<1, true, 1>(p, lds, p.out, o0, o0); }
    GRID_BAR();
    phase_moe_sort(p, lds);
    GRID_BAR();
    { const int* pst = (const int*)(p.ws + WS_CTL) + 256;
      pg8::Sched<3> Sc; Sc.init(pst[NE], 2 * FE, gridDim.x, blockIdx.x, p.ws + WS_XS, p.ws + WO_EGU, D / 2, D / 2, pst, (size_t)FE * D);
      pg8::EpiPairEl<EpiSwiglu8> E{{p.ws + WS_HIDM, FE}};
      pg8::gemm_phase<pg8::EpiPairEl<EpiSwiglu8>, pg8::Sched<3>, true, true, 1>(lds, D / 2, D / 2, D / 2, 128, Sc, E, 127 - 5); }
    GRID_BAR();
    { const int* pst = (const int*)(p.ws + WS_CTL) + 256;
      pg8::Sched<3> Sc; Sc.init(pst[NE], D, gridDim.x, blockIdx.x, p.ws + WS_HIDM, p.ws + WO_EDN, FE / 2, FE / 2, pst, (size_t)D * FE / 2);
      pg8::EpiEl<EpiBf16> E{{(bf16_t*)(p.ws + WS_Y), D}};
      pg8::gemm_phase<pg8::EpiEl<EpiBf16>, pg8::Sched<3>, true, true, 1>(lds, FE / 2, FE / 2, FE / 2, 128, Sc, E, 127 - 6); }
    GRID_BAR();
    phase_combine(p);
}

extern "C" void kernel_launch(void* const* d_in, const int* in_sizes, int n_in, void* d_out, int out_size, void* d_ws, size_t ws_size, hipStream_t stream) {
    if (n_in != 28 || out_size != T * D || ws_size < WS_END) { fprintf(stderr, "kernel_launch: unexpected shapes (n_in %d out %d ws %zu need %zu)\n", n_in, out_size, ws_size, (size_t)WS_END); return; }
    static int grid = 0;
    if (grid == 0) {
        int dev = 0, cus = 0, per_cu = 0;
        if (hipGetDevice(&dev) != hipSuccess || hipDeviceGetAttribute(&cus, hipDeviceAttributeMultiprocessorCount, dev) != hipSuccess) { grid = -1; return; }
        if (hipFuncSetAttribute((const void*)k_fused, hipFuncAttributeMaxDynamicSharedMemorySize, LDS_BYTES) != hipSuccess) { grid = -1; return; }
        if (hipOccupancyMaxActiveBlocksPerMultiprocessor(&per_cu, (const void*)k_fused, NTHR, LDS_BYTES) != hipSuccess || per_cu < 1) { fprintf(stderr, "kernel_launch: occupancy query says %d\n", per_cu); }
        (void)hipGetLastError();
        grid = cus;
    }
    if (grid < 0) return;
    Params p{};
    const float** pp = (const float**)&p;
    for (int i = 0; i < 28; ++i) pp[i] = (const float*)d_in[i];
    p.out = (float*)d_out; p.ws = (unsigned char*)d_ws;
    (void)hipMemsetAsync((char*)d_ws + WS_CTL, 0, CTL_BYTES, stream);
    k_fused<<<dim3(grid), dim3(NTHR), LDS_BYTES, stream>>>(p);
}
```

```cpp
#include <hip/hip_runtime.h>
#include <cstdint>
#include <cstdio>

#define LAS __attribute__((address_space(3)))
typedef unsigned short bf16_t;
typedef short bf16x8 __attribute__((ext_vector_type(8)));
typedef float f32x4 __attribute__((ext_vector_type(4)));
typedef float f32x2 __attribute__((ext_vector_type(2)));
typedef unsigned u32x4 __attribute__((ext_vector_type(4)));
typedef unsigned u32x2 __attribute__((ext_vector_type(2)));

constexpr int NB = 4, S = 8192, D = 1024, T = NB * S;
constexpr int FF = 2816, NE = 8, FE = 3584;
constexpr int NKV = 1536, NQP = 1280, NQ = 1072;
constexpr int G = 4, HD = 64, NH = 16;
constexpr int NC = 512;
constexpr int NSB = 128;
constexpr int NSEL = 16;
constexpr int WIN = 512;
constexpr int MOE_ROWS = 69632;
constexpr float EPS = 1e-6f;
constexpr int NTHR = 512, NWAVE = 8;

constexpr size_t MiB = 1u << 20;
constexpr size_t WS_CTL = 0, CTL_BYTES = 1 * MiB;
constexpr size_t WS_MODV = 1 * MiB;
constexpr size_t WS_CMPB = WS_MODV + 14 * 4 * 1024 * 4;
constexpr size_t WS_FGMAX = WS_CMPB + 4096;
constexpr size_t WS_ASC = WS_FGMAX + 2 * FF * 4;
constexpr size_t WS_TOPE = 2 * MiB;
constexpr size_t WS_TOPW = WS_TOPE + (size_t)T * 8;
constexpr size_t WS_RPOS = WS_TOPW + (size_t)T * 8;
constexpr size_t WS_RTOK = WS_RPOS + (size_t)T * 8;
constexpr size_t WS_SMALL_END = WS_RTOK + (size_t)MOE_ROWS * 4;
static_assert(WS_SMALL_END <= 8 * MiB && WS_ASC + (size_t)T * 4 <= 2 * MiB, "small region");
constexpr size_t WS_W = 8 * MiB;
constexpr size_t WO_POOL = WS_W;
constexpr size_t WO_FGU = WO_POOL + (size_t)4 * 256 * 256 * 2;
constexpr size_t WO_FDN = WO_FGU + (size_t)2 * FF * D * 2;
constexpr size_t WO_KV = WO_FDN + (size_t)D * FF * 2;
constexpr size_t WO_Q = WO_KV + (size_t)NKV * D * 2;
constexpr size_t WO_O = WO_Q + (size_t)NQP * D * 2;
constexpr size_t WO_CK = WO_O + (size_t)D * D * 2;
constexpr size_t WO_CV = WO_CK + (size_t)256 * 2048 * 2;
constexpr size_t WO_EGU = WO_CV + (size_t)256 * 2048 * 2;
constexpr size_t WO_EDN = WO_EGU + (size_t)NE * 2 * FE * D * 2;
constexpr size_t WO_END = WO_EDN + (size_t)NE * D * FE * 2;
static_assert(WO_END <= 203 * MiB, "weights region");
constexpr size_t WS_HB = 203 * MiB;
constexpr size_t WS_X1 = 267 * MiB;
constexpr size_t WS_X2 = 395 * MiB;
constexpr size_t WS_HID0 = 523 * MiB;
constexpr size_t WS_Q = 523 * MiB;
constexpr size_t WS_GATE = 587 * MiB;
constexpr size_t WS_CMPH = 593 * MiB;
constexpr size_t WS_KC = 601 * MiB;
constexpr size_t WS_VC = 602 * MiB;
constexpr size_t WS_KSB = 603 * MiB;
constexpr size_t WS_VSB = 619 * MiB;
constexpr size_t WS_KWB = 635 * MiB;
constexpr size_t WS_VWB = 651 * MiB;
constexpr size_t WS_Q8 = 267 * MiB;
constexpr size_t WS_SEL = 667 * MiB;
constexpr size_t WS_HA = 699 * MiB;
constexpr size_t WS_KVB = 763 * MiB;
constexpr size_t WS_HIDM = 267 * MiB;
constexpr size_t WS_Y = 743 * MiB;
constexpr size_t WS_XS = WS_Y;
constexpr size_t WS_END = 880 * MiB;
static_assert(WS_HIDM + (size_t)MOE_ROWS * FE * 2 <= WS_Y && WS_Y + (size_t)MOE_ROWS * D * 2 <= WS_END, "moe map");
static_assert(WS_KVB + (size_t)T * NKV * 2 + 65536 <= WS_END, "kv map");
constexpr int CW_CNT = 512;
constexpr int CW_CUR = 1024;
constexpr int CW_HN = 2048, CW_VT = 2112;
constexpr int CW_BAR = 4096;

struct Params {
    const float *x, *c, *ada_w, *ada_b, *norm_g, *pool_w, *pool_scale, *q_w, *q_gain, *o_w, *kv_ada_w, *kv_ada_b, *kv_norm_g, *kv_w,
        *cmp_pe_k, *cmp_pe_v, *cmp_k_w1, *cmp_k_w2, *cmp_v_w1, *cmp_v_w2, *k_gain, *rel_bias, *ffn_gu, *ffn_dn, *router_w, *router_b, *exp_gu, *exp_dn;
    float* out; unsigned char* ws;
};

__device__ __forceinline__ unsigned cvt_pk_bf16(float lo, float hi) { unsigned r; asm volatile("v_cvt_pk_bf16_f32 %0, %1, %2" : "=v"(r) : "v"(lo), "v"(hi)); return r; }
__device__ __forceinline__ float bf2f(unsigned short v) { return __uint_as_float((unsigned)v << 16); }
__device__ __forceinline__ float bflo(unsigned w) { return __uint_as_float(w << 16); }
__device__ __forceinline__ float bfhi(unsigned w) { return __uint_as_float(w & 0xffff0000u); }
__device__ __forceinline__ int opaque_tid() { int t = threadIdx.x; asm volatile("" : "+v"(t)); return t; }
__device__ __forceinline__ float readlane_f(float v, int l) { return __uint_as_float((unsigned)__builtin_amdgcn_readlane((int)__float_as_uint(v), l)); }
__device__ __forceinline__ unsigned pack_i8x4(float a, float b, float c, float d) {
    const int ia = (int)__builtin_rintf(fminf(fmaxf(a, -127.f), 127.f)), ib = (int)__builtin_rintf(fminf(fmaxf(b, -127.f), 127.f)), ic = (int)__builtin_rintf(fminf(fmaxf(c, -127.f), 127.f)), id = (int)__builtin_rintf(fminf(fmaxf(d, -127.f), 127.f));
    return (unsigned)(ia & 0xff) | ((unsigned)(ib & 0xff) << 8) | ((unsigned)(ic & 0xff) << 16) | ((unsigned)(id & 0xff) << 24);
}
__device__ __forceinline__ float sel_q_scale(const float* q_gain) { float m = 0.f; for (int i = 0; i < 64; ++i) m = fmaxf(m, fabsf(q_gain[i])); return 127.f / (4.f * m * 0.125f * 1.4426950408889634f); }
__device__ __forceinline__ float sel_k_scale(const float* k_gain) { float m = 0.f; for (int i = 0; i < 64; ++i) m = fmaxf(m, fabsf(k_gain[64 + i])); return 127.f / (4.f * m); }
__device__ __forceinline__ float wave_sum(float v) {
#pragma unroll
    for (int o = 1; o < 64; o <<= 1) v += __shfl_xor(v, o);
    return v;
}
__device__ __forceinline__ float wave_max(float v) {
#pragma unroll
    for (int o = 1; o < 64; o <<= 1) v = fmaxf(v, __shfl_xor(v, o));
    return v;
}
__device__ __forceinline__ float silu_f(float v) { return v * __builtin_amdgcn_rcpf(1.f + __builtin_amdgcn_exp2f(v * -1.4426950408889634f)); }
__device__ __forceinline__ float sigmoid_f(float v) { return __builtin_amdgcn_rcpf(1.f + __builtin_amdgcn_exp2f(v * -1.4426950408889634f)); }
__device__ __forceinline__ float gelu_tanh_f(float v) {
    const float u = 0.7978845608028654f * (v + 0.044715f * v * v * v);
    const float e = __builtin_amdgcn_exp2f(fabsf(u) * -2.8853900817779268f); const float th = (1.f - e) * __builtin_amdgcn_rcpf(1.f + e);
    return 0.5f * v * (1.f + (u < 0.f ? -th : th));
}
__device__ __forceinline__ int rel_bucket(int d) {
    if (d < 16) return d;
    int b = 16;
    b += (d >= 21); b += (d >= 27); b += (d >= 35); b += (d >= 46); b += (d >= 59); b += (d >= 77); b += (d >= 99); b += (d >= 128);
    b += (d >= 166); b += (d >= 216); b += (d >= 280); b += (d >= 363); b += (d >= 470); b += (d >= 609); b += (d >= 790);
    return b;
}

template <bool FP8 = false>
__device__ __forceinline__ void transpose_item(const float* W, int K, int N, bf16_t* WT, int k0, int n0, int drow0, LAS float* scr, int lane, float wscale = 1.f) {
    float wv[32];
#pragma unroll
    for (int i = 0; i < 32; ++i) { const int kk = 2 * i + (lane >> 5); const int n = n0 + (lane & 31); wv[i] = (n < N) ? W[(size_t)(k0 + kk) * N + n] : 0.f; }
#pragma unroll
    for (int i = 0; i < 32; ++i) { const int kk = 2 * i + (lane >> 5); scr[kk * 33 + (lane & 31)] = wv[i]; }
    asm volatile("s_waitcnt lgkmcnt(0)" ::: "memory");
    const int c = lane & 7;
#pragma unroll
    for (int j = 0; j < 4; ++j) { const int n = (lane >> 3) + 8 * j; const LAS float* s = scr + (8 * c) * 33 + n;
        if constexpr (FP8) {
            unsigned w0 = 0u, w1 = 0u;
            w0 = __builtin_amdgcn_cvt_pk_fp8_f32(s[0 * 33] * wscale, s[1 * 33] * wscale, w0, false); w0 = __builtin_amdgcn_cvt_pk_fp8_f32(s[2 * 33] * wscale, s[3 * 33] * wscale, w0, true);
            w1 = __builtin_amdgcn_cvt_pk_fp8_f32(s[4 * 33] * wscale, s[5 * 33] * wscale, w1, false); w1 = __builtin_amdgcn_cvt_pk_fp8_f32(s[6 * 33] * wscale, s[7 * 33] * wscale, w1, true);
            *(u32x2*)((unsigned char*)WT + (size_t)(drow0 + n) * K + k0 + 8 * c) = (u32x2){w0, w1};
        } else {
        u32x4 o; o.x = cvt_pk_bf16(s[0 * 33], s[1 * 33]); o.y = cvt_pk_bf16(s[2 * 33], s[3 * 33]); o.z = cvt_pk_bf16(s[4 * 33], s[5 * 33]); o.w = cvt_pk_bf16(s[6 * 33], s[7 * 33]);
        *(u32x4*)(WT + (size_t)(drow0 + n) * K + k0 + 8 * c) = o; } }
    asm volatile("s_waitcnt lgkmcnt(0)" ::: "memory");
}
template <int MODE, bool FP8 = false>
__device__ __forceinline__ void transpose_mat(const float* W, int K, int N, int NP, int F, bf16_t* WT, int it, LAS float* scr, int lane, float wscale = 1.f) {
    const int nblk = NP / 32, kb = it / nblk, nb = it % nblk, n0 = nb * 32;
    int drow0 = n0;
    if (MODE == 1) { const int up = n0 >= F, j = up ? n0 - F : n0; drow0 = (j >> 7) * 256 + (up ? 128 : 0) + (j & 127); }
    transpose_item<FP8>(W, K, N, WT, kb * 64, n0, drow0, scr, lane, wscale);
}
__device__ __forceinline__ void phase_convert_fgu(const Params& p, LAS unsigned char* lds) {
    const int tid = opaque_tid(), lane = tid & 63, wave = tid >> 6;
    LAS float* scr = (LAS float*)(lds + wave * 16384);
    const int gw = blockIdx.x * NWAVE + wave, NGW = gridDim.x * NWAVE;
    const float* FGMAX = (const float*)(p.ws + WS_FGMAX); unsigned char* WT = p.ws + WO_FGU;
    for (int it = gw; it < 16 * 176; it += NGW) {
        const int kb = it / 176, nb = it % 176, n0 = nb * 32, k0 = kb * 64;
        const int up = n0 >= FF, j0 = up ? n0 - FF : n0, drow0 = (j0 >> 7) * 256 + (up ? 128 : 0) + (j0 & 127);
        float wv[32];
#pragma unroll
        for (int i = 0; i < 32; ++i) wv[i] = p.ffn_gu[(size_t)(k0 + 2 * i + (lane >> 5)) * (2 * FF) + n0 + (lane & 31)];
#pragma unroll
        for (int i = 0; i < 32; ++i) scr[(2 * i + (lane >> 5)) * 33 + (lane & 31)] = wv[i];
        asm volatile("s_waitcnt lgkmcnt(0)" ::: "memory");
        const int c = lane & 7;
#pragma unroll
        for (int j = 0; j < 4; ++j) { const int n = (lane >> 3) + 8 * j; const LAS float* sp = scr + (8 * c) * 33 + n; const float sc = 127.f / FGMAX[n0 + n];
            const unsigned w0 = pack_i8x4(sp[0 * 33] * sc, sp[1 * 33] * sc, sp[2 * 33] * sc, sp[3 * 33] * sc), w1 = pack_i8x4(sp[4 * 33] * sc, sp[5 * 33] * sc, sp[6 * 33] * sc, sp[7 * 33] * sc);
            *(u32x2*)(WT + (size_t)(drow0 + n) * D + k0 + 8 * c) = (u32x2){w0, w1}; }
        asm volatile("s_waitcnt lgkmcnt(0)" ::: "memory");
    }
}
__device__ __forceinline__ void phase_weights(const Params& p, LAS unsigned char* lds) {
    const int tid = opaque_tid(), lane = tid & 63, wave = tid >> 6;
    LAS float* scr = (LAS float*)(lds + wave * 16384);
    const int gw = blockIdx.x * NWAVE + wave, NGW = gridDim.x * NWAVE;
    unsigned char* ws = p.ws;
    constexpr int I_POOL = 4 * 8, I_FGU = 16 * 176, I_FDN = 44 * 32, I_KV = 16 * 48, I_Q = 16 * 40, I_O = 16 * 32, I_C = 32 * 8, I_EGU = 16 * 224, I_EDN = 56 * 32;
    constexpr int TOT = 4 * I_POOL + I_FGU + I_FDN + I_KV + I_Q + I_O + 2 * I_C + NE * I_EGU + NE * I_EDN;
    for (int it = gw; it < TOT; it += NGW) {
        int r = it;
        if (r < 4 * I_POOL) { const int g = r / I_POOL; transpose_mat<0>(p.pool_w + (size_t)g * 65536, 256, 256, 256, 0, (bf16_t*)(ws + WO_POOL) + (size_t)g * 65536, r % I_POOL, scr, lane); continue; } r -= 4 * I_POOL;
        if (r < I_FGU) continue; r -= I_FGU;
        if (r < I_FDN) { transpose_mat<0>(p.ffn_dn, FF, D, D, 0, (bf16_t*)(ws + WO_FDN), r, scr, lane); continue; } r -= I_FDN;
        if (r < I_KV) { transpose_mat<0>(p.kv_w, D, NKV, NKV, 0, (bf16_t*)(ws + WO_KV), r, scr, lane); continue; } r -= I_KV;
        if (r < I_Q) { transpose_mat<0>(p.q_w, D, NQ, NQP, 0, (bf16_t*)(ws + WO_Q), r, scr, lane); continue; } r -= I_Q;
        if (r < I_O) { transpose_mat<0>(p.o_w, D, D, D, 0, (bf16_t*)(ws + WO_O), r, scr, lane); continue; } r -= I_O;
        if (r < I_C) { transpose_mat<0>(p.cmp_k_w1, 2048, 256, 256, 0, (bf16_t*)(ws + WO_CK), r, scr, lane); continue; } r -= I_C;
        if (r < I_C) { transpose_mat<0>(p.cmp_v_w1, 2048, 256, 256, 0, (bf16_t*)(ws + WO_CV), r, scr, lane); continue; } r -= I_C;
        if (r < NE * I_EGU) { const int e = r / I_EGU; transpose_mat<1, true>(p.exp_gu + (size_t)e * D * 2 * FE, D, 2 * FE, 2 * FE, FE, (bf16_t*)(ws + WO_EGU + (size_t)e * 2 * FE * D), r % I_EGU, scr, lane, 32.f); continue; } r -= NE * I_EGU;
        { const int e = r / I_EDN; transpose_mat<0, true>(p.exp_dn + (size_t)e * FE * D, FE, D, D, 0, (bf16_t*)(ws + WO_EDN + (size_t)e * D * FE), r % I_EDN, scr, lane, 64.f); }
    }
}

__device__ __forceinline__ void phase_modvec(const Params& p, LAS unsigned char* lds) {
    const int tid = opaque_tid(), lane = tid & 63, wave = tid >> 6;
    LAS float* part = (LAS float*)lds;
    LAS float* sc_l = (LAS float*)(lds + 8192);
    for (int i = tid; i < 4 * D; i += NTHR) sc_l[i] = silu_f(p.c[i]);
    __syncthreads();
    float* MODV = (float*)(p.ws + WS_MODV);
    float* CMPB = (float*)(p.ws + WS_CMPB);
    { float* FGMAX = (float*)(p.ws + WS_FGMAX);
      for (int u = blockIdx.x; u < 2 * FF / 64; u += gridDim.x) {
        const int col = u * 64 + lane; float m = 0.f;
#pragma unroll 16
        for (int k = wave * 128; k < wave * 128 + 128; ++k) m = fmaxf(m, fabsf(p.ffn_gu[(size_t)k * (2 * FF) + col]));
        part[wave * 64 + lane] = m;
        __syncthreads();
        if (tid < 64) { float mm = part[lane];
#pragma unroll
            for (int w = 1; w < 8; ++w) mm = fmaxf(mm, part[w * 64 + lane]);
            FGMAX[u * 64 + lane] = fmaxf(mm, 1e-30f); }
        __syncthreads();
      } }
    constexpr int NU_MOD = 14336 / 64, NU = NU_MOD + 8;
    for (int u = blockIdx.x; u < NU; u += gridDim.x) {
        float acc[4] = {0.f, 0.f, 0.f, 0.f};
        if (u < NU_MOD) {
            const int gc = u * 64 + lane;
            const float* W; int ldw, col;
            if (gc < 6144) { W = p.ada_w; ldw = 6144; col = gc; } else if (gc < 12288) { W = p.ada_w + (size_t)D * 6144; ldw = 6144; col = gc - 6144; } else { W = p.kv_ada_w; ldw = 2048; col = gc - 12288; }
#pragma unroll 16
            for (int k = wave * 128; k < wave * 128 + 128; ++k) {
                const float w = W[(size_t)k * ldw + col];
#pragma unroll
                for (int b = 0; b < 4; ++b) acc[b] += sc_l[b * D + k] * w;
            }
        } else {
            const int cu = u - NU_MOD, kv = cu >> 2, col = (cu & 3) * 64 + lane;
            const float* W = kv ? p.cmp_v_w1 : p.cmp_k_w1; const float* pe = kv ? p.cmp_pe_v : p.cmp_pe_k;
#pragma unroll 16
            for (int k = wave * 256; k < wave * 256 + 256; ++k) acc[0] += pe[k] * W[(size_t)k * 256 + col];
        }
#pragma unroll
        for (int b = 0; b < 4; ++b) part[(wave * 4 + b) * 64 + lane] = acc[b];
        __syncthreads();
        if (tid < 256) {
            const int b = tid >> 6; float s = 0.f;
#pragma unroll
            for (int w = 0; w < 8; ++w) s += part[(w * 4 + b) * 64 + lane];
            if (u < NU_MOD) {
                const int gc = u * 64 + lane; int which, n; float bias;
                if (gc < 6144) { which = gc >> 10; n = gc & 1023; bias = p.ada_b[gc]; } else if (gc < 12288) { which = 6 + ((gc - 6144) >> 10); n = gc & 1023; bias = p.ada_b[gc]; }
                else { which = 12 + ((gc - 12288) >> 10); n = gc & 1023; bias = p.kv_ada_b[gc - 12288]; }
                MODV[(which * 4 + b) * D + n] = s + bias;
            } else if (b == 0) { const int cu = u - NU_MOD; CMPB[(cu >> 2) * 256 + (cu & 3) * 64 + lane] = s; }
        }
        __syncthreads();
    }
}

template <int W>
__device__ __forceinline__ void pool_rows(const float* xb, int t0, const LAS float* rs, f32x2 gm, f32x2 sh, bf16_t* outb, int c0) {
    f32x2 ring[16];
#pragma unroll
    for (int i = 0; i < 15; ++i) {
        const int t = t0 - 15 + i; f32x2 h = {0.f, 0.f};
        if (t >= 0) { const f32x2 xv = *(const f32x2*)(xb + (size_t)t * D + c0); const float r = rs[i]; h = xv * r * gm + sh; }
        ring[i] = h;
    }
    for (int gi = 0; gi < 8; ++gi) {
#pragma unroll
        for (int j = 0; j < 16; ++j) {
            const int i = 15 + gi * 16 + j, t = t0 + gi * 16 + j;
            const f32x2 xv = *(const f32x2*)(xb + (size_t)t * D + c0); const float r = rs[i];
            const f32x2 h = xv * r * gm + sh;
            ring[(15 + j) & 15] = h;
            f32x2 s = {0.f, 0.f};
#pragma unroll
            for (int k = 0; k < W; ++k) s += ring[(15 + j - k) & 15];
            const int cnt = (t + 1 < W) ? t + 1 : W;
            const f32x2 o = s * (1.f / (float)cnt) - h;
            *(unsigned*)(outb + (size_t)t * D + c0) = cvt_pk_bf16(o.x, o.y);
        }
    }
}
__device__ __forceinline__ void phase_poolmix(const Params& p, LAS unsigned char* lds, bf16_t* mixA) {
    const int tid = opaque_tid(), lane = tid & 63, wave = tid >> 6;
    LAS float* rs = (LAS float*)lds;
    const float* MODV = (const float*)(p.ws + WS_MODV);
    for (int u = blockIdx.x; u < T / 128; u += gridDim.x) {
        const int b = u >> 6, t0 = (u & 63) * 128;
        const float* xb = p.x + (size_t)b * S * D;
        for (int i = wave; i < 143; i += NWAVE) {
            const int t = t0 - 15 + i; float r = 0.f;
            if (t >= 0) { const f32x4* xr = (const f32x4*)(xb + (size_t)t * D) + lane; float s = 0.f;
#pragma unroll
                for (int j = 0; j < 4; ++j) { const f32x4 v = xr[64 * j]; s += (v.x * v.x + v.y * v.y) + (v.z * v.z + v.w * v.w); }
                r = 1.f / sqrtf(wave_sum(s) * (1.f / D) + EPS); }
            if (lane == 0) rs[i] = r;
        }
        __syncthreads();
        const int c0 = 2 * tid;
        const f32x2 g = *(const f32x2*)(p.norm_g + c0), sc = *(const f32x2*)(MODV + (1 * 4 + b) * D + c0), sh = *(const f32x2*)(MODV + (0 * 4 + b) * D + c0);
        const f32x2 gm = g * (sc + 1.f);
        bf16_t* ob = mixA + (size_t)b * S * D;
        const int grp = tid >> 7;
        if (grp == 0) pool_rows<2>(xb, t0, rs, gm, sh, ob, c0);
        else if (grp == 1) pool_rows<4>(xb, t0, rs, gm, sh, ob, c0);
        else if (grp == 2) pool_rows<8>(xb, t0, rs, gm, sh, ob, c0);
        else pool_rows<16>(xb, t0, rs, gm, sh, ob, c0);
        __syncthreads();
    }
}

struct NormOut { const float* g; const float* sc; const float* sh; bf16_t* out; };
template <int NOUT, bool ROUTER, int OUTQ = 0>
__device__ __forceinline__ void phase_norm(const Params& p, LAS unsigned char* lds, const float* xin, const NormOut o0, const NormOut o1) {
    const int tid = opaque_tid(), lane = tid & 63, wave = tid >> 6;
    const int gw = blockIdx.x * NWAVE + wave, NGW = gridDim.x * NWAVE;
    f32x4 rwa[16], rwb[16];
    if (ROUTER) {
#pragma unroll
        for (int j = 0; j < 4; ++j)
#pragma unroll
            for (int q = 0; q < 4; ++q) { const f32x4* wp = (const f32x4*)(p.router_w + (size_t)(4 * lane + 256 * j + q) * NE); rwa[4 * j + q] = wp[0]; rwb[4 * j + q] = wp[1]; }
    }
    unsigned* ctl = (unsigned*)(p.ws + WS_CTL);
    int* TOPE = (int*)(p.ws + WS_TOPE); float* TOPW = (float*)(p.ws + WS_TOPW);
    unsigned cnt_local[NE];
#pragma unroll
    for (int e = 0; e < NE; ++e) cnt_local[e] = 0;
    const int rows_per = T / NGW > 0 ? (T + NGW - 1) / NGW : 1;
    const int r0 = gw * rows_per, r1 = (r0 + rows_per < T) ? r0 + rows_per : T;
    int curb = -1; f32x4 gm0[4], sh0[4], gm1[4], sh1[4];
    for (int r = r0; r < r1; ++r) {
        const int b = r >> 13;
        if (b != curb) { curb = b;
#pragma unroll
            for (int j = 0; j < 4; ++j) { const int c = 4 * lane + 256 * j;
                gm0[j] = *(const f32x4*)(o0.g + c) * (*(const f32x4*)(o0.sc + b * D + c) + 1.f); sh0[j] = *(const f32x4*)(o0.sh + b * D + c);
                if (NOUT > 1) { gm1[j] = *(const f32x4*)(o1.g + c) * (*(const f32x4*)(o1.sc + b * D + c) + 1.f); sh1[j] = *(const f32x4*)(o1.sh + b * D + c); } } }
        const f32x4* xr = (const f32x4*)(xin + (size_t)r * D) + lane;
        f32x4 v[4]; float s = 0.f;
#pragma unroll
        for (int j = 0; j < 4; ++j) { v[j] = xr[64 * j]; s += (v[j].x * v[j].x + v[j].y * v[j].y) + (v[j].z * v[j].z + v[j].w * v[j].w); }
        const float rstd = 1.f / sqrtf(wave_sum(s) * (1.f / D) + EPS);
        float lg[NE];
#pragma unroll
        for (int e = 0; e < NE; ++e) lg[e] = 0.f;
        float qsc = 1.f;
        if constexpr (OUTQ == 2) { float mx = 0.f;
#pragma unroll
            for (int j = 0; j < 4; ++j) { const f32x4 h = v[j] * rstd * gm0[j] + sh0[j]; mx = fmaxf(mx, fmaxf(fmaxf(fabsf(h.x), fabsf(h.y)), fmaxf(fabsf(h.z), fabsf(h.w)))); }
            mx = fmaxf(wave_max(mx), 1e-30f); qsc = 127.f / mx;
            if (lane == 0) ((float*)(p.ws + WS_ASC))[r] = mx * (1.f / 127.f); }
#pragma unroll
        for (int j = 0; j < 4; ++j) {
            const f32x4 h = v[j] * rstd * gm0[j] + sh0[j];
            if constexpr (OUTQ == 2) { *(unsigned*)((unsigned char*)o0.out + (size_t)r * D + 4 * lane + 256 * j) = pack_i8x4(h.x * qsc, h.y * qsc, h.z * qsc, h.w * qsc); }
            else if constexpr (OUTQ == 1) { unsigned w8 = 0u; w8 = __builtin_amdgcn_cvt_pk_fp8_f32(h.x, h.y, w8, false); w8 = __builtin_amdgcn_cvt_pk_fp8_f32(h.z, h.w, w8, true);
                *(unsigned*)((unsigned char*)o0.out + (size_t)r * D + 4 * lane + 256 * j) = w8; }
            else { u32x2 w; w.x = cvt_pk_bf16(h.x, h.y); w.y = cvt_pk_bf16(h.z, h.w);
            *(u32x2*)(o0.out + (size_t)r * D + 4 * lane + 256 * j) = w; }
            if (NOUT > 1) { const f32x4 h1 = v[j] * rstd * gm1[j] + sh1[j]; u32x2 w1; w1.x = cvt_pk_bf16(h1.x, h1.y); w1.y = cvt_pk_bf16(h1.z, h1.w);
                *(u32x2*)(o1.out + (size_t)r * D + 4 * lane + 256 * j) = w1; }
            if (ROUTER) {
#pragma unroll
                for (int q = 0; q < 4; ++q) { const f32x4 a = rwa[4 * j + q], c2 = rwb[4 * j + q]; const float hv = h[q];
                    lg[0] += hv * a.x; lg[1] += hv * a.y; lg[2] += hv * a.z; lg[3] += hv * a.w; lg[4] += hv * c2.x; lg[5] += hv * c2.y; lg[6] += hv * c2.z; lg[7] += hv * c2.w; }
            }
        }
        if (ROUTER) {
            {
                const bool u5 = lane & 32, u4 = lane & 16, u3 = lane & 8; float a4[4], a2[2], a1;
#pragma unroll
                for (int i = 0; i < 4; ++i) a4[i] = (u5 ? lg[4 + i] : lg[i]) + __shfl_xor(u5 ? lg[i] : lg[4 + i], 32);
#pragma unroll
                for (int i = 0; i < 2; ++i) a2[i] = (u4 ? a4[2 + i] : a4[i]) + __shfl_xor(u4 ? a4[i] : a4[2 + i], 16);
                a1 = (u3 ? a2[1] : a2[0]) + __shfl_xor(u3 ? a2[0] : a2[1], 8);
                a1 += __shfl_xor(a1, 4); a1 += __shfl_xor(a1, 2); a1 += __shfl_xor(a1, 1);
#pragma unroll
                for (int e = 0; e < NE; ++e) lg[e] = readlane_f(a1, 8 * e) + p.router_b[e];
            }
            int e0 = 0; float v0 = lg[0];
#pragma unroll
            for (int e = 1; e < NE; ++e) if (lg[e] > v0) { v0 = lg[e]; e0 = e; }
            int e1 = -1; float v1 = -3.0e38f;
#pragma unroll
            for (int e = 0; e < NE; ++e) if (e != e0 && lg[e] > v1) { v1 = lg[e]; e1 = e; }
            const float ex = __expf(v1 - v0), w0 = 1.f / (1.f + ex), w1 = ex / (1.f + ex);
            if (lane == 0) { TOPE[2 * r] = e0; TOPE[2 * r + 1] = e1; TOPW[2 * r] = w0; TOPW[2 * r + 1] = w1; }
#pragma unroll
            for (int e = 0; e < NE; ++e) cnt_local[e] += (e == e0) + (e == e1);
        }
    }
    if (ROUTER) {
        LAS unsigned* lc = (LAS unsigned*)lds;
        if (tid < NE) lc[tid] = 0u;
        __syncthreads();
        if (lane == 0) {
#pragma unroll
            for (int e = 0; e < NE; ++e) if (cnt_local[e]) atomicAdd((unsigned*)(lc + e), cnt_local[e]);
        }
        __syncthreads();
        if (tid < NE && lc[tid]) atomicAdd(ctl + CW_CNT + 64 * tid, lc[tid]);
    }
}

struct GemmArgs { const bf16_t* A; const bf16_t* Bt; int M, N, K; long lda, ldb; };
template <class Epi, int AMODE, bool PAIR>
__device__ __forceinline__ void gemm_simple(const GemmArgs g, const Epi& E, const int* tok, const int* pst, size_t bstride) {
    const int tid = opaque_tid(), lane = tid & 63, wid = tid >> 6, wr = wid >> 2, wc = wid & 3, fr = lane & 15, fq = lane >> 4;
    const int ntn = g.N / 256, ntm = g.M / 128, ntiles = ntm * ntn;
    for (int tile = blockIdx.x; tile < ntiles; tile += gridDim.x) {
        const int tm = tile / ntn, tn = tile % ntn, m0 = tm * 128, n0 = tn * 256;
        const bf16_t* Bt = g.Bt;
        if (pst) { if (m0 >= pst[NE]) continue; int e = 0;
#pragma unroll
            for (int q = 1; q < NE; ++q) e += (m0 >= pst[q]); Bt += (size_t)e * bstride; }
        const bf16_t* ap[4]; const bf16_t* bp[4];
#pragma unroll
        for (int m = 0; m < 4; ++m) { const int r = m0 + wr * 64 + 16 * m + fr; const long rr = (AMODE == 1) ? (long)tok[r] : (long)r; ap[m] = g.A + rr * g.lda + 8 * fq; }
#pragma unroll
        for (int n = 0; n < 4; ++n) { const int c = n0 + (n >> 1) * 128 + wc * 32 + (n & 1) * 16 + fr; bp[n] = Bt + (long)c * g.ldb + 8 * fq; }
        f32x4 acc[4][4];
#pragma unroll
        for (int m = 0; m < 4; ++m)
#pragma unroll
            for (int n = 0; n < 4; ++n) acc[m][n] = (f32x4){0.f, 0.f, 0.f, 0.f};
        for (int k0 = 0; k0 < g.K; k0 += 32) {
            const long ka = (AMODE == 2) ? (long)(k0 >> 6) * NKV + (k0 & 63) : (long)k0;
            bf16x8 a[4], b[4];
#pragma unroll
            for (int m = 0; m < 4; ++m) a[m] = *(const bf16x8*)(ap[m] + ka);
#pragma unroll
            for (int n = 0; n < 4; ++n) b[n] = *(const bf16x8*)(bp[n] + k0);
#pragma unroll
            for (int m = 0; m < 4; ++m)
#pragma unroll
                for (int n = 0; n < 4; ++n) acc[m][n] = __builtin_amdgcn_mfma_f32_16x16x32_bf16(b[n], a[m], acc[m][n], 0, 0, 0);
        }
#pragma unroll
        for (int m = 0; m < 4; ++m) {
            const int row = m0 + wr * 64 + 16 * m + fr;
            if constexpr (PAIR) {
#pragma unroll
                for (int n = 0; n < 2; ++n) E.pair(row, tn * 128 + wc * 32 + n * 16 + 4 * fq, acc[m][n], acc[m][n + 2]);
            } else {
#pragma unroll
                for (int n = 0; n < 4; ++n) E(row, n0 + (n >> 1) * 128 + wc * 32 + (n & 1) * 16 + 4 * fq, acc[m][n]);
            }
        }
    }
}
struct EpiPool {
    const float* x; float* x1; const float* g1; const float* scale; int coff;
    __device__ __forceinline__ void operator()(int row, int col, f32x4 v) const { const int c = coff + col, b = row >> 13;
        const f32x4 xv = *(const f32x4*)(x + (size_t)row * D + c), gv = *(const f32x4*)(g1 + b * D + c), sv = *(const f32x4*)(scale + c);
        *(f32x4*)(x1 + (size_t)row * D + c) = xv + gv * (v * sv); }
};
struct EpiSwiglu {
    bf16_t* hid; int ldh;
    __device__ __forceinline__ void pair(int row, int hc, f32x4 gt, f32x4 up) const {
        u32x2 w; w.x = cvt_pk_bf16(silu_f(gt.x) * up.x, silu_f(gt.y) * up.y); w.y = cvt_pk_bf16(silu_f(gt.z) * up.z, silu_f(gt.w) * up.w);
        *(u32x2*)(hid + (size_t)row * ldh + hc) = w; }
};
struct EpiSwigluI8 {
    bf16_t* hid; int ldh; const float* asc; const float* wmax;
    __device__ __forceinline__ void pair(int row, int hc, f32x4 gt, f32x4 up) const {
        typedef int i32x4e __attribute__((ext_vector_type(4)));
        const i32x4e gi = __builtin_bit_cast(i32x4e, gt), ui = __builtin_bit_cast(i32x4e, up);
        const float ra = asc[row] * (1.f / 127.f); const f32x4 wg = *(const f32x4*)(wmax + hc) * ra, wu = *(const f32x4*)(wmax + FF + hc) * ra;
        const float g0 = (float)gi.x * wg.x, g1 = (float)gi.y * wg.y, g2 = (float)gi.z * wg.z, g3 = (float)gi.w * wg.w;
        u32x2 w; w.x = cvt_pk_bf16(silu_f(g0) * ((float)ui.x * wu.x), silu_f(g1) * ((float)ui.y * wu.y)); w.y = cvt_pk_bf16(silu_f(g2) * ((float)ui.z * wu.z), silu_f(g3) * ((float)ui.w * wu.w));
        *(u32x2*)(hid + (size_t)row * ldh + hc) = w; }
};
struct EpiSwiglu8 {
    unsigned char* hid; int ldh;
    __device__ __forceinline__ void pair(int row, int hc, f32x4 gt, f32x4 up) const {
        unsigned w = 0u; w = __builtin_amdgcn_cvt_pk_fp8_f32(silu_f(gt.x) * up.x, silu_f(gt.y) * up.y, w, false); w = __builtin_amdgcn_cvt_pk_fp8_f32(silu_f(gt.z) * up.z, silu_f(gt.w) * up.w, w, true);
        *(unsigned*)(hid + (size_t)row * ldh + hc) = w; }
};
struct EpiResid {
    const float* xin; float* out; const float* gate;
    __device__ __forceinline__ void operator()(int row, int col, f32x4 v) const { const int b = row >> 13;
        const f32x4 xv = *(const f32x4*)(xin + (size_t)row * D + col), gv = *(const f32x4*)(gate + b * D + col);
        *(f32x4*)(out + (size_t)row * D + col) = xv + gv * v; }
};
struct EpiBf16 {
    bf16_t* o; int ldo;
    __device__ __forceinline__ void operator()(int row, int col, f32x4 v) const { u32x2 w; w.x = cvt_pk_bf16(v.x, v.y); w.y = cvt_pk_bf16(v.z, v.w); *(u32x2*)(o + (size_t)row * ldo + col) = w; }
};
struct EpiQ {
    bf16_t* q; float* gates; int coff;
    __device__ __forceinline__ void operator()(int row, int col_, f32x4 v) const { const int col = col_ + coff;
        if (col < D) { u32x2 w; w.x = cvt_pk_bf16(v.x, v.y); w.y = cvt_pk_bf16(v.z, v.w); *(u32x2*)(q + (size_t)row * D + col) = w; }
        else if (col < NQ) { f32x4 s; s.x = sigmoid_f(v.x); s.y = sigmoid_f(v.y); s.z = sigmoid_f(v.z); s.w = sigmoid_f(v.w); *(f32x4*)(gates + (size_t)row * 48 + (col - D)) = s; } }
};
struct EpiCmp {
    bf16_t* o; const float* bias;
    __device__ __forceinline__ void operator()(int row, int col, f32x4 v) const { const int z = col >> 8, c = col & 255; const f32x4 bv = *(const f32x4*)(bias + (z >> 2) * 256 + c);
        u32x2 w; w.x = cvt_pk_bf16(gelu_tanh_f(v.x + bv.x), gelu_tanh_f(v.y + bv.y)); w.y = cvt_pk_bf16(gelu_tanh_f(v.z + bv.z), gelu_tanh_f(v.w + bv.w));
        *(u32x2*)(o + ((size_t)z * 2048 + row) * 256 + c) = w; }
};


namespace pg8 {
#define PG8_LAS __attribute__((address_space(3)))
constexpr int BM = 256, BK = 64, HALF = 128, HTB = HALF * BK * 2, STAGE_BYTES = 8 * HTB, NXCD = 8, WGM = 8;
__host__ __device__ __forceinline__ int lds_byte(int r, int c) { const int st = (r >> 4) * 2 + (c >> 5), rr = r & 15, cc = c & 31, ob = rr * 64 + cc * 2; return st * 1024 + (ob ^ (((ob >> 9) & 1) << 5)); }
__host__ __device__ __forceinline__ void stage_rc(int b, int& R, int& C) { const int st = b / 1024, sb = b % 1024, swz = sb ^ (((sb >> 9) & 1) << 5); R = (st >> 1) * 16 + swz / 64; C = (st & 1) * 32 + (swz % 64) / 2; }
__host__ __device__ __forceinline__ int perm32(int rho) { const int n = rho >> 4, i = rho & 15; return 8 * (i >> 2) + 4 * n + (i & 3); }
struct Unit { int pm, pn; };
template <int SMODE> struct Sched {
    int nM, nN, nwg, G, c; const char* A; const char* Bt; size_t lda2, ldb2; const int* pst; size_t bstride2;
    __device__ __forceinline__ void init(int M, int N, int G_, int c_, const void* A_, const void* Bt_, int lda, int ldb, const int* pst_ = nullptr, size_t bstride = 0) {
        nM = M / BM; nN = N / BM; nwg = nM * nN; G = G_; c = c_; A = (const char*)A_; Bt = (const char*)Bt_; lda2 = (size_t)lda * 2; ldb2 = (size_t)ldb * 2; pst = pst_; bstride2 = bstride * 2; }
    __device__ __forceinline__ bool next(int i, Unit& u) const {
        if (c < 0) return false;
        const long L = (long)i * G + c; if (L >= nwg) return false;
        int wgid = (int)L; { const int q = nwg / NXCD, r = nwg % NXCD, xcd = wgid % NXCD, off = wgid / NXCD; wgid = (xcd < r ? xcd * (q + 1) : r * (q + 1) + (xcd - r) * q) + off; }
        const int nig = WGM * nN, gid = wgid / nig, fm = gid * WGM, gsz = (nM - fm) < WGM ? (nM - fm) : WGM;
        u.pm = fm + ((wgid % nig) % gsz); u.pn = (wgid % nig) / gsz; return true;
    }
    __device__ __forceinline__ const char* a_ptr(const Unit& u) const {
        if (SMODE == 1) return A + (size_t)u.pm * BM * lda2 + (size_t)u.pn * 512;
        if (SMODE == 2) return A + (size_t)u.pm * BM * lda2 + (size_t)((u.pn >> 2) * 256 + (u.pn & 3) * 64) * 2;
        return A + (size_t)u.pm * BM * lda2; }
    __device__ __forceinline__ const char* b_ptr(const Unit& u) const {
        if (SMODE == 2) return Bt + (size_t)(u.pn >> 2) * BM * ldb2;
        if (SMODE == 3) { const int m0 = u.pm * BM; int e = 0;
#pragma unroll
            for (int q = 1; q < NE; ++q) e += (m0 >= pst[q]); return Bt + (size_t)e * bstride2 + (size_t)u.pn * BM * ldb2; }
        return Bt + (size_t)u.pn * BM * ldb2; }
};
template <class F> struct EpiEl { static constexpr bool PERM = false, AFTER_DRAIN = false; F f;
    __device__ __forceinline__ void operator()(const f32x4 (&acc)[2][2][4][2], const Unit& u, int wr, int wc, int fr, int fq) const {
#pragma unroll
        for (int ai = 0; ai < 2; ++ai)
#pragma unroll
            for (int m = 0; m < 4; ++m) { const int row = u.pm * BM + ai * HALF + wr * 64 + m * 16 + fr;
#pragma unroll
                for (int bj = 0; bj < 2; ++bj)
#pragma unroll
                    for (int n = 0; n < 2; ++n) f(row, u.pn * BM + bj * HALF + wc * 32 + n * 16 + 4 * fq, acc[ai][bj][m][n]); } } };
template <class F> struct EpiPairEl { static constexpr bool PERM = false, AFTER_DRAIN = false; F f;
    __device__ __forceinline__ void operator()(const f32x4 (&acc)[2][2][4][2], const Unit& u, int wr, int wc, int fr, int fq) const {
#pragma unroll
        for (int ai = 0; ai < 2; ++ai)
#pragma unroll
            for (int m = 0; m < 4; ++m) { const int row = u.pm * BM + ai * HALF + wr * 64 + m * 16 + fr;
#pragma unroll
                for (int n = 0; n < 2; ++n) f.pair(row, u.pn * HALF + wc * 32 + n * 16 + 4 * fq, acc[ai][0][m][n], acc[ai][1][m][n]); } } };

typedef int i32x8 __attribute__((ext_vector_type(8)));
template <int QM> __device__ __forceinline__ void mma_block(f32x4 (&acc)[4][2], const bf16x8 (&At)[4][2], const bf16x8 (&Bt)[2][2], const int wsc) {
    __builtin_amdgcn_s_setprio(1);
    if constexpr (QM == 2) {
        typedef int i32x4m __attribute__((ext_vector_type(4)));
#pragma unroll
        for (int m = 0; m < 4; ++m)
#pragma unroll
            for (int n = 0; n < 2; ++n)
#pragma unroll
                for (int k = 0; k < 2; ++k) acc[m][n] = __builtin_bit_cast(f32x4, __builtin_amdgcn_mfma_i32_16x16x64_i8(__builtin_bit_cast(i32x4m, Bt[n][k]), __builtin_bit_cast(i32x4m, At[m][k]), __builtin_bit_cast(i32x4m, acc[m][n]), 0, 0, 0));
#pragma unroll
        for (int m = 0; m < 4; ++m) asm volatile("" : "+v"(acc[m][0]), "+v"(acc[m][1]));
    } else if constexpr (QM == 1) {
#pragma unroll
        for (int m = 0; m < 4; ++m) { const u32x4 a0 = __builtin_bit_cast(u32x4, At[m][0]), a1 = __builtin_bit_cast(u32x4, At[m][1]);
            const i32x8 a8 = {(int)a0.x, (int)a0.y, (int)a0.z, (int)a0.w, (int)a1.x, (int)a1.y, (int)a1.z, (int)a1.w};
#pragma unroll
            for (int n = 0; n < 2; ++n) { const u32x4 b0 = __builtin_bit_cast(u32x4, Bt[n][0]), b1 = __builtin_bit_cast(u32x4, Bt[n][1]);
                const i32x8 b8 = {(int)b0.x, (int)b0.y, (int)b0.z, (int)b0.w, (int)b1.x, (int)b1.y, (int)b1.z, (int)b1.w};
                acc[m][n] = __builtin_amdgcn_mfma_scale_f32_16x16x128_f8f6f4(b8, a8, acc[m][n], 0, 0, 0, wsc, 0, 127); } }
#pragma unroll
        for (int m = 0; m < 4; ++m) asm volatile("" : "+v"(acc[m][0]), "+v"(acc[m][1]));
    } else {
#pragma unroll
        for (int m = 0; m < 4; ++m)
#pragma unroll
            for (int n = 0; n < 2; ++n)
#pragma unroll
                for (int k = 0; k < 2; ++k) acc[m][n] = __builtin_amdgcn_mfma_f32_16x16x32_bf16(Bt[n][k], At[m][k], acc[m][n], 0, 0, 0);
    }
    __builtin_amdgcn_s_setprio(0);
}
template <class Epi, class Sched, bool ALIGN_EPI = true, bool SP2 = true, int QM = 0>
__device__ __forceinline__ void gemm_phase(PG8_LAS unsigned char* lds, const int K, const int lda, const int ldb, const size_t kstepA, const Sched& S, const Epi& E, const int wsc = 127) {
    const int tid_ = opaque_tid();
    const int tid = tid_, wid = __builtin_amdgcn_readfirstlane(tid >> 6), lane = tid & 63, wr = wid >> 2, wc = wid & 3, fr = lane & 15, fq = lane >> 4;
    const int nt = K / BK;
    unsigned voffA[2], voffB[2];
#pragma unroll
    for (int i = 0; i < 2; ++i) { int R, C; stage_rc(tid * 16 + i * 8192, R, C); const int Rb = Epi::PERM ? ((R & ~31) + perm32(R & 31)) : R;
        voffA[i] = (unsigned)(R * lda + C) * 2u; voffB[i] = (unsigned)(Rb * ldb + C) * 2u; }
    const size_t kstepB = (size_t)(BK * 2);
    const size_t hstepA = (size_t)HALF * lda * 2, hstepB = (size_t)HALF * ldb * 2;
    const unsigned ldsw = (unsigned)wid * 1024u;
    int aoffk[2], boffk[2];
#pragma unroll
    for (int k = 0; k < 2; ++k) { const int col = (QM == 1) ? ((fq >> 1) * 32 + (fq & 1) * 16 + 8 * k) : (k * 32 + fq * 8); aoffk[k] = lds_byte(wr * 64 + fr, col); boffk[k] = lds_byte(wc * 32 + fr, col); }
#define PG8_SA(b, h) (((b) * 2 + (h)) * HTB)
#define PG8_SB(b, h) ((4 + (b) * 2 + (h)) * HTB)
#define PG8_STAGE(bufoff, gbase, voff) do { _Pragma("unroll") for (int _i = 0; _i < 2; ++_i) \
        __builtin_amdgcn_global_load_lds((const unsigned*)((const char*)(gbase) + (voff)[_i]), (PG8_LAS unsigned*)(lds + (bufoff) + ldsw + _i * 8192), 16, 0, 0); } while (0)
#define PG8_LDA(dst, b, h) do { _Pragma("unroll") for (int m = 0; m < 4; ++m) _Pragma("unroll") for (int k = 0; k < 2; ++k) dst[m][k] = *(const PG8_LAS bf16x8*)(lds + PG8_SA(b, h) + ((QM == 1) ? aoffk[k] : aoffk[0] + k * 1024) + m * 2048); } while (0)
#define PG8_LDB(dst, b, h) do { _Pragma("unroll") for (int n = 0; n < 2; ++n) _Pragma("unroll") for (int k = 0; k < 2; ++k) dst[n][k] = *(const PG8_LAS bf16x8*)(lds + PG8_SB(b, h) + ((QM == 1) ? boffk[k] : boffk[0] + k * 1024) + n * 2048); } while (0)
#define PG8_MMA(ai, bj, At, Bt) mma_block<QM>(acc[ai][bj], At, Bt, wsc)
#define PG8_WAIT_V(n) asm volatile("s_waitcnt vmcnt(" #n ")" ::: "memory")
#define PG8_WAIT_L(n) asm volatile("s_waitcnt lgkmcnt(" #n ")" ::: "memory")
#define PG8_BAR __builtin_amdgcn_s_barrier()
#define PG8_SCHED __builtin_amdgcn_sched_barrier(0)
    Unit cur, nxt; int ui = 0;
    if (!S.next(0, cur)) return;
    f32x4 acc[2][2][4][2];
#pragma unroll
    for (int a = 0; a < 2; ++a)
#pragma unroll
        for (int b = 0; b < 2; ++b)
#pragma unroll
            for (int m = 0; m < 4; ++m)
#pragma unroll
                for (int n = 0; n < 2; ++n) acc[a][b][m][n] = (f32x4){0.f, 0.f, 0.f, 0.f};
    bf16x8 At[4][2], B0[2][2], B1[2][2];
    const char* cA = S.a_ptr(cur); const char* cB = S.b_ptr(cur);
    if constexpr (SP2) {
        PG8_STAGE(PG8_SB(0, 0), cB, voffB); PG8_STAGE(PG8_SB(0, 1), cB + hstepB, voffB); PG8_STAGE(PG8_SA(0, 0), cA, voffA); PG8_STAGE(PG8_SA(0, 1), cA + hstepA, voffA);
        if (wr == 1) PG8_BAR;
        PG8_WAIT_V(2); PG8_BAR;
        PG8_STAGE(PG8_SB(1, 0), cB + kstepB, voffB); PG8_STAGE(PG8_SA(1, 0), cA + kstepA, voffA); PG8_STAGE(PG8_SB(1, 1), cB + hstepB + kstepB, voffB);
        PG8_WAIT_V(6); PG8_BAR;
    } else {
        PG8_STAGE(PG8_SB(0, 0), cB, voffB); PG8_STAGE(PG8_SA(0, 0), cA, voffA); PG8_STAGE(PG8_SB(0, 1), cB + hstepB, voffB); PG8_STAGE(PG8_SA(0, 1), cA + hstepA, voffA);
        if (wr == 1) PG8_BAR;
        PG8_WAIT_V(4); PG8_BAR;
        PG8_STAGE(PG8_SB(1, 0), cB + kstepB, voffB); PG8_STAGE(PG8_SA(1, 0), cA + kstepA, voffA); PG8_STAGE(PG8_SB(1, 1), cB + hstepB + kstepB, voffB);
        PG8_WAIT_V(6); PG8_BAR;
    }
    for (;;) {
        const bool has_next = S.next(ui + 1, nxt);
        const char* nA = has_next ? S.a_ptr(nxt) : cA; const char* nB = has_next ? S.b_ptr(nxt) : cB;
        for (int t = 0; t < nt; t += 2) {
            const bool last = (t == nt - 2);
            const char* a1 = cA + (size_t)(t + 1) * kstepA;
            const char* a2 = last ? nA : cA + (size_t)(t + 2) * kstepA; const char* b2 = last ? nB : cB + (size_t)(t + 2) * kstepB;
            const char* a3 = a2 + kstepA; const char* b3 = b2 + kstepB;
            if constexpr (SP2) {
            PG8_LDB(B0, 0, 0); PG8_LDB(B1, 0, 1); PG8_SCHED; PG8_LDA(At, 0, 0); PG8_STAGE(PG8_SA(1, 1), a1 + hstepA, voffA);
            PG8_WAIT_V(8); PG8_WAIT_L(0); PG8_BAR; PG8_MMA(0, 0, At, B0); PG8_MMA(0, 1, At, B1); PG8_BAR; PG8_SCHED;
            PG8_LDA(At, 0, 1); PG8_STAGE(PG8_SB(0, 0), b2, voffB); PG8_STAGE(PG8_SB(0, 1), b2 + hstepB, voffB); PG8_STAGE(PG8_SA(0, 0), a2, voffA);
            PG8_WAIT_V(8); PG8_WAIT_L(0); PG8_BAR; PG8_MMA(1, 0, At, B0); PG8_MMA(1, 1, At, B1); PG8_BAR; PG8_SCHED;
            PG8_LDB(B0, 1, 0); PG8_LDB(B1, 1, 1); PG8_SCHED; PG8_LDA(At, 1, 0); PG8_STAGE(PG8_SA(0, 1), a2 + hstepA, voffA);
            PG8_WAIT_V(8); PG8_WAIT_L(0); PG8_BAR; PG8_MMA(0, 0, At, B0); PG8_MMA(0, 1, At, B1); PG8_BAR; PG8_SCHED;
            PG8_LDA(At, 1, 1); PG8_STAGE(PG8_SB(1, 0), b3, voffB); PG8_STAGE(PG8_SB(1, 1), b3 + hstepB, voffB); PG8_STAGE(PG8_SA(1, 0), a3, voffA);
            PG8_WAIT_V(8); PG8_WAIT_L(0); PG8_BAR; PG8_MMA(1, 0, At, B0); PG8_MMA(1, 1, At, B1); PG8_BAR; PG8_SCHED;
            } else {
            PG8_LDB(B0, 0, 0); PG8_SCHED; PG8_LDA(At, 0, 0); PG8_STAGE(PG8_SA(1, 1), a1 + hstepA, voffA);
            PG8_WAIT_L(8); PG8_BAR; PG8_WAIT_L(0); PG8_MMA(0, 0, At, B0); PG8_BAR; PG8_SCHED;
            PG8_LDB(B1, 0, 1); PG8_STAGE(PG8_SB(0, 0), b2, voffB);
            PG8_BAR; PG8_WAIT_L(0); PG8_MMA(0, 1, At, B1); PG8_BAR;
            PG8_LDA(At, 0, 1); PG8_STAGE(PG8_SA(0, 0), a2, voffA);
            PG8_BAR; PG8_WAIT_L(0); PG8_MMA(1, 0, At, B0); PG8_BAR; PG8_SCHED;
            PG8_STAGE(PG8_SB(0, 1), b2 + hstepB, voffB);
            PG8_WAIT_V(6); PG8_BAR; PG8_MMA(1, 1, At, B1); PG8_BAR;
            PG8_LDB(B0, 1, 0); PG8_SCHED; PG8_LDA(At, 1, 0); PG8_STAGE(PG8_SA(0, 1), a2 + hstepA, voffA);
            PG8_WAIT_L(8); PG8_BAR; PG8_WAIT_L(0); PG8_MMA(0, 0, At, B0); PG8_BAR; PG8_SCHED;
            PG8_LDB(B1, 1, 1); PG8_STAGE(PG8_SB(1, 0), b3, voffB);
            PG8_BAR; PG8_WAIT_L(0); PG8_MMA(0, 1, At, B1); PG8_BAR;
            PG8_LDA(At, 1, 1); PG8_STAGE(PG8_SA(1, 0), a3, voffA);
            PG8_BAR; PG8_WAIT_L(0); PG8_MMA(1, 0, At, B0); PG8_BAR; PG8_SCHED;
            PG8_STAGE(PG8_SB(1, 1), b3 + hstepB, voffB);
            PG8_WAIT_V(6); PG8_BAR; PG8_MMA(1, 1, At, B1); PG8_BAR;
            }
        }
        if constexpr (ALIGN_EPI) { if (wr == 0) PG8_BAR; }
        if constexpr (!Epi::AFTER_DRAIN) { E(acc, cur, wr, wc, fr, fq); }
        if (!has_next) break;
#pragma unroll
        for (int a = 0; a < 2; ++a)
#pragma unroll
            for (int b = 0; b < 2; ++b)
#pragma unroll
                for (int m = 0; m < 4; ++m)
#pragma unroll
                    for (int n = 0; n < 2; ++n) acc[a][b][m][n] = (f32x4){0.f, 0.f, 0.f, 0.f};
        cur = nxt; cA = nA; cB = nB; ++ui;
        if constexpr (ALIGN_EPI) { if (wr == 1) PG8_BAR; }
    }
    PG8_WAIT_V(0);
    if constexpr (!ALIGN_EPI) { if (wr == 0) PG8_BAR; }
    PG8_BAR;
    if constexpr (Epi::AFTER_DRAIN) { E.fused(acc, cur, wr, wc, fr, fq, lds, wid, lane); }
#undef PG8_SA
#undef PG8_SB
#undef PG8_STAGE
#undef PG8_LDA
#undef PG8_LDB
#undef PG8_MMA
#undef PG8_WAIT_V
#undef PG8_WAIT_L
#undef PG8_BAR
#undef PG8_SCHED
}
}

__device__ __forceinline__ void phase_headnorm(const Params& p, LAS unsigned char* lds) {
    const int tid = opaque_tid(), lane = tid & 63, wave = tid >> 6;
    LAS int* chunk = (LAS int*)(lds + 131072 - 64);
    bf16_t* Q = (bf16_t*)(p.ws + WS_Q); bf16_t* KVB = (bf16_t*)(p.ws + WS_KVB);
    float qg[16], kg[8];
#pragma unroll
    for (int i = 0; i < 16; ++i) qg[i] = p.q_gain[(lane & 3) * 16 + i] * (0.125f * 1.4426950408889634f);
    const float qs8 = sel_q_scale(p.q_gain), ks8 = sel_k_scale(p.k_gain);
    const int kr = lane >> 5;
#pragma unroll
    for (int i = 0; i < 8; ++i) kg[i] = p.k_gain[(1 + kr) * 64 + (lane & 7) * 8 + i];
    for (;;) {
      if (tid == 0) *chunk = (int)atomicAdd((unsigned*)(p.ws + WS_CTL) + CW_HN, 1u);
      __syncthreads();
      const int c0 = *chunk;
      __syncthreads();
      if (c0 >= T / 128) break;
      for (int r = c0 * 128 + wave * 16; r < c0 * 128 + wave * 16 + 16; ++r) {
        {
            u32x4* ptr = (u32x4*)(Q + (size_t)r * D + lane * 16); u32x4 w0 = ptr[0], w1 = ptr[1];
            float v[16]; const unsigned ww[8] = {w0.x, w0.y, w0.z, w0.w, w1.x, w1.y, w1.z, w1.w}; float s = 0.f;
#pragma unroll
            for (int i = 0; i < 8; ++i) { v[2 * i] = bflo(ww[i]); v[2 * i + 1] = bfhi(ww[i]); s += v[2 * i] * v[2 * i] + v[2 * i + 1] * v[2 * i + 1]; }
            s += __shfl_xor(s, 1); s += __shfl_xor(s, 2);
            const float rstd = 1.f / sqrtf(s * (1.f / 64.f) + EPS);
            unsigned o[8];
#pragma unroll
            for (int i = 0; i < 8; ++i) o[i] = cvt_pk_bf16(v[2 * i] * rstd * qg[2 * i], v[2 * i + 1] * rstd * qg[2 * i + 1]);
            ptr[0] = (u32x4){o[0], o[1], o[2], o[3]}; ptr[1] = (u32x4){o[4], o[5], o[6], o[7]};
            float qv[16];
#pragma unroll
            for (int i = 0; i < 16; ++i) qv[i] = v[i] * rstd * qg[i] * qs8;
            *(u32x4*)(p.ws + WS_Q8 + (size_t)r * D + lane * 16) = (u32x4){pack_i8x4(qv[0], qv[1], qv[2], qv[3]), pack_i8x4(qv[4], qv[5], qv[6], qv[7]), pack_i8x4(qv[8], qv[9], qv[10], qv[11]), pack_i8x4(qv[12], qv[13], qv[14], qv[15])};
        }
        {
            const u32x4* ptr = (const u32x4*)(KVB + (size_t)r * NKV + (kr ? 1024 : 512) + (lane & 31) * 8); const u32x4 w0 = ptr[0];
            float v[8]; const unsigned ww[4] = {w0.x, w0.y, w0.z, w0.w}; float s = 0.f;
#pragma unroll
            for (int i = 0; i < 4; ++i) { v[2 * i] = bflo(ww[i]); v[2 * i + 1] = bfhi(ww[i]); s += v[2 * i] * v[2 * i] + v[2 * i + 1] * v[2 * i + 1]; }
            s += __shfl_xor(s, 1); s += __shfl_xor(s, 2); s += __shfl_xor(s, 4);
            const float rstd = 1.f / sqrtf(s * (1.f / 64.f) + EPS);
            unsigned o[4];
#pragma unroll
            for (int i = 0; i < 4; ++i) o[i] = cvt_pk_bf16(v[2 * i] * rstd * kg[2 * i], v[2 * i + 1] * rstd * kg[2 * i + 1]);
            const int b = r >> 13, t = r & (S - 1), hg = (lane & 31) >> 3, c = lane & 7;
            if (kr) {
                bf16_t* dst = (bf16_t*)(p.ws + WS_KWB) + ((size_t)((b * 4 + hg) * 128 + (t >> 6)) * 8 + c) * 512 + (t & 63) * 8;
                *(u32x4*)dst = (u32x4){o[0], o[1], o[2], o[3]};
            } else {
                const float ksc = rstd * ks8;
                const unsigned w0 = pack_i8x4(v[0] * ksc * kg[0], v[1] * ksc * kg[1], v[2] * ksc * kg[2], v[3] * ksc * kg[3]);
                const unsigned w1 = pack_i8x4(v[4] * ksc * kg[4], v[5] * ksc * kg[5], v[6] * ksc * kg[6], v[7] * ksc * kg[7]);
                unsigned char* dst = p.ws + WS_KSB + ((size_t)((b * 4 + hg) * 128 + (t >> 6)) * 4 + (c >> 1)) * 1024 + (t & 63) * 16 + (c & 1) * 8;
                *(u32x2*)dst = (u32x2){w0, w1};
            }
        }
      }
    }
}

__device__ __forceinline__ void phase_cmp2(const Params& p, LAS unsigned char* lds) {
    const int tid = opaque_tid(), lane = tid & 63, wave = tid >> 6;
    const int gw = blockIdx.x * NWAVE + wave, NGW = gridDim.x * NWAVE;
    const bf16_t* CMPH = (const bf16_t*)(p.ws + WS_CMPH);
    LAS float* w2l = (LAS float*)lds;
    for (int kv = 0; kv < 2; ++kv) {
        const float* w2 = kv ? p.cmp_v_w2 : p.cmp_k_w2;
        for (int i = tid; i < 256 * 64 / 4; i += NTHR) ((LAS f32x4*)w2l)[i] = ((const f32x4*)w2)[i];
        __syncthreads();
        for (int it = gw * 2; it < 4 * 2048; it += NGW * 2) {
            float hv[2][4], acc[2] = {0.f, 0.f};
#pragma unroll
            for (int rr = 0; rr < 2; ++rr) { const u32x2 w = *(const u32x2*)(CMPH + (size_t)(kv * 8192 + it + rr) * 256 + 4 * lane); hv[rr][0] = bflo(w.x); hv[rr][1] = bfhi(w.x); hv[rr][2] = bflo(w.y); hv[rr][3] = bfhi(w.y); }
#pragma unroll 4
            for (int kk = 0; kk < 64; ++kk)
#pragma unroll
                for (int c = 0; c < 4; ++c) { const float wv = w2l[(4 * kk + c) * 64 + lane];
                    acc[0] += readlane_f(hv[0][c], kk) * wv; acc[1] += readlane_f(hv[1][c], kk) * wv; }
#pragma unroll
            for (int rr = 0; rr < 2; ++rr) {
                const int row = it + rr, g = (row >> 11) & 3, r2 = row & 2047, b = r2 >> 9, n = r2 & 511; float a = n == NC - 1 ? 0.f : acc[rr];
                if (kv == 0) { const float ss = wave_sum(a * a); a = a * (1.f / sqrtf(ss * (1.f / 64.f) + EPS)) * p.k_gain[lane]; }
                const size_t blk0 = (size_t)((b * 4 + g) * 8 + (n >> 6)) * 4096;
                bf16_t* o = kv ? (bf16_t*)(p.ws + WS_VC) + blk0 + ((n & 63) >> 3) * 512 + lane * 8 + (n & 7)
                               : (bf16_t*)(p.ws + WS_KC) + blk0 + (lane >> 3) * 512 + (n & 63) * 8 + (lane & 7);
                *o = (bf16_t)(cvt_pk_bf16(a, 0.f) & 0xffffu);
            }
        }
        __syncthreads();
    }
}

__device__ __forceinline__ float dot64(const float (&q)[64], const bf16_t* krow) {
    const u32x4* kp = (const u32x4*)krow; float s = 0.f;
#pragma unroll
    for (int i = 0; i < 8; ++i) { const u32x4 w = kp[i];
        s += q[8 * i + 0] * bflo(w.x) + q[8 * i + 1] * bfhi(w.x) + q[8 * i + 2] * bflo(w.y) + q[8 * i + 3] * bfhi(w.y)
           + q[8 * i + 4] * bflo(w.z) + q[8 * i + 5] * bfhi(w.z) + q[8 * i + 6] * bflo(w.w) + q[8 * i + 7] * bfhi(w.w); }
    return s;
}
__device__ __forceinline__ void phase_attn_naive(const Params& p, LAS unsigned char* lds, bf16_t* AO) {
    const int tid = opaque_tid(), lane = tid & 63, wave = tid >> 6, g = wave >> 1;
    LAS float* sc = (LAS float*)lds + wave * 1024;
    LAS float* pc = (LAS float*)(lds + 32768);
    LAS float* hb = (LAS float*)(lds + 65536);
    LAS unsigned char* lut = lds + 65536 + 2048;
    for (int i = tid; i < 512; i += NTHR) hb[i] = p.rel_bias[(i & 31) * NH + (i >> 5)];
    for (int i = tid; i < 1024; i += NTHR) lut[i] = (unsigned char)rel_bucket(i);
    __syncthreads();
    const bf16_t* Q = (const bf16_t*)(p.ws + WS_Q); const bf16_t* KVB = (const bf16_t*)(p.ws + WS_KVB);
    const bf16_t* KC = (const bf16_t*)(p.ws + WS_KC); const bf16_t* VC = (const bf16_t*)(p.ws + WS_VC);
    const float* GATE = (const float*)(p.ws + WS_GATE);
    for (int u = blockIdx.x; u < T; u += gridDim.x) {
        const int b = u >> 13, t = u & (S - 1);
        const int ncv = t >= 31 ? ((t - 31) >> 4) + 1 : 0;
        const bf16_t* kc = KC + (size_t)(b * 4 + g) * NC * 64; const bf16_t* vc = VC + (size_t)(b * 4 + g) * NC * 64;
        float oc[2], os[2], ow[2];
        for (int hh = 0; hh < 2; ++hh) {
            const int head = wave * 2 + hh;
            float q[64];
            { const u32x4* qp = (const u32x4*)(Q + (size_t)u * D + head * 64);
#pragma unroll
                for (int i = 0; i < 8; ++i) { const u32x4 w = qp[i]; q[8 * i] = bflo(w.x); q[8 * i + 1] = bfhi(w.x); q[8 * i + 2] = bflo(w.y); q[8 * i + 3] = bfhi(w.y); q[8 * i + 4] = bflo(w.z); q[8 * i + 5] = bfhi(w.z); q[8 * i + 6] = bflo(w.w); q[8 * i + 7] = bfhi(w.w); }
#pragma unroll
                for (int i = 0; i < 64; ++i) q[i] *= 0.6931471805599453f; }
            float mx = -3.0e38f;
            for (int kk = lane; kk < ncv; kk += 64) { const int dist = t - (16 * kk + 31); const float s = dot64(q, kc + (size_t)kk * 64) + hb[head * 32 + lut[dist < 1023 ? dist : 1023]]; sc[kk] = s; mx = fmaxf(mx, s); }
            mx = wave_max(mx); float sum = 0.f;
            for (int kk = lane; kk < ncv; kk += 64) { const float e = __expf(sc[kk] - mx); sc[kk] = e; sum += e; }
            sum = wave_sum(sum); const float inv = ncv > 0 ? 1.f / sum : 0.f;
            for (int kk = lane; kk < NC; kk += 64) { const float pv = kk < ncv ? sc[kk] * inv : 0.f; pc[head * 512 + kk] = pv; }
            asm volatile("s_waitcnt lgkmcnt(0)" ::: "memory");
            float o = 0.f;
            for (int kk = 0; kk < ncv; ++kk) o += pc[head * 512 + kk] * bf2f(vc[(size_t)kk * 64 + lane]);
            oc[hh] = o;
        }
        __syncthreads();
        LAS int* sel = (LAS int*)(lds + 65536 + 4096) + wave * NSEL;
        {
            const int cur = t >> 6; float cs[2];
#pragma unroll
            for (int h2 = 0; h2 < 2; ++h2) { const int j = lane + 64 * h2; float ps = 0.f;
#pragma unroll
                for (int k = 0; k < 5; ++k) { const int c = 4 * j + k - 1; if (c >= 0 && c < ncv) { const float wk = (k == 0 || k == 4) ? 1.f : 2.f;
                    ps += wk * (((pc[(4 * g + 0) * 512 + c] + pc[(4 * g + 1) * 512 + c]) + pc[(4 * g + 2) * 512 + c]) + pc[(4 * g + 3) * 512 + c]); } }
                const bool forced = (j == 0) || (j == cur) || (j == cur - 1), valid = j * 64 <= t;
                cs[h2] = forced ? 1.0e6f : (valid ? ps : -1.0e6f); }
#pragma unroll
            for (int i = 0; i < NSEL; ++i) {
                float bv; int bi;
                if (cs[0] >= cs[1]) { bv = cs[0]; bi = lane; } else { bv = cs[1]; bi = lane + 64; }
#pragma unroll
                for (int o = 1; o < 64; o <<= 1) { const float ov = __shfl_xor(bv, o); const int oi = __shfl_xor(bi, o); if (ov > bv || (ov == bv && oi < bi)) { bv = ov; bi = oi; } }
                if (lane == 0) sel[i] = bi;
                if (bi == lane) cs[0] = -3.0e38f;
                if (bi == lane + 64) cs[1] = -3.0e38f;
            }
        }
        for (int hh = 0; hh < 2; ++hh) {
            const int head = wave * 2 + hh;
            float q[64];
            { const u32x4* qp = (const u32x4*)(Q + (size_t)u * D + head * 64);
#pragma unroll
                for (int i = 0; i < 8; ++i) { const u32x4 w = qp[i]; q[8 * i] = bflo(w.x); q[8 * i + 1] = bfhi(w.x); q[8 * i + 2] = bflo(w.y); q[8 * i + 3] = bfhi(w.y); q[8 * i + 4] = bflo(w.z); q[8 * i + 5] = bfhi(w.z); q[8 * i + 6] = bflo(w.w); q[8 * i + 7] = bfhi(w.w); }
#pragma unroll
                for (int i = 0; i < 64; ++i) q[i] *= 0.6931471805599453f; }
            const bf16_t* kvb = KVB + (size_t)b * S * NKV + g * 64;
            {
                float mx = -3.0e38f;
#pragma unroll
                for (int i = 0; i < NSEL; ++i) { const int pos = sel[i] * 64 + lane; float s = -3.0e38f;
                    if (pos <= t) { const int dist = t - pos; s = dot64(q, kvb + (size_t)pos * NKV + 512) + hb[head * 32 + lut[dist < 1023 ? dist : 1023]]; }
                    sc[i * 64 + lane] = s; mx = fmaxf(mx, s); }
                mx = wave_max(mx); float sum = 0.f;
#pragma unroll
                for (int i = 0; i < NSEL; ++i) { const float s = sc[i * 64 + lane]; const float e = s > -1.0e38f ? __expf(s - mx) : 0.f; sc[i * 64 + lane] = e; sum += e; }
                sum = wave_sum(sum); const float inv = 1.f / sum;
                asm volatile("s_waitcnt lgkmcnt(0)" ::: "memory");
                float o = 0.f;
#pragma unroll 1
                for (int i = 0; i < NSEL; ++i) { const int pos0 = sel[i] * 64; if (pos0 > t) continue; const int nk = (t - pos0 + 1 < 64) ? t - pos0 + 1 : 64;
                    for (int l = 0; l < nk; ++l) o += sc[i * 64 + l] * bf2f(kvb[(size_t)(pos0 + l) * NKV + 768 + lane]); }
                os[hh] = o * inv;
            }
            {
                float mx = -3.0e38f;
#pragma unroll
                for (int i = 0; i < 8; ++i) { const int pos = t - 511 + i * 64 + lane; float s = -3.0e38f;
                    if (pos >= 0) { const int dist = t - pos; s = dot64(q, kvb + (size_t)pos * NKV + 1024) + hb[head * 32 + lut[dist]]; }
                    sc[i * 64 + lane] = s; mx = fmaxf(mx, s); }
                mx = wave_max(mx); float sum = 0.f;
#pragma unroll
                for (int i = 0; i < 8; ++i) { const float s = sc[i * 64 + lane]; const float e = s > -1.0e38f ? __expf(s - mx) : 0.f; sc[i * 64 + lane] = e; sum += e; }
                sum = wave_sum(sum); const float inv = 1.f / sum;
                asm volatile("s_waitcnt lgkmcnt(0)" ::: "memory");
                float o = 0.f; const int p0 = t - 511 > 0 ? t - 511 : 0;
                for (int pos = p0; pos <= t; ++pos) o += sc[pos - (t - 511)] * bf2f(kvb[(size_t)pos * NKV + 1280 + lane]);
                ow[hh] = o * inv;
            }
            const float* gt = GATE + (size_t)u * 48 + head * 3;
            const float r = gt[0] * oc[hh] + gt[1] * os[hh] + gt[2] * ow[hh];
            AO[(size_t)u * D + head * 64 + lane] = (bf16_t)(cvt_pk_bf16(r, 0.f) & 0xffffu);
        }
        __syncthreads();
    }
}

__device__ __forceinline__ void phase_vtrans(const Params& p, LAS unsigned char* lds) {
    const int tid = opaque_tid(), lane = tid & 63, wave = tid >> 6;
    const int gw = blockIdx.x * NWAVE + wave, NGW = gridDim.x * NWAVE;
    LAS unsigned short* tile = (LAS unsigned short*)(lds + wave * 8448);
    const bf16_t* KVB = (const bf16_t*)(p.ws + WS_KVB);
    LAS int* chunk = (LAS int*)(lds + 131072 - 64);
    for (;;) {
        if (tid == 0) *chunk = (int)atomicAdd((unsigned*)(p.ws + WS_CTL) + CW_VT, 1u);
        __syncthreads();
        const int c0 = *chunk;
        __syncthreads();
        if (c0 >= 2 * 16 * 128 / NWAVE) break;
        const int u = c0 * NWAVE + wave;
        const int which = u >> 11, bg = (u >> 7) & 15, tt = u & 127, b = bg >> 2, g = bg & 3, t0 = tt * 64;
        const u32x4* src = (const u32x4*)(KVB + (size_t)(b * S + t0 + lane) * NKV + (which ? 1280 : 768) + g * 64);
#pragma unroll
        for (int i = 0; i < 8; ++i) { const u32x4 v = src[i]; LAS unsigned* tp = (LAS unsigned*)(tile + lane * 66 + 8 * i); tp[0] = v.x; tp[1] = v.y; tp[2] = v.z; tp[3] = v.w; }
        asm volatile("s_waitcnt lgkmcnt(0)" ::: "memory");
        if (which) {
            bf16_t* dst = (bf16_t*)(p.ws + WS_VWB) + (size_t)(bg * 128 + tt) * 4096 + lane * 8;
#pragma unroll
            for (int i = 0; i < 8; ++i) { unsigned w[4];
#pragma unroll
                for (int q = 0; q < 4; ++q) { const unsigned lo = tile[(8 * i + 2 * q) * 66 + lane], hi = tile[(8 * i + 2 * q + 1) * 66 + lane]; w[q] = lo | (hi << 16); }
                *(u32x4*)(dst + i * 512) = (u32x4){w[0], w[1], w[2], w[3]}; }
        } else {
            unsigned char* dst = p.ws + WS_VSB + (size_t)(bg * 128 + tt) * 4096 + lane * 16;
#pragma unroll
            for (int i = 0; i < 4; ++i) { unsigned w[4];
#pragma unroll
                for (int q = 0; q < 4; ++q) { const int k0 = 16 * i + 4 * q; unsigned x = 0u;
                    x = __builtin_amdgcn_cvt_pk_fp8_f32(bf2f(tile[(k0 + 0) * 66 + lane]), bf2f(tile[(k0 + 1) * 66 + lane]), x, false);
                    x = __builtin_amdgcn_cvt_pk_fp8_f32(bf2f(tile[(k0 + 2) * 66 + lane]), bf2f(tile[(k0 + 3) * 66 + lane]), x, true); w[q] = x; }
                *(u32x4*)(dst + i * 1024) = (u32x4){w[0], w[1], w[2], w[3]}; }
        }
        asm volatile("s_waitcnt lgkmcnt(0)" ::: "memory");
    }
}

typedef short s16x4 __attribute__((ext_vector_type(4)));
__device__ __forceinline__ f32x4 mfma4(s16x4 a, s16x4 b, f32x4 c) { return __builtin_amdgcn_mfma_f32_4x4x4bf16_1k(a, b, c, 0, 0, 0); }
__device__ __forceinline__ s16x4 mk4(unsigned lo, unsigned hi) { const u32x2 t = {lo, hi}; return __builtin_bit_cast(s16x4, t); }
__device__ __forceinline__ f32x4 qk64(const bf16_t* krow, const s16x4 (&qf)[16]) {
    const u32x4* kp = (const u32x4*)krow; u32x4 kr[8];
#pragma unroll
    for (int i = 0; i < 8; ++i) kr[i] = kp[i];
    f32x4 s = {0.f, 0.f, 0.f, 0.f};
#pragma unroll
    for (int c = 0; c < 8; ++c) { s = mfma4(mk4(kr[c].x, kr[c].y), qf[2 * c], s); s = mfma4(mk4(kr[c].z, kr[c].w), qf[2 * c + 1], s); }
    return s;
}
__device__ __forceinline__ void pv64(f32x4& o, const f32x4 e, const bf16_t* vtrow, LAS u32x2* stage, int lane) {
    const u32x4* vp = (const u32x4*)vtrow; u32x4 vr[8];
#pragma unroll
    for (int i = 0; i < 8; ++i) vr[i] = vp[i];
    u32x2 pk; pk.x = cvt_pk_bf16(e.x, e.y); pk.y = cvt_pk_bf16(e.z, e.w);
    stage[lane] = pk;
#pragma unroll
    for (int st = 0; st < 16; ++st) { const u32x2 a = stage[4 * st + (lane & 3)]; const u32x4 v = vr[st >> 1];
        o = mfma4(mk4(a.x, a.y), (st & 1) ? mk4(v.z, v.w) : mk4(v.x, v.y), o); }
}
__device__ __forceinline__ float quadx_sum(float v) { v += __shfl_xor(v, 4); v += __shfl_xor(v, 8); v += __shfl_xor(v, 16); v += __shfl_xor(v, 32); return v; }

constexpr int HBN = 800;
constexpr int ATT_HBD = 0, ATT_MH = 51200, ATT_PSLC = 53248, ATT_STAGE = 118784;
__device__ __forceinline__ void attn_tables(const Params& p, LAS unsigned char* lds) {
    const int tid = opaque_tid();
    LAS float* hbd = (LAS float*)(lds + ATT_HBD); LAS float* mh = (LAS float*)(lds + ATT_MH);
    for (int i = tid; i < 16 * HBN; i += NTHR) { const int hd = i / HBN, d = i - hd * HBN; hbd[i] = p.rel_bias[rel_bucket(d) * NH + hd] * 1.4426950408889634f; }
    if (tid < 16) { float qg = 0.f, kg = 0.f, bm = -3.0e38f;
        for (int i = 0; i < 64; ++i) qg = fmaxf(qg, fabsf(p.q_gain[i]));
        for (int i = 0; i < 192; ++i) kg = fmaxf(kg, fabsf(p.k_gain[i]));
        for (int i = 0; i < 32; ++i) bm = fmaxf(bm, p.rel_bias[i * NH + tid]);
        mh[tid] = (qg * kg * 8.f * 1.02f + bm) * 1.4426950408889634f; }
    __syncthreads();
}
typedef float f32x16 __attribute__((ext_vector_type(16)));
__device__ __forceinline__ f32x16 mfma32(bf16x8 a, bf16x8 b, f32x16 c) { return __builtin_amdgcn_mfma_f32_32x32x16_bf16(a, b, c, 0, 0, 0); }
struct DFrag { bf16x8 ka[4]; bf16x8 va[2][2]; };
__device__ __forceinline__ void dense_load_k(bf16x8 (&ka)[4], const bf16_t* KB, int kt, int l31, int h) {
    const int blk = kt >> 6, hh = (kt >> 5) & 1;
    const bf16_t* kb = KB + (size_t)blk * 4096 + (32 * hh + l31) * 8;
#pragma unroll
    for (int ks = 0; ks < 4; ++ks) ka[ks] = *(const bf16x8*)(kb + (2 * ks + h) * 512);
}
__device__ __forceinline__ void dense_load_v(bf16x8 (&va)[2][2], const bf16_t* VB, int kt, int l31, int h) {
    const int blk = kt >> 6, hh = (kt >> 5) & 1;
    const bf16_t* vb = VB + (size_t)blk * 4096 + l31 * 8 + 4 * h;
#pragma unroll
    for (int dt = 0; dt < 2; ++dt)
#pragma unroll
        for (int st = 0; st < 2; ++st) { const bf16_t* q0 = vb + (4 * hh + 2 * st) * 512 + dt * 256; const u32x2 lo = *(const u32x2*)q0, hi = *(const u32x2*)(q0 + 512);
            const u32x4 w = {lo.x, lo.y, hi.x, hi.y}; va[dt][st] = __builtin_bit_cast(bf16x8, w); }
}
__device__ __forceinline__ f32x16 dense_scores(const DFrag& f, const bf16x8 (&q)[4]) {
    f32x16 sacc;
#pragma unroll
    for (int i = 0; i < 16; ++i) sacc[i] = 0.f;
#pragma unroll
    for (int ks = 0; ks < 4; ++ks) sacc = mfma32(f.ka[ks], q[ks], sacc);
    return sacc;
}
__device__ __forceinline__ void dense_pv(f32x16 (&O)[2], const DFrag& f, const float (&ev)[16]) {
    bf16x8 pb[2];
#pragma unroll
    for (int st = 0; st < 2; ++st) { const u32x4 w = {cvt_pk_bf16(ev[8 * st], ev[8 * st + 1]), cvt_pk_bf16(ev[8 * st + 2], ev[8 * st + 3]), cvt_pk_bf16(ev[8 * st + 4], ev[8 * st + 5]), cvt_pk_bf16(ev[8 * st + 6], ev[8 * st + 7])};
        pb[st] = __builtin_bit_cast(bf16x8, w); }
#pragma unroll
    for (int dt = 0; dt < 2; ++dt)
#pragma unroll
        for (int st = 0; st < 2; ++st) O[dt] = mfma32(f.va[dt][st], pb[st], O[dt]);
}
__device__ __forceinline__ void phase_dense(const Params& p, LAS unsigned char* lds, bf16_t* OW) {
    const int tid = opaque_tid(), lane0 = tid & 63, wave = tid >> 6;
    const LAS float* hbd = (const LAS float*)(lds + ATT_HBD); const LAS float* mh = (const LAS float*)(lds + ATT_MH);
    LAS float* pslc = (LAS float*)(lds + ATT_PSLC) + wave * 2048;
    const bf16_t* Q = (const bf16_t*)(p.ws + WS_Q); const float* GATE = (const float*)(p.ws + WS_GATE);
    short* SEL = (short*)(p.ws + WS_SEL);
    const int Gn = gridDim.x, vcu = (Gn % 8 == 0) ? (blockIdx.x % 8) * (Gn / 8) + blockIdx.x / 8 : blockIdx.x;
    for (int u = vcu * NWAVE + wave; u < T * G / 16; u += Gn * NWAVE) {
        int lane = lane0; asm volatile("" : "+v"(lane));
        const int l31 = lane & 31, h = lane >> 5;
        const int bg = u >> 9, t0 = (((u & 511) + 128 * (u >> 11)) & 511) * 16, b = bg >> 2, g = bg & 3, head = 4 * g + (lane & 3);
        const LAS float* hb = hbd + head * HBN; const float mhv = mh[head];
        int tok[2]; bf16x8 qf[2][4];
#pragma unroll
        for (int r = 0; r < 2; ++r) { tok[r] = t0 + 8 * r + (l31 >> 2); const bf16_t* qp = Q + (size_t)(b * S + tok[r]) * D + head * 64 + 8 * h;
#pragma unroll
            for (int ks = 0; ks < 4; ++ks) qf[r][ks] = *(const bf16x8*)(qp + 16 * ks); }
        f32x16 O[2][2];
#pragma unroll
        for (int r = 0; r < 2; ++r)
#pragma unroll
            for (int dt = 0; dt < 2; ++dt)
#pragma unroll
                for (int q = 0; q < 16; ++q) O[r][dt][q] = 0.f;
        DFrag cur; bf16x8 nxtk[4];
        {
            const bf16_t* KB = (const bf16_t*)(p.ws + WS_KWB) + (size_t)bg * 128 * 4096; const bf16_t* VB = (const bf16_t*)(p.ws + WS_VWB) + (size_t)bg * 128 * 4096;
            float lw[2] = {0.f, 0.f};
            const int lo = t0 - (WIN - 1) > 0 ? t0 - (WIN - 1) : 0, kt_last = t0 & ~31;
            dense_load_k(cur.ka, KB, lo & ~31, l31, h);
            for (int kt = lo & ~31; kt <= kt_last; kt += 32) {
                dense_load_v(cur.va, VB, kt, l31, h);
                dense_load_k(nxtk, KB, kt + 32 <= kt_last ? kt + 32 : kt_last, l31, h);
                __builtin_amdgcn_sched_barrier(0);
#pragma unroll
                for (int r = 0; r < 2; ++r) {
                    const f32x16 sacc = dense_scores(cur, qf[r]);
                    const int dbase = tok[r] - kt - 4 * h; float ev[16];
                    if (kt + 31 <= t0 + 8 * r && kt >= t0 + 8 * r + 7 - (WIN - 1)) {
                        const LAS float* hbp = hb + dbase;
#pragma unroll
                        for (int q = 0; q < 16; ++q) { const float e = __builtin_amdgcn_exp2f(sacc[q] + hbp[-((q & 3) + 8 * (q >> 2))] - mhv); ev[q] = e; lw[r] += e; }
                    } else {
#pragma unroll
                    for (int q = 0; q < 16; ++q) { const int dist = dbase - ((q & 3) + 8 * (q >> 2)); const bool ok = (unsigned)dist < (unsigned)WIN;
                        const float e0 = __builtin_amdgcn_exp2f(sacc[q] + hb[ok ? dist : 0] - mhv); const float e = ok ? e0 : 0.f; ev[q] = e; lw[r] += e; }
                    }
                    dense_pv(O[r], cur, ev);
                }
#pragma unroll
                for (int ks = 0; ks < 4; ++ks) cur.ka[ks] = nxtk[ks];
            }
#pragma unroll
            for (int r = 0; r < 2; ++r) { const float l = lw[r] + __shfl_xor(lw[r], 32); int tk = tok[r]; asm volatile("" : "+v"(tk)); const float* gp = GATE + (size_t)(b * S + tk) * 48 + head * 3;
                const float sc = gp[2] / (l * gp[0]);
#pragma unroll
                for (int dt = 0; dt < 2; ++dt) O[r][dt] = O[r][dt] * sc; }
        }
        const int ncmax = t0 >> 4;
        {
            int l31c = l31, hc = h; asm volatile("" : "+v"(l31c), "+v"(hc));
            const bf16_t* KB = (const bf16_t*)(p.ws + WS_KC) + (size_t)bg * 8 * 4096; const bf16_t* VB = (const bf16_t*)(p.ws + WS_VC) + (size_t)bg * 8 * 4096;
            float lc[2] = {0.f, 0.f};
            const int kt_last = ncmax > 0 ? ((ncmax - 1) & ~31) : -32;
            if (ncmax > 0) {
                dense_load_k(cur.ka, KB, 0, l31c, hc);
                for (int kt = 0; kt <= kt_last; kt += 32) {
                    dense_load_k(nxtk, KB, kt + 32 <= kt_last ? kt + 32 : kt_last, l31c, hc);
                    __builtin_amdgcn_sched_barrier(0);
#pragma unroll
                    for (int r = 0; r < 2; ++r) {
                        const f32x16 sacc = dense_scores(cur, qf[r]);
                        if (t0 - 31 - 16 * (kt + 31) >= HBN - 1) {
                            const float bfar = hb[HBN - 1] - mhv;
#pragma unroll
                            for (int q = 0; q < 16; ++q) lc[r] += __builtin_amdgcn_exp2f(sacc[q] + bfar);
                        } else {
                        const int dbase = tok[r] - 31 - 16 * (kt + 4 * hc);
#pragma unroll
                        for (int q = 0; q < 16; ++q) { const int dist = dbase - 16 * ((q & 3) + 8 * (q >> 2)); const int di = dist < 0 ? 0 : (dist > HBN - 1 ? HBN - 1 : dist);
                            const float e0 = __builtin_amdgcn_exp2f(sacc[q] + hb[di] - mhv); lc[r] += dist >= 0 ? e0 : 0.f; }
                        }
                    }
#pragma unroll
                    for (int ks = 0; ks < 4; ++ks) cur.ka[ks] = nxtk[ks];
                }
            }
            float linv[2];
#pragma unroll
            for (int r = 0; r < 2; ++r) { const float l = lc[r] + __shfl_xor(lc[r], 32); linv[r] = l > 0.f ? 1.f / l : 0.f; }
            { const f32x4 z = {0.f, 0.f, 0.f, 0.f};
#pragma unroll
              for (int i = 0; i < 8; ++i) *(LAS f32x4*)(pslc + (i * 64 + lane) * 4) = z; }
            if (ncmax > 0) {
                float carry[2] = {0.f, 0.f};
                dense_load_k(cur.ka, KB, 0, l31c, hc);
                for (int kt = 0; kt <= kt_last; kt += 32) {
                    dense_load_v(cur.va, VB, kt, l31c, hc);
                    dense_load_k(nxtk, KB, kt + 32 <= kt_last ? kt + 32 : kt_last, l31c, hc);
                    __builtin_amdgcn_sched_barrier(0);
#pragma unroll
                    for (int r = 0; r < 2; ++r) {
                        const f32x16 sacc = dense_scores(cur, qf[r]);
                        float pv[16];
                        const int dbase = tok[r] - 31 - 16 * (kt + 4 * hc);
#pragma unroll
                        for (int q = 0; q < 16; ++q) { const int dist = dbase - 16 * ((q & 3) + 8 * (q >> 2)); const int di = dist < 0 ? 0 : (dist > HBN - 1 ? HBN - 1 : dist);
                            const float e0 = __builtin_amdgcn_exp2f(sacc[q] + hb[di] - mhv); pv[q] = dist >= 0 ? e0 * linv[r] : 0.f; }
                        dense_pv(O[r], cur, pv);
#pragma unroll
                        for (int q = 0; q < 16; ++q) { pv[q] += __shfl_xor(pv[q], 1); pv[q] += __shfl_xor(pv[q], 2); }
                        float y[4];
#pragma unroll
                        for (int gq = 0; gq < 4; ++gq) y[gq] = __shfl_xor(pv[4 * gq + 3], 32);
#pragma unroll
                        for (int gq = 0; gq < 4; ++gq) { const float prevv = h ? y[gq] : (gq > 0 ? y[gq > 0 ? gq - 1 : 0] : carry[r]);
                            const float val = 2.f * ((pv[4 * gq] + pv[4 * gq + 1]) + pv[4 * gq + 2]) + pv[4 * gq + 3] + prevv;
                            if ((lane & 3) == 0) pslc[(8 * r + (l31c >> 2)) * 128 + (kt >> 2) + 2 * gq + hc] = val; }
                        carry[r] = y[3];
                    }
#pragma unroll
                    for (int ks = 0; ks < 4; ++ks) cur.ka[ks] = nxtk[ks];
                }
            }
        }
#pragma unroll
        for (int r = 0; r < 2; ++r) { int tk = tok[r]; asm volatile("" : "+v"(tk)); bf16_t* op = OW + (size_t)(b * S + tk) * D + head * 64 + 4 * h; const float gc = GATE[(size_t)(b * S + tk) * 48 + head * 3];
#pragma unroll
            for (int dt = 0; dt < 2; ++dt)
#pragma unroll
                for (int gq = 0; gq < 4; ++gq) { u32x2 w; w.x = cvt_pk_bf16(O[r][dt][4 * gq] * gc, O[r][dt][4 * gq + 1] * gc); w.y = cvt_pk_bf16(O[r][dt][4 * gq + 2] * gc, O[r][dt][4 * gq + 3] * gc);
                    *(u32x2*)(op + dt * 32 + 8 * gq) = w; } }
#pragma unroll 1
        for (int tl = 0; tl < 16; ++tl) {
            int ln = lane; asm volatile("" : "+v"(ln));
            const int t = t0 + tl, cur_b = t >> 6, j0 = ln, j1 = ln + 64;
            const float c0 = pslc[tl * 128 + j0], c1 = pslc[tl * 128 + j1];
            const bool f0 = (j0 == 0) || (j0 == cur_b) || (j0 == cur_b - 1), f1 = (j1 == cur_b) || (j1 == cur_b - 1);
            const bool v0 = j0 * 64 <= t, v1 = j1 * 64 <= t;
            const unsigned u0 = (v0 && !f0) ? __float_as_uint(c0) : 0u, u1 = (v1 && !f1) ? __float_as_uint(c1) : 0u;
            unsigned th = 1u;
            if (cur_b + 1 > NSEL) {
                th = 0u;
#pragma unroll 1
                for (int bit = 30; bit >= 0; --bit) {
                    const unsigned trial = th | (1u << bit);
                    const int cnt = __popcll(__ballot(u0 >= trial)) + __popcll(__ballot(u1 >= trial));
                    if (cnt >= NSEL - 3) { th = trial; if (cnt == NSEL - 3) break; }
                }
            }
            const bool s0 = f0 || (u0 >= th && u0 != 0u), s1 = f1 || (u1 >= th && u1 != 0u);
            const unsigned long long m0 = __ballot(s0), m1 = __ballot(s1), lt = (1ull << ln) - 1ull;
            const int p0 = __popcll(m0 & lt), p1 = __popcll(m0) + __popcll(m1 & lt);
            short* so = SEL + ((size_t)(b * S + t) * 4 + g) * NSEL;
            if (s0 && p0 < NSEL) so[p0] = (short)j0;
            if (s1 && p1 < NSEL) so[p1] = (short)j1;
        }
    }
}

struct Row16 { u32x4 r[8]; };
struct Row8 { u32x4 r[4]; };
__device__ __forceinline__ void load_row(Row16& r, const unsigned char* ptr) {
#pragma unroll
    for (int i = 0; i < 8; ++i) r.r[i] = *(const u32x4*)(ptr + i * 1024);
}
__device__ __forceinline__ void load_row(Row8& r, const unsigned char* ptr) {
#pragma unroll
    for (int i = 0; i < 4; ++i) r.r[i] = *(const u32x4*)(ptr + i * 1024);
}
typedef __bf16 bf16x2_t __attribute__((ext_vector_type(2)));
__device__ __forceinline__ s16x4 cvt4_fp8(unsigned w) {
    const bf16x2_t lo = __builtin_amdgcn_cvt_scalef32_pk_bf16_fp8(w, 1.0f, false), hi = __builtin_amdgcn_cvt_scalef32_pk_bf16_fp8(w, 1.0f, true);
    return mk4(__builtin_bit_cast(unsigned, lo), __builtin_bit_cast(unsigned, hi));
}
__device__ __forceinline__ s16x4 frag4(const Row16& k, int c) { const u32x4 v = k.r[c >> 1]; return (c & 1) ? mk4(v.z, v.w) : mk4(v.x, v.y); }
__device__ __forceinline__ s16x4 frag4(const Row8& k, int c) { return cvt4_fp8(k.r[c >> 2][c & 3]); }
typedef int i32x4v __attribute__((ext_vector_type(4)));
__device__ __forceinline__ f32x4 qk_row_i8(const Row8& k, const int (&qi)[16]) {
    i32x4v s0 = {0, 0, 0, 0}, s1 = s0;
#pragma unroll
    for (int c = 0; c < 16; c += 2) { s0 = __builtin_amdgcn_mfma_i32_4x4x4i8((int)k.r[c >> 2][c & 3], qi[c], s0, 0, 0, 0); s1 = __builtin_amdgcn_mfma_i32_4x4x4i8((int)k.r[(c + 1) >> 2][(c + 1) & 3], qi[c + 1], s1, 0, 0, 0); }
    const i32x4v t = s0 + s1; return (f32x4){(float)t.x, (float)t.y, (float)t.z, (float)t.w};
}
template <class Row> __device__ __forceinline__ f32x4 qk_row(const Row& k, const s16x4 (&qf)[16]) {
    f32x4 s = {0.f, 0.f, 0.f, 0.f};
#pragma unroll
    for (int c = 0; c < 16; ++c) s = mfma4(frag4(k, c), qf[c], s);
    return s;
}
template <class Row> __device__ __forceinline__ void pv_row(f32x4& o, const f32x4 e, const Row& v, LAS u32x2* stage, int lane) {
    u32x2 pk; pk.x = cvt_pk_bf16(e.x, e.y); pk.y = cvt_pk_bf16(e.z, e.w);
    stage[lane] = pk;
#pragma unroll
    for (int st = 0; st < 16; ++st) { const u32x2 a = stage[4 * st + (lane & 3)]; o = mfma4(mk4(a.x, a.y), frag4(v, st), o); }
}
#define PIPE_PIN() __builtin_amdgcn_sched_barrier(0)
template <bool HASV, class F>
__device__ __forceinline__ void pipe_blocks(const int n, F& f, const s16x4 (&qf)[16]) {
    if (n <= 0) return;
    typename F::Row kA, kB, vA, vB;
    const int l = n - 1;
    load_row(kA, f.kptr(0)); if (HASV) load_row(vA, f.vptr(0));
    PIPE_PIN();
    for (int i = 0; i < n; i += 2) {
        { const int j = i + 1 < l ? i + 1 : l; load_row(kB, f.kptr(j)); if (HASV) load_row(vB, f.vptr(j)); PIPE_PIN();
          const f32x4 sv = qk_row(kA, qf); f.use(i, sv, vA); PIPE_PIN(); }
        if (i + 1 < n) { const int j = i + 2 < l ? i + 2 : l; load_row(kA, f.kptr(j)); if (HASV) load_row(vA, f.vptr(j)); PIPE_PIN();
          const f32x4 sv = qk_row(kB, qf); f.use(i + 1, sv, vB); PIPE_PIN(); }
    }
}
template <class F>
__device__ __forceinline__ void pipe_blocks3(const int n, F& f) {
    if (n <= 0) return;
    typename F::Row k0, k1, k2, v0, v1, v2;
    const int l = n - 1;
#define PB3_IDX(j) ((j) < l ? (j) : l)
    load_row(k0, f.kptr(0)); load_row(v0, f.vptr(0)); load_row(k1, f.kptr(PB3_IDX(1))); load_row(v1, f.vptr(PB3_IDX(1)));
    PIPE_PIN();
#define PB3_STEP(j, KN, VN, KC, VC) if (i + (j) < n) { load_row(KN, f.kptr(PB3_IDX(i + (j) + 2))); load_row(VN, f.vptr(PB3_IDX(i + (j) + 2))); PIPE_PIN(); \
        const f32x4 sv = f.qk(KC); f.use(i + (j), sv, VC); PIPE_PIN(); }
    for (int i = 0; i < n; i += 3) { PB3_STEP(0, k2, v2, k0, v0) PB3_STEP(1, k0, v0, k1, v1) PB3_STEP(2, k1, v1, k2, v2) }
#undef PB3_STEP
#undef PB3_IDX
}
struct SelCtx {
    typedef Row8 Row;
    const unsigned char* ks; const unsigned char* vs; const LAS float* hb; LAS u32x2* stage; float mhv, dq; int selv, t, lane, qd;
    int qi[16];
    f32x4 os; float ls;
    __device__ __forceinline__ f32x4 qk(const Row8& k) const { return qk_row_i8(k, qi) * dq; }
    __device__ __forceinline__ const unsigned char* kptr(int i) const { return ks + (size_t)__builtin_amdgcn_readlane(selv, i) * 4096; }
    __device__ __forceinline__ const unsigned char* vptr(int i) const { return vs + (size_t)__builtin_amdgcn_readlane(selv, i) * 4096; }
    __device__ __forceinline__ void use(int i, const f32x4 sv, const Row8& vr) {
        const int pos0 = __builtin_amdgcn_readlane(selv, i) * 64;
        f32x4 e;
        if (t - pos0 - 63 >= HBN - 1) {
            const float bfar = hb[HBN - 1] - mhv;
#pragma unroll
            for (int q = 0; q < 4; ++q) e[q] = __builtin_amdgcn_exp2f(sv[q] + bfar);
        } else {
#pragma unroll
        for (int q = 0; q < 4; ++q) { const int dist = t - (pos0 + 4 * qd + q); const int di = dist < 0 ? 0 : (dist > HBN - 1 ? HBN - 1 : dist);
            const float e0 = __builtin_amdgcn_exp2f(sv[q] + hb[di] - mhv); e[q] = dist >= 0 ? e0 : 0.f; }
        }
        ls += (e[0] + e[1]) + (e[2] + e[3]);
        pv_row(os, e, vr, stage, lane);
    }
};

__device__ __forceinline__ void phase_attn_pair(const Params& p, LAS unsigned char* lds, bf16_t* AO, const bf16_t* OW) {
    const int tid = opaque_tid(), lane = tid & 63, wave = tid >> 6, jq = lane & 3, qd = lane >> 2;
    const LAS float* hbd = (const LAS float*)(lds + ATT_HBD); const LAS float* mh = (const LAS float*)(lds + ATT_MH);
    LAS u32x2* stage = (LAS u32x2*)(lds + ATT_STAGE) + wave * 64;
    const float dq8 = 1.f / (sel_q_scale(p.q_gain) * sel_k_scale(p.k_gain));
    const unsigned char* KSB = p.ws + WS_KSB; const unsigned char* VSB = p.ws + WS_VSB;
    const float* GATE = (const float*)(p.ws + WS_GATE); const short* SEL = (const short*)(p.ws + WS_SEL);
    const int Gn = gridDim.x, vcu = (Gn % 8 == 0) ? (blockIdx.x % 8) * (Gn / 8) + blockIdx.x / 8 : blockIdx.x;
    for (int idx = vcu * NWAVE + wave; idx < T * G; idx += Gn * NWAVE) {
        const int bg = idx >> 13, t = idx & (S - 1), b = bg >> 2, g = bg & 3, u = b * S + t;
        const int head = 4 * g + jq;
        const int cur = t >> 6, nv = cur + 1 < NSEL ? cur + 1 : NSEL;
        SelCtx sw;
        { const u32x4* qp = (const u32x4*)(p.ws + WS_Q8 + (size_t)u * D + head * 64);
#pragma unroll
            for (int i = 0; i < 4; ++i) { const u32x4 w = qp[i]; sw.qi[4 * i] = (int)w.x; sw.qi[4 * i + 1] = (int)w.y; sw.qi[4 * i + 2] = (int)w.z; sw.qi[4 * i + 3] = (int)w.w; } }
        sw.dq = dq8; sw.selv = (int)SEL[((size_t)u * 4 + g) * NSEL + (lane & 15)];
        sw.ks = KSB + (size_t)bg * 128 * 4096 + lane * 16; sw.vs = VSB + (size_t)bg * 128 * 4096 + lane * 16; sw.hb = hbd + head * HBN; sw.stage = stage; sw.mhv = mh[head]; sw.t = t; sw.lane = lane; sw.qd = qd;
        sw.os = (f32x4){0.f, 0.f, 0.f, 0.f}; sw.ls = 0.f;
        pipe_blocks3(nv, sw);
        const float lsi = 1.f / quadx_sum(sw.ls);
        const float* gt = GATE + (size_t)u * 48 + g * 12;
#pragma unroll
        for (int i = 0; i < 4; ++i) {
            const float si = __shfl(lsi, (lane & ~3) + i);
            const float r = gt[3 * i + 1] * (sw.os[i] * si) + bf2f(OW[(size_t)u * D + (4 * g + i) * 64 + lane]);
            AO[(size_t)u * D + (4 * g + i) * 64 + lane] = (bf16_t)(cvt_pk_bf16(r, 0.f) & 0xffffu);
        }
    }
}

__device__ __forceinline__ void moe_pstarts(const unsigned* ctl, int (&pst)[NE + 1]) {
    int a = 0;
#pragma unroll
    for (int e = 0; e < NE; ++e) { pst[e] = a; const int c = (int)ctl[CW_CNT + 64 * e]; a += (c + 511) / 512 * 512; }
    pst[NE] = a;
}
__device__ __forceinline__ void phase_moe_sort(const Params& p, LAS unsigned char* lds) {
    const int tid = opaque_tid(), lane = tid & 63, wave = tid >> 6;
    unsigned* ctl = (unsigned*)(p.ws + WS_CTL);
    const int* TOPE = (const int*)(p.ws + WS_TOPE); int* RPOS = (int*)(p.ws + WS_RPOS);
    const bf16_t* HB = (const bf16_t*)(p.ws + WS_HB); bf16_t* XS = (bf16_t*)(p.ws + WS_XS);
    LAS int* wcnt = (LAS int*)lds;
    LAS int* base = (LAS int*)(lds + 128);
    LAS int* posl = (LAS int*)(lds + 256);
    int pst[NE + 1]; moe_pstarts(ctl, pst);
    if (blockIdx.x == 0 && tid <= NE) ((int*)(ctl + 256))[tid] = pst[tid];
    for (int c0 = blockIdx.x * 256; c0 < 2 * T; c0 += gridDim.x * 256) {
        int e = 0, rank = 0;
        if (wave < 4) { e = TOPE[c0 + wave * 64 + lane];
#pragma unroll
            for (int q = 0; q < NE; ++q) { const unsigned long long m = __ballot(e == q); if (e == q) rank = __popcll(m & ((1ull << lane) - 1ull)); if (lane == 0) wcnt[wave * NE + q] = __popcll(m); } }
        __syncthreads();
        if (tid < NE) { const int n = wcnt[tid] + wcnt[NE + tid] + wcnt[2 * NE + tid] + wcnt[3 * NE + tid]; base[tid] = n ? (int)atomicAdd(ctl + CW_CUR + 64 * tid, (unsigned)n) : 0; }
        __syncthreads();
        if (wave < 4) { int off = 0;
            for (int w = 0; w < wave; ++w) off += wcnt[w * NE + e];
            const int pos = pst[e] + base[e] + off + rank; posl[wave * 64 + lane] = pos; RPOS[c0 + wave * 64 + lane] = pos; }
        __syncthreads();
        for (int j = wave * 32; j < wave * 32 + 32; j += 8) {
            u32x4 v0[8]; int ps[8];
#pragma unroll
            for (int q = 0; q < 8; ++q) { const int tk = (c0 + j + q) >> 1; ps[q] = posl[j + q]; v0[q] = *((const u32x4*)((const unsigned char*)HB + (size_t)tk * D) + lane); }
#pragma unroll
            for (int q = 0; q < 8; ++q) *((u32x4*)((unsigned char*)XS + (size_t)ps[q] * D) + lane) = v0[q];
        }
        __syncthreads();
    }
}
__device__ __forceinline__ void phase_fill_rtok(const Params& p) {
    int* RTOK = (int*)(p.ws + WS_RTOK);
    for (int i = blockIdx.x * NTHR + threadIdx.x; i < MOE_ROWS; i += gridDim.x * NTHR) RTOK[i] = 0;
}
__device__ __forceinline__ void phase_combine(const Params& p) {
    const int tid = opaque_tid(), lane = tid & 63, wave = tid >> 6;
    const int gw = blockIdx.x * NWAVE + wave, NGW = gridDim.x * NWAVE;
    const float* TOPW = (const float*)(p.ws + WS_TOPW); const int* RPOS = (const int*)(p.ws + WS_RPOS);
    const bf16_t* Y = (const bf16_t*)(p.ws + WS_Y); const float* g2 = (const float*)(p.ws + WS_MODV) + (11 * 4) * D;
    for (int r = gw; r < T; r += NGW) {
        const int b = r >> 13; const int p0 = RPOS[2 * r], p1 = RPOS[2 * r + 1]; const float w0 = TOPW[2 * r], w1 = TOPW[2 * r + 1];
#pragma unroll
        for (int j = 0; j < 4; ++j) { const int c = 4 * lane + 256 * j;
            const u32x2 y0 = *(const u32x2*)(Y + (size_t)p0 * D + c), y1 = *(const u32x2*)(Y + (size_t)p1 * D + c);
            const f32x4 gv = *(const f32x4*)(g2 + b * D + c); f32x4 xv = *(const f32x4*)(p.out + (size_t)r * D + c);
            f32x4 f; f.x = w0 * bflo(y0.x) + w1 * bflo(y1.x); f.y = w0 * bfhi(y0.x) + w1 * bfhi(y1.x); f.z = w0 * bflo(y0.y) + w1 * bflo(y1.y); f.w = w0 * bfhi(y0.y) + w1 * bfhi(y1.y);
            *(f32x4*)(p.out + (size_t)r * D + c) = xv + gv * f; }
    }
}

#define XB_TMO      128
#define XB_XCNT(j)  (256  + 64 * (j))
#define XB_XSUB(j)  (1280 + 64 * (j))
#define XB_XGEN(j)  (2304 + 64 * (j))
#define XB_TOP      3328
#define XB_TOPGEN   3392
#define XCD_BAR_WORDS 3456
#define XB_SPIN_CAP (1u << 18)
__device__ __forceinline__ unsigned xb_ld(unsigned* p)              { return __hip_atomic_load(p, __ATOMIC_RELAXED, __HIP_MEMORY_SCOPE_AGENT); }
__device__ __forceinline__ unsigned xb_add(unsigned* p, unsigned v) { return __hip_atomic_fetch_add(p, v, __ATOMIC_RELAXED, __HIP_MEMORY_SCOPE_AGENT); }
__device__ __forceinline__ unsigned xb_xcc_id() { return (unsigned)__builtin_amdgcn_s_getreg((3 << 11) | 20) & 0xFu; }
#define XB_SPIN(cond, bar) do { unsigned _sp = 0; while (cond) { __builtin_amdgcn_s_sleep(1); \
    if ((++_sp & 255u) == 0u) { if (xb_ld(&(bar)[XB_TMO])) break; if (_sp > XB_SPIN_CAP) { atomicAdd(&(bar)[XB_TMO], 1u); break; } } } } while (0)
struct XcdBarrier { unsigned* bar; unsigned x; volatile LAS unsigned* st; };
__device__ __forceinline__ XcdBarrier xcd_barrier_post(unsigned* bar, volatile LAS unsigned* st) {
    XcdBarrier b; b.bar = bar; b.x = xb_xcc_id(); b.st = st;
    if (threadIdx.x == 0) (void)xb_add(&bar[XB_XCNT(b.x)], 1u);
    return b;
}
__device__ __forceinline__ void xcd_barrier_complete(unsigned* bar, unsigned x, unsigned& nloc, unsigned& nx) {
    const unsigned G_ = gridDim.x * gridDim.y * gridDim.z;
    unsigned sum, cnt, mine, sp = 0u;
    for (;;) {
        sum = 0u; cnt = 0u; mine = 0u;
#pragma unroll
        for (unsigned j = 0; j < 16; ++j) { const unsigned c = xb_ld(&bar[XB_XCNT(j)]); sum += c; cnt += (c > 0u) ? 1u : 0u; mine = (j == x) ? c : mine; }
        if (sum == G_) break;
        __builtin_amdgcn_s_sleep(1);
        if ((++sp & 255u) == 0u) { if (xb_ld(&bar[XB_TMO])) break; if (sp > XB_SPIN_CAP) { atomicAdd(&bar[XB_TMO], 1u); break; } }
    }
    nloc = mine > 0u ? mine : 1u; nx = cnt > 0u ? cnt : 1u;
}
__device__ __forceinline__ void xcd_barrier(const XcdBarrier& b) {
    asm volatile("s_waitcnt vmcnt(0)" ::: "memory");
    __syncthreads();
    if (threadIdx.x == 0) {
        unsigned* bar = b.bar;
        __builtin_amdgcn_s_waitcnt(0);
        unsigned nloc = b.st[0], nx = b.st[1];
        if (nloc == 0u) { xcd_barrier_complete(bar, b.x, nloc, nx); b.st[0] = nloc; b.st[1] = nx; }
        const unsigned old = xb_add(&bar[XB_XSUB(b.x)], 1u);
        const unsigned gen = old / nloc;
        if (old + 1u == (gen + 1u) * nloc) {
            __builtin_amdgcn_fence(__ATOMIC_RELEASE, "agent");
            asm volatile("s_waitcnt vmcnt(0)" ::: "memory");
            const unsigned og = xb_add(&bar[XB_TOP], 1u);
            const unsigned tg = og / nx;
            if (og + 1u == (tg + 1u) * nx) xb_add(&bar[XB_TOPGEN], 1u);
            else XB_SPIN(xb_ld(&bar[XB_TOPGEN]) == tg, bar);
            __builtin_amdgcn_fence(__ATOMIC_ACQUIRE, "agent");
            xb_add(&bar[XB_XGEN(b.x)], 1u);
            asm volatile("s_waitcnt vmcnt(0)" ::: "memory");
        } else {
            XB_SPIN(xb_ld(&bar[XB_XGEN(b.x)]) == gen, bar);
            __builtin_amdgcn_fence(__ATOMIC_ACQUIRE, "agent");
            asm volatile("s_waitcnt vmcnt(0)" ::: "memory");
        }
    }
    __syncthreads();
}

constexpr int LDS_SCRATCH = 131072, MISC_OFF = LDS_SCRATCH + 320, LDS_BYTES = 147456;
#define MODP(which) ((const float*)(p.ws + WS_MODV) + (size_t)(which) * 4 * D)

__global__ void __launch_bounds__(NTHR, 2) k_fused(Params p) {
    extern __shared__ __attribute__((aligned(16))) unsigned char lds_raw[];
    LAS unsigned char* lds = (LAS unsigned char*)lds_raw;
    for (int u = threadIdx.x; u < (LDS_BYTES - LDS_SCRATCH) / 4; u += NTHR) ((LAS unsigned*)(lds + LDS_SCRATCH))[u] = 0u;
    __syncthreads();
    const XcdBarrier bar = xcd_barrier_post((unsigned*)(p.ws + WS_CTL) + CW_BAR, (volatile LAS unsigned*)(lds + MISC_OFF) + 8);
#define GRID_BAR() xcd_barrier(bar)
    phase_weights(p, lds); __syncthreads(); phase_modvec(p, lds);
    GRID_BAR();
    phase_convert_fgu(p, lds); __syncthreads();
    phase_poolmix(p, lds, (bf16_t*)(p.ws + WS_HA));
    GRID_BAR();
    { pg8::Sched<1> Sc; Sc.init(T, D, gridDim.x, blockIdx.x, p.ws + WS_HA, p.ws + WO_POOL, D, 256);
      pg8::EpiEl<EpiPool> E{{p.x, (float*)(p.ws + WS_X1), MODP(2), p.pool_scale, 0}};
      pg8::gemm_phase(lds, 256, D, 256, 128, Sc, E); }
    GRID_BAR();
    { NormOut o0{p.norm_g + D, MODP(4), MODP(3), (bf16_t*)(p.ws + WS_HB)}; phase_norm<1, false, 2>(p, lds, (const float*)(p.ws + WS_X1), o0, o0); }
    GRID_BAR();
    { pg8::Sched<0> Sc; Sc.init(T, 2 * FF, gridDim.x, blockIdx.x, p.ws + WS_HB, p.ws + WO_FGU, D / 2, D / 2);
      pg8::EpiPairEl<EpiSwigluI8> E{{(bf16_t*)(p.ws + WS_HID0), FF, (const float*)(p.ws + WS_ASC), (const float*)(p.ws + WS_FGMAX)}};
      pg8::gemm_phase<pg8::EpiPairEl<EpiSwigluI8>, pg8::Sched<0>, true, true, 2>(lds, D / 2, D / 2, D / 2, 128, Sc, E); }
    GRID_BAR();
    { pg8::Sched<0> Sc; Sc.init(T, D, gridDim.x, blockIdx.x, p.ws + WS_HID0, p.ws + WO_FDN, FF, FF);
      pg8::EpiEl<EpiResid> E{{(const float*)(p.ws + WS_X1), (float*)(p.ws + WS_X2), MODP(5)}};
      pg8::gemm_phase(lds, FF, FF, FF, 128, Sc, E); }
    GRID_BAR();
    { NormOut o0{p.kv_norm_g, MODP(13), MODP(12), (bf16_t*)(p.ws + WS_HA)}; NormOut o1{p.norm_g + 2 * D, MODP(7), MODP(6), (bf16_t*)(p.ws + WS_HB)}; phase_norm<2, false>(p, lds, (const float*)(p.ws + WS_X2), o0, o1); }
    GRID_BAR();
    { pg8::Sched<0> Sc; Sc.init(T, NKV, gridDim.x, blockIdx.x, p.ws + WS_HA, p.ws + WO_KV, D, D);
      pg8::EpiEl<EpiBf16> E{{(bf16_t*)(p.ws + WS_KVB), NKV}};
      pg8::gemm_phase(lds, D, D, D, 128, Sc, E); }
    { pg8::Sched<0> Sc; Sc.init(T, D, gridDim.x, blockIdx.x, p.ws + WS_HB, p.ws + WO_Q, D, D);
      pg8::EpiEl<EpiQ> E{{(bf16_t*)(p.ws + WS_Q), (float*)(p.ws + WS_GATE), 0}};
      pg8::gemm_phase(lds, D, D, D, 128, Sc, E); }
    GRID_BAR();
    { pg8::Sched<2> Sc; Sc.init(2048, 2048, gridDim.x, blockIdx.x, p.ws + WS_KVB, p.ws + WO_CK, 16 * NKV, 2048);
      pg8::EpiEl<EpiCmp> E{{(bf16_t*)(p.ws + WS_CMPH), (const float*)(p.ws + WS_CMPB)}};
      pg8::gemm_phase(lds, 2048, 16 * NKV, 2048, (size_t)NKV * 2, Sc, E); }
    { pg8::Sched<0> Sc; Sc.init(T, 256, (int)gridDim.x - 64 > 0 ? (int)gridDim.x - 64 : 1, (int)gridDim.x > 64 ? (int)blockIdx.x - 64 : (int)blockIdx.x, p.ws + WS_HB, p.ws + WO_Q + (size_t)D * D * 2, D, D);
      pg8::EpiEl<EpiQ> E{{(bf16_t*)(p.ws + WS_Q), (float*)(p.ws + WS_GATE), D}};
      pg8::gemm_phase(lds, D, D, D, 128, Sc, E); }
    phase_headnorm(p, lds); phase_vtrans(p, lds);
    GRID_BAR();
    phase_cmp2(p, lds);
    GRID_BAR();
    attn_tables(p, lds);
    phase_dense(p, lds, (bf16_t*)(p.ws + WS_HB));
    GRID_BAR();
    phase_attn_pair(p, lds, (bf16_t*)(p.ws + WS_HA), (const bf16_t*)(p.ws + WS_HB));
    GRID_BAR();
    { pg8::Sched<0> Sc; Sc.init(T, D, gridDim.x, blockIdx.x, p.ws + WS_HA, p.ws + WO_O, D, D);
      pg8::EpiEl<EpiResid> E{{(const float*)(p.ws + WS_X2), p.out, MODP(8)}};
      pg8::gemm_phase(lds, D, D, D, 128, Sc, E); }
    GRID_BAR();
    { NormOut o0{p.norm_g + 3 * D, MODP(10), MODP(9), (bf16_t*)(p.ws + WS_HB)}; phase_norm<1, true, 1>(p, lds, p.out, o0, o0); }
    GRID_BAR();
    phase_moe_sort(p, lds);
    GRID_BAR();
    { const int* pst = (const int*)(p.ws + WS_CTL) + 256;
      pg8::Sched<3> Sc; Sc.init(pst[NE], 2 * FE, gridDim.x, blockIdx.x, p.ws + WS_XS, p.ws + WO_EGU, D / 2, D / 2, pst, (size_t)FE * D);
      pg8::EpiPairEl<EpiSwiglu8> E{{p.ws + WS_HIDM, FE}};
      pg8::gemm_phase<pg8::EpiPairEl<EpiSwiglu8>, pg8::Sched<3>, true, true, 1>(lds, D / 2, D / 2, D / 2, 128, Sc, E, 127 - 5); }
    GRID_BAR();
    { const int* pst = (const int*)(p.ws + WS_CTL) + 256;
      pg8::Sched<3> Sc; Sc.init(pst[NE], D, gridDim.x, blockIdx.x, p.ws + WS_HIDM, p.ws + WO_EDN, FE / 2, FE / 2, pst, (size_t)D * FE / 2);
      pg8::EpiEl<EpiBf16> E{{(bf16_t*)(p.ws + WS_Y), D}};
      pg8::gemm_phase<pg8::EpiEl<EpiBf16>, pg8::Sched<3>, true, true, 1>(lds, FE / 2, FE / 2, FE / 2, 128, Sc, E, 127 - 6); }
    GRID_BAR();
    phase_combine(p);
}

extern "C" void kernel_launch(void* const* d_in, const int* in_sizes, int n_in, void* d_out, int out_size, void* d_ws, size_t ws_size, hipStream_t stream) {
    if (n_in != 28 || out_size != T * D || ws_size < WS_END) { fprintf(stderr, "kernel_launch: unexpected shapes (n_in %d out %d ws %zu need %zu)\n", n_in, out_size, ws_size, (size_t)WS_END); return; }
    static int grid = 0;
    if (grid == 0) {
        int dev = 0, cus = 0, per_cu = 0;
        if (hipGetDevice(&dev) != hipSuccess || hipDeviceGetAttribute(&cus, hipDeviceAttributeMultiprocessorCount, dev) != hipSuccess) { grid = -1; return; }
        if (hipFuncSetAttribute((const void*)k_fused, hipFuncAttributeMaxDynamicSharedMemorySize, LDS_BYTES) != hipSuccess) { grid = -1; return; }
        if (hipOccupancyMaxActiveBlocksPerMultiprocessor(&per_cu, (const void*)k_fused, NTHR, LDS_BYTES) != hipSuccess || per_cu < 1) { fprintf(stderr, "kernel_launch: occupancy query says %d\n", per_cu); }
        (void)hipGetLastError();
        grid = cus;
    }
    if (grid < 0) return;
    Params p{};
    const float** pp = (const float**)&p;
    for (int i = 0; i < 28; ++i) pp[i] = (const float*)d_in[i];
    p.out = (float*)d_out; p.ws = (unsigned char*)d_ws;
    (void)hipMemsetAsync((char*)d_ws + WS_CTL, 0, CTL_BYTES, stream);
    k_fused<<<dim3(grid), dim3(NTHR), LDS_BYTES, stream>>>(p);
}
```

```cpp
#include <hip/hip_runtime.h>
#include <cstdint>
#include <cstdio>

#define LAS __attribute__((address_space(3)))
typedef unsigned short bf16_t;
typedef short bf16x8 __attribute__((ext_vector_type(8)));
typedef float f32x4 __attribute__((ext_vector_type(4)));
typedef float f32x2 __attribute__((ext_vector_type(2)));
typedef unsigned u32x4 __attribute__((ext_vector_type(4)));
typedef unsigned u32x2 __attribute__((ext_vector_type(2)));

constexpr int NB = 4, S = 8192, D = 1024, T = NB * S;
constexpr int FF = 2816, NE = 8, FE = 3584;
constexpr int NKV = 1536, NQP = 1280, NQ = 1072;
constexpr int G = 4, HD = 64, NH = 16;
constexpr int NC = 512;
constexpr int NSB = 128;
constexpr int NSEL = 16;
constexpr int WIN = 512;
constexpr int MOE_ROWS = 69632;
constexpr float EPS = 1e-6f;
constexpr int NTHR = 512, NWAVE = 8;

constexpr size_t MiB = 1u << 20;
constexpr size_t WS_CTL = 0, CTL_BYTES = 1 * MiB;
constexpr size_t WS_MODV = 1 * MiB;
constexpr size_t WS_CMPB = WS_MODV + 14 * 4 * 1024 * 4;
constexpr size_t WS_FGMAX = WS_CMPB + 4096;
constexpr size_t WS_ASC = WS_FGMAX + 2 * FF * 4;
constexpr size_t WS_TOPE = 2 * MiB;
constexpr size_t WS_TOPW = WS_TOPE + (size_t)T * 8;
constexpr size_t WS_RPOS = WS_TOPW + (size_t)T * 8;
constexpr size_t WS_RTOK = WS_RPOS + (size_t)T * 8;
constexpr size_t WS_SMALL_END = WS_RTOK + (size_t)MOE_ROWS * 4;
static_assert(WS_SMALL_END <= 8 * MiB && WS_ASC + (size_t)T * 4 <= 2 * MiB, "small region");
constexpr size_t WS_W = 8 * MiB;
constexpr size_t WO_POOL = WS_W;
constexpr size_t WO_FGU = WO_POOL + (size_t)4 * 256 * 256 * 2;
constexpr size_t WO_FDN = WO_FGU + (size_t)2 * FF * D * 2;
constexpr size_t WO_KV = WO_FDN + (size_t)D * FF * 2;
constexpr size_t WO_Q = WO_KV + (size_t)NKV * D * 2;
constexpr size_t WO_O = WO_Q + (size_t)NQP * D * 2;
constexpr size_t WO_CK = WO_O + (size_t)D * D * 2;
constexpr size_t WO_CV = WO_CK + (size_t)256 * 2048 * 2;
constexpr size_t WO_EGU = WO_CV + (size_t)256 * 2048 * 2;
constexpr size_t WO_EDN = WO_EGU + (size_t)NE * 2 * FE * D * 2;
constexpr size_t WO_END = WO_EDN + (size_t)NE * D * FE * 2;
static_assert(WO_END <= 203 * MiB, "weights region");
constexpr size_t WS_HB = 203 * MiB;
constexpr size_t WS_X1 = 267 * MiB;
constexpr size_t WS_X2 = 395 * MiB;
constexpr size_t WS_HID0 = 523 * MiB;
constexpr size_t WS_Q = 523 * MiB;
constexpr size_t WS_GATE = 587 * MiB;
constexpr size_t WS_CMPH = 593 * MiB;
constexpr size_t WS_KC = 601 * MiB;
constexpr size_t WS_VC = 602 * MiB;
constexpr size_t WS_KSB = 603 * MiB;
constexpr size_t WS_VSB = 619 * MiB;
constexpr size_t WS_KWB = 635 * MiB;
constexpr size_t WS_VWB = 651 * MiB;
constexpr size_t WS_Q8 = 267 * MiB;
constexpr size_t WS_SEL = 667 * MiB;
constexpr size_t WS_HA = 699 * MiB;
constexpr size_t WS_KVB = 763 * MiB;
constexpr size_t WS_HIDM = 267 * MiB;
constexpr size_t WS_Y = 743 * MiB;
constexpr size_t WS_XS = WS_Y;
constexpr size_t WS_END = 880 * MiB;
static_assert(WS_HIDM + (size_t)MOE_ROWS * FE * 2 <= WS_Y && WS_Y + (size_t)MOE_ROWS * D * 2 <= WS_END, "moe map");
static_assert(WS_KVB + (size_t)T * NKV * 2 + 65536 <= WS_END, "kv map");
constexpr int CW_CNT = 512;
constexpr int CW_CUR = 1024;
constexpr int CW_HN = 2048, CW_VT = 2112;
constexpr int CW_BAR = 4096;

struct Params {
    const float *x, *c, *ada_w, *ada_b, *norm_g, *pool_w, *pool_scale, *q_w, *q_gain, *o_w, *kv_ada_w, *kv_ada_b, *kv_norm_g, *kv_w,
        *cmp_pe_k, *cmp_pe_v, *cmp_k_w1, *cmp_k_w2, *cmp_v_w1, *cmp_v_w2, *k_gain, *rel_bias, *ffn_gu, *ffn_dn, *router_w, *router_b, *exp_gu, *exp_dn;
    float* out; unsigned char* ws;
};

__device__ __forceinline__ unsigned cvt_pk_bf16(float lo, float hi) { unsigned r; asm volatile("v_cvt_pk_bf16_f32 %0, %1, %2" : "=v"(r) : "v"(lo), "v"(hi)); return r; }
__device__ __forceinline__ float bf2f(unsigned short v) { return __uint_as_float((unsigned)v << 16); }
__device__ __forceinline__ float bflo(unsigned w) { return __uint_as_float(w << 16); }
__device__ __forceinline__ float bfhi(unsigned w) { return __uint_as_float(w & 0xffff0000u); }
__device__ __forceinline__ int opaque_tid() { int t = threadIdx.x; asm volatile("" : "+v"(t)); return t; }
__device__ __forceinline__ float readlane_f(float v, int l) { return __uint_as_float((unsigned)__builtin_amdgcn_readlane((int)__float_as_uint(v), l)); }
__device__ __forceinline__ unsigned pack_i8x4(float a, float b, float c, float d) {
    const int ia = (int)__builtin_rintf(fminf(fmaxf(a, -127.f), 127.f)), ib = (int)__builtin_rintf(fminf(fmaxf(b, -127.f), 127.f)), ic = (int)__builtin_rintf(fminf(fmaxf(c, -127.f), 127.f)), id = (int)__builtin_rintf(fminf(fmaxf(d, -127.f), 127.f));
    return (unsigned)(ia & 0xff) | ((unsigned)(ib & 0xff) << 8) | ((unsigned)(ic & 0xff) << 16) | ((unsigned)(id & 0xff) << 24);
}
__device__ __forceinline__ float sel_q_scale(const float* q_gain) { float m = 0.f; for (int i = 0; i < 64; ++i) m = fmaxf(m, fabsf(q_gain[i])); return 127.f / (4.f * m * 0.125f * 1.4426950408889634f); }
__device__ __forceinline__ float sel_k_scale(const float* k_gain) { float m = 0.f; for (int i = 0; i < 64; ++i) m = fmaxf(m, fabsf(k_gain[64 + i])); return 127.f / (4.f * m); }
__device__ __forceinline__ float wave_sum(float v) {
#pragma unroll
    for (int o = 1; o < 64; o <<= 1) v += __shfl_xor(v, o);
    return v;
}
__device__ __forceinline__ float wave_max(float v) {
#pragma unroll
    for (int o = 1; o < 64; o <<= 1) v = fmaxf(v, __shfl_xor(v, o));
    return v;
}
__device__ __forceinline__ float silu_f(float v) { return v * __builtin_amdgcn_rcpf(1.f + __builtin_amdgcn_exp2f(v * -1.4426950408889634f)); }
__device__ __forceinline__ float sigmoid_f(float v) { return __builtin_amdgcn_rcpf(1.f + __builtin_amdgcn_exp2f(v * -1.4426950408889634f)); }
__device__ __forceinline__ float gelu_tanh_f(float v) {
    const float u = 0.7978845608028654f * (v + 0.044715f * v * v * v);
    const float e = __builtin_amdgcn_exp2f(fabsf(u) * -2.8853900817779268f); const float th = (1.f - e) * __builtin_amdgcn_rcpf(1.f + e);
    return 0.5f * v * (1.f + (u < 0.f ? -th : th));
}
__device__ __forceinline__ int rel_bucket(int d) {
    if (d < 16) return d;
    int b = 16;
    b += (d >= 21); b += (d >= 27); b += (d >= 35); b += (d >= 46); b += (d >= 59); b += (d >= 77); b += (d >= 99); b += (d >= 128);
    b += (d >= 166); b += (d >= 216); b += (d >= 280); b += (d >= 363); b += (d >= 470); b += (d >= 609); b += (d >= 790);
    return b;
}

template <bool FP8 = false>
__device__ __forceinline__ void transpose_item(const float* W, int K, int N, bf16_t* WT, int k0, int n0, int drow0, LAS float* scr, int lane, float wscale = 1.f) {
    float wv[32];
#pragma unroll
    for (int i = 0; i < 32; ++i) { const int kk = 2 * i + (lane >> 5); const int n = n0 + (lane & 31); wv[i] = (n < N) ? W[(size_t)(k0 + kk) * N + n] : 0.f; }
#pragma unroll
    for (int i = 0; i < 32; ++i) { const int kk = 2 * i + (lane >> 5); scr[kk * 33 + (lane & 31)] = wv[i]; }
    asm volatile("s_waitcnt lgkmcnt(0)" ::: "memory");
    const int c = lane & 7;
#pragma unroll
    for (int j = 0; j < 4; ++j) { const int n = (lane >> 3) + 8 * j; const LAS float* s = scr + (8 * c) * 33 + n;
        if constexpr (FP8) {
            unsigned w0 = 0u, w1 = 0u;
            w0 = __builtin_amdgcn_cvt_pk_fp8_f32(s[0 * 33] * wscale, s[1 * 33] * wscale, w0, false); w0 = __builtin_amdgcn_cvt_pk_fp8_f32(s[2 * 33] * wscale, s[3 * 33] * wscale, w0, true);
            w1 = __builtin_amdgcn_cvt_pk_fp8_f32(s[4 * 33] * wscale, s[5 * 33] * wscale, w1, false); w1 = __builtin_amdgcn_cvt_pk_fp8_f32(s[6 * 33] * wscale, s[7 * 33] * wscale, w1, true);
            *(u32x2*)((unsigned char*)WT + (size_t)(drow0 + n) * K + k0 + 8 * c) = (u32x2){w0, w1};
        } else {
        u32x4 o; o.x = cvt_pk_bf16(s[0 * 33], s[1 * 33]); o.y = cvt_pk_bf16(s[2 * 33], s[3 * 33]); o.z = cvt_pk_bf16(s[4 * 33], s[5 * 33]); o.w = cvt_pk_bf16(s[6 * 33], s[7 * 33]);
        *(u32x4*)(WT + (size_t)(drow0 + n) * K + k0 + 8 * c) = o; } }
    asm volatile("s_waitcnt lgkmcnt(0)" ::: "memory");
}
template <int MODE, bool FP8 = false>
__device__ __forceinline__ void transpose_mat(const float* W, int K, int N, int NP, int F, bf16_t* WT, int it, LAS float* scr, int lane, float wscale = 1.f) {
    const int nblk = NP / 32, kb = it / nblk, nb = it % nblk, n0 = nb * 32;
    int drow0 = n0;
    if (MODE == 1) { const int up = n0 >= F, j = up ? n0 - F : n0; drow0 = (j >> 7) * 256 + (up ? 128 : 0) + (j & 127); }
    transpose_item<FP8>(W, K, N, WT, kb * 64, n0, drow0, scr, lane, wscale);
}
__device__ __forceinline__ void phase_convert_fgu(const Params& p, LAS unsigned char* lds) {
    const int tid = opaque_tid(), lane = tid & 63, wave = tid >> 6;
    LAS float* scr = (LAS float*)(lds + wave * 16384);
    const int gw = blockIdx.x * NWAVE + wave, NGW = gridDim.x * NWAVE;
    const float* FGMAX = (const float*)(p.ws + WS_FGMAX); unsigned char* WT = p.ws + WO_FGU;
    for (int it = gw; it < 16 * 176; it += NGW) {
        const int kb = it / 176, nb = it % 176, n0 = nb * 32, k0 = kb * 64;
        const int up = n0 >= FF, j0 = up ? n0 - FF : n0, drow0 = (j0 >> 7) * 256 + (up ? 128 : 0) + (j0 & 127);
        float wv[32];
#pragma unroll
        for (int i = 0; i < 32; ++i) wv[i] = p.ffn_gu[(size_t)(k0 + 2 * i + (lane >> 5)) * (2 * FF) + n0 + (lane & 31)];
#pragma unroll
        for (int i = 0; i < 32; ++i) scr[(2 * i + (lane >> 5)) * 33 + (lane & 31)] = wv[i];
        asm volatile("s_waitcnt lgkmcnt(0)" ::: "memory");
        const int c = lane & 7;
#pragma unroll
        for (int j = 0; j < 4; ++j) { const int n = (lane >> 3) + 8 * j; const LAS float* sp = scr + (8 * c) * 33 + n; const float sc = 127.f / FGMAX[n0 + n];
            const unsigned w0 = pack_i8x4(sp[0 * 33] * sc, sp[1 * 33] * sc, sp[2 * 33] * sc, sp[3 * 33] * sc), w1 = pack_i8x4(sp[4 * 33] * sc, sp[5 * 33] * sc, sp[6 * 33] * sc, sp[7 * 33] * sc);
            *(u32x2*)(WT + (size_t)(drow0 + n) * D + k0 + 8 * c) = (u32x2){w0, w1}; }
        asm volatile("s_waitcnt lgkmcnt(0)" ::: "memory");
    }
}
__device__ __forceinline__ void phase_weights(const Params& p, LAS unsigned char* lds) {
    const int tid = opaque_tid(), lane = tid & 63, wave = tid >> 6;
    LAS float* scr = (LAS float*)(lds + wave * 16384);
    const int gw = blockIdx.x * NWAVE + wave, NGW = gridDim.x * NWAVE;
    unsigned char* ws = p.ws;
    constexpr int I_POOL = 4 * 8, I_FGU = 16 * 176, I_FDN = 44 * 32, I_KV = 16 * 48, I_Q = 16 * 40, I_O = 16 * 32, I_C = 32 * 8, I_EGU = 16 * 224, I_EDN = 56 * 32;
    constexpr int TOT = 4 * I_POOL + I_FGU + I_FDN + I_KV + I_Q + I_O + 2 * I_C + NE * I_EGU + NE * I_EDN;
    for (int it = gw; it < TOT; it += NGW) {
        int r = it;
        if (r < 4 * I_POOL) { const int g = r / I_POOL; transpose_mat<0>(p.pool_w + (size_t)g * 65536, 256, 256, 256, 0, (bf16_t*)(ws + WO_POOL) + (size_t)g * 65536, r % I_POOL, scr, lane); continue; } r -= 4 * I_POOL;
        if (r < I_FGU) continue; r -= I_FGU;
        if (r < I_FDN) { transpose_mat<0>(p.ffn_dn, FF, D, D, 0, (bf16_t*)(ws + WO_FDN), r, scr, lane); continue; } r -= I_FDN;
        if (r < I_KV) { transpose_mat<0>(p.kv_w, D, NKV, NKV, 0, (bf16_t*)(ws + WO_KV), r, scr, lane); continue; } r -= I_KV;
        if (r < I_Q) { transpose_mat<0>(p.q_w, D, NQ, NQP, 0, (bf16_t*)(ws + WO_Q), r, scr, lane); continue; } r -= I_Q;
        if (r < I_O) { transpose_mat<0>(p.o_w, D, D, D, 0, (bf16_t*)(ws + WO_O), r, scr, lane); continue; } r -= I_O;
        if (r < I_C) { transpose_mat<0>(p.cmp_k_w1, 2048, 256, 256, 0, (bf16_t*)(ws + WO_CK), r, scr, lane); continue; } r -= I_C;
        if (r < I_C) { transpose_mat<0>(p.cmp_v_w1, 2048, 256, 256, 0, (bf16_t*)(ws + WO_CV), r, scr, lane); continue; } r -= I_C;
        if (r < NE * I_EGU) { const int e = r / I_EGU; transpose_mat<1, true>(p.exp_gu + (size_t)e * D * 2 * FE, D, 2 * FE, 2 * FE, FE, (bf16_t*)(ws + WO_EGU + (size_t)e * 2 * FE * D), r % I_EGU, scr, lane, 32.f); continue; } r -= NE * I_EGU;
        { const int e = r / I_EDN; transpose_mat<0, true>(p.exp_dn + (size_t)e * FE * D, FE, D, D, 0, (bf16_t*)(ws + WO_EDN + (size_t)e * D * FE), r % I_EDN, scr, lane, 64.f); }
    }
}

__device__ __forceinline__ void phase_modvec(const Params& p, LAS unsigned char* lds) {
    const int tid = opaque_tid(), lane = tid & 63, wave = tid >> 6;
    LAS float* part = (LAS float*)lds;
    LAS float* sc_l = (LAS float*)(lds + 8192);
    for (int i = tid; i < 4 * D; i += NTHR) sc_l[i] = silu_f(p.c[i]);
    __syncthreads();
    float* MODV = (float*)(p.ws + WS_MODV);
    float* CMPB = (float*)(p.ws + WS_CMPB);
    { float* FGMAX = (float*)(p.ws + WS_FGMAX);
      for (int u = blockIdx.x; u < 2 * FF / 64; u += gridDim.x) {
        const int col = u * 64 + lane; float m = 0.f;
#pragma unroll 16
        for (int k = wave * 128; k < wave * 128 + 128; ++k) m = fmaxf(m, fabsf(p.ffn_gu[(size_t)k * (2 * FF) + col]));
        part[wave * 64 + lane] = m;
        __syncthreads();
        if (tid < 64) { float mm = part[lane];
#pragma unroll
            for (int w = 1; w < 8; ++w) mm = fmaxf(mm, part[w * 64 + lane]);
            FGMAX[u * 64 + lane] = fmaxf(mm, 1e-30f); }
        __syncthreads();
      } }
    constexpr int NU_MOD = 14336 / 64, NU = NU_MOD + 8;
    for (int u = blockIdx.x; u < NU; u += gridDim.x) {
        float acc[4] = {0.f, 0.f, 0.f, 0.f};
        if (u < NU_MOD) {
            const int gc = u * 64 + lane;
            const float* W; int ldw, col;
            if (gc < 6144) { W = p.ada_w; ldw = 6144; col = gc; } else if (gc < 12288) { W = p.ada_w + (size_t)D * 6144; ldw = 6144; col = gc - 6144; } else { W = p.kv_ada_w; ldw = 2048; col = gc - 12288; }
#pragma unroll 16
            for (int k = wave * 128; k < wave * 128 + 128; ++k) {
                const float w = W[(size_t)k * ldw + col];
#pragma unroll
                for (int b = 0; b < 4; ++b) acc[b] += sc_l[b * D + k] * w;
            }
        } else {
            const int cu = u - NU_MOD, kv = cu >> 2, col = (cu & 3) * 64 + lane;
            const float* W = kv ? p.cmp_v_w1 : p.cmp_k_w1; const float* pe = kv ? p.cmp_pe_v : p.cmp_pe_k;
#pragma unroll 16
            for (int k = wave * 256; k < wave * 256 + 256; ++k) acc[0] += pe[k] * W[(size_t)k * 256 + col];
        }
#pragma unroll
        for (int b = 0; b < 4; ++b) part[(wave * 4 + b) * 64 + lane] = acc[b];
        __syncthreads();
        if (tid < 256) {
            const int b = tid >> 6; float s = 0.f;
#pragma unroll
            for (int w = 0; w < 8; ++w) s += part[(w * 4 + b) * 64 + lane];
            if (u < NU_MOD) {
                const int gc = u * 64 + lane; int which, n; float bias;
                if (gc < 6144) { which = gc >> 10; n = gc & 1023; bias = p.ada_b[gc]; } else if (gc < 12288) { which = 6 + ((gc - 6144) >> 10); n = gc & 1023; bias = p.ada_b[gc]; }
                else { which = 12 + ((gc - 12288) >> 10); n = gc & 1023; bias = p.kv_ada_b[gc - 12288]; }
                MODV[(which * 4 + b) * D + n] = s + bias;
            } else if (b == 0) { const int cu = u - NU_MOD; CMPB[(cu >> 2) * 256 + (cu & 3) * 64 + lane] = s; }
        }
        __syncthreads();
    }
}

template <int W>
__device__ __forceinline__ void pool_rows(const float* xb, int t0, const LAS float* rs, f32x2 gm, f32x2 sh, bf16_t* outb, int c0) {
    f32x2 ring[16];
#pragma unroll
    for (int i = 0; i < 15; ++i) {
        const int t = t0 - 15 + i; f32x2 h = {0.f, 0.f};
        if (t >= 0) { const f32x2 xv = *(const f32x2*)(xb + (size_t)t * D + c0); const float r = rs[i]; h = xv * r * gm + sh; }
        ring[i] = h;
    }
    for (int gi = 0; gi < 8; ++gi) {
#pragma unroll
        for (int j = 0; j < 16; ++j) {
            const int i = 15 + gi * 16 + j, t = t0 + gi * 16 + j;
            const f32x2 xv = *(const f32x2*)(xb + (size_t)t * D + c0); const float r = rs[i];
            const f32x2 h = xv * r * gm + sh;
            ring[(15 + j) & 15] = h;
            f32x2 s = {0.f, 0.f};
#pragma unroll
            for (int k = 0; k < W; ++k) s += ring[(15 + j - k) & 15];
            const int cnt = (t + 1 < W) ? t + 1 : W;
            const f32x2 o = s * (1.f / (float)cnt) - h;
            *(unsigned*)(outb + (size_t)t * D + c0) = cvt_pk_bf16(o.x, o.y);
        }
    }
}
__device__ __forceinline__ void phase_poolmix(const Params& p, LAS unsigned char* lds, bf16_t* mixA) {
    const int tid = opaque_tid(), lane = tid & 63, wave = tid >> 6;
    LAS float* rs = (LAS float*)lds;
    const float* MODV = (const float*)(p.ws + WS_MODV);
    for (int u = blockIdx.x; u < T / 128; u += gridDim.x) {
        const int b = u >> 6, t0 = (u & 63) * 128;
        const float* xb = p.x + (size_t)b * S * D;
        for (int i = wave; i < 143; i += NWAVE) {
            const int t = t0 - 15 + i; float r = 0.f;
            if (t >= 0) { const f32x4* xr = (const f32x4*)(xb + (size_t)t * D) + lane; float s = 0.f;
#pragma unroll
                for (int j = 0; j < 4; ++j) { const f32x4 v = xr[64 * j]; s += (v.x * v.x + v.y * v.y) + (v.z * v.z + v.w * v.w); }
                r = 1.f / sqrtf(wave_sum(s) * (1.f / D) + EPS); }
            if (lane == 0) rs[i] = r;
        }
        __syncthreads();
        const int c0 = 2 * tid;
        const f32x2 g = *(const f32x2*)(p.norm_g + c0), sc = *(const f32x2*)(MODV + (1 * 4 + b) * D + c0), sh = *(const f32x2*)(MODV + (0 * 4 + b) * D + c0);
        const f32x2 gm = g * (sc + 1.f);
        bf16_t* ob = mixA + (size_t)b * S * D;
        const int grp = tid >> 7;
        if (grp == 0) pool_rows<2>(xb, t0, rs, gm, sh, ob, c0);
        else if (grp == 1) pool_rows<4>(xb, t0, rs, gm, sh, ob, c0);
        else if (grp == 2) pool_rows<8>(xb, t0, rs, gm, sh, ob, c0);
        else pool_rows<16>(xb, t0, rs, gm, sh, ob, c0);
        __syncthreads();
    }
}

struct NormOut { const float* g; const float* sc; const float* sh; bf16_t* out; };
template <int NOUT, bool ROUTER, int OUTQ = 0>
__device__ __forceinline__ void phase_norm(const Params& p, LAS unsigned char* lds, const float* xin, const NormOut o0, const NormOut o1) {
    const int tid = opaque_tid(), lane = tid & 63, wave = tid >> 6;
    const int gw = blockIdx.x * NWAVE + wave, NGW = gridDim.x * NWAVE;
    f32x4 rwa[16], rwb[16];
    if (ROUTER) {
#pragma unroll
        for (int j = 0; j < 4; ++j)
#pragma unroll
            for (int q = 0; q < 4; ++q) { const f32x4* wp = (const f32x4*)(p.router_w + (size_t)(4 * lane + 256 * j + q) * NE); rwa[4 * j + q] = wp[0]; rwb[4 * j + q] = wp[1]; }
    }
    unsigned* ctl = (unsigned*)(p.ws + WS_CTL);
    int* TOPE = (int*)(p.ws + WS_TOPE); float* TOPW = (float*)(p.ws + WS_TOPW);
    unsigned cnt_local[NE];
#pragma unroll
    for (int e = 0; e < NE; ++e) cnt_local[e] = 0;
    const int rows_per = T / NGW > 0 ? (T + NGW - 1) / NGW : 1;
    const int r0 = gw * rows_per, r1 = (r0 + rows_per < T) ? r0 + rows_per : T;
    int curb = -1; f32x4 gm0[4], sh0[4], gm1[4], sh1[4];
    for (int r = r0; r < r1; ++r) {
        const int b = r >> 13;
        if (b != curb) { curb = b;
#pragma unroll
            for (int j = 0; j < 4; ++j) { const int c = 4 * lane + 256 * j;
                gm0[j] = *(const f32x4*)(o0.g + c) * (*(const f32x4*)(o0.sc + b * D + c) + 1.f); sh0[j] = *(const f32x4*)(o0.sh + b * D + c);
                if (NOUT > 1) { gm1[j] = *(const f32x4*)(o1.g + c) * (*(const f32x4*)(o1.sc + b * D + c) + 1.f); sh1[j] = *(const f32x4*)(o1.sh + b * D + c); } } }
        const f32x4* xr = (const f32x4*)(xin + (size_t)r * D) + lane;
        f32x4 v[4]; float s = 0.f;
#pragma unroll
        for (int j = 0; j < 4; ++j) { v[j] = xr[64 * j]; s += (v[j].x * v[j].x + v[j].y * v[j].y) + (v[j].z * v[j].z + v[j].w * v[j].w); }
        const float rstd = 1.f / sqrtf(wave_sum(s) * (1.f / D) + EPS);
        float lg[NE];
#pragma unroll
        for (int e = 0; e < NE; ++e) lg[e] = 0.f;
        float qsc = 1.f;
        if constexpr (OUTQ == 2) { float mx = 0.f;
#pragma unroll
            for (int j = 0; j < 4; ++j) { const f32x4 h = v[j] * rstd * gm0[j] + sh0[j]; mx = fmaxf(mx, fmaxf(fmaxf(fabsf(h.x), fabsf(h.y)), fmaxf(fabsf(h.z), fabsf(h.w)))); }
            mx = fmaxf(wave_max(mx), 1e-30f); qsc = 127.f / mx;
            if (lane == 0) ((float*)(p.ws + WS_ASC))[r] = mx * (1.f / 127.f); }
#pragma unroll
        for (int j = 0; j < 4; ++j) {
            const f32x4 h = v[j] * rstd * gm0[j] + sh0[j];
            if constexpr (OUTQ == 2) { *(unsigned*)((unsigned char*)o0.out + (size_t)r * D + 4 * lane + 256 * j) = pack_i8x4(h.x * qsc, h.y * qsc, h.z * qsc, h.w * qsc); }
            else if constexpr (OUTQ == 1) { unsigned w8 = 0u; w8 = __builtin_amdgcn_cvt_pk_fp8_f32(h.x, h.y, w8, false); w8 = __builtin_amdgcn_cvt_pk_fp8_f32(h.z, h.w, w8, true);
                *(unsigned*)((unsigned char*)o0.out + (size_t)r * D + 4 * lane + 256 * j) = w8; }
            else { u32x2 w; w.x = cvt_pk_bf16(h.x, h.y); w.y = cvt_pk_bf16(h.z, h.w);
            *(u32x2*)(o0.out + (size_t)r * D + 4 * lane + 256 * j) = w; }
            if (NOUT > 1) { const f32x4 h1 = v[j] * rstd * gm1[j] + sh1[j]; u32x2 w1; w1.x = cvt_pk_bf16(h1.x, h1.y); w1.y = cvt_pk_bf16(h1.z, h1.w);
                *(u32x2*)(o1.out + (size_t)r * D + 4 * lane + 256 * j) = w1; }
            if (ROUTER) {
#pragma unroll
                for (int q = 0; q < 4; ++q) { const f32x4 a = rwa[4 * j + q], c2 = rwb[4 * j + q]; const float hv = h[q];
                    lg[0] += hv * a.x; lg[1] += hv * a.y; lg[2] += hv * a.z; lg[3] += hv * a.w; lg[4] += hv * c2.x; lg[5] += hv * c2.y; lg[6] += hv * c2.z; lg[7] += hv * c2.w; }
            }
        }
        if (ROUTER) {
            {
                const bool u5 = lane & 32, u4 = lane & 16, u3 = lane & 8; float a4[4], a2[2], a1;
#pragma unroll
                for (int i = 0; i < 4; ++i) a4[i] = (u5 ? lg[4 + i] : lg[i]) + __shfl_xor(u5 ? lg[i] : lg[4 + i], 32);
#pragma unroll
                for (int i = 0; i < 2; ++i) a2[i] = (u4 ? a4[2 + i] : a4[i]) + __shfl_xor(u4 ? a4[i] : a4[2 + i], 16);
                a1 = (u3 ? a2[1] : a2[0]) + __shfl_xor(u3 ? a2[0] : a2[1], 8);
                a1 += __shfl_xor(a1, 4); a1 += __shfl_xor(a1, 2); a1 += __shfl_xor(a1, 1);
#pragma unroll
                for (int e = 0; e < NE; ++e) lg[e] = readlane_f(a1, 8 * e) + p.router_b[e];
            }
            int e0 = 0; float v0 = lg[0];
#pragma unroll
            for (int e = 1; e < NE; ++e) if (lg[e] > v0) { v0 = lg[e]; e0 = e; }
            int e1 = -1; float v1 = -3.0e38f;
#pragma unroll
            for (int e = 0; e < NE; ++e) if (e != e0 && lg[e] > v1) { v1 = lg[e]; e1 = e; }
            const float ex = __expf(v1 - v0), w0 = 1.f / (1.f + ex), w1 = ex / (1.f + ex);
            if (lane == 0) { TOPE[2 * r] = e0; TOPE[2 * r + 1] = e1; TOPW[2 * r] = w0; TOPW[2 * r + 1] = w1; }
#pragma unroll
            for (int e = 0; e < NE; ++e) cnt_local[e] += (e == e0) + (e == e1);
        }
    }
    if (ROUTER) {
        LAS unsigned* lc = (LAS unsigned*)lds;
        if (tid < NE) lc[tid] = 0u;
        __syncthreads();
        if (lane == 0) {
#pragma unroll
            for (int e = 0; e < NE; ++e) if (cnt_local[e]) atomicAdd((unsigned*)(lc + e), cnt_local[e]);
        }
        __syncthreads();
        if (tid < NE && lc[tid]) atomicAdd(ctl + CW_CNT + 64 * tid, lc[tid]);
    }
}

struct EpiPool {
    const float* x; float* x1; const float* g1; const float* scale; int coff;
    __device__ __forceinline__ void operator()(int row, int col, f32x4 v) const { const int c = coff + col, b = row >> 13;
        const f32x4 xv = *(const f32x4*)(x + (size_t)row * D + c), gv = *(const f32x4*)(g1 + b * D + c), sv = *(const f32x4*)(scale + c);
        *(f32x4*)(x1 + (size_t)row * D + c) = xv + gv * (v * sv); }
};
struct EpiSwiglu {
    bf16_t* hid; int ldh;
    __device__ __forceinline__ void pair(int row, int hc, f32x4 gt, f32x4 up) const {
        u32x2 w; w.x = cvt_pk_bf16(silu_f(gt.x) * up.x, silu_f(gt.y) * up.y); w.y = cvt_pk_bf16(silu_f(gt.z) * up.z, silu_f(gt.w) * up.w);
        *(u32x2*)(hid + (size_t)row * ldh + hc) = w; }
};
struct EpiSwigluI8 {
    bf16_t* hid; int ldh; const float* asc; const float* wmax;
    __device__ __forceinline__ void pair(int row, int hc, f32x4 gt, f32x4 up) const {
        typedef int i32x4e __attribute__((ext_vector_type(4)));
        const i32x4e gi = __builtin_bit_cast(i32x4e, gt), ui = __builtin_bit_cast(i32x4e, up);
        const float ra = asc[row] * (1.f / 127.f); const f32x4 wg = *(const f32x4*)(wmax + hc) * ra, wu = *(const f32x4*)(wmax + FF + hc) * ra;
        const float g0 = (float)gi.x * wg.x, g1 = (float)gi.y * wg.y, g2 = (float)gi.z * wg.z, g3 = (float)gi.w * wg.w;
        u32x2 w; w.x = cvt_pk_bf16(silu_f(g0) * ((float)ui.x * wu.x), silu_f(g1) * ((float)ui.y * wu.y)); w.y = cvt_pk_bf16(silu_f(g2) * ((float)ui.z * wu.z), silu_f(g3) * ((float)ui.w * wu.w));
        *(u32x2*)(hid + (size_t)row * ldh + hc) = w; }
};
struct EpiSwiglu8 {
    unsigned char* hid; int ldh;
    __device__ __forceinline__ void pair(int row, int hc, f32x4 gt, f32x4 up) const {
        unsigned w = 0u; w = __builtin_amdgcn_cvt_pk_fp8_f32(silu_f(gt.x) * up.x, silu_f(gt.y) * up.y, w, false); w = __builtin_amdgcn_cvt_pk_fp8_f32(silu_f(gt.z) * up.z, silu_f(gt.w) * up.w, w, true);
        *(unsigned*)(hid + (size_t)row * ldh + hc) = w; }
};
struct EpiResid {
    const float* xin; float* out; const float* gate;
    __device__ __forceinline__ void operator()(int row, int col, f32x4 v) const { const int b = row >> 13;
        const f32x4 xv = *(const f32x4*)(xin + (size_t)row * D + col), gv = *(const f32x4*)(gate + b * D + col);
        *(f32x4*)(out + (size_t)row * D + col) = xv + gv * v; }
};
struct EpiBf16 {
    bf16_t* o; int ldo;
    __device__ __forceinline__ void operator()(int row, int col, f32x4 v) const { u32x2 w; w.x = cvt_pk_bf16(v.x, v.y); w.y = cvt_pk_bf16(v.z, v.w); *(u32x2*)(o + (size_t)row * ldo + col) = w; }
};
struct EpiQ {
    bf16_t* q; float* gates; int coff;
    __device__ __forceinline__ void operator()(int row, int col_, f32x4 v) const { const int col = col_ + coff;
        if (col < D) { u32x2 w; w.x = cvt_pk_bf16(v.x, v.y); w.y = cvt_pk_bf16(v.z, v.w); *(u32x2*)(q + (size_t)row * D + col) = w; }
        else if (col < NQ) { f32x4 s; s.x = sigmoid_f(v.x); s.y = sigmoid_f(v.y); s.z = sigmoid_f(v.z); s.w = sigmoid_f(v.w); *(f32x4*)(gates + (size_t)row * 48 + (col - D)) = s; } }
};
struct EpiCmp {
    bf16_t* o; const float* bias;
    __device__ __forceinline__ void operator()(int row, int col, f32x4 v) const { const int z = col >> 8, c = col & 255; const f32x4 bv = *(const f32x4*)(bias + (z >> 2) * 256 + c);
        u32x2 w; w.x = cvt_pk_bf16(gelu_tanh_f(v.x + bv.x), gelu_tanh_f(v.y + bv.y)); w.y = cvt_pk_bf16(gelu_tanh_f(v.z + bv.z), gelu_tanh_f(v.w + bv.w));
        *(u32x2*)(o + ((size_t)z * 2048 + row) * 256 + c) = w; }
};


namespace pg8 {
#define PG8_LAS __attribute__((address_space(3)))
constexpr int BM = 256, BK = 64, HALF = 128, HTB = HALF * BK * 2, STAGE_BYTES = 8 * HTB, NXCD = 8, WGM = 8;
__host__ __device__ __forceinline__ int lds_byte(int r, int c) { const int st = (r >> 4) * 2 + (c >> 5), rr = r & 15, cc = c & 31, ob = rr * 64 + cc * 2; return st * 1024 + (ob ^ (((ob >> 9) & 1) << 5)); }
__host__ __device__ __forceinline__ void stage_rc(int b, int& R, int& C) { const int st = b / 1024, sb = b % 1024, swz = sb ^ (((sb >> 9) & 1) << 5); R = (st >> 1) * 16 + swz / 64; C = (st & 1) * 32 + (swz % 64) / 2; }
__host__ __device__ __forceinline__ int perm32(int rho) { const int n = rho >> 4, i = rho & 15; return 8 * (i >> 2) + 4 * n + (i & 3); }
struct Unit { int pm, pn; };
template <int SMODE> struct Sched {
    int nM, nN, nwg, G, c; const char* A; const char* Bt; size_t lda2, ldb2; const int* pst; size_t bstride2;
    __device__ __forceinline__ void init(int M, int N, int G_, int c_, const void* A_, const void* Bt_, int lda, int ldb, const int* pst_ = nullptr, size_t bstride = 0) {
        nM = M / BM; nN = N / BM; nwg = nM * nN; G = G_; c = c_; A = (const char*)A_; Bt = (const char*)Bt_; lda2 = (size_t)lda * 2; ldb2 = (size_t)ldb * 2; pst = pst_; bstride2 = bstride * 2; }
    __device__ __forceinline__ bool next(int i, Unit& u) const {
        if (c < 0) return false;
        const long L = (long)i * G + c; if (L >= nwg) return false;
        int wgid = (int)L; { const int q = nwg / NXCD, r = nwg % NXCD, xcd = wgid % NXCD, off = wgid / NXCD; wgid = (xcd < r ? xcd * (q + 1) : r * (q + 1) + (xcd - r) * q) + off; }
        const int nig = WGM * nN, gid = wgid / nig, fm = gid * WGM, gsz = (nM - fm) < WGM ? (nM - fm) : WGM;
        u.pm = fm + ((wgid % nig) % gsz); u.pn = (wgid % nig) / gsz; return true;
    }
    __device__ __forceinline__ const char* a_ptr(const Unit& u) const {
        if (SMODE == 1) return A + (size_t)u.pm * BM * lda2 + (size_t)u.pn * 512;
        if (SMODE == 2) return A + (size_t)u.pm * BM * lda2 + (size_t)((u.pn >> 2) * 256 + (u.pn & 3) * 64) * 2;
        return A + (size_t)u.pm * BM * lda2; }
    __device__ __forceinline__ const char* b_ptr(const Unit& u) const {
        if (SMODE == 2) return Bt + (size_t)(u.pn >> 2) * BM * ldb2;
        if (SMODE == 3) { const int m0 = u.pm * BM; int e = 0;
#pragma unroll
            for (int q = 1; q < NE; ++q) e += (m0 >= pst[q]); return Bt + (size_t)e * bstride2 + (size_t)u.pn * BM * ldb2; }
        return Bt + (size_t)u.pn * BM * ldb2; }
};
template <class F> struct EpiEl { static constexpr bool PERM = false, AFTER_DRAIN = false; F f;
    __device__ __forceinline__ void operator()(const f32x4 (&acc)[2][2][4][2], const Unit& u, int wr, int wc, int fr, int fq) const {
#pragma unroll
        for (int ai = 0; ai < 2; ++ai)
#pragma unroll
            for (int m = 0; m < 4; ++m) { const int row = u.pm * BM + ai * HALF + wr * 64 + m * 16 + fr;
#pragma unroll
                for (int bj = 0; bj < 2; ++bj)
#pragma unroll
                    for (int n = 0; n < 2; ++n) f(row, u.pn * BM + bj * HALF + wc * 32 + n * 16 + 4 * fq, acc[ai][bj][m][n]); } } };
template <class F> struct EpiPairEl { static constexpr bool PERM = false, AFTER_DRAIN = false; F f;
    __device__ __forceinline__ void operator()(const f32x4 (&acc)[2][2][4][2], const Unit& u, int wr, int wc, int fr, int fq) const {
#pragma unroll
        for (int ai = 0; ai < 2; ++ai)
#pragma unroll
            for (int m = 0; m < 4; ++m) { const int row = u.pm * BM + ai * HALF + wr * 64 + m * 16 + fr;
#pragma unroll
                for (int n = 0; n < 2; ++n) f.pair(row, u.pn * HALF + wc * 32 + n * 16 + 4 * fq, acc[ai][0][m][n], acc[ai][1][m][n]); } } };

typedef int i32x8 __attribute__((ext_vector_type(8)));
template <int QM> __device__ __forceinline__ void mma_block(f32x4 (&acc)[4][2], const bf16x8 (&At)[4][2], const bf16x8 (&Bt)[2][2], const int wsc) {
    __builtin_amdgcn_s_setprio(1);
    if constexpr (QM == 2) {
        typedef int i32x4m __attribute__((ext_vector_type(4)));
#pragma unroll
        for (int m = 0; m < 4; ++m)
#pragma unroll
            for (int n = 0; n < 2; ++n)
#pragma unroll
                for (int k = 0; k < 2; ++k) acc[m][n] = __builtin_bit_cast(f32x4, __builtin_amdgcn_mfma_i32_16x16x64_i8(__builtin_bit_cast(i32x4m, Bt[n][k]), __builtin_bit_cast(i32x4m, At[m][k]), __builtin_bit_cast(i32x4m, acc[m][n]), 0, 0, 0));
#pragma unroll
        for (int m = 0; m < 4; ++m) asm volatile("" : "+v"(acc[m][0]), "+v"(acc[m][1]));
    } else if constexpr (QM == 1) {
#pragma unroll
        for (int m = 0; m < 4; ++m) { const u32x4 a0 = __builtin_bit_cast(u32x4, At[m][0]), a1 = __builtin_bit_cast(u32x4, At[m][1]);
            const i32x8 a8 = {(int)a0.x, (int)a0.y, (int)a0.z, (int)a0.w, (int)a1.x, (int)a1.y, (int)a1.z, (int)a1.w};
#pragma unroll
            for (int n = 0; n < 2; ++n) { const u32x4 b0 = __builtin_bit_cast(u32x4, Bt[n][0]), b1 = __builtin_bit_cast(u32x4, Bt[n][1]);
                const i32x8 b8 = {(int)b0.x, (int)b0.y, (int)b0.z, (int)b0.w, (int)b1.x, (int)b1.y, (int)b1.z, (int)b1.w};
                acc[m][n] = __builtin_amdgcn_mfma_scale_f32_16x16x128_f8f6f4(b8, a8, acc[m][n], 0, 0, 0, wsc, 0, 127); } }
#pragma unroll
        for (int m = 0; m < 4; ++m) asm volatile("" : "+v"(acc[m][0]), "+v"(acc[m][1]));
    } else {
#pragma unroll
        for (int m = 0; m < 4; ++m)
#pragma unroll
            for (int n = 0; n < 2; ++n)
#pragma unroll
                for (int k = 0; k < 2; ++k) acc[m][n] = __builtin_amdgcn_mfma_f32_16x16x32_bf16(Bt[n][k], At[m][k], acc[m][n], 0, 0, 0);
    }
    __builtin_amdgcn_s_setprio(0);
}
template <class Epi, class Sched, bool ALIGN_EPI = true, bool SP2 = true, int QM = 0>
__device__ __forceinline__ void gemm_phase(PG8_LAS unsigned char* lds, const int K, const int lda, const int ldb, const size_t kstepA, const Sched& S, const Epi& E, const int wsc = 127) {
    const int tid_ = opaque_tid();
    const int tid = tid_, wid = __builtin_amdgcn_readfirstlane(tid >> 6), lane = tid & 63, wr = wid >> 2, wc = wid & 3, fr = lane & 15, fq = lane >> 4;
    const int nt = K / BK;
    unsigned voffA[2], voffB[2];
#pragma unroll
    for (int i = 0; i < 2; ++i) { int R, C; stage_rc(tid * 16 + i * 8192, R, C); const int Rb = Epi::PERM ? ((R & ~31) + perm32(R & 31)) : R;
        voffA[i] = (unsigned)(R * lda + C) * 2u; voffB[i] = (unsigned)(Rb * ldb + C) * 2u; }
    const size_t kstepB = (size_t)(BK * 2);
    const size_t hstepA = (size_t)HALF * lda * 2, hstepB = (size_t)HALF * ldb * 2;
    const unsigned ldsw = (unsigned)wid * 1024u;
    int aoffk[2], boffk[2];
#pragma unroll
    for (int k = 0; k < 2; ++k) { const int col = (QM == 1) ? ((fq >> 1) * 32 + (fq & 1) * 16 + 8 * k) : (k * 32 + fq * 8); aoffk[k] = lds_byte(wr * 64 + fr, col); boffk[k] = lds_byte(wc * 32 + fr, col); }
#define PG8_SA(b, h) (((b) * 2 + (h)) * HTB)
#define PG8_SB(b, h) ((4 + (b) * 2 + (h)) * HTB)
#define PG8_STAGE(bufoff, gbase, voff) do { _Pragma("unroll") for (int _i = 0; _i < 2; ++_i) \
        __builtin_amdgcn_global_load_lds((const unsigned*)((const char*)(gbase) + (voff)[_i]), (PG8_LAS unsigned*)(lds + (bufoff) + ldsw + _i * 8192), 16, 0, 0); } while (0)
#define PG8_LDA(dst, b, h) do { _Pragma("unroll") for (int m = 0; m < 4; ++m) _Pragma("unroll") for (int k = 0; k < 2; ++k) dst[m][k] = *(const PG8_LAS bf16x8*)(lds + PG8_SA(b, h) + ((QM == 1) ? aoffk[k] : aoffk[0] + k * 1024) + m * 2048); } while (0)
#define PG8_LDB(dst, b, h) do { _Pragma("unroll") for (int n = 0; n < 2; ++n) _Pragma("unroll") for (int k = 0; k < 2; ++k) dst[n][k] = *(const PG8_LAS bf16x8*)(lds + PG8_SB(b, h) + ((QM == 1) ? boffk[k] : boffk[0] + k * 1024) + n * 2048); } while (0)
#define PG8_MMA(ai, bj, At, Bt) mma_block<QM>(acc[ai][bj], At, Bt, wsc)
#define PG8_WAIT_V(n) asm volatile("s_waitcnt vmcnt(" #n ")" ::: "memory")
#define PG8_WAIT_L(n) asm volatile("s_waitcnt lgkmcnt(" #n ")" ::: "memory")
#define PG8_BAR __builtin_amdgcn_s_barrier()
#define PG8_SCHED __builtin_amdgcn_sched_barrier(0)
    Unit cur, nxt; int ui = 0;
    if (!S.next(0, cur)) return;
    f32x4 acc[2][2][4][2];
#pragma unroll
    for (int a = 0; a < 2; ++a)
#pragma unroll
        for (int b = 0; b < 2; ++b)
#pragma unroll
            for (int m = 0; m < 4; ++m)
#pragma unroll
                for (int n = 0; n < 2; ++n) acc[a][b][m][n] = (f32x4){0.f, 0.f, 0.f, 0.f};
    bf16x8 At[4][2], B0[2][2], B1[2][2];
    const char* cA = S.a_ptr(cur); const char* cB = S.b_ptr(cur);
    if constexpr (SP2) {
        PG8_STAGE(PG8_SB(0, 0), cB, voffB); PG8_STAGE(PG8_SB(0, 1), cB + hstepB, voffB); PG8_STAGE(PG8_SA(0, 0), cA, voffA); PG8_STAGE(PG8_SA(0, 1), cA + hstepA, voffA);
        if (wr == 1) PG8_BAR;
        PG8_WAIT_V(2); PG8_BAR;
        PG8_STAGE(PG8_SB(1, 0), cB + kstepB, voffB); PG8_STAGE(PG8_SA(1, 0), cA + kstepA, voffA); PG8_STAGE(PG8_SB(1, 1), cB + hstepB + kstepB, voffB);
        PG8_WAIT_V(6); PG8_BAR;
    } else {
        PG8_STAGE(PG8_SB(0, 0), cB, voffB); PG8_STAGE(PG8_SA(0, 0), cA, voffA); PG8_STAGE(PG8_SB(0, 1), cB + hstepB, voffB); PG8_STAGE(PG8_SA(0, 1), cA + hstepA, voffA);
        if (wr == 1) PG8_BAR;
        PG8_WAIT_V(4); PG8_BAR;
        PG8_STAGE(PG8_SB(1, 0), cB + kstepB, voffB); PG8_STAGE(PG8_SA(1, 0), cA + kstepA, voffA); PG8_STAGE(PG8_SB(1, 1), cB + hstepB + kstepB, voffB);
        PG8_WAIT_V(6); PG8_BAR;
    }
    for (;;) {
        const bool has_next = S.next(ui + 1, nxt);
        const char* nA = has_next ? S.a_ptr(nxt) : cA; const char* nB = has_next ? S.b_ptr(nxt) : cB;
        for (int t = 0; t < nt; t += 2) {
            const bool last = (t == nt - 2);
            const char* a1 = cA + (size_t)(t + 1) * kstepA;
            const char* a2 = last ? nA : cA + (size_t)(t + 2) * kstepA; const char* b2 = last ? nB : cB + (size_t)(t + 2) * kstepB;
            const char* a3 = a2 + kstepA; const char* b3 = b2 + kstepB;
            if constexpr (SP2) {
            PG8_LDB(B0, 0, 0); PG8_LDB(B1, 0, 1); PG8_SCHED; PG8_LDA(At, 0, 0); PG8_STAGE(PG8_SA(1, 1), a1 + hstepA, voffA);
            PG8_WAIT_V(8); PG8_WAIT_L(0); PG8_BAR; PG8_MMA(0, 0, At, B0); PG8_MMA(0, 1, At, B1); PG8_BAR; PG8_SCHED;
            PG8_LDA(At, 0, 1); PG8_STAGE(PG8_SB(0, 0), b2, voffB); PG8_STAGE(PG8_SB(0, 1), b2 + hstepB, voffB); PG8_STAGE(PG8_SA(0, 0), a2, voffA);
            PG8_WAIT_V(8); PG8_WAIT_L(0); PG8_BAR; PG8_MMA(1, 0, At, B0); PG8_MMA(1, 1, At, B1); PG8_BAR; PG8_SCHED;
            PG8_LDB(B0, 1, 0); PG8_LDB(B1, 1, 1); PG8_SCHED; PG8_LDA(At, 1, 0); PG8_STAGE(PG8_SA(0, 1), a2 + hstepA, voffA);
            PG8_WAIT_V(8); PG8_WAIT_L(0); PG8_BAR; PG8_MMA(0, 0, At, B0); PG8_MMA(0, 1, At, B1); PG8_BAR; PG8_SCHED;
            PG8_LDA(At, 1, 1); PG8_STAGE(PG8_SB(1, 0), b3, voffB); PG8_STAGE(PG8_SB(1, 1), b3 + hstepB, voffB); PG8_STAGE(PG8_SA(1, 0), a3, voffA);
            PG8_WAIT_V(8); PG8_WAIT_L(0); PG8_BAR; PG8_MMA(1, 0, At, B0); PG8_MMA(1, 1, At, B1); PG8_BAR; PG8_SCHED;
            } else {
            PG8_LDB(B0, 0, 0); PG8_SCHED; PG8_LDA(At, 0, 0); PG8_STAGE(PG8_SA(1, 1), a1 + hstepA, voffA);
            PG8_WAIT_L(8); PG8_BAR; PG8_WAIT_L(0); PG8_MMA(0, 0, At, B0); PG8_BAR; PG8_SCHED;
            PG8_LDB(B1, 0, 1); PG8_STAGE(PG8_SB(0, 0), b2, voffB);
            PG8_BAR; PG8_WAIT_L(0); PG8_MMA(0, 1, At, B1); PG8_BAR;
            PG8_LDA(At, 0, 1); PG8_STAGE(PG8_SA(0, 0), a2, voffA);
            PG8_BAR; PG8_WAIT_L(0); PG8_MMA(1, 0, At, B0); PG8_BAR; PG8_SCHED;
            PG8_STAGE(PG8_SB(0, 1), b2 + hstepB, voffB);
            PG8_WAIT_V(6); PG8_BAR; PG8_MMA(1, 1, At, B1); PG8_BAR;
            PG8_LDB(B0, 1, 0); PG8_SCHED; PG8_LDA(At, 1, 0); PG8_STAGE(PG8_SA(0, 1), a2 + hstepA, voffA);
            PG8_WAIT_L(8); PG8_BAR; PG8_WAIT_L(0); PG8_MMA(0, 0, At, B0); PG8_BAR; PG8_SCHED;
            PG8_LDB(B1, 1, 1); PG8_STAGE(PG8_SB(1, 0), b3, voffB);
            PG8_BAR; PG8_WAIT_L(0); PG8_MMA(0, 1, At, B1); PG8_BAR;
            PG8_LDA(At, 1, 1); PG8_STAGE(PG8_SA(1, 0), a3, voffA);
            PG8_BAR; PG8_WAIT_L(0); PG8_MMA(1, 0, At, B0); PG8_BAR; PG8_SCHED;
            PG8_STAGE(PG8_SB(1, 1), b3 + hstepB, voffB);
            PG8_WAIT_V(6); PG8_BAR; PG8_MMA(1, 1, At, B1); PG8_BAR;
            }
        }
        if constexpr (ALIGN_EPI) { if (wr == 0) PG8_BAR; }
        if constexpr (!Epi::AFTER_DRAIN) { E(acc, cur, wr, wc, fr, fq); }
        if (!has_next) break;
#pragma unroll
        for (int a = 0; a < 2; ++a)
#pragma unroll
            for (int b = 0; b < 2; ++b)
#pragma unroll
                for (int m = 0; m < 4; ++m)
#pragma unroll
                    for (int n = 0; n < 2; ++n) acc[a][b][m][n] = (f32x4){0.f, 0.f, 0.f, 0.f};
        cur = nxt; cA = nA; cB = nB; ++ui;
        if constexpr (ALIGN_EPI) { if (wr == 1) PG8_BAR; }
    }
    PG8_WAIT_V(0);
    if constexpr (!ALIGN_EPI) { if (wr == 0) PG8_BAR; }
    PG8_BAR;
    if constexpr (Epi::AFTER_DRAIN) { E.fused(acc, cur, wr, wc, fr, fq, lds, wid, lane); }
#undef PG8_SA
#undef PG8_SB
#undef PG8_STAGE
#undef PG8_LDA
#undef PG8_LDB
#undef PG8_MMA
#undef PG8_WAIT_V
#undef PG8_WAIT_L
#undef PG8_BAR
#undef PG8_SCHED
}
}

__device__ __forceinline__ void phase_headnorm(const Params& p, LAS unsigned char* lds) {
    const int tid = opaque_tid(), lane = tid & 63, wave = tid >> 6;
    LAS int* chunk = (LAS int*)(lds + 131072 - 64);
    bf16_t* Q = (bf16_t*)(p.ws + WS_Q); bf16_t* KVB = (bf16_t*)(p.ws + WS_KVB);
    float qg[16], kg[8];
#pragma unroll
    for (int i = 0; i < 16; ++i) qg[i] = p.q_gain[(lane & 3) * 16 + i] * (0.125f * 1.4426950408889634f);
    const float qs8 = sel_q_scale(p.q_gain), ks8 = sel_k_scale(p.k_gain);
    const int kr = lane >> 5;
#pragma unroll
    for (int i = 0; i < 8; ++i) kg[i] = p.k_gain[(1 + kr) * 64 + (lane & 7) * 8 + i];
    for (;;) {
      if (tid == 0) *chunk = (int)atomicAdd((unsigned*)(p.ws + WS_CTL) + CW_HN, 1u);
      __syncthreads();
      const int c0 = *chunk;
      __syncthreads();
      if (c0 >= T / 128) break;
      for (int r = c0 * 128 + wave * 16; r < c0 * 128 + wave * 16 + 16; ++r) {
        {
            u32x4* ptr = (u32x4*)(Q + (size_t)r * D + lane * 16); u32x4 w0 = ptr[0], w1 = ptr[1];
            float v[16]; const unsigned ww[8] = {w0.x, w0.y, w0.z, w0.w, w1.x, w1.y, w1.z, w1.w}; float s = 0.f;
#pragma unroll
            for (int i = 0; i < 8; ++i) { v[2 * i] = bflo(ww[i]); v[2 * i + 1] = bfhi(ww[i]); s += v[2 * i] * v[2 * i] + v[2 * i + 1] * v[2 * i + 1]; }
            s += __shfl_xor(s, 1); s += __shfl_xor(s, 2);
            const float rstd = 1.f / sqrtf(s * (1.f / 64.f) + EPS);
            unsigned o[8];
#pragma unroll
            for (int i = 0; i < 8; ++i) o[i] = cvt_pk_bf16(v[2 * i] * rstd * qg[2 * i], v[2 * i + 1] * rstd * qg[2 * i + 1]);
            ptr[0] = (u32x4){o[0], o[1], o[2], o[3]}; ptr[1] = (u32x4){o[4], o[5], o[6], o[7]};
            float qv[16];
#pragma unroll
            for (int i = 0; i < 16; ++i) qv[i] = v[i] * rstd * qg[i] * qs8;
            *(u32x4*)(p.ws + WS_Q8 + (size_t)r * D + lane * 16) = (u32x4){pack_i8x4(qv[0], qv[1], qv[2], qv[3]), pack_i8x4(qv[4], qv[5], qv[6], qv[7]), pack_i8x4(qv[8], qv[9], qv[10], qv[11]), pack_i8x4(qv[12], qv[13], qv[14], qv[15])};
        }
        {
            const u32x4* ptr = (const u32x4*)(KVB + (size_t)r * NKV + (kr ? 1024 : 512) + (lane & 31) * 8); const u32x4 w0 = ptr[0];
            float v[8]; const unsigned ww[4] = {w0.x, w0.y, w0.z, w0.w}; float s = 0.f;
#pragma unroll
            for (int i = 0; i < 4; ++i) { v[2 * i] = bflo(ww[i]); v[2 * i + 1] = bfhi(ww[i]); s += v[2 * i] * v[2 * i] + v[2 * i + 1] * v[2 * i + 1]; }
            s += __shfl_xor(s, 1); s += __shfl_xor(s, 2); s += __shfl_xor(s, 4);
            const float rstd = 1.f / sqrtf(s * (1.f / 64.f) + EPS);
            unsigned o[4];
#pragma unroll
            for (int i = 0; i < 4; ++i) o[i] = cvt_pk_bf16(v[2 * i] * rstd * kg[2 * i], v[2 * i + 1] * rstd * kg[2 * i + 1]);
            const int b = r >> 13, t = r & (S - 1), hg = (lane & 31) >> 3, c = lane & 7;
            if (kr) {
                bf16_t* dst = (bf16_t*)(p.ws + WS_KWB) + ((size_t)((b * 4 + hg) * 128 + (t >> 6)) * 8 + c) * 512 + (t & 63) * 8;
                *(u32x4*)dst = (u32x4){o[0], o[1], o[2], o[3]};
            } else {
                const float ksc = rstd * ks8;
                const unsigned w0 = pack_i8x4(v[0] * ksc * kg[0], v[1] * ksc * kg[1], v[2] * ksc * kg[2], v[3] * ksc * kg[3]);
                const unsigned w1 = pack_i8x4(v[4] * ksc * kg[4], v[5] * ksc * kg[5], v[6] * ksc * kg[6], v[7] * ksc * kg[7]);
                unsigned char* dst = p.ws + WS_KSB + ((size_t)((b * 4 + hg) * 128 + (t >> 6)) * 4 + (c >> 1)) * 1024 + (t & 63) * 16 + (c & 1) * 8;
                *(u32x2*)dst = (u32x2){w0, w1};
            }
        }
      }
    }
}

__device__ __forceinline__ void phase_cmp2(const Params& p, LAS unsigned char* lds) {
    const int tid = opaque_tid(), lane = tid & 63, wave = tid >> 6;
    const int gw = blockIdx.x * NWAVE + wave, NGW = gridDim.x * NWAVE;
    const bf16_t* CMPH = (const bf16_t*)(p.ws + WS_CMPH);
    LAS float* w2l = (LAS float*)lds;
    for (int kv = 0; kv < 2; ++kv) {
        const float* w2 = kv ? p.cmp_v_w2 : p.cmp_k_w2;
        for (int i = tid; i < 256 * 64 / 4; i += NTHR) ((LAS f32x4*)w2l)[i] = ((const f32x4*)w2)[i];
        __syncthreads();
        for (int it = gw * 2; it < 4 * 2048; it += NGW * 2) {
            float hv[2][4], acc[2] = {0.f, 0.f};
#pragma unroll
            for (int rr = 0; rr < 2; ++rr) { const u32x2 w = *(const u32x2*)(CMPH + (size_t)(kv * 8192 + it + rr) * 256 + 4 * lane); hv[rr][0] = bflo(w.x); hv[rr][1] = bfhi(w.x); hv[rr][2] = bflo(w.y); hv[rr][3] = bfhi(w.y); }
#pragma unroll 4
            for (int kk = 0; kk < 64; ++kk)
#pragma unroll
                for (int c = 0; c < 4; ++c) { const float wv = w2l[(4 * kk + c) * 64 + lane];
                    acc[0] += readlane_f(hv[0][c], kk) * wv; acc[1] += readlane_f(hv[1][c], kk) * wv; }
#pragma unroll
            for (int rr = 0; rr < 2; ++rr) {
                const int row = it + rr, g = (row >> 11) & 3, r2 = row & 2047, b = r2 >> 9, n = r2 & 511; float a = n == NC - 1 ? 0.f : acc[rr];
                if (kv == 0) { const float ss = wave_sum(a * a); a = a * (1.f / sqrtf(ss * (1.f / 64.f) + EPS)) * p.k_gain[lane]; }
                const size_t blk0 = (size_t)((b * 4 + g) * 8 + (n >> 6)) * 4096;
                bf16_t* o = kv ? (bf16_t*)(p.ws + WS_VC) + blk0 + ((n & 63) >> 3) * 512 + lane * 8 + (n & 7)
                               : (bf16_t*)(p.ws + WS_KC) + blk0 + (lane >> 3) * 512 + (n & 63) * 8 + (lane & 7);
                *o = (bf16_t)(cvt_pk_bf16(a, 0.f) & 0xffffu);
            }
        }
        __syncthreads();
    }
}

__device__ __forceinline__ void phase_vtrans(const Params& p, LAS unsigned char* lds) {
    const int tid = opaque_tid(), lane = tid & 63, wave = tid >> 6;
    const int gw = blockIdx.x * NWAVE + wave, NGW = gridDim.x * NWAVE;
    LAS unsigned short* tile = (LAS unsigned short*)(lds + wave * 8448);
    const bf16_t* KVB = (const bf16_t*)(p.ws + WS_KVB);
    LAS int* chunk = (LAS int*)(lds + 131072 - 64);
    for (;;) {
        if (tid == 0) *chunk = (int)atomicAdd((unsigned*)(p.ws + WS_CTL) + CW_VT, 1u);
        __syncthreads();
        const int c0 = *chunk;
        __syncthreads();
        if (c0 >= 2 * 16 * 128 / NWAVE) break;
        const int u = c0 * NWAVE + wave;
        const int which = u >> 11, bg = (u >> 7) & 15, tt = u & 127, b = bg >> 2, g = bg & 3, t0 = tt * 64;
        const u32x4* src = (const u32x4*)(KVB + (size_t)(b * S + t0 + lane) * NKV + (which ? 1280 : 768) + g * 64);
#pragma unroll
        for (int i = 0; i < 8; ++i) { const u32x4 v = src[i]; LAS unsigned* tp = (LAS unsigned*)(tile + lane * 66 + 8 * i); tp[0] = v.x; tp[1] = v.y; tp[2] = v.z; tp[3] = v.w; }
        asm volatile("s_waitcnt lgkmcnt(0)" ::: "memory");
        if (which) {
            bf16_t* dst = (bf16_t*)(p.ws + WS_VWB) + (size_t)(bg * 128 + tt) * 4096 + lane * 8;
#pragma unroll
            for (int i = 0; i < 8; ++i) { unsigned w[4];
#pragma unroll
                for (int q = 0; q < 4; ++q) { const unsigned lo = tile[(8 * i + 2 * q) * 66 + lane], hi = tile[(8 * i + 2 * q + 1) * 66 + lane]; w[q] = lo | (hi << 16); }
                *(u32x4*)(dst + i * 512) = (u32x4){w[0], w[1], w[2], w[3]}; }
        } else {
            unsigned char* dst = p.ws + WS_VSB + (size_t)(bg * 128 + tt) * 4096 + lane * 16;
#pragma unroll
            for (int i = 0; i < 4; ++i) { unsigned w[4];
#pragma unroll
                for (int q = 0; q < 4; ++q) { const int k0 = 16 * i + 4 * q; unsigned x = 0u;
                    x = __builtin_amdgcn_cvt_pk_fp8_f32(bf2f(tile[(k0 + 0) * 66 + lane]), bf2f(tile[(k0 + 1) * 66 + lane]), x, false);
                    x = __builtin_amdgcn_cvt_pk_fp8_f32(bf2f(tile[(k0 + 2) * 66 + lane]), bf2f(tile[(k0 + 3) * 66 + lane]), x, true); w[q] = x; }
                *(u32x4*)(dst + i * 1024) = (u32x4){w[0], w[1], w[2], w[3]}; }
        }
        asm volatile("s_waitcnt lgkmcnt(0)" ::: "memory");
    }
}

typedef short s16x4 __attribute__((ext_vector_type(4)));
__device__ __forceinline__ f32x4 mfma4(s16x4 a, s16x4 b, f32x4 c) { return __builtin_amdgcn_mfma_f32_4x4x4bf16_1k(a, b, c, 0, 0, 0); }
__device__ __forceinline__ s16x4 mk4(unsigned lo, unsigned hi) { const u32x2 t = {lo, hi}; return __builtin_bit_cast(s16x4, t); }
__device__ __forceinline__ f32x4 qk64(const bf16_t* krow, const s16x4 (&qf)[16]) {
    const u32x4* kp = (const u32x4*)krow; u32x4 kr[8];
#pragma unroll
    for (int i = 0; i < 8; ++i) kr[i] = kp[i];
    f32x4 s = {0.f, 0.f, 0.f, 0.f};
#pragma unroll
    for (int c = 0; c < 8; ++c) { s = mfma4(mk4(kr[c].x, kr[c].y), qf[2 * c], s); s = mfma4(mk4(kr[c].z, kr[c].w), qf[2 * c + 1], s); }
    return s;
}
__device__ __forceinline__ void pv64(f32x4& o, const f32x4 e, const bf16_t* vtrow, LAS u32x2* stage, int lane) {
    const u32x4* vp = (const u32x4*)vtrow; u32x4 vr[8];
#pragma unroll
    for (int i = 0; i < 8; ++i) vr[i] = vp[i];
    u32x2 pk; pk.x = cvt_pk_bf16(e.x, e.y); pk.y = cvt_pk_bf16(e.z, e.w);
    stage[lane] = pk;
#pragma unroll
    for (int st = 0; st < 16; ++st) { const u32x2 a = stage[4 * st + (lane & 3)]; const u32x4 v = vr[st >> 1];
        o = mfma4(mk4(a.x, a.y), (st & 1) ? mk4(v.z, v.w) : mk4(v.x, v.y), o); }
}
__device__ __forceinline__ float quadx_sum(float v) { v += __shfl_xor(v, 4); v += __shfl_xor(v, 8); v += __shfl_xor(v, 16); v += __shfl_xor(v, 32); return v; }

constexpr int HBN = 800;
constexpr int ATT_HBD = 0, ATT_MH = 51200, ATT_PSLC = 53248, ATT_STAGE = 118784;
__device__ __forceinline__ void attn_tables(const Params& p, LAS unsigned char* lds) {
    const int tid = opaque_tid();
    LAS float* hbd = (LAS float*)(lds + ATT_HBD); LAS float* mh = (LAS float*)(lds + ATT_MH);
    for (int i = tid; i < 16 * HBN; i += NTHR) { const int hd = i / HBN, d = i - hd * HBN; hbd[i] = p.rel_bias[rel_bucket(d) * NH + hd] * 1.4426950408889634f; }
    if (tid < 16) { float qg = 0.f, kg = 0.f, bm = -3.0e38f;
        for (int i = 0; i < 64; ++i) qg = fmaxf(qg, fabsf(p.q_gain[i]));
        for (int i = 0; i < 192; ++i) kg = fmaxf(kg, fabsf(p.k_gain[i]));
        for (int i = 0; i < 32; ++i) bm = fmaxf(bm, p.rel_bias[i * NH + tid]);
        mh[tid] = (qg * kg * 8.f * 1.02f + bm) * 1.4426950408889634f; }
    __syncthreads();
}
typedef float f32x16 __attribute__((ext_vector_type(16)));
__device__ __forceinline__ f32x16 mfma32(bf16x8 a, bf16x8 b, f32x16 c) { return __builtin_amdgcn_mfma_f32_32x32x16_bf16(a, b, c, 0, 0, 0); }
struct DFrag { bf16x8 ka[4]; bf16x8 va[2][2]; };
__device__ __forceinline__ void dense_load_k(bf16x8 (&ka)[4], const bf16_t* KB, int kt, int l31, int h) {
    const int blk = kt >> 6, hh = (kt >> 5) & 1;
    const bf16_t* kb = KB + (size_t)blk * 4096 + (32 * hh + l31) * 8;
#pragma unroll
    for (int ks = 0; ks < 4; ++ks) ka[ks] = *(const bf16x8*)(kb + (2 * ks + h) * 512);
}
__device__ __forceinline__ void dense_load_v(bf16x8 (&va)[2][2], const bf16_t* VB, int kt, int l31, int h) {
    const int blk = kt >> 6, hh = (kt >> 5) & 1;
    const bf16_t* vb = VB + (size_t)blk * 4096 + l31 * 8 + 4 * h;
#pragma unroll
    for (int dt = 0; dt < 2; ++dt)
#pragma unroll
        for (int st = 0; st < 2; ++st) { const bf16_t* q0 = vb + (4 * hh + 2 * st) * 512 + dt * 256; const u32x2 lo = *(const u32x2*)q0, hi = *(const u32x2*)(q0 + 512);
            const u32x4 w = {lo.x, lo.y, hi.x, hi.y}; va[dt][st] = __builtin_bit_cast(bf16x8, w); }
}
__device__ __forceinline__ f32x16 dense_scores(const DFrag& f, const bf16x8 (&q)[4]) {
    f32x16 sacc;
#pragma unroll
    for (int i = 0; i < 16; ++i) sacc[i] = 0.f;
#pragma unroll
    for (int ks = 0; ks < 4; ++ks) sacc = mfma32(f.ka[ks], q[ks], sacc);
    return sacc;
}
__device__ __forceinline__ void dense_pv(f32x16 (&O)[2], const DFrag& f, const float (&ev)[16]) {
    bf16x8 pb[2];
#pragma unroll
    for (int st = 0; st < 2; ++st) { const u32x4 w = {cvt_pk_bf16(ev[8 * st], ev[8 * st + 1]), cvt_pk_bf16(ev[8 * st + 2], ev[8 * st + 3]), cvt_pk_bf16(ev[8 * st + 4], ev[8 * st + 5]), cvt_pk_bf16(ev[8 * st + 6], ev[8 * st + 7])};
        pb[st] = __builtin_bit_cast(bf16x8, w); }
#pragma unroll
    for (int dt = 0; dt < 2; ++dt)
#pragma unroll
        for (int st = 0; st < 2; ++st) O[dt] = mfma32(f.va[dt][st], pb[st], O[dt]);
}
__device__ __forceinline__ void phase_dense(const Params& p, LAS unsigned char* lds, bf16_t* OW) {
    const int tid = opaque_tid(), lane0 = tid & 63, wave = tid >> 6;
    const LAS float* hbd = (const LAS float*)(lds + ATT_HBD); const LAS float* mh = (const LAS float*)(lds + ATT_MH);
    LAS float* pslc = (LAS float*)(lds + ATT_PSLC) + wave * 2048;
    const bf16_t* Q = (const bf16_t*)(p.ws + WS_Q); const float* GATE = (const float*)(p.ws + WS_GATE);
    short* SEL = (short*)(p.ws + WS_SEL);
    const int Gn = gridDim.x, vcu = (Gn % 8 == 0) ? (blockIdx.x % 8) * (Gn / 8) + blockIdx.x / 8 : blockIdx.x;
    for (int u = vcu * NWAVE + wave; u < T * G / 16; u += Gn * NWAVE) {
        int lane = lane0; asm volatile("" : "+v"(lane));
        const int l31 = lane & 31, h = lane >> 5;
        const int bg = u >> 9, t0 = (((u & 511) + 128 * (u >> 11)) & 511) * 16, b = bg >> 2, g = bg & 3, head = 4 * g + (lane & 3);
        const LAS float* hb = hbd + head * HBN; const float mhv = mh[head];
        int tok[2]; bf16x8 qf[2][4];
#pragma unroll
        for (int r = 0; r < 2; ++r) { tok[r] = t0 + 8 * r + (l31 >> 2); const bf16_t* qp = Q + (size_t)(b * S + tok[r]) * D + head * 64 + 8 * h;
#pragma unroll
            for (int ks = 0; ks < 4; ++ks) qf[r][ks] = *(const bf16x8*)(qp + 16 * ks); }
        f32x16 O[2][2];
#pragma unroll
        for (int r = 0; r < 2; ++r)
#pragma unroll
            for (int dt = 0; dt < 2; ++dt)
#pragma unroll
                for (int q = 0; q < 16; ++q) O[r][dt][q] = 0.f;
        DFrag cur; bf16x8 nxtk[4];
        {
            const bf16_t* KB = (const bf16_t*)(p.ws + WS_KWB) + (size_t)bg * 128 * 4096; const bf16_t* VB = (const bf16_t*)(p.ws + WS_VWB) + (size_t)bg * 128 * 4096;
            float lw[2] = {0.f, 0.f};
            const int lo = t0 - (WIN - 1) > 0 ? t0 - (WIN - 1) : 0, kt_last = t0 & ~31;
            dense_load_k(cur.ka, KB, lo & ~31, l31, h);
            for (int kt = lo & ~31; kt <= kt_last; kt += 32) {
                dense_load_v(cur.va, VB, kt, l31, h);
                dense_load_k(nxtk, KB, kt + 32 <= kt_last ? kt + 32 : kt_last, l31, h);
                __builtin_amdgcn_sched_barrier(0);
#pragma unroll
                for (int r = 0; r < 2; ++r) {
                    const f32x16 sacc = dense_scores(cur, qf[r]);
                    const int dbase = tok[r] - kt - 4 * h; float ev[16];
                    if (kt + 31 <= t0 + 8 * r && kt >= t0 + 8 * r + 7 - (WIN - 1)) {
                        const LAS float* hbp = hb + dbase;
#pragma unroll
                        for (int q = 0; q < 16; ++q) { const float e = __builtin_amdgcn_exp2f(sacc[q] + hbp[-((q & 3) + 8 * (q >> 2))] - mhv); ev[q] = e; lw[r] += e; }
                    } else {
#pragma unroll
                    for (int q = 0; q < 16; ++q) { const int dist = dbase - ((q & 3) + 8 * (q >> 2)); const bool ok = (unsigned)dist < (unsigned)WIN;
                        const float e0 = __builtin_amdgcn_exp2f(sacc[q] + hb[ok ? dist : 0] - mhv); const float e = ok ? e0 : 0.f; ev[q] = e; lw[r] += e; }
                    }
                    dense_pv(O[r], cur, ev);
                }
#pragma unroll
                for (int ks = 0; ks < 4; ++ks) cur.ka[ks] = nxtk[ks];
            }
#pragma unroll
            for (int r = 0; r < 2; ++r) { const float l = lw[r] + __shfl_xor(lw[r], 32); int tk = tok[r]; asm volatile("" : "+v"(tk)); const float* gp = GATE + (size_t)(b * S + tk) * 48 + head * 3;
                const float sc = gp[2] / (l * gp[0]);
#pragma unroll
                for (int dt = 0; dt < 2; ++dt) O[r][dt] = O[r][dt] * sc; }
        }
        const int ncmax = t0 >> 4;
        {
            int l31c = l31, hc = h; asm volatile("" : "+v"(l31c), "+v"(hc));
            const bf16_t* KB = (const bf16_t*)(p.ws + WS_KC) + (size_t)bg * 8 * 4096; const bf16_t* VB = (const bf16_t*)(p.ws + WS_VC) + (size_t)bg * 8 * 4096;
            float lc[2] = {0.f, 0.f};
            const int kt_last = ncmax > 0 ? ((ncmax - 1) & ~31) : -32;
            if (ncmax > 0) {
                dense_load_k(cur.ka, KB, 0, l31c, hc);
                for (int kt = 0; kt <= kt_last; kt += 32) {
                    dense_load_k(nxtk, KB, kt + 32 <= kt_last ? kt + 32 : kt_last, l31c, hc);
                    __builtin_amdgcn_sched_barrier(0);
#pragma unroll
                    for (int r = 0; r < 2; ++r) {
                        const f32x16 sacc = dense_scores(cur, qf[r]);
                        if (t0 - 31 - 16 * (kt + 31) >= HBN - 1) {
                            const float bfar = hb[HBN - 1] - mhv;
#pragma unroll
                            for (int q = 0; q < 16; ++q) lc[r] += __builtin_amdgcn_exp2f(sacc[q] + bfar);
                        } else {
                        const int dbase = tok[r] - 31 - 16 * (kt + 4 * hc);
#pragma unroll
                        for (int q = 0; q < 16; ++q) { const int dist = dbase - 16 * ((q & 3) + 8 * (q >> 2)); const int di = dist < 0 ? 0 : (dist > HBN - 1 ? HBN - 1 : dist);
                            const float e0 = __builtin_amdgcn_exp2f(sacc[q] + hb[di] - mhv); lc[r] += dist >= 0 ? e0 : 0.f; }
                        }
                    }
#pragma unroll
                    for (int ks = 0; ks < 4; ++ks) cur.ka[ks] = nxtk[ks];
                }
            }
            float linv[2];
#pragma unroll
            for (int r = 0; r < 2; ++r) { const float l = lc[r] + __shfl_xor(lc[r], 32); linv[r] = l > 0.f ? 1.f / l : 0.f; }
            { const f32x4 z = {0.f, 0.f, 0.f, 0.f};
#pragma unroll
              for (int i = 0; i < 8; ++i) *(LAS f32x4*)(pslc + (i * 64 + lane) * 4) = z; }
            if (ncmax > 0) {
                float carry[2] = {0.f, 0.f};
                dense_load_k(cur.ka, KB, 0, l31c, hc);
                for (int kt = 0; kt <= kt_last; kt += 32) {
                    dense_load_v(cur.va, VB, kt, l31c, hc);
                    dense_load_k(nxtk, KB, kt + 32 <= kt_last ? kt + 32 : kt_last, l31c, hc);
                    __builtin_amdgcn_sched_barrier(0);
#pragma unroll
                    for (int r = 0; r < 2; ++r) {
                        const f32x16 sacc = dense_scores(cur, qf[r]);
                        float pv[16];
                        const int dbase = tok[r] - 31 - 16 * (kt + 4 * hc);
#pragma unroll
                        for (int q = 0; q < 16; ++q) { const int dist = dbase - 16 * ((q & 3) + 8 * (q >> 2)); const int di = dist < 0 ? 0 : (dist > HBN - 1 ? HBN - 1 : dist);
                            const float e0 = __builtin_amdgcn_exp2f(sacc[q] + hb[di] - mhv); pv[q] = dist >= 0 ? e0 * linv[r] : 0.f; }
                        dense_pv(O[r], cur, pv);
#pragma unroll
                        for (int q = 0; q < 16; ++q) { pv[q] += __shfl_xor(pv[q], 1); pv[q] += __shfl_xor(pv[q], 2); }
                        float y[4];
#pragma unroll
                        for (int gq = 0; gq < 4; ++gq) y[gq] = __shfl_xor(pv[4 * gq + 3], 32);
#pragma unroll
                        for (int gq = 0; gq < 4; ++gq) { const float prevv = h ? y[gq] : (gq > 0 ? y[gq > 0 ? gq - 1 : 0] : carry[r]);
                            const float val = 2.f * ((pv[4 * gq] + pv[4 * gq + 1]) + pv[4 * gq + 2]) + pv[4 * gq + 3] + prevv;
                            if ((lane & 3) == 0) pslc[(8 * r + (l31c >> 2)) * 128 + (kt >> 2) + 2 * gq + hc] = val; }
                        carry[r] = y[3];
                    }
#pragma unroll
                    for (int ks = 0; ks < 4; ++ks) cur.ka[ks] = nxtk[ks];
                }
            }
        }
#pragma unroll
        for (int r = 0; r < 2; ++r) { int tk = tok[r]; asm volatile("" : "+v"(tk)); bf16_t* op = OW + (size_t)(b * S + tk) * D + head * 64 + 4 * h; const float gc = GATE[(size_t)(b * S + tk) * 48 + head * 3];
#pragma unroll
            for (int dt = 0; dt < 2; ++dt)
#pragma unroll
                for (int gq = 0; gq < 4; ++gq) { u32x2 w; w.x = cvt_pk_bf16(O[r][dt][4 * gq] * gc, O[r][dt][4 * gq + 1] * gc); w.y = cvt_pk_bf16(O[r][dt][4 * gq + 2] * gc, O[r][dt][4 * gq + 3] * gc);
                    *(u32x2*)(op + dt * 32 + 8 * gq) = w; } }
#pragma unroll 1
        for (int tl = 0; tl < 16; ++tl) {
            int ln = lane; asm volatile("" : "+v"(ln));
            const int t = t0 + tl, cur_b = t >> 6, j0 = ln, j1 = ln + 64;
            const float c0 = pslc[tl * 128 + j0], c1 = pslc[tl * 128 + j1];
            const bool f0 = (j0 == 0) || (j0 == cur_b) || (j0 == cur_b - 1), f1 = (j1 == cur_b) || (j1 == cur_b - 1);
            const bool v0 = j0 * 64 <= t, v1 = j1 * 64 <= t;
            const unsigned u0 = (v0 && !f0) ? __float_as_uint(c0) : 0u, u1 = (v1 && !f1) ? __float_as_uint(c1) : 0u;
            unsigned th = 1u;
            if (cur_b + 1 > NSEL) {
                th = 0u;
#pragma unroll 1
                for (int bit = 30; bit >= 0; --bit) {
                    const unsigned trial = th | (1u << bit);
                    const int cnt = __popcll(__ballot(u0 >= trial)) + __popcll(__ballot(u1 >= trial));
                    if (cnt >= NSEL - 3) { th = trial; if (cnt == NSEL - 3) break; }
                }
            }
            const bool s0 = f0 || (u0 >= th && u0 != 0u), s1 = f1 || (u1 >= th && u1 != 0u);
            const unsigned long long m0 = __ballot(s0), m1 = __ballot(s1), lt = (1ull << ln) - 1ull;
            const int p0 = __popcll(m0 & lt), p1 = __popcll(m0) + __popcll(m1 & lt);
            short* so = SEL + ((size_t)(b * S + t) * 4 + g) * NSEL;
            if (s0 && p0 < NSEL) so[p0] = (short)j0;
            if (s1 && p1 < NSEL) so[p1] = (short)j1;
        }
    }
}

struct Row16 { u32x4 r[8]; };
struct Row8 { u32x4 r[4]; };
__device__ __forceinline__ void load_row(Row16& r, const unsigned char* ptr) {
#pragma unroll
    for (int i = 0; i < 8; ++i) r.r[i] = *(const u32x4*)(ptr + i * 1024);
}
__device__ __forceinline__ void load_row(Row8& r, const unsigned char* ptr) {
#pragma unroll
    for (int i = 0; i < 4; ++i) r.r[i] = *(const u32x4*)(ptr + i * 1024);
}
typedef __bf16 bf16x2_t __attribute__((ext_vector_type(2)));
__device__ __forceinline__ s16x4 cvt4_fp8(unsigned w) {
    const bf16x2_t lo = __builtin_amdgcn_cvt_scalef32_pk_bf16_fp8(w, 1.0f, false), hi = __builtin_amdgcn_cvt_scalef32_pk_bf16_fp8(w, 1.0f, true);
    return mk4(__builtin_bit_cast(unsigned, lo), __builtin_bit_cast(unsigned, hi));
}
__device__ __forceinline__ s16x4 frag4(const Row16& k, int c) { const u32x4 v = k.r[c >> 1]; return (c & 1) ? mk4(v.z, v.w) : mk4(v.x, v.y); }
__device__ __forceinline__ s16x4 frag4(const Row8& k, int c) { return cvt4_fp8(k.r[c >> 2][c & 3]); }
typedef int i32x4v __attribute__((ext_vector_type(4)));
__device__ __forceinline__ f32x4 qk_row_i8(const Row8& k, const int (&qi)[16]) {
    i32x4v s0 = {0, 0, 0, 0}, s1 = s0;
#pragma unroll
    for (int c = 0; c < 16; c += 2) { s0 = __builtin_amdgcn_mfma_i32_4x4x4i8((int)k.r[c >> 2][c & 3], qi[c], s0, 0, 0, 0); s1 = __builtin_amdgcn_mfma_i32_4x4x4i8((int)k.r[(c + 1) >> 2][(c + 1) & 3], qi[c + 1], s1, 0, 0, 0); }
    const i32x4v t = s0 + s1; return (f32x4){(float)t.x, (float)t.y, (float)t.z, (float)t.w};
}
template <class Row> __device__ __forceinline__ f32x4 qk_row(const Row& k, const s16x4 (&qf)[16]) {
    f32x4 s = {0.f, 0.f, 0.f, 0.f};
#pragma unroll
    for (int c = 0; c < 16; ++c) s = mfma4(frag4(k, c), qf[c], s);
    return s;
}
template <class Row> __device__ __forceinline__ void pv_row(f32x4& o, const f32x4 e, const Row& v, LAS u32x2* stage, int lane) {
    u32x2 pk; pk.x = cvt_pk_bf16(e.x, e.y); pk.y = cvt_pk_bf16(e.z, e.w);
    stage[lane] = pk;
#pragma unroll
    for (int st = 0; st < 16; ++st) { const u32x2 a = stage[4 * st + (lane & 3)]; o = mfma4(mk4(a.x, a.y), frag4(v, st), o); }
}
#define PIPE_PIN() __builtin_amdgcn_sched_barrier(0)
template <bool HASV, class F>
__device__ __forceinline__ void pipe_blocks(const int n, F& f, const s16x4 (&qf)[16]) {
    if (n <= 0) return;
    typename F::Row kA, kB, vA, vB;
    const int l = n - 1;
    load_row(kA, f.kptr(0)); if (HASV) load_row(vA, f.vptr(0));
    PIPE_PIN();
    for (int i = 0; i < n; i += 2) {
        { const int j = i + 1 < l ? i + 1 : l; load_row(kB, f.kptr(j)); if (HASV) load_row(vB, f.vptr(j)); PIPE_PIN();
          const f32x4 sv = qk_row(kA, qf); f.use(i, sv, vA); PIPE_PIN(); }
        if (i + 1 < n) { const int j = i + 2 < l ? i + 2 : l; load_row(kA, f.kptr(j)); if (HASV) load_row(vA, f.vptr(j)); PIPE_PIN();
          const f32x4 sv = qk_row(kB, qf); f.use(i + 1, sv, vB); PIPE_PIN(); }
    }
}
template <class F>
__device__ __forceinline__ void pipe_blocks3(const int n, F& f) {
    if (n <= 0) return;
    typename F::Row k0, k1, k2, v0, v1, v2;
    const int l = n - 1;
#define PB3_IDX(j) ((j) < l ? (j) : l)
    load_row(k0, f.kptr(0)); load_row(v0, f.vptr(0)); load_row(k1, f.kptr(PB3_IDX(1))); load_row(v1, f.vptr(PB3_IDX(1)));
    PIPE_PIN();
#define PB3_STEP(j, KN, VN, KC, VC) if (i + (j) < n) { load_row(KN, f.kptr(PB3_IDX(i + (j) + 2))); load_row(VN, f.vptr(PB3_IDX(i + (j) + 2))); PIPE_PIN(); \
        const f32x4 sv = f.qk(KC); f.use(i + (j), sv, VC); PIPE_PIN(); }
    for (int i = 0; i < n; i += 3) { PB3_STEP(0, k2, v2, k0, v0) PB3_STEP(1, k0, v0, k1, v1) PB3_STEP(2, k1, v1, k2, v2) }
#undef PB3_STEP
#undef PB3_IDX
}
struct SelCtx {
    typedef Row8 Row;
    const unsigned char* ks; const unsigned char* vs; const LAS float* hb; LAS u32x2* stage; float mhv, dq; int selv, t, lane, qd;
    int qi[16];
    f32x4 os; float ls;
    __device__ __forceinline__ f32x4 qk(const Row8& k) const { return qk_row_i8(k, qi) * dq; }
    __device__ __forceinline__ const unsigned char* kptr(int i) const { return ks + (size_t)__builtin_amdgcn_readlane(selv, i) * 4096; }
    __device__ __forceinline__ const unsigned char* vptr(int i) const { return vs + (size_t)__builtin_amdgcn_readlane(selv, i) * 4096; }
    __device__ __forceinline__ void use(int i, const f32x4 sv, const Row8& vr) {
        const int pos0 = __builtin_amdgcn_readlane(selv, i) * 64;
        f32x4 e;
        if (t - pos0 - 63 >= HBN - 1) {
            const float bfar = hb[HBN - 1] - mhv;
#pragma unroll
            for (int q = 0; q < 4; ++q) e[q] = __builtin_amdgcn_exp2f(sv[q] + bfar);
        } else {
#pragma unroll
        for (int q = 0; q < 4; ++q) { const int dist = t - (pos0 + 4 * qd + q); const int di = dist < 0 ? 0 : (dist > HBN - 1 ? HBN - 1 : dist);
            const float e0 = __builtin_amdgcn_exp2f(sv[q] + hb[di] - mhv); e[q] = dist >= 0 ? e0 : 0.f; }
        }
        ls += (e[0] + e[1]) + (e[2] + e[3]);
        pv_row(os, e, vr, stage, lane);
    }
};

__device__ __forceinline__ void phase_attn_pair(const Params& p, LAS unsigned char* lds, bf16_t* AO, const bf16_t* OW) {
    const int tid = opaque_tid(), lane = tid & 63, wave = tid >> 6, jq = lane & 3, qd = lane >> 2;
    const LAS float* hbd = (const LAS float*)(lds + ATT_HBD); const LAS float* mh = (const LAS float*)(lds + ATT_MH);
    LAS u32x2* stage = (LAS u32x2*)(lds + ATT_STAGE) + wave * 64;
    const float dq8 = 1.f / (sel_q_scale(p.q_gain) * sel_k_scale(p.k_gain));
    const unsigned char* KSB = p.ws + WS_KSB; const unsigned char* VSB = p.ws + WS_VSB;
    const float* GATE = (const float*)(p.ws + WS_GATE); const short* SEL = (const short*)(p.ws + WS_SEL);
    const int Gn = gridDim.x, vcu = (Gn % 8 == 0) ? (blockIdx.x % 8) * (Gn / 8) + blockIdx.x / 8 : blockIdx.x;
    for (int idx = vcu * NWAVE + wave; idx < T * G; idx += Gn * NWAVE) {
        const int bg = idx >> 13, t = idx & (S - 1), b = bg >> 2, g = bg & 3, u = b * S + t;
        const int head = 4 * g + jq;
        const int cur = t >> 6, nv = cur + 1 < NSEL ? cur + 1 : NSEL;
        SelCtx sw;
        { const u32x4* qp = (const u32x4*)(p.ws + WS_Q8 + (size_t)u * D + head * 64);
#pragma unroll
            for (int i = 0; i < 4; ++i) { const u32x4 w = qp[i]; sw.qi[4 * i] = (int)w.x; sw.qi[4 * i + 1] = (int)w.y; sw.qi[4 * i + 2] = (int)w.z; sw.qi[4 * i + 3] = (int)w.w; } }
        sw.dq = dq8; sw.selv = (int)SEL[((size_t)u * 4 + g) * NSEL + (lane & 15)];
        sw.ks = KSB + (size_t)bg * 128 * 4096 + lane * 16; sw.vs = VSB + (size_t)bg * 128 * 4096 + lane * 16; sw.hb = hbd + head * HBN; sw.stage = stage; sw.mhv = mh[head]; sw.t = t; sw.lane = lane; sw.qd = qd;
        sw.os = (f32x4){0.f, 0.f, 0.f, 0.f}; sw.ls = 0.f;
        pipe_blocks3(nv, sw);
        const float lsi = 1.f / quadx_sum(sw.ls);
        const float* gt = GATE + (size_t)u * 48 + g * 12;
#pragma unroll
        for (int i = 0; i < 4; ++i) {
            const float si = __shfl(lsi, (lane & ~3) + i);
            const float r = gt[3 * i + 1] * (sw.os[i] * si) + bf2f(OW[(size_t)u * D + (4 * g + i) * 64 + lane]);
            AO[(size_t)u * D + (4 * g + i) * 64 + lane] = (bf16_t)(cvt_pk_bf16(r, 0.f) & 0xffffu);
        }
    }
}

__device__ __forceinline__ void moe_pstarts(const unsigned* ctl, int (&pst)[NE + 1]) {
    int a = 0;
#pragma unroll
    for (int e = 0; e < NE; ++e) { pst[e] = a; const int c = (int)ctl[CW_CNT + 64 * e]; a += (c + 511) / 512 * 512; }
    pst[NE] = a;
}
__device__ __forceinline__ void phase_moe_sort(const Params& p, LAS unsigned char* lds) {
    const int tid = opaque_tid(), lane = tid & 63, wave = tid >> 6;
    unsigned* ctl = (unsigned*)(p.ws + WS_CTL);
    const int* TOPE = (const int*)(p.ws + WS_TOPE); int* RPOS = (int*)(p.ws + WS_RPOS);
    const bf16_t* HB = (const bf16_t*)(p.ws + WS_HB); bf16_t* XS = (bf16_t*)(p.ws + WS_XS);
    LAS int* wcnt = (LAS int*)lds;
    LAS int* base = (LAS int*)(lds + 128);
    LAS int* posl = (LAS int*)(lds + 256);
    int pst[NE + 1]; moe_pstarts(ctl, pst);
    if (blockIdx.x == 0 && tid <= NE) ((int*)(ctl + 256))[tid] = pst[tid];
    for (int c0 = blockIdx.x * 256; c0 < 2 * T; c0 += gridDim.x * 256) {
        int e = 0, rank = 0;
        if (wave < 4) { e = TOPE[c0 + wave * 64 + lane];
#pragma unroll
            for (int q = 0; q < NE; ++q) { const unsigned long long m = __ballot(e == q); if (e == q) rank = __popcll(m & ((1ull << lane) - 1ull)); if (lane == 0) wcnt[wave * NE + q] = __popcll(m); } }
        __syncthreads();
        if (tid < NE) { const int n = wcnt[tid] + wcnt[NE + tid] + wcnt[2 * NE + tid] + wcnt[3 * NE + tid]; base[tid] = n ? (int)atomicAdd(ctl + CW_CUR + 64 * tid, (unsigned)n) : 0; }
        __syncthreads();
        if (wave < 4) { int off = 0;
            for (int w = 0; w < wave; ++w) off += wcnt[w * NE + e];
            const int pos = pst[e] + base[e] + off + rank; posl[wave * 64 + lane] = pos; RPOS[c0 + wave * 64 + lane] = pos; }
        __syncthreads();
        for (int j = wave * 32; j < wave * 32 + 32; j += 8) {
            u32x4 v0[8]; int ps[8];
#pragma unroll
            for (int q = 0; q < 8; ++q) { const int tk = (c0 + j + q) >> 1; ps[q] = posl[j + q]; v0[q] = *((const u32x4*)((const unsigned char*)HB + (size_t)tk * D) + lane); }
#pragma unroll
            for (int q = 0; q < 8; ++q) *((u32x4*)((unsigned char*)XS + (size_t)ps[q] * D) + lane) = v0[q];
        }
        __syncthreads();
    }
}
__device__ __forceinline__ void phase_combine(const Params& p) {
    const int tid = opaque_tid(), lane = tid & 63, wave = tid >> 6;
    const int gw = blockIdx.x * NWAVE + wave, NGW = gridDim.x * NWAVE;
    const float* TOPW = (const float*)(p.ws + WS_TOPW); const int* RPOS = (const int*)(p.ws + WS_RPOS);
    const bf16_t* Y = (const bf16_t*)(p.ws + WS_Y); const float* g2 = (const float*)(p.ws + WS_MODV) + (11 * 4) * D;
    for (int r = gw; r < T; r += NGW) {
        const int b = r >> 13; const int p0 = RPOS[2 * r], p1 = RPOS[2 * r + 1]; const float w0 = TOPW[2 * r], w1 = TOPW[2 * r + 1];
#pragma unroll
        for (int j = 0; j < 4; ++j) { const int c = 4 * lane + 256 * j;
            const u32x2 y0 = *(const u32x2*)(Y + (size_t)p0 * D + c), y1 = *(const u32x2*)(Y + (size_t)p1 * D + c);
            const f32x4 gv = *(const f32x4*)(g2 + b * D + c); f32x4 xv = *(const f32x4*)(p.out + (size_t)r * D + c);
            f32x4 f; f.x = w0 * bflo(y0.x) + w1 * bflo(y1.x); f.y = w0 * bfhi(y0.x) + w1 * bfhi(y1.x); f.z = w0 * bflo(y0.y) + w1 * bflo(y1.y); f.w = w0 * bfhi(y0.y) + w1 * bfhi(y1.y);
            *(f32x4*)(p.out + (size_t)r * D + c) = xv + gv * f; }
    }
}

#define XB_TMO      128
#define XB_XCNT(j)  (256  + 64 * (j))
#define XB_XSUB(j)  (1280 + 64 * (j))
#define XB_XGEN(j)  (2304 + 64 * (j))
#define XB_TOP      3328
#define XB_TOPGEN   3392
#define XCD_BAR_WORDS 3456
#define XB_SPIN_CAP (1u << 18)
__device__ __forceinline__ unsigned xb_ld(unsigned* p)              { return __hip_atomic_load(p, __ATOMIC_RELAXED, __HIP_MEMORY_SCOPE_AGENT); }
__device__ __forceinline__ unsigned xb_add(unsigned* p, unsigned v) { return __hip_atomic_fetch_add(p, v, __ATOMIC_RELAXED, __HIP_MEMORY_SCOPE_AGENT); }
__device__ __forceinline__ unsigned xb_xcc_id() { return (unsigned)__builtin_amdgcn_s_getreg((3 << 11) | 20) & 0xFu; }
#define XB_SPIN(cond, bar) do { unsigned _sp = 0; while (cond) { __builtin_amdgcn_s_sleep(1); \
    if ((++_sp & 255u) == 0u) { if (xb_ld(&(bar)[XB_TMO])) break; if (_sp > XB_SPIN_CAP) { atomicAdd(&(bar)[XB_TMO], 1u); break; } } } } while (0)
struct XcdBarrier { unsigned* bar; unsigned x; volatile LAS unsigned* st; };
__device__ __forceinline__ XcdBarrier xcd_barrier_post(unsigned* bar, volatile LAS unsigned* st) {
    XcdBarrier b; b.bar = bar; b.x = xb_xcc_id(); b.st = st;
    if (threadIdx.x == 0) (void)xb_add(&bar[XB_XCNT(b.x)], 1u);
    return b;
}
__device__ __forceinline__ void xcd_barrier_complete(unsigned* bar, unsigned x, unsigned& nloc, unsigned& nx) {
    const unsigned G_ = gridDim.x * gridDim.y * gridDim.z;
    unsigned sum, cnt, mine, sp = 0u;
    for (;;) {
        sum = 0u; cnt = 0u; mine = 0u;
#pragma unroll
        for (unsigned j = 0; j < 16; ++j) { const unsigned c = xb_ld(&bar[XB_XCNT(j)]); sum += c; cnt += (c > 0u) ? 1u : 0u; mine = (j == x) ? c : mine; }
        if (sum == G_) break;
        __builtin_amdgcn_s_sleep(1);
        if ((++sp & 255u) == 0u) { if (xb_ld(&bar[XB_TMO])) break; if (sp > XB_SPIN_CAP) { atomicAdd(&bar[XB_TMO], 1u); break; } }
    }
    nloc = mine > 0u ? mine : 1u; nx = cnt > 0u ? cnt : 1u;
}
__device__ __forceinline__ void xcd_barrier(const XcdBarrier& b) {
    asm volatile("s_waitcnt vmcnt(0)" ::: "memory");
    __syncthreads();
    if (threadIdx.x == 0) {
        unsigned* bar = b.bar;
        __builtin_amdgcn_s_waitcnt(0);
        unsigned nloc = b.st[0], nx = b.st[1];
        if (nloc == 0u) { xcd_barrier_complete(bar, b.x, nloc, nx); b.st[0] = nloc; b.st[1] = nx; }
        const unsigned old = xb_add(&bar[XB_XSUB(b.x)], 1u);
        const unsigned gen = old / nloc;
        if (old + 1u == (gen + 1u) * nloc) {
            __builtin_amdgcn_fence(__ATOMIC_RELEASE, "agent");
            asm volatile("s_waitcnt vmcnt(0)" ::: "memory");
            const unsigned og = xb_add(&bar[XB_TOP], 1u);
            const unsigned tg = og / nx;
            if (og + 1u == (tg + 1u) * nx) xb_add(&bar[XB_TOPGEN], 1u);
            else XB_SPIN(xb_ld(&bar[XB_TOPGEN]) == tg, bar);
            __builtin_amdgcn_fence(__ATOMIC_ACQUIRE, "agent");
            xb_add(&bar[XB_XGEN(b.x)], 1u);
            asm volatile("s_waitcnt vmcnt(0)" ::: "memory");
        } else {
            XB_SPIN(xb_ld(&bar[XB_XGEN(b.x)]) == gen, bar);
            __builtin_amdgcn_fence(__ATOMIC_ACQUIRE, "agent");
            asm volatile("s_waitcnt vmcnt(0)" ::: "memory");
        }
    }
    __syncthreads();
}

constexpr int LDS_SCRATCH = 131072, MISC_OFF = LDS_SCRATCH + 320, LDS_BYTES = 147456;
#define MODP(which) ((const float*)(p.ws + WS_MODV) + (size_t)(which) * 4 * D)

__global__ void __launch_bounds__(NTHR, 2) k_fused(Params p) {
    extern __shared__ __attribute__((aligned(16))) unsigned char lds_raw[];
    LAS unsigned char* lds = (LAS unsigned char*)lds_raw;
    for (int u = threadIdx.x; u < (LDS_BYTES - LDS_SCRATCH) / 4; u += NTHR) ((LAS unsigned*)(lds + LDS_SCRATCH))[u] = 0u;
    __syncthreads();
    const XcdBarrier bar = xcd_barrier_post((unsigned*)(p.ws + WS_CTL) + CW_BAR, (volatile LAS unsigned*)(lds + MISC_OFF) + 8);
#define GRID_BAR() xcd_barrier(bar)
    phase_weights(p, lds); __syncthreads(); phase_modvec(p, lds);
    GRID_BAR();
    phase_convert_fgu(p, lds); __syncthreads();
    phase_poolmix(p, lds, (bf16_t*)(p.ws + WS_HA));
    GRID_BAR();
    { pg8::Sched<1> Sc; Sc.init(T, D, gridDim.x, blockIdx.x, p.ws + WS_HA, p.ws + WO_POOL, D, 256);
      pg8::EpiEl<EpiPool> E{{p.x, (float*)(p.ws + WS_X1), MODP(2), p.pool_scale, 0}};
      pg8::gemm_phase(lds, 256, D, 256, 128, Sc, E); }
    GRID_BAR();
    { NormOut o0{p.norm_g + D, MODP(4), MODP(3), (bf16_t*)(p.ws + WS_HB)}; phase_norm<1, false, 2>(p, lds, (const float*)(p.ws + WS_X1), o0, o0); }
    GRID_BAR();
    { pg8::Sched<0> Sc; Sc.init(T, 2 * FF, gridDim.x, blockIdx.x, p.ws + WS_HB, p.ws + WO_FGU, D / 2, D / 2);
      pg8::EpiPairEl<EpiSwigluI8> E{{(bf16_t*)(p.ws + WS_HID0), FF, (const float*)(p.ws + WS_ASC), (const float*)(p.ws + WS_FGMAX)}};
      pg8::gemm_phase<pg8::EpiPairEl<EpiSwigluI8>, pg8::Sched<0>, true, true, 2>(lds, D / 2, D / 2, D / 2, 128, Sc, E); }
    GRID_BAR();
    { pg8::Sched<0> Sc; Sc.init(T, D, gridDim.x, blockIdx.x, p.ws + WS_HID0, p.ws + WO_FDN, FF, FF);
      pg8::EpiEl<EpiResid> E{{(const float*)(p.ws + WS_X1), (float*)(p.ws + WS_X2), MODP(5)}};
      pg8::gemm_phase(lds, FF, FF, FF, 128, Sc, E); }
    GRID_BAR();
    { NormOut o0{p.kv_norm_g, MODP(13), MODP(12), (bf16_t*)(p.ws + WS_HA)}; NormOut o1{p.norm_g + 2 * D, MODP(7), MODP(6), (bf16_t*)(p.ws + WS_HB)}; phase_norm<2, false>(p, lds, (const float*)(p.ws + WS_X2), o0, o1); }
    GRID_BAR();
    { pg8::Sched<0> Sc; Sc.init(T, NKV, gridDim.x, blockIdx.x, p.ws + WS_HA, p.ws + WO_KV, D, D);
      pg8::EpiEl<EpiBf16> E{{(bf16_t*)(p.ws + WS_KVB), NKV}};
      pg8::gemm_phase(lds, D, D, D, 128, Sc, E); }
    { pg8::Sched<0> Sc; Sc.init(T, D, gridDim.x, blockIdx.x, p.ws + WS_HB, p.ws + WO_Q, D, D);
      pg8::EpiEl<EpiQ> E{{(bf16_t*)(p.ws + WS_Q), (float*)(p.ws + WS_GATE), 0}};
      pg8::gemm_phase(lds, D, D, D, 128, Sc, E); }
    GRID_BAR();
    { pg8::Sched<2> Sc; Sc.init(2048, 2048, gridDim.x, blockIdx.x, p.ws + WS_KVB, p.ws + WO_CK, 16 * NKV, 2048);
      pg8::EpiEl<EpiCmp> E{{(bf16_t*)(p.ws + WS_CMPH), (const float*)(p.ws + WS_CMPB)}};
      pg8::gemm_phase(lds, 2048, 16 * NKV, 2048, (size_t)NKV * 2, Sc, E); }
    { pg8::Sched<0> Sc; Sc.init(T, 256, (int)gridDim.x - 64 > 0 ? (int)gridDim.x - 64 : 1, (int)gridDim.x > 64 ? (int)blockIdx.x - 64 : (int)blockIdx.x, p.ws + WS_HB, p.ws + WO_Q + (size_t)D * D * 2, D, D);
      pg8::EpiEl<EpiQ> E{{(bf16_t*)(p.ws + WS_Q), (float*)(p.ws + WS_GATE), D}};
      pg8::gemm_phase(lds, D, D, D, 128, Sc, E); }
    phase_headnorm(p, lds); phase_vtrans(p, lds);
    GRID_BAR();
    phase_cmp2(p, lds);
    GRID_BAR();
    attn_tables(p, lds);
    phase_dense(p, lds, (bf16_t*)(p.ws + WS_HB));
    GRID_BAR();
    phase_attn_pair(p, lds, (bf16_t*)(p.ws + WS_HA), (const bf16_t*)(p.ws + WS_HB));
    GRID_BAR();
    { pg8::Sched<0> Sc; Sc.init(T, D, gridDim.x, blockIdx.x, p.ws + WS_HA, p.ws + WO_O, D, D);
      pg8::EpiEl<EpiResid> E{{(const float*)(p.ws + WS_X2), p.out, MODP(8)}};
      pg8::gemm_phase(lds, D, D, D, 128, Sc, E); }
    GRID_BAR();
    { NormOut o0{p.norm_g + 3 * D, MODP(10), MODP(9), (bf16_t*)(p.ws + WS_HB)}; phase_norm<1, true, 1>(p, lds, p.out, o0, o0); }
    GRID_BAR();
    phase_moe_sort(p, lds);
    GRID_BAR();
    { const int* pst = (const int*)(p.ws + WS_CTL) + 256;
      pg8::Sched<3> Sc; Sc.init(pst[NE], 2 * FE, gridDim.x, blockIdx.x, p.ws + WS_XS, p.ws + WO_EGU, D / 2, D / 2, pst, (size_t)FE * D);
      pg8::EpiPairEl<EpiSwiglu8> E{{p.ws + WS_HIDM, FE}};
      pg8::gemm_phase<pg8::EpiPairEl<EpiSwiglu8>, pg8::Sched<3>, true, true, 1>(lds, D / 2, D / 2, D / 2, 128, Sc, E, 127 - 5); }
    GRID_BAR();
    { const int* pst = (const int*)(p.ws + WS_CTL) + 256;
      pg8::Sched<3> Sc; Sc.init(pst[NE], D, gridDim.x, blockIdx.x, p.ws + WS_HIDM, p.ws + WO_EDN, FE / 2, FE / 2, pst, (size_t)D * FE / 2);
      pg8::EpiEl<EpiBf16> E{{(bf16_t*)(p.ws + WS_Y), D}};
      pg8::gemm_phase<pg8::EpiEl<EpiBf16>, pg8::Sched<3>, true, true, 1>(lds, FE / 2, FE / 2, FE / 2, 128, Sc, E, 127 - 6); }
    GRID_BAR();
    phase_combine(p);
}

extern "C" void kernel_launch(void* const* d_in, const int* in_sizes, int n_in, void* d_out, int out_size, void* d_ws, size_t ws_size, hipStream_t stream) {
    if (n_in != 28 || out_size != T * D || ws_size < WS_END) { fprintf(stderr, "kernel_launch: unexpected shapes (n_in %d out %d ws %zu need %zu)\n", n_in, out_size, ws_size, (size_t)WS_END); return; }
    static int grid = 0;
    if (grid == 0) {
        int dev = 0, cus = 0, per_cu = 0;
        if (hipGetDevice(&dev) != hipSuccess || hipDeviceGetAttribute(&cus, hipDeviceAttributeMultiprocessorCount, dev) != hipSuccess) { grid = -1; return; }
        if (hipFuncSetAttribute((const void*)k_fused, hipFuncAttributeMaxDynamicSharedMemorySize, LDS_BYTES) != hipSuccess) { grid = -1; return; }
        if (hipOccupancyMaxActiveBlocksPerMultiprocessor(&per_cu, (const void*)k_fused, NTHR, LDS_BYTES) != hipSuccess || per_cu < 1) { fprintf(stderr, "kernel_launch: occupancy query says %d\n", per_cu); }
        (void)hipGetLastError();
        grid = cus;
    }
    if (grid < 0) return;
    Params p{};
    const float** pp = (const float**)&p;
    for (int i = 0; i < 28; ++i) pp[i] = (const float*)d_in[i];
    p.out = (float*)d_out; p.ws = (unsigned char*)d_ws;
    (void)hipMemsetAsync((char*)d_ws + WS_CTL, 0, CTL_BYTES, stream);
    k_fused<<<dim3(grid), dim3(NTHR), LDS_BYTES, stream>>>(p);
}
```

```cpp
#include <hip/hip_runtime.h>
#include <cstdint>
#include <cstdio>

#define LAS __attribute__((address_space(3)))
typedef unsigned short bf16_t;
typedef short bf16x8 __attribute__((ext_vector_type(8)));
typedef float f32x4 __attribute__((ext_vector_type(4)));
typedef float f32x2 __attribute__((ext_vector_type(2)));
typedef unsigned u32x4 __attribute__((ext_vector_type(4)));
typedef unsigned u32x2 __attribute__((ext_vector_type(2)));

constexpr int NB = 4, S = 8192, D = 1024, T = NB * S;
constexpr int FF = 2816, NE = 8, FE = 3584;
constexpr int NKV = 1536, NQP = 1280, NQ = 1072;
constexpr int G = 4, HD = 64, NH = 16;
constexpr int NC = 512;
constexpr int NSB = 128;
constexpr int NSEL = 16;
constexpr int WIN = 512;
constexpr int MOE_ROWS = 69632;
constexpr float EPS = 1e-6f;
constexpr int NTHR = 512, NWAVE = 8;

constexpr size_t MiB = 1u << 20;
constexpr size_t WS_CTL = 0, CTL_BYTES = 1 * MiB;
constexpr size_t WS_MODV = 1 * MiB;
constexpr size_t WS_CMPB = WS_MODV + 14 * 4 * 1024 * 4;
constexpr size_t WS_FGMAX = WS_CMPB + 4096;
constexpr size_t WS_ASC = WS_FGMAX + 2 * FF * 4;
constexpr size_t WS_HBG = 6 * MiB;
constexpr size_t WS_MHG = WS_HBG + 65536;
constexpr size_t WS_TOPE = 2 * MiB;
constexpr size_t WS_TOPW = WS_TOPE + (size_t)T * 8;
constexpr size_t WS_RPOS = WS_TOPW + (size_t)T * 8;
constexpr size_t WS_RTOK = WS_RPOS + (size_t)T * 8;
constexpr size_t WS_SMALL_END = WS_RTOK + (size_t)MOE_ROWS * 4;
static_assert(WS_SMALL_END <= 8 * MiB && WS_ASC + (size_t)T * 4 <= 2 * MiB, "small region");
constexpr size_t WS_W = 8 * MiB;
constexpr size_t WO_POOL = WS_W;
constexpr size_t WO_FGU = WO_POOL + (size_t)4 * 256 * 256 * 2;
constexpr size_t WO_FDN = WO_FGU + (size_t)2 * FF * D * 2;
constexpr size_t WO_KV = WO_FDN + (size_t)D * FF * 2;
constexpr size_t WO_Q = WO_KV + (size_t)NKV * D * 2;
constexpr size_t WO_O = WO_Q + (size_t)NQP * D * 2;
constexpr size_t WO_CK = WO_O + (size_t)D * D * 2;
constexpr size_t WO_CV = WO_CK + (size_t)256 * 2048 * 2;
constexpr size_t WO_EGU = WO_CV + (size_t)256 * 2048 * 2;
constexpr size_t WO_EDN = WO_EGU + (size_t)NE * 2 * FE * D * 2;
constexpr size_t WO_END = WO_EDN + (size_t)NE * D * FE * 2;
static_assert(WO_END <= 203 * MiB, "weights region");
constexpr size_t WS_HB = 203 * MiB;
constexpr size_t WS_X1 = 267 * MiB;
constexpr size_t WS_X2 = 395 * MiB;
constexpr size_t WS_HID0 = 523 * MiB;
constexpr size_t WS_Q = 523 * MiB;
constexpr size_t WS_GATE = 587 * MiB;
constexpr size_t WS_CMPH = 593 * MiB;
constexpr size_t WS_KC = 601 * MiB;
constexpr size_t WS_VC = 602 * MiB;
constexpr size_t WS_KSB = 603 * MiB;
constexpr size_t WS_VSB = 619 * MiB;
constexpr size_t WS_KWB = 635 * MiB;
constexpr size_t WS_VWB = 651 * MiB;
constexpr size_t WS_Q8 = 267 * MiB;
constexpr size_t WS_SEL = 667 * MiB;
constexpr size_t WS_HA = 699 * MiB;
constexpr size_t WS_KVB = 763 * MiB;
constexpr size_t WS_HIDM = 267 * MiB;
constexpr size_t WS_Y = 743 * MiB;
constexpr size_t WS_XS = WS_Y;
constexpr size_t WS_END = 880 * MiB;
static_assert(WS_HIDM + (size_t)MOE_ROWS * FE * 2 <= WS_Y && WS_Y + (size_t)MOE_ROWS * D * 2 <= WS_END, "moe map");
static_assert(WS_KVB + (size_t)T * NKV * 2 + 65536 <= WS_END, "kv map");
constexpr int CW_CNT = 512;
constexpr int CW_CUR = 1024;
constexpr int CW_HN = 2048, CW_VT = 2112;
constexpr int CW_BAR = 4096;

struct Params {
    const float *x, *c, *ada_w, *ada_b, *norm_g, *pool_w, *pool_scale, *q_w, *q_gain, *o_w, *kv_ada_w, *kv_ada_b, *kv_norm_g, *kv_w,
        *cmp_pe_k, *cmp_pe_v, *cmp_k_w1, *cmp_k_w2, *cmp_v_w1, *cmp_v_w2, *k_gain, *rel_bias, *ffn_gu, *ffn_dn, *router_w, *router_b, *exp_gu, *exp_dn;
    float* out; unsigned char* ws;
};

__device__ __forceinline__ unsigned cvt_pk_bf16(float lo, float hi) { unsigned r; asm volatile("v_cvt_pk_bf16_f32 %0, %1, %2" : "=v"(r) : "v"(lo), "v"(hi)); return r; }
__device__ __forceinline__ float bf2f(unsigned short v) { return __uint_as_float((unsigned)v << 16); }
__device__ __forceinline__ float bflo(unsigned w) { return __uint_as_float(w << 16); }
__device__ __forceinline__ float bfhi(unsigned w) { return __uint_as_float(w & 0xffff0000u); }
__device__ __forceinline__ int opaque_tid() { int t = threadIdx.x; asm volatile("" : "+v"(t)); return t; }
__device__ __forceinline__ float readlane_f(float v, int l) { return __uint_as_float((unsigned)__builtin_amdgcn_readlane((int)__float_as_uint(v), l)); }
__device__ __forceinline__ unsigned pack_i8x4(float a, float b, float c, float d) {
    const int ia = (int)__builtin_rintf(fminf(fmaxf(a, -127.f), 127.f)), ib = (int)__builtin_rintf(fminf(fmaxf(b, -127.f), 127.f)), ic = (int)__builtin_rintf(fminf(fmaxf(c, -127.f), 127.f)), id = (int)__builtin_rintf(fminf(fmaxf(d, -127.f), 127.f));
    return (unsigned)(ia & 0xff) | ((unsigned)(ib & 0xff) << 8) | ((unsigned)(ic & 0xff) << 16) | ((unsigned)(id & 0xff) << 24);
}
__device__ __forceinline__ float sel_q_scale(const float* q_gain) { float m = 0.f; for (int i = 0; i < 64; ++i) m = fmaxf(m, fabsf(q_gain[i])); return 127.f / (4.f * m * 0.125f * 1.4426950408889634f); }
__device__ __forceinline__ float sel_k_scale(const float* k_gain) { float m = 0.f; for (int i = 0; i < 64; ++i) m = fmaxf(m, fabsf(k_gain[64 + i])); return 127.f / (4.f * m); }
__device__ __forceinline__ float wave_sum(float v) {
#pragma unroll
    for (int o = 1; o < 64; o <<= 1) v += __shfl_xor(v, o);
    return v;
}
__device__ __forceinline__ float wave_max(float v) {
#pragma unroll
    for (int o = 1; o < 64; o <<= 1) v = fmaxf(v, __shfl_xor(v, o));
    return v;
}
__device__ __forceinline__ float silu_f(float v) { return v * __builtin_amdgcn_rcpf(1.f + __builtin_amdgcn_exp2f(v * -1.4426950408889634f)); }
__device__ __forceinline__ float sigmoid_f(float v) { return __builtin_amdgcn_rcpf(1.f + __builtin_amdgcn_exp2f(v * -1.4426950408889634f)); }
__device__ __forceinline__ float gelu_tanh_f(float v) {
    const float u = 0.7978845608028654f * (v + 0.044715f * v * v * v);
    const float e = __builtin_amdgcn_exp2f(fabsf(u) * -2.8853900817779268f); const float th = (1.f - e) * __builtin_amdgcn_rcpf(1.f + e);
    return 0.5f * v * (1.f + (u < 0.f ? -th : th));
}
__device__ __forceinline__ int rel_bucket(int d) {
    if (d < 16) return d;
    int b = 16;
    b += (d >= 21); b += (d >= 27); b += (d >= 35); b += (d >= 46); b += (d >= 59); b += (d >= 77); b += (d >= 99); b += (d >= 128);
    b += (d >= 166); b += (d >= 216); b += (d >= 280); b += (d >= 363); b += (d >= 470); b += (d >= 609); b += (d >= 790);
    return b;
}

template <bool FP8 = false>
__device__ __forceinline__ void transpose_item(const float* W, int K, int N, bf16_t* WT, int k0, int n0, int drow0, LAS float* scr, int lane, float wscale = 1.f) {
    float wv[32];
#pragma unroll
    for (int i = 0; i < 32; ++i) { const int kk = 2 * i + (lane >> 5); const int n = n0 + (lane & 31); wv[i] = (n < N) ? W[(size_t)(k0 + kk) * N + n] : 0.f; }
#pragma unroll
    for (int i = 0; i < 32; ++i) { const int kk = 2 * i + (lane >> 5); scr[kk * 33 + (lane & 31)] = wv[i]; }
    asm volatile("s_waitcnt lgkmcnt(0)" ::: "memory");
    const int c = lane & 7;
#pragma unroll
    for (int j = 0; j < 4; ++j) { const int n = (lane >> 3) + 8 * j; const LAS float* s = scr + (8 * c) * 33 + n;
        if constexpr (FP8) {
            unsigned w0 = 0u, w1 = 0u;
            w0 = __builtin_amdgcn_cvt_pk_fp8_f32(s[0 * 33] * wscale, s[1 * 33] * wscale, w0, false); w0 = __builtin_amdgcn_cvt_pk_fp8_f32(s[2 * 33] * wscale, s[3 * 33] * wscale, w0, true);
            w1 = __builtin_amdgcn_cvt_pk_fp8_f32(s[4 * 33] * wscale, s[5 * 33] * wscale, w1, false); w1 = __builtin_amdgcn_cvt_pk_fp8_f32(s[6 * 33] * wscale, s[7 * 33] * wscale, w1, true);
            *(u32x2*)((unsigned char*)WT + (size_t)(drow0 + n) * K + k0 + 8 * c) = (u32x2){w0, w1};
        } else {
        u32x4 o; o.x = cvt_pk_bf16(s[0 * 33], s[1 * 33]); o.y = cvt_pk_bf16(s[2 * 33], s[3 * 33]); o.z = cvt_pk_bf16(s[4 * 33], s[5 * 33]); o.w = cvt_pk_bf16(s[6 * 33], s[7 * 33]);
        *(u32x4*)(WT + (size_t)(drow0 + n) * K + k0 + 8 * c) = o; } }
    asm volatile("s_waitcnt lgkmcnt(0)" ::: "memory");
}
template <int MODE, bool FP8 = false>
__device__ __forceinline__ void transpose_mat(const float* W, int K, int N, int NP, int F, bf16_t* WT, int it, LAS float* scr, int lane, float wscale = 1.f) {
    const int nblk = NP / 32, kb = it / nblk, nb = it % nblk, n0 = nb * 32;
    int drow0 = n0;
    if (MODE == 1) { const int up = n0 >= F, j = up ? n0 - F : n0; drow0 = (j >> 7) * 256 + (up ? 128 : 0) + (j & 127); }
    transpose_item<FP8>(W, K, N, WT, kb * 64, n0, drow0, scr, lane, wscale);
}
__device__ __forceinline__ void phase_convert_fgu(const Params& p, LAS unsigned char* lds) {
    const int tid = opaque_tid(), lane = tid & 63, wave = tid >> 6;
    LAS float* scr = (LAS float*)(lds + wave * 16384);
    const int gw = blockIdx.x * NWAVE + wave, NGW = gridDim.x * NWAVE;
    const float* FGMAX = (const float*)(p.ws + WS_FGMAX); unsigned char* WT = p.ws + WO_FGU;
    for (int it = gw; it < 16 * 176; it += NGW) {
        const int kb = it / 176, nb = it % 176, n0 = nb * 32, k0 = kb * 64;
        const int up = n0 >= FF, j0 = up ? n0 - FF : n0, drow0 = (j0 >> 7) * 256 + (up ? 128 : 0) + (j0 & 127);
        float wv[32];
#pragma unroll
        for (int i = 0; i < 32; ++i) wv[i] = p.ffn_gu[(size_t)(k0 + 2 * i + (lane >> 5)) * (2 * FF) + n0 + (lane & 31)];
#pragma unroll
        for (int i = 0; i < 32; ++i) scr[(2 * i + (lane >> 5)) * 33 + (lane & 31)] = wv[i];
        asm volatile("s_waitcnt lgkmcnt(0)" ::: "memory");
        const int c = lane & 7;
#pragma unroll
        for (int j = 0; j < 4; ++j) { const int n = (lane >> 3) + 8 * j; const LAS float* sp = scr + (8 * c) * 33 + n; const float sc = 127.f / FGMAX[n0 + n];
            const unsigned w0 = pack_i8x4(sp[0 * 33] * sc, sp[1 * 33] * sc, sp[2 * 33] * sc, sp[3 * 33] * sc), w1 = pack_i8x4(sp[4 * 33] * sc, sp[5 * 33] * sc, sp[6 * 33] * sc, sp[7 * 33] * sc);
            *(u32x2*)(WT + (size_t)(drow0 + n) * D + k0 + 8 * c) = (u32x2){w0, w1}; }
        asm volatile("s_waitcnt lgkmcnt(0)" ::: "memory");
    }
}
__device__ __forceinline__ void phase_weights(const Params& p, LAS unsigned char* lds) {
    const int tid = opaque_tid(), lane = tid & 63, wave = tid >> 6;
    LAS float* scr = (LAS float*)(lds + wave * 16384);
    const int gw = blockIdx.x * NWAVE + wave, NGW = gridDim.x * NWAVE;
    unsigned char* ws = p.ws;
    constexpr int I_POOL = 4 * 8, I_FGU = 16 * 176, I_FDN = 44 * 32, I_KV = 16 * 48, I_Q = 16 * 40, I_O = 16 * 32, I_C = 32 * 8, I_EGU = 16 * 224, I_EDN = 56 * 32;
    constexpr int TOT = 4 * I_POOL + I_FGU + I_FDN + I_KV + I_Q + I_O + 2 * I_C + NE * I_EGU + NE * I_EDN;
    for (int it = gw; it < TOT; it += NGW) {
        int r = it;
        if (r < 4 * I_POOL) { const int g = r / I_POOL; transpose_mat<0>(p.pool_w + (size_t)g * 65536, 256, 256, 256, 0, (bf16_t*)(ws + WO_POOL) + (size_t)g * 65536, r % I_POOL, scr, lane); continue; } r -= 4 * I_POOL;
        if (r < I_FGU) continue; r -= I_FGU;
        if (r < I_FDN) { transpose_mat<0>(p.ffn_dn, FF, D, D, 0, (bf16_t*)(ws + WO_FDN), r, scr, lane); continue; } r -= I_FDN;
        if (r < I_KV) { transpose_mat<0>(p.kv_w, D, NKV, NKV, 0, (bf16_t*)(ws + WO_KV), r, scr, lane); continue; } r -= I_KV;
        if (r < I_Q) { transpose_mat<0>(p.q_w, D, NQ, NQP, 0, (bf16_t*)(ws + WO_Q), r, scr, lane); continue; } r -= I_Q;
        if (r < I_O) { transpose_mat<0>(p.o_w, D, D, D, 0, (bf16_t*)(ws + WO_O), r, scr, lane); continue; } r -= I_O;
        if (r < I_C) { transpose_mat<0>(p.cmp_k_w1, 2048, 256, 256, 0, (bf16_t*)(ws + WO_CK), r, scr, lane); continue; } r -= I_C;
        if (r < I_C) { transpose_mat<0>(p.cmp_v_w1, 2048, 256, 256, 0, (bf16_t*)(ws + WO_CV), r, scr, lane); continue; } r -= I_C;
        if (r < NE * I_EGU) { const int e = r / I_EGU; transpose_mat<1, true>(p.exp_gu + (size_t)e * D * 2 * FE, D, 2 * FE, 2 * FE, FE, (bf16_t*)(ws + WO_EGU + (size_t)e * 2 * FE * D), r % I_EGU, scr, lane, 32.f); continue; } r -= NE * I_EGU;
        { const int e = r / I_EDN; transpose_mat<0, true>(p.exp_dn + (size_t)e * FE * D, FE, D, D, 0, (bf16_t*)(ws + WO_EDN + (size_t)e * D * FE), r % I_EDN, scr, lane, 64.f); }
    }
}

__device__ __forceinline__ void phase_modvec(const Params& p, LAS unsigned char* lds) {
    const int tid = opaque_tid(), lane = tid & 63, wave = tid >> 6;
    LAS float* part = (LAS float*)lds;
    LAS float* sc_l = (LAS float*)(lds + 8192);
    for (int i = tid; i < 4 * D; i += NTHR) sc_l[i] = silu_f(p.c[i]);
    __syncthreads();
    float* MODV = (float*)(p.ws + WS_MODV);
    float* CMPB = (float*)(p.ws + WS_CMPB);
    { float* FGMAX = (float*)(p.ws + WS_FGMAX);
      for (int u = blockIdx.x; u < 2 * FF / 64; u += gridDim.x) {
        const int col = u * 64 + lane; float m = 0.f;
#pragma unroll 16
        for (int k = wave * 128; k < wave * 128 + 128; ++k) m = fmaxf(m, fabsf(p.ffn_gu[(size_t)k * (2 * FF) + col]));
        part[wave * 64 + lane] = m;
        __syncthreads();
        if (tid < 64) { float mm = part[lane];
#pragma unroll
            for (int w = 1; w < 8; ++w) mm = fmaxf(mm, part[w * 64 + lane]);
            FGMAX[u * 64 + lane] = fmaxf(mm, 1e-30f); }
        __syncthreads();
      } }
    constexpr int NU_MOD = 14336 / 64, NU = NU_MOD + 8;
    for (int u = blockIdx.x; u < NU; u += gridDim.x) {
        float acc[4] = {0.f, 0.f, 0.f, 0.f};
        if (u < NU_MOD) {
            const int gc = u * 64 + lane;
            const float* W; int ldw, col;
            if (gc < 6144) { W = p.ada_w; ldw = 6144; col = gc; } else if (gc < 12288) { W = p.ada_w + (size_t)D * 6144; ldw = 6144; col = gc - 6144; } else { W = p.kv_ada_w; ldw = 2048; col = gc - 12288; }
#pragma unroll 16
            for (int k = wave * 128; k < wave * 128 + 128; ++k) {
                const float w = W[(size_t)k * ldw + col];
#pragma unroll
                for (int b = 0; b < 4; ++b) acc[b] += sc_l[b * D + k] * w;
            }
        } else {
            const int cu = u - NU_MOD, kv = cu >> 2, col = (cu & 3) * 64 + lane;
            const float* W = kv ? p.cmp_v_w1 : p.cmp_k_w1; const float* pe = kv ? p.cmp_pe_v : p.cmp_pe_k;
#pragma unroll 16
            for (int k = wave * 256; k < wave * 256 + 256; ++k) acc[0] += pe[k] * W[(size_t)k * 256 + col];
        }
#pragma unroll
        for (int b = 0; b < 4; ++b) part[(wave * 4 + b) * 64 + lane] = acc[b];
        __syncthreads();
        if (tid < 256) {
            const int b = tid >> 6; float s = 0.f;
#pragma unroll
            for (int w = 0; w < 8; ++w) s += part[(w * 4 + b) * 64 + lane];
            if (u < NU_MOD) {
                const int gc = u * 64 + lane; int which, n; float bias;
                if (gc < 6144) { which = gc >> 10; n = gc & 1023; bias = p.ada_b[gc]; } else if (gc < 12288) { which = 6 + ((gc - 6144) >> 10); n = gc & 1023; bias = p.ada_b[gc]; }
                else { which = 12 + ((gc - 12288) >> 10); n = gc & 1023; bias = p.kv_ada_b[gc - 12288]; }
                MODV[(which * 4 + b) * D + n] = s + bias;
            } else if (b == 0) { const int cu = u - NU_MOD; CMPB[(cu >> 2) * 256 + (cu & 3) * 64 + lane] = s; }
        }
        __syncthreads();
    }
}

template <int W>
__device__ __forceinline__ void pool_rows(const float* xb, int t0, const LAS float* rs, f32x2 gm, f32x2 sh, bf16_t* outb, int c0) {
    f32x2 ring[16];
#pragma unroll
    for (int i = 0; i < 15; ++i) {
        const int t = t0 - 15 + i; f32x2 h = {0.f, 0.f};
        if (t >= 0) { const f32x2 xv = *(const f32x2*)(xb + (size_t)t * D + c0); const float r = rs[i]; h = xv * r * gm + sh; }
        ring[i] = h;
    }
    for (int gi = 0; gi < 8; ++gi) {
#pragma unroll
        for (int j = 0; j < 16; ++j) {
            const int i = 15 + gi * 16 + j, t = t0 + gi * 16 + j;
            const f32x2 xv = *(const f32x2*)(xb + (size_t)t * D + c0); const float r = rs[i];
            const f32x2 h = xv * r * gm + sh;
            ring[(15 + j) & 15] = h;
            f32x2 s = {0.f, 0.f};
#pragma unroll
            for (int k = 0; k < W; ++k) s += ring[(15 + j - k) & 15];
            const int cnt = (t + 1 < W) ? t + 1 : W;
            const f32x2 o = s * (1.f / (float)cnt) - h;
            *(unsigned*)(outb + (size_t)t * D + c0) = cvt_pk_bf16(o.x, o.y);
        }
    }
}
__device__ __forceinline__ void phase_poolmix(const Params& p, LAS unsigned char* lds, bf16_t* mixA) {
    const int tid = opaque_tid(), lane = tid & 63, wave = tid >> 6;
    LAS float* rs = (LAS float*)lds;
    const float* MODV = (const float*)(p.ws + WS_MODV);
    for (int u = blockIdx.x; u < T / 128; u += gridDim.x) {
        const int b = u >> 6, t0 = (u & 63) * 128;
        const float* xb = p.x + (size_t)b * S * D;
        for (int i = wave; i < 143; i += NWAVE) {
            const int t = t0 - 15 + i; float r = 0.f;
            if (t >= 0) { const f32x4* xr = (const f32x4*)(xb + (size_t)t * D) + lane; float s = 0.f;
#pragma unroll
                for (int j = 0; j < 4; ++j) { const f32x4 v = xr[64 * j]; s += (v.x * v.x + v.y * v.y) + (v.z * v.z + v.w * v.w); }
                r = 1.f / sqrtf(wave_sum(s) * (1.f / D) + EPS); }
            if (lane == 0) rs[i] = r;
        }
        __syncthreads();
        const int c0 = 2 * tid;
        const f32x2 g = *(const f32x2*)(p.norm_g + c0), sc = *(const f32x2*)(MODV + (1 * 4 + b) * D + c0), sh = *(const f32x2*)(MODV + (0 * 4 + b) * D + c0);
        const f32x2 gm = g * (sc + 1.f);
        bf16_t* ob = mixA + (size_t)b * S * D;
        const int grp = tid >> 7;
        if (grp == 0) pool_rows<2>(xb, t0, rs, gm, sh, ob, c0);
        else if (grp == 1) pool_rows<4>(xb, t0, rs, gm, sh, ob, c0);
        else if (grp == 2) pool_rows<8>(xb, t0, rs, gm, sh, ob, c0);
        else pool_rows<16>(xb, t0, rs, gm, sh, ob, c0);
        __syncthreads();
    }
}

struct NormOut { const float* g; const float* sc; const float* sh; bf16_t* out; };
template <int NOUT, bool ROUTER, int OUTQ = 0>
__device__ __forceinline__ void phase_norm(const Params& p, LAS unsigned char* lds, const float* xin, const NormOut o0, const NormOut o1) {
    const int tid = opaque_tid(), lane = tid & 63, wave = tid >> 6;
    const int gw = blockIdx.x * NWAVE + wave, NGW = gridDim.x * NWAVE;
    f32x4 rwa[16], rwb[16];
    if (ROUTER) {
#pragma unroll
        for (int j = 0; j < 4; ++j)
#pragma unroll
            for (int q = 0; q < 4; ++q) { const f32x4* wp = (const f32x4*)(p.router_w + (size_t)(4 * lane + 256 * j + q) * NE); rwa[4 * j + q] = wp[0]; rwb[4 * j + q] = wp[1]; }
    }
    unsigned* ctl = (unsigned*)(p.ws + WS_CTL);
    int* TOPE = (int*)(p.ws + WS_TOPE); float* TOPW = (float*)(p.ws + WS_TOPW);
    unsigned cnt_local[NE];
#pragma unroll
    for (int e = 0; e < NE; ++e) cnt_local[e] = 0;
    const int rows_per = T / NGW > 0 ? (T + NGW - 1) / NGW : 1;
    const int r0 = gw * rows_per, r1 = (r0 + rows_per < T) ? r0 + rows_per : T;
    int curb = -1; f32x4 gm0[4], sh0[4], gm1[4], sh1[4];
    for (int r = r0; r < r1; ++r) {
        const int b = r >> 13;
        if (b != curb) { curb = b;
#pragma unroll
            for (int j = 0; j < 4; ++j) { const int c = 4 * lane + 256 * j;
                gm0[j] = *(const f32x4*)(o0.g + c) * (*(const f32x4*)(o0.sc + b * D + c) + 1.f); sh0[j] = *(const f32x4*)(o0.sh + b * D + c);
                if (NOUT > 1) { gm1[j] = *(const f32x4*)(o1.g + c) * (*(const f32x4*)(o1.sc + b * D + c) + 1.f); sh1[j] = *(const f32x4*)(o1.sh + b * D + c); } } }
        const f32x4* xr = (const f32x4*)(xin + (size_t)r * D) + lane;
        f32x4 v[4]; float s = 0.f;
#pragma unroll
        for (int j = 0; j < 4; ++j) { v[j] = xr[64 * j]; s += (v[j].x * v[j].x + v[j].y * v[j].y) + (v[j].z * v[j].z + v[j].w * v[j].w); }
        const float rstd = 1.f / sqrtf(wave_sum(s) * (1.f / D) + EPS);
        float lg[NE];
#pragma unroll
        for (int e = 0; e < NE; ++e) lg[e] = 0.f;
        float qsc = 1.f;
        if constexpr (OUTQ == 2) { float mx = 0.f;
#pragma unroll
            for (int j = 0; j < 4; ++j) { const f32x4 h = v[j] * rstd * gm0[j] + sh0[j]; mx = fmaxf(mx, fmaxf(fmaxf(fabsf(h.x), fabsf(h.y)), fmaxf(fabsf(h.z), fabsf(h.w)))); }
            mx = fmaxf(wave_max(mx), 1e-30f); qsc = 127.f / mx;
            if (lane == 0) ((float*)(p.ws + WS_ASC))[r] = mx * (1.f / 127.f); }
#pragma unroll
        for (int j = 0; j < 4; ++j) {
            const f32x4 h = v[j] * rstd * gm0[j] + sh0[j];
            if constexpr (OUTQ == 2) { *(unsigned*)((unsigned char*)o0.out + (size_t)r * D + 4 * lane + 256 * j) = pack_i8x4(h.x * qsc, h.y * qsc, h.z * qsc, h.w * qsc); }
            else if constexpr (OUTQ == 1) { unsigned w8 = 0u; w8 = __builtin_amdgcn_cvt_pk_fp8_f32(h.x, h.y, w8, false); w8 = __builtin_amdgcn_cvt_pk_fp8_f32(h.z, h.w, w8, true);
                *(unsigned*)((unsigned char*)o0.out + (size_t)r * D + 4 * lane + 256 * j) = w8; }
            else { u32x2 w; w.x = cvt_pk_bf16(h.x, h.y); w.y = cvt_pk_bf16(h.z, h.w);
            *(u32x2*)(o0.out + (size_t)r * D + 4 * lane + 256 * j) = w; }
            if (NOUT > 1) { const f32x4 h1 = v[j] * rstd * gm1[j] + sh1[j]; u32x2 w1; w1.x = cvt_pk_bf16(h1.x, h1.y); w1.y = cvt_pk_bf16(h1.z, h1.w);
                *(u32x2*)(o1.out + (size_t)r * D + 4 * lane + 256 * j) = w1; }
            if (ROUTER) {
#pragma unroll
                for (int q = 0; q < 4; ++q) { const f32x4 a = rwa[4 * j + q], c2 = rwb[4 * j + q]; const float hv = h[q];
                    lg[0] += hv * a.x; lg[1] += hv * a.y; lg[2] += hv * a.z; lg[3] += hv * a.w; lg[4] += hv * c2.x; lg[5] += hv * c2.y; lg[6] += hv * c2.z; lg[7] += hv * c2.w; }
            }
        }
        if (ROUTER) {
            {
                const bool u5 = lane & 32, u4 = lane & 16, u3 = lane & 8; float a4[4], a2[2], a1;
#pragma unroll
                for (int i = 0; i < 4; ++i) a4[i] = (u5 ? lg[4 + i] : lg[i]) + __shfl_xor(u5 ? lg[i] : lg[4 + i], 32);
#pragma unroll
                for (int i = 0; i < 2; ++i) a2[i] = (u4 ? a4[2 + i] : a4[i]) + __shfl_xor(u4 ? a4[i] : a4[2 + i], 16);
                a1 = (u3 ? a2[1] : a2[0]) + __shfl_xor(u3 ? a2[0] : a2[1], 8);
                a1 += __shfl_xor(a1, 4); a1 += __shfl_xor(a1, 2); a1 += __shfl_xor(a1, 1);
#pragma unroll
                for (int e = 0; e < NE; ++e) lg[e] = readlane_f(a1, 8 * e) + p.router_b[e];
            }
            int e0 = 0; float v0 = lg[0];
#pragma unroll
            for (int e = 1; e < NE; ++e) if (lg[e] > v0) { v0 = lg[e]; e0 = e; }
            int e1 = -1; float v1 = -3.0e38f;
#pragma unroll
            for (int e = 0; e < NE; ++e) if (e != e0 && lg[e] > v1) { v1 = lg[e]; e1 = e; }
            const float ex = __expf(v1 - v0), w0 = 1.f / (1.f + ex), w1 = ex / (1.f + ex);
            if (lane == 0) { TOPE[2 * r] = e0; TOPE[2 * r + 1] = e1; TOPW[2 * r] = w0; TOPW[2 * r + 1] = w1; }
#pragma unroll
            for (int e = 0; e < NE; ++e) cnt_local[e] += (e == e0) + (e == e1);
        }
    }
    if (ROUTER) {
        LAS unsigned* lc = (LAS unsigned*)lds;
        if (tid < NE) lc[tid] = 0u;
        __syncthreads();
        if (lane == 0) {
#pragma unroll
            for (int e = 0; e < NE; ++e) if (cnt_local[e]) atomicAdd((unsigned*)(lc + e), cnt_local[e]);
        }
        __syncthreads();
        if (tid < NE && lc[tid]) atomicAdd(ctl + CW_CNT + 64 * tid, lc[tid]);
    }
}

struct EpiPool {
    const float* x; float* x1; const float* g1; const float* scale; int coff;
    __device__ __forceinline__ void operator()(int row, int col, f32x4 v) const { const int c = coff + col, b = row >> 13;
        const f32x4 xv = *(const f32x4*)(x + (size_t)row * D + c), gv = *(const f32x4*)(g1 + b * D + c), sv = *(const f32x4*)(scale + c);
        *(f32x4*)(x1 + (size_t)row * D + c) = xv + gv * (v * sv); }
};
struct EpiSwiglu {
    bf16_t* hid; int ldh;
    __device__ __forceinline__ void pair(int row, int hc, f32x4 gt, f32x4 up) const {
        u32x2 w; w.x = cvt_pk_bf16(silu_f(gt.x) * up.x, silu_f(gt.y) * up.y); w.y = cvt_pk_bf16(silu_f(gt.z) * up.z, silu_f(gt.w) * up.w);
        *(u32x2*)(hid + (size_t)row * ldh + hc) = w; }
};
struct EpiSwigluI8 {
    bf16_t* hid; int ldh; const float* asc; const float* wmax;
    __device__ __forceinline__ void pair(int row, int hc, f32x4 gt, f32x4 up) const {
        typedef int i32x4e __attribute__((ext_vector_type(4)));
        const i32x4e gi = __builtin_bit_cast(i32x4e, gt), ui = __builtin_bit_cast(i32x4e, up);
        const float ra = asc[row] * (1.f / 127.f); const f32x4 wg = *(const f32x4*)(wmax + hc) * ra, wu = *(const f32x4*)(wmax + FF + hc) * ra;
        const float g0 = (float)gi.x * wg.x, g1 = (float)gi.y * wg.y, g2 = (float)gi.z * wg.z, g3 = (float)gi.w * wg.w;
        u32x2 w; w.x = cvt_pk_bf16(silu_f(g0) * ((float)ui.x * wu.x), silu_f(g1) * ((float)ui.y * wu.y)); w.y = cvt_pk_bf16(silu_f(g2) * ((float)ui.z * wu.z), silu_f(g3) * ((float)ui.w * wu.w));
        *(u32x2*)(hid + (size_t)row * ldh + hc) = w; }
};
struct EpiSwiglu8 {
    unsigned char* hid; int ldh;
    __device__ __forceinline__ void pair(int row, int hc, f32x4 gt, f32x4 up) const {
        unsigned w = 0u; w = __builtin_amdgcn_cvt_pk_fp8_f32(silu_f(gt.x) * up.x, silu_f(gt.y) * up.y, w, false); w = __builtin_amdgcn_cvt_pk_fp8_f32(silu_f(gt.z) * up.z, silu_f(gt.w) * up.w, w, true);
        *(unsigned*)(hid + (size_t)row * ldh + hc) = w; }
};
struct EpiResid {
    const float* xin; float* out; const float* gate;
    __device__ __forceinline__ void operator()(int row, int col, f32x4 v) const { const int b = row >> 13;
        const f32x4 xv = *(const f32x4*)(xin + (size_t)row * D + col), gv = *(const f32x4*)(gate + b * D + col);
        *(f32x4*)(out + (size_t)row * D + col) = xv + gv * v; }
};
struct EpiBf16 {
    bf16_t* o; int ldo;
    __device__ __forceinline__ void operator()(int row, int col, f32x4 v) const { u32x2 w; w.x = cvt_pk_bf16(v.x, v.y); w.y = cvt_pk_bf16(v.z, v.w); *(u32x2*)(o + (size_t)row * ldo + col) = w; }
};
struct EpiQ {
    bf16_t* q; float* gates; int coff;
    __device__ __forceinline__ void operator()(int row, int col_, f32x4 v) const { const int col = col_ + coff;
        if (col < D) { u32x2 w; w.x = cvt_pk_bf16(v.x, v.y); w.y = cvt_pk_bf16(v.z, v.w); *(u32x2*)(q + (size_t)row * D + col) = w; }
        else if (col < NQ) { f32x4 s; s.x = sigmoid_f(v.x); s.y = sigmoid_f(v.y); s.z = sigmoid_f(v.z); s.w = sigmoid_f(v.w); *(f32x4*)(gates + (size_t)row * 48 + (col - D)) = s; } }
};
struct EpiCmp {
    bf16_t* o; const float* bias;
    __device__ __forceinline__ void operator()(int row, int col, f32x4 v) const { const int z = col >> 8, c = col & 255; const f32x4 bv = *(const f32x4*)(bias + (z >> 2) * 256 + c);
        u32x2 w; w.x = cvt_pk_bf16(gelu_tanh_f(v.x + bv.x), gelu_tanh_f(v.y + bv.y)); w.y = cvt_pk_bf16(gelu_tanh_f(v.z + bv.z), gelu_tanh_f(v.w + bv.w));
        *(u32x2*)(o + ((size_t)z * 2048 + row) * 256 + c) = w; }
};


namespace pg8 {
#define PG8_LAS __attribute__((address_space(3)))
constexpr int BM = 256, BK = 64, HALF = 128, HTB = HALF * BK * 2, STAGE_BYTES = 8 * HTB, NXCD = 8, WGM = 8;
__host__ __device__ __forceinline__ int lds_byte(int r, int c) { const int st = (r >> 4) * 2 + (c >> 5), rr = r & 15, cc = c & 31, ob = rr * 64 + cc * 2; return st * 1024 + (ob ^ (((ob >> 9) & 1) << 5)); }
__host__ __device__ __forceinline__ void stage_rc(int b, int& R, int& C) { const int st = b / 1024, sb = b % 1024, swz = sb ^ (((sb >> 9) & 1) << 5); R = (st >> 1) * 16 + swz / 64; C = (st & 1) * 32 + (swz % 64) / 2; }
__host__ __device__ __forceinline__ int perm32(int rho) { const int n = rho >> 4, i = rho & 15; return 8 * (i >> 2) + 4 * n + (i & 3); }
struct Unit { int pm, pn; };
template <int SMODE> struct Sched {
    int nM, nN, nwg, G, c; const char* A; const char* Bt; size_t lda2, ldb2; const int* pst; size_t bstride2;
    __device__ __forceinline__ void init(int M, int N, int G_, int c_, const void* A_, const void* Bt_, int lda, int ldb, const int* pst_ = nullptr, size_t bstride = 0) {
        nM = M / BM; nN = N / BM; nwg = nM * nN; G = G_; c = c_; A = (const char*)A_; Bt = (const char*)Bt_; lda2 = (size_t)lda * 2; ldb2 = (size_t)ldb * 2; pst = pst_; bstride2 = bstride * 2; }
    __device__ __forceinline__ bool next(int i, Unit& u) const {
        if (c < 0) return false;
        const long L = (long)i * G + c; if (L >= nwg) return false;
        int wgid = (int)L; { const int q = nwg / NXCD, r = nwg % NXCD, xcd = wgid % NXCD, off = wgid / NXCD; wgid = (xcd < r ? xcd * (q + 1) : r * (q + 1) + (xcd - r) * q) + off; }
        const int nig = WGM * nN, gid = wgid / nig, fm = gid * WGM, gsz = (nM - fm) < WGM ? (nM - fm) : WGM;
        u.pm = fm + ((wgid % nig) % gsz); u.pn = (wgid % nig) / gsz; return true;
    }
    __device__ __forceinline__ const char* a_ptr(const Unit& u) const {
        if (SMODE == 1) return A + (size_t)u.pm * BM * lda2 + (size_t)u.pn * 512;
        if (SMODE == 2) return A + (size_t)u.pm * BM * lda2 + (size_t)((u.pn >> 2) * 256 + (u.pn & 3) * 64) * 2;
        return A + (size_t)u.pm * BM * lda2; }
    __device__ __forceinline__ const char* b_ptr(const Unit& u) const {
        if (SMODE == 2) return Bt + (size_t)(u.pn >> 2) * BM * ldb2;
        if (SMODE == 3) { const int m0 = u.pm * BM; int e = 0;
#pragma unroll
            for (int q = 1; q < NE; ++q) e += (m0 >= pst[q]); return Bt + (size_t)e * bstride2 + (size_t)u.pn * BM * ldb2; }
        return Bt + (size_t)u.pn * BM * ldb2; }
};
template <class F> struct EpiEl { static constexpr bool PERM = false, AFTER_DRAIN = false; F f;
    __device__ __forceinline__ void operator()(const f32x4 (&acc)[2][2][4][2], const Unit& u, int wr, int wc, int fr, int fq) const {
#pragma unroll
        for (int ai = 0; ai < 2; ++ai)
#pragma unroll
            for (int m = 0; m < 4; ++m) { const int row = u.pm * BM + ai * HALF + wr * 64 + m * 16 + fr;
#pragma unroll
                for (int bj = 0; bj < 2; ++bj)
#pragma unroll
                    for (int n = 0; n < 2; ++n) f(row, u.pn * BM + bj * HALF + wc * 32 + n * 16 + 4 * fq, acc[ai][bj][m][n]); } } };
template <class F> struct EpiPairEl { static constexpr bool PERM = false, AFTER_DRAIN = false; F f;
    __device__ __forceinline__ void operator()(const f32x4 (&acc)[2][2][4][2], const Unit& u, int wr, int wc, int fr, int fq) const {
#pragma unroll
        for (int ai = 0; ai < 2; ++ai)
#pragma unroll
            for (int m = 0; m < 4; ++m) { const int row = u.pm * BM + ai * HALF + wr * 64 + m * 16 + fr;
#pragma unroll
                for (int n = 0; n < 2; ++n) f.pair(row, u.pn * HALF + wc * 32 + n * 16 + 4 * fq, acc[ai][0][m][n], acc[ai][1][m][n]); } } };

typedef int i32x8 __attribute__((ext_vector_type(8)));
template <int QM> __device__ __forceinline__ void mma_block(f32x4 (&acc)[4][2], const bf16x8 (&At)[4][2], const bf16x8 (&Bt)[2][2], const int wsc) {
    __builtin_amdgcn_s_setprio(1);
    if constexpr (QM == 2) {
        typedef int i32x4m __attribute__((ext_vector_type(4)));
#pragma unroll
        for (int m = 0; m < 4; ++m)
#pragma unroll
            for (int n = 0; n < 2; ++n)
#pragma unroll
                for (int k = 0; k < 2; ++k) acc[m][n] = __builtin_bit_cast(f32x4, __builtin_amdgcn_mfma_i32_16x16x64_i8(__builtin_bit_cast(i32x4m, Bt[n][k]), __builtin_bit_cast(i32x4m, At[m][k]), __builtin_bit_cast(i32x4m, acc[m][n]), 0, 0, 0));
#pragma unroll
        for (int m = 0; m < 4; ++m) asm volatile("" : "+v"(acc[m][0]), "+v"(acc[m][1]));
    } else if constexpr (QM == 1) {
#pragma unroll
        for (int m = 0; m < 4; ++m) { const u32x4 a0 = __builtin_bit_cast(u32x4, At[m][0]), a1 = __builtin_bit_cast(u32x4, At[m][1]);
            const i32x8 a8 = {(int)a0.x, (int)a0.y, (int)a0.z, (int)a0.w, (int)a1.x, (int)a1.y, (int)a1.z, (int)a1.w};
#pragma unroll
            for (int n = 0; n < 2; ++n) { const u32x4 b0 = __builtin_bit_cast(u32x4, Bt[n][0]), b1 = __builtin_bit_cast(u32x4, Bt[n][1]);
                const i32x8 b8 = {(int)b0.x, (int)b0.y, (int)b0.z, (int)b0.w, (int)b1.x, (int)b1.y, (int)b1.z, (int)b1.w};
                acc[m][n] = __builtin_amdgcn_mfma_scale_f32_16x16x128_f8f6f4(b8, a8, acc[m][n], 0, 0, 0, wsc, 0, 127); } }
#pragma unroll
        for (int m = 0; m < 4; ++m) asm volatile("" : "+v"(acc[m][0]), "+v"(acc[m][1]));
    } else {
#pragma unroll
        for (int m = 0; m < 4; ++m)
#pragma unroll
            for (int n = 0; n < 2; ++n)
#pragma unroll
                for (int k = 0; k < 2; ++k) acc[m][n] = __builtin_amdgcn_mfma_f32_16x16x32_bf16(Bt[n][k], At[m][k], acc[m][n], 0, 0, 0);
    }
    __builtin_amdgcn_s_setprio(0);
}
template <class Epi, class Sched, bool ALIGN_EPI = true, bool SP2 = true, int QM = 0>
__device__ __forceinline__ void gemm_phase(PG8_LAS unsigned char* lds, const int K, const int lda, const int ldb, const size_t kstepA, const Sched& S, const Epi& E, const int wsc = 127) {
    const int tid_ = opaque_tid();
    const int tid = tid_, wid = __builtin_amdgcn_readfirstlane(tid >> 6), lane = tid & 63, wr = wid >> 2, wc = wid & 3, fr = lane & 15, fq = lane >> 4;
    const int nt = K / BK;
    unsigned voffA[2], voffB[2];
#pragma unroll
    for (int i = 0; i < 2; ++i) { int R, C; stage_rc(tid * 16 + i * 8192, R, C); const int Rb = Epi::PERM ? ((R & ~31) + perm32(R & 31)) : R;
        voffA[i] = (unsigned)(R * lda + C) * 2u; voffB[i] = (unsigned)(Rb * ldb + C) * 2u; }
    const size_t kstepB = (size_t)(BK * 2);
    const size_t hstepA = (size_t)HALF * lda * 2, hstepB = (size_t)HALF * ldb * 2;
    const unsigned ldsw = (unsigned)wid * 1024u;
    int aoffk[2], boffk[2];
#pragma unroll
    for (int k = 0; k < 2; ++k) { const int col = (QM == 1) ? ((fq >> 1) * 32 + (fq & 1) * 16 + 8 * k) : (k * 32 + fq * 8); aoffk[k] = lds_byte(wr * 64 + fr, col); boffk[k] = lds_byte(wc * 32 + fr, col); }
#define PG8_SA(b, h) (((b) * 2 + (h)) * HTB)
#define PG8_SB(b, h) ((4 + (b) * 2 + (h)) * HTB)
#define PG8_STAGE(bufoff, gbase, voff) do { _Pragma("unroll") for (int _i = 0; _i < 2; ++_i) \
        __builtin_amdgcn_global_load_lds((const unsigned*)((const char*)(gbase) + (voff)[_i]), (PG8_LAS unsigned*)(lds + (bufoff) + ldsw + _i * 8192), 16, 0, 0); } while (0)
#define PG8_LDA(dst, b, h) do { _Pragma("unroll") for (int m = 0; m < 4; ++m) _Pragma("unroll") for (int k = 0; k < 2; ++k) dst[m][k] = *(const PG8_LAS bf16x8*)(lds + PG8_SA(b, h) + ((QM == 1) ? aoffk[k] : aoffk[0] + k * 1024) + m * 2048); } while (0)
#define PG8_LDB(dst, b, h) do { _Pragma("unroll") for (int n = 0; n < 2; ++n) _Pragma("unroll") for (int k = 0; k < 2; ++k) dst[n][k] = *(const PG8_LAS bf16x8*)(lds + PG8_SB(b, h) + ((QM == 1) ? boffk[k] : boffk[0] + k * 1024) + n * 2048); } while (0)
#define PG8_MMA(ai, bj, At, Bt) mma_block<QM>(acc[ai][bj], At, Bt, wsc)
#define PG8_WAIT_V(n) asm volatile("s_waitcnt vmcnt(" #n ")" ::: "memory")
#define PG8_WAIT_L(n) asm volatile("s_waitcnt lgkmcnt(" #n ")" ::: "memory")
#define PG8_BAR __builtin_amdgcn_s_barrier()
#define PG8_SCHED __builtin_amdgcn_sched_barrier(0)
    Unit cur, nxt; int ui = 0;
    if (!S.next(0, cur)) return;
    f32x4 acc[2][2][4][2];
#pragma unroll
    for (int a = 0; a < 2; ++a)
#pragma unroll
        for (int b = 0; b < 2; ++b)
#pragma unroll
            for (int m = 0; m < 4; ++m)
#pragma unroll
                for (int n = 0; n < 2; ++n) acc[a][b][m][n] = (f32x4){0.f, 0.f, 0.f, 0.f};
    bf16x8 At[4][2], B0[2][2], B1[2][2];
    const char* cA = S.a_ptr(cur); const char* cB = S.b_ptr(cur);
    if constexpr (SP2) {
        PG8_STAGE(PG8_SB(0, 0), cB, voffB); PG8_STAGE(PG8_SB(0, 1), cB + hstepB, voffB); PG8_STAGE(PG8_SA(0, 0), cA, voffA); PG8_STAGE(PG8_SA(0, 1), cA + hstepA, voffA);
        if (wr == 1) PG8_BAR;
        PG8_WAIT_V(2); PG8_BAR;
        PG8_STAGE(PG8_SB(1, 0), cB + kstepB, voffB); PG8_STAGE(PG8_SA(1, 0), cA + kstepA, voffA); PG8_STAGE(PG8_SB(1, 1), cB + hstepB + kstepB, voffB);
        PG8_WAIT_V(6); PG8_BAR;
    } else {
        PG8_STAGE(PG8_SB(0, 0), cB, voffB); PG8_STAGE(PG8_SA(0, 0), cA, voffA); PG8_STAGE(PG8_SB(0, 1), cB + hstepB, voffB); PG8_STAGE(PG8_SA(0, 1), cA + hstepA, voffA);
        if (wr == 1) PG8_BAR;
        PG8_WAIT_V(4); PG8_BAR;
        PG8_STAGE(PG8_SB(1, 0), cB + kstepB, voffB); PG8_STAGE(PG8_SA(1, 0), cA + kstepA, voffA); PG8_STAGE(PG8_SB(1, 1), cB + hstepB + kstepB, voffB);
        PG8_WAIT_V(6); PG8_BAR;
    }
    for (;;) {
        const bool has_next = S.next(ui + 1, nxt);
        const char* nA = has_next ? S.a_ptr(nxt) : cA; const char* nB = has_next ? S.b_ptr(nxt) : cB;
        for (int t = 0; t < nt; t += 2) {
            const bool last = (t == nt - 2);
            const char* a1 = cA + (size_t)(t + 1) * kstepA;
            const char* a2 = last ? nA : cA + (size_t)(t + 2) * kstepA; const char* b2 = last ? nB : cB + (size_t)(t + 2) * kstepB;
            const char* a3 = a2 + kstepA; const char* b3 = b2 + kstepB;
            if constexpr (SP2) {
            PG8_LDB(B0, 0, 0); PG8_LDB(B1, 0, 1); PG8_SCHED; PG8_LDA(At, 0, 0); PG8_STAGE(PG8_SA(1, 1), a1 + hstepA, voffA);
            PG8_WAIT_V(8); PG8_WAIT_L(0); PG8_BAR; PG8_MMA(0, 0, At, B0); PG8_MMA(0, 1, At, B1); PG8_BAR; PG8_SCHED;
            PG8_LDA(At, 0, 1); PG8_STAGE(PG8_SB(0, 0), b2, voffB); PG8_STAGE(PG8_SB(0, 1), b2 + hstepB, voffB); PG8_STAGE(PG8_SA(0, 0), a2, voffA);
            PG8_WAIT_V(8); PG8_WAIT_L(0); PG8_BAR; PG8_MMA(1, 0, At, B0); PG8_MMA(1, 1, At, B1); PG8_BAR; PG8_SCHED;
            PG8_LDB(B0, 1, 0); PG8_LDB(B1, 1, 1); PG8_SCHED; PG8_LDA(At, 1, 0); PG8_STAGE(PG8_SA(0, 1), a2 + hstepA, voffA);
            PG8_WAIT_V(8); PG8_WAIT_L(0); PG8_BAR; PG8_MMA(0, 0, At, B0); PG8_MMA(0, 1, At, B1); PG8_BAR; PG8_SCHED;
            PG8_LDA(At, 1, 1); PG8_STAGE(PG8_SB(1, 0), b3, voffB); PG8_STAGE(PG8_SB(1, 1), b3 + hstepB, voffB); PG8_STAGE(PG8_SA(1, 0), a3, voffA);
            PG8_WAIT_V(8); PG8_WAIT_L(0); PG8_BAR; PG8_MMA(1, 0, At, B0); PG8_MMA(1, 1, At, B1); PG8_BAR; PG8_SCHED;
            } else {
            PG8_LDB(B0, 0, 0); PG8_SCHED; PG8_LDA(At, 0, 0); PG8_STAGE(PG8_SA(1, 1), a1 + hstepA, voffA);
            PG8_WAIT_L(8); PG8_BAR; PG8_WAIT_L(0); PG8_MMA(0, 0, At, B0); PG8_BAR; PG8_SCHED;
            PG8_LDB(B1, 0, 1); PG8_STAGE(PG8_SB(0, 0), b2, voffB);
            PG8_BAR; PG8_WAIT_L(0); PG8_MMA(0, 1, At, B1); PG8_BAR;
            PG8_LDA(At, 0, 1); PG8_STAGE(PG8_SA(0, 0), a2, voffA);
            PG8_BAR; PG8_WAIT_L(0); PG8_MMA(1, 0, At, B0); PG8_BAR; PG8_SCHED;
            PG8_STAGE(PG8_SB(0, 1), b2 + hstepB, voffB);
            PG8_WAIT_V(6); PG8_BAR; PG8_MMA(1, 1, At, B1); PG8_BAR;
            PG8_LDB(B0, 1, 0); PG8_SCHED; PG8_LDA(At, 1, 0); PG8_STAGE(PG8_SA(0, 1), a2 + hstepA, voffA);
            PG8_WAIT_L(8); PG8_BAR; PG8_WAIT_L(0); PG8_MMA(0, 0, At, B0); PG8_BAR; PG8_SCHED;
            PG8_LDB(B1, 1, 1); PG8_STAGE(PG8_SB(1, 0), b3, voffB);
            PG8_BAR; PG8_WAIT_L(0); PG8_MMA(0, 1, At, B1); PG8_BAR;
            PG8_LDA(At, 1, 1); PG8_STAGE(PG8_SA(1, 0), a3, voffA);
            PG8_BAR; PG8_WAIT_L(0); PG8_MMA(1, 0, At, B0); PG8_BAR; PG8_SCHED;
            PG8_STAGE(PG8_SB(1, 1), b3 + hstepB, voffB);
            PG8_WAIT_V(6); PG8_BAR; PG8_MMA(1, 1, At, B1); PG8_BAR;
            }
        }
        if constexpr (ALIGN_EPI) { if (wr == 0) PG8_BAR; }
        if constexpr (!Epi::AFTER_DRAIN) { E(acc, cur, wr, wc, fr, fq); }
        if (!has_next) break;
#pragma unroll
        for (int a = 0; a < 2; ++a)
#pragma unroll
            for (int b = 0; b < 2; ++b)
#pragma unroll
                for (int m = 0; m < 4; ++m)
#pragma unroll
                    for (int n = 0; n < 2; ++n) acc[a][b][m][n] = (f32x4){0.f, 0.f, 0.f, 0.f};
        cur = nxt; cA = nA; cB = nB; ++ui;
        if constexpr (ALIGN_EPI) { if (wr == 1) PG8_BAR; }
    }
    PG8_WAIT_V(0);
    if constexpr (!ALIGN_EPI) { if (wr == 0) PG8_BAR; }
    PG8_BAR;
    if constexpr (Epi::AFTER_DRAIN) { E.fused(acc, cur, wr, wc, fr, fq, lds, wid, lane); }
#undef PG8_SA
#undef PG8_SB
#undef PG8_STAGE
#undef PG8_LDA
#undef PG8_LDB
#undef PG8_MMA
#undef PG8_WAIT_V
#undef PG8_WAIT_L
#undef PG8_BAR
#undef PG8_SCHED
}
}

__device__ __forceinline__ void phase_headnorm(const Params& p, LAS unsigned char* lds) {
    const int tid = opaque_tid(), lane = tid & 63, wave = tid >> 6;
    LAS int* chunk = (LAS int*)(lds + 131072 - 64);
    bf16_t* Q = (bf16_t*)(p.ws + WS_Q); bf16_t* KVB = (bf16_t*)(p.ws + WS_KVB);
    float qg[16], kg[8];
#pragma unroll
    for (int i = 0; i < 16; ++i) qg[i] = p.q_gain[(lane & 3) * 16 + i] * (0.125f * 1.4426950408889634f);
    const int kr = lane >> 5;
#pragma unroll
    for (int i = 0; i < 8; ++i) kg[i] = p.k_gain[(1 + kr) * 64 + (lane & 7) * 8 + i];
    for (;;) {
      if (tid == 0) *chunk = (int)atomicAdd((unsigned*)(p.ws + WS_CTL) + CW_HN, 1u);
      __syncthreads();
      const int c0 = *chunk;
      __syncthreads();
      if (c0 >= T / 128) break;
      for (int r = c0 * 128 + wave * 16; r < c0 * 128 + wave * 16 + 16; ++r) {
        {
            u32x4* ptr = (u32x4*)(Q + (size_t)r * D + lane * 16); u32x4 w0 = ptr[0], w1 = ptr[1];
            float v[16]; const unsigned ww[8] = {w0.x, w0.y, w0.z, w0.w, w1.x, w1.y, w1.z, w1.w}; float s = 0.f;
#pragma unroll
            for (int i = 0; i < 8; ++i) { v[2 * i] = bflo(ww[i]); v[2 * i + 1] = bfhi(ww[i]); s += v[2 * i] * v[2 * i] + v[2 * i + 1] * v[2 * i + 1]; }
            s += __shfl_xor(s, 1); s += __shfl_xor(s, 2);
            const float rstd = 1.f / sqrtf(s * (1.f / 64.f) + EPS);
            unsigned o[8];
#pragma unroll
            for (int i = 0; i < 8; ++i) o[i] = cvt_pk_bf16(v[2 * i] * rstd * qg[2 * i], v[2 * i + 1] * rstd * qg[2 * i + 1]);
            ptr[0] = (u32x4){o[0], o[1], o[2], o[3]}; ptr[1] = (u32x4){o[4], o[5], o[6], o[7]};
        }
        {
            const u32x4* ptr = (const u32x4*)(KVB + (size_t)r * NKV + (kr ? 1024 : 512) + (lane & 31) * 8); const u32x4 w0 = ptr[0];
            float v[8]; const unsigned ww[4] = {w0.x, w0.y, w0.z, w0.w}; float s = 0.f;
#pragma unroll
            for (int i = 0; i < 4; ++i) { v[2 * i] = bflo(ww[i]); v[2 * i + 1] = bfhi(ww[i]); s += v[2 * i] * v[2 * i] + v[2 * i + 1] * v[2 * i + 1]; }
            s += __shfl_xor(s, 1); s += __shfl_xor(s, 2); s += __shfl_xor(s, 4);
            const float rstd = 1.f / sqrtf(s * (1.f / 64.f) + EPS);
            unsigned o[4];
#pragma unroll
            for (int i = 0; i < 4; ++i) o[i] = cvt_pk_bf16(v[2 * i] * rstd * kg[2 * i], v[2 * i + 1] * rstd * kg[2 * i + 1]);
            const int b = r >> 13, t = r & (S - 1), hg = (lane & 31) >> 3, c = lane & 7;
            {
                bf16_t* dst = (bf16_t*)(p.ws + (kr ? WS_KWB : WS_KSB)) + ((size_t)((b * 4 + hg) * 128 + (t >> 6)) * 8 + c) * 512 + (t & 63) * 8;
                *(u32x4*)dst = (u32x4){o[0], o[1], o[2], o[3]};
            }
        }
      }
    }
}

__device__ __forceinline__ void phase_cmp2(const Params& p, LAS unsigned char* lds) {
    const int tid = opaque_tid(), lane = tid & 63, wave = tid >> 6;
    const int gw = blockIdx.x * NWAVE + wave, NGW = gridDim.x * NWAVE;
    const bf16_t* CMPH = (const bf16_t*)(p.ws + WS_CMPH);
    LAS float* w2l = (LAS float*)lds;
    for (int kv = 0; kv < 2; ++kv) {
        const float* w2 = kv ? p.cmp_v_w2 : p.cmp_k_w2;
        for (int i = tid; i < 256 * 64 / 4; i += NTHR) ((LAS f32x4*)w2l)[i] = ((const f32x4*)w2)[i];
        __syncthreads();
        for (int it = gw * 2; it < 4 * 2048; it += NGW * 2) {
            float hv[2][4], acc[2] = {0.f, 0.f};
#pragma unroll
            for (int rr = 0; rr < 2; ++rr) { const u32x2 w = *(const u32x2*)(CMPH + (size_t)(kv * 8192 + it + rr) * 256 + 4 * lane); hv[rr][0] = bflo(w.x); hv[rr][1] = bfhi(w.x); hv[rr][2] = bflo(w.y); hv[rr][3] = bfhi(w.y); }
#pragma unroll 4
            for (int kk = 0; kk < 64; ++kk)
#pragma unroll
                for (int c = 0; c < 4; ++c) { const float wv = w2l[(4 * kk + c) * 64 + lane];
                    acc[0] += readlane_f(hv[0][c], kk) * wv; acc[1] += readlane_f(hv[1][c], kk) * wv; }
#pragma unroll
            for (int rr = 0; rr < 2; ++rr) {
                const int row = it + rr, g = (row >> 11) & 3, r2 = row & 2047, b = r2 >> 9, n = r2 & 511; float a = n == NC - 1 ? 0.f : acc[rr];
                if (kv == 0) { const float ss = wave_sum(a * a); a = a * (1.f / sqrtf(ss * (1.f / 64.f) + EPS)) * p.k_gain[lane]; }
                const size_t blk0 = (size_t)((b * 4 + g) * 8 + (n >> 6)) * 4096;
                bf16_t* o = kv ? (bf16_t*)(p.ws + WS_VC) + blk0 + ((n & 63) >> 3) * 512 + lane * 8 + (n & 7)
                               : (bf16_t*)(p.ws + WS_KC) + blk0 + (lane >> 3) * 512 + (n & 63) * 8 + (lane & 7);
                *o = (bf16_t)(cvt_pk_bf16(a, 0.f) & 0xffffu);
            }
        }
        __syncthreads();
    }
}

__device__ __forceinline__ void phase_vtrans(const Params& p, LAS unsigned char* lds) {
    const int tid = opaque_tid(), lane = tid & 63, wave = tid >> 6;
    const int gw = blockIdx.x * NWAVE + wave, NGW = gridDim.x * NWAVE;
    LAS unsigned short* tile = (LAS unsigned short*)(lds + wave * 8448);
    const bf16_t* KVB = (const bf16_t*)(p.ws + WS_KVB);
    LAS int* chunk = (LAS int*)(lds + 131072 - 64);
    for (;;) {
        if (tid == 0) *chunk = (int)atomicAdd((unsigned*)(p.ws + WS_CTL) + CW_VT, 1u);
        __syncthreads();
        const int c0 = *chunk;
        __syncthreads();
        if (c0 >= 2 * 16 * 128 / NWAVE) break;
        const int u = c0 * NWAVE + wave;
        const int which = u >> 11, bg = (u >> 7) & 15, tt = u & 127, b = bg >> 2, g = bg & 3, t0 = tt * 64;
        const u32x4* src = (const u32x4*)(KVB + (size_t)(b * S + t0 + lane) * NKV + (which ? 1280 : 768) + g * 64);
#pragma unroll
        for (int i = 0; i < 8; ++i) { const u32x4 v = src[i]; LAS unsigned* tp = (LAS unsigned*)(tile + lane * 66 + 8 * i); tp[0] = v.x; tp[1] = v.y; tp[2] = v.z; tp[3] = v.w; }
        asm volatile("s_waitcnt lgkmcnt(0)" ::: "memory");
        {
            bf16_t* dst = (bf16_t*)(p.ws + (which ? WS_VWB : WS_VSB)) + (size_t)(bg * 128 + tt) * 4096 + lane * 8;
#pragma unroll
            for (int i = 0; i < 8; ++i) { unsigned w[4];
#pragma unroll
                for (int q = 0; q < 4; ++q) { const unsigned lo = tile[(8 * i + 2 * q) * 66 + lane], hi = tile[(8 * i + 2 * q + 1) * 66 + lane]; w[q] = lo | (hi << 16); }
                *(u32x4*)(dst + i * 512) = (u32x4){w[0], w[1], w[2], w[3]}; }
        }
        asm volatile("s_waitcnt lgkmcnt(0)" ::: "memory");
    }
}

typedef short s16x4 __attribute__((ext_vector_type(4)));
__device__ __forceinline__ f32x4 mfma4(s16x4 a, s16x4 b, f32x4 c) { return __builtin_amdgcn_mfma_f32_4x4x4bf16_1k(a, b, c, 0, 0, 0); }
__device__ __forceinline__ s16x4 mk4(unsigned lo, unsigned hi) { const u32x2 t = {lo, hi}; return __builtin_bit_cast(s16x4, t); }
__device__ __forceinline__ f32x4 qk64(const bf16_t* krow, const s16x4 (&qf)[16]) {
    const u32x4* kp = (const u32x4*)krow; u32x4 kr[8];
#pragma unroll
    for (int i = 0; i < 8; ++i) kr[i] = kp[i];
    f32x4 s = {0.f, 0.f, 0.f, 0.f};
#pragma unroll
    for (int c = 0; c < 8; ++c) { s = mfma4(mk4(kr[c].x, kr[c].y), qf[2 * c], s); s = mfma4(mk4(kr[c].z, kr[c].w), qf[2 * c + 1], s); }
    return s;
}
__device__ __forceinline__ void pv64(f32x4& o, const f32x4 e, const bf16_t* vtrow, LAS u32x2* stage, int lane) {
    const u32x4* vp = (const u32x4*)vtrow; u32x4 vr[8];
#pragma unroll
    for (int i = 0; i < 8; ++i) vr[i] = vp[i];
    u32x2 pk; pk.x = cvt_pk_bf16(e.x, e.y); pk.y = cvt_pk_bf16(e.z, e.w);
    stage[lane] = pk;
#pragma unroll
    for (int st = 0; st < 16; ++st) { const u32x2 a = stage[4 * st + (lane & 3)]; const u32x4 v = vr[st >> 1];
        o = mfma4(mk4(a.x, a.y), (st & 1) ? mk4(v.z, v.w) : mk4(v.x, v.y), o); }
}
__device__ __forceinline__ float quadx_sum(float v) { v += __shfl_xor(v, 4); v += __shfl_xor(v, 8); v += __shfl_xor(v, 16); v += __shfl_xor(v, 32); return v; }

constexpr int HBN = 800;
constexpr int ATT_HBD = 0, ATT_MH = 51200, ATT_PSLC = 53248, ATT_STAGE = 118784;
__device__ __forceinline__ void attn_tables(const Params& p, LAS unsigned char* lds) {
    const int tid = opaque_tid();
    LAS float* hbd = (LAS float*)(lds + ATT_HBD); LAS float* mh = (LAS float*)(lds + ATT_MH);
    for (int i = tid; i < 16 * HBN; i += NTHR) { const int hd = i / HBN, d = i - hd * HBN; const float v = p.rel_bias[rel_bucket(d) * NH + hd] * 1.4426950408889634f; hbd[i] = v; if (blockIdx.x == 0) ((float*)(p.ws + WS_HBG))[i] = v; }
    if (tid < 16) { float qg = 0.f, kg = 0.f, bm = -3.0e38f;
        for (int i = 0; i < 64; ++i) qg = fmaxf(qg, fabsf(p.q_gain[i]));
        for (int i = 0; i < 192; ++i) kg = fmaxf(kg, fabsf(p.k_gain[i]));
        for (int i = 0; i < 32; ++i) bm = fmaxf(bm, p.rel_bias[i * NH + tid]);
        const float mv = (qg * kg * 8.f * 1.02f + bm) * 1.4426950408889634f; mh[tid] = mv; if (blockIdx.x == 0) ((float*)(p.ws + WS_MHG))[tid] = mv; }
    __syncthreads();
}
typedef float f32x16 __attribute__((ext_vector_type(16)));
__device__ __forceinline__ f32x16 mfma32(bf16x8 a, bf16x8 b, f32x16 c) { return __builtin_amdgcn_mfma_f32_32x32x16_bf16(a, b, c, 0, 0, 0); }
struct DFrag { bf16x8 ka[4]; bf16x8 va[2][2]; };
__device__ __forceinline__ void dense_load_k(bf16x8 (&ka)[4], const bf16_t* KB, int kt, int l31, int h) {
    const int blk = kt >> 6, hh = (kt >> 5) & 1;
    const bf16_t* kb = KB + (size_t)blk * 4096 + (32 * hh + l31) * 8;
#pragma unroll
    for (int ks = 0; ks < 4; ++ks) ka[ks] = *(const bf16x8*)(kb + (2 * ks + h) * 512);
}
__device__ __forceinline__ void dense_load_v(bf16x8 (&va)[2][2], const bf16_t* VB, int kt, int l31, int h) {
    const int blk = kt >> 6, hh = (kt >> 5) & 1;
    const bf16_t* vb = VB + (size_t)blk * 4096 + l31 * 8 + 4 * h;
#pragma unroll
    for (int dt = 0; dt < 2; ++dt)
#pragma unroll
        for (int st = 0; st < 2; ++st) { const bf16_t* q0 = vb + (4 * hh + 2 * st) * 512 + dt * 256; const u32x2 lo = *(const u32x2*)q0, hi = *(const u32x2*)(q0 + 512);
            const u32x4 w = {lo.x, lo.y, hi.x, hi.y}; va[dt][st] = __builtin_bit_cast(bf16x8, w); }
}
__device__ __forceinline__ f32x16 dense_scores(const DFrag& f, const bf16x8 (&q)[4]) {
    f32x16 sacc;
#pragma unroll
    for (int i = 0; i < 16; ++i) sacc[i] = 0.f;
#pragma unroll
    for (int ks = 0; ks < 4; ++ks) sacc = mfma32(f.ka[ks], q[ks], sacc);
    return sacc;
}
__device__ __forceinline__ void dense_pv(f32x16 (&O)[2], const DFrag& f, const float (&ev)[16]) {
    bf16x8 pb[2];
#pragma unroll
    for (int st = 0; st < 2; ++st) { const u32x4 w = {cvt_pk_bf16(ev[8 * st], ev[8 * st + 1]), cvt_pk_bf16(ev[8 * st + 2], ev[8 * st + 3]), cvt_pk_bf16(ev[8 * st + 4], ev[8 * st + 5]), cvt_pk_bf16(ev[8 * st + 6], ev[8 * st + 7])};
        pb[st] = __builtin_bit_cast(bf16x8, w); }
#pragma unroll
    for (int dt = 0; dt < 2; ++dt)
#pragma unroll
        for (int st = 0; st < 2; ++st) O[dt] = mfma32(f.va[dt][st], pb[st], O[dt]);
}
__device__ __forceinline__ void phase_dense(const Params& p, LAS unsigned char* lds, bf16_t* OW) {
    const int tid = opaque_tid(), lane0 = tid & 63, wave = tid >> 6;
    const LAS float* hbd = (const LAS float*)(lds + ATT_HBD); const LAS float* mh = (const LAS float*)(lds + ATT_MH);
    LAS float* pslc = (LAS float*)(lds + ATT_PSLC) + wave * 2048;
    const bf16_t* Q = (const bf16_t*)(p.ws + WS_Q); const float* GATE = (const float*)(p.ws + WS_GATE);
    short* SEL = (short*)(p.ws + WS_SEL);
    const int Gn = gridDim.x, vcu = (Gn % 8 == 0) ? (blockIdx.x % 8) * (Gn / 8) + blockIdx.x / 8 : blockIdx.x;
    for (int u = vcu * NWAVE + wave; u < T * G / 16; u += Gn * NWAVE) {
        int lane = lane0; asm volatile("" : "+v"(lane));
        const int l31 = lane & 31, h = lane >> 5;
        const int bg = u >> 9, t0 = (((u & 511) + 128 * (u >> 11)) & 511) * 16, b = bg >> 2, g = bg & 3, head = 4 * g + (lane & 3);
        const LAS float* hb = hbd + head * HBN; const float mhv = mh[head];
        int tok[2]; bf16x8 qf[2][4];
#pragma unroll
        for (int r = 0; r < 2; ++r) { tok[r] = t0 + 8 * r + (l31 >> 2); const bf16_t* qp = Q + (size_t)(b * S + tok[r]) * D + head * 64 + 8 * h;
#pragma unroll
            for (int ks = 0; ks < 4; ++ks) qf[r][ks] = *(const bf16x8*)(qp + 16 * ks); }
        f32x16 O[2][2];
#pragma unroll
        for (int r = 0; r < 2; ++r)
#pragma unroll
            for (int dt = 0; dt < 2; ++dt)
#pragma unroll
                for (int q = 0; q < 16; ++q) O[r][dt][q] = 0.f;
        DFrag cur; bf16x8 nxtk[4];
        {
            const bf16_t* KB = (const bf16_t*)(p.ws + WS_KWB) + (size_t)bg * 128 * 4096; const bf16_t* VB = (const bf16_t*)(p.ws + WS_VWB) + (size_t)bg * 128 * 4096;
            float lw[2] = {0.f, 0.f};
            const int lo = t0 - (WIN - 1) > 0 ? t0 - (WIN - 1) : 0, kt_last = t0 & ~31;
            dense_load_k(cur.ka, KB, lo & ~31, l31, h);
            for (int kt = lo & ~31; kt <= kt_last; kt += 32) {
                dense_load_v(cur.va, VB, kt, l31, h);
                dense_load_k(nxtk, KB, kt + 32 <= kt_last ? kt + 32 : kt_last, l31, h);
                __builtin_amdgcn_sched_barrier(0);
#pragma unroll
                for (int r = 0; r < 2; ++r) {
                    const f32x16 sacc = dense_scores(cur, qf[r]);
                    const int dbase = tok[r] - kt - 4 * h; float ev[16];
                    if (kt + 31 <= t0 + 8 * r && kt >= t0 + 8 * r + 7 - (WIN - 1)) {
                        const LAS float* hbp = hb + dbase;
#pragma unroll
                        for (int q = 0; q < 16; ++q) { const float e = __builtin_amdgcn_exp2f(sacc[q] + hbp[-((q & 3) + 8 * (q >> 2))] - mhv); ev[q] = e; lw[r] += e; }
                    } else {
#pragma unroll
                    for (int q = 0; q < 16; ++q) { const int dist = dbase - ((q & 3) + 8 * (q >> 2)); const bool ok = (unsigned)dist < (unsigned)WIN;
                        const float e0 = __builtin_amdgcn_exp2f(sacc[q] + hb[ok ? dist : 0] - mhv); const float e = ok ? e0 : 0.f; ev[q] = e; lw[r] += e; }
                    }
                    dense_pv(O[r], cur, ev);
                }
#pragma unroll
                for (int ks = 0; ks < 4; ++ks) cur.ka[ks] = nxtk[ks];
            }
#pragma unroll
            for (int r = 0; r < 2; ++r) { const float l = lw[r] + __shfl_xor(lw[r], 32); int tk = tok[r]; asm volatile("" : "+v"(tk)); const float* gp = GATE + (size_t)(b * S + tk) * 48 + head * 3;
                const float sc = gp[2] / (l * gp[0]);
#pragma unroll
                for (int dt = 0; dt < 2; ++dt) O[r][dt] = O[r][dt] * sc; }
        }
        const int ncmax = t0 >> 4;
        {
            int l31c = l31, hc = h; asm volatile("" : "+v"(l31c), "+v"(hc));
            const bf16_t* KB = (const bf16_t*)(p.ws + WS_KC) + (size_t)bg * 8 * 4096; const bf16_t* VB = (const bf16_t*)(p.ws + WS_VC) + (size_t)bg * 8 * 4096;
            float lc[2] = {0.f, 0.f};
            const int kt_last = ncmax > 0 ? ((ncmax - 1) & ~31) : -32;
            if (ncmax > 0) {
                dense_load_k(cur.ka, KB, 0, l31c, hc);
                for (int kt = 0; kt <= kt_last; kt += 32) {
                    dense_load_k(nxtk, KB, kt + 32 <= kt_last ? kt + 32 : kt_last, l31c, hc);
                    __builtin_amdgcn_sched_barrier(0);
#pragma unroll
                    for (int r = 0; r < 2; ++r) {
                        const f32x16 sacc = dense_scores(cur, qf[r]);
                        if (t0 - 31 - 16 * (kt + 31) >= HBN - 1) {
                            const float bfar = hb[HBN - 1] - mhv;
#pragma unroll
                            for (int q = 0; q < 16; ++q) lc[r] += __builtin_amdgcn_exp2f(sacc[q] + bfar);
                        } else {
                        const int dbase = tok[r] - 31 - 16 * (kt + 4 * hc);
#pragma unroll
                        for (int q = 0; q < 16; ++q) { const int dist = dbase - 16 * ((q & 3) + 8 * (q >> 2)); const int di = dist < 0 ? 0 : (dist > HBN - 1 ? HBN - 1 : dist);
                            const float e0 = __builtin_amdgcn_exp2f(sacc[q] + hb[di] - mhv); lc[r] += dist >= 0 ? e0 : 0.f; }
                        }
                    }
#pragma unroll
                    for (int ks = 0; ks < 4; ++ks) cur.ka[ks] = nxtk[ks];
                }
            }
            float linv[2];
#pragma unroll
            for (int r = 0; r < 2; ++r) { const float l = lc[r] + __shfl_xor(lc[r], 32); linv[r] = l > 0.f ? 1.f / l : 0.f; }
            { const f32x4 z = {0.f, 0.f, 0.f, 0.f};
#pragma unroll
              for (int i = 0; i < 8; ++i) *(LAS f32x4*)(pslc + (i * 64 + lane) * 4) = z; }
            if (ncmax > 0) {
                float carry[2] = {0.f, 0.f};
                dense_load_k(cur.ka, KB, 0, l31c, hc);
                for (int kt = 0; kt <= kt_last; kt += 32) {
                    dense_load_v(cur.va, VB, kt, l31c, hc);
                    dense_load_k(nxtk, KB, kt + 32 <= kt_last ? kt + 32 : kt_last, l31c, hc);
                    __builtin_amdgcn_sched_barrier(0);
#pragma unroll
                    for (int r = 0; r < 2; ++r) {
                        const f32x16 sacc = dense_scores(cur, qf[r]);
                        float pv[16];
                        const int dbase = tok[r] - 31 - 16 * (kt + 4 * hc);
#pragma unroll
                        for (int q = 0; q < 16; ++q) { const int dist = dbase - 16 * ((q & 3) + 8 * (q >> 2)); const int di = dist < 0 ? 0 : (dist > HBN - 1 ? HBN - 1 : dist);
                            const float e0 = __builtin_amdgcn_exp2f(sacc[q] + hb[di] - mhv); pv[q] = dist >= 0 ? e0 * linv[r] : 0.f; }
                        dense_pv(O[r], cur, pv);
#pragma unroll
                        for (int q = 0; q < 16; ++q) { pv[q] += __shfl_xor(pv[q], 1); pv[q] += __shfl_xor(pv[q], 2); }
                        float y[4];
#pragma unroll
                        for (int gq = 0; gq < 4; ++gq) y[gq] = __shfl_xor(pv[4 * gq + 3], 32);
#pragma unroll
                        for (int gq = 0; gq < 4; ++gq) { const float prevv = h ? y[gq] : (gq > 0 ? y[gq > 0 ? gq - 1 : 0] : carry[r]);
                            const float val = 2.f * ((pv[4 * gq] + pv[4 * gq + 1]) + pv[4 * gq + 2]) + pv[4 * gq + 3] + prevv;
                            if ((lane & 3) == 0) pslc[(8 * r + (l31c >> 2)) * 128 + (kt >> 2) + 2 * gq + hc] = val; }
                        carry[r] = y[3];
                    }
#pragma unroll
                    for (int ks = 0; ks < 4; ++ks) cur.ka[ks] = nxtk[ks];
                }
            }
        }
#pragma unroll
        for (int r = 0; r < 2; ++r) { int tk = tok[r]; asm volatile("" : "+v"(tk)); bf16_t* op = OW + (size_t)(b * S + tk) * D + head * 64 + 4 * h; const float gc = GATE[(size_t)(b * S + tk) * 48 + head * 3];
#pragma unroll
            for (int dt = 0; dt < 2; ++dt)
#pragma unroll
                for (int gq = 0; gq < 4; ++gq) { u32x2 w; w.x = cvt_pk_bf16(O[r][dt][4 * gq] * gc, O[r][dt][4 * gq + 1] * gc); w.y = cvt_pk_bf16(O[r][dt][4 * gq + 2] * gc, O[r][dt][4 * gq + 3] * gc);
                    *(u32x2*)(op + dt * 32 + 8 * gq) = w; } }
#pragma unroll 1
        for (int tl = 0; tl < 16; ++tl) {
            int ln = lane; asm volatile("" : "+v"(ln));
            const int t = t0 + tl, cur_b = t >> 6, j0 = ln, j1 = ln + 64;
            const float c0 = pslc[tl * 128 + j0], c1 = pslc[tl * 128 + j1];
            const bool f0 = (j0 == 0) || (j0 == cur_b) || (j0 == cur_b - 1), f1 = (j1 == cur_b) || (j1 == cur_b - 1);
            const bool v0 = j0 * 64 <= t, v1 = j1 * 64 <= t;
            const unsigned u0 = (v0 && !f0) ? __float_as_uint(c0) : 0u, u1 = (v1 && !f1) ? __float_as_uint(c1) : 0u;
            unsigned th = 1u;
            if (cur_b + 1 > NSEL) {
                th = 0u;
#pragma unroll 1
                for (int bit = 30; bit >= 0; --bit) {
                    const unsigned trial = th | (1u << bit);
                    const int cnt = __popcll(__ballot(u0 >= trial)) + __popcll(__ballot(u1 >= trial));
                    if (cnt >= NSEL - 3) { th = trial; if (cnt == NSEL - 3) break; }
                }
            }
            const bool s0 = f0 || (u0 >= th && u0 != 0u), s1 = f1 || (u1 >= th && u1 != 0u);
            const unsigned long long m0 = __ballot(s0), m1 = __ballot(s1), lt = (1ull << ln) - 1ull;
            const int p0 = __popcll(m0 & lt), p1 = __popcll(m0) + __popcll(m1 & lt);
            short* so = SEL + ((size_t)(b * S + t) * 4 + g) * NSEL;
            if (s0 && p0 < NSEL) so[p0] = (short)j0;
            if (s1 && p1 < NSEL) so[p1] = (short)j1;
        }
    }
}

constexpr int ST_ACC = 0, ST_LACC = 133120, ST_MASK = 135168, ST_LIST = 136192, ST_CTR = 138240;
__device__ __forceinline__ void lds_add_f64(unsigned addr, double v) { asm volatile("ds_add_f64 %0, %1" :: "v"(addr), "v"(v) : "memory"); }
__device__ __forceinline__ void phase_sel_tile(const Params& p, LAS unsigned char* lds, bf16_t* AO, const bf16_t* OW) {
    const int tid = opaque_tid(), lane = tid & 63, wave = tid >> 6, l31 = lane & 31, h = lane >> 5;
    LAS double* acc = (LAS double*)(lds + ST_ACC); LAS double* lacc = (LAS double*)(lds + ST_LACC);
    LAS unsigned* mask = (LAS unsigned*)(lds + ST_MASK); LAS int* list = (LAS int*)(lds + ST_LIST) + wave * 64; LAS int* ctr = (LAS int*)(lds + ST_CTR);
    const bf16_t* Q = (const bf16_t*)(p.ws + WS_Q); const float* GATE = (const float*)(p.ws + WS_GATE); const short* SEL = (const short*)(p.ws + WS_SEL);
    const int Gn = gridDim.x;
    for (int kk = 0, u = blockIdx.x; u < 16 * 128; u += Gn, ++kk) {
        const int bg = u >> 7, ti = u & 127, tt = (kk & 1) ? 127 - ti : ti, b = bg >> 2, g = bg & 3, t0 = tt * 64, cur = tt, nv = cur + 1 < NSEL ? cur + 1 : NSEL;
        for (int i = tid; i < ST_LIST / 16; i += NTHR) ((LAS u32x4*)lds)[i] = (u32x4){0u, 0u, 0u, 0u};
        if (tid == 0) *ctr = 0;
        __syncthreads();
        { const int tl = tid >> 3; const short* sp = SEL + ((size_t)(b * S + t0 + tl) * 4 + g) * NSEL;
#pragma unroll
          for (int e = (tid & 7) * 2; e < (tid & 7) * 2 + 2; ++e) if (e < nv) { const int blk = sp[e]; __hip_atomic_fetch_or(mask + blk * 2 + (tl >> 5), 1u << (tl & 31), __ATOMIC_RELAXED, __HIP_MEMORY_SCOPE_WORKGROUP); } }
        __syncthreads();
        const int nf = cur >= 2 ? 3 : cur + 1, nitems = 2 * nf + (cur >= 3 ? cur - 2 : 0);
        const bf16_t* KB = (const bf16_t*)(p.ws + WS_KSB) + (size_t)bg * 128 * 4096; const bf16_t* VB = (const bf16_t*)(p.ws + WS_VSB) + (size_t)bg * 128 * 4096;
        const int hl = lane & 3, head = 4 * g + hl;
        const float* hbg = (const float*)(p.ws + WS_HBG) + head * HBN; const float mhv = ((const float*)(p.ws + WS_MHG))[head], bfar = hbg[HBN - 1] - mhv;
        for (;;) {
            int it = 0; if (lane == 0) it = __hip_atomic_fetch_add(ctr, 1, __ATOMIC_RELAXED, __HIP_MEMORY_SCOPE_WORKGROUP);
            it = __builtin_amdgcn_readfirstlane(it);
            if (it >= nitems) break;
            int j, c_lo, c_hi;
            if (it < 2 * nf) { const int f = it >> 1; j = f == 0 ? cur : (f == 1 ? cur - 1 : 0); c_lo = (it & 1) * 4; c_hi = c_lo + 4; }
            else { j = it - 2 * nf + 1; c_lo = 0; c_hi = 8; }
            const unsigned mlo = (unsigned)__builtin_amdgcn_readfirstlane((int)mask[2 * j]), mhi = (unsigned)__builtin_amdgcn_readfirstlane((int)mask[2 * j + 1]);
            const unsigned long long m = ((unsigned long long)mhi << 32) | mlo; const int n = __popcll(m), nch = (n + 7) >> 3;
            if (c_hi > nch) c_hi = nch;
            if (c_lo >= c_hi) continue;
            if ((m >> lane) & 1ull) list[__popcll(m & ((1ull << lane) - 1ull))] = lane;
            for (int c = c_lo; c < c_hi; ++c) {
                const int slot = c * 8 + (l31 >> 2); const bool valid = slot < n; const int tokl = list[valid ? slot : n - 1], tok = t0 + tokl;
                bf16x8 qf[4];
                { const bf16_t* qp = Q + (size_t)(b * S + tok) * D + head * 64 + 8 * h;
#pragma unroll
                  for (int ks = 0; ks < 4; ++ks) qf[ks] = *(const bf16x8*)(qp + 16 * ks); }
                f32x16 O[2]; float ls = 0.f;
#pragma unroll
                for (int dt = 0; dt < 2; ++dt)
#pragma unroll
                    for (int q = 0; q < 16; ++q) O[dt][q] = 0.f;
#pragma unroll 1
                for (int half = 0; half < 2; ++half) {
                    const int kt = j * 64 + 32 * half; DFrag fr;
                    dense_load_k(fr.ka, KB, kt, l31, h); dense_load_v(fr.va, VB, kt, l31, h);
                    const f32x16 sacc = dense_scores(fr, qf); float ev[16];
                    if (t0 - kt - 31 >= HBN - 1) {
#pragma unroll
                        for (int q = 0; q < 16; ++q) { ev[q] = __builtin_amdgcn_exp2f(sacc[q] + bfar); ls += ev[q]; }
                    } else { const int dbase = tok - kt - 4 * h;
#pragma unroll
                        for (int q = 0; q < 16; ++q) { const int dist = dbase - ((q & 3) + 8 * (q >> 2)); const int di = dist < 0 ? 0 : (dist > HBN - 1 ? HBN - 1 : dist);
                            const float e0 = __builtin_amdgcn_exp2f(sacc[q] + hbg[di] - mhv); ev[q] = dist >= 0 ? e0 : 0.f; ls += ev[q]; } }
                    dense_pv(O, fr, ev);
                }
                const float lt = ls + __shfl_xor(ls, 32);
                if (valid) {
                    const unsigned a0 = (unsigned)(size_t)(acc + (tokl * 4 + hl) * 65 + 4 * h);
#pragma unroll
                    for (int dt = 0; dt < 2; ++dt)
#pragma unroll
                        for (int q = 0; q < 16; ++q) lds_add_f64(a0 + (dt * 32 + (q & 3) + 8 * (q >> 2)) * 8, (double)O[dt][q]);
                    if (h == 0) lds_add_f64((unsigned)(size_t)(lacc + tokl * 4 + hl), (double)lt);
                }
            }
        }
        __syncthreads();
        for (int r = wave * 32; r < wave * 32 + 32; ++r) {
            const int tokl = r >> 2, hd = r & 3; const size_t ur = (size_t)(b * S + t0 + tokl);
            const float o = (float)acc[r * 65 + lane] * (1.f / (float)lacc[r]) * GATE[ur * 48 + (4 * g + hd) * 3 + 1] + bf2f(OW[ur * D + (4 * g + hd) * 64 + lane]);
            AO[ur * D + (4 * g + hd) * 64 + lane] = (bf16_t)(cvt_pk_bf16(o, 0.f) & 0xffffu);
        }
        __syncthreads();
    }
}

__device__ __forceinline__ void moe_pstarts(const unsigned* ctl, int (&pst)[NE + 1]) {
    int a = 0;
#pragma unroll
    for (int e = 0; e < NE; ++e) { pst[e] = a; const int c = (int)ctl[CW_CNT + 64 * e]; a += (c + 511) / 512 * 512; }
    pst[NE] = a;
}
__device__ __forceinline__ void phase_moe_sort(const Params& p, LAS unsigned char* lds) {
    const int tid = opaque_tid(), lane = tid & 63, wave = tid >> 6;
    unsigned* ctl = (unsigned*)(p.ws + WS_CTL);
    const int* TOPE = (const int*)(p.ws + WS_TOPE); int* RPOS = (int*)(p.ws + WS_RPOS);
    const bf16_t* HB = (const bf16_t*)(p.ws + WS_HB); bf16_t* XS = (bf16_t*)(p.ws + WS_XS);
    LAS int* wcnt = (LAS int*)lds;
    LAS int* base = (LAS int*)(lds + 128);
    LAS int* posl = (LAS int*)(lds + 256);
    int pst[NE + 1]; moe_pstarts(ctl, pst);
    if (blockIdx.x == 0 && tid <= NE) ((int*)(ctl + 256))[tid] = pst[tid];
    for (int c0 = blockIdx.x * 256; c0 < 2 * T; c0 += gridDim.x * 256) {
        int e = 0, rank = 0;
        if (wave < 4) { e = TOPE[c0 + wave * 64 + lane];
#pragma unroll
            for (int q = 0; q < NE; ++q) { const unsigned long long m = __ballot(e == q); if (e == q) rank = __popcll(m & ((1ull << lane) - 1ull)); if (lane == 0) wcnt[wave * NE + q] = __popcll(m); } }
        __syncthreads();
        if (tid < NE) { const int n = wcnt[tid] + wcnt[NE + tid] + wcnt[2 * NE + tid] + wcnt[3 * NE + tid]; base[tid] = n ? (int)atomicAdd(ctl + CW_CUR + 64 * tid, (unsigned)n) : 0; }
        __syncthreads();
        if (wave < 4) { int off = 0;
            for (int w = 0; w < wave; ++w) off += wcnt[w * NE + e];
            const int pos = pst[e] + base[e] + off + rank; posl[wave * 64 + lane] = pos; RPOS[c0 + wave * 64 + lane] = pos; }
        __syncthreads();
        for (int j = wave * 32; j < wave * 32 + 32; j += 8) {
            u32x4 v0[8]; int ps[8];
#pragma unroll
            for (int q = 0; q < 8; ++q) { const int tk = (c0 + j + q) >> 1; ps[q] = posl[j + q]; v0[q] = *((const u32x4*)((const unsigned char*)HB + (size_t)tk * D) + lane); }
#pragma unroll
            for (int q = 0; q < 8; ++q) *((u32x4*)((unsigned char*)XS + (size_t)ps[q] * D) + lane) = v0[q];
        }
        __syncthreads();
    }
}
__device__ __forceinline__ void phase_combine(const Params& p) {
    const int tid = opaque_tid(), lane = tid & 63, wave = tid >> 6;
    const int gw = blockIdx.x * NWAVE + wave, NGW = gridDim.x * NWAVE;
    const float* TOPW = (const float*)(p.ws + WS_TOPW); const int* RPOS = (const int*)(p.ws + WS_RPOS);
    const bf16_t* Y = (const bf16_t*)(p.ws + WS_Y); const float* g2 = (const float*)(p.ws + WS_MODV) + (11 * 4) * D;
    for (int r = gw; r < T; r += NGW) {
        const int b = r >> 13; const int p0 = RPOS[2 * r], p1 = RPOS[2 * r + 1]; const float w0 = TOPW[2 * r], w1 = TOPW[2 * r + 1];
#pragma unroll
        for (int j = 0; j < 4; ++j) { const int c = 4 * lane + 256 * j;
            const u32x2 y0 = *(const u32x2*)(Y + (size_t)p0 * D + c), y1 = *(const u32x2*)(Y + (size_t)p1 * D + c);
            const f32x4 gv = *(const f32x4*)(g2 + b * D + c); f32x4 xv = *(const f32x4*)(p.out + (size_t)r * D + c);
            f32x4 f; f.x = w0 * bflo(y0.x) + w1 * bflo(y1.x); f.y = w0 * bfhi(y0.x) + w1 * bfhi(y1.x); f.z = w0 * bflo(y0.y) + w1 * bflo(y1.y); f.w = w0 * bfhi(y0.y) + w1 * bfhi(y1.y);
            *(f32x4*)(p.out + (size_t)r * D + c) = xv + gv * f; }
    }
}

#define XB_TMO      128
#define XB_XCNT(j)  (256  + 64 * (j))
#define XB_XSUB(j)  (1280 + 64 * (j))
#define XB_XGEN(j)  (2304 + 64 * (j))
#define XB_TOP      3328
#define XB_TOPGEN   3392
#define XCD_BAR_WORDS 3456
#define XB_SPIN_CAP (1u << 18)
__device__ __forceinline__ unsigned xb_ld(unsigned* p)              { return __hip_atomic_load(p, __ATOMIC_RELAXED, __HIP_MEMORY_SCOPE_AGENT); }
__device__ __forceinline__ unsigned xb_add(unsigned* p, unsigned v) { return __hip_atomic_fetch_add(p, v, __ATOMIC_RELAXED, __HIP_MEMORY_SCOPE_AGENT); }
__device__ __forceinline__ unsigned xb_xcc_id() { return (unsigned)__builtin_amdgcn_s_getreg((3 << 11) | 20) & 0xFu; }
#define XB_SPIN(cond, bar) do { unsigned _sp = 0; while (cond) { __builtin_amdgcn_s_sleep(1); \
    if ((++_sp & 255u) == 0u) { if (xb_ld(&(bar)[XB_TMO])) break; if (_sp > XB_SPIN_CAP) { atomicAdd(&(bar)[XB_TMO], 1u); break; } } } } while (0)
struct XcdBarrier { unsigned* bar; unsigned x; volatile LAS unsigned* st; };
__device__ __forceinline__ XcdBarrier xcd_barrier_post(unsigned* bar, volatile LAS unsigned* st) {
    XcdBarrier b; b.bar = bar; b.x = xb_xcc_id(); b.st = st;
    if (threadIdx.x == 0) (void)xb_add(&bar[XB_XCNT(b.x)], 1u);
    return b;
}
__device__ __forceinline__ void xcd_barrier_complete(unsigned* bar, unsigned x, unsigned& nloc, unsigned& nx) {
    const unsigned G_ = gridDim.x * gridDim.y * gridDim.z;
    unsigned sum, cnt, mine, sp = 0u;
    for (;;) {
        sum = 0u; cnt = 0u; mine = 0u;
#pragma unroll
        for (unsigned j = 0; j < 16; ++j) { const unsigned c = xb_ld(&bar[XB_XCNT(j)]); sum += c; cnt += (c > 0u) ? 1u : 0u; mine = (j == x) ? c : mine; }
        if (sum == G_) break;
        __builtin_amdgcn_s_sleep(1);
        if ((++sp & 255u) == 0u) { if (xb_ld(&bar[XB_TMO])) break; if (sp > XB_SPIN_CAP) { atomicAdd(&bar[XB_TMO], 1u); break; } }
    }
    nloc = mine > 0u ? mine : 1u; nx = cnt > 0u ? cnt : 1u;
}
__device__ __forceinline__ void xcd_barrier(const XcdBarrier& b) {
    asm volatile("s_waitcnt vmcnt(0)" ::: "memory");
    __syncthreads();
    if (threadIdx.x == 0) {
        unsigned* bar = b.bar;
        __builtin_amdgcn_s_waitcnt(0);
        unsigned nloc = b.st[0], nx = b.st[1];
        if (nloc == 0u) { xcd_barrier_complete(bar, b.x, nloc, nx); b.st[0] = nloc; b.st[1] = nx; }
        const unsigned old = xb_add(&bar[XB_XSUB(b.x)], 1u);
        const unsigned gen = old / nloc;
        if (old + 1u == (gen + 1u) * nloc) {
            __builtin_amdgcn_fence(__ATOMIC_RELEASE, "agent");
            asm volatile("s_waitcnt vmcnt(0)" ::: "memory");
            const unsigned og = xb_add(&bar[XB_TOP], 1u);
            const unsigned tg = og / nx;
            if (og + 1u == (tg + 1u) * nx) xb_add(&bar[XB_TOPGEN], 1u);
            else XB_SPIN(xb_ld(&bar[XB_TOPGEN]) == tg, bar);
            __builtin_amdgcn_fence(__ATOMIC_ACQUIRE, "agent");
            xb_add(&bar[XB_XGEN(b.x)], 1u);
            asm volatile("s_waitcnt vmcnt(0)" ::: "memory");
        } else {
            XB_SPIN(xb_ld(&bar[XB_XGEN(b.x)]) == gen, bar);
            __builtin_amdgcn_fence(__ATOMIC_ACQUIRE, "agent");
            asm volatile("s_waitcnt vmcnt(0)" ::: "memory");
        }
    }
    __syncthreads();
}

constexpr int LDS_SCRATCH = 131072, MISC_OFF = 143360, LDS_BYTES = 147456;
#define MODP(which) ((const float*)(p.ws + WS_MODV) + (size_t)(which) * 4 * D)

__global__ void __launch_bounds__(NTHR, 2) k_fused(Params p) {
    extern __shared__ __attribute__((aligned(16))) unsigned char lds_raw[];
    LAS unsigned char* lds = (LAS unsigned char*)lds_raw;
    for (int u = threadIdx.x; u < (LDS_BYTES - LDS_SCRATCH) / 4; u += NTHR) ((LAS unsigned*)(lds + LDS_SCRATCH))[u] = 0u;
    __syncthreads();
    const XcdBarrier bar = xcd_barrier_post((unsigned*)(p.ws + WS_CTL) + CW_BAR, (volatile LAS unsigned*)(lds + MISC_OFF) + 8);
#define GRID_BAR() xcd_barrier(bar)
    phase_weights(p, lds); __syncthreads(); phase_modvec(p, lds);
    GRID_BAR();
    phase_convert_fgu(p, lds); __syncthreads();
    phase_poolmix(p, lds, (bf16_t*)(p.ws + WS_HA));
    GRID_BAR();
    { pg8::Sched<1> Sc; Sc.init(T, D, gridDim.x, blockIdx.x, p.ws + WS_HA, p.ws + WO_POOL, D, 256);
      pg8::EpiEl<EpiPool> E{{p.x, (float*)(p.ws + WS_X1), MODP(2), p.pool_scale, 0}};
      pg8::gemm_phase(lds, 256, D, 256, 128, Sc, E); }
    GRID_BAR();
    { NormOut o0{p.norm_g + D, MODP(4), MODP(3), (bf16_t*)(p.ws + WS_HB)}; phase_norm<1, false, 2>(p, lds, (const float*)(p.ws + WS_X1), o0, o0); }
    GRID_BAR();
    { pg8::Sched<0> Sc; Sc.init(T, 2 * FF, gridDim.x, blockIdx.x, p.ws + WS_HB, p.ws + WO_FGU, D / 2, D / 2);
      pg8::EpiPairEl<EpiSwigluI8> E{{(bf16_t*)(p.ws + WS_HID0), FF, (const float*)(p.ws + WS_ASC), (const float*)(p.ws + WS_FGMAX)}};
      pg8::gemm_phase<pg8::EpiPairEl<EpiSwigluI8>, pg8::Sched<0>, true, true, 2>(lds, D / 2, D / 2, D / 2, 128, Sc, E); }
    GRID_BAR();
    { pg8::Sched<0> Sc; Sc.init(T, D, gridDim.x, blockIdx.x, p.ws + WS_HID0, p.ws + WO_FDN, FF, FF);
      pg8::EpiEl<EpiResid> E{{(const float*)(p.ws + WS_X1), (float*)(p.ws + WS_X2), MODP(5)}};
      pg8::gemm_phase(lds, FF, FF, FF, 128, Sc, E); }
    GRID_BAR();
    { NormOut o0{p.kv_norm_g, MODP(13), MODP(12), (bf16_t*)(p.ws + WS_HA)}; NormOut o1{p.norm_g + 2 * D, MODP(7), MODP(6), (bf16_t*)(p.ws + WS_HB)}; phase_norm<2, false>(p, lds, (const float*)(p.ws + WS_X2), o0, o1); }
    GRID_BAR();
    { pg8::Sched<0> Sc; Sc.init(T, NKV, gridDim.x, blockIdx.x, p.ws + WS_HA, p.ws + WO_KV, D, D);
      pg8::EpiEl<EpiBf16> E{{(bf16_t*)(p.ws + WS_KVB), NKV}};
      pg8::gemm_phase(lds, D, D, D, 128, Sc, E); }
    { pg8::Sched<0> Sc; Sc.init(T, D, gridDim.x, blockIdx.x, p.ws + WS_HB, p.ws + WO_Q, D, D);
      pg8::EpiEl<EpiQ> E{{(bf16_t*)(p.ws + WS_Q), (float*)(p.ws + WS_GATE), 0}};
      pg8::gemm_phase(lds, D, D, D, 128, Sc, E); }
    GRID_BAR();
    { pg8::Sched<2> Sc; Sc.init(2048, 2048, gridDim.x, blockIdx.x, p.ws + WS_KVB, p.ws + WO_CK, 16 * NKV, 2048);
      pg8::EpiEl<EpiCmp> E{{(bf16_t*)(p.ws + WS_CMPH), (const float*)(p.ws + WS_CMPB)}};
      pg8::gemm_phase(lds, 2048, 16 * NKV, 2048, (size_t)NKV * 2, Sc, E); }
    { pg8::Sched<0> Sc; Sc.init(T, 256, (int)gridDim.x - 64 > 0 ? (int)gridDim.x - 64 : 1, (int)gridDim.x > 64 ? (int)blockIdx.x - 64 : (int)blockIdx.x, p.ws + WS_HB, p.ws + WO_Q + (size_t)D * D * 2, D, D);
      pg8::EpiEl<EpiQ> E{{(bf16_t*)(p.ws + WS_Q), (float*)(p.ws + WS_GATE), D}};
      pg8::gemm_phase(lds, D, D, D, 128, Sc, E); }
    phase_headnorm(p, lds); phase_vtrans(p, lds);
    GRID_BAR();
    phase_cmp2(p, lds);
    GRID_BAR();
    attn_tables(p, lds);
    phase_dense(p, lds, (bf16_t*)(p.ws + WS_HB));
    GRID_BAR();
    phase_sel_tile(p, lds, (bf16_t*)(p.ws + WS_HA), (const bf16_t*)(p.ws + WS_HB));
    GRID_BAR();
    { pg8::Sched<0> Sc; Sc.init(T, D, gridDim.x, blockIdx.x, p.ws + WS_HA, p.ws + WO_O, D, D);
      pg8::EpiEl<EpiResid> E{{(const float*)(p.ws + WS_X2), p.out, MODP(8)}};
      pg8::gemm_phase(lds, D, D, D, 128, Sc, E); }
    GRID_BAR();
    { NormOut o0{p.norm_g + 3 * D, MODP(10), MODP(9), (bf16_t*)(p.ws + WS_HB)}; phase_norm<1, true, 1>(p, lds, p.out, o0, o0); }
    GRID_BAR();
    phase_moe_sort(p, lds);
    GRID_BAR();
    { const int* pst = (const int*)(p.ws + WS_CTL) + 256;
      pg8::Sched<3> Sc; Sc.init(pst[NE], 2 * FE, gridDim.x, blockIdx.x, p.ws + WS_XS, p.ws + WO_EGU, D / 2, D / 2, pst, (size_t)FE * D);
      pg8::EpiPairEl<EpiSwiglu8> E{{p.ws + WS_HIDM, FE}};
      pg8::gemm_phase<pg8::EpiPairEl<EpiSwiglu8>, pg8::Sched<3>, true, true, 1>(lds, D / 2, D / 2, D / 2, 128, Sc, E, 127 - 5); }
    GRID_BAR();
    { const int* pst = (const int*)(p.ws + WS_CTL) + 256;
      pg8::Sched<3> Sc; Sc.init(pst[NE], D, gridDim.x, blockIdx.x, p.ws + WS_HIDM, p.ws + WO_EDN, FE / 2, FE / 2, pst, (size_t)D * FE / 2);
      pg8::EpiEl<EpiBf16> E{{(bf16_t*)(p.ws + WS_Y), D}};
      pg8::gemm_phase<pg8::EpiEl<EpiBf16>, pg8::Sched<3>, true, true, 1>(lds, FE / 2, FE / 2, FE / 2, 128, Sc, E, 127 - 6); }
    GRID_BAR();
    phase_combine(p);
}

extern "C" void kernel_launch(void* const* d_in, const int* in_sizes, int n_in, void* d_out, int out_size, void* d_ws, size_t ws_size, hipStream_t stream) {
    if (n_in != 28 || out_size != T * D || ws_size < WS_END) { fprintf(stderr, "kernel_launch: unexpected shapes (n_in %d out %d ws %zu need %zu)\n", n_in, out_size, ws_size, (size_t)WS_END); return; }
    static int grid = 0;
    if (grid == 0) {
        int dev = 0, cus = 0, per_cu = 0;
        if (hipGetDevice(&dev) != hipSuccess || hipDeviceGetAttribute(&cus, hipDeviceAttributeMultiprocessorCount, dev) != hipSuccess) { grid = -1; return; }
        if (hipFuncSetAttribute((const void*)k_fused, hipFuncAttributeMaxDynamicSharedMemorySize, LDS_BYTES) != hipSuccess) { grid = -1; return; }
        if (hipOccupancyMaxActiveBlocksPerMultiprocessor(&per_cu, (const void*)k_fused, NTHR, LDS_BYTES) != hipSuccess || per_cu < 1) { fprintf(stderr, "kernel_launch: occupancy query says %d\n", per_cu); }
        (void)hipGetLastError();
        grid = cus;
    }
    if (grid < 0) return;
    Params p{};
    const float** pp = (const float**)&p;
    for (int i = 0; i < 28; ++i) pp[i] = (const float*)d_in[i];
    p.out = (float*)d_out; p.ws = (unsigned char*)d_ws;
    (void)hipMemsetAsync((char*)d_ws + WS_CTL, 0, CTL_BYTES, stream);
    k_fused<<<dim3(grid), dim3(NTHR), LDS_BYTES, stream>>>(p);
}
```

```cpp
#include <hip/hip_runtime.h>
#include <cstdint>
#include <cstdio>

#define LAS __attribute__((address_space(3)))
typedef unsigned short bf16_t;
typedef short bf16x8 __attribute__((ext_vector_type(8)));
typedef float f32x4 __attribute__((ext_vector_type(4)));
typedef float f32x2 __attribute__((ext_vector_type(2)));
typedef unsigned u32x4 __attribute__((ext_vector_type(4)));
typedef unsigned u32x2 __attribute__((ext_vector_type(2)));

constexpr int NB = 4, S = 8192, D = 1024, T = NB * S;
constexpr int FF = 2816, NE = 8, FE = 3584;
constexpr int NKV = 1536, NQP = 1280, NQ = 1072;
constexpr int G = 4, HD = 64, NH = 16;
constexpr int NC = 512;
constexpr int NSB = 128;
constexpr int NSEL = 16;
constexpr int WIN = 512;
constexpr int MOE_ROWS = 69632;
constexpr float EPS = 1e-6f;
constexpr int NTHR = 512, NWAVE = 8;

constexpr size_t MiB = 1u << 20;
constexpr size_t WS_CTL = 0, CTL_BYTES = 1 * MiB;
constexpr size_t WS_MODV = 1 * MiB;
constexpr size_t WS_CMPB = WS_MODV + 14 * 4 * 1024 * 4;
constexpr size_t WS_FGMAX = WS_CMPB + 4096;
constexpr size_t WS_ASC = WS_FGMAX + 2 * FF * 4;
constexpr size_t WS_HBG = 6 * MiB;
constexpr size_t WS_MHG = WS_HBG + 65536;
constexpr size_t WS_TOPE = 2 * MiB;
constexpr size_t WS_TOPW = WS_TOPE + (size_t)T * 8;
constexpr size_t WS_RPOS = WS_TOPW + (size_t)T * 8;
constexpr size_t WS_RTOK = WS_RPOS + (size_t)T * 8;
constexpr size_t WS_SMALL_END = WS_RTOK + (size_t)MOE_ROWS * 4;
static_assert(WS_SMALL_END <= 8 * MiB && WS_ASC + (size_t)T * 4 <= 2 * MiB, "small region");
constexpr size_t WS_W = 8 * MiB;
constexpr size_t WO_POOL = WS_W;
constexpr size_t WO_FGU = WO_POOL + (size_t)4 * 256 * 256 * 2;
constexpr size_t WO_FDN = WO_FGU + (size_t)2 * FF * D * 2;
constexpr size_t WO_KV = WO_FDN + (size_t)D * FF * 2;
constexpr size_t WO_Q = WO_KV + (size_t)NKV * D * 2;
constexpr size_t WO_O = WO_Q + (size_t)NQP * D * 2;
constexpr size_t WO_CK = WO_O + (size_t)D * D * 2;
constexpr size_t WO_CV = WO_CK + (size_t)256 * 2048 * 2;
constexpr size_t WO_EGU = WO_CV + (size_t)256 * 2048 * 2;
constexpr size_t WO_EDN = WO_EGU + (size_t)NE * 2 * FE * D * 2;
constexpr size_t WO_END = WO_EDN + (size_t)NE * D * FE * 2;
static_assert(WO_END <= 203 * MiB, "weights region");
constexpr size_t WS_HB = 203 * MiB;
constexpr size_t WS_X1 = 267 * MiB;
constexpr size_t WS_X2 = 395 * MiB;
constexpr size_t WS_HID0 = 523 * MiB;
constexpr size_t WS_Q = 523 * MiB;
constexpr size_t WS_GATE = 587 * MiB;
constexpr size_t WS_CMPH = 593 * MiB;
constexpr size_t WS_KC = 601 * MiB;
constexpr size_t WS_VC = 602 * MiB;
constexpr size_t WS_KSB = 603 * MiB;
constexpr size_t WS_VSB = 619 * MiB;
constexpr size_t WS_KWB = 635 * MiB;
constexpr size_t WS_VWB = 651 * MiB;
constexpr size_t WS_Q8 = 267 * MiB;
constexpr size_t WS_SEL = 667 * MiB;
constexpr size_t WS_HA = 699 * MiB;
constexpr size_t WS_KVB = 763 * MiB;
constexpr size_t WS_HIDM = 267 * MiB;
constexpr size_t WS_Y = 743 * MiB;
constexpr size_t WS_XS = WS_Y;
constexpr size_t WS_END = 880 * MiB;
static_assert(WS_HIDM + (size_t)MOE_ROWS * FE * 2 <= WS_Y && WS_Y + (size_t)MOE_ROWS * D * 2 <= WS_END, "moe map");
static_assert(WS_KVB + (size_t)T * NKV * 2 + 65536 <= WS_END, "kv map");
constexpr int CW_CNT = 512;
constexpr int CW_CUR = 1024;
constexpr int CW_HN = 2048, CW_VT = 2112;
constexpr int CW_BAR = 4096;

struct Params {
    const float *x, *c, *ada_w, *ada_b, *norm_g, *pool_w, *pool_scale, *q_w, *q_gain, *o_w, *kv_ada_w, *kv_ada_b, *kv_norm_g, *kv_w,
        *cmp_pe_k, *cmp_pe_v, *cmp_k_w1, *cmp_k_w2, *cmp_v_w1, *cmp_v_w2, *k_gain, *rel_bias, *ffn_gu, *ffn_dn, *router_w, *router_b, *exp_gu, *exp_dn;
    float* out; unsigned char* ws;
};

__device__ __forceinline__ unsigned cvt_pk_bf16(float lo, float hi) { unsigned r; asm volatile("v_cvt_pk_bf16_f32 %0, %1, %2" : "=v"(r) : "v"(lo), "v"(hi)); return r; }
__device__ __forceinline__ float bf2f(unsigned short v) { return __uint_as_float((unsigned)v << 16); }
__device__ __forceinline__ float bflo(unsigned w) { return __uint_as_float(w << 16); }
__device__ __forceinline__ float bfhi(unsigned w) { return __uint_as_float(w & 0xffff0000u); }
constexpr int TID_TAB_OFF = 155648 + 512;
__device__ __forceinline__ int hw_wave_slot() { return (int)(__builtin_amdgcn_s_getreg((5 << 11) | 4) & 63u); }
__device__ __forceinline__ int opaque_tid() { const int w = __builtin_amdgcn_readfirstlane(((const LAS int*)(size_t)TID_TAB_OFF)[hw_wave_slot()]);
    int l; asm volatile("v_mbcnt_lo_u32_b32 %0, -1, 0\n\tv_mbcnt_hi_u32_b32 %0, -1, %0" : "=v"(l));
    int t = (w << 6) | l; asm volatile("" : "+v"(t)); return t; }
__device__ __forceinline__ float readlane_f(float v, int l) { return __uint_as_float((unsigned)__builtin_amdgcn_readlane((int)__float_as_uint(v), l)); }
__device__ __forceinline__ unsigned pack_i8x4(float a, float b, float c, float d) {
    const int ia = (int)__builtin_rintf(fminf(fmaxf(a, -127.f), 127.f)), ib = (int)__builtin_rintf(fminf(fmaxf(b, -127.f), 127.f)), ic = (int)__builtin_rintf(fminf(fmaxf(c, -127.f), 127.f)), id = (int)__builtin_rintf(fminf(fmaxf(d, -127.f), 127.f));
    return (unsigned)(ia & 0xff) | ((unsigned)(ib & 0xff) << 8) | ((unsigned)(ic & 0xff) << 16) | ((unsigned)(id & 0xff) << 24);
}
__device__ __forceinline__ float sel_q_scale(const float* q_gain) { float m = 0.f; for (int i = 0; i < 64; ++i) m = fmaxf(m, fabsf(q_gain[i])); return 127.f / (4.f * m * 0.125f * 1.4426950408889634f); }
__device__ __forceinline__ float sel_k_scale(const float* k_gain) { float m = 0.f; for (int i = 0; i < 64; ++i) m = fmaxf(m, fabsf(k_gain[64 + i])); return 127.f / (4.f * m); }
__device__ __forceinline__ float wave_sum(float v) {
#pragma unroll
    for (int o = 1; o < 64; o <<= 1) v += __shfl_xor(v, o);
    return v;
}
__device__ __forceinline__ float wave_max(float v) {
#pragma unroll
    for (int o = 1; o < 64; o <<= 1) v = fmaxf(v, __shfl_xor(v, o));
    return v;
}
__device__ __forceinline__ float silu_f(float v) { return v * __builtin_amdgcn_rcpf(1.f + __builtin_amdgcn_exp2f(v * -1.4426950408889634f)); }
__device__ __forceinline__ float sigmoid_f(float v) { return __builtin_amdgcn_rcpf(1.f + __builtin_amdgcn_exp2f(v * -1.4426950408889634f)); }
__device__ __forceinline__ float gelu_tanh_f(float v) {
    const float u = 0.7978845608028654f * (v + 0.044715f * v * v * v);
    const float e = __builtin_amdgcn_exp2f(fabsf(u) * -2.8853900817779268f); const float th = (1.f - e) * __builtin_amdgcn_rcpf(1.f + e);
    return 0.5f * v * (1.f + (u < 0.f ? -th : th));
}
__device__ __forceinline__ int rel_bucket(int d) {
    if (d < 16) return d;
    int b = 16;
    b += (d >= 21); b += (d >= 27); b += (d >= 35); b += (d >= 46); b += (d >= 59); b += (d >= 77); b += (d >= 99); b += (d >= 128);
    b += (d >= 166); b += (d >= 216); b += (d >= 280); b += (d >= 363); b += (d >= 470); b += (d >= 609); b += (d >= 790);
    return b;
}

template <bool FP8 = false>
__device__ __forceinline__ void transpose_item(const float* W, int K, int N, bf16_t* WT, int k0, int n0, int drow0, LAS float* scr, int lane, float wscale = 1.f) {
    float wv[32];
#pragma unroll
    for (int i = 0; i < 32; ++i) { const int kk = 2 * i + (lane >> 5); const int n = n0 + (lane & 31); wv[i] = (n < N) ? W[(size_t)(k0 + kk) * N + n] : 0.f; }
#pragma unroll
    for (int i = 0; i < 32; ++i) { const int kk = 2 * i + (lane >> 5); scr[kk * 33 + (lane & 31)] = wv[i]; }
    asm volatile("s_waitcnt lgkmcnt(0)" ::: "memory");
    const int c = lane & 7;
#pragma unroll
    for (int j = 0; j < 4; ++j) { const int n = (lane >> 3) + 8 * j; const LAS float* s = scr + (8 * c) * 33 + n;
        if constexpr (FP8) {
            unsigned w0 = 0u, w1 = 0u;
            w0 = __builtin_amdgcn_cvt_pk_fp8_f32(s[0 * 33] * wscale, s[1 * 33] * wscale, w0, false); w0 = __builtin_amdgcn_cvt_pk_fp8_f32(s[2 * 33] * wscale, s[3 * 33] * wscale, w0, true);
            w1 = __builtin_amdgcn_cvt_pk_fp8_f32(s[4 * 33] * wscale, s[5 * 33] * wscale, w1, false); w1 = __builtin_amdgcn_cvt_pk_fp8_f32(s[6 * 33] * wscale, s[7 * 33] * wscale, w1, true);
            *(u32x2*)((unsigned char*)WT + (size_t)(drow0 + n) * K + k0 + 8 * c) = (u32x2){w0, w1};
        } else {
        u32x4 o; o.x = cvt_pk_bf16(s[0 * 33], s[1 * 33]); o.y = cvt_pk_bf16(s[2 * 33], s[3 * 33]); o.z = cvt_pk_bf16(s[4 * 33], s[5 * 33]); o.w = cvt_pk_bf16(s[6 * 33], s[7 * 33]);
        *(u32x4*)(WT + (size_t)(drow0 + n) * K + k0 + 8 * c) = o; } }
    asm volatile("s_waitcnt lgkmcnt(0)" ::: "memory");
}
template <int MODE, bool FP8 = false>
__device__ __forceinline__ void transpose_mat(const float* W, int K, int N, int NP, int F, bf16_t* WT, int it, LAS float* scr, int lane, float wscale = 1.f) {
    const int nblk = NP / 32, kb = it / nblk, nb = it % nblk, n0 = nb * 32;
    int drow0 = n0;
    if (MODE == 1) { const int up = n0 >= F, j = up ? n0 - F : n0; drow0 = (j >> 7) * 256 + (up ? 128 : 0) + (j & 127); }
    transpose_item<FP8>(W, K, N, WT, kb * 64, n0, drow0, scr, lane, wscale);
}
__device__ __forceinline__ void phase_convert_fgu(const Params& p, LAS unsigned char* lds) {
    const int tid = opaque_tid(), lane = tid & 63, wave = tid >> 6;
    LAS float* scr = (LAS float*)(lds + wave * 16384);
    const int gw = blockIdx.x * NWAVE + wave, NGW = gridDim.x * NWAVE;
    const float* FGMAX = (const float*)(p.ws + WS_FGMAX); unsigned char* WT = p.ws + WO_FGU;
    for (int it = gw; it < 16 * 176; it += NGW) {
        const int kb = it / 176, nb = it % 176, n0 = nb * 32, k0 = kb * 64;
        const int up = n0 >= FF, j0 = up ? n0 - FF : n0, drow0 = (j0 >> 7) * 256 + (up ? 128 : 0) + (j0 & 127);
        float wv[32];
#pragma unroll
        for (int i = 0; i < 32; ++i) wv[i] = p.ffn_gu[(size_t)(k0 + 2 * i + (lane >> 5)) * (2 * FF) + n0 + (lane & 31)];
#pragma unroll
        for (int i = 0; i < 32; ++i) scr[(2 * i + (lane >> 5)) * 33 + (lane & 31)] = wv[i];
        asm volatile("s_waitcnt lgkmcnt(0)" ::: "memory");
        const int c = lane & 7;
#pragma unroll
        for (int j = 0; j < 4; ++j) { const int n = (lane >> 3) + 8 * j; const LAS float* sp = scr + (8 * c) * 33 + n; const float sc = 127.f / FGMAX[n0 + n];
            const unsigned w0 = pack_i8x4(sp[0 * 33] * sc, sp[1 * 33] * sc, sp[2 * 33] * sc, sp[3 * 33] * sc), w1 = pack_i8x4(sp[4 * 33] * sc, sp[5 * 33] * sc, sp[6 * 33] * sc, sp[7 * 33] * sc);
            *(u32x2*)(WT + (size_t)(drow0 + n) * D + k0 + 8 * c) = (u32x2){w0, w1}; }
        asm volatile("s_waitcnt lgkmcnt(0)" ::: "memory");
    }
}
__device__ __forceinline__ void phase_weights(const Params& p, LAS unsigned char* lds) {
    const int tid = opaque_tid(), lane = tid & 63, wave = tid >> 6;
    LAS float* scr = (LAS float*)(lds + wave * 16384);
    const int gw = blockIdx.x * NWAVE + wave, NGW = gridDim.x * NWAVE;
    unsigned char* ws = p.ws;
    constexpr int I_POOL = 4 * 8, I_FGU = 16 * 176, I_FDN = 44 * 32, I_KV = 16 * 48, I_Q = 16 * 40, I_O = 16 * 32, I_C = 32 * 8, I_EGU = 16 * 224, I_EDN = 56 * 32;
    constexpr int TOT = 4 * I_POOL + I_FGU + I_FDN + I_KV + I_Q + I_O + 2 * I_C + NE * I_EGU + NE * I_EDN;
    for (int it = gw; it < TOT; it += NGW) {
        int r = it;
        if (r < 4 * I_POOL) { const int g = r / I_POOL; transpose_mat<0>(p.pool_w + (size_t)g * 65536, 256, 256, 256, 0, (bf16_t*)(ws + WO_POOL) + (size_t)g * 65536, r % I_POOL, scr, lane); continue; } r -= 4 * I_POOL;
        if (r < I_FGU) continue; r -= I_FGU;
        if (r < I_FDN) { transpose_mat<0>(p.ffn_dn, FF, D, D, 0, (bf16_t*)(ws + WO_FDN), r, scr, lane); continue; } r -= I_FDN;
        if (r < I_KV) { transpose_mat<0>(p.kv_w, D, NKV, NKV, 0, (bf16_t*)(ws + WO_KV), r, scr, lane); continue; } r -= I_KV;
        if (r < I_Q) { transpose_mat<0>(p.q_w, D, NQ, NQP, 0, (bf16_t*)(ws + WO_Q), r, scr, lane); continue; } r -= I_Q;
        if (r < I_O) { transpose_mat<0>(p.o_w, D, D, D, 0, (bf16_t*)(ws + WO_O), r, scr, lane); continue; } r -= I_O;
        if (r < I_C) { transpose_mat<0>(p.cmp_k_w1, 2048, 256, 256, 0, (bf16_t*)(ws + WO_CK), r, scr, lane); continue; } r -= I_C;
        if (r < I_C) { transpose_mat<0>(p.cmp_v_w1, 2048, 256, 256, 0, (bf16_t*)(ws + WO_CV), r, scr, lane); continue; } r -= I_C;
        if (r < NE * I_EGU) { const int e = r / I_EGU; transpose_mat<1, true>(p.exp_gu + (size_t)e * D * 2 * FE, D, 2 * FE, 2 * FE, FE, (bf16_t*)(ws + WO_EGU + (size_t)e * 2 * FE * D), r % I_EGU, scr, lane, 32.f); continue; } r -= NE * I_EGU;
        { const int e = r / I_EDN; transpose_mat<0, true>(p.exp_dn + (size_t)e * FE * D, FE, D, D, 0, (bf16_t*)(ws + WO_EDN + (size_t)e * D * FE), r % I_EDN, scr, lane, 64.f); }
    }
}

__device__ __forceinline__ void phase_modvec(const Params& p, LAS unsigned char* lds) {
    const int tid = opaque_tid(), lane = tid & 63, wave = tid >> 6;
    LAS float* part = (LAS float*)lds;
    LAS float* sc_l = (LAS float*)(lds + 8192);
    for (int i = tid; i < 4 * D; i += NTHR) sc_l[i] = silu_f(p.c[i]);
    __syncthreads();
    float* MODV = (float*)(p.ws + WS_MODV);
    float* CMPB = (float*)(p.ws + WS_CMPB);
    { float* FGMAX = (float*)(p.ws + WS_FGMAX);
      for (int u = blockIdx.x; u < 2 * FF / 64; u += gridDim.x) {
        const int col = u * 64 + lane; float m = 0.f;
#pragma unroll 16
        for (int k = wave * 128; k < wave * 128 + 128; ++k) m = fmaxf(m, fabsf(p.ffn_gu[(size_t)k * (2 * FF) + col]));
        part[wave * 64 + lane] = m;
        __syncthreads();
        if (tid < 64) { float mm = part[lane];
#pragma unroll
            for (int w = 1; w < 8; ++w) mm = fmaxf(mm, part[w * 64 + lane]);
            FGMAX[u * 64 + lane] = fmaxf(mm, 1e-30f); }
        __syncthreads();
      } }
    constexpr int NU_MOD = 14336 / 64, NU = NU_MOD + 8;
    for (int u = blockIdx.x; u < NU; u += gridDim.x) {
        float acc[4] = {0.f, 0.f, 0.f, 0.f};
        if (u < NU_MOD) {
            const int gc = u * 64 + lane;
            const float* W; int ldw, col;
            if (gc < 6144) { W = p.ada_w; ldw = 6144; col = gc; } else if (gc < 12288) { W = p.ada_w + (size_t)D * 6144; ldw = 6144; col = gc - 6144; } else { W = p.kv_ada_w; ldw = 2048; col = gc - 12288; }
#pragma unroll 16
            for (int k = wave * 128; k < wave * 128 + 128; ++k) {
                const float w = W[(size_t)k * ldw + col];
#pragma unroll
                for (int b = 0; b < 4; ++b) acc[b] += sc_l[b * D + k] * w;
            }
        } else {
            const int cu = u - NU_MOD, kv = cu >> 2, col = (cu & 3) * 64 + lane;
            const float* W = kv ? p.cmp_v_w1 : p.cmp_k_w1; const float* pe = kv ? p.cmp_pe_v : p.cmp_pe_k;
#pragma unroll 16
            for (int k = wave * 256; k < wave * 256 + 256; ++k) acc[0] += pe[k] * W[(size_t)k * 256 + col];
        }
#pragma unroll
        for (int b = 0; b < 4; ++b) part[(wave * 4 + b) * 64 + lane] = acc[b];
        __syncthreads();
        if (tid < 256) {
            const int b = tid >> 6; float s = 0.f;
#pragma unroll
            for (int w = 0; w < 8; ++w) s += part[(w * 4 + b) * 64 + lane];
            if (u < NU_MOD) {
                const int gc = u * 64 + lane; int which, n; float bias;
                if (gc < 6144) { which = gc >> 10; n = gc & 1023; bias = p.ada_b[gc]; } else if (gc < 12288) { which = 6 + ((gc - 6144) >> 10); n = gc & 1023; bias = p.ada_b[gc]; }
                else { which = 12 + ((gc - 12288) >> 10); n = gc & 1023; bias = p.kv_ada_b[gc - 12288]; }
                MODV[(which * 4 + b) * D + n] = s + bias;
            } else if (b == 0) { const int cu = u - NU_MOD; CMPB[(cu >> 2) * 256 + (cu & 3) * 64 + lane] = s; }
        }
        __syncthreads();
    }
}

template <int W>
__device__ __forceinline__ void pool_rows(const float* xb, int t0, const LAS float* rs, f32x2 gm, f32x2 sh, bf16_t* outb, int c0) {
    f32x2 ring[16];
#pragma unroll
    for (int i = 0; i < 15; ++i) {
        const int t = t0 - 15 + i; f32x2 h = {0.f, 0.f};
        if (t >= 0) { const f32x2 xv = *(const f32x2*)(xb + (size_t)t * D + c0); const float r = rs[i]; h = xv * r * gm + sh; }
        ring[i] = h;
    }
    for (int gi = 0; gi < 8; ++gi) {
#pragma unroll
        for (int j = 0; j < 16; ++j) {
            const int i = 15 + gi * 16 + j, t = t0 + gi * 16 + j;
            const f32x2 xv = *(const f32x2*)(xb + (size_t)t * D + c0); const float r = rs[i];
            const f32x2 h = xv * r * gm + sh;
            ring[(15 + j) & 15] = h;
            f32x2 s = {0.f, 0.f};
#pragma unroll
            for (int k = 0; k < W; ++k) s += ring[(15 + j - k) & 15];
            const int cnt = (t + 1 < W) ? t + 1 : W;
            const f32x2 o = s * (1.f / (float)cnt) - h;
            *(unsigned*)(outb + (size_t)t * D + c0) = cvt_pk_bf16(o.x, o.y);
        }
    }
}
__device__ __forceinline__ void phase_poolmix(const Params& p, LAS unsigned char* lds, bf16_t* mixA) {
    const int tid = opaque_tid(), lane = tid & 63, wave = tid >> 6;
    LAS float* rs = (LAS float*)lds;
    const float* MODV = (const float*)(p.ws + WS_MODV);
    for (int u = blockIdx.x; u < T / 128; u += gridDim.x) {
        const int b = u >> 6, t0 = (u & 63) * 128;
        const float* xb = p.x + (size_t)b * S * D;
        for (int i = wave; i < 143; i += NWAVE) {
            const int t = t0 - 15 + i; float r = 0.f;
            if (t >= 0) { const f32x4* xr = (const f32x4*)(xb + (size_t)t * D) + lane; float s = 0.f;
#pragma unroll
                for (int j = 0; j < 4; ++j) { const f32x4 v = xr[64 * j]; s += (v.x * v.x + v.y * v.y) + (v.z * v.z + v.w * v.w); }
                r = 1.f / sqrtf(wave_sum(s) * (1.f / D) + EPS); }
            if (lane == 0) rs[i] = r;
        }
        __syncthreads();
        const int c0 = 2 * tid;
        const f32x2 g = *(const f32x2*)(p.norm_g + c0), sc = *(const f32x2*)(MODV + (1 * 4 + b) * D + c0), sh = *(const f32x2*)(MODV + (0 * 4 + b) * D + c0);
        const f32x2 gm = g * (sc + 1.f);
        bf16_t* ob = mixA + (size_t)b * S * D;
        const int grp = tid >> 7;
        if (grp == 0) pool_rows<2>(xb, t0, rs, gm, sh, ob, c0);
        else if (grp == 1) pool_rows<4>(xb, t0, rs, gm, sh, ob, c0);
        else if (grp == 2) pool_rows<8>(xb, t0, rs, gm, sh, ob, c0);
        else pool_rows<16>(xb, t0, rs, gm, sh, ob, c0);
        __syncthreads();
    }
}

struct NormOut { const float* g; const float* sc; const float* sh; bf16_t* out; };
template <int NOUT, bool ROUTER, int OUTQ = 0>
__device__ __forceinline__ void phase_norm(const Params& p, LAS unsigned char* lds, const float* xin, const NormOut o0, const NormOut o1) {
    const int tid = opaque_tid(), lane = tid & 63, wave = tid >> 6;
    const int gw = blockIdx.x * NWAVE + wave, NGW = gridDim.x * NWAVE;
    f32x4 rwa[16], rwb[16];
    if (ROUTER) {
#pragma unroll
        for (int j = 0; j < 4; ++j)
#pragma unroll
            for (int q = 0; q < 4; ++q) { const f32x4* wp = (const f32x4*)(p.router_w + (size_t)(4 * lane + 256 * j + q) * NE); rwa[4 * j + q] = wp[0]; rwb[4 * j + q] = wp[1]; }
    }
    unsigned* ctl = (unsigned*)(p.ws + WS_CTL);
    int* TOPE = (int*)(p.ws + WS_TOPE); float* TOPW = (float*)(p.ws + WS_TOPW);
    unsigned cnt_local[NE];
#pragma unroll
    for (int e = 0; e < NE; ++e) cnt_local[e] = 0;
    const int rows_per = T / NGW > 0 ? (T + NGW - 1) / NGW : 1;
    const int r0 = gw * rows_per, r1 = (r0 + rows_per < T) ? r0 + rows_per : T;
    int curb = -1; f32x4 gm0[4], sh0[4], gm1[4], sh1[4];
    for (int r = r0; r < r1; ++r) {
        const int b = r >> 13;
        if (b != curb) { curb = b;
#pragma unroll
            for (int j = 0; j < 4; ++j) { const int c = 4 * lane + 256 * j;
                gm0[j] = *(const f32x4*)(o0.g + c) * (*(const f32x4*)(o0.sc + b * D + c) + 1.f); sh0[j] = *(const f32x4*)(o0.sh + b * D + c);
                if (NOUT > 1) { gm1[j] = *(const f32x4*)(o1.g + c) * (*(const f32x4*)(o1.sc + b * D + c) + 1.f); sh1[j] = *(const f32x4*)(o1.sh + b * D + c); } } }
        const f32x4* xr = (const f32x4*)(xin + (size_t)r * D) + lane;
        f32x4 v[4]; float s = 0.f;
#pragma unroll
        for (int j = 0; j < 4; ++j) { v[j] = xr[64 * j]; s += (v[j].x * v[j].x + v[j].y * v[j].y) + (v[j].z * v[j].z + v[j].w * v[j].w); }
        const float rstd = 1.f / sqrtf(wave_sum(s) * (1.f / D) + EPS);
        float lg[NE];
#pragma unroll
        for (int e = 0; e < NE; ++e) lg[e] = 0.f;
        float qsc = 1.f;
        if constexpr (OUTQ == 2) { float mx = 0.f;
#pragma unroll
            for (int j = 0; j < 4; ++j) { const f32x4 h = v[j] * rstd * gm0[j] + sh0[j]; mx = fmaxf(mx, fmaxf(fmaxf(fabsf(h.x), fabsf(h.y)), fmaxf(fabsf(h.z), fabsf(h.w)))); }
            mx = fmaxf(wave_max(mx), 1e-30f); qsc = 127.f / mx;
            if (lane == 0) ((float*)(p.ws + WS_ASC))[r] = mx * (1.f / 127.f); }
#pragma unroll
        for (int j = 0; j < 4; ++j) {
            const f32x4 h = v[j] * rstd * gm0[j] + sh0[j];
            if constexpr (OUTQ == 2) { *(unsigned*)((unsigned char*)o0.out + (size_t)r * D + 4 * lane + 256 * j) = pack_i8x4(h.x * qsc, h.y * qsc, h.z * qsc, h.w * qsc); }
            else if constexpr (OUTQ == 1) { unsigned w8 = 0u; w8 = __builtin_amdgcn_cvt_pk_fp8_f32(h.x, h.y, w8, false); w8 = __builtin_amdgcn_cvt_pk_fp8_f32(h.z, h.w, w8, true);
                *(unsigned*)((unsigned char*)o0.out + (size_t)r * D + 4 * lane + 256 * j) = w8; }
            else { u32x2 w; w.x = cvt_pk_bf16(h.x, h.y); w.y = cvt_pk_bf16(h.z, h.w);
            *(u32x2*)(o0.out + (size_t)r * D + 4 * lane + 256 * j) = w; }
            if (NOUT > 1) { const f32x4 h1 = v[j] * rstd * gm1[j] + sh1[j]; u32x2 w1; w1.x = cvt_pk_bf16(h1.x, h1.y); w1.y = cvt_pk_bf16(h1.z, h1.w);
                *(u32x2*)(o1.out + (size_t)r * D + 4 * lane + 256 * j) = w1; }
            if (ROUTER) {
#pragma unroll
                for (int q = 0; q < 4; ++q) { const f32x4 a = rwa[4 * j + q], c2 = rwb[4 * j + q]; const float hv = h[q];
                    lg[0] += hv * a.x; lg[1] += hv * a.y; lg[2] += hv * a.z; lg[3] += hv * a.w; lg[4] += hv * c2.x; lg[5] += hv * c2.y; lg[6] += hv * c2.z; lg[7] += hv * c2.w; }
            }
        }
        if (ROUTER) {
            {
                const bool u5 = lane & 32, u4 = lane & 16, u3 = lane & 8; float a4[4], a2[2], a1;
#pragma unroll
                for (int i = 0; i < 4; ++i) a4[i] = (u5 ? lg[4 + i] : lg[i]) + __shfl_xor(u5 ? lg[i] : lg[4 + i], 32);
#pragma unroll
                for (int i = 0; i < 2; ++i) a2[i] = (u4 ? a4[2 + i] : a4[i]) + __shfl_xor(u4 ? a4[i] : a4[2 + i], 16);
                a1 = (u3 ? a2[1] : a2[0]) + __shfl_xor(u3 ? a2[0] : a2[1], 8);
                a1 += __shfl_xor(a1, 4); a1 += __shfl_xor(a1, 2); a1 += __shfl_xor(a1, 1);
#pragma unroll
                for (int e = 0; e < NE; ++e) lg[e] = readlane_f(a1, 8 * e) + p.router_b[e];
            }
            int e0 = 0; float v0 = lg[0];
#pragma unroll
            for (int e = 1; e < NE; ++e) if (lg[e] > v0) { v0 = lg[e]; e0 = e; }
            int e1 = -1; float v1 = -3.0e38f;
#pragma unroll
            for (int e = 0; e < NE; ++e) if (e != e0 && lg[e] > v1) { v1 = lg[e]; e1 = e; }
            const float ex = __expf(v1 - v0), w0 = 1.f / (1.f + ex), w1 = ex / (1.f + ex);
            if (lane == 0) { TOPE[2 * r] = e0; TOPE[2 * r + 1] = e1; TOPW[2 * r] = w0; TOPW[2 * r + 1] = w1; }
#pragma unroll
            for (int e = 0; e < NE; ++e) cnt_local[e] += (e == e0) + (e == e1);
        }
    }
    if (ROUTER) {
        LAS unsigned* lc = (LAS unsigned*)lds;
        if (tid < NE) lc[tid] = 0u;
        __syncthreads();
        if (lane == 0) {
#pragma unroll
            for (int e = 0; e < NE; ++e) if (cnt_local[e]) atomicAdd((unsigned*)(lc + e), cnt_local[e]);
        }
        __syncthreads();
        if (tid < NE && lc[tid]) atomicAdd(ctl + CW_CNT + 64 * tid, lc[tid]);
    }
}

struct EpiPool {
    const float* x; float* x1; const float* g1; const float* scale; int coff;
    __device__ __forceinline__ void operator()(int row, int col, f32x4 v) const { const int c = coff + col, b = row >> 13;
        const f32x4 xv = *(const f32x4*)(x + (size_t)row * D + c), gv = *(const f32x4*)(g1 + b * D + c), sv = *(const f32x4*)(scale + c);
        *(f32x4*)(x1 + (size_t)row * D + c) = xv + gv * (v * sv); }
};
struct EpiSwiglu {
    bf16_t* hid; int ldh;
    __device__ __forceinline__ void pair(int row, int hc, f32x4 gt, f32x4 up) const {
        u32x2 w; w.x = cvt_pk_bf16(silu_f(gt.x) * up.x, silu_f(gt.y) * up.y); w.y = cvt_pk_bf16(silu_f(gt.z) * up.z, silu_f(gt.w) * up.w);
        *(u32x2*)(hid + (size_t)row * ldh + hc) = w; }
};
struct EpiSwigluI8 {
    bf16_t* hid; int ldh; const float* asc; const float* wmax;
    __device__ __forceinline__ void pair(int row, int hc, f32x4 gt, f32x4 up) const {
        typedef int i32x4e __attribute__((ext_vector_type(4)));
        const i32x4e gi = __builtin_bit_cast(i32x4e, gt), ui = __builtin_bit_cast(i32x4e, up);
        const float ra = asc[row] * (1.f / 127.f); const f32x4 wg = *(const f32x4*)(wmax + hc) * ra, wu = *(const f32x4*)(wmax + FF + hc) * ra;
        const float g0 = (float)gi.x * wg.x, g1 = (float)gi.y * wg.y, g2 = (float)gi.z * wg.z, g3 = (float)gi.w * wg.w;
        u32x2 w; w.x = cvt_pk_bf16(silu_f(g0) * ((float)ui.x * wu.x), silu_f(g1) * ((float)ui.y * wu.y)); w.y = cvt_pk_bf16(silu_f(g2) * ((float)ui.z * wu.z), silu_f(g3) * ((float)ui.w * wu.w));
        *(u32x2*)(hid + (size_t)row * ldh + hc) = w; }
};
struct EpiSwiglu8 {
    unsigned char* hid; int ldh;
    __device__ __forceinline__ void pair(int row, int hc, f32x4 gt, f32x4 up) const {
        unsigned w = 0u; w = __builtin_amdgcn_cvt_pk_fp8_f32(silu_f(gt.x) * up.x, silu_f(gt.y) * up.y, w, false); w = __builtin_amdgcn_cvt_pk_fp8_f32(silu_f(gt.z) * up.z, silu_f(gt.w) * up.w, w, true);
        *(unsigned*)(hid + (size_t)row * ldh + hc) = w; }
};
struct EpiResid {
    const float* xin; float* out; const float* gate;
    __device__ __forceinline__ void operator()(int row, int col, f32x4 v) const { const int b = row >> 13;
        const f32x4 xv = *(const f32x4*)(xin + (size_t)row * D + col), gv = *(const f32x4*)(gate + b * D + col);
        *(f32x4*)(out + (size_t)row * D + col) = xv + gv * v; }
};
struct EpiBf16 {
    bf16_t* o; int ldo;
    __device__ __forceinline__ void operator()(int row, int col, f32x4 v) const { u32x2 w; w.x = cvt_pk_bf16(v.x, v.y); w.y = cvt_pk_bf16(v.z, v.w); *(u32x2*)(o + (size_t)row * ldo + col) = w; }
};
struct EpiQ {
    bf16_t* q; float* gates; int coff;
    __device__ __forceinline__ void operator()(int row, int col_, f32x4 v) const { const int col = col_ + coff;
        if (col < D) { u32x2 w; w.x = cvt_pk_bf16(v.x, v.y); w.y = cvt_pk_bf16(v.z, v.w); *(u32x2*)(q + (size_t)row * D + col) = w; }
        else if (col < NQ) { f32x4 s; s.x = sigmoid_f(v.x); s.y = sigmoid_f(v.y); s.z = sigmoid_f(v.z); s.w = sigmoid_f(v.w); *(f32x4*)(gates + (size_t)row * 48 + (col - D)) = s; } }
};
struct EpiCmp {
    bf16_t* o; const float* bias;
    __device__ __forceinline__ void operator()(int row, int col, f32x4 v) const { const int z = col >> 8, c = col & 255; const f32x4 bv = *(const f32x4*)(bias + (z >> 2) * 256 + c);
        u32x2 w; w.x = cvt_pk_bf16(gelu_tanh_f(v.x + bv.x), gelu_tanh_f(v.y + bv.y)); w.y = cvt_pk_bf16(gelu_tanh_f(v.z + bv.z), gelu_tanh_f(v.w + bv.w));
        *(u32x2*)(o + ((size_t)z * 2048 + row) * 256 + c) = w; }
};


namespace pg8 {
#define PG8_LAS __attribute__((address_space(3)))
constexpr int BM = 256, BK = 64, HALF = 128, HTB = HALF * BK * 2, STAGE_BYTES = 8 * HTB, NXCD = 8, WGM = 8;
__host__ __device__ __forceinline__ int lds_byte(int r, int c) { const int st = (r >> 4) * 2 + (c >> 5), rr = r & 15, cc = c & 31, ob = rr * 64 + cc * 2; return st * 1024 + (ob ^ (((ob >> 9) & 1) << 5)); }
__host__ __device__ __forceinline__ void stage_rc(int b, int& R, int& C) { const int st = b / 1024, sb = b % 1024, swz = sb ^ (((sb >> 9) & 1) << 5); R = (st >> 1) * 16 + swz / 64; C = (st & 1) * 32 + (swz % 64) / 2; }
__host__ __device__ __forceinline__ int perm32(int rho) { const int n = rho >> 4, i = rho & 15; return 8 * (i >> 2) + 4 * n + (i & 3); }
struct Unit { int pm, pn; };
template <int SMODE> struct Sched {
    int nM, nN, nwg, G, c; const char* A; const char* Bt; size_t lda2, ldb2; const int* pst; size_t bstride2;
    __device__ __forceinline__ void init(int M, int N, int G_, int c_, const void* A_, const void* Bt_, int lda, int ldb, const int* pst_ = nullptr, size_t bstride = 0) {
        nM = M / BM; nN = N / BM; nwg = nM * nN; G = G_; c = c_; A = (const char*)A_; Bt = (const char*)Bt_; lda2 = (size_t)lda * 2; ldb2 = (size_t)ldb * 2; pst = pst_; bstride2 = bstride * 2; }
    __device__ __forceinline__ bool next(int i, Unit& u) const {
        if (c < 0) return false;
        const long L = (long)i * G + c; if (L >= nwg) return false;
        int wgid = (int)L; { const int q = nwg / NXCD, r = nwg % NXCD, xcd = wgid % NXCD, off = wgid / NXCD; wgid = (xcd < r ? xcd * (q + 1) : r * (q + 1) + (xcd - r) * q) + off; }
        const int nig = WGM * nN, gid = wgid / nig, fm = gid * WGM, gsz = (nM - fm) < WGM ? (nM - fm) : WGM;
        u.pm = fm + ((wgid % nig) % gsz); u.pn = (wgid % nig) / gsz; return true;
    }
    __device__ __forceinline__ const char* a_ptr(const Unit& u) const {
        if (SMODE == 1) return A + (size_t)u.pm * BM * lda2 + (size_t)u.pn * 512;
        if (SMODE == 2) return A + (size_t)u.pm * BM * lda2 + (size_t)((u.pn >> 2) * 256 + (u.pn & 3) * 64) * 2;
        return A + (size_t)u.pm * BM * lda2; }
    __device__ __forceinline__ const char* b_ptr(const Unit& u) const {
        if (SMODE == 2) return Bt + (size_t)(u.pn >> 2) * BM * ldb2;
        if (SMODE == 3) { const int m0 = u.pm * BM; int e = 0;
#pragma unroll
            for (int q = 1; q < NE; ++q) e += (m0 >= pst[q]); return Bt + (size_t)e * bstride2 + (size_t)u.pn * BM * ldb2; }
        return Bt + (size_t)u.pn * BM * ldb2; }
};
template <class F> struct EpiEl { static constexpr bool PERM = false, AFTER_DRAIN = false; F f;
    __device__ __forceinline__ void operator()(const f32x4 (&acc)[2][2][4][2], const Unit& u, int wr, int wc, int fr, int fq) const {
#pragma unroll
        for (int ai = 0; ai < 2; ++ai)
#pragma unroll
            for (int m = 0; m < 4; ++m) { const int row = u.pm * BM + ai * HALF + wr * 64 + m * 16 + fr;
#pragma unroll
                for (int bj = 0; bj < 2; ++bj)
#pragma unroll
                    for (int n = 0; n < 2; ++n) f(row, u.pn * BM + bj * HALF + wc * 32 + n * 16 + 4 * fq, acc[ai][bj][m][n]); } } };
template <class F> struct EpiPairEl { static constexpr bool PERM = false, AFTER_DRAIN = false; F f;
    __device__ __forceinline__ void operator()(const f32x4 (&acc)[2][2][4][2], const Unit& u, int wr, int wc, int fr, int fq) const {
#pragma unroll
        for (int ai = 0; ai < 2; ++ai)
#pragma unroll
            for (int m = 0; m < 4; ++m) { const int row = u.pm * BM + ai * HALF + wr * 64 + m * 16 + fr;
#pragma unroll
                for (int n = 0; n < 2; ++n) f.pair(row, u.pn * HALF + wc * 32 + n * 16 + 4 * fq, acc[ai][0][m][n], acc[ai][1][m][n]); } } };

typedef int i32x8 __attribute__((ext_vector_type(8)));
template <int QM> __device__ __forceinline__ void mma_block(f32x4 (&acc)[4][2], const bf16x8 (&At)[4][2], const bf16x8 (&Bt)[2][2], const int wsc) {
    __builtin_amdgcn_s_setprio(1);
    if constexpr (QM == 2) {
        typedef int i32x4m __attribute__((ext_vector_type(4)));
#pragma unroll
        for (int m = 0; m < 4; ++m)
#pragma unroll
            for (int n = 0; n < 2; ++n)
#pragma unroll
                for (int k = 0; k < 2; ++k) acc[m][n] = __builtin_bit_cast(f32x4, __builtin_amdgcn_mfma_i32_16x16x64_i8(__builtin_bit_cast(i32x4m, Bt[n][k]), __builtin_bit_cast(i32x4m, At[m][k]), __builtin_bit_cast(i32x4m, acc[m][n]), 0, 0, 0));
#pragma unroll
        for (int m = 0; m < 4; ++m) asm volatile("" : "+v"(acc[m][0]), "+v"(acc[m][1]));
    } else if constexpr (QM == 1) {
#pragma unroll
        for (int m = 0; m < 4; ++m) { const u32x4 a0 = __builtin_bit_cast(u32x4, At[m][0]), a1 = __builtin_bit_cast(u32x4, At[m][1]);
            const i32x8 a8 = {(int)a0.x, (int)a0.y, (int)a0.z, (int)a0.w, (int)a1.x, (int)a1.y, (int)a1.z, (int)a1.w};
#pragma unroll
            for (int n = 0; n < 2; ++n) { const u32x4 b0 = __builtin_bit_cast(u32x4, Bt[n][0]), b1 = __builtin_bit_cast(u32x4, Bt[n][1]);
                const i32x8 b8 = {(int)b0.x, (int)b0.y, (int)b0.z, (int)b0.w, (int)b1.x, (int)b1.y, (int)b1.z, (int)b1.w};
                acc[m][n] = __builtin_amdgcn_mfma_scale_f32_16x16x128_f8f6f4(b8, a8, acc[m][n], 0, 0, 0, wsc, 0, 127); } }
#pragma unroll
        for (int m = 0; m < 4; ++m) asm volatile("" : "+v"(acc[m][0]), "+v"(acc[m][1]));
    } else {
#pragma unroll
        for (int m = 0; m < 4; ++m)
#pragma unroll
            for (int n = 0; n < 2; ++n)
#pragma unroll
                for (int k = 0; k < 2; ++k) acc[m][n] = __builtin_amdgcn_mfma_f32_16x16x32_bf16(Bt[n][k], At[m][k], acc[m][n], 0, 0, 0);
    }
    __builtin_amdgcn_s_setprio(0);
}
template <class Epi, class Sched, bool ALIGN_EPI = true, bool SP2 = true, int QM = 0>
__device__ __forceinline__ void gemm_phase(PG8_LAS unsigned char* lds, const int K, const int lda, const int ldb, const size_t kstepA, const Sched& S, const Epi& E, const int wsc = 127) {
    const int tid_ = opaque_tid();
    const int tid = tid_, wid = __builtin_amdgcn_readfirstlane(tid >> 6), lane = tid & 63, wr = wid >> 2, wc = wid & 3, fr = lane & 15, fq = lane >> 4;
    const int nt = K / BK;
    unsigned voffA[2], voffB[2];
#pragma unroll
    for (int i = 0; i < 2; ++i) { int R, C; stage_rc(tid * 16 + i * 8192, R, C); const int Rb = Epi::PERM ? ((R & ~31) + perm32(R & 31)) : R;
        voffA[i] = (unsigned)(R * lda + C) * 2u; voffB[i] = (unsigned)(Rb * ldb + C) * 2u; }
    const size_t kstepB = (size_t)(BK * 2);
    const size_t hstepA = (size_t)HALF * lda * 2, hstepB = (size_t)HALF * ldb * 2;
    const unsigned ldsw = (unsigned)wid * 1024u;
    int aoffk[2], boffk[2];
#pragma unroll
    for (int k = 0; k < 2; ++k) { const int col = (QM == 1) ? ((fq >> 1) * 32 + (fq & 1) * 16 + 8 * k) : (k * 32 + fq * 8); aoffk[k] = lds_byte(wr * 64 + fr, col); boffk[k] = lds_byte(wc * 32 + fr, col); }
#define PG8_SA(b, h) (((b) * 2 + (h)) * HTB)
#define PG8_SB(b, h) ((4 + (b) * 2 + (h)) * HTB)
#define PG8_STAGE(bufoff, gbase, voff) do { _Pragma("unroll") for (int _i = 0; _i < 2; ++_i) \
        __builtin_amdgcn_global_load_lds((const unsigned*)((const char*)(gbase) + (voff)[_i]), (PG8_LAS unsigned*)(lds + (bufoff) + ldsw + _i * 8192), 16, 0, 0); } while (0)
#define PG8_LDA(dst, b, h) do { _Pragma("unroll") for (int m = 0; m < 4; ++m) _Pragma("unroll") for (int k = 0; k < 2; ++k) dst[m][k] = *(const PG8_LAS bf16x8*)(lds + PG8_SA(b, h) + ((QM == 1) ? aoffk[k] : aoffk[0] + k * 1024) + m * 2048); } while (0)
#define PG8_LDB(dst, b, h) do { _Pragma("unroll") for (int n = 0; n < 2; ++n) _Pragma("unroll") for (int k = 0; k < 2; ++k) dst[n][k] = *(const PG8_LAS bf16x8*)(lds + PG8_SB(b, h) + ((QM == 1) ? boffk[k] : boffk[0] + k * 1024) + n * 2048); } while (0)
#define PG8_MMA(ai, bj, At, Bt) mma_block<QM>(acc[ai][bj], At, Bt, wsc)
#define PG8_WAIT_V(n) asm volatile("s_waitcnt vmcnt(" #n ")" ::: "memory")
#define PG8_WAIT_L(n) asm volatile("s_waitcnt lgkmcnt(" #n ")" ::: "memory")
#define PG8_BAR __builtin_amdgcn_s_barrier()
#define PG8_SCHED __builtin_amdgcn_sched_barrier(0)
    Unit cur, nxt; int ui = 0;
    if (!S.next(0, cur)) return;
    f32x4 acc[2][2][4][2];
#pragma unroll
    for (int a = 0; a < 2; ++a)
#pragma unroll
        for (int b = 0; b < 2; ++b)
#pragma unroll
            for (int m = 0; m < 4; ++m)
#pragma unroll
                for (int n = 0; n < 2; ++n) acc[a][b][m][n] = (f32x4){0.f, 0.f, 0.f, 0.f};
    bf16x8 At[4][2], B0[2][2], B1[2][2];
    const char* cA = S.a_ptr(cur); const char* cB = S.b_ptr(cur);
    if constexpr (SP2) {
        PG8_STAGE(PG8_SB(0, 0), cB, voffB); PG8_STAGE(PG8_SB(0, 1), cB + hstepB, voffB); PG8_STAGE(PG8_SA(0, 0), cA, voffA); PG8_STAGE(PG8_SA(0, 1), cA + hstepA, voffA);
        if (wr == 1) PG8_BAR;
        PG8_WAIT_V(2); PG8_BAR;
        PG8_STAGE(PG8_SB(1, 0), cB + kstepB, voffB); PG8_STAGE(PG8_SA(1, 0), cA + kstepA, voffA); PG8_STAGE(PG8_SB(1, 1), cB + hstepB + kstepB, voffB);
        PG8_WAIT_V(6); PG8_BAR;
    } else {
        PG8_STAGE(PG8_SB(0, 0), cB, voffB); PG8_STAGE(PG8_SA(0, 0), cA, voffA); PG8_STAGE(PG8_SB(0, 1), cB + hstepB, voffB); PG8_STAGE(PG8_SA(0, 1), cA + hstepA, voffA);
        if (wr == 1) PG8_BAR;
        PG8_WAIT_V(4); PG8_BAR;
        PG8_STAGE(PG8_SB(1, 0), cB + kstepB, voffB); PG8_STAGE(PG8_SA(1, 0), cA + kstepA, voffA); PG8_STAGE(PG8_SB(1, 1), cB + hstepB + kstepB, voffB);
        PG8_WAIT_V(6); PG8_BAR;
    }
    for (;;) {
        const bool has_next = S.next(ui + 1, nxt);
        const char* nA = has_next ? S.a_ptr(nxt) : cA; const char* nB = has_next ? S.b_ptr(nxt) : cB;
        for (int t = 0; t < nt; t += 2) {
            const bool last = (t == nt - 2);
            const char* a1 = cA + (size_t)(t + 1) * kstepA;
            const char* a2 = last ? nA : cA + (size_t)(t + 2) * kstepA; const char* b2 = last ? nB : cB + (size_t)(t + 2) * kstepB;
            const char* a3 = a2 + kstepA; const char* b3 = b2 + kstepB;
            if constexpr (SP2) {
            PG8_LDB(B0, 0, 0); PG8_LDB(B1, 0, 1); PG8_SCHED; PG8_LDA(At, 0, 0); PG8_STAGE(PG8_SA(1, 1), a1 + hstepA, voffA);
            PG8_WAIT_V(8); PG8_WAIT_L(0); PG8_BAR; PG8_MMA(0, 0, At, B0); PG8_MMA(0, 1, At, B1); PG8_BAR; PG8_SCHED;
            PG8_LDA(At, 0, 1); PG8_STAGE(PG8_SB(0, 0), b2, voffB); PG8_STAGE(PG8_SB(0, 1), b2 + hstepB, voffB); PG8_STAGE(PG8_SA(0, 0), a2, voffA);
            PG8_WAIT_V(8); PG8_WAIT_L(0); PG8_BAR; PG8_MMA(1, 0, At, B0); PG8_MMA(1, 1, At, B1); PG8_BAR; PG8_SCHED;
            PG8_LDB(B0, 1, 0); PG8_LDB(B1, 1, 1); PG8_SCHED; PG8_LDA(At, 1, 0); PG8_STAGE(PG8_SA(0, 1), a2 + hstepA, voffA);
            PG8_WAIT_V(8); PG8_WAIT_L(0); PG8_BAR; PG8_MMA(0, 0, At, B0); PG8_MMA(0, 1, At, B1); PG8_BAR; PG8_SCHED;
            PG8_LDA(At, 1, 1); PG8_STAGE(PG8_SB(1, 0), b3, voffB); PG8_STAGE(PG8_SB(1, 1), b3 + hstepB, voffB); PG8_STAGE(PG8_SA(1, 0), a3, voffA);
            PG8_WAIT_V(8); PG8_WAIT_L(0); PG8_BAR; PG8_MMA(1, 0, At, B0); PG8_MMA(1, 1, At, B1); PG8_BAR; PG8_SCHED;
            } else {
            PG8_LDB(B0, 0, 0); PG8_SCHED; PG8_LDA(At, 0, 0); PG8_STAGE(PG8_SA(1, 1), a1 + hstepA, voffA);
            PG8_WAIT_L(8); PG8_BAR; PG8_WAIT_L(0); PG8_MMA(0, 0, At, B0); PG8_BAR; PG8_SCHED;
            PG8_LDB(B1, 0, 1); PG8_STAGE(PG8_SB(0, 0), b2, voffB);
            PG8_BAR; PG8_WAIT_L(0); PG8_MMA(0, 1, At, B1); PG8_BAR;
            PG8_LDA(At, 0, 1); PG8_STAGE(PG8_SA(0, 0), a2, voffA);
            PG8_BAR; PG8_WAIT_L(0); PG8_MMA(1, 0, At, B0); PG8_BAR; PG8_SCHED;
            PG8_STAGE(PG8_SB(0, 1), b2 + hstepB, voffB);
            PG8_WAIT_V(6); PG8_BAR; PG8_MMA(1, 1, At, B1); PG8_BAR;
            PG8_LDB(B0, 1, 0); PG8_SCHED; PG8_LDA(At, 1, 0); PG8_STAGE(PG8_SA(0, 1), a2 + hstepA, voffA);
            PG8_WAIT_L(8); PG8_BAR; PG8_WAIT_L(0); PG8_MMA(0, 0, At, B0); PG8_BAR; PG8_SCHED;
            PG8_LDB(B1, 1, 1); PG8_STAGE(PG8_SB(1, 0), b3, voffB);
            PG8_BAR; PG8_WAIT_L(0); PG8_MMA(0, 1, At, B1); PG8_BAR;
            PG8_LDA(At, 1, 1); PG8_STAGE(PG8_SA(1, 0), a3, voffA);
            PG8_BAR; PG8_WAIT_L(0); PG8_MMA(1, 0, At, B0); PG8_BAR; PG8_SCHED;
            PG8_STAGE(PG8_SB(1, 1), b3 + hstepB, voffB);
            PG8_WAIT_V(6); PG8_BAR; PG8_MMA(1, 1, At, B1); PG8_BAR;
            }
        }
        if constexpr (ALIGN_EPI) { if (wr == 0) PG8_BAR; }
        if constexpr (!Epi::AFTER_DRAIN) { E(acc, cur, wr, wc, fr, fq); }
        if (!has_next) break;
#pragma unroll
        for (int a = 0; a < 2; ++a)
#pragma unroll
            for (int b = 0; b < 2; ++b)
#pragma unroll
                for (int m = 0; m < 4; ++m)
#pragma unroll
                    for (int n = 0; n < 2; ++n) acc[a][b][m][n] = (f32x4){0.f, 0.f, 0.f, 0.f};
        cur = nxt; cA = nA; cB = nB; ++ui;
        if constexpr (ALIGN_EPI) { if (wr == 1) PG8_BAR; }
    }
    PG8_WAIT_V(0);
    if constexpr (!ALIGN_EPI) { if (wr == 0) PG8_BAR; }
    PG8_BAR;
    if constexpr (Epi::AFTER_DRAIN) { E.fused(acc, cur, wr, wc, fr, fq, lds, wid, lane); }
#undef PG8_SA
#undef PG8_SB
#undef PG8_STAGE
#undef PG8_LDA
#undef PG8_LDB
#undef PG8_MMA
#undef PG8_WAIT_V
#undef PG8_WAIT_L
#undef PG8_BAR
#undef PG8_SCHED
}
}

__device__ __forceinline__ void phase_headnorm(const Params& p, LAS unsigned char* lds) {
    const int tid = opaque_tid(), lane = tid & 63, wave = tid >> 6;
    LAS int* chunk = (LAS int*)(lds + 131072 - 64);
    bf16_t* Q = (bf16_t*)(p.ws + WS_Q); bf16_t* KVB = (bf16_t*)(p.ws + WS_KVB);
    float qg[16], kg[8];
#pragma unroll
    for (int i = 0; i < 16; ++i) qg[i] = p.q_gain[(lane & 3) * 16 + i] * (0.125f * 1.4426950408889634f);
    const int kr = lane >> 5;
#pragma unroll
    for (int i = 0; i < 8; ++i) kg[i] = p.k_gain[(1 + kr) * 64 + (lane & 7) * 8 + i];
    for (;;) {
      if (tid == 0) *chunk = (int)atomicAdd((unsigned*)(p.ws + WS_CTL) + CW_HN, 1u);
      __syncthreads();
      const int c0 = *chunk;
      __syncthreads();
      if (c0 >= T / 128) break;
      for (int r = c0 * 128 + wave * 16; r < c0 * 128 + wave * 16 + 16; ++r) {
        {
            u32x4* ptr = (u32x4*)(Q + (size_t)r * D + lane * 16); u32x4 w0 = ptr[0], w1 = ptr[1];
            float v[16]; const unsigned ww[8] = {w0.x, w0.y, w0.z, w0.w, w1.x, w1.y, w1.z, w1.w}; float s = 0.f;
#pragma unroll
            for (int i = 0; i < 8; ++i) { v[2 * i] = bflo(ww[i]); v[2 * i + 1] = bfhi(ww[i]); s += v[2 * i] * v[2 * i] + v[2 * i + 1] * v[2 * i + 1]; }
            s += __shfl_xor(s, 1); s += __shfl_xor(s, 2);
            const float rstd = 1.f / sqrtf(s * (1.f / 64.f) + EPS);
            unsigned o[8];
#pragma unroll
            for (int i = 0; i < 8; ++i) o[i] = cvt_pk_bf16(v[2 * i] * rstd * qg[2 * i], v[2 * i + 1] * rstd * qg[2 * i + 1]);
            ptr[0] = (u32x4){o[0], o[1], o[2], o[3]}; ptr[1] = (u32x4){o[4], o[5], o[6], o[7]};
        }
        {
            const u32x4* ptr = (const u32x4*)(KVB + (size_t)r * NKV + (kr ? 1024 : 512) + (lane & 31) * 8); const u32x4 w0 = ptr[0];
            float v[8]; const unsigned ww[4] = {w0.x, w0.y, w0.z, w0.w}; float s = 0.f;
#pragma unroll
            for (int i = 0; i < 4; ++i) { v[2 * i] = bflo(ww[i]); v[2 * i + 1] = bfhi(ww[i]); s += v[2 * i] * v[2 * i] + v[2 * i + 1] * v[2 * i + 1]; }
            s += __shfl_xor(s, 1); s += __shfl_xor(s, 2); s += __shfl_xor(s, 4);
            const float rstd = 1.f / sqrtf(s * (1.f / 64.f) + EPS);
            unsigned o[4];
#pragma unroll
            for (int i = 0; i < 4; ++i) o[i] = cvt_pk_bf16(v[2 * i] * rstd * kg[2 * i], v[2 * i + 1] * rstd * kg[2 * i + 1]);
            const int b = r >> 13, t = r & (S - 1), hg = (lane & 31) >> 3, c = lane & 7;
            {
                bf16_t* dst = (bf16_t*)(p.ws + (kr ? WS_KWB : WS_KSB)) + ((size_t)((b * 4 + hg) * 128 + (t >> 6)) * 8 + c) * 512 + (t & 63) * 8;
                *(u32x4*)dst = (u32x4){o[0], o[1], o[2], o[3]};
            }
        }
      }
    }
}

__device__ __forceinline__ void phase_cmp2(const Params& p, LAS unsigned char* lds) {
    const int tid = opaque_tid(), lane = tid & 63, wave = tid >> 6;
    const int gw = blockIdx.x * NWAVE + wave, NGW = gridDim.x * NWAVE;
    const bf16_t* CMPH = (const bf16_t*)(p.ws + WS_CMPH);
    LAS float* w2l = (LAS float*)lds;
    for (int kv = 0; kv < 2; ++kv) {
        const float* w2 = kv ? p.cmp_v_w2 : p.cmp_k_w2;
        for (int i = tid; i < 256 * 64 / 4; i += NTHR) ((LAS f32x4*)w2l)[i] = ((const f32x4*)w2)[i];
        __syncthreads();
        for (int it = gw * 2; it < 4 * 2048; it += NGW * 2) {
            float hv[2][4], acc[2] = {0.f, 0.f};
#pragma unroll
            for (int rr = 0; rr < 2; ++rr) { const u32x2 w = *(const u32x2*)(CMPH + (size_t)(kv * 8192 + it + rr) * 256 + 4 * lane); hv[rr][0] = bflo(w.x); hv[rr][1] = bfhi(w.x); hv[rr][2] = bflo(w.y); hv[rr][3] = bfhi(w.y); }
#pragma unroll 4
            for (int kk = 0; kk < 64; ++kk)
#pragma unroll
                for (int c = 0; c < 4; ++c) { const float wv = w2l[(4 * kk + c) * 64 + lane];
                    acc[0] += readlane_f(hv[0][c], kk) * wv; acc[1] += readlane_f(hv[1][c], kk) * wv; }
#pragma unroll
            for (int rr = 0; rr < 2; ++rr) {
                const int row = it + rr, g = (row >> 11) & 3, r2 = row & 2047, b = r2 >> 9, n = r2 & 511; float a = n == NC - 1 ? 0.f : acc[rr];
                if (kv == 0) { const float ss = wave_sum(a * a); a = a * (1.f / sqrtf(ss * (1.f / 64.f) + EPS)) * p.k_gain[lane]; }
                const size_t blk0 = (size_t)((b * 4 + g) * 8 + (n >> 6)) * 4096;
                bf16_t* o = kv ? (bf16_t*)(p.ws + WS_VC) + blk0 + ((n & 63) >> 3) * 512 + lane * 8 + (n & 7)
                               : (bf16_t*)(p.ws + WS_KC) + blk0 + (lane >> 3) * 512 + (n & 63) * 8 + (lane & 7);
                *o = (bf16_t)(cvt_pk_bf16(a, 0.f) & 0xffffu);
            }
        }
        __syncthreads();
    }
}

__device__ __forceinline__ void phase_vtrans(const Params& p, LAS unsigned char* lds) {
    const int tid = opaque_tid(), lane = tid & 63, wave = tid >> 6;
    const int gw = blockIdx.x * NWAVE + wave, NGW = gridDim.x * NWAVE;
    LAS unsigned short* tile = (LAS unsigned short*)(lds + wave * 8448);
    const bf16_t* KVB = (const bf16_t*)(p.ws + WS_KVB);
    LAS int* chunk = (LAS int*)(lds + 131072 - 64);
    for (;;) {
        if (tid == 0) *chunk = (int)atomicAdd((unsigned*)(p.ws + WS_CTL) + CW_VT, 1u);
        __syncthreads();
        const int c0 = *chunk;
        __syncthreads();
        if (c0 >= 2 * 16 * 128 / NWAVE) break;
        const int u = c0 * NWAVE + wave;
        const int which = u >> 11, bg = (u >> 7) & 15, tt = u & 127, b = bg >> 2, g = bg & 3, t0 = tt * 64;
        const u32x4* src = (const u32x4*)(KVB + (size_t)(b * S + t0 + lane) * NKV + (which ? 1280 : 768) + g * 64);
#pragma unroll
        for (int i = 0; i < 8; ++i) { const u32x4 v = src[i]; LAS unsigned* tp = (LAS unsigned*)(tile + lane * 66 + 8 * i); tp[0] = v.x; tp[1] = v.y; tp[2] = v.z; tp[3] = v.w; }
        asm volatile("s_waitcnt lgkmcnt(0)" ::: "memory");
        {
            bf16_t* dst = (bf16_t*)(p.ws + (which ? WS_VWB : WS_VSB)) + (size_t)(bg * 128 + tt) * 4096 + lane * 8;
#pragma unroll
            for (int i = 0; i < 8; ++i) { unsigned w[4];
#pragma unroll
                for (int q = 0; q < 4; ++q) { const unsigned lo = tile[(8 * i + 2 * q) * 66 + lane], hi = tile[(8 * i + 2 * q + 1) * 66 + lane]; w[q] = lo | (hi << 16); }
                *(u32x4*)(dst + i * 512) = (u32x4){w[0], w[1], w[2], w[3]}; }
        }
        asm volatile("s_waitcnt lgkmcnt(0)" ::: "memory");
    }
}

typedef short s16x4 __attribute__((ext_vector_type(4)));
__device__ __forceinline__ f32x4 mfma4(s16x4 a, s16x4 b, f32x4 c) { return __builtin_amdgcn_mfma_f32_4x4x4bf16_1k(a, b, c, 0, 0, 0); }
__device__ __forceinline__ s16x4 mk4(unsigned lo, unsigned hi) { const u32x2 t = {lo, hi}; return __builtin_bit_cast(s16x4, t); }
__device__ __forceinline__ f32x4 qk64(const bf16_t* krow, const s16x4 (&qf)[16]) {
    const u32x4* kp = (const u32x4*)krow; u32x4 kr[8];
#pragma unroll
    for (int i = 0; i < 8; ++i) kr[i] = kp[i];
    f32x4 s = {0.f, 0.f, 0.f, 0.f};
#pragma unroll
    for (int c = 0; c < 8; ++c) { s = mfma4(mk4(kr[c].x, kr[c].y), qf[2 * c], s); s = mfma4(mk4(kr[c].z, kr[c].w), qf[2 * c + 1], s); }
    return s;
}
__device__ __forceinline__ void pv64(f32x4& o, const f32x4 e, const bf16_t* vtrow, LAS u32x2* stage, int lane) {
    const u32x4* vp = (const u32x4*)vtrow; u32x4 vr[8];
#pragma unroll
    for (int i = 0; i < 8; ++i) vr[i] = vp[i];
    u32x2 pk; pk.x = cvt_pk_bf16(e.x, e.y); pk.y = cvt_pk_bf16(e.z, e.w);
    stage[lane] = pk;
#pragma unroll
    for (int st = 0; st < 16; ++st) { const u32x2 a = stage[4 * st + (lane & 3)]; const u32x4 v = vr[st >> 1];
        o = mfma4(mk4(a.x, a.y), (st & 1) ? mk4(v.z, v.w) : mk4(v.x, v.y), o); }
}
__device__ __forceinline__ float quadx_sum(float v) { v += __shfl_xor(v, 4); v += __shfl_xor(v, 8); v += __shfl_xor(v, 16); v += __shfl_xor(v, 32); return v; }

constexpr int HBN = 800;
constexpr int ATT_HBD = 0, ATT_MH = 51200, ATT_PSLC = 53248, ATT_STAGE = 118784;
__device__ __forceinline__ void attn_tables(const Params& p, LAS unsigned char* lds) {
    const int tid = opaque_tid();
    LAS float* hbd = (LAS float*)(lds + ATT_HBD); LAS float* mh = (LAS float*)(lds + ATT_MH);
    for (int i = tid; i < 16 * HBN; i += NTHR) { const int hd = i / HBN, d = i - hd * HBN; const float v = p.rel_bias[rel_bucket(d) * NH + hd] * 1.4426950408889634f; hbd[i] = v; if (blockIdx.x == 0) ((float*)(p.ws + WS_HBG))[i] = v; }
    if (tid < 16) { float qg = 0.f, kg = 0.f, bm = -3.0e38f;
        for (int i = 0; i < 64; ++i) qg = fmaxf(qg, fabsf(p.q_gain[i]));
        for (int i = 0; i < 192; ++i) kg = fmaxf(kg, fabsf(p.k_gain[i]));
        for (int i = 0; i < 32; ++i) bm = fmaxf(bm, p.rel_bias[i * NH + tid]);
        const float mv = (qg * kg * 8.f * 1.02f + bm) * 1.4426950408889634f; mh[tid] = mv; if (blockIdx.x == 0) ((float*)(p.ws + WS_MHG))[tid] = mv; }
    __syncthreads();
}
typedef float f32x16 __attribute__((ext_vector_type(16)));
__device__ __forceinline__ f32x16 mfma32(bf16x8 a, bf16x8 b, f32x16 c) { return __builtin_amdgcn_mfma_f32_32x32x16_bf16(a, b, c, 0, 0, 0); }
struct DFrag { bf16x8 ka[4]; bf16x8 va[2][2]; };
__device__ __forceinline__ void dense_load_k(bf16x8 (&ka)[4], const bf16_t* KB, int kt, int l31, int h) {
    const int blk = kt >> 6, hh = (kt >> 5) & 1;
    const bf16_t* kb = KB + (size_t)blk * 4096 + (32 * hh + l31) * 8;
#pragma unroll
    for (int ks = 0; ks < 4; ++ks) ka[ks] = *(const bf16x8*)(kb + (2 * ks + h) * 512);
}
__device__ __forceinline__ void dense_load_v(bf16x8 (&va)[2][2], const bf16_t* VB, int kt, int l31, int h) {
    const int blk = kt >> 6, hh = (kt >> 5) & 1;
    const bf16_t* vb = VB + (size_t)blk * 4096 + l31 * 8 + 4 * h;
#pragma unroll
    for (int dt = 0; dt < 2; ++dt)
#pragma unroll
        for (int st = 0; st < 2; ++st) { const bf16_t* q0 = vb + (4 * hh + 2 * st) * 512 + dt * 256; const u32x2 lo = *(const u32x2*)q0, hi = *(const u32x2*)(q0 + 512);
            const u32x4 w = {lo.x, lo.y, hi.x, hi.y}; va[dt][st] = __builtin_bit_cast(bf16x8, w); }
}
__device__ __forceinline__ f32x16 dense_scores(const DFrag& f, const bf16x8 (&q)[4]) {
    f32x16 sacc;
#pragma unroll
    for (int i = 0; i < 16; ++i) sacc[i] = 0.f;
#pragma unroll
    for (int ks = 0; ks < 4; ++ks) sacc = mfma32(f.ka[ks], q[ks], sacc);
    return sacc;
}
__device__ __forceinline__ void dense_pv(f32x16 (&O)[2], const DFrag& f, const float (&ev)[16]) {
    bf16x8 pb[2];
#pragma unroll
    for (int st = 0; st < 2; ++st) { const u32x4 w = {cvt_pk_bf16(ev[8 * st], ev[8 * st + 1]), cvt_pk_bf16(ev[8 * st + 2], ev[8 * st + 3]), cvt_pk_bf16(ev[8 * st + 4], ev[8 * st + 5]), cvt_pk_bf16(ev[8 * st + 6], ev[8 * st + 7])};
        pb[st] = __builtin_bit_cast(bf16x8, w); }
#pragma unroll
    for (int dt = 0; dt < 2; ++dt)
#pragma unroll
        for (int st = 0; st < 2; ++st) O[dt] = mfma32(f.va[dt][st], pb[st], O[dt]);
}
__device__ __forceinline__ void phase_dense(const Params& p, LAS unsigned char* lds, bf16_t* OW) {
    const int tid = opaque_tid(), lane0 = tid & 63, wave = tid >> 6;
    const LAS float* hbd = (const LAS float*)(lds + ATT_HBD); const LAS float* mh = (const LAS float*)(lds + ATT_MH);
    LAS float* pslc = (LAS float*)(lds + ATT_PSLC) + wave * 2048;
    const bf16_t* Q = (const bf16_t*)(p.ws + WS_Q); const float* GATE = (const float*)(p.ws + WS_GATE);
    short* SEL = (short*)(p.ws + WS_SEL);
    const int Gn = gridDim.x, vcu = (Gn % 8 == 0) ? (blockIdx.x % 8) * (Gn / 8) + blockIdx.x / 8 : blockIdx.x;
    for (int u = vcu * NWAVE + wave; u < T * G / 16; u += Gn * NWAVE) {
        int lane = lane0; asm volatile("" : "+v"(lane));
        const int l31 = lane & 31, h = lane >> 5;
        const int bg = u >> 9, t0 = (((u & 511) + 128 * (u >> 11)) & 511) * 16, b = bg >> 2, g = bg & 3, head = 4 * g + (lane & 3);
        const LAS float* hb = hbd + head * HBN; const float mhv = mh[head];
        int tok[2]; bf16x8 qf[2][4];
#pragma unroll
        for (int r = 0; r < 2; ++r) { tok[r] = t0 + 8 * r + (l31 >> 2); const bf16_t* qp = Q + (size_t)(b * S + tok[r]) * D + head * 64 + 8 * h;
#pragma unroll
            for (int ks = 0; ks < 4; ++ks) qf[r][ks] = *(const bf16x8*)(qp + 16 * ks); }
        f32x16 O[2][2];
#pragma unroll
        for (int r = 0; r < 2; ++r)
#pragma unroll
            for (int dt = 0; dt < 2; ++dt)
#pragma unroll
                for (int q = 0; q < 16; ++q) O[r][dt][q] = 0.f;
        DFrag cur; bf16x8 nxtk[4];
        {
            const bf16_t* KB = (const bf16_t*)(p.ws + WS_KWB) + (size_t)bg * 128 * 4096; const bf16_t* VB = (const bf16_t*)(p.ws + WS_VWB) + (size_t)bg * 128 * 4096;
            float lw[2] = {0.f, 0.f};
            const int lo = t0 - (WIN - 1) > 0 ? t0 - (WIN - 1) : 0, kt_last = t0 & ~31;
            dense_load_k(cur.ka, KB, lo & ~31, l31, h);
            for (int kt = lo & ~31; kt <= kt_last; kt += 32) {
                dense_load_v(cur.va, VB, kt, l31, h);
                dense_load_k(nxtk, KB, kt + 32 <= kt_last ? kt + 32 : kt_last, l31, h);
                __builtin_amdgcn_sched_barrier(0);
#pragma unroll
                for (int r = 0; r < 2; ++r) {
                    const f32x16 sacc = dense_scores(cur, qf[r]);
                    const int dbase = tok[r] - kt - 4 * h; float ev[16];
                    if (kt + 31 <= t0 + 8 * r && kt >= t0 + 8 * r + 7 - (WIN - 1)) {
                        const LAS float* hbp = hb + dbase;
#pragma unroll
                        for (int q = 0; q < 16; ++q) { const float e = __builtin_amdgcn_exp2f(sacc[q] + hbp[-((q & 3) + 8 * (q >> 2))] - mhv); ev[q] = e; lw[r] += e; }
                    } else {
#pragma unroll
                    for (int q = 0; q < 16; ++q) { const int dist = dbase - ((q & 3) + 8 * (q >> 2)); const bool ok = (unsigned)dist < (unsigned)WIN;
                        const float e0 = __builtin_amdgcn_exp2f(sacc[q] + hb[ok ? dist : 0] - mhv); const float e = ok ? e0 : 0.f; ev[q] = e; lw[r] += e; }
                    }
                    dense_pv(O[r], cur, ev);
                }
#pragma unroll
                for (int ks = 0; ks < 4; ++ks) cur.ka[ks] = nxtk[ks];
            }
#pragma unroll
            for (int r = 0; r < 2; ++r) { const float l = lw[r] + __shfl_xor(lw[r], 32); int tk = tok[r]; asm volatile("" : "+v"(tk)); const float* gp = GATE + (size_t)(b * S + tk) * 48 + head * 3;
                const float sc = gp[2] / (l * gp[0]);
#pragma unroll
                for (int dt = 0; dt < 2; ++dt) O[r][dt] = O[r][dt] * sc; }
        }
        const int ncmax = t0 >> 4;
        {
            int l31c = l31, hc = h; asm volatile("" : "+v"(l31c), "+v"(hc));
            const bf16_t* KB = (const bf16_t*)(p.ws + WS_KC) + (size_t)bg * 8 * 4096; const bf16_t* VB = (const bf16_t*)(p.ws + WS_VC) + (size_t)bg * 8 * 4096;
            float lc[2] = {0.f, 0.f};
            const int kt_last = ncmax > 0 ? ((ncmax - 1) & ~31) : -32;
            if (ncmax > 0) {
                dense_load_k(cur.ka, KB, 0, l31c, hc);
                for (int kt = 0; kt <= kt_last; kt += 32) {
                    dense_load_k(nxtk, KB, kt + 32 <= kt_last ? kt + 32 : kt_last, l31c, hc);
                    __builtin_amdgcn_sched_barrier(0);
#pragma unroll
                    for (int r = 0; r < 2; ++r) {
                        const f32x16 sacc = dense_scores(cur, qf[r]);
                        if (t0 - 31 - 16 * (kt + 31) >= HBN - 1) {
                            const float bfar = hb[HBN - 1] - mhv;
#pragma unroll
                            for (int q = 0; q < 16; ++q) lc[r] += __builtin_amdgcn_exp2f(sacc[q] + bfar);
                        } else {
                        const int dbase = tok[r] - 31 - 16 * (kt + 4 * hc);
#pragma unroll
                        for (int q = 0; q < 16; ++q) { const int dist = dbase - 16 * ((q & 3) + 8 * (q >> 2)); const int di = dist < 0 ? 0 : (dist > HBN - 1 ? HBN - 1 : dist);
                            const float e0 = __builtin_amdgcn_exp2f(sacc[q] + hb[di] - mhv); lc[r] += dist >= 0 ? e0 : 0.f; }
                        }
                    }
#pragma unroll
                    for (int ks = 0; ks < 4; ++ks) cur.ka[ks] = nxtk[ks];
                }
            }
            float linv[2];
#pragma unroll
            for (int r = 0; r < 2; ++r) { const float l = lc[r] + __shfl_xor(lc[r], 32); linv[r] = l > 0.f ? 1.f / l : 0.f; }
            { const f32x4 z = {0.f, 0.f, 0.f, 0.f};
#pragma unroll
              for (int i = 0; i < 8; ++i) *(LAS f32x4*)(pslc + (i * 64 + lane) * 4) = z; }
            if (ncmax > 0) {
                float carry[2] = {0.f, 0.f};
                dense_load_k(cur.ka, KB, 0, l31c, hc);
                for (int kt = 0; kt <= kt_last; kt += 32) {
                    dense_load_v(cur.va, VB, kt, l31c, hc);
                    dense_load_k(nxtk, KB, kt + 32 <= kt_last ? kt + 32 : kt_last, l31c, hc);
                    __builtin_amdgcn_sched_barrier(0);
#pragma unroll
                    for (int r = 0; r < 2; ++r) {
                        const f32x16 sacc = dense_scores(cur, qf[r]);
                        float pv[16];
                        const int dbase = tok[r] - 31 - 16 * (kt + 4 * hc);
#pragma unroll
                        for (int q = 0; q < 16; ++q) { const int dist = dbase - 16 * ((q & 3) + 8 * (q >> 2)); const int di = dist < 0 ? 0 : (dist > HBN - 1 ? HBN - 1 : dist);
                            const float e0 = __builtin_amdgcn_exp2f(sacc[q] + hb[di] - mhv); pv[q] = dist >= 0 ? e0 * linv[r] : 0.f; }
                        dense_pv(O[r], cur, pv);
#pragma unroll
                        for (int q = 0; q < 16; ++q) { pv[q] += __shfl_xor(pv[q], 1); pv[q] += __shfl_xor(pv[q], 2); }
                        float y[4];
#pragma unroll
                        for (int gq = 0; gq < 4; ++gq) y[gq] = __shfl_xor(pv[4 * gq + 3], 32);
#pragma unroll
                        for (int gq = 0; gq < 4; ++gq) { const float prevv = h ? y[gq] : (gq > 0 ? y[gq > 0 ? gq - 1 : 0] : carry[r]);
                            const float val = 2.f * ((pv[4 * gq] + pv[4 * gq + 1]) + pv[4 * gq + 2]) + pv[4 * gq + 3] + prevv;
                            if ((lane & 3) == 0) pslc[(8 * r + (l31c >> 2)) * 128 + (kt >> 2) + 2 * gq + hc] = val; }
                        carry[r] = y[3];
                    }
#pragma unroll
                    for (int ks = 0; ks < 4; ++ks) cur.ka[ks] = nxtk[ks];
                }
            }
        }
#pragma unroll
        for (int r = 0; r < 2; ++r) { int tk = tok[r]; asm volatile("" : "+v"(tk)); bf16_t* op = OW + (size_t)(b * S + tk) * D + head * 64 + 4 * h; const float gc = GATE[(size_t)(b * S + tk) * 48 + head * 3];
#pragma unroll
            for (int dt = 0; dt < 2; ++dt)
#pragma unroll
                for (int gq = 0; gq < 4; ++gq) { u32x2 w; w.x = cvt_pk_bf16(O[r][dt][4 * gq] * gc, O[r][dt][4 * gq + 1] * gc); w.y = cvt_pk_bf16(O[r][dt][4 * gq + 2] * gc, O[r][dt][4 * gq + 3] * gc);
                    *(u32x2*)(op + dt * 32 + 8 * gq) = w; } }
#pragma unroll 1
        for (int tl = 0; tl < 16; ++tl) {
            int ln = lane; asm volatile("" : "+v"(ln));
            const int t = t0 + tl, cur_b = t >> 6, j0 = ln, j1 = ln + 64;
            const float c0 = pslc[tl * 128 + j0], c1 = pslc[tl * 128 + j1];
            const bool f0 = (j0 == 0) || (j0 == cur_b) || (j0 == cur_b - 1), f1 = (j1 == cur_b) || (j1 == cur_b - 1);
            const bool v0 = j0 * 64 <= t, v1 = j1 * 64 <= t;
            const unsigned u0 = (v0 && !f0) ? __float_as_uint(c0) : 0u, u1 = (v1 && !f1) ? __float_as_uint(c1) : 0u;
            unsigned th = 1u;
            if (cur_b + 1 > NSEL) {
                th = 0u;
#pragma unroll 1
                for (int bit = 30; bit >= 0; --bit) {
                    const unsigned trial = th | (1u << bit);
                    const int cnt = __popcll(__ballot(u0 >= trial)) + __popcll(__ballot(u1 >= trial));
                    if (cnt >= NSEL - 3) { th = trial; if (cnt == NSEL - 3) break; }
                }
            }
            const bool s0 = f0 || (u0 >= th && u0 != 0u), s1 = f1 || (u1 >= th && u1 != 0u);
            const unsigned long long m0 = __ballot(s0), m1 = __ballot(s1), lt = (1ull << ln) - 1ull;
            const int p0 = __popcll(m0 & lt), p1 = __popcll(m0) + __popcll(m1 & lt);
            short* so = SEL + ((size_t)(b * S + t) * 4 + g) * NSEL;
            if (s0 && p0 < NSEL) so[p0] = (short)j0;
            if (s1 && p1 < NSEL) so[p1] = (short)j1;
        }
    }
}

constexpr int ST_ACC = 0, ST_LACC = 133120, ST_MASK = 135168, ST_LIST = 136192, ST_CTR = 138240, ST_HB4 = 138304;
__device__ __forceinline__ void lds_add_f64(unsigned addr, double v) { asm volatile("ds_add_f64 %0, %1" :: "v"(addr), "v"(v) : "memory"); }
__device__ __forceinline__ void phase_sel_tile(const Params& p, LAS unsigned char* lds, bf16_t* AO, const bf16_t* OW) {
    const int tid = opaque_tid(), lane = tid & 63, wave = tid >> 6, l31 = lane & 31, h = lane >> 5;
    LAS double* acc = (LAS double*)(lds + ST_ACC); LAS double* lacc = (LAS double*)(lds + ST_LACC);
    LAS unsigned* mask = (LAS unsigned*)(lds + ST_MASK); LAS int* list = (LAS int*)(lds + ST_LIST) + wave * 64; LAS int* ctr = (LAS int*)(lds + ST_CTR);
    const bf16_t* Q = (const bf16_t*)(p.ws + WS_Q); const float* GATE = (const float*)(p.ws + WS_GATE); const short* SEL = (const short*)(p.ws + WS_SEL);
    const int Gn = gridDim.x;
    for (int kk = 0, u = blockIdx.x; u < 16 * 128; u += Gn, ++kk) {
        const int bg = u >> 7, ti = u & 127, tt = (kk & 1) ? 127 - ti : ti, b = bg >> 2, g = bg & 3, t0 = tt * 64, cur = tt, nv = cur + 1 < NSEL ? cur + 1 : NSEL;
        for (int i = tid; i < ST_LIST / 16; i += NTHR) ((LAS u32x4*)lds)[i] = (u32x4){0u, 0u, 0u, 0u};
        if (tid == 0) *ctr = 0;
        { LAS float* hb4 = (LAS float*)(lds + ST_HB4); const float* hsrc = (const float*)(p.ws + WS_HBG) + 4 * g * HBN; for (int i = tid; i < 4 * HBN; i += NTHR) hb4[i] = hsrc[i]; }
        __syncthreads();
        { const int tl = tid >> 3; const short* sp = SEL + ((size_t)(b * S + t0 + tl) * 4 + g) * NSEL;
#pragma unroll
          for (int e = (tid & 7) * 2; e < (tid & 7) * 2 + 2; ++e) if (e < nv) { const int blk = sp[e]; __hip_atomic_fetch_or(mask + blk * 2 + (tl >> 5), 1u << (tl & 31), __ATOMIC_RELAXED, __HIP_MEMORY_SCOPE_WORKGROUP); } }
        __syncthreads();
        const int nf = cur >= 2 ? 3 : cur + 1, nitems = 2 * nf + (cur >= 3 ? cur - 2 : 0);
        const bf16_t* KB = (const bf16_t*)(p.ws + WS_KSB) + (size_t)bg * 128 * 4096; const bf16_t* VB = (const bf16_t*)(p.ws + WS_VSB) + (size_t)bg * 128 * 4096;
        const int hl = lane & 3, head = 4 * g + hl;
        const LAS float* hbg = (const LAS float*)(lds + ST_HB4) + hl * HBN; const float mhv = ((const float*)(p.ws + WS_MHG))[head], bfar = hbg[HBN - 1] - mhv;
        for (;;) {
            int it = 0; if (lane == 0) it = __hip_atomic_fetch_add(ctr, 1, __ATOMIC_RELAXED, __HIP_MEMORY_SCOPE_WORKGROUP);
            it = __builtin_amdgcn_readfirstlane(it);
            if (it >= nitems) break;
            int j, c_lo, c_hi;
            if (it < 2 * nf) { const int f = it >> 1; j = f == 0 ? cur : (f == 1 ? cur - 1 : 0); c_lo = (it & 1) * 4; c_hi = c_lo + 4; }
            else { j = it - 2 * nf + 1; c_lo = 0; c_hi = 8; }
            const unsigned mlo = (unsigned)__builtin_amdgcn_readfirstlane((int)mask[2 * j]), mhi = (unsigned)__builtin_amdgcn_readfirstlane((int)mask[2 * j + 1]);
            const unsigned long long m = ((unsigned long long)mhi << 32) | mlo; const int n = __popcll(m), nch = (n + 7) >> 3;
            if (c_hi > nch) c_hi = nch;
            if (c_lo >= c_hi) continue;
            if ((m >> lane) & 1ull) list[__popcll(m & ((1ull << lane) - 1ull))] = lane;
            DFrag fr0, fr1;
            dense_load_k(fr0.ka, KB, j * 64, l31, h); dense_load_v(fr0.va, VB, j * 64, l31, h);
            dense_load_k(fr1.ka, KB, j * 64 + 32, l31, h); dense_load_v(fr1.va, VB, j * 64 + 32, l31, h);
            bf16x8 qn[4];
            { const int slot = c_lo * 8 + (l31 >> 2); const int tokl = list[slot < n ? slot : n - 1]; const bf16_t* qp = Q + (size_t)(b * S + t0 + tokl) * D + head * 64 + 8 * h;
#pragma unroll
              for (int ks = 0; ks < 4; ++ks) qn[ks] = *(const bf16x8*)(qp + 16 * ks); }
            for (int c = c_lo; c < c_hi; ++c) {
                const int slot = c * 8 + (l31 >> 2); const bool valid = slot < n; const int tokl = list[valid ? slot : n - 1], tok = t0 + tokl;
                bf16x8 qf[4];
#pragma unroll
                for (int ks = 0; ks < 4; ++ks) qf[ks] = qn[ks];
                { const int sn = (c + 1 < c_hi ? c + 1 : c) * 8 + (l31 >> 2); const int tn = list[sn < n ? sn : n - 1]; const bf16_t* qp = Q + (size_t)(b * S + t0 + tn) * D + head * 64 + 8 * h;
#pragma unroll
                  for (int ks = 0; ks < 4; ++ks) qn[ks] = *(const bf16x8*)(qp + 16 * ks); }
                __builtin_amdgcn_sched_barrier(0);
                f32x16 O[2]; float ls = 0.f;
#pragma unroll
                for (int dt = 0; dt < 2; ++dt)
#pragma unroll
                    for (int q = 0; q < 16; ++q) O[dt][q] = 0.f;
#pragma unroll
                for (int half = 0; half < 2; ++half) {
                    const int kt = j * 64 + 32 * half; const DFrag& fr = half ? fr1 : fr0;
                    const f32x16 sacc = dense_scores(fr, qf); float ev[16];
                    if (t0 - kt - 31 >= HBN - 1) {
#pragma unroll
                        for (int q = 0; q < 16; ++q) { ev[q] = __builtin_amdgcn_exp2f(sacc[q] + bfar); ls += ev[q]; }
                    } else { const int dbase = tok - kt - 4 * h;
#pragma unroll
                        for (int q = 0; q < 16; ++q) { const int dist = dbase - ((q & 3) + 8 * (q >> 2)); const int di = dist < 0 ? 0 : (dist > HBN - 1 ? HBN - 1 : dist);
                            const float e0 = __builtin_amdgcn_exp2f(sacc[q] + hbg[di] - mhv); ev[q] = dist >= 0 ? e0 : 0.f; ls += ev[q]; } }
                    dense_pv(O, fr, ev);
                }
                const float lt = ls + __shfl_xor(ls, 32);
                if (valid) {
                    const unsigned a0 = (unsigned)(size_t)(acc + (tokl * 4 + hl) * 65 + 4 * h);
#pragma unroll
                    for (int dt = 0; dt < 2; ++dt)
#pragma unroll
                        for (int q = 0; q < 16; ++q) lds_add_f64(a0 + (dt * 32 + (q & 3) + 8 * (q >> 2)) * 8, (double)O[dt][q]);
                    if (h == 0) lds_add_f64((unsigned)(size_t)(lacc + tokl * 4 + hl), (double)lt);
                }
            }
        }
        __syncthreads();
        for (int r0 = wave * 32; r0 < wave * 32 + 32; r0 += 8) {
            float gv[8], ov[8];
#pragma unroll
            for (int i = 0; i < 8; ++i) { const int r = r0 + i, tokl = r >> 2, hd = r & 3; const size_t ur = (size_t)(b * S + t0 + tokl);
                gv[i] = GATE[ur * 48 + (4 * g + hd) * 3 + 1]; ov[i] = bf2f(OW[ur * D + (4 * g + hd) * 64 + lane]); }
#pragma unroll
            for (int i = 0; i < 8; ++i) { const int r = r0 + i, tokl = r >> 2, hd = r & 3; const size_t ur = (size_t)(b * S + t0 + tokl);
                const float o = (float)acc[r * 65 + lane] * (1.f / (float)lacc[r]) * gv[i] + ov[i];
                AO[ur * D + (4 * g + hd) * 64 + lane] = (bf16_t)(cvt_pk_bf16(o, 0.f) & 0xffffu); }
        }
        __syncthreads();
    }
}

__device__ __forceinline__ void moe_pstarts(const unsigned* ctl, int (&pst)[NE + 1]) {
    int a = 0;
#pragma unroll
    for (int e = 0; e < NE; ++e) { pst[e] = a; const int c = (int)ctl[CW_CNT + 64 * e]; a += (c + 511) / 512 * 512; }
    pst[NE] = a;
}
__device__ __forceinline__ void phase_moe_sort(const Params& p, LAS unsigned char* lds) {
    const int tid = opaque_tid(), lane = tid & 63, wave = tid >> 6;
    unsigned* ctl = (unsigned*)(p.ws + WS_CTL);
    const int* TOPE = (const int*)(p.ws + WS_TOPE); int* RPOS = (int*)(p.ws + WS_RPOS);
    const bf16_t* HB = (const bf16_t*)(p.ws + WS_HB); bf16_t* XS = (bf16_t*)(p.ws + WS_XS);
    LAS int* wcnt = (LAS int*)lds;
    LAS int* base = (LAS int*)(lds + 128);
    LAS int* posl = (LAS int*)(lds + 256);
    int pst[NE + 1]; moe_pstarts(ctl, pst);
    if (blockIdx.x == 0 && tid <= NE) ((int*)(ctl + 256))[tid] = pst[tid];
    for (int c0 = blockIdx.x * 256; c0 < 2 * T; c0 += gridDim.x * 256) {
        int e = 0, rank = 0;
        if (wave < 4) { e = TOPE[c0 + wave * 64 + lane];
#pragma unroll
            for (int q = 0; q < NE; ++q) { const unsigned long long m = __ballot(e == q); if (e == q) rank = __popcll(m & ((1ull << lane) - 1ull)); if (lane == 0) wcnt[wave * NE + q] = __popcll(m); } }
        __syncthreads();
        if (tid < NE) { const int n = wcnt[tid] + wcnt[NE + tid] + wcnt[2 * NE + tid] + wcnt[3 * NE + tid]; base[tid] = n ? (int)atomicAdd(ctl + CW_CUR + 64 * tid, (unsigned)n) : 0; }
        __syncthreads();
        if (wave < 4) { int off = 0;
            for (int w = 0; w < wave; ++w) off += wcnt[w * NE + e];
            const int pos = pst[e] + base[e] + off + rank; posl[wave * 64 + lane] = pos; RPOS[c0 + wave * 64 + lane] = pos; }
        __syncthreads();
        for (int j = wave * 32; j < wave * 32 + 32; j += 8) {
            u32x4 v0[8]; int ps[8];
#pragma unroll
            for (int q = 0; q < 8; ++q) { const int tk = (c0 + j + q) >> 1; ps[q] = posl[j + q]; v0[q] = *((const u32x4*)((const unsigned char*)HB + (size_t)tk * D) + lane); }
#pragma unroll
            for (int q = 0; q < 8; ++q) *((u32x4*)((unsigned char*)XS + (size_t)ps[q] * D) + lane) = v0[q];
        }
        __syncthreads();
    }
}
__device__ __forceinline__ void phase_combine(const Params& p) {
    const int tid = opaque_tid(), lane = tid & 63, wave = tid >> 6;
    const int gw = blockIdx.x * NWAVE + wave, NGW = gridDim.x * NWAVE;
    const float* TOPW = (const float*)(p.ws + WS_TOPW); const int* RPOS = (const int*)(p.ws + WS_RPOS);
    const bf16_t* Y = (const bf16_t*)(p.ws + WS_Y); const float* g2 = (const float*)(p.ws + WS_MODV) + (11 * 4) * D;
    for (int r = gw; r < T; r += NGW) {
        const int b = r >> 13; const int p0 = RPOS[2 * r], p1 = RPOS[2 * r + 1]; const float w0 = TOPW[2 * r], w1 = TOPW[2 * r + 1];
#pragma unroll
        for (int j = 0; j < 4; ++j) { const int c = 4 * lane + 256 * j;
            const u32x2 y0 = *(const u32x2*)(Y + (size_t)p0 * D + c), y1 = *(const u32x2*)(Y + (size_t)p1 * D + c);
            const f32x4 gv = *(const f32x4*)(g2 + b * D + c); f32x4 xv = *(const f32x4*)(p.out + (size_t)r * D + c);
            f32x4 f; f.x = w0 * bflo(y0.x) + w1 * bflo(y1.x); f.y = w0 * bfhi(y0.x) + w1 * bfhi(y1.x); f.z = w0 * bflo(y0.y) + w1 * bflo(y1.y); f.w = w0 * bfhi(y0.y) + w1 * bfhi(y1.y);
            *(f32x4*)(p.out + (size_t)r * D + c) = xv + gv * f; }
    }
}

#define XB_TMO      128
#define XB_XCNT(j)  (256  + 64 * (j))
#define XB_XSUB(j)  (1280 + 64 * (j))
#define XB_XGEN(j)  (2304 + 64 * (j))
#define XB_TOP      3328
#define XB_TOPGEN   3392
#define XCD_BAR_WORDS 3456
#define XB_SPIN_CAP (1u << 18)
__device__ __forceinline__ unsigned xb_ld(unsigned* p)              { return __hip_atomic_load(p, __ATOMIC_RELAXED, __HIP_MEMORY_SCOPE_AGENT); }
__device__ __forceinline__ unsigned xb_add(unsigned* p, unsigned v) { return __hip_atomic_fetch_add(p, v, __ATOMIC_RELAXED, __HIP_MEMORY_SCOPE_AGENT); }
__device__ __forceinline__ unsigned xb_xcc_id() { return (unsigned)__builtin_amdgcn_s_getreg((3 << 11) | 20) & 0xFu; }
#define XB_SPIN(cond, bar) do { unsigned _sp = 0; while (cond) { __builtin_amdgcn_s_sleep(1); \
    if ((++_sp & 255u) == 0u) { if (xb_ld(&(bar)[XB_TMO])) break; if (_sp > XB_SPIN_CAP) { atomicAdd(&(bar)[XB_TMO], 1u); break; } } } } while (0)
struct XcdBarrier { unsigned* bar; unsigned x; volatile LAS unsigned* st; };
__device__ __forceinline__ XcdBarrier xcd_barrier_post(unsigned* bar, volatile LAS unsigned* st) {
    XcdBarrier b; b.bar = bar; b.x = xb_xcc_id(); b.st = st;
    if (threadIdx.x == 0) (void)xb_add(&bar[XB_XCNT(b.x)], 1u);
    return b;
}
__device__ __forceinline__ void xcd_barrier_complete(unsigned* bar, unsigned x, unsigned& nloc, unsigned& nx) {
    const unsigned G_ = gridDim.x * gridDim.y * gridDim.z;
    unsigned sum, cnt, mine, sp = 0u;
    for (;;) {
        sum = 0u; cnt = 0u; mine = 0u;
#pragma unroll
        for (unsigned j = 0; j < 16; ++j) { const unsigned c = xb_ld(&bar[XB_XCNT(j)]); sum += c; cnt += (c > 0u) ? 1u : 0u; mine = (j == x) ? c : mine; }
        if (sum == G_) break;
        __builtin_amdgcn_s_sleep(1);
        if ((++sp & 255u) == 0u) { if (xb_ld(&bar[XB_TMO])) break; if (sp > XB_SPIN_CAP) { atomicAdd(&bar[XB_TMO], 1u); break; } }
    }
    nloc = mine > 0u ? mine : 1u; nx = cnt > 0u ? cnt : 1u;
}
__device__ __forceinline__ void xcd_barrier(const XcdBarrier& b) {
    asm volatile("s_waitcnt vmcnt(0)" ::: "memory");
    __syncthreads();
    if (threadIdx.x == 0) {
        unsigned* bar = b.bar;
        __builtin_amdgcn_s_waitcnt(0);
        unsigned nloc = b.st[0], nx = b.st[1];
        if (nloc == 0u) { xcd_barrier_complete(bar, b.x, nloc, nx); b.st[0] = nloc; b.st[1] = nx; }
        const unsigned old = xb_add(&bar[XB_XSUB(b.x)], 1u);
        const unsigned gen = old / nloc;
        if (old + 1u == (gen + 1u) * nloc) {
            __builtin_amdgcn_fence(__ATOMIC_RELEASE, "agent");
            asm volatile("s_waitcnt vmcnt(0)" ::: "memory");
            const unsigned og = xb_add(&bar[XB_TOP], 1u);
            const unsigned tg = og / nx;
            if (og + 1u == (tg + 1u) * nx) xb_add(&bar[XB_TOPGEN], 1u);
            else XB_SPIN(xb_ld(&bar[XB_TOPGEN]) == tg, bar);
            __builtin_amdgcn_fence(__ATOMIC_ACQUIRE, "agent");
            xb_add(&bar[XB_XGEN(b.x)], 1u);
            asm volatile("s_waitcnt vmcnt(0)" ::: "memory");
        } else {
            XB_SPIN(xb_ld(&bar[XB_XGEN(b.x)]) == gen, bar);
            __builtin_amdgcn_fence(__ATOMIC_ACQUIRE, "agent");
            asm volatile("s_waitcnt vmcnt(0)" ::: "memory");
        }
    }
    __syncthreads();
}

constexpr int LDS_SCRATCH = 131072, MISC_OFF = 155648, LDS_BYTES = 163840;
#define MODP(which) ((const float*)(p.ws + WS_MODV) + (size_t)(which) * 4 * D)

__global__ void __launch_bounds__(NTHR, 2) k_fused(Params p) {
    extern __shared__ __attribute__((aligned(16))) unsigned char lds_raw[];
    LAS unsigned char* lds = (LAS unsigned char*)lds_raw;
    for (int u = threadIdx.x; u < (LDS_BYTES - LDS_SCRATCH) / 4; u += NTHR) ((LAS unsigned*)(lds + LDS_SCRATCH))[u] = 0u;
    __syncthreads();
    if ((threadIdx.x & 63) == 0) ((LAS int*)(lds + TID_TAB_OFF))[hw_wave_slot()] = (int)(threadIdx.x >> 6);
    __syncthreads();
    const XcdBarrier bar = xcd_barrier_post((unsigned*)(p.ws + WS_CTL) + CW_BAR, (volatile LAS unsigned*)(lds + MISC_OFF) + 8);
#define GRID_BAR() xcd_barrier(bar)
    phase_weights(p, lds); __syncthreads(); phase_modvec(p, lds);
    GRID_BAR();
    phase_convert_fgu(p, lds); __syncthreads();
    phase_poolmix(p, lds, (bf16_t*)(p.ws + WS_HA));
    GRID_BAR();
    { pg8::Sched<1> Sc; Sc.init(T, D, gridDim.x, blockIdx.x, p.ws + WS_HA, p.ws + WO_POOL, D, 256);
      pg8::EpiEl<EpiPool> E{{p.x, (float*)(p.ws + WS_X1), MODP(2), p.pool_scale, 0}};
      pg8::gemm_phase(lds, 256, D, 256, 128, Sc, E); }
    GRID_BAR();
    { NormOut o0{p.norm_g + D, MODP(4), MODP(3), (bf16_t*)(p.ws + WS_HB)}; phase_norm<1, false, 2>(p, lds, (const float*)(p.ws + WS_X1), o0, o0); }
    GRID_BAR();
    { pg8::Sched<0> Sc; Sc.init(T, 2 * FF, gridDim.x, blockIdx.x, p.ws + WS_HB, p.ws + WO_FGU, D / 2, D / 2);
      pg8::EpiPairEl<EpiSwigluI8> E{{(bf16_t*)(p.ws + WS_HID0), FF, (const float*)(p.ws + WS_ASC), (const float*)(p.ws + WS_FGMAX)}};
      pg8::gemm_phase<pg8::EpiPairEl<EpiSwigluI8>, pg8::Sched<0>, true, true, 2>(lds, D / 2, D / 2, D / 2, 128, Sc, E); }
    GRID_BAR();
    { pg8::Sched<0> Sc; Sc.init(T, D, gridDim.x, blockIdx.x, p.ws + WS_HID0, p.ws + WO_FDN, FF, FF);
      pg8::EpiEl<EpiResid> E{{(const float*)(p.ws + WS_X1), (float*)(p.ws + WS_X2), MODP(5)}};
      pg8::gemm_phase(lds, FF, FF, FF, 128, Sc, E); }
    GRID_BAR();
    { NormOut o0{p.kv_norm_g, MODP(13), MODP(12), (bf16_t*)(p.ws + WS_HA)}; NormOut o1{p.norm_g + 2 * D, MODP(7), MODP(6), (bf16_t*)(p.ws + WS_HB)}; phase_norm<2, false>(p, lds, (const float*)(p.ws + WS_X2), o0, o1); }
    GRID_BAR();
    { pg8::Sched<0> Sc; Sc.init(T, NKV, gridDim.x, blockIdx.x, p.ws + WS_HA, p.ws + WO_KV, D, D);
      pg8::EpiEl<EpiBf16> E{{(bf16_t*)(p.ws + WS_KVB), NKV}};
      pg8::gemm_phase(lds, D, D, D, 128, Sc, E); }
    { pg8::Sched<0> Sc; Sc.init(T, D, gridDim.x, blockIdx.x, p.ws + WS_HB, p.ws + WO_Q, D, D);
      pg8::EpiEl<EpiQ> E{{(bf16_t*)(p.ws + WS_Q), (float*)(p.ws + WS_GATE), 0}};
      pg8::gemm_phase(lds, D, D, D, 128, Sc, E); }
    GRID_BAR();
    { pg8::Sched<2> Sc; Sc.init(2048, 2048, gridDim.x, blockIdx.x, p.ws + WS_KVB, p.ws + WO_CK, 16 * NKV, 2048);
      pg8::EpiEl<EpiCmp> E{{(bf16_t*)(p.ws + WS_CMPH), (const float*)(p.ws + WS_CMPB)}};
      pg8::gemm_phase(lds, 2048, 16 * NKV, 2048, (size_t)NKV * 2, Sc, E); }
    { pg8::Sched<0> Sc; Sc.init(T, 256, (int)gridDim.x - 64 > 0 ? (int)gridDim.x - 64 : 1, (int)gridDim.x > 64 ? (int)blockIdx.x - 64 : (int)blockIdx.x, p.ws + WS_HB, p.ws + WO_Q + (size_t)D * D * 2, D, D);
      pg8::EpiEl<EpiQ> E{{(bf16_t*)(p.ws + WS_Q), (float*)(p.ws + WS_GATE), D}};
      pg8::gemm_phase(lds, D, D, D, 128, Sc, E); }
    phase_headnorm(p, lds); phase_vtrans(p, lds);
    GRID_BAR();
    phase_cmp2(p, lds);
    GRID_BAR();
    attn_tables(p, lds);
    phase_dense(p, lds, (bf16_t*)(p.ws + WS_HB));
    GRID_BAR();
    phase_sel_tile(p, lds, (bf16_t*)(p.ws + WS_HA), (const bf16_t*)(p.ws + WS_HB));
    GRID_BAR();
    { pg8::Sched<0> Sc; Sc.init(T, D, gridDim.x, blockIdx.x, p.ws + WS_HA, p.ws + WO_O, D, D);
      pg8::EpiEl<EpiResid> E{{(const float*)(p.ws + WS_X2), p.out, MODP(8)}};
      pg8::gemm_phase(lds, D, D, D, 128, Sc, E); }
    GRID_BAR();
    { NormOut o0{p.norm_g + 3 * D, MODP(10), MODP(9), (bf16_t*)(p.ws + WS_HB)}; phase_norm<1, true, 1>(p, lds, p.out, o0, o0); }
    GRID_BAR();
    phase_moe_sort(p, lds);
    GRID_BAR();
    { const int* pst = (const int*)(p.ws + WS_CTL) + 256;
      pg8::Sched<3> Sc; Sc.init(pst[NE], 2 * FE, gridDim.x, blockIdx.x, p.ws + WS_XS, p.ws + WO_EGU, D / 2, D / 2, pst, (size_t)FE * D);
      pg8::EpiPairEl<EpiSwiglu8> E{{p.ws + WS_HIDM, FE}};
      pg8::gemm_phase<pg8::EpiPairEl<EpiSwiglu8>, pg8::Sched<3>, true, true, 1>(lds, D / 2, D / 2, D / 2, 128, Sc, E, 127 - 5); }
    GRID_BAR();
    { const int* pst = (const int*)(p.ws + WS_CTL) + 256;
      pg8::Sched<3> Sc; Sc.init(pst[NE], D, gridDim.x, blockIdx.x, p.ws + WS_HIDM, p.ws + WO_EDN, FE / 2, FE / 2, pst, (size_t)D * FE / 2);
      pg8::EpiEl<EpiBf16> E{{(bf16_t*)(p.ws + WS_Y), D}};
      pg8::gemm_phase<pg8::EpiEl<EpiBf16>, pg8::Sched<3>, true, true, 1>(lds, FE / 2, FE / 2, FE / 2, 128, Sc, E, 127 - 6); }
    GRID_BAR();
    phase_combine(p);
}

extern "C" void kernel_launch(void* const* d_in, const int* in_sizes, int n_in, void* d_out, int out_size, void* d_ws, size_t ws_size, hipStream_t stream) {
    if (n_in != 28 || out_size != T * D || ws_size < WS_END) { fprintf(stderr, "kernel_launch: unexpected shapes (n_in %d out %d ws %zu need %zu)\n", n_in, out_size, ws_size, (size_t)WS_END); return; }
    static int grid = 0;
    if (grid == 0) {
        int dev = 0, cus = 0, per_cu = 0;
        if (hipGetDevice(&dev) != hipSuccess || hipDeviceGetAttribute(&cus, hipDeviceAttributeMultiprocessorCount, dev) != hipSuccess) { grid = -1; return; }
        if (hipFuncSetAttribute((const void*)k_fused, hipFuncAttributeMaxDynamicSharedMemorySize, LDS_BYTES) != hipSuccess) { grid = -1; return; }
        if (hipOccupancyMaxActiveBlocksPerMultiprocessor(&per_cu, (const void*)k_fused, NTHR, LDS_BYTES) != hipSuccess || per_cu < 1) { fprintf(stderr, "kernel_launch: occupancy query says %d\n", per_cu); }
        (void)hipGetLastError();
        grid = cus;
    }
    if (grid < 0) return;
    Params p{};
    const float** pp = (const float**)&p;
    for (int i = 0; i < 28; ++i) pp[i] = (const float*)d_in[i];
    p.out = (float*)d_out; p.ws = (unsigned char*)d_ws;
    (void)hipMemsetAsync((char*)d_ws + WS_CTL, 0, CTL_BYTES, stream);
    k_fused<<<dim3(grid), dim3(NTHR), LDS_BYTES, stream>>>(p);
}
```

```cpp
#include <hip/hip_runtime.h>
#include <cstdint>
#include <cstdio>

#define LAS __attribute__((address_space(3)))
typedef unsigned short bf16_t;
typedef short bf16x8 __attribute__((ext_vector_type(8)));
typedef float f32x4 __attribute__((ext_vector_type(4)));
typedef float f32x2 __attribute__((ext_vector_type(2)));
typedef unsigned u32x4 __attribute__((ext_vector_type(4)));
typedef unsigned u32x2 __attribute__((ext_vector_type(2)));

constexpr int NB = 4, S = 8192, D = 1024, T = NB * S;
constexpr int FF = 2816, NE = 8, FE = 3584;
constexpr int NKV = 1536, NQP = 1280, NQ = 1072;
constexpr int G = 4, HD = 64, NH = 16;
constexpr int NC = 512;
constexpr int NSB = 128;
constexpr int NSEL = 16;
constexpr int WIN = 512;
constexpr int MOE_ROWS = 69632;
constexpr float EPS = 1e-6f;
constexpr int NTHR = 512, NWAVE = 8;

constexpr size_t MiB = 1u << 20;
constexpr size_t WS_CTL = 0, CTL_BYTES = 1 * MiB;
constexpr size_t WS_MODV = 1 * MiB;
constexpr size_t WS_CMPB = WS_MODV + 14 * 4 * 1024 * 4;
constexpr size_t WS_FGMAX = WS_CMPB + 4096;
constexpr size_t WS_ASC = WS_FGMAX + 2 * FF * 4;
constexpr size_t WS_HBG = 6 * MiB;
constexpr size_t WS_MHG = WS_HBG + 65536;
constexpr size_t WS_TOPE = 2 * MiB;
constexpr size_t WS_TOPW = WS_TOPE + (size_t)T * 8;
constexpr size_t WS_RPOS = WS_TOPW + (size_t)T * 8;
constexpr size_t WS_RTOK = WS_RPOS + (size_t)T * 8;
constexpr size_t WS_SMALL_END = WS_RTOK + (size_t)MOE_ROWS * 4;
static_assert(WS_SMALL_END <= 8 * MiB && WS_ASC + (size_t)T * 4 <= 2 * MiB, "small region");
constexpr size_t WS_W = 8 * MiB;
constexpr size_t WO_POOL = WS_W;
constexpr size_t WO_FGU = WO_POOL + (size_t)4 * 256 * 256 * 2;
constexpr size_t WO_FDN = WO_FGU + (size_t)2 * FF * D * 2;
constexpr size_t WO_KV = WO_FDN + (size_t)D * FF * 2;
constexpr size_t WO_Q = WO_KV + (size_t)NKV * D * 2;
constexpr size_t WO_O = WO_Q + (size_t)NQP * D * 2;
constexpr size_t WO_CK = WO_O + (size_t)D * D * 2;
constexpr size_t WO_CV = WO_CK + (size_t)256 * 2048 * 2;
constexpr size_t WO_EGU = WO_CV + (size_t)256 * 2048 * 2;
constexpr size_t WO_EDN = WO_EGU + (size_t)NE * 2 * FE * D * 2;
constexpr size_t WO_END = WO_EDN + (size_t)NE * D * FE * 2;
static_assert(WO_END <= 203 * MiB, "weights region");
constexpr size_t WS_HB = 203 * MiB;
constexpr size_t WS_X1 = 267 * MiB;
constexpr size_t WS_X2 = 395 * MiB;
constexpr size_t WS_HID0 = 523 * MiB;
constexpr size_t WS_Q = 523 * MiB;
constexpr size_t WS_GATE = 587 * MiB;
constexpr size_t WS_CMPH = 593 * MiB;
constexpr size_t WS_KC = 601 * MiB;
constexpr size_t WS_VC = 602 * MiB;
constexpr size_t WS_KSB = 603 * MiB;
constexpr size_t WS_VSB = 619 * MiB;
constexpr size_t WS_KWB = 635 * MiB;
constexpr size_t WS_VWB = 651 * MiB;
constexpr size_t WS_Q8 = 267 * MiB;
constexpr size_t WS_SEL = 667 * MiB;
constexpr size_t WS_HA = 699 * MiB;
constexpr size_t WS_KVB = 763 * MiB;
constexpr size_t WS_HIDM = 267 * MiB;
constexpr size_t WS_Y = 743 * MiB;
constexpr size_t WS_XS = WS_Y;
constexpr size_t WS_END = 880 * MiB;
static_assert(WS_HIDM + (size_t)MOE_ROWS * FE * 2 <= WS_Y && WS_Y + (size_t)MOE_ROWS * D * 2 <= WS_END, "moe map");
static_assert(WS_KVB + (size_t)T * NKV * 2 + 65536 <= WS_END, "kv map");
constexpr int CW_CNT = 512;
constexpr int CW_CUR = 1024;
constexpr int CW_HN = 2048, CW_VT = 2112;
constexpr int CW_BAR = 4096;

struct Params {
    const float *x, *c, *ada_w, *ada_b, *norm_g, *pool_w, *pool_scale, *q_w, *q_gain, *o_w, *kv_ada_w, *kv_ada_b, *kv_norm_g, *kv_w,
        *cmp_pe_k, *cmp_pe_v, *cmp_k_w1, *cmp_k_w2, *cmp_v_w1, *cmp_v_w2, *k_gain, *rel_bias, *ffn_gu, *ffn_dn, *router_w, *router_b, *exp_gu, *exp_dn;
    float* out; unsigned char* ws;
};

__device__ __forceinline__ unsigned cvt_pk_bf16(float lo, float hi) { unsigned r; asm volatile("v_cvt_pk_bf16_f32 %0, %1, %2" : "=v"(r) : "v"(lo), "v"(hi)); return r; }
__device__ __forceinline__ float bf2f(unsigned short v) { return __uint_as_float((unsigned)v << 16); }
__device__ __forceinline__ float bflo(unsigned w) { return __uint_as_float(w << 16); }
__device__ __forceinline__ float bfhi(unsigned w) { return __uint_as_float(w & 0xffff0000u); }
__device__ __forceinline__ int opaque_tid() { int t = threadIdx.x; asm volatile("" : "+v"(t)); return t; }
__device__ __forceinline__ float readlane_f(float v, int l) { return __uint_as_float((unsigned)__builtin_amdgcn_readlane((int)__float_as_uint(v), l)); }
__device__ __forceinline__ unsigned pack_i8x4(float a, float b, float c, float d) {
    const int ia = (int)__builtin_rintf(fminf(fmaxf(a, -127.f), 127.f)), ib = (int)__builtin_rintf(fminf(fmaxf(b, -127.f), 127.f)), ic = (int)__builtin_rintf(fminf(fmaxf(c, -127.f), 127.f)), id = (int)__builtin_rintf(fminf(fmaxf(d, -127.f), 127.f));
    return (unsigned)(ia & 0xff) | ((unsigned)(ib & 0xff) << 8) | ((unsigned)(ic & 0xff) << 16) | ((unsigned)(id & 0xff) << 24);
}
__device__ __forceinline__ float sel_q_scale(const float* q_gain) { float m = 0.f; for (int i = 0; i < 64; ++i) m = fmaxf(m, fabsf(q_gain[i])); return 127.f / (4.f * m * 0.125f * 1.4426950408889634f); }
__device__ __forceinline__ float sel_k_scale(const float* k_gain) { float m = 0.f; for (int i = 0; i < 64; ++i) m = fmaxf(m, fabsf(k_gain[64 + i])); return 127.f / (4.f * m); }
__device__ __forceinline__ float wave_sum(float v) {
#pragma unroll
    for (int o = 1; o < 64; o <<= 1) v += __shfl_xor(v, o);
    return v;
}
__device__ __forceinline__ float wave_max(float v) {
#pragma unroll
    for (int o = 1; o < 64; o <<= 1) v = fmaxf(v, __shfl_xor(v, o));
    return v;
}
__device__ __forceinline__ float silu_f(float v) { return v * __builtin_amdgcn_rcpf(1.f + __builtin_amdgcn_exp2f(v * -1.4426950408889634f)); }
__device__ __forceinline__ float sigmoid_f(float v) { return __builtin_amdgcn_rcpf(1.f + __builtin_amdgcn_exp2f(v * -1.4426950408889634f)); }
__device__ __forceinline__ float gelu_tanh_f(float v) {
    const float u = 0.7978845608028654f * (v + 0.044715f * v * v * v);
    const float e = __builtin_amdgcn_exp2f(fabsf(u) * -2.8853900817779268f); const float th = (1.f - e) * __builtin_amdgcn_rcpf(1.f + e);
    return 0.5f * v * (1.f + (u < 0.f ? -th : th));
}
__device__ __forceinline__ int rel_bucket(int d) {
    if (d < 16) return d;
    int b = 16;
    b += (d >= 21); b += (d >= 27); b += (d >= 35); b += (d >= 46); b += (d >= 59); b += (d >= 77); b += (d >= 99); b += (d >= 128);
    b += (d >= 166); b += (d >= 216); b += (d >= 280); b += (d >= 363); b += (d >= 470); b += (d >= 609); b += (d >= 790);
    return b;
}

template <bool FP8 = false>
__device__ __forceinline__ void transpose_item(const float* W, int K, int N, bf16_t* WT, int k0, int n0, int drow0, LAS float* scr, int lane, float wscale = 1.f) {
    float wv[32];
#pragma unroll
    for (int i = 0; i < 32; ++i) { const int kk = 2 * i + (lane >> 5); const int n = n0 + (lane & 31); wv[i] = (n < N) ? W[(size_t)(k0 + kk) * N + n] : 0.f; }
#pragma unroll
    for (int i = 0; i < 32; ++i) { const int kk = 2 * i + (lane >> 5); scr[kk * 33 + (lane & 31)] = wv[i]; }
    asm volatile("s_waitcnt lgkmcnt(0)" ::: "memory");
    const int c = lane & 7;
#pragma unroll
    for (int j = 0; j < 4; ++j) { const int n = (lane >> 3) + 8 * j; const LAS float* s = scr + (8 * c) * 33 + n;
        if constexpr (FP8) {
            unsigned w0 = 0u, w1 = 0u;
            w0 = __builtin_amdgcn_cvt_pk_fp8_f32(s[0 * 33] * wscale, s[1 * 33] * wscale, w0, false); w0 = __builtin_amdgcn_cvt_pk_fp8_f32(s[2 * 33] * wscale, s[3 * 33] * wscale, w0, true);
            w1 = __builtin_amdgcn_cvt_pk_fp8_f32(s[4 * 33] * wscale, s[5 * 33] * wscale, w1, false); w1 = __builtin_amdgcn_cvt_pk_fp8_f32(s[6 * 33] * wscale, s[7 * 33] * wscale, w1, true);
            *(u32x2*)((unsigned char*)WT + (size_t)(drow0 + n) * K + k0 + 8 * c) = (u32x2){w0, w1};
        } else {
        u32x4 o; o.x = cvt_pk_bf16(s[0 * 33], s[1 * 33]); o.y = cvt_pk_bf16(s[2 * 33], s[3 * 33]); o.z = cvt_pk_bf16(s[4 * 33], s[5 * 33]); o.w = cvt_pk_bf16(s[6 * 33], s[7 * 33]);
        *(u32x4*)(WT + (size_t)(drow0 + n) * K + k0 + 8 * c) = o; } }
    asm volatile("s_waitcnt lgkmcnt(0)" ::: "memory");
}
template <int MODE, bool FP8 = false>
__device__ __forceinline__ void transpose_mat(const float* W, int K, int N, int NP, int F, bf16_t* WT, int it, LAS float* scr, int lane, float wscale = 1.f) {
    const int nblk = NP / 32, kb = it / nblk, nb = it % nblk, n0 = nb * 32;
    int drow0 = n0;
    if (MODE == 1) { const int up = n0 >= F, j = up ? n0 - F : n0; drow0 = (j >> 7) * 256 + (up ? 128 : 0) + (j & 127); }
    transpose_item<FP8>(W, K, N, WT, kb * 64, n0, drow0, scr, lane, wscale);
}
__device__ __forceinline__ void phase_convert_fgu(const Params& p, LAS unsigned char* lds) {
    const int tid = opaque_tid(), lane = tid & 63, wave = tid >> 6;
    LAS float* scr = (LAS float*)(lds + wave * 16384);
    const int gw = blockIdx.x * NWAVE + wave, NGW = gridDim.x * NWAVE;
    const float* FGMAX = (const float*)(p.ws + WS_FGMAX); unsigned char* WT = p.ws + WO_FGU;
    for (int it = gw; it < 16 * 176; it += NGW) {
        const int kb = it / 176, nb = it % 176, n0 = nb * 32, k0 = kb * 64;
        const int up = n0 >= FF, j0 = up ? n0 - FF : n0, drow0 = (j0 >> 7) * 256 + (up ? 128 : 0) + (j0 & 127);
        float wv[32];
#pragma unroll
        for (int i = 0; i < 32; ++i) wv[i] = p.ffn_gu[(size_t)(k0 + 2 * i + (lane >> 5)) * (2 * FF) + n0 + (lane & 31)];
#pragma unroll
        for (int i = 0; i < 32; ++i) scr[(2 * i + (lane >> 5)) * 33 + (lane & 31)] = wv[i];
        asm volatile("s_waitcnt lgkmcnt(0)" ::: "memory");
        const int c = lane & 7;
#pragma unroll
        for (int j = 0; j < 4; ++j) { const int n = (lane >> 3) + 8 * j; const LAS float* sp = scr + (8 * c) * 33 + n; const float sc = 127.f / FGMAX[n0 + n];
            const unsigned w0 = pack_i8x4(sp[0 * 33] * sc, sp[1 * 33] * sc, sp[2 * 33] * sc, sp[3 * 33] * sc), w1 = pack_i8x4(sp[4 * 33] * sc, sp[5 * 33] * sc, sp[6 * 33] * sc, sp[7 * 33] * sc);
            *(u32x2*)(WT + (size_t)(drow0 + n) * D + k0 + 8 * c) = (u32x2){w0, w1}; }
        asm volatile("s_waitcnt lgkmcnt(0)" ::: "memory");
    }
}
__device__ __forceinline__ void phase_weights(const Params& p, LAS unsigned char* lds) {
    const int tid = opaque_tid(), lane = tid & 63, wave = tid >> 6;
    LAS float* scr = (LAS float*)(lds + wave * 16384);
    const int gw = blockIdx.x * NWAVE + wave, NGW = gridDim.x * NWAVE;
    unsigned char* ws = p.ws;
    constexpr int I_POOL = 4 * 8, I_FGU = 16 * 176, I_FDN = 44 * 32, I_KV = 16 * 48, I_Q = 16 * 40, I_O = 16 * 32, I_C = 32 * 8, I_EGU = 16 * 224, I_EDN = 56 * 32;
    constexpr int TOT = 4 * I_POOL + I_FGU + I_FDN + I_KV + I_Q + I_O + 2 * I_C + NE * I_EGU + NE * I_EDN;
    for (int it = gw; it < TOT; it += NGW) {
        int r = it;
        if (r < 4 * I_POOL) { const int g = r / I_POOL; transpose_mat<0>(p.pool_w + (size_t)g * 65536, 256, 256, 256, 0, (bf16_t*)(ws + WO_POOL) + (size_t)g * 65536, r % I_POOL, scr, lane); continue; } r -= 4 * I_POOL;
        if (r < I_FGU) continue; r -= I_FGU;
        if (r < I_FDN) { transpose_mat<0>(p.ffn_dn, FF, D, D, 0, (bf16_t*)(ws + WO_FDN), r, scr, lane); continue; } r -= I_FDN;
        if (r < I_KV) { transpose_mat<0>(p.kv_w, D, NKV, NKV, 0, (bf16_t*)(ws + WO_KV), r, scr, lane); continue; } r -= I_KV;
        if (r < I_Q) { transpose_mat<0>(p.q_w, D, NQ, NQP, 0, (bf16_t*)(ws + WO_Q), r, scr, lane); continue; } r -= I_Q;
        if (r < I_O) { transpose_mat<0>(p.o_w, D, D, D, 0, (bf16_t*)(ws + WO_O), r, scr, lane); continue; } r -= I_O;
        if (r < I_C) { transpose_mat<0>(p.cmp_k_w1, 2048, 256, 256, 0, (bf16_t*)(ws + WO_CK), r, scr, lane); continue; } r -= I_C;
        if (r < I_C) { transpose_mat<0>(p.cmp_v_w1, 2048, 256, 256, 0, (bf16_t*)(ws + WO_CV), r, scr, lane); continue; } r -= I_C;
        if (r < NE * I_EGU) { const int e = r / I_EGU; transpose_mat<1, true>(p.exp_gu + (size_t)e * D * 2 * FE, D, 2 * FE, 2 * FE, FE, (bf16_t*)(ws + WO_EGU + (size_t)e * 2 * FE * D), r % I_EGU, scr, lane, 32.f); continue; } r -= NE * I_EGU;
        { const int e = r / I_EDN; transpose_mat<0, true>(p.exp_dn + (size_t)e * FE * D, FE, D, D, 0, (bf16_t*)(ws + WO_EDN + (size_t)e * D * FE), r % I_EDN, scr, lane, 64.f); }
    }
}

__device__ __forceinline__ void phase_modvec(const Params& p, LAS unsigned char* lds) {
    const int tid = opaque_tid(), lane = tid & 63, wave = tid >> 6;
    LAS float* part = (LAS float*)lds;
    LAS float* sc_l = (LAS float*)(lds + 8192);
    for (int i = tid; i < 4 * D; i += NTHR) sc_l[i] = silu_f(p.c[i]);
    __syncthreads();
    float* MODV = (float*)(p.ws + WS_MODV);
    float* CMPB = (float*)(p.ws + WS_CMPB);
    { float* FGMAX = (float*)(p.ws + WS_FGMAX);
      for (int u = blockIdx.x; u < 2 * FF / 64; u += gridDim.x) {
        const int col = u * 64 + lane; float m = 0.f;
#pragma unroll 16
        for (int k = wave * 128; k < wave * 128 + 128; ++k) m = fmaxf(m, fabsf(p.ffn_gu[(size_t)k * (2 * FF) + col]));
        part[wave * 64 + lane] = m;
        __syncthreads();
        if (tid < 64) { float mm = part[lane];
#pragma unroll
            for (int w = 1; w < 8; ++w) mm = fmaxf(mm, part[w * 64 + lane]);
            FGMAX[u * 64 + lane] = fmaxf(mm, 1e-30f); }
        __syncthreads();
      } }
    constexpr int NU_MOD = 14336 / 64, NU = NU_MOD + 8;
    for (int u = blockIdx.x; u < NU; u += gridDim.x) {
        float acc[4] = {0.f, 0.f, 0.f, 0.f};
        if (u < NU_MOD) {
            const int gc = u * 64 + lane;
            const float* W; int ldw, col;
            if (gc < 6144) { W = p.ada_w; ldw = 6144; col = gc; } else if (gc < 12288) { W = p.ada_w + (size_t)D * 6144; ldw = 6144; col = gc - 6144; } else { W = p.kv_ada_w; ldw = 2048; col = gc - 12288; }
#pragma unroll 16
            for (int k = wave * 128; k < wave * 128 + 128; ++k) {
                const float w = W[(size_t)k * ldw + col];
#pragma unroll
                for (int b = 0; b < 4; ++b) acc[b] += sc_l[b * D + k] * w;
            }
        } else {
            const int cu = u - NU_MOD, kv = cu >> 2, col = (cu & 3) * 64 + lane;
            const float* W = kv ? p.cmp_v_w1 : p.cmp_k_w1; const float* pe = kv ? p.cmp_pe_v : p.cmp_pe_k;
#pragma unroll 16
            for (int k = wave * 256; k < wave * 256 + 256; ++k) acc[0] += pe[k] * W[(size_t)k * 256 + col];
        }
#pragma unroll
        for (int b = 0; b < 4; ++b) part[(wave * 4 + b) * 64 + lane] = acc[b];
        __syncthreads();
        if (tid < 256) {
            const int b = tid >> 6; float s = 0.f;
#pragma unroll
            for (int w = 0; w < 8; ++w) s += part[(w * 4 + b) * 64 + lane];
            if (u < NU_MOD) {
                const int gc = u * 64 + lane; int which, n; float bias;
                if (gc < 6144) { which = gc >> 10; n = gc & 1023; bias = p.ada_b[gc]; } else if (gc < 12288) { which = 6 + ((gc - 6144) >> 10); n = gc & 1023; bias = p.ada_b[gc]; }
                else { which = 12 + ((gc - 12288) >> 10); n = gc & 1023; bias = p.kv_ada_b[gc - 12288]; }
                MODV[(which * 4 + b) * D + n] = s + bias;
            } else if (b == 0) { const int cu = u - NU_MOD; CMPB[(cu >> 2) * 256 + (cu & 3) * 64 + lane] = s; }
        }
        __syncthreads();
    }
}

template <int W>
__device__ __forceinline__ void pool_rows(const float* xb, int t0, const LAS float* rs, f32x2 gm, f32x2 sh, bf16_t* outb, int c0) {
    f32x2 ring[16];
#pragma unroll
    for (int i = 0; i < 15; ++i) {
        const int t = t0 - 15 + i; f32x2 h = {0.f, 0.f};
        if (t >= 0) { const f32x2 xv = *(const f32x2*)(xb + (size_t)t * D + c0); const float r = rs[i]; h = xv * r * gm + sh; }
        ring[i] = h;
    }
    for (int gi = 0; gi < 8; ++gi) {
#pragma unroll
        for (int j = 0; j < 16; ++j) {
            const int i = 15 + gi * 16 + j, t = t0 + gi * 16 + j;
            const f32x2 xv = *(const f32x2*)(xb + (size_t)t * D + c0); const float r = rs[i];
            const f32x2 h = xv * r * gm + sh;
            ring[(15 + j) & 15] = h;
            f32x2 s = {0.f, 0.f};
#pragma unroll
            for (int k = 0; k < W; ++k) s += ring[(15 + j - k) & 15];
            const int cnt = (t + 1 < W) ? t + 1 : W;
            const f32x2 o = s * (1.f / (float)cnt) - h;
            *(unsigned*)(outb + (size_t)t * D + c0) = cvt_pk_bf16(o.x, o.y);
        }
    }
}
__device__ __forceinline__ void phase_poolmix(const Params& p, LAS unsigned char* lds, bf16_t* mixA) {
    const int tid = opaque_tid(), lane = tid & 63, wave = tid >> 6;
    LAS float* rs = (LAS float*)lds;
    const float* MODV = (const float*)(p.ws + WS_MODV);
    for (int u = blockIdx.x; u < T / 128; u += gridDim.x) {
        const int b = u >> 6, t0 = (u & 63) * 128;
        const float* xb = p.x + (size_t)b * S * D;
        for (int i = wave; i < 143; i += NWAVE) {
            const int t = t0 - 15 + i; float r = 0.f;
            if (t >= 0) { const f32x4* xr = (const f32x4*)(xb + (size_t)t * D) + lane; float s = 0.f;
#pragma unroll
                for (int j = 0; j < 4; ++j) { const f32x4 v = xr[64 * j]; s += (v.x * v.x + v.y * v.y) + (v.z * v.z + v.w * v.w); }
                r = 1.f / sqrtf(wave_sum(s) * (1.f / D) + EPS); }
            if (lane == 0) rs[i] = r;
        }
        __syncthreads();
        const int c0 = 2 * tid;
        const f32x2 g = *(const f32x2*)(p.norm_g + c0), sc = *(const f32x2*)(MODV + (1 * 4 + b) * D + c0), sh = *(const f32x2*)(MODV + (0 * 4 + b) * D + c0);
        const f32x2 gm = g * (sc + 1.f);
        bf16_t* ob = mixA + (size_t)b * S * D;
        const int grp = tid >> 7;
        if (grp == 0) pool_rows<2>(xb, t0, rs, gm, sh, ob, c0);
        else if (grp == 1) pool_rows<4>(xb, t0, rs, gm, sh, ob, c0);
        else if (grp == 2) pool_rows<8>(xb, t0, rs, gm, sh, ob, c0);
        else pool_rows<16>(xb, t0, rs, gm, sh, ob, c0);
        __syncthreads();
    }
}

struct NormOut { const float* g; const float* sc; const float* sh; bf16_t* out; };
template <int NOUT, bool ROUTER, int OUTQ = 0>
__device__ __forceinline__ void phase_norm(const Params& p, LAS unsigned char* lds, const float* xin, const NormOut o0, const NormOut o1) {
    const int tid = opaque_tid(), lane = tid & 63, wave = tid >> 6;
    const int gw = blockIdx.x * NWAVE + wave, NGW = gridDim.x * NWAVE;
    f32x4 rwa[16], rwb[16];
    if (ROUTER) {
#pragma unroll
        for (int j = 0; j < 4; ++j)
#pragma unroll
            for (int q = 0; q < 4; ++q) { const f32x4* wp = (const f32x4*)(p.router_w + (size_t)(4 * lane + 256 * j + q) * NE); rwa[4 * j + q] = wp[0]; rwb[4 * j + q] = wp[1]; }
    }
    unsigned* ctl = (unsigned*)(p.ws + WS_CTL);
    int* TOPE = (int*)(p.ws + WS_TOPE); float* TOPW = (float*)(p.ws + WS_TOPW);
    unsigned cnt_local[NE];
#pragma unroll
    for (int e = 0; e < NE; ++e) cnt_local[e] = 0;
    const int rows_per = T / NGW > 0 ? (T + NGW - 1) / NGW : 1;
    const int r0 = gw * rows_per, r1 = (r0 + rows_per < T) ? r0 + rows_per : T;
    int curb = -1; f32x4 gm0[4], sh0[4], gm1[4], sh1[4];
    for (int r = r0; r < r1; ++r) {
        const int b = r >> 13;
        if (b != curb) { curb = b;
#pragma unroll
            for (int j = 0; j < 4; ++j) { const int c = 4 * lane + 256 * j;
                gm0[j] = *(const f32x4*)(o0.g + c) * (*(const f32x4*)(o0.sc + b * D + c) + 1.f); sh0[j] = *(const f32x4*)(o0.sh + b * D + c);
                if (NOUT > 1) { gm1[j] = *(const f32x4*)(o1.g + c) * (*(const f32x4*)(o1.sc + b * D + c) + 1.f); sh1[j] = *(const f32x4*)(o1.sh + b * D + c); } } }
        const f32x4* xr = (const f32x4*)(xin + (size_t)r * D) + lane;
        f32x4 v[4]; float s = 0.f;
#pragma unroll
        for (int j = 0; j < 4; ++j) { v[j] = xr[64 * j]; s += (v[j].x * v[j].x + v[j].y * v[j].y) + (v[j].z * v[j].z + v[j].w * v[j].w); }
        const float rstd = 1.f / sqrtf(wave_sum(s) * (1.f / D) + EPS);
        float lg[NE];
#pragma unroll
        for (int e = 0; e < NE; ++e) lg[e] = 0.f;
        float qsc = 1.f;
        if constexpr (OUTQ == 2) { float mx = 0.f;
#pragma unroll
            for (int j = 0; j < 4; ++j) { const f32x4 h = v[j] * rstd * gm0[j] + sh0[j]; mx = fmaxf(mx, fmaxf(fmaxf(fabsf(h.x), fabsf(h.y)), fmaxf(fabsf(h.z), fabsf(h.w)))); }
            mx = fmaxf(wave_max(mx), 1e-30f); qsc = 127.f / mx;
            if (lane == 0) ((float*)(p.ws + WS_ASC))[r] = mx * (1.f / 127.f); }
#pragma unroll
        for (int j = 0; j < 4; ++j) {
            const f32x4 h = v[j] * rstd * gm0[j] + sh0[j];
            if constexpr (OUTQ == 2) { *(unsigned*)((unsigned char*)o0.out + (size_t)r * D + 4 * lane + 256 * j) = pack_i8x4(h.x * qsc, h.y * qsc, h.z * qsc, h.w * qsc); }
            else if constexpr (OUTQ == 1) { unsigned w8 = 0u; w8 = __builtin_amdgcn_cvt_pk_fp8_f32(h.x, h.y, w8, false); w8 = __builtin_amdgcn_cvt_pk_fp8_f32(h.z, h.w, w8, true);
                *(unsigned*)((unsigned char*)o0.out + (size_t)r * D + 4 * lane + 256 * j) = w8; }
            else { u32x2 w; w.x = cvt_pk_bf16(h.x, h.y); w.y = cvt_pk_bf16(h.z, h.w);
            *(u32x2*)(o0.out + (size_t)r * D + 4 * lane + 256 * j) = w; }
            if (NOUT > 1) { const f32x4 h1 = v[j] * rstd * gm1[j] + sh1[j]; u32x2 w1; w1.x = cvt_pk_bf16(h1.x, h1.y); w1.y = cvt_pk_bf16(h1.z, h1.w);
                *(u32x2*)(o1.out + (size_t)r * D + 4 * lane + 256 * j) = w1; }
            if (ROUTER) {
#pragma unroll
                for (int q = 0; q < 4; ++q) { const f32x4 a = rwa[4 * j + q], c2 = rwb[4 * j + q]; const float hv = h[q];
                    lg[0] += hv * a.x; lg[1] += hv * a.y; lg[2] += hv * a.z; lg[3] += hv * a.w; lg[4] += hv * c2.x; lg[5] += hv * c2.y; lg[6] += hv * c2.z; lg[7] += hv * c2.w; }
            }
        }
        if (ROUTER) {
            {
                const bool u5 = lane & 32, u4 = lane & 16, u3 = lane & 8; float a4[4], a2[2], a1;
#pragma unroll
                for (int i = 0; i < 4; ++i) a4[i] = (u5 ? lg[4 + i] : lg[i]) + __shfl_xor(u5 ? lg[i] : lg[4 + i], 32);
#pragma unroll
                for (int i = 0; i < 2; ++i) a2[i] = (u4 ? a4[2 + i] : a4[i]) + __shfl_xor(u4 ? a4[i] : a4[2 + i], 16);
                a1 = (u3 ? a2[1] : a2[0]) + __shfl_xor(u3 ? a2[0] : a2[1], 8);
                a1 += __shfl_xor(a1, 4); a1 += __shfl_xor(a1, 2); a1 += __shfl_xor(a1, 1);
#pragma unroll
                for (int e = 0; e < NE; ++e) lg[e] = readlane_f(a1, 8 * e) + p.router_b[e];
            }
            int e0 = 0; float v0 = lg[0];
#pragma unroll
            for (int e = 1; e < NE; ++e) if (lg[e] > v0) { v0 = lg[e]; e0 = e; }
            int e1 = -1; float v1 = -3.0e38f;
#pragma unroll
            for (int e = 0; e < NE; ++e) if (e != e0 && lg[e] > v1) { v1 = lg[e]; e1 = e; }
            const float ex = __expf(v1 - v0), w0 = 1.f / (1.f + ex), w1 = ex / (1.f + ex);
            if (lane == 0) { TOPE[2 * r] = e0; TOPE[2 * r + 1] = e1; TOPW[2 * r] = w0; TOPW[2 * r + 1] = w1; }
#pragma unroll
            for (int e = 0; e < NE; ++e) cnt_local[e] += (e == e0) + (e == e1);
        }
    }
    if (ROUTER) {
        LAS unsigned* lc = (LAS unsigned*)lds;
        if (tid < NE) lc[tid] = 0u;
        __syncthreads();
        if (lane == 0) {
#pragma unroll
            for (int e = 0; e < NE; ++e) if (cnt_local[e]) atomicAdd((unsigned*)(lc + e), cnt_local[e]);
        }
        __syncthreads();
        if (tid < NE && lc[tid]) atomicAdd(ctl + CW_CNT + 64 * tid, lc[tid]);
    }
}

struct EpiPool {
    const float* x; float* x1; const float* g1; const float* scale; int coff;
    __device__ __forceinline__ void operator()(int row, int col, f32x4 v) const { const int c = coff + col, b = row >> 13;
        const f32x4 xv = *(const f32x4*)(x + (size_t)row * D + c), gv = *(const f32x4*)(g1 + b * D + c), sv = *(const f32x4*)(scale + c);
        *(f32x4*)(x1 + (size_t)row * D + c) = xv + gv * (v * sv); }
};
struct EpiSwiglu {
    bf16_t* hid; int ldh;
    __device__ __forceinline__ void pair(int row, int hc, f32x4 gt, f32x4 up) const {
        u32x2 w; w.x = cvt_pk_bf16(silu_f(gt.x) * up.x, silu_f(gt.y) * up.y); w.y = cvt_pk_bf16(silu_f(gt.z) * up.z, silu_f(gt.w) * up.w);
        *(u32x2*)(hid + (size_t)row * ldh + hc) = w; }
};
struct EpiSwigluI8 {
    bf16_t* hid; int ldh; const float* asc; const float* wmax;
    __device__ __forceinline__ void pair(int row, int hc, f32x4 gt, f32x4 up) const {
        typedef int i32x4e __attribute__((ext_vector_type(4)));
        const i32x4e gi = __builtin_bit_cast(i32x4e, gt), ui = __builtin_bit_cast(i32x4e, up);
        const float ra = asc[row] * (1.f / 127.f); const f32x4 wg = *(const f32x4*)(wmax + hc) * ra, wu = *(const f32x4*)(wmax + FF + hc) * ra;
        const float g0 = (float)gi.x * wg.x, g1 = (float)gi.y * wg.y, g2 = (float)gi.z * wg.z, g3 = (float)gi.w * wg.w;
        u32x2 w; w.x = cvt_pk_bf16(silu_f(g0) * ((float)ui.x * wu.x), silu_f(g1) * ((float)ui.y * wu.y)); w.y = cvt_pk_bf16(silu_f(g2) * ((float)ui.z * wu.z), silu_f(g3) * ((float)ui.w * wu.w));
        *(u32x2*)(hid + (size_t)row * ldh + hc) = w; }
};
struct EpiSwiglu8 {
    unsigned char* hid; int ldh;
    __device__ __forceinline__ void pair(int row, int hc, f32x4 gt, f32x4 up) const {
        unsigned w = 0u; w = __builtin_amdgcn_cvt_pk_fp8_f32(silu_f(gt.x) * up.x, silu_f(gt.y) * up.y, w, false); w = __builtin_amdgcn_cvt_pk_fp8_f32(silu_f(gt.z) * up.z, silu_f(gt.w) * up.w, w, true);
        *(unsigned*)(hid + (size_t)row * ldh + hc) = w; }
};
struct EpiResid {
    const float* xin; float* out; const float* gate;
    __device__ __forceinline__ void operator()(int row, int col, f32x4 v) const { const int b = row >> 13;
        const f32x4 xv = *(const f32x4*)(xin + (size_t)row * D + col), gv = *(const f32x4*)(gate + b * D + col);
        *(f32x4*)(out + (size_t)row * D + col) = xv + gv * v; }
};
struct EpiBf16 {
    bf16_t* o; int ldo;
    __device__ __forceinline__ void operator()(int row, int col, f32x4 v) const { u32x2 w; w.x = cvt_pk_bf16(v.x, v.y); w.y = cvt_pk_bf16(v.z, v.w); *(u32x2*)(o + (size_t)row * ldo + col) = w; }
};
struct EpiQ {
    bf16_t* q; float* gates; int coff;
    __device__ __forceinline__ void operator()(int row, int col_, f32x4 v) const { const int col = col_ + coff;
        if (col < D) { u32x2 w; w.x = cvt_pk_bf16(v.x, v.y); w.y = cvt_pk_bf16(v.z, v.w); *(u32x2*)(q + (size_t)row * D + col) = w; }
        else if (col < NQ) { f32x4 s; s.x = sigmoid_f(v.x); s.y = sigmoid_f(v.y); s.z = sigmoid_f(v.z); s.w = sigmoid_f(v.w); *(f32x4*)(gates + (size_t)row * 48 + (col - D)) = s; } }
};
struct EpiCmp {
    bf16_t* o; const float* bias;
    __device__ __forceinline__ void operator()(int row, int col, f32x4 v) const { const int z = col >> 8, c = col & 255; const f32x4 bv = *(const f32x4*)(bias + (z >> 2) * 256 + c);
        u32x2 w; w.x = cvt_pk_bf16(gelu_tanh_f(v.x + bv.x), gelu_tanh_f(v.y + bv.y)); w.y = cvt_pk_bf16(gelu_tanh_f(v.z + bv.z), gelu_tanh_f(v.w + bv.w));
        *(u32x2*)(o + ((size_t)z * 2048 + row) * 256 + c) = w; }
};


namespace pg8 {
#define PG8_LAS __attribute__((address_space(3)))
constexpr int BM = 256, BK = 64, HALF = 128, HTB = HALF * BK * 2, STAGE_BYTES = 8 * HTB, NXCD = 8, WGM = 8;
__host__ __device__ __forceinline__ int lds_byte(int r, int c) { const int st = (r >> 4) * 2 + (c >> 5), rr = r & 15, cc = c & 31, ob = rr * 64 + cc * 2; return st * 1024 + (ob ^ (((ob >> 9) & 1) << 5)); }
__host__ __device__ __forceinline__ void stage_rc(int b, int& R, int& C) { const int st = b / 1024, sb = b % 1024, swz = sb ^ (((sb >> 9) & 1) << 5); R = (st >> 1) * 16 + swz / 64; C = (st & 1) * 32 + (swz % 64) / 2; }
__host__ __device__ __forceinline__ int perm32(int rho) { const int n = rho >> 4, i = rho & 15; return 8 * (i >> 2) + 4 * n + (i & 3); }
struct Unit { int pm, pn; };
template <int SMODE> struct Sched {
    int nM, nN, nwg, G, c; const char* A; const char* Bt; size_t lda2, ldb2; const int* pst; size_t bstride2;
    __device__ __forceinline__ void init(int M, int N, int G_, int c_, const void* A_, const void* Bt_, int lda, int ldb, const int* pst_ = nullptr, size_t bstride = 0) {
        nM = M / BM; nN = N / BM; nwg = nM * nN; G = G_; c = c_; A = (const char*)A_; Bt = (const char*)Bt_; lda2 = (size_t)lda * 2; ldb2 = (size_t)ldb * 2; pst = pst_; bstride2 = bstride * 2; }
    __device__ __forceinline__ bool next(int i, Unit& u) const {
        if (c < 0) return false;
        const long L = (long)i * G + c; if (L >= nwg) return false;
        int wgid = (int)L; { const int q = nwg / NXCD, r = nwg % NXCD, xcd = wgid % NXCD, off = wgid / NXCD; wgid = (xcd < r ? xcd * (q + 1) : r * (q + 1) + (xcd - r) * q) + off; }
        const int nig = WGM * nN, gid = wgid / nig, fm = gid * WGM, gsz = (nM - fm) < WGM ? (nM - fm) : WGM;
        u.pm = fm + ((wgid % nig) % gsz); u.pn = (wgid % nig) / gsz; return true;
    }
    __device__ __forceinline__ const char* a_ptr(const Unit& u) const {
        if (SMODE == 1) return A + (size_t)u.pm * BM * lda2 + (size_t)u.pn * 512;
        if (SMODE == 2) return A + (size_t)u.pm * BM * lda2 + (size_t)((u.pn >> 2) * 256 + (u.pn & 3) * 64) * 2;
        return A + (size_t)u.pm * BM * lda2; }
    __device__ __forceinline__ const char* b_ptr(const Unit& u) const {
        if (SMODE == 2) return Bt + (size_t)(u.pn >> 2) * BM * ldb2;
        if (SMODE == 3) { const int m0 = u.pm * BM; int e = 0;
#pragma unroll
            for (int q = 1; q < NE; ++q) e += (m0 >= pst[q]); return Bt + (size_t)e * bstride2 + (size_t)u.pn * BM * ldb2; }
        return Bt + (size_t)u.pn * BM * ldb2; }
};
template <class F> struct EpiEl { static constexpr bool PERM = false, AFTER_DRAIN = false; F f;
    __device__ __forceinline__ void operator()(const f32x4 (&acc)[2][2][4][2], const Unit& u, int wr, int wc, int fr, int fq) const {
#pragma unroll
        for (int ai = 0; ai < 2; ++ai)
#pragma unroll
            for (int m = 0; m < 4; ++m) { const int row = u.pm * BM + ai * HALF + wr * 64 + m * 16 + fr;
#pragma unroll
                for (int bj = 0; bj < 2; ++bj)
#pragma unroll
                    for (int n = 0; n < 2; ++n) f(row, u.pn * BM + bj * HALF + wc * 32 + n * 16 + 4 * fq, acc[ai][bj][m][n]); } } };
template <class F> struct EpiPairEl { static constexpr bool PERM = false, AFTER_DRAIN = false; F f;
    __device__ __forceinline__ void operator()(const f32x4 (&acc)[2][2][4][2], const Unit& u, int wr, int wc, int fr, int fq) const {
#pragma unroll
        for (int ai = 0; ai < 2; ++ai)
#pragma unroll
            for (int m = 0; m < 4; ++m) { const int row = u.pm * BM + ai * HALF + wr * 64 + m * 16 + fr;
#pragma unroll
                for (int n = 0; n < 2; ++n) f.pair(row, u.pn * HALF + wc * 32 + n * 16 + 4 * fq, acc[ai][0][m][n], acc[ai][1][m][n]); } } };

typedef int i32x8 __attribute__((ext_vector_type(8)));
template <int QM> __device__ __forceinline__ void mma_block(f32x4 (&acc)[4][2], const bf16x8 (&At)[4][2], const bf16x8 (&Bt)[2][2], const int wsc) {
    __builtin_amdgcn_s_setprio(1);
    if constexpr (QM == 2) {
        typedef int i32x4m __attribute__((ext_vector_type(4)));
#pragma unroll
        for (int m = 0; m < 4; ++m)
#pragma unroll
            for (int n = 0; n < 2; ++n)
#pragma unroll
                for (int k = 0; k < 2; ++k) acc[m][n] = __builtin_bit_cast(f32x4, __builtin_amdgcn_mfma_i32_16x16x64_i8(__builtin_bit_cast(i32x4m, Bt[n][k]), __builtin_bit_cast(i32x4m, At[m][k]), __builtin_bit_cast(i32x4m, acc[m][n]), 0, 0, 0));
#pragma unroll
        for (int m = 0; m < 4; ++m) asm volatile("" : "+v"(acc[m][0]), "+v"(acc[m][1]));
    } else if constexpr (QM == 1) {
#pragma unroll
        for (int m = 0; m < 4; ++m) { const u32x4 a0 = __builtin_bit_cast(u32x4, At[m][0]), a1 = __builtin_bit_cast(u32x4, At[m][1]);
            const i32x8 a8 = {(int)a0.x, (int)a0.y, (int)a0.z, (int)a0.w, (int)a1.x, (int)a1.y, (int)a1.z, (int)a1.w};
#pragma unroll
            for (int n = 0; n < 2; ++n) { const u32x4 b0 = __builtin_bit_cast(u32x4, Bt[n][0]), b1 = __builtin_bit_cast(u32x4, Bt[n][1]);
                const i32x8 b8 = {(int)b0.x, (int)b0.y, (int)b0.z, (int)b0.w, (int)b1.x, (int)b1.y, (int)b1.z, (int)b1.w};
                acc[m][n] = __builtin_amdgcn_mfma_scale_f32_16x16x128_f8f6f4(b8, a8, acc[m][n], 0, 0, 0, wsc, 0, 127); } }
#pragma unroll
        for (int m = 0; m < 4; ++m) asm volatile("" : "+v"(acc[m][0]), "+v"(acc[m][1]));
    } else {
#pragma unroll
        for (int m = 0; m < 4; ++m)
#pragma unroll
            for (int n = 0; n < 2; ++n)
#pragma unroll
                for (int k = 0; k < 2; ++k) acc[m][n] = __builtin_amdgcn_mfma_f32_16x16x32_bf16(Bt[n][k], At[m][k], acc[m][n], 0, 0, 0);
    }
    __builtin_amdgcn_s_setprio(0);
}
template <class Epi, class Sched, bool ALIGN_EPI = true, bool SP2 = true, int QM = 0>
__device__ __forceinline__ void gemm_phase(PG8_LAS unsigned char* lds, const int K, const int lda, const int ldb, const size_t kstepA, const Sched& S, const Epi& E, const int wsc = 127) {
    const int tid_ = opaque_tid();
    const int tid = tid_, wid = __builtin_amdgcn_readfirstlane(tid >> 6), lane = tid & 63, wr = wid >> 2, wc = wid & 3, fr = lane & 15, fq = lane >> 4;
    const int nt = K / BK;
    unsigned voffA[2], voffB[2];
#pragma unroll
    for (int i = 0; i < 2; ++i) { int R, C; stage_rc(tid * 16 + i * 8192, R, C); const int Rb = Epi::PERM ? ((R & ~31) + perm32(R & 31)) : R;
        voffA[i] = (unsigned)(R * lda + C) * 2u; voffB[i] = (unsigned)(Rb * ldb + C) * 2u; }
    const size_t kstepB = (size_t)(BK * 2);
    const size_t hstepA = (size_t)HALF * lda * 2, hstepB = (size_t)HALF * ldb * 2;
    const unsigned ldsw = (unsigned)wid * 1024u;
    int aoffk[2], boffk[2];
#pragma unroll
    for (int k = 0; k < 2; ++k) { const int col = (QM == 1) ? ((fq >> 1) * 32 + (fq & 1) * 16 + 8 * k) : (k * 32 + fq * 8); aoffk[k] = lds_byte(wr * 64 + fr, col); boffk[k] = lds_byte(wc * 32 + fr, col); }
#define PG8_SA(b, h) (((b) * 2 + (h)) * HTB)
#define PG8_SB(b, h) ((4 + (b) * 2 + (h)) * HTB)
#define PG8_STAGE(bufoff, gbase, voff) do { _Pragma("unroll") for (int _i = 0; _i < 2; ++_i) \
        __builtin_amdgcn_global_load_lds((const unsigned*)((const char*)(gbase) + (voff)[_i]), (PG8_LAS unsigned*)(lds + (bufoff) + ldsw + _i * 8192), 16, 0, 0); } while (0)
#define PG8_LDA(dst, b, h) do { _Pragma("unroll") for (int m = 0; m < 4; ++m) _Pragma("unroll") for (int k = 0; k < 2; ++k) dst[m][k] = *(const PG8_LAS bf16x8*)(lds + PG8_SA(b, h) + ((QM == 1) ? aoffk[k] : aoffk[0] + k * 1024) + m * 2048); } while (0)
#define PG8_LDB(dst, b, h) do { _Pragma("unroll") for (int n = 0; n < 2; ++n) _Pragma("unroll") for (int k = 0; k < 2; ++k) dst[n][k] = *(const PG8_LAS bf16x8*)(lds + PG8_SB(b, h) + ((QM == 1) ? boffk[k] : boffk[0] + k * 1024) + n * 2048); } while (0)
#define PG8_MMA(ai, bj, At, Bt) mma_block<QM>(acc[ai][bj], At, Bt, wsc)
#define PG8_WAIT_V(n) asm volatile("s_waitcnt vmcnt(" #n ")" ::: "memory")
#define PG8_WAIT_L(n) asm volatile("s_waitcnt lgkmcnt(" #n ")" ::: "memory")
#define PG8_BAR __builtin_amdgcn_s_barrier()
#define PG8_SCHED __builtin_amdgcn_sched_barrier(0)
    Unit cur, nxt; int ui = 0;
    if (!S.next(0, cur)) return;
    f32x4 acc[2][2][4][2];
#pragma unroll
    for (int a = 0; a < 2; ++a)
#pragma unroll
        for (int b = 0; b < 2; ++b)
#pragma unroll
            for (int m = 0; m < 4; ++m)
#pragma unroll
                for (int n = 0; n < 2; ++n) acc[a][b][m][n] = (f32x4){0.f, 0.f, 0.f, 0.f};
    bf16x8 At[4][2], B0[2][2], B1[2][2];
    const char* cA = S.a_ptr(cur); const char* cB = S.b_ptr(cur);
    if constexpr (SP2) {
        PG8_STAGE(PG8_SB(0, 0), cB, voffB); PG8_STAGE(PG8_SB(0, 1), cB + hstepB, voffB); PG8_STAGE(PG8_SA(0, 0), cA, voffA); PG8_STAGE(PG8_SA(0, 1), cA + hstepA, voffA);
        if (wr == 1) PG8_BAR;
        PG8_WAIT_V(2); PG8_BAR;
        PG8_STAGE(PG8_SB(1, 0), cB + kstepB, voffB); PG8_STAGE(PG8_SA(1, 0), cA + kstepA, voffA); PG8_STAGE(PG8_SB(1, 1), cB + hstepB + kstepB, voffB);
        PG8_WAIT_V(6); PG8_BAR;
    } else {
        PG8_STAGE(PG8_SB(0, 0), cB, voffB); PG8_STAGE(PG8_SA(0, 0), cA, voffA); PG8_STAGE(PG8_SB(0, 1), cB + hstepB, voffB); PG8_STAGE(PG8_SA(0, 1), cA + hstepA, voffA);
        if (wr == 1) PG8_BAR;
        PG8_WAIT_V(4); PG8_BAR;
        PG8_STAGE(PG8_SB(1, 0), cB + kstepB, voffB); PG8_STAGE(PG8_SA(1, 0), cA + kstepA, voffA); PG8_STAGE(PG8_SB(1, 1), cB + hstepB + kstepB, voffB);
        PG8_WAIT_V(6); PG8_BAR;
    }
    for (;;) {
        const bool has_next = S.next(ui + 1, nxt);
        const char* nA = has_next ? S.a_ptr(nxt) : cA; const char* nB = has_next ? S.b_ptr(nxt) : cB;
        for (int t = 0; t < nt; t += 2) {
            const bool last = (t == nt - 2);
            const char* a1 = cA + (size_t)(t + 1) * kstepA;
            const char* a2 = last ? nA : cA + (size_t)(t + 2) * kstepA; const char* b2 = last ? nB : cB + (size_t)(t + 2) * kstepB;
            const char* a3 = a2 + kstepA; const char* b3 = b2 + kstepB;
            if constexpr (SP2) {
            PG8_LDB(B0, 0, 0); PG8_LDB(B1, 0, 1); PG8_SCHED; PG8_LDA(At, 0, 0); PG8_STAGE(PG8_SA(1, 1), a1 + hstepA, voffA);
            PG8_WAIT_V(8); PG8_WAIT_L(0); PG8_BAR; PG8_MMA(0, 0, At, B0); PG8_MMA(0, 1, At, B1); PG8_BAR; PG8_SCHED;
            PG8_LDA(At, 0, 1); PG8_STAGE(PG8_SB(0, 0), b2, voffB); PG8_STAGE(PG8_SB(0, 1), b2 + hstepB, voffB); PG8_STAGE(PG8_SA(0, 0), a2, voffA);
            PG8_WAIT_V(8); PG8_WAIT_L(0); PG8_BAR; PG8_MMA(1, 0, At, B0); PG8_MMA(1, 1, At, B1); PG8_BAR; PG8_SCHED;
            PG8_LDB(B0, 1, 0); PG8_LDB(B1, 1, 1); PG8_SCHED; PG8_LDA(At, 1, 0); PG8_STAGE(PG8_SA(0, 1), a2 + hstepA, voffA);
            PG8_WAIT_V(8); PG8_WAIT_L(0); PG8_BAR; PG8_MMA(0, 0, At, B0); PG8_MMA(0, 1, At, B1); PG8_BAR; PG8_SCHED;
            PG8_LDA(At, 1, 1); PG8_STAGE(PG8_SB(1, 0), b3, voffB); PG8_STAGE(PG8_SB(1, 1), b3 + hstepB, voffB); PG8_STAGE(PG8_SA(1, 0), a3, voffA);
            PG8_WAIT_V(8); PG8_WAIT_L(0); PG8_BAR; PG8_MMA(1, 0, At, B0); PG8_MMA(1, 1, At, B1); PG8_BAR; PG8_SCHED;
            } else {
            PG8_LDB(B0, 0, 0); PG8_SCHED; PG8_LDA(At, 0, 0); PG8_STAGE(PG8_SA(1, 1), a1 + hstepA, voffA);
            PG8_WAIT_L(8); PG8_BAR; PG8_WAIT_L(0); PG8_MMA(0, 0, At, B0); PG8_BAR; PG8_SCHED;
            PG8_LDB(B1, 0, 1); PG8_STAGE(PG8_SB(0, 0), b2, voffB);
            PG8_BAR; PG8_WAIT_L(0); PG8_MMA(0, 1, At, B1); PG8_BAR;
            PG8_LDA(At, 0, 1); PG8_STAGE(PG8_SA(0, 0), a2, voffA);
            PG8_BAR; PG8_WAIT_L(0); PG8_MMA(1, 0, At, B0); PG8_BAR; PG8_SCHED;
            PG8_STAGE(PG8_SB(0, 1), b2 + hstepB, voffB);
            PG8_WAIT_V(6); PG8_BAR; PG8_MMA(1, 1, At, B1); PG8_BAR;
            PG8_LDB(B0, 1, 0); PG8_SCHED; PG8_LDA(At, 1, 0); PG8_STAGE(PG8_SA(0, 1), a2 + hstepA, voffA);
            PG8_WAIT_L(8); PG8_BAR; PG8_WAIT_L(0); PG8_MMA(0, 0, At, B0); PG8_BAR; PG8_SCHED;
            PG8_LDB(B1, 1, 1); PG8_STAGE(PG8_SB(1, 0), b3, voffB);
            PG8_BAR; PG8_WAIT_L(0); PG8_MMA(0, 1, At, B1); PG8_BAR;
            PG8_LDA(At, 1, 1); PG8_STAGE(PG8_SA(1, 0), a3, voffA);
            PG8_BAR; PG8_WAIT_L(0); PG8_MMA(1, 0, At, B0); PG8_BAR; PG8_SCHED;
            PG8_STAGE(PG8_SB(1, 1), b3 + hstepB, voffB);
            PG8_WAIT_V(6); PG8_BAR; PG8_MMA(1, 1, At, B1); PG8_BAR;
            }
        }
        if constexpr (ALIGN_EPI) { if (wr == 0) PG8_BAR; }
        if constexpr (!Epi::AFTER_DRAIN) { E(acc, cur, wr, wc, fr, fq); }
        if (!has_next) break;
#pragma unroll
        for (int a = 0; a < 2; ++a)
#pragma unroll
            for (int b = 0; b < 2; ++b)
#pragma unroll
                for (int m = 0; m < 4; ++m)
#pragma unroll
                    for (int n = 0; n < 2; ++n) acc[a][b][m][n] = (f32x4){0.f, 0.f, 0.f, 0.f};
        cur = nxt; cA = nA; cB = nB; ++ui;
        if constexpr (ALIGN_EPI) { if (wr == 1) PG8_BAR; }
    }
    PG8_WAIT_V(0);
    if constexpr (!ALIGN_EPI) { if (wr == 0) PG8_BAR; }
    PG8_BAR;
    if constexpr (Epi::AFTER_DRAIN) { E.fused(acc, cur, wr, wc, fr, fq, lds, wid, lane); }
#undef PG8_SA
#undef PG8_SB
#undef PG8_STAGE
#undef PG8_LDA
#undef PG8_LDB
#undef PG8_MMA
#undef PG8_WAIT_V
#undef PG8_WAIT_L
#undef PG8_BAR
#undef PG8_SCHED
}
}

__device__ __forceinline__ void phase_headnorm(const Params& p, LAS unsigned char* lds) {
    const int tid = opaque_tid(), lane = tid & 63, wave = tid >> 6;
    LAS int* chunk = (LAS int*)(lds + 131072 - 64);
    bf16_t* Q = (bf16_t*)(p.ws + WS_Q); bf16_t* KVB = (bf16_t*)(p.ws + WS_KVB);
    float qg[16], kg[8];
#pragma unroll
    for (int i = 0; i < 16; ++i) qg[i] = p.q_gain[(lane & 3) * 16 + i] * (0.125f * 1.4426950408889634f);
    const int kr = lane >> 5;
#pragma unroll
    for (int i = 0; i < 8; ++i) kg[i] = p.k_gain[(1 + kr) * 64 + (lane & 7) * 8 + i];
    for (;;) {
      if (tid == 0) *chunk = (int)atomicAdd((unsigned*)(p.ws + WS_CTL) + CW_HN, 1u);
      __syncthreads();
      const int c0 = *chunk;
      __syncthreads();
      if (c0 >= T / 128) break;
      for (int r = c0 * 128 + wave * 16; r < c0 * 128 + wave * 16 + 16; ++r) {
        {
            u32x4* ptr = (u32x4*)(Q + (size_t)r * D + lane * 16); u32x4 w0 = ptr[0], w1 = ptr[1];
            float v[16]; const unsigned ww[8] = {w0.x, w0.y, w0.z, w0.w, w1.x, w1.y, w1.z, w1.w}; float s = 0.f;
#pragma unroll
            for (int i = 0; i < 8; ++i) { v[2 * i] = bflo(ww[i]); v[2 * i + 1] = bfhi(ww[i]); s += v[2 * i] * v[2 * i] + v[2 * i + 1] * v[2 * i + 1]; }
            s += __shfl_xor(s, 1); s += __shfl_xor(s, 2);
            const float rstd = 1.f / sqrtf(s * (1.f / 64.f) + EPS);
            unsigned o[8];
#pragma unroll
            for (int i = 0; i < 8; ++i) o[i] = cvt_pk_bf16(v[2 * i] * rstd * qg[2 * i], v[2 * i + 1] * rstd * qg[2 * i + 1]);
            ptr[0] = (u32x4){o[0], o[1], o[2], o[3]}; ptr[1] = (u32x4){o[4], o[5], o[6], o[7]};
        }
        {
            const u32x4* ptr = (const u32x4*)(KVB + (size_t)r * NKV + (kr ? 1024 : 512) + (lane & 31) * 8); const u32x4 w0 = ptr[0];
            float v[8]; const unsigned ww[4] = {w0.x, w0.y, w0.z, w0.w}; float s = 0.f;
#pragma unroll
            for (int i = 0; i < 4; ++i) { v[2 * i] = bflo(ww[i]); v[2 * i + 1] = bfhi(ww[i]); s += v[2 * i] * v[2 * i] + v[2 * i + 1] * v[2 * i + 1]; }
            s += __shfl_xor(s, 1); s += __shfl_xor(s, 2); s += __shfl_xor(s, 4);
            const float rstd = 1.f / sqrtf(s * (1.f / 64.f) + EPS);
            unsigned o[4];
#pragma unroll
            for (int i = 0; i < 4; ++i) o[i] = cvt_pk_bf16(v[2 * i] * rstd * kg[2 * i], v[2 * i + 1] * rstd * kg[2 * i + 1]);
            const int b = r >> 13, t = r & (S - 1), hg = (lane & 31) >> 3, c = lane & 7;
            {
                bf16_t* dst = (bf16_t*)(p.ws + (kr ? WS_KWB : WS_KSB)) + ((size_t)((b * 4 + hg) * 128 + (t >> 6)) * 8 + c) * 512 + (t & 63) * 8;
                *(u32x4*)dst = (u32x4){o[0], o[1], o[2], o[3]};
            }
        }
      }
    }
}

__device__ __forceinline__ void phase_cmp2(const Params& p, LAS unsigned char* lds) {
    const int tid = opaque_tid(), lane = tid & 63, wave = tid >> 6;
    const int gw = blockIdx.x * NWAVE + wave, NGW = gridDim.x * NWAVE;
    const bf16_t* CMPH = (const bf16_t*)(p.ws + WS_CMPH);
    LAS float* w2l = (LAS float*)lds;
    for (int kv = 0; kv < 2; ++kv) {
        const float* w2 = kv ? p.cmp_v_w2 : p.cmp_k_w2;
        for (int i = tid; i < 256 * 64 / 4; i += NTHR) ((LAS f32x4*)w2l)[i] = ((const f32x4*)w2)[i];
        __syncthreads();
        for (int it = gw * 2; it < 4 * 2048; it += NGW * 2) {
            float hv[2][4], acc[2] = {0.f, 0.f};
#pragma unroll
            for (int rr = 0; rr < 2; ++rr) { const u32x2 w = *(const u32x2*)(CMPH + (size_t)(kv * 8192 + it + rr) * 256 + 4 * lane); hv[rr][0] = bflo(w.x); hv[rr][1] = bfhi(w.x); hv[rr][2] = bflo(w.y); hv[rr][3] = bfhi(w.y); }
#pragma unroll 4
            for (int kk = 0; kk < 64; ++kk)
#pragma unroll
                for (int c = 0; c < 4; ++c) { const float wv = w2l[(4 * kk + c) * 64 + lane];
                    acc[0] += readlane_f(hv[0][c], kk) * wv; acc[1] += readlane_f(hv[1][c], kk) * wv; }
#pragma unroll
            for (int rr = 0; rr < 2; ++rr) {
                const int row = it + rr, g = (row >> 11) & 3, r2 = row & 2047, b = r2 >> 9, n = r2 & 511; float a = n == NC - 1 ? 0.f : acc[rr];
                if (kv == 0) { const float ss = wave_sum(a * a); a = a * (1.f / sqrtf(ss * (1.f / 64.f) + EPS)) * p.k_gain[lane]; }
                const size_t blk0 = (size_t)((b * 4 + g) * 8 + (n >> 6)) * 4096;
                bf16_t* o = kv ? (bf16_t*)(p.ws + WS_VC) + blk0 + ((n & 63) >> 3) * 512 + lane * 8 + (n & 7)
                               : (bf16_t*)(p.ws + WS_KC) + blk0 + (lane >> 3) * 512 + (n & 63) * 8 + (lane & 7);
                *o = (bf16_t)(cvt_pk_bf16(a, 0.f) & 0xffffu);
            }
        }
        __syncthreads();
    }
}

__device__ __forceinline__ void phase_vtrans(const Params& p, LAS unsigned char* lds) {
    const int tid = opaque_tid(), lane = tid & 63, wave = tid >> 6;
    const int gw = blockIdx.x * NWAVE + wave, NGW = gridDim.x * NWAVE;
    LAS unsigned short* tile = (LAS unsigned short*)(lds + wave * 8448);
    const bf16_t* KVB = (const bf16_t*)(p.ws + WS_KVB);
    LAS int* chunk = (LAS int*)(lds + 131072 - 64);
    for (;;) {
        if (tid == 0) *chunk = (int)atomicAdd((unsigned*)(p.ws + WS_CTL) + CW_VT, 1u);
        __syncthreads();
        const int c0 = *chunk;
        __syncthreads();
        if (c0 >= 2 * 16 * 128 / NWAVE) break;
        const int u = c0 * NWAVE + wave;
        const int which = u >> 11, bg = (u >> 7) & 15, tt = u & 127, b = bg >> 2, g = bg & 3, t0 = tt * 64;
        const u32x4* src = (const u32x4*)(KVB + (size_t)(b * S + t0 + lane) * NKV + (which ? 1280 : 768) + g * 64);
#pragma unroll
        for (int i = 0; i < 8; ++i) { const u32x4 v = src[i]; LAS unsigned* tp = (LAS unsigned*)(tile + lane * 66 + 8 * i); tp[0] = v.x; tp[1] = v.y; tp[2] = v.z; tp[3] = v.w; }
        asm volatile("s_waitcnt lgkmcnt(0)" ::: "memory");
        {
            bf16_t* dst = (bf16_t*)(p.ws + (which ? WS_VWB : WS_VSB)) + (size_t)(bg * 128 + tt) * 4096 + lane * 8;
#pragma unroll
            for (int i = 0; i < 8; ++i) { unsigned w[4];
#pragma unroll
                for (int q = 0; q < 4; ++q) { const unsigned lo = tile[(8 * i + 2 * q) * 66 + lane], hi = tile[(8 * i + 2 * q + 1) * 66 + lane]; w[q] = lo | (hi << 16); }
                *(u32x4*)(dst + i * 512) = (u32x4){w[0], w[1], w[2], w[3]}; }
        }
        asm volatile("s_waitcnt lgkmcnt(0)" ::: "memory");
    }
}

typedef short s16x4 __attribute__((ext_vector_type(4)));
__device__ __forceinline__ f32x4 mfma4(s16x4 a, s16x4 b, f32x4 c) { return __builtin_amdgcn_mfma_f32_4x4x4bf16_1k(a, b, c, 0, 0, 0); }
__device__ __forceinline__ s16x4 mk4(unsigned lo, unsigned hi) { const u32x2 t = {lo, hi}; return __builtin_bit_cast(s16x4, t); }
__device__ __forceinline__ f32x4 qk64(const bf16_t* krow, const s16x4 (&qf)[16]) {
    const u32x4* kp = (const u32x4*)krow; u32x4 kr[8];
#pragma unroll
    for (int i = 0; i < 8; ++i) kr[i] = kp[i];
    f32x4 s = {0.f, 0.f, 0.f, 0.f};
#pragma unroll
    for (int c = 0; c < 8; ++c) { s = mfma4(mk4(kr[c].x, kr[c].y), qf[2 * c], s); s = mfma4(mk4(kr[c].z, kr[c].w), qf[2 * c + 1], s); }
    return s;
}
__device__ __forceinline__ void pv64(f32x4& o, const f32x4 e, const bf16_t* vtrow, LAS u32x2* stage, int lane) {
    const u32x4* vp = (const u32x4*)vtrow; u32x4 vr[8];
#pragma unroll
    for (int i = 0; i < 8; ++i) vr[i] = vp[i];
    u32x2 pk; pk.x = cvt_pk_bf16(e.x, e.y); pk.y = cvt_pk_bf16(e.z, e.w);
    stage[lane] = pk;
#pragma unroll
    for (int st = 0; st < 16; ++st) { const u32x2 a = stage[4 * st + (lane & 3)]; const u32x4 v = vr[st >> 1];
        o = mfma4(mk4(a.x, a.y), (st & 1) ? mk4(v.z, v.w) : mk4(v.x, v.y), o); }
}
__device__ __forceinline__ float quadx_sum(float v) { v += __shfl_xor(v, 4); v += __shfl_xor(v, 8); v += __shfl_xor(v, 16); v += __shfl_xor(v, 32); return v; }

constexpr int HBN = 800;
constexpr int ATT_HBD = 0, ATT_MH = 51200, ATT_PSLC = 53248, ATT_STAGE = 118784;
__device__ __forceinline__ void attn_tables(const Params& p, LAS unsigned char* lds) {
    const int tid = opaque_tid();
    LAS float* hbd = (LAS float*)(lds + ATT_HBD); LAS float* mh = (LAS float*)(lds + ATT_MH);
    for (int i = tid; i < 16 * HBN; i += NTHR) { const int hd = i / HBN, d = i - hd * HBN; const float v = p.rel_bias[rel_bucket(d) * NH + hd] * 1.4426950408889634f; hbd[i] = v; if (blockIdx.x == 0) ((float*)(p.ws + WS_HBG))[i] = v; }
    if (tid < 16) { float qg = 0.f, kg = 0.f, bm = -3.0e38f;
        for (int i = 0; i < 64; ++i) qg = fmaxf(qg, fabsf(p.q_gain[i]));
        for (int i = 0; i < 192; ++i) kg = fmaxf(kg, fabsf(p.k_gain[i]));
        for (int i = 0; i < 32; ++i) bm = fmaxf(bm, p.rel_bias[i * NH + tid]);
        const float mv = (qg * kg * 8.f * 1.02f + bm) * 1.4426950408889634f; mh[tid] = mv; if (blockIdx.x == 0) ((float*)(p.ws + WS_MHG))[tid] = mv; }
    __syncthreads();
}
typedef float f32x16 __attribute__((ext_vector_type(16)));
__device__ __forceinline__ f32x16 mfma32(bf16x8 a, bf16x8 b, f32x16 c) { return __builtin_amdgcn_mfma_f32_32x32x16_bf16(a, b, c, 0, 0, 0); }
struct DFrag { bf16x8 ka[4]; bf16x8 va[2][2]; };
__device__ __forceinline__ void dense_load_k(bf16x8 (&ka)[4], const bf16_t* KB, int kt, int l31, int h) {
    const int blk = kt >> 6, hh = (kt >> 5) & 1;
    const bf16_t* kb = KB + (size_t)blk * 4096 + (32 * hh + l31) * 8;
#pragma unroll
    for (int ks = 0; ks < 4; ++ks) ka[ks] = *(const bf16x8*)(kb + (2 * ks + h) * 512);
}
__device__ __forceinline__ void dense_load_v(bf16x8 (&va)[2][2], const bf16_t* VB, int kt, int l31, int h) {
    const int blk = kt >> 6, hh = (kt >> 5) & 1;
    const bf16_t* vb = VB + (size_t)blk * 4096 + l31 * 8 + 4 * h;
#pragma unroll
    for (int dt = 0; dt < 2; ++dt)
#pragma unroll
        for (int st = 0; st < 2; ++st) { const bf16_t* q0 = vb + (4 * hh + 2 * st) * 512 + dt * 256; const u32x2 lo = *(const u32x2*)q0, hi = *(const u32x2*)(q0 + 512);
            const u32x4 w = {lo.x, lo.y, hi.x, hi.y}; va[dt][st] = __builtin_bit_cast(bf16x8, w); }
}
__device__ __forceinline__ f32x16 dense_scores(const DFrag& f, const bf16x8 (&q)[4]) {
    f32x16 sacc;
#pragma unroll
    for (int i = 0; i < 16; ++i) sacc[i] = 0.f;
#pragma unroll
    for (int ks = 0; ks < 4; ++ks) sacc = mfma32(f.ka[ks], q[ks], sacc);
    return sacc;
}
__device__ __forceinline__ void dense_pv(f32x16 (&O)[2], const DFrag& f, const float (&ev)[16]) {
    bf16x8 pb[2];
#pragma unroll
    for (int st = 0; st < 2; ++st) { const u32x4 w = {cvt_pk_bf16(ev[8 * st], ev[8 * st + 1]), cvt_pk_bf16(ev[8 * st + 2], ev[8 * st + 3]), cvt_pk_bf16(ev[8 * st + 4], ev[8 * st + 5]), cvt_pk_bf16(ev[8 * st + 6], ev[8 * st + 7])};
        pb[st] = __builtin_bit_cast(bf16x8, w); }
#pragma unroll
    for (int dt = 0; dt < 2; ++dt)
#pragma unroll
        for (int st = 0; st < 2; ++st) O[dt] = mfma32(f.va[dt][st], pb[st], O[dt]);
}
__device__ __forceinline__ void phase_dense(const Params& p, LAS unsigned char* lds, bf16_t* OW) {
    const int tid = opaque_tid(), lane0 = tid & 63, wave = tid >> 6;
    const LAS float* hbd = (const LAS float*)(lds + ATT_HBD); const LAS float* mh = (const LAS float*)(lds + ATT_MH);
    LAS float* pslc = (LAS float*)(lds + ATT_PSLC) + wave * 2048;
    const bf16_t* Q = (const bf16_t*)(p.ws + WS_Q); const float* GATE = (const float*)(p.ws + WS_GATE);
    short* SEL = (short*)(p.ws + WS_SEL);
    const int Gn = gridDim.x, vcu = (Gn % 8 == 0) ? (blockIdx.x % 8) * (Gn / 8) + blockIdx.x / 8 : blockIdx.x;
    for (int u = vcu * NWAVE + wave; u < T * G / 16; u += Gn * NWAVE) {
        int lane = lane0; asm volatile("" : "+v"(lane));
        const int l31 = lane & 31, h = lane >> 5;
        const int bg = u >> 9, t0 = (((u & 511) + 128 * (u >> 11)) & 511) * 16, b = bg >> 2, g = bg & 3, head = 4 * g + (lane & 3);
        const LAS float* hb = hbd + head * HBN; const float mhv = mh[head];
        int tok[2]; bf16x8 qf[2][4];
#pragma unroll
        for (int r = 0; r < 2; ++r) { tok[r] = t0 + 8 * r + (l31 >> 2); const bf16_t* qp = Q + (size_t)(b * S + tok[r]) * D + head * 64 + 8 * h;
#pragma unroll
            for (int ks = 0; ks < 4; ++ks) qf[r][ks] = *(const bf16x8*)(qp + 16 * ks); }
        f32x16 O[2][2];
#pragma unroll
        for (int r = 0; r < 2; ++r)
#pragma unroll
            for (int dt = 0; dt < 2; ++dt)
#pragma unroll
                for (int q = 0; q < 16; ++q) O[r][dt][q] = 0.f;
        DFrag cur; bf16x8 nxtk[4];
        {
            const bf16_t* KB = (const bf16_t*)(p.ws + WS_KWB) + (size_t)bg * 128 * 4096; const bf16_t* VB = (const bf16_t*)(p.ws + WS_VWB) + (size_t)bg * 128 * 4096;
            float lw[2] = {0.f, 0.f};
            const int lo = t0 - (WIN - 1) > 0 ? t0 - (WIN - 1) : 0, kt_last = t0 & ~31;
            dense_load_k(cur.ka, KB, lo & ~31, l31, h);
            for (int kt = lo & ~31; kt <= kt_last; kt += 32) {
                dense_load_v(cur.va, VB, kt, l31, h);
                dense_load_k(nxtk, KB, kt + 32 <= kt_last ? kt + 32 : kt_last, l31, h);
                __builtin_amdgcn_sched_barrier(0);
#pragma unroll
                for (int r = 0; r < 2; ++r) {
                    const f32x16 sacc = dense_scores(cur, qf[r]);
                    const int dbase = tok[r] - kt - 4 * h; float ev[16];
                    if (kt + 31 <= t0 + 8 * r && kt >= t0 + 8 * r + 7 - (WIN - 1)) {
                        const LAS float* hbp = hb + dbase;
#pragma unroll
                        for (int q = 0; q < 16; ++q) { const float e = __builtin_amdgcn_exp2f(sacc[q] + hbp[-((q & 3) + 8 * (q >> 2))] - mhv); ev[q] = e; lw[r] += e; }
                    } else {
#pragma unroll
                    for (int q = 0; q < 16; ++q) { const int dist = dbase - ((q & 3) + 8 * (q >> 2)); const bool ok = (unsigned)dist < (unsigned)WIN;
                        const float e0 = __builtin_amdgcn_exp2f(sacc[q] + hb[ok ? dist : 0] - mhv); const float e = ok ? e0 : 0.f; ev[q] = e; lw[r] += e; }
                    }
                    dense_pv(O[r], cur, ev);
                }
#pragma unroll
                for (int ks = 0; ks < 4; ++ks) cur.ka[ks] = nxtk[ks];
            }
#pragma unroll
            for (int r = 0; r < 2; ++r) { const float l = lw[r] + __shfl_xor(lw[r], 32); int tk = tok[r]; asm volatile("" : "+v"(tk)); const float* gp = GATE + (size_t)(b * S + tk) * 48 + head * 3;
                const float sc = gp[2] / (l * gp[0]);
#pragma unroll
                for (int dt = 0; dt < 2; ++dt) O[r][dt] = O[r][dt] * sc; }
        }
        const int ncmax = t0 >> 4;
        {
            int l31c = l31, hc = h; asm volatile("" : "+v"(l31c), "+v"(hc));
            const bf16_t* KB = (const bf16_t*)(p.ws + WS_KC) + (size_t)bg * 8 * 4096; const bf16_t* VB = (const bf16_t*)(p.ws + WS_VC) + (size_t)bg * 8 * 4096;
            float lc[2] = {0.f, 0.f};
            const int kt_last = ncmax > 0 ? ((ncmax - 1) & ~31) : -32;
            if (ncmax > 0) {
                dense_load_k(cur.ka, KB, 0, l31c, hc);
                for (int kt = 0; kt <= kt_last; kt += 32) {
                    dense_load_k(nxtk, KB, kt + 32 <= kt_last ? kt + 32 : kt_last, l31c, hc);
                    __builtin_amdgcn_sched_barrier(0);
#pragma unroll
                    for (int r = 0; r < 2; ++r) {
                        const f32x16 sacc = dense_scores(cur, qf[r]);
                        if (t0 - 31 - 16 * (kt + 31) >= HBN - 1) {
                            const float bfar = hb[HBN - 1] - mhv;
#pragma unroll
                            for (int q = 0; q < 16; ++q) lc[r] += __builtin_amdgcn_exp2f(sacc[q] + bfar);
                        } else {
                        const int dbase = tok[r] - 31 - 16 * (kt + 4 * hc);
#pragma unroll
                        for (int q = 0; q < 16; ++q) { const int dist = dbase - 16 * ((q & 3) + 8 * (q >> 2)); const int di = dist < 0 ? 0 : (dist > HBN - 1 ? HBN - 1 : dist);
                            const float e0 = __builtin_amdgcn_exp2f(sacc[q] + hb[di] - mhv); lc[r] += dist >= 0 ? e0 : 0.f; }
                        }
                    }
#pragma unroll
                    for (int ks = 0; ks < 4; ++ks) cur.ka[ks] = nxtk[ks];
                }
            }
            float linv[2];
#pragma unroll
            for (int r = 0; r < 2; ++r) { const float l = lc[r] + __shfl_xor(lc[r], 32); linv[r] = l > 0.f ? 1.f / l : 0.f; }
            { const f32x4 z = {0.f, 0.f, 0.f, 0.f};
#pragma unroll
              for (int i = 0; i < 8; ++i) *(LAS f32x4*)(pslc + (i * 64 + lane) * 4) = z; }
            if (ncmax > 0) {
                float carry[2] = {0.f, 0.f};
                dense_load_k(cur.ka, KB, 0, l31c, hc);
                for (int kt = 0; kt <= kt_last; kt += 32) {
                    dense_load_v(cur.va, VB, kt, l31c, hc);
                    dense_load_k(nxtk, KB, kt + 32 <= kt_last ? kt + 32 : kt_last, l31c, hc);
                    __builtin_amdgcn_sched_barrier(0);
#pragma unroll
                    for (int r = 0; r < 2; ++r) {
                        const f32x16 sacc = dense_scores(cur, qf[r]);
                        float pv[16];
                        const int dbase = tok[r] - 31 - 16 * (kt + 4 * hc);
#pragma unroll
                        for (int q = 0; q < 16; ++q) { const int dist = dbase - 16 * ((q & 3) + 8 * (q >> 2)); const int di = dist < 0 ? 0 : (dist > HBN - 1 ? HBN - 1 : dist);
                            const float e0 = __builtin_amdgcn_exp2f(sacc[q] + hb[di] - mhv); pv[q] = dist >= 0 ? e0 * linv[r] : 0.f; }
                        dense_pv(O[r], cur, pv);
#pragma unroll
                        for (int q = 0; q < 16; ++q) { pv[q] += __shfl_xor(pv[q], 1); pv[q] += __shfl_xor(pv[q], 2); }
                        float y[4];
#pragma unroll
                        for (int gq = 0; gq < 4; ++gq) y[gq] = __shfl_xor(pv[4 * gq + 3], 32);
#pragma unroll
                        for (int gq = 0; gq < 4; ++gq) { const float prevv = h ? y[gq] : (gq > 0 ? y[gq > 0 ? gq - 1 : 0] : carry[r]);
                            const float val = 2.f * ((pv[4 * gq] + pv[4 * gq + 1]) + pv[4 * gq + 2]) + pv[4 * gq + 3] + prevv;
                            if ((lane & 3) == 0) pslc[(8 * r + (l31c >> 2)) * 128 + (kt >> 2) + 2 * gq + hc] = val; }
                        carry[r] = y[3];
                    }
#pragma unroll
                    for (int ks = 0; ks < 4; ++ks) cur.ka[ks] = nxtk[ks];
                }
            }
        }
#pragma unroll
        for (int r = 0; r < 2; ++r) { int tk = tok[r]; asm volatile("" : "+v"(tk)); bf16_t* op = OW + (size_t)(b * S + tk) * D + head * 64 + 4 * h; const float gc = GATE[(size_t)(b * S + tk) * 48 + head * 3];
#pragma unroll
            for (int dt = 0; dt < 2; ++dt)
#pragma unroll
                for (int gq = 0; gq < 4; ++gq) { u32x2 w; w.x = cvt_pk_bf16(O[r][dt][4 * gq] * gc, O[r][dt][4 * gq + 1] * gc); w.y = cvt_pk_bf16(O[r][dt][4 * gq + 2] * gc, O[r][dt][4 * gq + 3] * gc);
                    *(u32x2*)(op + dt * 32 + 8 * gq) = w; } }
#pragma unroll 1
        for (int tl = 0; tl < 16; ++tl) {
            int ln = lane; asm volatile("" : "+v"(ln));
            const int t = t0 + tl, cur_b = t >> 6, j0 = ln, j1 = ln + 64;
            const float c0 = pslc[tl * 128 + j0], c1 = pslc[tl * 128 + j1];
            const bool f0 = (j0 == 0) || (j0 == cur_b) || (j0 == cur_b - 1), f1 = (j1 == cur_b) || (j1 == cur_b - 1);
            const bool v0 = j0 * 64 <= t, v1 = j1 * 64 <= t;
            const unsigned u0 = (v0 && !f0) ? __float_as_uint(c0) : 0u, u1 = (v1 && !f1) ? __float_as_uint(c1) : 0u;
            unsigned th = 1u;
            if (cur_b + 1 > NSEL) {
                th = 0u;
#pragma unroll 1
                for (int bit = 30; bit >= 0; --bit) {
                    const unsigned trial = th | (1u << bit);
                    const int cnt = __popcll(__ballot(u0 >= trial)) + __popcll(__ballot(u1 >= trial));
                    if (cnt >= NSEL - 3) { th = trial; if (cnt == NSEL - 3) break; }
                }
            }
            const bool s0 = f0 || (u0 >= th && u0 != 0u), s1 = f1 || (u1 >= th && u1 != 0u);
            const unsigned long long m0 = __ballot(s0), m1 = __ballot(s1), lt = (1ull << ln) - 1ull;
            const int p0 = __popcll(m0 & lt), p1 = __popcll(m0) + __popcll(m1 & lt);
            short* so = SEL + ((size_t)(b * S + t) * 4 + g) * NSEL;
            if (s0 && p0 < NSEL) so[p0] = (short)j0;
            if (s1 && p1 < NSEL) so[p1] = (short)j1;
        }
    }
}

constexpr int ST_ACC = 0, ST_LACC = 133120, ST_MASK = 135168, ST_LIST = 136192, ST_CTR = 138240, ST_HB4 = 138304;
__device__ __forceinline__ void lds_add_f64(unsigned addr, double v) { asm volatile("ds_add_f64 %0, %1" :: "v"(addr), "v"(v) : "memory"); }
__device__ __forceinline__ void phase_sel_tile(const Params& p, LAS unsigned char* lds, bf16_t* AO, const bf16_t* OW) {
    const int tid = opaque_tid(), lane = tid & 63, wave = tid >> 6, l31 = lane & 31, h = lane >> 5;
    LAS double* acc = (LAS double*)(lds + ST_ACC); LAS double* lacc = (LAS double*)(lds + ST_LACC);
    LAS unsigned* mask = (LAS unsigned*)(lds + ST_MASK); LAS int* list = (LAS int*)(lds + ST_LIST) + wave * 64; LAS int* ctr = (LAS int*)(lds + ST_CTR);
    const bf16_t* Q = (const bf16_t*)(p.ws + WS_Q); const float* GATE = (const float*)(p.ws + WS_GATE); const short* SEL = (const short*)(p.ws + WS_SEL);
    const int Gn = gridDim.x;
    for (int kk = 0, u = blockIdx.x; u < 16 * 128; u += Gn, ++kk) {
        const int bg = u >> 7, ti = u & 127, tt = (kk & 1) ? 127 - ti : ti, b = bg >> 2, g = bg & 3, t0 = tt * 64, cur = tt, nv = cur + 1 < NSEL ? cur + 1 : NSEL;
        for (int i = tid; i < ST_LIST / 16; i += NTHR) ((LAS u32x4*)lds)[i] = (u32x4){0u, 0u, 0u, 0u};
        if (tid == 0) *ctr = 0;
        { LAS float* hb4 = (LAS float*)(lds + ST_HB4); const float* hsrc = (const float*)(p.ws + WS_HBG) + 4 * g * HBN; for (int i = tid; i < 4 * HBN; i += NTHR) hb4[i] = hsrc[i]; }
        __syncthreads();
        { const int tl = tid >> 3; const short* sp = SEL + ((size_t)(b * S + t0 + tl) * 4 + g) * NSEL;
#pragma unroll
          for (int e = (tid & 7) * 2; e < (tid & 7) * 2 + 2; ++e) if (e < nv) { const int blk = sp[e]; __hip_atomic_fetch_or(mask + blk * 2 + (tl >> 5), 1u << (tl & 31), __ATOMIC_RELAXED, __HIP_MEMORY_SCOPE_WORKGROUP); } }
        __syncthreads();
        const int nf = cur >= 2 ? 3 : cur + 1, nitems = 2 * nf + (cur >= 3 ? cur - 2 : 0);
        const bf16_t* KB = (const bf16_t*)(p.ws + WS_KSB) + (size_t)bg * 128 * 4096; const bf16_t* VB = (const bf16_t*)(p.ws + WS_VSB) + (size_t)bg * 128 * 4096;
        const int hl = lane & 3, head = 4 * g + hl;
        const LAS float* hbg = (const LAS float*)(lds + ST_HB4) + hl * HBN; const float mhv = ((const float*)(p.ws + WS_MHG))[head], bfar = hbg[HBN - 1] - mhv;
        for (;;) {
            int it = 0; if (lane == 0) it = __hip_atomic_fetch_add(ctr, 1, __ATOMIC_RELAXED, __HIP_MEMORY_SCOPE_WORKGROUP);
            it = __builtin_amdgcn_readfirstlane(it);
            if (it >= nitems) break;
            int j, c_lo, c_hi;
            if (it < 2 * nf) { const int f = it >> 1; j = f == 0 ? cur : (f == 1 ? cur - 1 : 0); c_lo = (it & 1) * 4; c_hi = c_lo + 4; }
            else { j = it - 2 * nf + 1; c_lo = 0; c_hi = 8; }
            const unsigned mlo = (unsigned)__builtin_amdgcn_readfirstlane((int)mask[2 * j]), mhi = (unsigned)__builtin_amdgcn_readfirstlane((int)mask[2 * j + 1]);
            const unsigned long long m = ((unsigned long long)mhi << 32) | mlo; const int n = __popcll(m), nch = (n + 7) >> 3;
            if (c_hi > nch) c_hi = nch;
            if (c_lo >= c_hi) continue;
            if ((m >> lane) & 1ull) list[__popcll(m & ((1ull << lane) - 1ull))] = lane;
            DFrag fr0, fr1;
            dense_load_k(fr0.ka, KB, j * 64, l31, h); dense_load_v(fr0.va, VB, j * 64, l31, h);
            dense_load_k(fr1.ka, KB, j * 64 + 32, l31, h); dense_load_v(fr1.va, VB, j * 64 + 32, l31, h);
            bf16x8 qn[4];
            { const int slot = c_lo * 8 + (l31 >> 2); const int tokl = list[slot < n ? slot : n - 1]; const bf16_t* qp = Q + (size_t)(b * S + t0 + tokl) * D + head * 64 + 8 * h;
#pragma unroll
              for (int ks = 0; ks < 4; ++ks) qn[ks] = *(const bf16x8*)(qp + 16 * ks); }
            for (int c = c_lo; c < c_hi; ++c) {
                const int slot = c * 8 + (l31 >> 2); const bool valid = slot < n; const int tokl = list[valid ? slot : n - 1], tok = t0 + tokl;
                bf16x8 qf[4];
#pragma unroll
                for (int ks = 0; ks < 4; ++ks) qf[ks] = qn[ks];
                { const int sn = (c + 1 < c_hi ? c + 1 : c) * 8 + (l31 >> 2); const int tn = list[sn < n ? sn : n - 1]; const bf16_t* qp = Q + (size_t)(b * S + t0 + tn) * D + head * 64 + 8 * h;
#pragma unroll
                  for (int ks = 0; ks < 4; ++ks) qn[ks] = *(const bf16x8*)(qp + 16 * ks); }
                __builtin_amdgcn_sched_barrier(0);
                f32x16 O[2]; float ls = 0.f;
#pragma unroll
                for (int dt = 0; dt < 2; ++dt)
#pragma unroll
                    for (int q = 0; q < 16; ++q) O[dt][q] = 0.f;
#pragma unroll
                for (int half = 0; half < 2; ++half) {
                    const int kt = j * 64 + 32 * half; const DFrag& fr = half ? fr1 : fr0;
                    const f32x16 sacc = dense_scores(fr, qf); float ev[16];
                    if (t0 - kt - 31 >= HBN - 1) {
#pragma unroll
                        for (int q = 0; q < 16; ++q) { ev[q] = __builtin_amdgcn_exp2f(sacc[q] + bfar); ls += ev[q]; }
                    } else { const int dbase = tok - kt - 4 * h;
#pragma unroll
                        for (int q = 0; q < 16; ++q) { const int dist = dbase - ((q & 3) + 8 * (q >> 2)); const int di = dist < 0 ? 0 : (dist > HBN - 1 ? HBN - 1 : dist);
                            const float e0 = __builtin_amdgcn_exp2f(sacc[q] + hbg[di] - mhv); ev[q] = dist >= 0 ? e0 : 0.f; ls += ev[q]; } }
                    dense_pv(O, fr, ev);
                }
                const float lt = ls + __shfl_xor(ls, 32);
                if (valid) {
                    const unsigned a0 = (unsigned)(size_t)(acc + (tokl * 4 + hl) * 65 + 4 * h);
#pragma unroll
                    for (int dt = 0; dt < 2; ++dt)
#pragma unroll
                        for (int q = 0; q < 16; ++q) lds_add_f64(a0 + (dt * 32 + (q & 3) + 8 * (q >> 2)) * 8, (double)O[dt][q]);
                    if (h == 0) lds_add_f64((unsigned)(size_t)(lacc + tokl * 4 + hl), (double)lt);
                }
            }
        }
        __syncthreads();
        for (int r0 = wave * 32; r0 < wave * 32 + 32; r0 += 8) {
            float gv[8], ov[8];
#pragma unroll
            for (int i = 0; i < 8; ++i) { const int r = r0 + i, tokl = r >> 2, hd = r & 3; const size_t ur = (size_t)(b * S + t0 + tokl);
                gv[i] = GATE[ur * 48 + (4 * g + hd) * 3 + 1]; ov[i] = bf2f(OW[ur * D + (4 * g + hd) * 64 + lane]); }
#pragma unroll
            for (int i = 0; i < 8; ++i) { const int r = r0 + i, tokl = r >> 2, hd = r & 3; const size_t ur = (size_t)(b * S + t0 + tokl);
                const float o = (float)acc[r * 65 + lane] * (1.f / (float)lacc[r]) * gv[i] + ov[i];
                AO[ur * D + (4 * g + hd) * 64 + lane] = (bf16_t)(cvt_pk_bf16(o, 0.f) & 0xffffu); }
        }
        __syncthreads();
    }
}

__device__ __forceinline__ void moe_pstarts(const unsigned* ctl, int (&pst)[NE + 1]) {
    int a = 0;
#pragma unroll
    for (int e = 0; e < NE; ++e) { pst[e] = a; const int c = (int)ctl[CW_CNT + 64 * e]; a += (c + 511) / 512 * 512; }
    pst[NE] = a;
}
__device__ __forceinline__ void phase_moe_sort(const Params& p, LAS unsigned char* lds) {
    const int tid = opaque_tid(), lane = tid & 63, wave = tid >> 6;
    unsigned* ctl = (unsigned*)(p.ws + WS_CTL);
    const int* TOPE = (const int*)(p.ws + WS_TOPE); int* RPOS = (int*)(p.ws + WS_RPOS);
    const bf16_t* HB = (const bf16_t*)(p.ws + WS_HB); bf16_t* XS = (bf16_t*)(p.ws + WS_XS);
    LAS int* wcnt = (LAS int*)lds;
    LAS int* base = (LAS int*)(lds + 128);
    LAS int* posl = (LAS int*)(lds + 256);
    int pst[NE + 1]; moe_pstarts(ctl, pst);
    if (blockIdx.x == 0 && tid <= NE) ((int*)(ctl + 256))[tid] = pst[tid];
    for (int c0 = blockIdx.x * 256; c0 < 2 * T; c0 += gridDim.x * 256) {
        int e = 0, rank = 0;
        if (wave < 4) { e = TOPE[c0 + wave * 64 + lane];
#pragma unroll
            for (int q = 0; q < NE; ++q) { const unsigned long long m = __ballot(e == q); if (e == q) rank = __popcll(m & ((1ull << lane) - 1ull)); if (lane == 0) wcnt[wave * NE + q] = __popcll(m); } }
        __syncthreads();
        if (tid < NE) { const int n = wcnt[tid] + wcnt[NE + tid] + wcnt[2 * NE + tid] + wcnt[3 * NE + tid]; base[tid] = n ? (int)atomicAdd(ctl + CW_CUR + 64 * tid, (unsigned)n) : 0; }
        __syncthreads();
        if (wave < 4) { int off = 0;
            for (int w = 0; w < wave; ++w) off += wcnt[w * NE + e];
            const int pos = pst[e] + base[e] + off + rank; posl[wave * 64 + lane] = pos; RPOS[c0 + wave * 64 + lane] = pos; }
        __syncthreads();
        for (int j = wave * 32; j < wave * 32 + 32; j += 8) {
            u32x4 v0[8]; int ps[8];
#pragma unroll
            for (int q = 0; q < 8; ++q) { const int tk = (c0 + j + q) >> 1; ps[q] = posl[j + q]; v0[q] = *((const u32x4*)((const unsigned char*)HB + (size_t)tk * D) + lane); }
#pragma unroll
            for (int q = 0; q < 8; ++q) *((u32x4*)((unsigned char*)XS + (size_t)ps[q] * D) + lane) = v0[q];
        }
        __syncthreads();
    }
}
__device__ __forceinline__ void phase_combine(const Params& p) {
    const int tid = opaque_tid(), lane = tid & 63, wave = tid >> 6;
    const int gw = blockIdx.x * NWAVE + wave, NGW = gridDim.x * NWAVE;
    const float* TOPW = (const float*)(p.ws + WS_TOPW); const int* RPOS = (const int*)(p.ws + WS_RPOS);
    const bf16_t* Y = (const bf16_t*)(p.ws + WS_Y); const float* g2 = (const float*)(p.ws + WS_MODV) + (11 * 4) * D;
    for (int r = gw; r < T; r += NGW) {
        const int b = r >> 13; const int p0 = RPOS[2 * r], p1 = RPOS[2 * r + 1]; const float w0 = TOPW[2 * r], w1 = TOPW[2 * r + 1];
#pragma unroll
        for (int j = 0; j < 4; ++j) { const int c = 4 * lane + 256 * j;
            const u32x2 y0 = *(const u32x2*)(Y + (size_t)p0 * D + c), y1 = *(const u32x2*)(Y + (size_t)p1 * D + c);
            const f32x4 gv = *(const f32x4*)(g2 + b * D + c); f32x4 xv = *(const f32x4*)(p.out + (size_t)r * D + c);
            f32x4 f; f.x = w0 * bflo(y0.x) + w1 * bflo(y1.x); f.y = w0 * bfhi(y0.x) + w1 * bfhi(y1.x); f.z = w0 * bflo(y0.y) + w1 * bflo(y1.y); f.w = w0 * bfhi(y0.y) + w1 * bfhi(y1.y);
            *(f32x4*)(p.out + (size_t)r * D + c) = xv + gv * f; }
    }
}

#define XB_TMO      128
#define XB_XCNT(j)  (256  + 64 * (j))
#define XB_XSUB(j)  (1280 + 64 * (j))
#define XB_XGEN(j)  (2304 + 64 * (j))
#define XB_TOP      3328
#define XB_TOPGEN   3392
#define XCD_BAR_WORDS 3456
#define XB_SPIN_CAP (1u << 18)
__device__ __forceinline__ unsigned xb_ld(unsigned* p)              { return __hip_atomic_load(p, __ATOMIC_RELAXED, __HIP_MEMORY_SCOPE_AGENT); }
__device__ __forceinline__ unsigned xb_add(unsigned* p, unsigned v) { return __hip_atomic_fetch_add(p, v, __ATOMIC_RELAXED, __HIP_MEMORY_SCOPE_AGENT); }
__device__ __forceinline__ unsigned xb_xcc_id() { return (unsigned)__builtin_amdgcn_s_getreg((3 << 11) | 20) & 0xFu; }
#define XB_SPIN(cond, bar) do { unsigned _sp = 0; while (cond) { __builtin_amdgcn_s_sleep(1); \
    if ((++_sp & 255u) == 0u) { if (xb_ld(&(bar)[XB_TMO])) break; if (_sp > XB_SPIN_CAP) { atomicAdd(&(bar)[XB_TMO], 1u); break; } } } } while (0)
struct XcdBarrier { unsigned* bar; unsigned x; volatile LAS unsigned* st; };
__device__ __forceinline__ XcdBarrier xcd_barrier_post(unsigned* bar, volatile LAS unsigned* st) {
    XcdBarrier b; b.bar = bar; b.x = xb_xcc_id(); b.st = st;
    if (threadIdx.x == 0) (void)xb_add(&bar[XB_XCNT(b.x)], 1u);
    return b;
}
__device__ __forceinline__ void xcd_barrier_complete(unsigned* bar, unsigned x, unsigned& nloc, unsigned& nx) {
    const unsigned G_ = gridDim.x * gridDim.y * gridDim.z;
    unsigned sum, cnt, mine, sp = 0u;
    for (;;) {
        sum = 0u; cnt = 0u; mine = 0u;
#pragma unroll
        for (unsigned j = 0; j < 16; ++j) { const unsigned c = xb_ld(&bar[XB_XCNT(j)]); sum += c; cnt += (c > 0u) ? 1u : 0u; mine = (j == x) ? c : mine; }
        if (sum == G_) break;
        __builtin_amdgcn_s_sleep(1);
        if ((++sp & 255u) == 0u) { if (xb_ld(&bar[XB_TMO])) break; if (sp > XB_SPIN_CAP) { atomicAdd(&bar[XB_TMO], 1u); break; } }
    }
    nloc = mine > 0u ? mine : 1u; nx = cnt > 0u ? cnt : 1u;
}
__device__ __forceinline__ void xcd_barrier(const XcdBarrier& b) {
    asm volatile("s_waitcnt vmcnt(0)" ::: "memory");
    __syncthreads();
    if (threadIdx.x == 0) {
        unsigned* bar = b.bar;
        __builtin_amdgcn_s_waitcnt(0);
        unsigned nloc = b.st[0], nx = b.st[1];
        if (nloc == 0u) { xcd_barrier_complete(bar, b.x, nloc, nx); b.st[0] = nloc; b.st[1] = nx; }
        const unsigned old = xb_add(&bar[XB_XSUB(b.x)], 1u);
        const unsigned gen = old / nloc;
        if (old + 1u == (gen + 1u) * nloc) {
            __builtin_amdgcn_fence(__ATOMIC_RELEASE, "agent");
            asm volatile("s_waitcnt vmcnt(0)" ::: "memory");
            const unsigned og = xb_add(&bar[XB_TOP], 1u);
            const unsigned tg = og / nx;
            if (og + 1u == (tg + 1u) * nx) xb_add(&bar[XB_TOPGEN], 1u);
            else XB_SPIN(xb_ld(&bar[XB_TOPGEN]) == tg, bar);
            __builtin_amdgcn_fence(__ATOMIC_ACQUIRE, "agent");
            xb_add(&bar[XB_XGEN(b.x)], 1u);
            asm volatile("s_waitcnt vmcnt(0)" ::: "memory");
        } else {
            XB_SPIN(xb_ld(&bar[XB_XGEN(b.x)]) == gen, bar);
            __builtin_amdgcn_fence(__ATOMIC_ACQUIRE, "agent");
            asm volatile("s_waitcnt vmcnt(0)" ::: "memory");
        }
    }
    __syncthreads();
}

constexpr int LDS_SCRATCH = 131072, MISC_OFF = 155648, LDS_BYTES = 163840;
#define MODP(which) ((const float*)(p.ws + WS_MODV) + (size_t)(which) * 4 * D)

__global__ void __launch_bounds__(NTHR, 2) k_fused(Params p) {
    extern __shared__ __attribute__((aligned(16))) unsigned char lds_raw[];
    LAS unsigned char* lds = (LAS unsigned char*)lds_raw;
    for (int u = threadIdx.x; u < (LDS_BYTES - LDS_SCRATCH) / 4; u += NTHR) ((LAS unsigned*)(lds + LDS_SCRATCH))[u] = 0u;
    __syncthreads();
    const XcdBarrier bar = xcd_barrier_post((unsigned*)(p.ws + WS_CTL) + CW_BAR, (volatile LAS unsigned*)(lds + MISC_OFF) + 8);
#define GRID_BAR() xcd_barrier(bar)
    phase_weights(p, lds); __syncthreads(); phase_modvec(p, lds);
    GRID_BAR();
    phase_convert_fgu(p, lds); __syncthreads();
    phase_poolmix(p, lds, (bf16_t*)(p.ws + WS_HA));
    GRID_BAR();
    { pg8::Sched<1> Sc; Sc.init(T, D, gridDim.x, blockIdx.x, p.ws + WS_HA, p.ws + WO_POOL, D, 256);
      pg8::EpiEl<EpiPool> E{{p.x, (float*)(p.ws + WS_X1), MODP(2), p.pool_scale, 0}};
      pg8::gemm_phase(lds, 256, D, 256, 128, Sc, E); }
    GRID_BAR();
    { NormOut o0{p.norm_g + D, MODP(4), MODP(3), (bf16_t*)(p.ws + WS_HB)}; phase_norm<1, false, 2>(p, lds, (const float*)(p.ws + WS_X1), o0, o0); }
    GRID_BAR();
    { pg8::Sched<0> Sc; Sc.init(T, 2 * FF, gridDim.x, blockIdx.x, p.ws + WS_HB, p.ws + WO_FGU, D / 2, D / 2);
      pg8::EpiPairEl<EpiSwigluI8> E{{(bf16_t*)(p.ws + WS_HID0), FF, (const float*)(p.ws + WS_ASC), (const float*)(p.ws + WS_FGMAX)}};
      pg8::gemm_phase<pg8::EpiPairEl<EpiSwigluI8>, pg8::Sched<0>, true, true, 2>(lds, D / 2, D / 2, D / 2, 128, Sc, E); }
    GRID_BAR();
    { pg8::Sched<0> Sc; Sc.init(T, D, gridDim.x, blockIdx.x, p.ws + WS_HID0, p.ws + WO_FDN, FF, FF);
      pg8::EpiEl<EpiResid> E{{(const float*)(p.ws + WS_X1), (float*)(p.ws + WS_X2), MODP(5)}};
      pg8::gemm_phase(lds, FF, FF, FF, 128, Sc, E); }
    GRID_BAR();
    { NormOut o0{p.kv_norm_g, MODP(13), MODP(12), (bf16_t*)(p.ws + WS_HA)}; NormOut o1{p.norm_g + 2 * D, MODP(7), MODP(6), (bf16_t*)(p.ws + WS_HB)}; phase_norm<2, false>(p, lds, (const float*)(p.ws + WS_X2), o0, o1); }
    GRID_BAR();
    { pg8::Sched<0> Sc; Sc.init(T, NKV, gridDim.x, blockIdx.x, p.ws + WS_HA, p.ws + WO_KV, D, D);
      pg8::EpiEl<EpiBf16> E{{(bf16_t*)(p.ws + WS_KVB), NKV}};
      pg8::gemm_phase(lds, D, D, D, 128, Sc, E); }
    { pg8::Sched<0> Sc; Sc.init(T, D, gridDim.x, blockIdx.x, p.ws + WS_HB, p.ws + WO_Q, D, D);
      pg8::EpiEl<EpiQ> E{{(bf16_t*)(p.ws + WS_Q), (float*)(p.ws + WS_GATE), 0}};
      pg8::gemm_phase(lds, D, D, D, 128, Sc, E); }
    GRID_BAR();
    { pg8::Sched<2> Sc; Sc.init(2048, 2048, gridDim.x, blockIdx.x, p.ws + WS_KVB, p.ws + WO_CK, 16 * NKV, 2048);
      pg8::EpiEl<EpiCmp> E{{(bf16_t*)(p.ws + WS_CMPH), (const float*)(p.ws + WS_CMPB)}};
      pg8::gemm_phase(lds, 2048, 16 * NKV, 2048, (size_t)NKV * 2, Sc, E); }
    { pg8::Sched<0> Sc; Sc.init(T, 256, (int)gridDim.x - 64 > 0 ? (int)gridDim.x - 64 : 1, (int)gridDim.x > 64 ? (int)blockIdx.x - 64 : (int)blockIdx.x, p.ws + WS_HB, p.ws + WO_Q + (size_t)D * D * 2, D, D);
      pg8::EpiEl<EpiQ> E{{(bf16_t*)(p.ws + WS_Q), (float*)(p.ws + WS_GATE), D}};
      pg8::gemm_phase(lds, D, D, D, 128, Sc, E); }
    phase_headnorm(p, lds); phase_vtrans(p, lds);
    GRID_BAR();
    phase_cmp2(p, lds);
    GRID_BAR();
    attn_tables(p, lds);
    phase_dense(p, lds, (bf16_t*)(p.ws + WS_HB));
    GRID_BAR();
    phase_sel_tile(p, lds, (bf16_t*)(p.ws + WS_HA), (const bf16_t*)(p.ws + WS_HB));
    GRID_BAR();
    { pg8::Sched<0> Sc; Sc.init(T, D, gridDim.x, blockIdx.x, p.ws + WS_HA, p.ws + WO_O, D, D);
      pg8::EpiEl<EpiResid> E{{(const float*)(p.ws + WS_X2), p.out, MODP(8)}};
      pg8::gemm_phase(lds, D, D, D, 128, Sc, E); }
    GRID_BAR();
    { NormOut o0{p.norm_g + 3 * D, MODP(10), MODP(9), (bf16_t*)(p.ws + WS_HB)}; phase_norm<1, true, 1>(p, lds, p.out, o0, o0); }
    GRID_BAR();
    phase_moe_sort(p, lds);
    GRID_BAR();
    { const int* pst = (const int*)(p.ws + WS_CTL) + 256;
      pg8::Sched<3> Sc; Sc.init(pst[NE], 2 * FE, gridDim.x, blockIdx.x, p.ws + WS_XS, p.ws + WO_EGU, D / 2, D / 2, pst, (size_t)FE * D);
      pg8::EpiPairEl<EpiSwiglu8> E{{p.ws + WS_HIDM, FE}};
      pg8::gemm_phase<pg8::EpiPairEl<EpiSwiglu8>, pg8::Sched<3>, true, true, 1>(lds, D / 2, D / 2, D / 2, 128, Sc, E, 127 - 5); }
    GRID_BAR();
    { const int* pst = (const int*)(p.ws + WS_CTL) + 256;
      pg8::Sched<3> Sc; Sc.init(pst[NE], D, gridDim.x, blockIdx.x, p.ws + WS_HIDM, p.ws + WO_EDN, FE / 2, FE / 2, pst, (size_t)D * FE / 2);
      pg8::EpiEl<EpiBf16> E{{(bf16_t*)(p.ws + WS_Y), D}};
      pg8::gemm_phase<pg8::EpiEl<EpiBf16>, pg8::Sched<3>, true, true, 1>(lds, FE / 2, FE / 2, FE / 2, 128, Sc, E, 127 - 6); }
    GRID_BAR();
    phase_combine(p);
}

extern "C" void kernel_launch(void* const* d_in, const int* in_sizes, int n_in, void* d_out, int out_size, void* d_ws, size_t ws_size, hipStream_t stream) {
    if (n_in != 28 || out_size != T * D || ws_size < WS_END) { fprintf(stderr, "kernel_launch: unexpected shapes (n_in %d out %d ws %zu need %zu)\n", n_in, out_size, ws_size, (size_t)WS_END); return; }
    static int grid = 0;
    if (grid == 0) {
        int dev = 0, cus = 0, per_cu = 0;
        if (hipGetDevice(&dev) != hipSuccess || hipDeviceGetAttribute(&cus, hipDeviceAttributeMultiprocessorCount, dev) != hipSuccess) { grid = -1; return; }
        if (hipFuncSetAttribute((const void*)k_fused, hipFuncAttributeMaxDynamicSharedMemorySize, LDS_BYTES) != hipSuccess) { grid = -1; return; }
        if (hipOccupancyMaxActiveBlocksPerMultiprocessor(&per_cu, (const void*)k_fused, NTHR, LDS_BYTES) != hipSuccess || per_cu < 1) { fprintf(stderr, "kernel_launch: occupancy query says %d\n", per_cu); }
        (void)hipGetLastError();
        grid = cus;
    }
    if (grid < 0) return;
    Params p{};
    const float** pp = (const float**)&p;
    for (int i = 0; i < 28; ++i) pp[i] = (const float*)d_in[i];
    p.out = (float*)d_out; p.ws = (unsigned char*)d_ws;
    (void)hipMemsetAsync((char*)d_ws + WS_CTL, 0, CTL_BYTES, stream);
    k_fused<<<dim3(grid), dim3(NTHR), LDS_BYTES, stream>>>(p);
}
```

```cpp
#include <hip/hip_runtime.h>
#include <cstdint>
#include <cstdio>

#define LAS __attribute__((address_space(3)))
typedef unsigned short bf16_t;
typedef short bf16x8 __attribute__((ext_vector_type(8)));
typedef float f32x4 __attribute__((ext_vector_type(4)));
typedef float f32x2 __attribute__((ext_vector_type(2)));
typedef unsigned u32x4 __attribute__((ext_vector_type(4)));
typedef unsigned u32x2 __attribute__((ext_vector_type(2)));

constexpr int NB = 4, S = 8192, D = 1024, T = NB * S;
constexpr int FF = 2816, NE = 8, FE = 3584;
constexpr int NKV = 1536, NQP = 1280, NQ = 1072;
constexpr int G = 4, HD = 64, NH = 16;
constexpr int NC = 512;
constexpr int NSB = 128;
constexpr int NSEL = 16;
constexpr int WIN = 512;
constexpr int MOE_ROWS = 69632;
constexpr float EPS = 1e-6f;
constexpr int NTHR = 512, NWAVE = 8;

constexpr size_t MiB = 1u << 20;
constexpr size_t WS_CTL = 0, CTL_BYTES = 1 * MiB;
constexpr size_t WS_MODV = 1 * MiB;
constexpr size_t WS_CMPB = WS_MODV + 14 * 4 * 1024 * 4;
constexpr size_t WS_FGMAX = WS_CMPB + 4096;
constexpr size_t WS_ASC = WS_FGMAX + 2 * FF * 4;
constexpr size_t WS_HBG = 6 * MiB;
constexpr size_t WS_MHG = WS_HBG + 65536;
constexpr size_t WS_TOPE = 2 * MiB;
constexpr size_t WS_TOPW = WS_TOPE + (size_t)T * 8;
constexpr size_t WS_RPOS = WS_TOPW + (size_t)T * 8;
constexpr size_t WS_RTOK = WS_RPOS + (size_t)T * 8;
constexpr size_t WS_SMALL_END = WS_RTOK + (size_t)MOE_ROWS * 4;
static_assert(WS_SMALL_END <= 8 * MiB && WS_ASC + (size_t)T * 4 <= 2 * MiB, "small region");
constexpr size_t WS_W = 8 * MiB;
constexpr size_t WO_POOL = WS_W;
constexpr size_t WO_FGU = WO_POOL + (size_t)4 * 256 * 256 * 2;
constexpr size_t WO_FDN = WO_FGU + (size_t)2 * FF * D * 2;
constexpr size_t WO_KV = WO_FDN + (size_t)D * FF * 2;
constexpr size_t WO_Q = WO_KV + (size_t)NKV * D * 2;
constexpr size_t WO_O = WO_Q + (size_t)NQP * D * 2;
constexpr size_t WO_CK = WO_O + (size_t)D * D * 2;
constexpr size_t WO_CV = WO_CK + (size_t)256 * 2048 * 2;
constexpr size_t WO_EGU = WO_CV + (size_t)256 * 2048 * 2;
constexpr size_t WO_EDN = WO_EGU + (size_t)NE * 2 * FE * D * 2;
constexpr size_t WO_END = WO_EDN + (size_t)NE * D * FE * 2;
static_assert(WO_END <= 203 * MiB, "weights region");
constexpr size_t WS_HB = 203 * MiB;
constexpr size_t WS_X1 = 267 * MiB;
constexpr size_t WS_X2 = 395 * MiB;
constexpr size_t WS_HID0 = 523 * MiB;
constexpr size_t WS_Q = 523 * MiB;
constexpr size_t WS_GATE = 587 * MiB;
constexpr size_t WS_CMPH = 593 * MiB;
constexpr size_t WS_KC = 601 * MiB;
constexpr size_t WS_VC = 602 * MiB;
constexpr size_t WS_KSB = 603 * MiB;
constexpr size_t WS_VSB = 619 * MiB;
constexpr size_t WS_KWB = 635 * MiB;
constexpr size_t WS_VWB = 651 * MiB;
constexpr size_t WS_Q8 = 267 * MiB;
constexpr size_t WS_SEL = 667 * MiB;
constexpr size_t WS_HA = 699 * MiB;
constexpr size_t WS_KVB = 763 * MiB;
constexpr size_t WS_HIDM = 267 * MiB;
constexpr size_t WS_Y = 743 * MiB;
constexpr size_t WS_XS = WS_Y;
constexpr size_t WS_END = 880 * MiB;
static_assert(WS_HIDM + (size_t)MOE_ROWS * FE * 2 <= WS_Y && WS_Y + (size_t)MOE_ROWS * D * 2 <= WS_END, "moe map");
static_assert(WS_KVB + (size_t)T * NKV * 2 + 65536 <= WS_END, "kv map");
constexpr int CW_CNT = 512;
constexpr int CW_CUR = 1024;
constexpr int CW_HN = 2048, CW_VT = 2112;
constexpr int CW_BAR = 4096;

struct Params {
    const float *x, *c, *ada_w, *ada_b, *norm_g, *pool_w, *pool_scale, *q_w, *q_gain, *o_w, *kv_ada_w, *kv_ada_b, *kv_norm_g, *kv_w,
        *cmp_pe_k, *cmp_pe_v, *cmp_k_w1, *cmp_k_w2, *cmp_v_w1, *cmp_v_w2, *k_gain, *rel_bias, *ffn_gu, *ffn_dn, *router_w, *router_b, *exp_gu, *exp_dn;
    float* out; unsigned char* ws;
};

__device__ __forceinline__ unsigned cvt_pk_bf16(float lo, float hi) { unsigned r; asm volatile("v_cvt_pk_bf16_f32 %0, %1, %2" : "=v"(r) : "v"(lo), "v"(hi)); return r; }
__device__ __forceinline__ float bf2f(unsigned short v) { return __uint_as_float((unsigned)v << 16); }
__device__ __forceinline__ float bflo(unsigned w) { return __uint_as_float(w << 16); }
__device__ __forceinline__ float bfhi(unsigned w) { return __uint_as_float(w & 0xffff0000u); }
__device__ __forceinline__ int opaque_tid() { int t = threadIdx.x; asm volatile("" : "+v"(t)); return t; }
__device__ __forceinline__ float readlane_f(float v, int l) { return __uint_as_float((unsigned)__builtin_amdgcn_readlane((int)__float_as_uint(v), l)); }
__device__ __forceinline__ unsigned pack_i8x4(float a, float b, float c, float d) {
    const int ia = (int)__builtin_rintf(fminf(fmaxf(a, -127.f), 127.f)), ib = (int)__builtin_rintf(fminf(fmaxf(b, -127.f), 127.f)), ic = (int)__builtin_rintf(fminf(fmaxf(c, -127.f), 127.f)), id = (int)__builtin_rintf(fminf(fmaxf(d, -127.f), 127.f));
    return (unsigned)(ia & 0xff) | ((unsigned)(ib & 0xff) << 8) | ((unsigned)(ic & 0xff) << 16) | ((unsigned)(id & 0xff) << 24);
}
__device__ __forceinline__ float sel_q_scale(const float* q_gain) { float m = 0.f; for (int i = 0; i < 64; ++i) m = fmaxf(m, fabsf(q_gain[i])); return 127.f / (4.f * m * 0.125f * 1.4426950408889634f); }
__device__ __forceinline__ float sel_k_scale(const float* k_gain) { float m = 0.f; for (int i = 0; i < 64; ++i) m = fmaxf(m, fabsf(k_gain[64 + i])); return 127.f / (4.f * m); }
__device__ __forceinline__ float wave_sum(float v) {
#pragma unroll
    for (int o = 1; o < 64; o <<= 1) v += __shfl_xor(v, o);
    return v;
}
__device__ __forceinline__ float wave_max(float v) {
#pragma unroll
    for (int o = 1; o < 64; o <<= 1) v = fmaxf(v, __shfl_xor(v, o));
    return v;
}
__device__ __forceinline__ float silu_f(float v) { return v * __builtin_amdgcn_rcpf(1.f + __builtin_amdgcn_exp2f(v * -1.4426950408889634f)); }
__device__ __forceinline__ float sigmoid_f(float v) { return __builtin_amdgcn_rcpf(1.f + __builtin_amdgcn_exp2f(v * -1.4426950408889634f)); }
__device__ __forceinline__ float gelu_tanh_f(float v) {
    const float u = 0.7978845608028654f * (v + 0.044715f * v * v * v);
    const float e = __builtin_amdgcn_exp2f(fabsf(u) * -2.8853900817779268f); const float th = (1.f - e) * __builtin_amdgcn_rcpf(1.f + e);
    return 0.5f * v * (1.f + (u < 0.f ? -th : th));
}
__device__ __forceinline__ int rel_bucket(int d) {
    if (d < 16) return d;
    int b = 16;
    b += (d >= 21); b += (d >= 27); b += (d >= 35); b += (d >= 46); b += (d >= 59); b += (d >= 77); b += (d >= 99); b += (d >= 128);
    b += (d >= 166); b += (d >= 216); b += (d >= 280); b += (d >= 363); b += (d >= 470); b += (d >= 609); b += (d >= 790);
    return b;
}

template <bool FP8 = false>
__device__ __forceinline__ void transpose_item(const float* W, int K, int N, bf16_t* WT, int k0, int n0, int drow0, LAS float* scr, int lane, float wscale = 1.f) {
    float wv[32];
#pragma unroll
    for (int i = 0; i < 32; ++i) { const int kk = 2 * i + (lane >> 5); const int n = n0 + (lane & 31); wv[i] = (n < N) ? W[(size_t)(k0 + kk) * N + n] : 0.f; }
#pragma unroll
    for (int i = 0; i < 32; ++i) { const int kk = 2 * i + (lane >> 5); scr[kk * 33 + (lane & 31)] = wv[i]; }
    asm volatile("s_waitcnt lgkmcnt(0)" ::: "memory");
    const int c = lane & 7;
#pragma unroll
    for (int j = 0; j < 4; ++j) { const int n = (lane >> 3) + 8 * j; const LAS float* s = scr + (8 * c) * 33 + n;
        if constexpr (FP8) {
            unsigned w0 = 0u, w1 = 0u;
            w0 = __builtin_amdgcn_cvt_pk_fp8_f32(s[0 * 33] * wscale, s[1 * 33] * wscale, w0, false); w0 = __builtin_amdgcn_cvt_pk_fp8_f32(s[2 * 33] * wscale, s[3 * 33] * wscale, w0, true);
            w1 = __builtin_amdgcn_cvt_pk_fp8_f32(s[4 * 33] * wscale, s[5 * 33] * wscale, w1, false); w1 = __builtin_amdgcn_cvt_pk_fp8_f32(s[6 * 33] * wscale, s[7 * 33] * wscale, w1, true);
            *(u32x2*)((unsigned char*)WT + (size_t)(drow0 + n) * K + k0 + 8 * c) = (u32x2){w0, w1};
        } else {
        u32x4 o; o.x = cvt_pk_bf16(s[0 * 33], s[1 * 33]); o.y = cvt_pk_bf16(s[2 * 33], s[3 * 33]); o.z = cvt_pk_bf16(s[4 * 33], s[5 * 33]); o.w = cvt_pk_bf16(s[6 * 33], s[7 * 33]);
        *(u32x4*)(WT + (size_t)(drow0 + n) * K + k0 + 8 * c) = o; } }
    asm volatile("s_waitcnt lgkmcnt(0)" ::: "memory");
}
template <int MODE, bool FP8 = false>
__device__ __forceinline__ void transpose_mat(const float* W, int K, int N, int NP, int F, bf16_t* WT, int it, LAS float* scr, int lane, float wscale = 1.f) {
    const int nblk = NP / 32, kb = it / nblk, nb = it % nblk, n0 = nb * 32;
    int drow0 = n0;
    if (MODE == 1) { const int up = n0 >= F, j = up ? n0 - F : n0; drow0 = (j >> 7) * 256 + (up ? 128 : 0) + (j & 127); }
    transpose_item<FP8>(W, K, N, WT, kb * 64, n0, drow0, scr, lane, wscale);
}
__device__ __forceinline__ void phase_convert_fgu(const Params& p, LAS unsigned char* lds) {
    const int tid = opaque_tid(), lane = tid & 63, wave = tid >> 6;
    LAS float* scr = (LAS float*)(lds + wave * 16384);
    const int gw = blockIdx.x * NWAVE + wave, NGW = gridDim.x * NWAVE;
    const float* FGMAX = (const float*)(p.ws + WS_FGMAX); unsigned char* WT = p.ws + WO_FGU;
    for (int it = gw; it < 16 * 176; it += NGW) {
        const int kb = it / 176, nb = it % 176, n0 = nb * 32, k0 = kb * 64;
        const int up = n0 >= FF, j0 = up ? n0 - FF : n0, drow0 = (j0 >> 7) * 256 + (up ? 128 : 0) + (j0 & 127);
        float wv[32];
#pragma unroll
        for (int i = 0; i < 32; ++i) wv[i] = p.ffn_gu[(size_t)(k0 + 2 * i + (lane >> 5)) * (2 * FF) + n0 + (lane & 31)];
#pragma unroll
        for (int i = 0; i < 32; ++i) scr[(2 * i + (lane >> 5)) * 33 + (lane & 31)] = wv[i];
        asm volatile("s_waitcnt lgkmcnt(0)" ::: "memory");
        const int c = lane & 7;
#pragma unroll
        for (int j = 0; j < 4; ++j) { const int n = (lane >> 3) + 8 * j; const LAS float* sp = scr + (8 * c) * 33 + n; const float sc = 127.f / FGMAX[n0 + n];
            const unsigned w0 = pack_i8x4(sp[0 * 33] * sc, sp[1 * 33] * sc, sp[2 * 33] * sc, sp[3 * 33] * sc), w1 = pack_i8x4(sp[4 * 33] * sc, sp[5 * 33] * sc, sp[6 * 33] * sc, sp[7 * 33] * sc);
            *(u32x2*)(WT + (size_t)(drow0 + n) * D + k0 + 8 * c) = (u32x2){w0, w1}; }
        asm volatile("s_waitcnt lgkmcnt(0)" ::: "memory");
    }
}
__device__ __forceinline__ void phase_weights(const Params& p, LAS unsigned char* lds) {
    const int tid = opaque_tid(), lane = tid & 63, wave = tid >> 6;
    LAS float* scr = (LAS float*)(lds + wave * 16384);
    const int gw = blockIdx.x * NWAVE + wave, NGW = gridDim.x * NWAVE;
    unsigned char* ws = p.ws;
    constexpr int I_POOL = 4 * 8, I_FGU = 16 * 176, I_FDN = 44 * 32, I_KV = 16 * 48, I_Q = 16 * 40, I_O = 16 * 32, I_C = 32 * 8, I_EGU = 16 * 224, I_EDN = 56 * 32;
    constexpr int TOT = 4 * I_POOL + I_FGU + I_FDN + I_KV + I_Q + I_O + 2 * I_C + NE * I_EGU + NE * I_EDN;
    for (int it = gw; it < TOT; it += NGW) {
        int r = it;
        if (r < 4 * I_POOL) { const int g = r / I_POOL; transpose_mat<0>(p.pool_w + (size_t)g * 65536, 256, 256, 256, 0, (bf16_t*)(ws + WO_POOL) + (size_t)g * 65536, r % I_POOL, scr, lane); continue; } r -= 4 * I_POOL;
        if (r < I_FGU) continue; r -= I_FGU;
        if (r < I_FDN) { transpose_mat<0>(p.ffn_dn, FF, D, D, 0, (bf16_t*)(ws + WO_FDN), r, scr, lane); continue; } r -= I_FDN;
        if (r < I_KV) { transpose_mat<0>(p.kv_w, D, NKV, NKV, 0, (bf16_t*)(ws + WO_KV), r, scr, lane); continue; } r -= I_KV;
        if (r < I_Q) { transpose_mat<0>(p.q_w, D, NQ, NQP, 0, (bf16_t*)(ws + WO_Q), r, scr, lane); continue; } r -= I_Q;
        if (r < I_O) { transpose_mat<0>(p.o_w, D, D, D, 0, (bf16_t*)(ws + WO_O), r, scr, lane); continue; } r -= I_O;
        if (r < I_C) { transpose_mat<0>(p.cmp_k_w1, 2048, 256, 256, 0, (bf16_t*)(ws + WO_CK), r, scr, lane); continue; } r -= I_C;
        if (r < I_C) { transpose_mat<0>(p.cmp_v_w1, 2048, 256, 256, 0, (bf16_t*)(ws + WO_CV), r, scr, lane); continue; } r -= I_C;
        if (r < NE * I_EGU) { const int e = r / I_EGU; transpose_mat<1, true>(p.exp_gu + (size_t)e * D * 2 * FE, D, 2 * FE, 2 * FE, FE, (bf16_t*)(ws + WO_EGU + (size_t)e * 2 * FE * D), r % I_EGU, scr, lane, 32.f); continue; } r -= NE * I_EGU;
        { const int e = r / I_EDN; transpose_mat<0, true>(p.exp_dn + (size_t)e * FE * D, FE, D, D, 0, (bf16_t*)(ws + WO_EDN + (size_t)e * D * FE), r % I_EDN, scr, lane, 64.f); }
    }
}

__device__ __forceinline__ void phase_modvec(const Params& p, LAS unsigned char* lds) {
    const int tid = opaque_tid(), lane = tid & 63, wave = tid >> 6;
    LAS float* part = (LAS float*)lds;
    LAS float* sc_l = (LAS float*)(lds + 8192);
    for (int i = tid; i < 4 * D; i += NTHR) sc_l[i] = silu_f(p.c[i]);
    __syncthreads();
    float* MODV = (float*)(p.ws + WS_MODV);
    float* CMPB = (float*)(p.ws + WS_CMPB);
    { float* FGMAX = (float*)(p.ws + WS_FGMAX);
      for (int u = blockIdx.x; u < 2 * FF / 64; u += gridDim.x) {
        const int col = u * 64 + lane; float m = 0.f;
#pragma unroll 16
        for (int k = wave * 128; k < wave * 128 + 128; ++k) m = fmaxf(m, fabsf(p.ffn_gu[(size_t)k * (2 * FF) + col]));
        part[wave * 64 + lane] = m;
        __syncthreads();
        if (tid < 64) { float mm = part[lane];
#pragma unroll
            for (int w = 1; w < 8; ++w) mm = fmaxf(mm, part[w * 64 + lane]);
            FGMAX[u * 64 + lane] = fmaxf(mm, 1e-30f); }
        __syncthreads();
      } }
    constexpr int NU_MOD = 14336 / 64, NU = NU_MOD + 8;
    for (int u = blockIdx.x; u < NU; u += gridDim.x) {
        float acc[4] = {0.f, 0.f, 0.f, 0.f};
        if (u < NU_MOD) {
            const int gc = u * 64 + lane;
            const float* W; int ldw, col;
            if (gc < 6144) { W = p.ada_w; ldw = 6144; col = gc; } else if (gc < 12288) { W = p.ada_w + (size_t)D * 6144; ldw = 6144; col = gc - 6144; } else { W = p.kv_ada_w; ldw = 2048; col = gc - 12288; }
#pragma unroll 16
            for (int k = wave * 128; k < wave * 128 + 128; ++k) {
                const float w = W[(size_t)k * ldw + col];
#pragma unroll
                for (int b = 0; b < 4; ++b) acc[b] += sc_l[b * D + k] * w;
            }
        } else {
            const int cu = u - NU_MOD, kv = cu >> 2, col = (cu & 3) * 64 + lane;
            const float* W = kv ? p.cmp_v_w1 : p.cmp_k_w1; const float* pe = kv ? p.cmp_pe_v : p.cmp_pe_k;
#pragma unroll 16
            for (int k = wave * 256; k < wave * 256 + 256; ++k) acc[0] += pe[k] * W[(size_t)k * 256 + col];
        }
#pragma unroll
        for (int b = 0; b < 4; ++b) part[(wave * 4 + b) * 64 + lane] = acc[b];
        __syncthreads();
        if (tid < 256) {
            const int b = tid >> 6; float s = 0.f;
#pragma unroll
            for (int w = 0; w < 8; ++w) s += part[(w * 4 + b) * 64 + lane];
            if (u < NU_MOD) {
                const int gc = u * 64 + lane; int which, n; float bias;
                if (gc < 6144) { which = gc >> 10; n = gc & 1023; bias = p.ada_b[gc]; } else if (gc < 12288) { which = 6 + ((gc - 6144) >> 10); n = gc & 1023; bias = p.ada_b[gc]; }
                else { which = 12 + ((gc - 12288) >> 10); n = gc & 1023; bias = p.kv_ada_b[gc - 12288]; }
                MODV[(which * 4 + b) * D + n] = s + bias;
            } else if (b == 0) { const int cu = u - NU_MOD; CMPB[(cu >> 2) * 256 + (cu & 3) * 64 + lane] = s; }
        }
        __syncthreads();
    }
}

template <int W>
__device__ __forceinline__ void pool_rows(const float* xb, int t0, const LAS float* rs, f32x2 gm, f32x2 sh, bf16_t* outb, int c0) {
    f32x2 ring[16];
#pragma unroll
    for (int i = 0; i < 15; ++i) {
        const int t = t0 - 15 + i; f32x2 h = {0.f, 0.f};
        if (t >= 0) { const f32x2 xv = *(const f32x2*)(xb + (size_t)t * D + c0); const float r = rs[i]; h = xv * r * gm + sh; }
        ring[i] = h;
    }
    for (int gi = 0; gi < 8; ++gi) {
#pragma unroll
        for (int j = 0; j < 16; ++j) {
            const int i = 15 + gi * 16 + j, t = t0 + gi * 16 + j;
            const f32x2 xv = *(const f32x2*)(xb + (size_t)t * D + c0); const float r = rs[i];
            const f32x2 h = xv * r * gm + sh;
            ring[(15 + j) & 15] = h;
            f32x2 s = {0.f, 0.f};
#pragma unroll
            for (int k = 0; k < W; ++k) s += ring[(15 + j - k) & 15];
            const int cnt = (t + 1 < W) ? t + 1 : W;
            const f32x2 o = s * (1.f / (float)cnt) - h;
            *(unsigned*)(outb + (size_t)t * D + c0) = cvt_pk_bf16(o.x, o.y);
        }
    }
}
__device__ __forceinline__ void phase_poolmix(const Params& p, LAS unsigned char* lds, bf16_t* mixA) {
    const int tid = opaque_tid(), lane = tid & 63, wave = tid >> 6;
    LAS float* rs = (LAS float*)lds;
    const float* MODV = (const float*)(p.ws + WS_MODV);
    for (int u = blockIdx.x; u < T / 128; u += gridDim.x) {
        const int b = u >> 6, t0 = (u & 63) * 128;
        const float* xb = p.x + (size_t)b * S * D;
        for (int i = wave; i < 143; i += NWAVE) {
            const int t = t0 - 15 + i; float r = 0.f;
            if (t >= 0) { const f32x4* xr = (const f32x4*)(xb + (size_t)t * D) + lane; float s = 0.f;
#pragma unroll
                for (int j = 0; j < 4; ++j) { const f32x4 v = xr[64 * j]; s += (v.x * v.x + v.y * v.y) + (v.z * v.z + v.w * v.w); }
                r = 1.f / sqrtf(wave_sum(s) * (1.f / D) + EPS); }
            if (lane == 0) rs[i] = r;
        }
        __syncthreads();
        const int c0 = 2 * tid;
        const f32x2 g = *(const f32x2*)(p.norm_g + c0), sc = *(const f32x2*)(MODV + (1 * 4 + b) * D + c0), sh = *(const f32x2*)(MODV + (0 * 4 + b) * D + c0);
        const f32x2 gm = g * (sc + 1.f);
        bf16_t* ob = mixA + (size_t)b * S * D;
        const int grp = tid >> 7;
        if (grp == 0) pool_rows<2>(xb, t0, rs, gm, sh, ob, c0);
        else if (grp == 1) pool_rows<4>(xb, t0, rs, gm, sh, ob, c0);
        else if (grp == 2) pool_rows<8>(xb, t0, rs, gm, sh, ob, c0);
        else pool_rows<16>(xb, t0, rs, gm, sh, ob, c0);
        __syncthreads();
    }
}

struct NormOut { const float* g; const float* sc; const float* sh; bf16_t* out; };
template <int NOUT, bool ROUTER, int OUTQ = 0>
__device__ __forceinline__ void phase_norm(const Params& p, LAS unsigned char* lds, const float* xin, const NormOut o0, const NormOut o1) {
    const int tid = opaque_tid(), lane = tid & 63, wave = tid >> 6;
    const int gw = blockIdx.x * NWAVE + wave, NGW = gridDim.x * NWAVE;
    f32x4 rwa[16], rwb[16];
    if (ROUTER) {
#pragma unroll
        for (int j = 0; j < 4; ++j)
#pragma unroll
            for (int q = 0; q < 4; ++q) { const f32x4* wp = (const f32x4*)(p.router_w + (size_t)(4 * lane + 256 * j + q) * NE); rwa[4 * j + q] = wp[0]; rwb[4 * j + q] = wp[1]; }
    }
    unsigned* ctl = (unsigned*)(p.ws + WS_CTL);
    int* TOPE = (int*)(p.ws + WS_TOPE); float* TOPW = (float*)(p.ws + WS_TOPW);
    unsigned cnt_local[NE];
#pragma unroll
    for (int e = 0; e < NE; ++e) cnt_local[e] = 0;
    const int rows_per = T / NGW > 0 ? (T + NGW - 1) / NGW : 1;
    const int r0 = gw * rows_per, r1 = (r0 + rows_per < T) ? r0 + rows_per : T;
    int curb = -1; f32x4 gm0[4], sh0[4], gm1[4], sh1[4];
    for (int r = r0; r < r1; ++r) {
        const int b = r >> 13;
        if (b != curb) { curb = b;
#pragma unroll
            for (int j = 0; j < 4; ++j) { const int c = 4 * lane + 256 * j;
                gm0[j] = *(const f32x4*)(o0.g + c) * (*(const f32x4*)(o0.sc + b * D + c) + 1.f); sh0[j] = *(const f32x4*)(o0.sh + b * D + c);
                if (NOUT > 1) { gm1[j] = *(const f32x4*)(o1.g + c) * (*(const f32x4*)(o1.sc + b * D + c) + 1.f); sh1[j] = *(const f32x4*)(o1.sh + b * D + c); } } }
        const f32x4* xr = (const f32x4*)(xin + (size_t)r * D) + lane;
        f32x4 v[4]; float s = 0.f;
#pragma unroll
        for (int j = 0; j < 4; ++j) { v[j] = xr[64 * j]; s += (v[j].x * v[j].x + v[j].y * v[j].y) + (v[j].z * v[j].z + v[j].w * v[j].w); }
        const float rstd = 1.f / sqrtf(wave_sum(s) * (1.f / D) + EPS);
        float lg[NE];
#pragma unroll
        for (int e = 0; e < NE; ++e) lg[e] = 0.f;
        float qsc = 1.f;
        if constexpr (OUTQ == 2) { float mx = 0.f;
#pragma unroll
            for (int j = 0; j < 4; ++j) { const f32x4 h = v[j] * rstd * gm0[j] + sh0[j]; mx = fmaxf(mx, fmaxf(fmaxf(fabsf(h.x), fabsf(h.y)), fmaxf(fabsf(h.z), fabsf(h.w)))); }
            mx = fmaxf(wave_max(mx), 1e-30f); qsc = 127.f / mx;
            if (lane == 0) ((float*)(p.ws + WS_ASC))[r] = mx * (1.f / 127.f); }
#pragma unroll
        for (int j = 0; j < 4; ++j) {
            const f32x4 h = v[j] * rstd * gm0[j] + sh0[j];
            if constexpr (OUTQ == 2) { *(unsigned*)((unsigned char*)o0.out + (size_t)r * D + 4 * lane + 256 * j) = pack_i8x4(h.x * qsc, h.y * qsc, h.z * qsc, h.w * qsc); }
            else if constexpr (OUTQ == 1) { unsigned w8 = 0u; w8 = __builtin_amdgcn_cvt_pk_fp8_f32(h.x, h.y, w8, false); w8 = __builtin_amdgcn_cvt_pk_fp8_f32(h.z, h.w, w8, true);
                *(unsigned*)((unsigned char*)o0.out + (size_t)r * D + 4 * lane + 256 * j) = w8; }
            else { u32x2 w; w.x = cvt_pk_bf16(h.x, h.y); w.y = cvt_pk_bf16(h.z, h.w);
            *(u32x2*)(o0.out + (size_t)r * D + 4 * lane + 256 * j) = w; }
            if (NOUT > 1) { const f32x4 h1 = v[j] * rstd * gm1[j] + sh1[j]; u32x2 w1; w1.x = cvt_pk_bf16(h1.x, h1.y); w1.y = cvt_pk_bf16(h1.z, h1.w);
                *(u32x2*)(o1.out + (size_t)r * D + 4 * lane + 256 * j) = w1; }
            if (ROUTER) {
#pragma unroll
                for (int q = 0; q < 4; ++q) { const f32x4 a = rwa[4 * j + q], c2 = rwb[4 * j + q]; const float hv = h[q];
                    lg[0] += hv * a.x; lg[1] += hv * a.y; lg[2] += hv * a.z; lg[3] += hv * a.w; lg[4] += hv * c2.x; lg[5] += hv * c2.y; lg[6] += hv * c2.z; lg[7] += hv * c2.w; }
            }
        }
        if (ROUTER) {
            {
                const bool u5 = lane & 32, u4 = lane & 16, u3 = lane & 8; float a4[4], a2[2], a1;
#pragma unroll
                for (int i = 0; i < 4; ++i) a4[i] = (u5 ? lg[4 + i] : lg[i]) + __shfl_xor(u5 ? lg[i] : lg[4 + i], 32);
#pragma unroll
                for (int i = 0; i < 2; ++i) a2[i] = (u4 ? a4[2 + i] : a4[i]) + __shfl_xor(u4 ? a4[i] : a4[2 + i], 16);
                a1 = (u3 ? a2[1] : a2[0]) + __shfl_xor(u3 ? a2[0] : a2[1], 8);
                a1 += __shfl_xor(a1, 4); a1 += __shfl_xor(a1, 2); a1 += __shfl_xor(a1, 1);
#pragma unroll
                for (int e = 0; e < NE; ++e) lg[e] = readlane_f(a1, 8 * e) + p.router_b[e];
            }
            int e0 = 0; float v0 = lg[0];
#pragma unroll
            for (int e = 1; e < NE; ++e) if (lg[e] > v0) { v0 = lg[e]; e0 = e; }
            int e1 = -1; float v1 = -3.0e38f;
#pragma unroll
            for (int e = 0; e < NE; ++e) if (e != e0 && lg[e] > v1) { v1 = lg[e]; e1 = e; }
            const float ex = __expf(v1 - v0), w0 = 1.f / (1.f + ex), w1 = ex / (1.f + ex);
            if (lane == 0) { TOPE[2 * r] = e0; TOPE[2 * r + 1] = e1; TOPW[2 * r] = w0; TOPW[2 * r + 1] = w1; }
#pragma unroll
            for (int e = 0; e < NE; ++e) cnt_local[e] += (e == e0) + (e == e1);
        }
    }
    if (ROUTER) {
        LAS unsigned* lc = (LAS unsigned*)lds;
        if (tid < NE) lc[tid] = 0u;
        __syncthreads();
        if (lane == 0) {
#pragma unroll
            for (int e = 0; e < NE; ++e) if (cnt_local[e]) atomicAdd((unsigned*)(lc + e), cnt_local[e]);
        }
        __syncthreads();
        if (tid < NE && lc[tid]) atomicAdd(ctl + CW_CNT + 64 * tid, lc[tid]);
    }
}

struct NoCol {};
struct EpiPool {
    typedef f32x4 Col; static constexpr bool ROWLOAD = true;
    const float* x; float* x1; const float* g1; const float* scale; int coff;
    __device__ __forceinline__ f32x4 col(int row0, int c) const { return *(const f32x4*)(g1 + (row0 >> 13) * D + coff + c) * *(const f32x4*)(scale + coff + c); }
    __device__ __forceinline__ f32x4 rowload(int row, int c) const { return *(const f32x4*)(x + (size_t)row * D + coff + c); }
    __device__ __forceinline__ void apply(int row, int c, f32x4 v, f32x4 cg, f32x4 xv) const { *(f32x4*)(x1 + (size_t)row * D + coff + c) = xv + cg * v; }
};
struct EpiSwigluI8 {
    struct Col { f32x4 wg, wu; }; typedef float Row;
    bf16_t* hid; int ldh; const float* asc; const float* wmax;
    __device__ __forceinline__ Col col(int hc) const { Col c; c.wg = *(const f32x4*)(wmax + hc); c.wu = *(const f32x4*)(wmax + FF + hc); return c; }
    __device__ __forceinline__ float rowv(int row) const { return asc[row] * (1.f / 127.f); }
    __device__ __forceinline__ void pair(int row, int hc, f32x4 gt, f32x4 up, const Col& c, float ra) const {
        typedef int i32x4e __attribute__((ext_vector_type(4)));
        const i32x4e gi = __builtin_bit_cast(i32x4e, gt), ui = __builtin_bit_cast(i32x4e, up);
        const f32x4 wg = c.wg * ra, wu = c.wu * ra;
        const float g0 = (float)gi.x * wg.x, g1 = (float)gi.y * wg.y, g2 = (float)gi.z * wg.z, g3 = (float)gi.w * wg.w;
        u32x2 w; w.x = cvt_pk_bf16(silu_f(g0) * ((float)ui.x * wu.x), silu_f(g1) * ((float)ui.y * wu.y)); w.y = cvt_pk_bf16(silu_f(g2) * ((float)ui.z * wu.z), silu_f(g3) * ((float)ui.w * wu.w));
        *(u32x2*)(hid + (size_t)row * ldh + hc) = w; }
};
struct EpiSwiglu8 {
    typedef NoCol Col; typedef NoCol Row;
    unsigned char* hid; int ldh;
    __device__ __forceinline__ NoCol col(int) const { return NoCol{}; }
    __device__ __forceinline__ NoCol rowv(int) const { return NoCol{}; }
    __device__ __forceinline__ void pair(int row, int hc, f32x4 gt, f32x4 up, const NoCol&, NoCol) const {
        unsigned w = 0u; w = __builtin_amdgcn_cvt_pk_fp8_f32(silu_f(gt.x) * up.x, silu_f(gt.y) * up.y, w, false); w = __builtin_amdgcn_cvt_pk_fp8_f32(silu_f(gt.z) * up.z, silu_f(gt.w) * up.w, w, true);
        *(unsigned*)(hid + (size_t)row * ldh + hc) = w; }
};
struct EpiResid {
    typedef f32x4 Col; static constexpr bool ROWLOAD = true;
    const float* xin; float* out; const float* gate;
    __device__ __forceinline__ f32x4 col(int row0, int c) const { return *(const f32x4*)(gate + (row0 >> 13) * D + c); }
    __device__ __forceinline__ f32x4 rowload(int row, int c) const { return *(const f32x4*)(xin + (size_t)row * D + c); }
    __device__ __forceinline__ void apply(int row, int c, f32x4 v, f32x4 cg, f32x4 xv) const { *(f32x4*)(out + (size_t)row * D + c) = xv + cg * v; }
};
struct EpiBf16 {
    typedef NoCol Col; static constexpr bool ROWLOAD = false;
    bf16_t* o; int ldo;
    __device__ __forceinline__ NoCol col(int, int) const { return NoCol{}; }
    __device__ __forceinline__ void apply(int row, int c, f32x4 v, NoCol) const { u32x2 w; w.x = cvt_pk_bf16(v.x, v.y); w.y = cvt_pk_bf16(v.z, v.w); *(u32x2*)(o + (size_t)row * ldo + c) = w; }
};
struct EpiQ {
    typedef NoCol Col; static constexpr bool ROWLOAD = false;
    bf16_t* q; float* gates; int coff;
    __device__ __forceinline__ NoCol col(int, int) const { return NoCol{}; }
    __device__ __forceinline__ void apply(int row, int col_, f32x4 v, NoCol) const { const int col = col_ + coff;
        if (col < D) { u32x2 w; w.x = cvt_pk_bf16(v.x, v.y); w.y = cvt_pk_bf16(v.z, v.w); *(u32x2*)(q + (size_t)row * D + col) = w; }
        else if (col < NQ) { f32x4 s; s.x = sigmoid_f(v.x); s.y = sigmoid_f(v.y); s.z = sigmoid_f(v.z); s.w = sigmoid_f(v.w); *(f32x4*)(gates + (size_t)row * 48 + (col - D)) = s; } }
};
struct EpiCmp {
    typedef f32x4 Col; static constexpr bool ROWLOAD = false;
    bf16_t* o; const float* bias;
    __device__ __forceinline__ f32x4 col(int, int c_) const { const int z = c_ >> 8, c = c_ & 255; return *(const f32x4*)(bias + (z >> 2) * 256 + c); }
    __device__ __forceinline__ void apply(int row, int col, f32x4 v, f32x4 bv) const { const int z = col >> 8, c = col & 255;
        u32x2 w; w.x = cvt_pk_bf16(gelu_tanh_f(v.x + bv.x), gelu_tanh_f(v.y + bv.y)); w.y = cvt_pk_bf16(gelu_tanh_f(v.z + bv.z), gelu_tanh_f(v.w + bv.w));
        *(u32x2*)(o + ((size_t)z * 2048 + row) * 256 + c) = w; }
};

namespace pg8 {
#define PG8_LAS __attribute__((address_space(3)))
constexpr int BM = 256, BK = 64, HALF = 128, HTB = HALF * BK * 2, STAGE_BYTES = 8 * HTB, NXCD = 8, WGM = 8;
__host__ __device__ __forceinline__ int lds_byte(int r, int c) { const int st = (r >> 4) * 2 + (c >> 5), rr = r & 15, cc = c & 31, ob = rr * 64 + cc * 2; return st * 1024 + (ob ^ (((ob >> 9) & 1) << 5)); }
__host__ __device__ __forceinline__ void stage_rc(int b, int& R, int& C) { const int st = b / 1024, sb = b % 1024, swz = sb ^ (((sb >> 9) & 1) << 5); R = (st >> 1) * 16 + swz / 64; C = (st & 1) * 32 + (swz % 64) / 2; }
__host__ __device__ __forceinline__ int perm32(int rho) { const int n = rho >> 4, i = rho & 15; return 8 * (i >> 2) + 4 * n + (i & 3); }
struct Unit { int pm, pn; };
template <int SMODE> struct Sched {
    int nM, nN, nwg, G, c; const char* A; const char* Bt; size_t lda2, ldb2; const int* pst; size_t bstride2;
    __device__ __forceinline__ void init(int M, int N, int G_, int c_, const void* A_, const void* Bt_, int lda, int ldb, const int* pst_ = nullptr, size_t bstride = 0) {
        nM = M / BM; nN = N / BM; nwg = nM * nN; G = G_; c = c_; A = (const char*)A_; Bt = (const char*)Bt_; lda2 = (size_t)lda * 2; ldb2 = (size_t)ldb * 2; pst = pst_; bstride2 = bstride * 2; }
    __device__ __forceinline__ bool next(int i, Unit& u) const {
        if (c < 0) return false;
        const long L = (long)i * G + c; if (L >= nwg) return false;
        int wgid = (int)L; { const int q = nwg / NXCD, r = nwg % NXCD, xcd = wgid % NXCD, off = wgid / NXCD; wgid = (xcd < r ? xcd * (q + 1) : r * (q + 1) + (xcd - r) * q) + off; }
        const int nig = WGM * nN, gid = wgid / nig, fm = gid * WGM, gsz = (nM - fm) < WGM ? (nM - fm) : WGM;
        u.pm = fm + ((wgid % nig) % gsz); u.pn = (wgid % nig) / gsz; return true;
    }
    __device__ __forceinline__ const char* a_ptr(const Unit& u) const {
        if (SMODE == 1) return A + (size_t)u.pm * BM * lda2 + (size_t)u.pn * 512;
        if (SMODE == 2) return A + (size_t)u.pm * BM * lda2 + (size_t)((u.pn >> 2) * 256 + (u.pn & 3) * 64) * 2;
        return A + (size_t)u.pm * BM * lda2; }
    __device__ __forceinline__ const char* b_ptr(const Unit& u) const {
        if (SMODE == 2) return Bt + (size_t)(u.pn >> 2) * BM * ldb2;
        if (SMODE == 3) { const int m0 = u.pm * BM; int e = 0;
#pragma unroll
            for (int q = 1; q < NE; ++q) e += (m0 >= pst[q]); return Bt + (size_t)e * bstride2 + (size_t)u.pn * BM * ldb2; }
        return Bt + (size_t)u.pn * BM * ldb2; }
};
template <class F> struct EpiEl { static constexpr bool PERM = false, AFTER_DRAIN = false; F f;
    __device__ __forceinline__ void operator()(const f32x4 (&acc)[2][2][4][2], const Unit& u, int wr, int wc, int fr, int fq) const {
        const int row0 = u.pm * BM + wr * 64 + fr, col0 = u.pn * BM + wc * 32 + 4 * fq;
        typename F::Col cg[2][2];
#pragma unroll
        for (int bj = 0; bj < 2; ++bj)
#pragma unroll
            for (int n = 0; n < 2; ++n) cg[bj][n] = f.col(u.pm * BM, col0 + bj * HALF + n * 16);
        if constexpr (F::ROWLOAD) {
            f32x4 xv[2][2][4];
#pragma unroll
            for (int r = 0; r < 2; ++r)
#pragma unroll
                for (int c = 0; c < 4; ++c) xv[0][r][c] = f.rowload(row0 + r * 16, col0 + (c >> 1) * HALF + (c & 1) * 16);
#pragma unroll
            for (int b = 0; b < 4; ++b) {
                if (b + 1 < 4) {
#pragma unroll
                    for (int r = 0; r < 2; ++r)
#pragma unroll
                        for (int c = 0; c < 4; ++c) xv[(b + 1) & 1][r][c] = f.rowload(row0 + ((b + 1) >> 1) * HALF + (((b + 1) & 1) * 2 + r) * 16, col0 + (c >> 1) * HALF + (c & 1) * 16);
                }
#pragma unroll
                for (int r = 0; r < 2; ++r)
#pragma unroll
                    for (int c = 0; c < 4; ++c) { const int ai = b >> 1, m = (b & 1) * 2 + r;
                        f.apply(row0 + ai * HALF + m * 16, col0 + (c >> 1) * HALF + (c & 1) * 16, acc[ai][c >> 1][m][c & 1], cg[c >> 1][c & 1], xv[b & 1][r][c]); }
            }
        } else {
#pragma unroll
            for (int ai = 0; ai < 2; ++ai)
#pragma unroll
                for (int m = 0; m < 4; ++m)
#pragma unroll
                    for (int bj = 0; bj < 2; ++bj)
#pragma unroll
                        for (int n = 0; n < 2; ++n) f.apply(row0 + ai * HALF + m * 16, col0 + bj * HALF + n * 16, acc[ai][bj][m][n], cg[bj][n]);
        } } };
template <class F> struct EpiPairEl { static constexpr bool PERM = false, AFTER_DRAIN = false; F f;
    __device__ __forceinline__ void operator()(const f32x4 (&acc)[2][2][4][2], const Unit& u, int wr, int wc, int fr, int fq) const {
        const int row0 = u.pm * BM + wr * 64 + fr, hc0 = u.pn * HALF + wc * 32 + 4 * fq;
        typename F::Col cg[2]; typename F::Row rw[2][4];
#pragma unroll
        for (int n = 0; n < 2; ++n) cg[n] = f.col(hc0 + n * 16);
#pragma unroll
        for (int ai = 0; ai < 2; ++ai)
#pragma unroll
            for (int m = 0; m < 4; ++m) rw[ai][m] = f.rowv(row0 + ai * HALF + m * 16);
#pragma unroll
        for (int ai = 0; ai < 2; ++ai)
#pragma unroll
            for (int m = 0; m < 4; ++m)
#pragma unroll
                for (int n = 0; n < 2; ++n) f.pair(row0 + ai * HALF + m * 16, hc0 + n * 16, acc[ai][0][m][n], acc[ai][1][m][n], cg[n], rw[ai][m]); } };

typedef int i32x8 __attribute__((ext_vector_type(8)));
template <int QM> __device__ __forceinline__ void mma_block(f32x4 (&acc)[4][2], const bf16x8 (&At)[4][2], const bf16x8 (&Bt)[2][2], const int wsc) {
    __builtin_amdgcn_s_setprio(1);
    if constexpr (QM == 2) {
        typedef int i32x4m __attribute__((ext_vector_type(4)));
#pragma unroll
        for (int m = 0; m < 4; ++m)
#pragma unroll
            for (int n = 0; n < 2; ++n)
#pragma unroll
                for (int k = 0; k < 2; ++k) acc[m][n] = __builtin_bit_cast(f32x4, __builtin_amdgcn_mfma_i32_16x16x64_i8(__builtin_bit_cast(i32x4m, Bt[n][k]), __builtin_bit_cast(i32x4m, At[m][k]), __builtin_bit_cast(i32x4m, acc[m][n]), 0, 0, 0));
#pragma unroll
        for (int m = 0; m < 4; ++m) asm volatile("" : "+v"(acc[m][0]), "+v"(acc[m][1]));
    } else if constexpr (QM == 1) {
#pragma unroll
        for (int m = 0; m < 4; ++m) { const u32x4 a0 = __builtin_bit_cast(u32x4, At[m][0]), a1 = __builtin_bit_cast(u32x4, At[m][1]);
            const i32x8 a8 = {(int)a0.x, (int)a0.y, (int)a0.z, (int)a0.w, (int)a1.x, (int)a1.y, (int)a1.z, (int)a1.w};
#pragma unroll
            for (int n = 0; n < 2; ++n) { const u32x4 b0 = __builtin_bit_cast(u32x4, Bt[n][0]), b1 = __builtin_bit_cast(u32x4, Bt[n][1]);
                const i32x8 b8 = {(int)b0.x, (int)b0.y, (int)b0.z, (int)b0.w, (int)b1.x, (int)b1.y, (int)b1.z, (int)b1.w};
                acc[m][n] = __builtin_amdgcn_mfma_scale_f32_16x16x128_f8f6f4(b8, a8, acc[m][n], 0, 0, 0, wsc, 0, 127); } }
#pragma unroll
        for (int m = 0; m < 4; ++m) asm volatile("" : "+v"(acc[m][0]), "+v"(acc[m][1]));
    } else {
#pragma unroll
        for (int m = 0; m < 4; ++m)
#pragma unroll
            for (int n = 0; n < 2; ++n)
#pragma unroll
                for (int k = 0; k < 2; ++k) acc[m][n] = __builtin_amdgcn_mfma_f32_16x16x32_bf16(Bt[n][k], At[m][k], acc[m][n], 0, 0, 0);
    }
    __builtin_amdgcn_s_setprio(0);
}
template <class Epi, class Sched, bool ALIGN_EPI = true, bool SP2 = true, int QM = 0>
__device__ __forceinline__ void gemm_phase(PG8_LAS unsigned char* lds, const int K, const int lda, const int ldb, const size_t kstepA, const Sched& S, const Epi& E, const int wsc = 127) {
    const int tid_ = opaque_tid();
    const int tid = tid_, wid = __builtin_amdgcn_readfirstlane(tid >> 6), lane = tid & 63, wr = wid >> 2, wc = wid & 3, fr = lane & 15, fq = lane >> 4;
    const int nt = K / BK;
    unsigned voffA[2], voffB[2];
#pragma unroll
    for (int i = 0; i < 2; ++i) { int R, C; stage_rc(tid * 16 + i * 8192, R, C); const int Rb = Epi::PERM ? ((R & ~31) + perm32(R & 31)) : R;
        voffA[i] = (unsigned)(R * lda + C) * 2u; voffB[i] = (unsigned)(Rb * ldb + C) * 2u; }
    const size_t kstepB = (size_t)(BK * 2);
    const size_t hstepA = (size_t)HALF * lda * 2, hstepB = (size_t)HALF * ldb * 2;
    const unsigned ldsw = (unsigned)wid * 1024u;
    int aoffk[2], boffk[2];
#pragma unroll
    for (int k = 0; k < 2; ++k) { const int col = (QM == 1) ? ((fq >> 1) * 32 + (fq & 1) * 16 + 8 * k) : (k * 32 + fq * 8); aoffk[k] = lds_byte(wr * 64 + fr, col); boffk[k] = lds_byte(wc * 32 + fr, col); }
#define PG8_SA(b, h) (((b) * 2 + (h)) * HTB)
#define PG8_SB(b, h) ((4 + (b) * 2 + (h)) * HTB)
#define PG8_STAGE(bufoff, gbase, voff) do { _Pragma("unroll") for (int _i = 0; _i < 2; ++_i) \
        __builtin_amdgcn_global_load_lds((const unsigned*)((const char*)(gbase) + (voff)[_i]), (PG8_LAS unsigned*)(lds + (bufoff) + ldsw + _i * 8192), 16, 0, 0); } while (0)
#define PG8_LDA(dst, b, h) do { _Pragma("unroll") for (int m = 0; m < 4; ++m) _Pragma("unroll") for (int k = 0; k < 2; ++k) dst[m][k] = *(const PG8_LAS bf16x8*)(lds + PG8_SA(b, h) + ((QM == 1) ? aoffk[k] : aoffk[0] + k * 1024) + m * 2048); } while (0)
#define PG8_LDB(dst, b, h) do { _Pragma("unroll") for (int n = 0; n < 2; ++n) _Pragma("unroll") for (int k = 0; k < 2; ++k) dst[n][k] = *(const PG8_LAS bf16x8*)(lds + PG8_SB(b, h) + ((QM == 1) ? boffk[k] : boffk[0] + k * 1024) + n * 2048); } while (0)
#define PG8_MMA(ai, bj, At, Bt) mma_block<QM>(acc[ai][bj], At, Bt, wsc)
#define PG8_WAIT_V(n) asm volatile("s_waitcnt vmcnt(" #n ")" ::: "memory")
#define PG8_WAIT_L(n) asm volatile("s_waitcnt lgkmcnt(" #n ")" ::: "memory")
#define PG8_BAR __builtin_amdgcn_s_barrier()
#define PG8_SCHED __builtin_amdgcn_sched_barrier(0)
    Unit cur, nxt; int ui = 0;
    if (!S.next(0, cur)) return;
    f32x4 acc[2][2][4][2];
#pragma unroll
    for (int a = 0; a < 2; ++a)
#pragma unroll
        for (int b = 0; b < 2; ++b)
#pragma unroll
            for (int m = 0; m < 4; ++m)
#pragma unroll
                for (int n = 0; n < 2; ++n) acc[a][b][m][n] = (f32x4){0.f, 0.f, 0.f, 0.f};
    bf16x8 At[4][2], B0[2][2], B1[2][2];
    const char* cA = S.a_ptr(cur); const char* cB = S.b_ptr(cur);
    if constexpr (SP2) {
        PG8_STAGE(PG8_SB(0, 0), cB, voffB); PG8_STAGE(PG8_SB(0, 1), cB + hstepB, voffB); PG8_STAGE(PG8_SA(0, 0), cA, voffA); PG8_STAGE(PG8_SA(0, 1), cA + hstepA, voffA);
        if (wr == 1) PG8_BAR;
        PG8_WAIT_V(2); PG8_BAR;
        PG8_STAGE(PG8_SB(1, 0), cB + kstepB, voffB); PG8_STAGE(PG8_SA(1, 0), cA + kstepA, voffA); PG8_STAGE(PG8_SB(1, 1), cB + hstepB + kstepB, voffB);
        PG8_WAIT_V(6); PG8_BAR;
    } else {
        PG8_STAGE(PG8_SB(0, 0), cB, voffB); PG8_STAGE(PG8_SA(0, 0), cA, voffA); PG8_STAGE(PG8_SB(0, 1), cB + hstepB, voffB); PG8_STAGE(PG8_SA(0, 1), cA + hstepA, voffA);
        if (wr == 1) PG8_BAR;
        PG8_WAIT_V(4); PG8_BAR;
        PG8_STAGE(PG8_SB(1, 0), cB + kstepB, voffB); PG8_STAGE(PG8_SA(1, 0), cA + kstepA, voffA); PG8_STAGE(PG8_SB(1, 1), cB + hstepB + kstepB, voffB);
        PG8_WAIT_V(6); PG8_BAR;
    }
    for (;;) {
        const bool has_next = S.next(ui + 1, nxt);
        const char* nA = has_next ? S.a_ptr(nxt) : cA; const char* nB = has_next ? S.b_ptr(nxt) : cB;
        for (int t = 0; t < nt; t += 2) {
            const bool last = (t == nt - 2);
            const char* a1 = cA + (size_t)(t + 1) * kstepA;
            const char* a2 = last ? nA : cA + (size_t)(t + 2) * kstepA; const char* b2 = last ? nB : cB + (size_t)(t + 2) * kstepB;
            const char* a3 = a2 + kstepA; const char* b3 = b2 + kstepB;
            if constexpr (SP2) {
            PG8_LDB(B0, 0, 0); PG8_LDB(B1, 0, 1); PG8_SCHED; PG8_LDA(At, 0, 0); PG8_STAGE(PG8_SA(1, 1), a1 + hstepA, voffA);
            PG8_WAIT_V(8); PG8_WAIT_L(0); PG8_BAR; PG8_MMA(0, 0, At, B0); PG8_MMA(0, 1, At, B1); PG8_BAR; PG8_SCHED;
            PG8_LDA(At, 0, 1); PG8_STAGE(PG8_SB(0, 0), b2, voffB); PG8_STAGE(PG8_SB(0, 1), b2 + hstepB, voffB); PG8_STAGE(PG8_SA(0, 0), a2, voffA);
            PG8_WAIT_V(8); PG8_WAIT_L(0); PG8_BAR; PG8_MMA(1, 0, At, B0); PG8_MMA(1, 1, At, B1); PG8_BAR; PG8_SCHED;
            PG8_LDB(B0, 1, 0); PG8_LDB(B1, 1, 1); PG8_SCHED; PG8_LDA(At, 1, 0); PG8_STAGE(PG8_SA(0, 1), a2 + hstepA, voffA);
            PG8_WAIT_V(8); PG8_WAIT_L(0); PG8_BAR; PG8_MMA(0, 0, At, B0); PG8_MMA(0, 1, At, B1); PG8_BAR; PG8_SCHED;
            PG8_LDA(At, 1, 1); PG8_STAGE(PG8_SB(1, 0), b3, voffB); PG8_STAGE(PG8_SB(1, 1), b3 + hstepB, voffB); PG8_STAGE(PG8_SA(1, 0), a3, voffA);
            PG8_WAIT_V(8); PG8_WAIT_L(0); PG8_BAR; PG8_MMA(1, 0, At, B0); PG8_MMA(1, 1, At, B1); PG8_BAR; PG8_SCHED;
            } else {
            PG8_LDB(B0, 0, 0); PG8_SCHED; PG8_LDA(At, 0, 0); PG8_STAGE(PG8_SA(1, 1), a1 + hstepA, voffA);
            PG8_WAIT_L(8); PG8_BAR; PG8_WAIT_L(0); PG8_MMA(0, 0, At, B0); PG8_BAR; PG8_SCHED;
            PG8_LDB(B1, 0, 1); PG8_STAGE(PG8_SB(0, 0), b2, voffB);
            PG8_BAR; PG8_WAIT_L(0); PG8_MMA(0, 1, At, B1); PG8_BAR;
            PG8_LDA(At, 0, 1); PG8_STAGE(PG8_SA(0, 0), a2, voffA);
            PG8_BAR; PG8_WAIT_L(0); PG8_MMA(1, 0, At, B0); PG8_BAR; PG8_SCHED;
            PG8_STAGE(PG8_SB(0, 1), b2 + hstepB, voffB);
            PG8_WAIT_V(6); PG8_BAR; PG8_MMA(1, 1, At, B1); PG8_BAR;
            PG8_LDB(B0, 1, 0); PG8_SCHED; PG8_LDA(At, 1, 0); PG8_STAGE(PG8_SA(0, 1), a2 + hstepA, voffA);
            PG8_WAIT_L(8); PG8_BAR; PG8_WAIT_L(0); PG8_MMA(0, 0, At, B0); PG8_BAR; PG8_SCHED;
            PG8_LDB(B1, 1, 1); PG8_STAGE(PG8_SB(1, 0), b3, voffB);
            PG8_BAR; PG8_WAIT_L(0); PG8_MMA(0, 1, At, B1); PG8_BAR;
            PG8_LDA(At, 1, 1); PG8_STAGE(PG8_SA(1, 0), a3, voffA);
            PG8_BAR; PG8_WAIT_L(0); PG8_MMA(1, 0, At, B0); PG8_BAR; PG8_SCHED;
            PG8_STAGE(PG8_SB(1, 1), b3 + hstepB, voffB);
            PG8_WAIT_V(6); PG8_BAR; PG8_MMA(1, 1, At, B1); PG8_BAR;
            }
        }
        if constexpr (ALIGN_EPI) { if (wr == 0) PG8_BAR; }
        if constexpr (!Epi::AFTER_DRAIN) { E(acc, cur, wr, wc, fr, fq); }
        if (!has_next) break;
#pragma unroll
        for (int a = 0; a < 2; ++a)
#pragma unroll
            for (int b = 0; b < 2; ++b)
#pragma unroll
                for (int m = 0; m < 4; ++m)
#pragma unroll
                    for (int n = 0; n < 2; ++n) acc[a][b][m][n] = (f32x4){0.f, 0.f, 0.f, 0.f};
        cur = nxt; cA = nA; cB = nB; ++ui;
        if constexpr (ALIGN_EPI) { if (wr == 1) PG8_BAR; }
    }
    PG8_WAIT_V(0);
    if constexpr (!ALIGN_EPI) { if (wr == 0) PG8_BAR; }
    PG8_BAR;
    if constexpr (Epi::AFTER_DRAIN) { E.fused(acc, cur, wr, wc, fr, fq, lds, wid, lane); }
#undef PG8_SA
#undef PG8_SB
#undef PG8_STAGE
#undef PG8_LDA
#undef PG8_LDB
#undef PG8_MMA
#undef PG8_WAIT_V
#undef PG8_WAIT_L
#undef PG8_BAR
#undef PG8_SCHED
}
}

__device__ __forceinline__ void phase_headnorm(const Params& p, LAS unsigned char* lds) {
    const int tid = opaque_tid(), lane = tid & 63, wave = tid >> 6;
    LAS int* chunk = (LAS int*)(lds + 131072 - 64);
    bf16_t* Q = (bf16_t*)(p.ws + WS_Q); bf16_t* KVB = (bf16_t*)(p.ws + WS_KVB);
    float qg[16], kg[8];
#pragma unroll
    for (int i = 0; i < 16; ++i) qg[i] = p.q_gain[(lane & 3) * 16 + i] * (0.125f * 1.4426950408889634f);
    const int kr = lane >> 5;
#pragma unroll
    for (int i = 0; i < 8; ++i) kg[i] = p.k_gain[(1 + kr) * 64 + (lane & 7) * 8 + i];
    for (;;) {
      if (tid == 0) *chunk = (int)atomicAdd((unsigned*)(p.ws + WS_CTL) + CW_HN, 1u);
      __syncthreads();
      const int c0 = *chunk;
      __syncthreads();
      if (c0 >= T / 128) break;
      for (int r = c0 * 128 + wave * 16; r < c0 * 128 + wave * 16 + 16; ++r) {
        {
            u32x4* ptr = (u32x4*)(Q + (size_t)r * D + lane * 16); u32x4 w0 = ptr[0], w1 = ptr[1];
            float v[16]; const unsigned ww[8] = {w0.x, w0.y, w0.z, w0.w, w1.x, w1.y, w1.z, w1.w}; float s = 0.f;
#pragma unroll
            for (int i = 0; i < 8; ++i) { v[2 * i] = bflo(ww[i]); v[2 * i + 1] = bfhi(ww[i]); s += v[2 * i] * v[2 * i] + v[2 * i + 1] * v[2 * i + 1]; }
            s += __shfl_xor(s, 1); s += __shfl_xor(s, 2);
            const float rstd = 1.f / sqrtf(s * (1.f / 64.f) + EPS);
            unsigned o[8];
#pragma unroll
            for (int i = 0; i < 8; ++i) o[i] = cvt_pk_bf16(v[2 * i] * rstd * qg[2 * i], v[2 * i + 1] * rstd * qg[2 * i + 1]);
            ptr[0] = (u32x4){o[0], o[1], o[2], o[3]}; ptr[1] = (u32x4){o[4], o[5], o[6], o[7]};
        }
        {
            const u32x4* ptr = (const u32x4*)(KVB + (size_t)r * NKV + (kr ? 1024 : 512) + (lane & 31) * 8); const u32x4 w0 = ptr[0];
            float v[8]; const unsigned ww[4] = {w0.x, w0.y, w0.z, w0.w}; float s = 0.f;
#pragma unroll
            for (int i = 0; i < 4; ++i) { v[2 * i] = bflo(ww[i]); v[2 * i + 1] = bfhi(ww[i]); s += v[2 * i] * v[2 * i] + v[2 * i + 1] * v[2 * i + 1]; }
            s += __shfl_xor(s, 1); s += __shfl_xor(s, 2); s += __shfl_xor(s, 4);
            const float rstd = 1.f / sqrtf(s * (1.f / 64.f) + EPS);
            unsigned o[4];
#pragma unroll
            for (int i = 0; i < 4; ++i) o[i] = cvt_pk_bf16(v[2 * i] * rstd * kg[2 * i], v[2 * i + 1] * rstd * kg[2 * i + 1]);
            const int b = r >> 13, t = r & (S - 1), hg = (lane & 31) >> 3, c = lane & 7;
            {
                bf16_t* dst = (bf16_t*)(p.ws + (kr ? WS_KWB : WS_KSB)) + ((size_t)((b * 4 + hg) * 128 + (t >> 6)) * 8 + c) * 512 + (t & 63) * 8;
                *(u32x4*)dst = (u32x4){o[0], o[1], o[2], o[3]};
            }
        }
      }
    }
}

__device__ __forceinline__ void phase_cmp2(const Params& p, LAS unsigned char* lds) {
    const int tid = opaque_tid(), lane = tid & 63, wave = tid >> 6;
    const int gw = blockIdx.x * NWAVE + wave, NGW = gridDim.x * NWAVE;
    const bf16_t* CMPH = (const bf16_t*)(p.ws + WS_CMPH);
    LAS float* w2l = (LAS float*)lds;
    for (int kv = 0; kv < 2; ++kv) {
        const float* w2 = kv ? p.cmp_v_w2 : p.cmp_k_w2;
        for (int i = tid; i < 256 * 64 / 4; i += NTHR) ((LAS f32x4*)w2l)[i] = ((const f32x4*)w2)[i];
        __syncthreads();
        for (int it = gw * 2; it < 4 * 2048; it += NGW * 2) {
            float hv[2][4], acc[2] = {0.f, 0.f};
#pragma unroll
            for (int rr = 0; rr < 2; ++rr) { const u32x2 w = *(const u32x2*)(CMPH + (size_t)(kv * 8192 + it + rr) * 256 + 4 * lane); hv[rr][0] = bflo(w.x); hv[rr][1] = bfhi(w.x); hv[rr][2] = bflo(w.y); hv[rr][3] = bfhi(w.y); }
#pragma unroll 4
            for (int kk = 0; kk < 64; ++kk)
#pragma unroll
                for (int c = 0; c < 4; ++c) { const float wv = w2l[(4 * kk + c) * 64 + lane];
                    acc[0] += readlane_f(hv[0][c], kk) * wv; acc[1] += readlane_f(hv[1][c], kk) * wv; }
#pragma unroll
            for (int rr = 0; rr < 2; ++rr) {
                const int row = it + rr, g = (row >> 11) & 3, r2 = row & 2047, b = r2 >> 9, n = r2 & 511; float a = n == NC - 1 ? 0.f : acc[rr];
                if (kv == 0) { const float ss = wave_sum(a * a); a = a * (1.f / sqrtf(ss * (1.f / 64.f) + EPS)) * p.k_gain[lane]; }
                const size_t blk0 = (size_t)((b * 4 + g) * 8 + (n >> 6)) * 4096;
                bf16_t* o = kv ? (bf16_t*)(p.ws + WS_VC) + blk0 + ((n & 63) >> 3) * 512 + lane * 8 + (n & 7)
                               : (bf16_t*)(p.ws + WS_KC) + blk0 + (lane >> 3) * 512 + (n & 63) * 8 + (lane & 7);
                *o = (bf16_t)(cvt_pk_bf16(a, 0.f) & 0xffffu);
            }
        }
        __syncthreads();
    }
}

__device__ __forceinline__ void phase_vtrans(const Params& p, LAS unsigned char* lds) {
    const int tid = opaque_tid(), lane = tid & 63, wave = tid >> 6;
    const int gw = blockIdx.x * NWAVE + wave, NGW = gridDim.x * NWAVE;
    LAS unsigned short* tile = (LAS unsigned short*)(lds + wave * 8448);
    const bf16_t* KVB = (const bf16_t*)(p.ws + WS_KVB);
    LAS int* chunk = (LAS int*)(lds + 131072 - 64);
    for (;;) {
        if (tid == 0) *chunk = (int)atomicAdd((unsigned*)(p.ws + WS_CTL) + CW_VT, 1u);
        __syncthreads();
        const int c0 = *chunk;
        __syncthreads();
        if (c0 >= 2 * 16 * 128 / NWAVE) break;
        const int u = c0 * NWAVE + wave;
        const int which = u >> 11, bg = (u >> 7) & 15, tt = u & 127, b = bg >> 2, g = bg & 3, t0 = tt * 64;
        const u32x4* src = (const u32x4*)(KVB + (size_t)(b * S + t0 + lane) * NKV + (which ? 1280 : 768) + g * 64);
#pragma unroll
        for (int i = 0; i < 8; ++i) { const u32x4 v = src[i]; LAS unsigned* tp = (LAS unsigned*)(tile + lane * 66 + 8 * i); tp[0] = v.x; tp[1] = v.y; tp[2] = v.z; tp[3] = v.w; }
        asm volatile("s_waitcnt lgkmcnt(0)" ::: "memory");
        {
            bf16_t* dst = (bf16_t*)(p.ws + (which ? WS_VWB : WS_VSB)) + (size_t)(bg * 128 + tt) * 4096 + lane * 8;
#pragma unroll
            for (int i = 0; i < 8; ++i) { unsigned w[4];
#pragma unroll
                for (int q = 0; q < 4; ++q) { const unsigned lo = tile[(8 * i + 2 * q) * 66 + lane], hi = tile[(8 * i + 2 * q + 1) * 66 + lane]; w[q] = lo | (hi << 16); }
                *(u32x4*)(dst + i * 512) = (u32x4){w[0], w[1], w[2], w[3]}; }
        }
        asm volatile("s_waitcnt lgkmcnt(0)" ::: "memory");
    }
}

typedef short s16x4 __attribute__((ext_vector_type(4)));
__device__ __forceinline__ f32x4 mfma4(s16x4 a, s16x4 b, f32x4 c) { return __builtin_amdgcn_mfma_f32_4x4x4bf16_1k(a, b, c, 0, 0, 0); }
__device__ __forceinline__ s16x4 mk4(unsigned lo, unsigned hi) { const u32x2 t = {lo, hi}; return __builtin_bit_cast(s16x4, t); }
__device__ __forceinline__ f32x4 qk64(const bf16_t* krow, const s16x4 (&qf)[16]) {
    const u32x4* kp = (const u32x4*)krow; u32x4 kr[8];
#pragma unroll
    for (int i = 0; i < 8; ++i) kr[i] = kp[i];
    f32x4 s = {0.f, 0.f, 0.f, 0.f};
#pragma unroll
    for (int c = 0; c < 8; ++c) { s = mfma4(mk4(kr[c].x, kr[c].y), qf[2 * c], s); s = mfma4(mk4(kr[c].z, kr[c].w), qf[2 * c + 1], s); }
    return s;
}
__device__ __forceinline__ void pv64(f32x4& o, const f32x4 e, const bf16_t* vtrow, LAS u32x2* stage, int lane) {
    const u32x4* vp = (const u32x4*)vtrow; u32x4 vr[8];
#pragma unroll
    for (int i = 0; i < 8; ++i) vr[i] = vp[i];
    u32x2 pk; pk.x = cvt_pk_bf16(e.x, e.y); pk.y = cvt_pk_bf16(e.z, e.w);
    stage[lane] = pk;
#pragma unroll
    for (int st = 0; st < 16; ++st) { const u32x2 a = stage[4 * st + (lane & 3)]; const u32x4 v = vr[st >> 1];
        o = mfma4(mk4(a.x, a.y), (st & 1) ? mk4(v.z, v.w) : mk4(v.x, v.y), o); }
}
__device__ __forceinline__ float quadx_sum(float v) { v += __shfl_xor(v, 4); v += __shfl_xor(v, 8); v += __shfl_xor(v, 16); v += __shfl_xor(v, 32); return v; }

constexpr int HBN = 800;
constexpr int ATT_HBD = 0, ATT_MH = 51200, ATT_PSLC = 53248, ATT_STAGE = 118784;
__device__ __forceinline__ void attn_tables(const Params& p, LAS unsigned char* lds) {
    const int tid = opaque_tid();
    LAS float* hbd = (LAS float*)(lds + ATT_HBD); LAS float* mh = (LAS float*)(lds + ATT_MH);
    for (int i = tid; i < 16 * HBN; i += NTHR) { const int hd = i / HBN, d = i - hd * HBN; const float v = p.rel_bias[rel_bucket(d) * NH + hd] * 1.4426950408889634f; hbd[i] = v; if (blockIdx.x == 0) ((float*)(p.ws + WS_HBG))[i] = v; }
    if (tid < 16) { float qg = 0.f, kg = 0.f, bm = -3.0e38f;
        for (int i = 0; i < 64; ++i) qg = fmaxf(qg, fabsf(p.q_gain[i]));
        for (int i = 0; i < 192; ++i) kg = fmaxf(kg, fabsf(p.k_gain[i]));
        for (int i = 0; i < 32; ++i) bm = fmaxf(bm, p.rel_bias[i * NH + tid]);
        const float mv = (qg * kg * 8.f * 1.02f + bm) * 1.4426950408889634f; mh[tid] = mv; if (blockIdx.x == 0) ((float*)(p.ws + WS_MHG))[tid] = mv; }
    __syncthreads();
}
typedef float f32x16 __attribute__((ext_vector_type(16)));
__device__ __forceinline__ f32x16 mfma32(bf16x8 a, bf16x8 b, f32x16 c) { return __builtin_amdgcn_mfma_f32_32x32x16_bf16(a, b, c, 0, 0, 0); }
struct DFrag { bf16x8 ka[4]; bf16x8 va[2][2]; };
__device__ __forceinline__ void dense_load_k(bf16x8 (&ka)[4], const bf16_t* KB, int kt, int l31, int h) {
    const int blk = kt >> 6, hh = (kt >> 5) & 1;
    const bf16_t* kb = KB + (size_t)blk * 4096 + (32 * hh + l31) * 8;
#pragma unroll
    for (int ks = 0; ks < 4; ++ks) ka[ks] = *(const bf16x8*)(kb + (2 * ks + h) * 512);
}
__device__ __forceinline__ void dense_load_v(bf16x8 (&va)[2][2], const bf16_t* VB, int kt, int l31, int h) {
    const int blk = kt >> 6, hh = (kt >> 5) & 1;
    const bf16_t* vb = VB + (size_t)blk * 4096 + l31 * 8 + 4 * h;
#pragma unroll
    for (int dt = 0; dt < 2; ++dt)
#pragma unroll
        for (int st = 0; st < 2; ++st) { const bf16_t* q0 = vb + (4 * hh + 2 * st) * 512 + dt * 256; const u32x2 lo = *(const u32x2*)q0, hi = *(const u32x2*)(q0 + 512);
            const u32x4 w = {lo.x, lo.y, hi.x, hi.y}; va[dt][st] = __builtin_bit_cast(bf16x8, w); }
}
__device__ __forceinline__ f32x16 dense_scores(const DFrag& f, const bf16x8 (&q)[4]) {
    f32x16 sacc;
#pragma unroll
    for (int i = 0; i < 16; ++i) sacc[i] = 0.f;
#pragma unroll
    for (int ks = 0; ks < 4; ++ks) sacc = mfma32(f.ka[ks], q[ks], sacc);
    return sacc;
}
__device__ __forceinline__ void dense_pv(f32x16 (&O)[2], const DFrag& f, const float (&ev)[16]) {
    bf16x8 pb[2];
#pragma unroll
    for (int st = 0; st < 2; ++st) { const u32x4 w = {cvt_pk_bf16(ev[8 * st], ev[8 * st + 1]), cvt_pk_bf16(ev[8 * st + 2], ev[8 * st + 3]), cvt_pk_bf16(ev[8 * st + 4], ev[8 * st + 5]), cvt_pk_bf16(ev[8 * st + 6], ev[8 * st + 7])};
        pb[st] = __builtin_bit_cast(bf16x8, w); }
#pragma unroll
    for (int dt = 0; dt < 2; ++dt)
#pragma unroll
        for (int st = 0; st < 2; ++st) O[dt] = mfma32(f.va[dt][st], pb[st], O[dt]);
}
__device__ __forceinline__ void phase_dense(const Params& p, LAS unsigned char* lds, bf16_t* OW) {
    const int tid = opaque_tid(), lane0 = tid & 63, wave = tid >> 6;
    const LAS float* hbd = (const LAS float*)(lds + ATT_HBD); const LAS float* mh = (const LAS float*)(lds + ATT_MH);
    LAS float* pslc = (LAS float*)(lds + ATT_PSLC) + wave * 2048;
    const bf16_t* Q = (const bf16_t*)(p.ws + WS_Q); const float* GATE = (const float*)(p.ws + WS_GATE);
    short* SEL = (short*)(p.ws + WS_SEL);
    const int Gn = gridDim.x, vcu = (Gn % 8 == 0) ? (blockIdx.x % 8) * (Gn / 8) + blockIdx.x / 8 : blockIdx.x;
    for (int u = vcu * NWAVE + wave; u < T * G / 16; u += Gn * NWAVE) {
        int lane = lane0; asm volatile("" : "+v"(lane));
        const int l31 = lane & 31, h = lane >> 5;
        const int bg = u >> 9, t0 = (((u & 511) + 128 * (u >> 11)) & 511) * 16, b = bg >> 2, g = bg & 3, head = 4 * g + (lane & 3);
        const LAS float* hb = hbd + head * HBN; const float mhv = mh[head];
        int tok[2]; bf16x8 qf[2][4];
#pragma unroll
        for (int r = 0; r < 2; ++r) { tok[r] = t0 + 8 * r + (l31 >> 2); const bf16_t* qp = Q + (size_t)(b * S + tok[r]) * D + head * 64 + 8 * h;
#pragma unroll
            for (int ks = 0; ks < 4; ++ks) qf[r][ks] = *(const bf16x8*)(qp + 16 * ks); }
        f32x16 O[2][2];
#pragma unroll
        for (int r = 0; r < 2; ++r)
#pragma unroll
            for (int dt = 0; dt < 2; ++dt)
#pragma unroll
                for (int q = 0; q < 16; ++q) O[r][dt][q] = 0.f;
        DFrag cur; bf16x8 nxtk[4];
        {
            const bf16_t* KB = (const bf16_t*)(p.ws + WS_KWB) + (size_t)bg * 128 * 4096; const bf16_t* VB = (const bf16_t*)(p.ws + WS_VWB) + (size_t)bg * 128 * 4096;
            float lw[2] = {0.f, 0.f};
            const int lo = t0 - (WIN - 1) > 0 ? t0 - (WIN - 1) : 0, kt_last = t0 & ~31;
            dense_load_k(cur.ka, KB, lo & ~31, l31, h);
            for (int kt = lo & ~31; kt <= kt_last; kt += 32) {
                dense_load_v(cur.va, VB, kt, l31, h);
                dense_load_k(nxtk, KB, kt + 32 <= kt_last ? kt + 32 : kt_last, l31, h);
                __builtin_amdgcn_sched_barrier(0);
#pragma unroll
                for (int r = 0; r < 2; ++r) {
                    const f32x16 sacc = dense_scores(cur, qf[r]);
                    const int dbase = tok[r] - kt - 4 * h; float ev[16];
                    if (kt + 31 <= t0 + 8 * r && kt >= t0 + 8 * r + 7 - (WIN - 1)) {
                        const LAS float* hbp = hb + dbase;
#pragma unroll
                        for (int q = 0; q < 16; ++q) { const float e = __builtin_amdgcn_exp2f(sacc[q] + hbp[-((q & 3) + 8 * (q >> 2))] - mhv); ev[q] = e; lw[r] += e; }
                    } else {
#pragma unroll
                    for (int q = 0; q < 16; ++q) { const int dist = dbase - ((q & 3) + 8 * (q >> 2)); const bool ok = (unsigned)dist < (unsigned)WIN;
                        const float e0 = __builtin_amdgcn_exp2f(sacc[q] + hb[ok ? dist : 0] - mhv); const float e = ok ? e0 : 0.f; ev[q] = e; lw[r] += e; }
                    }
                    dense_pv(O[r], cur, ev);
                }
#pragma unroll
                for (int ks = 0; ks < 4; ++ks) cur.ka[ks] = nxtk[ks];
            }
#pragma unroll
            for (int r = 0; r < 2; ++r) { const float l = lw[r] + __shfl_xor(lw[r], 32); int tk = tok[r]; asm volatile("" : "+v"(tk)); const float* gp = GATE + (size_t)(b * S + tk) * 48 + head * 3;
                const float sc = gp[2] / (l * gp[0]);
#pragma unroll
                for (int dt = 0; dt < 2; ++dt) O[r][dt] = O[r][dt] * sc; }
        }
        const int ncmax = t0 >> 4;
        {
            int l31c = l31, hc = h; asm volatile("" : "+v"(l31c), "+v"(hc));
            const bf16_t* KB = (const bf16_t*)(p.ws + WS_KC) + (size_t)bg * 8 * 4096; const bf16_t* VB = (const bf16_t*)(p.ws + WS_VC) + (size_t)bg * 8 * 4096;
            float lc[2] = {0.f, 0.f};
            const int kt_last = ncmax > 0 ? ((ncmax - 1) & ~31) : -32;
            if (ncmax > 0) {
                dense_load_k(cur.ka, KB, 0, l31c, hc);
                for (int kt = 0; kt <= kt_last; kt += 32) {
                    dense_load_k(nxtk, KB, kt + 32 <= kt_last ? kt + 32 : kt_last, l31c, hc);
                    __builtin_amdgcn_sched_barrier(0);
#pragma unroll
                    for (int r = 0; r < 2; ++r) {
                        const f32x16 sacc = dense_scores(cur, qf[r]);
                        if (t0 - 31 - 16 * (kt + 31) >= HBN - 1) {
                            const float bfar = hb[HBN - 1] - mhv;
#pragma unroll
                            for (int q = 0; q < 16; ++q) lc[r] += __builtin_amdgcn_exp2f(sacc[q] + bfar);
                        } else {
                        const int dbase = tok[r] - 31 - 16 * (kt + 4 * hc);
#pragma unroll
                        for (int q = 0; q < 16; ++q) { const int dist = dbase - 16 * ((q & 3) + 8 * (q >> 2)); const int di = dist < 0 ? 0 : (dist > HBN - 1 ? HBN - 1 : dist);
                            const float e0 = __builtin_amdgcn_exp2f(sacc[q] + hb[di] - mhv); lc[r] += dist >= 0 ? e0 : 0.f; }
                        }
                    }
#pragma unroll
                    for (int ks = 0; ks < 4; ++ks) cur.ka[ks] = nxtk[ks];
                }
            }
            float linv[2];
#pragma unroll
            for (int r = 0; r < 2; ++r) { const float l = lc[r] + __shfl_xor(lc[r], 32); linv[r] = l > 0.f ? 1.f / l : 0.f; }
            { const f32x4 z = {0.f, 0.f, 0.f, 0.f};
#pragma unroll
              for (int i = 0; i < 8; ++i) *(LAS f32x4*)(pslc + (i * 64 + lane) * 4) = z; }
            if (ncmax > 0) {
                float carry[2] = {0.f, 0.f};
                dense_load_k(cur.ka, KB, 0, l31c, hc);
                for (int kt = 0; kt <= kt_last; kt += 32) {
                    dense_load_v(cur.va, VB, kt, l31c, hc);
                    dense_load_k(nxtk, KB, kt + 32 <= kt_last ? kt + 32 : kt_last, l31c, hc);
                    __builtin_amdgcn_sched_barrier(0);
#pragma unroll
                    for (int r = 0; r < 2; ++r) {
                        const f32x16 sacc = dense_scores(cur, qf[r]);
                        float pv[16];
                        const int dbase = tok[r] - 31 - 16 * (kt + 4 * hc);
#pragma unroll
                        for (int q = 0; q < 16; ++q) { const int dist = dbase - 16 * ((q & 3) + 8 * (q >> 2)); const int di = dist < 0 ? 0 : (dist > HBN - 1 ? HBN - 1 : dist);
                            const float e0 = __builtin_amdgcn_exp2f(sacc[q] + hb[di] - mhv); pv[q] = dist >= 0 ? e0 * linv[r] : 0.f; }
                        dense_pv(O[r], cur, pv);
#pragma unroll
                        for (int q = 0; q < 16; ++q) { pv[q] += __shfl_xor(pv[q], 1); pv[q] += __shfl_xor(pv[q], 2); }
                        float y[4];
#pragma unroll
                        for (int gq = 0; gq < 4; ++gq) y[gq] = __shfl_xor(pv[4 * gq + 3], 32);
#pragma unroll
                        for (int gq = 0; gq < 4; ++gq) { const float prevv = h ? y[gq] : (gq > 0 ? y[gq > 0 ? gq - 1 : 0] : carry[r]);
                            const float val = 2.f * ((pv[4 * gq] + pv[4 * gq + 1]) + pv[4 * gq + 2]) + pv[4 * gq + 3] + prevv;
                            if ((lane & 3) == 0) pslc[(8 * r + (l31c >> 2)) * 128 + (kt >> 2) + 2 * gq + hc] = val; }
                        carry[r] = y[3];
                    }
#pragma unroll
                    for (int ks = 0; ks < 4; ++ks) cur.ka[ks] = nxtk[ks];
                }
            }
        }
#pragma unroll
        for (int r = 0; r < 2; ++r) { int tk = tok[r]; asm volatile("" : "+v"(tk)); bf16_t* op = OW + (size_t)(b * S + tk) * D + head * 64 + 4 * h; const float gc = GATE[(size_t)(b * S + tk) * 48 + head * 3];
#pragma unroll
            for (int dt = 0; dt < 2; ++dt)
#pragma unroll
                for (int gq = 0; gq < 4; ++gq) { u32x2 w; w.x = cvt_pk_bf16(O[r][dt][4 * gq] * gc, O[r][dt][4 * gq + 1] * gc); w.y = cvt_pk_bf16(O[r][dt][4 * gq + 2] * gc, O[r][dt][4 * gq + 3] * gc);
                    *(u32x2*)(op + dt * 32 + 8 * gq) = w; } }
#pragma unroll 1
        for (int tl = 0; tl < 16; ++tl) {
            int ln = lane; asm volatile("" : "+v"(ln));
            const int t = t0 + tl, cur_b = t >> 6, j0 = ln, j1 = ln + 64;
            const float c0 = pslc[tl * 128 + j0], c1 = pslc[tl * 128 + j1];
            const bool f0 = (j0 == 0) || (j0 == cur_b) || (j0 == cur_b - 1), f1 = (j1 == cur_b) || (j1 == cur_b - 1);
            const bool v0 = j0 * 64 <= t, v1 = j1 * 64 <= t;
            const unsigned u0 = (v0 && !f0) ? __float_as_uint(c0) : 0u, u1 = (v1 && !f1) ? __float_as_uint(c1) : 0u;
            unsigned th = 1u;
            if (cur_b + 1 > NSEL) {
                th = 0u;
#pragma unroll 1
                for (int bit = 30; bit >= 0; --bit) {
                    const unsigned trial = th | (1u << bit);
                    const int cnt = __popcll(__ballot(u0 >= trial)) + __popcll(__ballot(u1 >= trial));
                    if (cnt >= NSEL - 3) { th = trial; if (cnt == NSEL - 3) break; }
                }
            }
            const bool s0 = f0 || (u0 >= th && u0 != 0u), s1 = f1 || (u1 >= th && u1 != 0u);
            const unsigned long long m0 = __ballot(s0), m1 = __ballot(s1), lt = (1ull << ln) - 1ull;
            const int p0 = __popcll(m0 & lt), p1 = __popcll(m0) + __popcll(m1 & lt);
            short* so = SEL + ((size_t)(b * S + t) * 4 + g) * NSEL;
            if (s0 && p0 < NSEL) so[p0] = (short)j0;
            if (s1 && p1 < NSEL) so[p1] = (short)j1;
        }
    }
}

constexpr int ST_ACC = 0, ST_LACC = 133120, ST_MASK = 135168, ST_LIST = 136192, ST_CTR = 138240, ST_HB4 = 138304;
__device__ __forceinline__ void lds_add_f64(unsigned addr, double v) { asm volatile("ds_add_f64 %0, %1" :: "v"(addr), "v"(v) : "memory"); }
__device__ __forceinline__ void phase_sel_tile(const Params& p, LAS unsigned char* lds, bf16_t* AO, const bf16_t* OW) {
    const int tid = opaque_tid(), lane = tid & 63, wave = tid >> 6, l31 = lane & 31, h = lane >> 5;
    LAS double* acc = (LAS double*)(lds + ST_ACC); LAS double* lacc = (LAS double*)(lds + ST_LACC);
    LAS unsigned* mask = (LAS unsigned*)(lds + ST_MASK); LAS int* list = (LAS int*)(lds + ST_LIST) + wave * 64; LAS int* ctr = (LAS int*)(lds + ST_CTR);
    const bf16_t* Q = (const bf16_t*)(p.ws + WS_Q); const float* GATE = (const float*)(p.ws + WS_GATE); const short* SEL = (const short*)(p.ws + WS_SEL);
    const int Gn = gridDim.x;
    for (int kk = 0, u = blockIdx.x; u < 16 * 128; u += Gn, ++kk) {
        const int bg = u >> 7, ti = u & 127, tt = (kk & 1) ? 127 - ti : ti, b = bg >> 2, g = bg & 3, t0 = tt * 64, cur = tt, nv = cur + 1 < NSEL ? cur + 1 : NSEL;
        for (int i = tid; i < ST_LIST / 16; i += NTHR) ((LAS u32x4*)lds)[i] = (u32x4){0u, 0u, 0u, 0u};
        if (tid == 0) *ctr = 0;
        { LAS float* hb4 = (LAS float*)(lds + ST_HB4); const float* hsrc = (const float*)(p.ws + WS_HBG) + 4 * g * HBN; for (int i = tid; i < 4 * HBN; i += NTHR) hb4[i] = hsrc[i]; }
        __syncthreads();
        { const int tl = tid >> 3; const short* sp = SEL + ((size_t)(b * S + t0 + tl) * 4 + g) * NSEL;
#pragma unroll
          for (int e = (tid & 7) * 2; e < (tid & 7) * 2 + 2; ++e) if (e < nv) { const int blk = sp[e]; __hip_atomic_fetch_or(mask + blk * 2 + (tl >> 5), 1u << (tl & 31), __ATOMIC_RELAXED, __HIP_MEMORY_SCOPE_WORKGROUP); } }
        __syncthreads();
        const int nf = cur >= 2 ? 3 : cur + 1, nitems = 2 * nf + (cur >= 3 ? cur - 2 : 0);
        const bf16_t* KB = (const bf16_t*)(p.ws + WS_KSB) + (size_t)bg * 128 * 4096; const bf16_t* VB = (const bf16_t*)(p.ws + WS_VSB) + (size_t)bg * 128 * 4096;
        const int hl = lane & 3, head = 4 * g + hl;
        const LAS float* hbg = (const LAS float*)(lds + ST_HB4) + hl * HBN; const float mhv = ((const float*)(p.ws + WS_MHG))[head], bfar = hbg[HBN - 1] - mhv;
        for (;;) {
            int it = 0; if (lane == 0) it = __hip_atomic_fetch_add(ctr, 1, __ATOMIC_RELAXED, __HIP_MEMORY_SCOPE_WORKGROUP);
            it = __builtin_amdgcn_readfirstlane(it);
            if (it >= nitems) break;
            int j, c_lo, c_hi;
            if (it < 2 * nf) { const int f = it >> 1; j = f == 0 ? cur : (f == 1 ? cur - 1 : 0); c_lo = (it & 1) * 4; c_hi = c_lo + 4; }
            else { j = it - 2 * nf + 1; c_lo = 0; c_hi = 8; }
            const unsigned mlo = (unsigned)__builtin_amdgcn_readfirstlane((int)mask[2 * j]), mhi = (unsigned)__builtin_amdgcn_readfirstlane((int)mask[2 * j + 1]);
            const unsigned long long m = ((unsigned long long)mhi << 32) | mlo; const int n = __popcll(m), nch = (n + 7) >> 3;
            if (c_hi > nch) c_hi = nch;
            if (c_lo >= c_hi) continue;
            if ((m >> lane) & 1ull) list[__popcll(m & ((1ull << lane) - 1ull))] = lane;
            DFrag fr0, fr1;
            dense_load_k(fr0.ka, KB, j * 64, l31, h); dense_load_v(fr0.va, VB, j * 64, l31, h);
            dense_load_k(fr1.ka, KB, j * 64 + 32, l31, h); dense_load_v(fr1.va, VB, j * 64 + 32, l31, h);
            bf16x8 qn[4];
            { const int slot = c_lo * 8 + (l31 >> 2); const int tokl = list[slot < n ? slot : n - 1]; const bf16_t* qp = Q + (size_t)(b * S + t0 + tokl) * D + head * 64 + 8 * h;
#pragma unroll
              for (int ks = 0; ks < 4; ++ks) qn[ks] = *(const bf16x8*)(qp + 16 * ks); }
            for (int c = c_lo; c < c_hi; ++c) {
                const int slot = c * 8 + (l31 >> 2); const bool valid = slot < n; const int tokl = list[valid ? slot : n - 1], tok = t0 + tokl;
                bf16x8 qf[4];
#pragma unroll
                for (int ks = 0; ks < 4; ++ks) qf[ks] = qn[ks];
                { const int sn = (c + 1 < c_hi ? c + 1 : c) * 8 + (l31 >> 2); const int tn = list[sn < n ? sn : n - 1]; const bf16_t* qp = Q + (size_t)(b * S + t0 + tn) * D + head * 64 + 8 * h;
#pragma unroll
                  for (int ks = 0; ks < 4; ++ks) qn[ks] = *(const bf16x8*)(qp + 16 * ks); }
                __builtin_amdgcn_sched_barrier(0);
                f32x16 O[2]; float ls = 0.f;
#pragma unroll
                for (int dt = 0; dt < 2; ++dt)
#pragma unroll
                    for (int q = 0; q < 16; ++q) O[dt][q] = 0.f;
#pragma unroll
                for (int half = 0; half < 2; ++half) {
                    const int kt = j * 64 + 32 * half; const DFrag& fr = half ? fr1 : fr0;
                    const f32x16 sacc = dense_scores(fr, qf); float ev[16];
                    if (t0 - kt - 31 >= HBN - 1) {
#pragma unroll
                        for (int q = 0; q < 16; ++q) { ev[q] = __builtin_amdgcn_exp2f(sacc[q] + bfar); ls += ev[q]; }
                    } else { const int dbase = tok - kt - 4 * h;
#pragma unroll
                        for (int q = 0; q < 16; ++q) { const int dist = dbase - ((q & 3) + 8 * (q >> 2)); const int di = dist < 0 ? 0 : (dist > HBN - 1 ? HBN - 1 : dist);
                            const float e0 = __builtin_amdgcn_exp2f(sacc[q] + hbg[di] - mhv); ev[q] = dist >= 0 ? e0 : 0.f; ls += ev[q]; } }
                    dense_pv(O, fr, ev);
                }
                const float lt = ls + __shfl_xor(ls, 32);
                if (valid) {
                    const unsigned a0 = (unsigned)(size_t)(acc + (tokl * 4 + hl) * 65 + 4 * h);
#pragma unroll
                    for (int dt = 0; dt < 2; ++dt)
#pragma unroll
                        for (int q = 0; q < 16; ++q) lds_add_f64(a0 + (dt * 32 + (q & 3) + 8 * (q >> 2)) * 8, (double)O[dt][q]);
                    if (h == 0) lds_add_f64((unsigned)(size_t)(lacc + tokl * 4 + hl), (double)lt);
                }
            }
        }
        __syncthreads();
        for (int r0 = wave * 32; r0 < wave * 32 + 32; r0 += 8) {
            float gv[8], ov[8];
#pragma unroll
            for (int i = 0; i < 8; ++i) { const int r = r0 + i, tokl = r >> 2, hd = r & 3; const size_t ur = (size_t)(b * S + t0 + tokl);
                gv[i] = GATE[ur * 48 + (4 * g + hd) * 3 + 1]; ov[i] = bf2f(OW[ur * D + (4 * g + hd) * 64 + lane]); }
#pragma unroll
            for (int i = 0; i < 8; ++i) { const int r = r0 + i, tokl = r >> 2, hd = r & 3; const size_t ur = (size_t)(b * S + t0 + tokl);
                const float o = (float)acc[r * 65 + lane] * (1.f / (float)lacc[r]) * gv[i] + ov[i];
                AO[ur * D + (4 * g + hd) * 64 + lane] = (bf16_t)(cvt_pk_bf16(o, 0.f) & 0xffffu); }
        }
        __syncthreads();
    }
}

__device__ __forceinline__ void moe_pstarts(const unsigned* ctl, int (&pst)[NE + 1]) {
    int a = 0;
#pragma unroll
    for (int e = 0; e < NE; ++e) { pst[e] = a; const int c = (int)ctl[CW_CNT + 64 * e]; a += (c + 511) / 512 * 512; }
    pst[NE] = a;
}
__device__ __forceinline__ void phase_moe_sort(const Params& p, LAS unsigned char* lds) {
    const int tid = opaque_tid(), lane = tid & 63, wave = tid >> 6;
    unsigned* ctl = (unsigned*)(p.ws + WS_CTL);
    const int* TOPE = (const int*)(p.ws + WS_TOPE); int* RPOS = (int*)(p.ws + WS_RPOS);
    const bf16_t* HB = (const bf16_t*)(p.ws + WS_HB); bf16_t* XS = (bf16_t*)(p.ws + WS_XS);
    LAS int* wcnt = (LAS int*)lds;
    LAS int* base = (LAS int*)(lds + 128);
    LAS int* posl = (LAS int*)(lds + 256);
    int pst[NE + 1]; moe_pstarts(ctl, pst);
    if (blockIdx.x == 0 && tid <= NE) ((int*)(ctl + 256))[tid] = pst[tid];
    for (int c0 = blockIdx.x * 256; c0 < 2 * T; c0 += gridDim.x * 256) {
        int e = 0, rank = 0;
        if (wave < 4) { e = TOPE[c0 + wave * 64 + lane];
#pragma unroll
            for (int q = 0; q < NE; ++q) { const unsigned long long m = __ballot(e == q); if (e == q) rank = __popcll(m & ((1ull << lane) - 1ull)); if (lane == 0) wcnt[wave * NE + q] = __popcll(m); } }
        __syncthreads();
        if (tid < NE) { const int n = wcnt[tid] + wcnt[NE + tid] + wcnt[2 * NE + tid] + wcnt[3 * NE + tid]; base[tid] = n ? (int)atomicAdd(ctl + CW_CUR + 64 * tid, (unsigned)n) : 0; }
        __syncthreads();
        if (wave < 4) { int off = 0;
            for (int w = 0; w < wave; ++w) off += wcnt[w * NE + e];
            const int pos = pst[e] + base[e] + off + rank; posl[wave * 64 + lane] = pos; RPOS[c0 + wave * 64 + lane] = pos; }
        __syncthreads();
        for (int j = wave * 32; j < wave * 32 + 32; j += 8) {
            u32x4 v0[8]; int ps[8];
#pragma unroll
            for (int q = 0; q < 8; ++q) { const int tk = (c0 + j + q) >> 1; ps[q] = posl[j + q]; v0[q] = *((const u32x4*)((const unsigned char*)HB + (size_t)tk * D) + lane); }
#pragma unroll
            for (int q = 0; q < 8; ++q) *((u32x4*)((unsigned char*)XS + (size_t)ps[q] * D) + lane) = v0[q];
        }
        __syncthreads();
    }
}
__device__ __forceinline__ void phase_combine(const Params& p) {
    const int tid = opaque_tid(), lane = tid & 63, wave = tid >> 6;
    const int gw = blockIdx.x * NWAVE + wave, NGW = gridDim.x * NWAVE;
    const float* TOPW = (const float*)(p.ws + WS_TOPW); const int* RPOS = (const int*)(p.ws + WS_RPOS);
    const bf16_t* Y = (const bf16_t*)(p.ws + WS_Y); const float* g2 = (const float*)(p.ws + WS_MODV) + (11 * 4) * D;
    for (int r = gw; r < T; r += NGW) {
        const int b = r >> 13; const int p0 = RPOS[2 * r], p1 = RPOS[2 * r + 1]; const float w0 = TOPW[2 * r], w1 = TOPW[2 * r + 1];
#pragma unroll
        for (int j = 0; j < 4; ++j) { const int c = 4 * lane + 256 * j;
            const u32x2 y0 = *(const u32x2*)(Y + (size_t)p0 * D + c), y1 = *(const u32x2*)(Y + (size_t)p1 * D + c);
            const f32x4 gv = *(const f32x4*)(g2 + b * D + c); f32x4 xv = *(const f32x4*)(p.out + (size_t)r * D + c);
            f32x4 f; f.x = w0 * bflo(y0.x) + w1 * bflo(y1.x); f.y = w0 * bfhi(y0.x) + w1 * bfhi(y1.x); f.z = w0 * bflo(y0.y) + w1 * bflo(y1.y); f.w = w0 * bfhi(y0.y) + w1 * bfhi(y1.y);
            *(f32x4*)(p.out + (size_t)r * D + c) = xv + gv * f; }
    }
}

#define XB_TMO      128
#define XB_XCNT(j)  (256  + 64 * (j))
#define XB_XSUB(j)  (1280 + 64 * (j))
#define XB_XGEN(j)  (2304 + 64 * (j))
#define XB_TOP      3328
#define XB_TOPGEN   3392
#define XCD_BAR_WORDS 3456
#define XB_SPIN_CAP (1u << 18)
__device__ __forceinline__ unsigned xb_ld(unsigned* p)              { return __hip_atomic_load(p, __ATOMIC_RELAXED, __HIP_MEMORY_SCOPE_AGENT); }
__device__ __forceinline__ unsigned xb_add(unsigned* p, unsigned v) { return __hip_atomic_fetch_add(p, v, __ATOMIC_RELAXED, __HIP_MEMORY_SCOPE_AGENT); }
__device__ __forceinline__ unsigned xb_xcc_id() { return (unsigned)__builtin_amdgcn_s_getreg((3 << 11) | 20) & 0xFu; }
#define XB_SPIN(cond, bar) do { unsigned _sp = 0; while (cond) { __builtin_amdgcn_s_sleep(1); \
    if ((++_sp & 255u) == 0u) { if (xb_ld(&(bar)[XB_TMO])) break; if (_sp > XB_SPIN_CAP) { atomicAdd(&(bar)[XB_TMO], 1u); break; } } } } while (0)
struct XcdBarrier { unsigned* bar; unsigned x; volatile LAS unsigned* st; };
__device__ __forceinline__ XcdBarrier xcd_barrier_post(unsigned* bar, volatile LAS unsigned* st) {
    XcdBarrier b; b.bar = bar; b.x = xb_xcc_id(); b.st = st;
    if (threadIdx.x == 0) (void)xb_add(&bar[XB_XCNT(b.x)], 1u);
    return b;
}
__device__ __forceinline__ void xcd_barrier_complete(unsigned* bar, unsigned x, unsigned& nloc, unsigned& nx) {
    const unsigned G_ = gridDim.x * gridDim.y * gridDim.z;
    unsigned sum, cnt, mine, sp = 0u;
    for (;;) {
        sum = 0u; cnt = 0u; mine = 0u;
#pragma unroll
        for (unsigned j = 0; j < 16; ++j) { const unsigned c = xb_ld(&bar[XB_XCNT(j)]); sum += c; cnt += (c > 0u) ? 1u : 0u; mine = (j == x) ? c : mine; }
        if (sum == G_) break;
        __builtin_amdgcn_s_sleep(1);
        if ((++sp & 255u) == 0u) { if (xb_ld(&bar[XB_TMO])) break; if (sp > XB_SPIN_CAP) { atomicAdd(&bar[XB_TMO], 1u); break; } }
    }
    nloc = mine > 0u ? mine : 1u; nx = cnt > 0u ? cnt : 1u;
}
__device__ __forceinline__ void xcd_barrier(const XcdBarrier& b) {
    asm volatile("s_waitcnt vmcnt(0)" ::: "memory");
    __syncthreads();
    if (threadIdx.x == 0) {
        unsigned* bar = b.bar;
        __builtin_amdgcn_s_waitcnt(0);
        unsigned nloc = b.st[0], nx = b.st[1];
        if (nloc == 0u) { xcd_barrier_complete(bar, b.x, nloc, nx); b.st[0] = nloc; b.st[1] = nx; }
        const unsigned old = xb_add(&bar[XB_XSUB(b.x)], 1u);
        const unsigned gen = old / nloc;
        if (old + 1u == (gen + 1u) * nloc) {
            __builtin_amdgcn_fence(__ATOMIC_RELEASE, "agent");
            asm volatile("s_waitcnt vmcnt(0)" ::: "memory");
            const unsigned og = xb_add(&bar[XB_TOP], 1u);
            const unsigned tg = og / nx;
            if (og + 1u == (tg + 1u) * nx) xb_add(&bar[XB_TOPGEN], 1u);
            else XB_SPIN(xb_ld(&bar[XB_TOPGEN]) == tg, bar);
            __builtin_amdgcn_fence(__ATOMIC_ACQUIRE, "agent");
            xb_add(&bar[XB_XGEN(b.x)], 1u);
            asm volatile("s_waitcnt vmcnt(0)" ::: "memory");
        } else {
            XB_SPIN(xb_ld(&bar[XB_XGEN(b.x)]) == gen, bar);
            __builtin_amdgcn_fence(__ATOMIC_ACQUIRE, "agent");
            asm volatile("s_waitcnt vmcnt(0)" ::: "memory");
        }
    }
    __syncthreads();
}

constexpr int LDS_SCRATCH = 131072, MISC_OFF = 155648, LDS_BYTES = 163840;
#define MODP(which) ((const float*)(p.ws + WS_MODV) + (size_t)(which) * 4 * D)

__global__ void __launch_bounds__(NTHR, 2) k_fused(Params p) {
    extern __shared__ __attribute__((aligned(16))) unsigned char lds_raw[];
    LAS unsigned char* lds = (LAS unsigned char*)lds_raw;
    for (int u = threadIdx.x; u < (LDS_BYTES - LDS_SCRATCH) / 4; u += NTHR) ((LAS unsigned*)(lds + LDS_SCRATCH))[u] = 0u;
    __syncthreads();
    const XcdBarrier bar = xcd_barrier_post((unsigned*)(p.ws + WS_CTL) + CW_BAR, (volatile LAS unsigned*)(lds + MISC_OFF) + 8);
#define GRID_BAR() xcd_barrier(bar)
    phase_weights(p, lds); __syncthreads(); phase_modvec(p, lds);
    GRID_BAR();
    phase_convert_fgu(p, lds); __syncthreads();
    phase_poolmix(p, lds, (bf16_t*)(p.ws + WS_HA));
    GRID_BAR();
    { pg8::Sched<1> Sc; Sc.init(T, D, gridDim.x, blockIdx.x, p.ws + WS_HA, p.ws + WO_POOL, D, 256);
      pg8::EpiEl<EpiPool> E{{p.x, (float*)(p.ws + WS_X1), MODP(2), p.pool_scale, 0}};
      pg8::gemm_phase(lds, 256, D, 256, 128, Sc, E); }
    GRID_BAR();
    { NormOut o0{p.norm_g + D, MODP(4), MODP(3), (bf16_t*)(p.ws + WS_HB)}; phase_norm<1, false, 2>(p, lds, (const float*)(p.ws + WS_X1), o0, o0); }
    GRID_BAR();
    { pg8::Sched<0> Sc; Sc.init(T, 2 * FF, gridDim.x, blockIdx.x, p.ws + WS_HB, p.ws + WO_FGU, D / 2, D / 2);
      pg8::EpiPairEl<EpiSwigluI8> E{{(bf16_t*)(p.ws + WS_HID0), FF, (const float*)(p.ws + WS_ASC), (const float*)(p.ws + WS_FGMAX)}};
      pg8::gemm_phase<pg8::EpiPairEl<EpiSwigluI8>, pg8::Sched<0>, true, true, 2>(lds, D / 2, D / 2, D / 2, 128, Sc, E); }
    GRID_BAR();
    { pg8::Sched<0> Sc; Sc.init(T, D, gridDim.x, blockIdx.x, p.ws + WS_HID0, p.ws + WO_FDN, FF, FF);
      pg8::EpiEl<EpiResid> E{{(const float*)(p.ws + WS_X1), (float*)(p.ws + WS_X2), MODP(5)}};
      pg8::gemm_phase(lds, FF, FF, FF, 128, Sc, E); }
    GRID_BAR();
    { NormOut o0{p.kv_norm_g, MODP(13), MODP(12), (bf16_t*)(p.ws + WS_HA)}; NormOut o1{p.norm_g + 2 * D, MODP(7), MODP(6), (bf16_t*)(p.ws + WS_HB)}; phase_norm<2, false>(p, lds, (const float*)(p.ws + WS_X2), o0, o1); }
    GRID_BAR();
    { pg8::Sched<0> Sc; Sc.init(T, NKV, gridDim.x, blockIdx.x, p.ws + WS_HA, p.ws + WO_KV, D, D);
      pg8::EpiEl<EpiBf16> E{{(bf16_t*)(p.ws + WS_KVB), NKV}};
      pg8::gemm_phase(lds, D, D, D, 128, Sc, E); }
    { pg8::Sched<0> Sc; Sc.init(T, D, gridDim.x, blockIdx.x, p.ws + WS_HB, p.ws + WO_Q, D, D);
      pg8::EpiEl<EpiQ> E{{(bf16_t*)(p.ws + WS_Q), (float*)(p.ws + WS_GATE), 0}};
      pg8::gemm_phase(lds, D, D, D, 128, Sc, E); }
    GRID_BAR();
    { pg8::Sched<2> Sc; Sc.init(2048, 2048, gridDim.x, blockIdx.x, p.ws + WS_KVB, p.ws + WO_CK, 16 * NKV, 2048);
      pg8::EpiEl<EpiCmp> E{{(bf16_t*)(p.ws + WS_CMPH), (const float*)(p.ws + WS_CMPB)}};
      pg8::gemm_phase(lds, 2048, 16 * NKV, 2048, (size_t)NKV * 2, Sc, E); }
    { pg8::Sched<0> Sc; Sc.init(T, 256, (int)gridDim.x - 64 > 0 ? (int)gridDim.x - 64 : 1, (int)gridDim.x > 64 ? (int)blockIdx.x - 64 : (int)blockIdx.x, p.ws + WS_HB, p.ws + WO_Q + (size_t)D * D * 2, D, D);
      pg8::EpiEl<EpiQ> E{{(bf16_t*)(p.ws + WS_Q), (float*)(p.ws + WS_GATE), D}};
      pg8::gemm_phase(lds, D, D, D, 128, Sc, E); }
    phase_headnorm(p, lds); phase_vtrans(p, lds);
    GRID_BAR();
    phase_cmp2(p, lds);
    GRID_BAR();
    attn_tables(p, lds);
    phase_dense(p, lds, (bf16_t*)(p.ws + WS_HB));
    GRID_BAR();
    phase_sel_tile(p, lds, (bf16_t*)(p.ws + WS_HA), (const bf16_t*)(p.ws + WS_HB));
    GRID_BAR();
    { pg8::Sched<0> Sc; Sc.init(T, D, gridDim.x, blockIdx.x, p.ws + WS_HA, p.ws + WO_O, D, D);
      pg8::EpiEl<EpiResid> E{{(const float*)(p.ws + WS_X2), p.out, MODP(8)}};
      pg8::gemm_phase(lds, D, D, D, 128, Sc, E); }
    GRID_BAR();
    { NormOut o0{p.norm_g + 3 * D, MODP(10), MODP(9), (bf16_t*)(p.ws + WS_HB)}; phase_norm<1, true, 1>(p, lds, p.out, o0, o0); }
    GRID_BAR();
    phase_moe_sort(p, lds);
    GRID_BAR();
    { const int* pst = (const int*)(p.ws + WS_CTL) + 256;
      pg8::Sched<3> Sc; Sc.init(pst[NE], 2 * FE, gridDim.x, blockIdx.x, p.ws + WS_XS, p.ws + WO_EGU, D / 2, D / 2, pst, (size_t)FE * D);
      pg8::EpiPairEl<EpiSwiglu8> E{{p.ws + WS_HIDM, FE}};
      pg8::gemm_phase<pg8::EpiPairEl<EpiSwiglu8>, pg8::Sched<3>, true, true, 1>(lds, D / 2, D / 2, D / 2, 128, Sc, E, 127 - 5); }
    GRID_BAR();
    { const int* pst = (const int*)(p.ws + WS_CTL) + 256;
      pg8::Sched<3> Sc; Sc.init(pst[NE], D, gridDim.x, blockIdx.x, p.ws + WS_HIDM, p.ws + WO_EDN, FE / 2, FE / 2, pst, (size_t)D * FE / 2);
      pg8::EpiEl<EpiBf16> E{{(bf16_t*)(p.ws + WS_Y), D}};
      pg8::gemm_phase<pg8::EpiEl<EpiBf16>, pg8::Sched<3>, true, true, 1>(lds, FE / 2, FE / 2, FE / 2, 128, Sc, E, 127 - 6); }
    GRID_BAR();
    phase_combine(p);
}

extern "C" void kernel_launch(void* const* d_in, const int* in_sizes, int n_in, void* d_out, int out_size, void* d_ws, size_t ws_size, hipStream_t stream) {
    if (n_in != 28 || out_size != T * D || ws_size < WS_END) { fprintf(stderr, "kernel_launch: unexpected shapes (n_in %d out %d ws %zu need %zu)\n", n_in, out_size, ws_size, (size_t)WS_END); return; }
    static int grid = 0;
    if (grid == 0) {
        int dev = 0, cus = 0, per_cu = 0;
        if (hipGetDevice(&dev) != hipSuccess || hipDeviceGetAttribute(&cus, hipDeviceAttributeMultiprocessorCount, dev) != hipSuccess) { grid = -1; return; }
        if (hipFuncSetAttribute((const void*)k_fused, hipFuncAttributeMaxDynamicSharedMemorySize, LDS_BYTES) != hipSuccess) { grid = -1; return; }
        if (hipOccupancyMaxActiveBlocksPerMultiprocessor(&per_cu, (const void*)k_fused, NTHR, LDS_BYTES) != hipSuccess || per_cu < 1) { fprintf(stderr, "kernel_launch: occupancy query says %d\n", per_cu); }
        (void)hipGetLastError();
        grid = cus;
    }
    if (grid < 0) return;
    Params p{};
    const float** pp = (const float**)&p;
    for (int i = 0; i < 28; ++i) pp[i] = (const float*)d_in[i];
    p.out = (float*)d_out; p.ws = (unsigned char*)d_ws;
    (void)hipMemsetAsync((char*)d_ws + WS_CTL, 0, CTL_BYTES, stream);
    k_fused<<<dim3(grid), dim3(NTHR), LDS_BYTES, stream>>>(p);
}
```

```cpp
#include <hip/hip_runtime.h>
#include <cstdint>
#include <cstdio>

#define LAS __attribute__((address_space(3)))
typedef unsigned short bf16_t;
typedef short bf16x8 __attribute__((ext_vector_type(8)));
typedef float f32x4 __attribute__((ext_vector_type(4)));
typedef float f32x2 __attribute__((ext_vector_type(2)));
typedef unsigned u32x4 __attribute__((ext_vector_type(4)));
typedef unsigned u32x2 __attribute__((ext_vector_type(2)));

constexpr int NB = 4, S = 8192, D = 1024, T = NB * S;
constexpr int FF = 2816, NE = 8, FE = 3584;
constexpr int NKV = 1536, NQP = 1280, NQ = 1072;
constexpr int G = 4, HD = 64, NH = 16;
constexpr int NC = 512;
constexpr int NSB = 128;
constexpr int NSEL = 16;
constexpr int WIN = 512;
constexpr int MOE_ROWS = 69632;
constexpr float EPS = 1e-6f;
constexpr int NTHR = 512, NWAVE = 8;

constexpr size_t MiB = 1u << 20;
constexpr size_t WS_CTL = 0, CTL_BYTES = 1 * MiB;
constexpr size_t WS_MODV = 1 * MiB;
constexpr size_t WS_CMPB = WS_MODV + 14 * 4 * 1024 * 4;
constexpr size_t WS_FGMAX = WS_CMPB + 4096;
constexpr size_t WS_ASC = WS_FGMAX + 2 * FF * 4;
constexpr size_t WS_HBG = 6 * MiB;
constexpr size_t WS_MHG = WS_HBG + 65536;
constexpr size_t WS_TOPE = 2 * MiB;
constexpr size_t WS_TOPW = WS_TOPE + (size_t)T * 8;
constexpr size_t WS_RPOS = WS_TOPW + (size_t)T * 8;
constexpr size_t WS_RTOK = WS_RPOS + (size_t)T * 8;
constexpr size_t WS_SMALL_END = WS_RTOK + (size_t)MOE_ROWS * 4;
static_assert(WS_SMALL_END <= 8 * MiB && WS_ASC + (size_t)T * 4 <= 2 * MiB, "small region");
constexpr size_t WS_W = 8 * MiB;
constexpr size_t WO_POOL = WS_W;
constexpr size_t WO_FGU = WO_POOL + (size_t)4 * 256 * 256 * 2;
constexpr size_t WO_FDN = WO_FGU + (size_t)2 * FF * D * 2;
constexpr size_t WO_KV = WO_FDN + (size_t)D * FF * 2;
constexpr size_t WO_Q = WO_KV + (size_t)NKV * D * 2;
constexpr size_t WO_O = WO_Q + (size_t)NQP * D * 2;
constexpr size_t WO_CK = WO_O + (size_t)D * D * 2;
constexpr size_t WO_CV = WO_CK + (size_t)256 * 2048 * 2;
constexpr size_t WO_EGU = WO_CV + (size_t)256 * 2048 * 2;
constexpr size_t WO_EDN = WO_EGU + (size_t)NE * 2 * FE * D * 2;
constexpr size_t WO_END = WO_EDN + (size_t)NE * D * FE * 2;
static_assert(WO_END <= 203 * MiB, "weights region");
constexpr size_t WS_HB = 203 * MiB;
constexpr size_t WS_X1 = 267 * MiB;
constexpr size_t WS_X2 = 395 * MiB;
constexpr size_t WS_HID0 = 523 * MiB;
constexpr size_t WS_Q = 523 * MiB;
constexpr size_t WS_GATE = 587 * MiB;
constexpr size_t WS_CMPH = 593 * MiB;
constexpr size_t WS_KC = 601 * MiB;
constexpr size_t WS_VC = 602 * MiB;
constexpr size_t WS_KSB = 603 * MiB;
constexpr size_t WS_VSB = 619 * MiB;
constexpr size_t WS_KWB = 635 * MiB;
constexpr size_t WS_VWB = 651 * MiB;
constexpr size_t WS_Q8 = 267 * MiB;
constexpr size_t WS_SEL = 667 * MiB;
constexpr size_t WS_HA = 699 * MiB;
constexpr size_t WS_KVB = 763 * MiB;
constexpr size_t WS_HIDM = 267 * MiB;
constexpr size_t WS_Y = 743 * MiB;
constexpr size_t WS_XS = WS_Y;
constexpr size_t WS_END = 880 * MiB;
static_assert(WS_HIDM + (size_t)MOE_ROWS * FE * 2 <= WS_Y && WS_Y + (size_t)MOE_ROWS * D * 2 <= WS_END, "moe map");
static_assert(WS_KVB + (size_t)T * NKV * 2 + 65536 <= WS_END, "kv map");
constexpr int CW_CNT = 512;
constexpr int CW_CUR = 1024;
constexpr int CW_HN = 2048, CW_VT = 2112;
constexpr int CW_BAR = 4096;

struct Params {
    const float *x, *c, *ada_w, *ada_b, *norm_g, *pool_w, *pool_scale, *q_w, *q_gain, *o_w, *kv_ada_w, *kv_ada_b, *kv_norm_g, *kv_w,
        *cmp_pe_k, *cmp_pe_v, *cmp_k_w1, *cmp_k_w2, *cmp_v_w1, *cmp_v_w2, *k_gain, *rel_bias, *ffn_gu, *ffn_dn, *router_w, *router_b, *exp_gu, *exp_dn;
    float* out; unsigned char* ws;
};

__device__ __forceinline__ unsigned cvt_pk_bf16(float lo, float hi) { unsigned r; asm volatile("v_cvt_pk_bf16_f32 %0, %1, %2" : "=v"(r) : "v"(lo), "v"(hi)); return r; }
__device__ __forceinline__ float bf2f(unsigned short v) { return __uint_as_float((unsigned)v << 16); }
__device__ __forceinline__ float bflo(unsigned w) { return __uint_as_float(w << 16); }
__device__ __forceinline__ float bfhi(unsigned w) { return __uint_as_float(w & 0xffff0000u); }
__device__ __forceinline__ int opaque_tid() { int t = threadIdx.x; asm volatile("" : "+v"(t)); return t; }
__device__ __forceinline__ float readlane_f(float v, int l) { return __uint_as_float((unsigned)__builtin_amdgcn_readlane((int)__float_as_uint(v), l)); }
__device__ __forceinline__ unsigned pack_i8x4(float a, float b, float c, float d) {
    const int ia = (int)__builtin_rintf(fminf(fmaxf(a, -127.f), 127.f)), ib = (int)__builtin_rintf(fminf(fmaxf(b, -127.f), 127.f)), ic = (int)__builtin_rintf(fminf(fmaxf(c, -127.f), 127.f)), id = (int)__builtin_rintf(fminf(fmaxf(d, -127.f), 127.f));
    return (unsigned)(ia & 0xff) | ((unsigned)(ib & 0xff) << 8) | ((unsigned)(ic & 0xff) << 16) | ((unsigned)(id & 0xff) << 24);
}
__device__ __forceinline__ float sel_q_scale(const float* q_gain) { float m = 0.f; for (int i = 0; i < 64; ++i) m = fmaxf(m, fabsf(q_gain[i])); return 127.f / (4.f * m * 0.125f * 1.4426950408889634f); }
__device__ __forceinline__ float sel_k_scale(const float* k_gain) { float m = 0.f; for (int i = 0; i < 64; ++i) m = fmaxf(m, fabsf(k_gain[64 + i])); return 127.f / (4.f * m); }
__device__ __forceinline__ float wave_sum(float v) {
#pragma unroll
    for (int o = 1; o < 64; o <<= 1) v += __shfl_xor(v, o);
    return v;
}
__device__ __forceinline__ float wave_max(float v) {
#pragma unroll
    for (int o = 1; o < 64; o <<= 1) v = fmaxf(v, __shfl_xor(v, o));
    return v;
}
__device__ __forceinline__ float silu_f(float v) { return v * __builtin_amdgcn_rcpf(1.f + __builtin_amdgcn_exp2f(v * -1.4426950408889634f)); }
__device__ __forceinline__ float sigmoid_f(float v) { return __builtin_amdgcn_rcpf(1.f + __builtin_amdgcn_exp2f(v * -1.4426950408889634f)); }
__device__ __forceinline__ float gelu_tanh_f(float v) {
    const float u = 0.7978845608028654f * (v + 0.044715f * v * v * v);
    const float e = __builtin_amdgcn_exp2f(fabsf(u) * -2.8853900817779268f); const float th = (1.f - e) * __builtin_amdgcn_rcpf(1.f + e);
    return 0.5f * v * (1.f + (u < 0.f ? -th : th));
}
__device__ __forceinline__ int rel_bucket(int d) {
    if (d < 16) return d;
    int b = 16;
    b += (d >= 21); b += (d >= 27); b += (d >= 35); b += (d >= 46); b += (d >= 59); b += (d >= 77); b += (d >= 99); b += (d >= 128);
    b += (d >= 166); b += (d >= 216); b += (d >= 280); b += (d >= 363); b += (d >= 470); b += (d >= 609); b += (d >= 790);
    return b;
}

template <bool FP8 = false>
__device__ __forceinline__ void transpose_item(const float* W, int K, int N, bf16_t* WT, int k0, int n0, int drow0, LAS float* scr, int lane, float wscale = 1.f) {
    float wv[32];
#pragma unroll
    for (int i = 0; i < 32; ++i) { const int kk = 2 * i + (lane >> 5); const int n = n0 + (lane & 31); wv[i] = (n < N) ? W[(size_t)(k0 + kk) * N + n] : 0.f; }
#pragma unroll
    for (int i = 0; i < 32; ++i) { const int kk = 2 * i + (lane >> 5); scr[kk * 33 + (lane & 31)] = wv[i]; }
    asm volatile("s_waitcnt lgkmcnt(0)" ::: "memory");
    const int c = lane & 7;
#pragma unroll
    for (int j = 0; j < 4; ++j) { const int n = (lane >> 3) + 8 * j; const LAS float* s = scr + (8 * c) * 33 + n;
        if constexpr (FP8) {
            unsigned w0 = 0u, w1 = 0u;
            w0 = __builtin_amdgcn_cvt_pk_fp8_f32(s[0 * 33] * wscale, s[1 * 33] * wscale, w0, false); w0 = __builtin_amdgcn_cvt_pk_fp8_f32(s[2 * 33] * wscale, s[3 * 33] * wscale, w0, true);
            w1 = __builtin_amdgcn_cvt_pk_fp8_f32(s[4 * 33] * wscale, s[5 * 33] * wscale, w1, false); w1 = __builtin_amdgcn_cvt_pk_fp8_f32(s[6 * 33] * wscale, s[7 * 33] * wscale, w1, true);
            *(u32x2*)((unsigned char*)WT + (size_t)(drow0 + n) * K + k0 + 8 * c) = (u32x2){w0, w1};
        } else {
        u32x4 o; o.x = cvt_pk_bf16(s[0 * 33], s[1 * 33]); o.y = cvt_pk_bf16(s[2 * 33], s[3 * 33]); o.z = cvt_pk_bf16(s[4 * 33], s[5 * 33]); o.w = cvt_pk_bf16(s[6 * 33], s[7 * 33]);
        *(u32x4*)(WT + (size_t)(drow0 + n) * K + k0 + 8 * c) = o; } }
    asm volatile("s_waitcnt lgkmcnt(0)" ::: "memory");
}
template <int MODE, bool FP8 = false>
__device__ __forceinline__ void transpose_mat(const float* W, int K, int N, int NP, int F, bf16_t* WT, int it, LAS float* scr, int lane, float wscale = 1.f) {
    const int nblk = NP / 32, kb = it / nblk, nb = it % nblk, n0 = nb * 32;
    int drow0 = n0;
    if (MODE == 1) { const int up = n0 >= F, j = up ? n0 - F : n0; drow0 = (j >> 7) * 256 + (up ? 128 : 0) + (j & 127); }
    transpose_item<FP8>(W, K, N, WT, kb * 64, n0, drow0, scr, lane, wscale);
}
__device__ __forceinline__ void phase_convert_fgu(const Params& p, LAS unsigned char* lds) {
    const int tid = opaque_tid(), lane = tid & 63, wave = tid >> 6;
    LAS float* scr = (LAS float*)(lds + wave * 16384);
    const int gw = blockIdx.x * NWAVE + wave, NGW = gridDim.x * NWAVE;
    const float* FGMAX = (const float*)(p.ws + WS_FGMAX); unsigned char* WT = p.ws + WO_FGU;
    for (int it = gw; it < 16 * 176; it += NGW) {
        const int kb = it / 176, nb = it % 176, n0 = nb * 32, k0 = kb * 64;
        const int up = n0 >= FF, j0 = up ? n0 - FF : n0, drow0 = (j0 >> 7) * 256 + (up ? 128 : 0) + (j0 & 127);
        float wv[32];
#pragma unroll
        for (int i = 0; i < 32; ++i) wv[i] = p.ffn_gu[(size_t)(k0 + 2 * i + (lane >> 5)) * (2 * FF) + n0 + (lane & 31)];
#pragma unroll
        for (int i = 0; i < 32; ++i) scr[(2 * i + (lane >> 5)) * 33 + (lane & 31)] = wv[i];
        asm volatile("s_waitcnt lgkmcnt(0)" ::: "memory");
        const int c = lane & 7;
#pragma unroll
        for (int j = 0; j < 4; ++j) { const int n = (lane >> 3) + 8 * j; const LAS float* sp = scr + (8 * c) * 33 + n; const float sc = 127.f / FGMAX[n0 + n];
            const unsigned w0 = pack_i8x4(sp[0 * 33] * sc, sp[1 * 33] * sc, sp[2 * 33] * sc, sp[3 * 33] * sc), w1 = pack_i8x4(sp[4 * 33] * sc, sp[5 * 33] * sc, sp[6 * 33] * sc, sp[7 * 33] * sc);
            *(u32x2*)(WT + (size_t)(drow0 + n) * D + k0 + 8 * c) = (u32x2){w0, w1}; }
        asm volatile("s_waitcnt lgkmcnt(0)" ::: "memory");
    }
}
__device__ __forceinline__ void phase_weights(const Params& p, LAS unsigned char* lds) {
    const int tid = opaque_tid(), lane = tid & 63, wave = tid >> 6;
    LAS float* scr = (LAS float*)(lds + wave * 16384);
    const int gw = blockIdx.x * NWAVE + wave, NGW = gridDim.x * NWAVE;
    unsigned char* ws = p.ws;
    constexpr int I_POOL = 4 * 8, I_FGU = 16 * 176, I_FDN = 44 * 32, I_KV = 16 * 48, I_Q = 16 * 40, I_O = 16 * 32, I_C = 32 * 8, I_EGU = 16 * 224, I_EDN = 56 * 32;
    constexpr int TOT = 4 * I_POOL + I_FGU + I_FDN + I_KV + I_Q + I_O + 2 * I_C + NE * I_EGU + NE * I_EDN;
    for (int it = gw; it < TOT; it += NGW) {
        int r = it;
        if (r < 4 * I_POOL) { const int g = r / I_POOL; transpose_mat<0>(p.pool_w + (size_t)g * 65536, 256, 256, 256, 0, (bf16_t*)(ws + WO_POOL) + (size_t)g * 65536, r % I_POOL, scr, lane); continue; } r -= 4 * I_POOL;
        if (r < I_FGU) continue; r -= I_FGU;
        if (r < I_FDN) { transpose_mat<0>(p.ffn_dn, FF, D, D, 0, (bf16_t*)(ws + WO_FDN), r, scr, lane); continue; } r -= I_FDN;
        if (r < I_KV) { transpose_mat<0>(p.kv_w, D, NKV, NKV, 0, (bf16_t*)(ws + WO_KV), r, scr, lane); continue; } r -= I_KV;
        if (r < I_Q) { transpose_mat<0>(p.q_w, D, NQ, NQP, 0, (bf16_t*)(ws + WO_Q), r, scr, lane); continue; } r -= I_Q;
        if (r < I_O) { transpose_mat<0>(p.o_w, D, D, D, 0, (bf16_t*)(ws + WO_O), r, scr, lane); continue; } r -= I_O;
        if (r < I_C) { transpose_mat<0>(p.cmp_k_w1, 2048, 256, 256, 0, (bf16_t*)(ws + WO_CK), r, scr, lane); continue; } r -= I_C;
        if (r < I_C) { transpose_mat<0>(p.cmp_v_w1, 2048, 256, 256, 0, (bf16_t*)(ws + WO_CV), r, scr, lane); continue; } r -= I_C;
        if (r < NE * I_EGU) { const int e = r / I_EGU; transpose_mat<1, true>(p.exp_gu + (size_t)e * D * 2 * FE, D, 2 * FE, 2 * FE, FE, (bf16_t*)(ws + WO_EGU + (size_t)e * 2 * FE * D), r % I_EGU, scr, lane, 32.f); continue; } r -= NE * I_EGU;
        { const int e = r / I_EDN; transpose_mat<0, true>(p.exp_dn + (size_t)e * FE * D, FE, D, D, 0, (bf16_t*)(ws + WO_EDN + (size_t)e * D * FE), r % I_EDN, scr, lane, 64.f); }
    }
}

__device__ __forceinline__ void phase_modvec(const Params& p, LAS unsigned char* lds) {
    const int tid = opaque_tid(), lane = tid & 63, wave = tid >> 6;
    LAS float* part = (LAS float*)lds;
    LAS float* sc_l = (LAS float*)(lds + 8192);
    for (int i = tid; i < 4 * D; i += NTHR) sc_l[i] = silu_f(p.c[i]);
    __syncthreads();
    float* MODV = (float*)(p.ws + WS_MODV);
    float* CMPB = (float*)(p.ws + WS_CMPB);
    { float* FGMAX = (float*)(p.ws + WS_FGMAX);
      for (int u = blockIdx.x; u < 2 * FF / 64; u += gridDim.x) {
        const int col = u * 64 + lane; float m = 0.f;
#pragma unroll 16
        for (int k = wave * 128; k < wave * 128 + 128; ++k) m = fmaxf(m, fabsf(p.ffn_gu[(size_t)k * (2 * FF) + col]));
        part[wave * 64 + lane] = m;
        __syncthreads();
        if (tid < 64) { float mm = part[lane];
#pragma unroll
            for (int w = 1; w < 8; ++w) mm = fmaxf(mm, part[w * 64 + lane]);
            FGMAX[u * 64 + lane] = fmaxf(mm, 1e-30f); }
        __syncthreads();
      } }
    constexpr int NU_MOD = 14336 / 64, NU = NU_MOD + 8;
    for (int u = blockIdx.x; u < NU; u += gridDim.x) {
        float acc[4] = {0.f, 0.f, 0.f, 0.f};
        if (u < NU_MOD) {
            const int gc = u * 64 + lane;
            const float* W; int ldw, col;
            if (gc < 6144) { W = p.ada_w; ldw = 6144; col = gc; } else if (gc < 12288) { W = p.ada_w + (size_t)D * 6144; ldw = 6144; col = gc - 6144; } else { W = p.kv_ada_w; ldw = 2048; col = gc - 12288; }
#pragma unroll 16
            for (int k = wave * 128; k < wave * 128 + 128; ++k) {
                const float w = W[(size_t)k * ldw + col];
#pragma unroll
                for (int b = 0; b < 4; ++b) acc[b] += sc_l[b * D + k] * w;
            }
        } else {
            const int cu = u - NU_MOD, kv = cu >> 2, col = (cu & 3) * 64 + lane;
            const float* W = kv ? p.cmp_v_w1 : p.cmp_k_w1; const float* pe = kv ? p.cmp_pe_v : p.cmp_pe_k;
#pragma unroll 16
            for (int k = wave * 256; k < wave * 256 + 256; ++k) acc[0] += pe[k] * W[(size_t)k * 256 + col];
        }
#pragma unroll
        for (int b = 0; b < 4; ++b) part[(wave * 4 + b) * 64 + lane] = acc[b];
        __syncthreads();
        if (tid < 256) {
            const int b = tid >> 6; float s = 0.f;
#pragma unroll
            for (int w = 0; w < 8; ++w) s += part[(w * 4 + b) * 64 + lane];
            if (u < NU_MOD) {
                const int gc = u * 64 + lane; int which, n; float bias;
                if (gc < 6144) { which = gc >> 10; n = gc & 1023; bias = p.ada_b[gc]; } else if (gc < 12288) { which = 6 + ((gc - 6144) >> 10); n = gc & 1023; bias = p.ada_b[gc]; }
                else { which = 12 + ((gc - 12288) >> 10); n = gc & 1023; bias = p.kv_ada_b[gc - 12288]; }
                MODV[(which * 4 + b) * D + n] = s + bias;
            } else if (b == 0) { const int cu = u - NU_MOD; CMPB[(cu >> 2) * 256 + (cu & 3) * 64 + lane] = s; }
        }
        __syncthreads();
    }
}

template <int W>
__device__ __forceinline__ void pool_rows(const float* xb, int t0, const LAS float* rs, f32x2 gm, f32x2 sh, bf16_t* outb, int c0) {
    f32x2 ring[16];
#pragma unroll
    for (int i = 0; i < 15; ++i) {
        const int t = t0 - 15 + i; f32x2 h = {0.f, 0.f};
        if (t >= 0) { const f32x2 xv = *(const f32x2*)(xb + (size_t)t * D + c0); const float r = rs[i]; h = xv * r * gm + sh; }
        ring[i] = h;
    }
    for (int gi = 0; gi < 8; ++gi) {
#pragma unroll
        for (int j = 0; j < 16; ++j) {
            const int i = 15 + gi * 16 + j, t = t0 + gi * 16 + j;
            const f32x2 xv = *(const f32x2*)(xb + (size_t)t * D + c0); const float r = rs[i];
            const f32x2 h = xv * r * gm + sh;
            ring[(15 + j) & 15] = h;
            f32x2 s = {0.f, 0.f};
#pragma unroll
            for (int k = 0; k < W; ++k) s += ring[(15 + j - k) & 15];
            const int cnt = (t + 1 < W) ? t + 1 : W;
            const f32x2 o = s * (1.f / (float)cnt) - h;
            *(unsigned*)(outb + (size_t)t * D + c0) = cvt_pk_bf16(o.x, o.y);
        }
    }
}
__device__ __forceinline__ void phase_poolmix(const Params& p, LAS unsigned char* lds, bf16_t* mixA) {
    const int tid = opaque_tid(), lane = tid & 63, wave = tid >> 6;
    LAS float* rs = (LAS float*)lds;
    const float* MODV = (const float*)(p.ws + WS_MODV);
    for (int u = blockIdx.x; u < T / 128; u += gridDim.x) {
        const int b = u >> 6, t0 = (u & 63) * 128;
        const float* xb = p.x + (size_t)b * S * D;
        for (int i = wave; i < 143; i += NWAVE) {
            const int t = t0 - 15 + i; float r = 0.f;
            if (t >= 0) { const f32x4* xr = (const f32x4*)(xb + (size_t)t * D) + lane; float s = 0.f;
#pragma unroll
                for (int j = 0; j < 4; ++j) { const f32x4 v = xr[64 * j]; s += (v.x * v.x + v.y * v.y) + (v.z * v.z + v.w * v.w); }
                r = 1.f / sqrtf(wave_sum(s) * (1.f / D) + EPS); }
            if (lane == 0) rs[i] = r;
        }
        __syncthreads();
        const int c0 = 2 * tid;
        const f32x2 g = *(const f32x2*)(p.norm_g + c0), sc = *(const f32x2*)(MODV + (1 * 4 + b) * D + c0), sh = *(const f32x2*)(MODV + (0 * 4 + b) * D + c0);
        const f32x2 gm = g * (sc + 1.f);
        bf16_t* ob = mixA + (size_t)b * S * D;
        const int grp = tid >> 7;
        if (grp == 0) pool_rows<2>(xb, t0, rs, gm, sh, ob, c0);
        else if (grp == 1) pool_rows<4>(xb, t0, rs, gm, sh, ob, c0);
        else if (grp == 2) pool_rows<8>(xb, t0, rs, gm, sh, ob, c0);
        else pool_rows<16>(xb, t0, rs, gm, sh, ob, c0);
        __syncthreads();
    }
}

struct NormOut { const float* g; const float* sc; const float* sh; bf16_t* out; };
template <int NOUT, bool ROUTER, int OUTQ = 0>
__device__ __forceinline__ void phase_norm(const Params& p, LAS unsigned char* lds, const float* xin, const NormOut o0, const NormOut o1) {
    const int tid = opaque_tid(), lane = tid & 63, wave = tid >> 6;
    const int gw = blockIdx.x * NWAVE + wave, NGW = gridDim.x * NWAVE;
    f32x4 rwa[16], rwb[16];
    if (ROUTER) {
#pragma unroll
        for (int j = 0; j < 4; ++j)
#pragma unroll
            for (int q = 0; q < 4; ++q) { const f32x4* wp = (const f32x4*)(p.router_w + (size_t)(4 * lane + 256 * j + q) * NE); rwa[4 * j + q] = wp[0]; rwb[4 * j + q] = wp[1]; }
    }
    unsigned* ctl = (unsigned*)(p.ws + WS_CTL);
    int* TOPE = (int*)(p.ws + WS_TOPE); float* TOPW = (float*)(p.ws + WS_TOPW);
    unsigned cnt_local[NE];
#pragma unroll
    for (int e = 0; e < NE; ++e) cnt_local[e] = 0;
    const int rows_per = T / NGW > 0 ? (T + NGW - 1) / NGW : 1;
    const int r0 = gw * rows_per, r1 = (r0 + rows_per < T) ? r0 + rows_per : T;
    int curb = -1; f32x4 gm0[4], sh0[4], gm1[4], sh1[4];
    for (int r = r0; r < r1; ++r) {
        const int b = r >> 13;
        if (b != curb) { curb = b;
#pragma unroll
            for (int j = 0; j < 4; ++j) { const int c = 4 * lane + 256 * j;
                gm0[j] = *(const f32x4*)(o0.g + c) * (*(const f32x4*)(o0.sc + b * D + c) + 1.f); sh0[j] = *(const f32x4*)(o0.sh + b * D + c);
                if (NOUT > 1) { gm1[j] = *(const f32x4*)(o1.g + c) * (*(const f32x4*)(o1.sc + b * D + c) + 1.f); sh1[j] = *(const f32x4*)(o1.sh + b * D + c); } } }
        const f32x4* xr = (const f32x4*)(xin + (size_t)r * D) + lane;
        f32x4 v[4]; float s = 0.f;
#pragma unroll
        for (int j = 0; j < 4; ++j) { v[j] = xr[64 * j]; s += (v[j].x * v[j].x + v[j].y * v[j].y) + (v[j].z * v[j].z + v[j].w * v[j].w); }
        const float rstd = 1.f / sqrtf(wave_sum(s) * (1.f / D) + EPS);
        float lg[NE];
#pragma unroll
        for (int e = 0; e < NE; ++e) lg[e] = 0.f;
        float qsc = 1.f;
        if constexpr (OUTQ == 2) { float mx = 0.f;
#pragma unroll
            for (int j = 0; j < 4; ++j) { const f32x4 h = v[j] * rstd * gm0[j] + sh0[j]; mx = fmaxf(mx, fmaxf(fmaxf(fabsf(h.x), fabsf(h.y)), fmaxf(fabsf(h.z), fabsf(h.w)))); }
            mx = fmaxf(wave_max(mx), 1e-30f); qsc = 127.f / mx;
            if (lane == 0) ((float*)(p.ws + WS_ASC))[r] = mx * (1.f / 127.f); }
#pragma unroll
        for (int j = 0; j < 4; ++j) {
            const f32x4 h = v[j] * rstd * gm0[j] + sh0[j];
            if constexpr (OUTQ == 2) { *(unsigned*)((unsigned char*)o0.out + (size_t)r * D + 4 * lane + 256 * j) = pack_i8x4(h.x * qsc, h.y * qsc, h.z * qsc, h.w * qsc); }
            else if constexpr (OUTQ == 1) { unsigned w8 = 0u; w8 = __builtin_amdgcn_cvt_pk_fp8_f32(h.x, h.y, w8, false); w8 = __builtin_amdgcn_cvt_pk_fp8_f32(h.z, h.w, w8, true);
                *(unsigned*)((unsigned char*)o0.out + (size_t)r * D + 4 * lane + 256 * j) = w8; }
            else { u32x2 w; w.x = cvt_pk_bf16(h.x, h.y); w.y = cvt_pk_bf16(h.z, h.w);
            *(u32x2*)(o0.out + (size_t)r * D + 4 * lane + 256 * j) = w; }
            if (NOUT > 1) { const f32x4 h1 = v[j] * rstd * gm1[j] + sh1[j]; u32x2 w1; w1.x = cvt_pk_bf16(h1.x, h1.y); w1.y = cvt_pk_bf16(h1.z, h1.w);
                *(u32x2*)(o1.out + (size_t)r * D + 4 * lane + 256 * j) = w1; }
            if (ROUTER) {
#pragma unroll
                for (int q = 0; q < 4; ++q) { const f32x4 a = rwa[4 * j + q], c2 = rwb[4 * j + q]; const float hv = h[q];
                    lg[0] += hv * a.x; lg[1] += hv * a.y; lg[2] += hv * a.z; lg[3] += hv * a.w; lg[4] += hv * c2.x; lg[5] += hv * c2.y; lg[6] += hv * c2.z; lg[7] += hv * c2.w; }
            }
        }
        if (ROUTER) {
            {
                const bool u5 = lane & 32, u4 = lane & 16, u3 = lane & 8; float a4[4], a2[2], a1;
#pragma unroll
                for (int i = 0; i < 4; ++i) a4[i] = (u5 ? lg[4 + i] : lg[i]) + __shfl_xor(u5 ? lg[i] : lg[4 + i], 32);
#pragma unroll
                for (int i = 0; i < 2; ++i) a2[i] = (u4 ? a4[2 + i] : a4[i]) + __shfl_xor(u4 ? a4[i] : a4[2 + i], 16);
                a1 = (u3 ? a2[1] : a2[0]) + __shfl_xor(u3 ? a2[0] : a2[1], 8);
                a1 += __shfl_xor(a1, 4); a1 += __shfl_xor(a1, 2); a1 += __shfl_xor(a1, 1);
#pragma unroll
                for (int e = 0; e < NE; ++e) lg[e] = readlane_f(a1, 8 * e) + p.router_b[e];
            }
            int e0 = 0; float v0 = lg[0];
#pragma unroll
            for (int e = 1; e < NE; ++e) if (lg[e] > v0) { v0 = lg[e]; e0 = e; }
            int e1 = -1; float v1 = -3.0e38f;
#pragma unroll
            for (int e = 0; e < NE; ++e) if (e != e0 && lg[e] > v1) { v1 = lg[e]; e1 = e; }
            const float ex = __expf(v1 - v0), w0 = 1.f / (1.f + ex), w1 = ex / (1.f + ex);
            if (lane == 0) { TOPE[2 * r] = e0; TOPE[2 * r + 1] = e1; TOPW[2 * r] = w0; TOPW[2 * r + 1] = w1; }
#pragma unroll
            for (int e = 0; e < NE; ++e) cnt_local[e] += (e == e0) + (e == e1);
        }
    }
    if (ROUTER) {
        LAS unsigned* lc = (LAS unsigned*)lds;
        if (tid < NE) lc[tid] = 0u;
        __syncthreads();
        if (lane == 0) {
#pragma unroll
            for (int e = 0; e < NE; ++e) if (cnt_local[e]) atomicAdd((unsigned*)(lc + e), cnt_local[e]);
        }
        __syncthreads();
        if (tid < NE && lc[tid]) atomicAdd(ctl + CW_CNT + 64 * tid, lc[tid]);
    }
}

struct NoCol {};
struct EpiPool {
    typedef f32x4 Col; static constexpr bool ROWLOAD = true;
    const float* x; float* x1; const float* g1; const float* scale; int coff;
    __device__ __forceinline__ f32x4 col(int row0, int c) const { return *(const f32x4*)(g1 + (row0 >> 13) * D + coff + c) * *(const f32x4*)(scale + coff + c); }
    __device__ __forceinline__ f32x4 rowload(int row, int c) const { return *(const f32x4*)(x + (size_t)row * D + coff + c); }
    __device__ __forceinline__ void apply(int row, int c, f32x4 v, f32x4 cg, f32x4 xv) const { *(f32x4*)(x1 + (size_t)row * D + coff + c) = xv + cg * v; }
};
struct EpiSwigluI8 {
    struct Col { f32x4 wg, wu; }; typedef float Row;
    bf16_t* hid; int ldh; const float* asc; const float* wmax;
    __device__ __forceinline__ Col col(int hc) const { Col c; c.wg = *(const f32x4*)(wmax + hc); c.wu = *(const f32x4*)(wmax + FF + hc); return c; }
    __device__ __forceinline__ float rowv(int row) const { return asc[row] * (1.f / 127.f); }
    __device__ __forceinline__ u32x2 four(f32x4 gt, f32x4 up, const Col& c, float ra) const {
        typedef int i32x4e __attribute__((ext_vector_type(4)));
        const i32x4e gi = __builtin_bit_cast(i32x4e, gt), ui = __builtin_bit_cast(i32x4e, up);
        const f32x4 wg = c.wg * ra, wu = c.wu * ra;
        const float g0 = (float)gi.x * wg.x, g1 = (float)gi.y * wg.y, g2 = (float)gi.z * wg.z, g3 = (float)gi.w * wg.w;
        u32x2 w; w.x = cvt_pk_bf16(silu_f(g0) * ((float)ui.x * wu.x), silu_f(g1) * ((float)ui.y * wu.y)); w.y = cvt_pk_bf16(silu_f(g2) * ((float)ui.z * wu.z), silu_f(g3) * ((float)ui.w * wu.w)); return w; }
    __device__ __forceinline__ void pair8(int row, int hc, f32x4 g0, f32x4 u0, f32x4 g1, f32x4 u1, const Col& c0, const Col& c1, float ra) const {
        const u32x2 a = four(g0, u0, c0, ra), b = four(g1, u1, c1, ra);
        *(u32x4*)(hid + (size_t)row * ldh + hc) = (u32x4){a.x, a.y, b.x, b.y}; }
};
struct EpiSwiglu8 {
    typedef NoCol Col; typedef NoCol Row;
    unsigned char* hid; int ldh;
    __device__ __forceinline__ NoCol col(int) const { return NoCol{}; }
    __device__ __forceinline__ NoCol rowv(int) const { return NoCol{}; }
    __device__ __forceinline__ unsigned four(f32x4 gt, f32x4 up) const {
        unsigned w = 0u; w = __builtin_amdgcn_cvt_pk_fp8_f32(silu_f(gt.x) * up.x, silu_f(gt.y) * up.y, w, false); w = __builtin_amdgcn_cvt_pk_fp8_f32(silu_f(gt.z) * up.z, silu_f(gt.w) * up.w, w, true); return w; }
    __device__ __forceinline__ void pair8(int row, int hc, f32x4 g0, f32x4 u0, f32x4 g1, f32x4 u1, const NoCol&, const NoCol&, NoCol) const {
        *(u32x2*)(hid + (size_t)row * ldh + hc) = (u32x2){four(g0, u0), four(g1, u1)}; }
};
struct EpiResid {
    typedef f32x4 Col; static constexpr bool ROWLOAD = true;
    const float* xin; float* out; const float* gate;
    __device__ __forceinline__ f32x4 col(int row0, int c) const { return *(const f32x4*)(gate + (row0 >> 13) * D + c); }
    __device__ __forceinline__ f32x4 rowload(int row, int c) const { return *(const f32x4*)(xin + (size_t)row * D + c); }
    __device__ __forceinline__ void apply(int row, int c, f32x4 v, f32x4 cg, f32x4 xv) const { *(f32x4*)(out + (size_t)row * D + c) = xv + cg * v; }
};
struct EpiBf16 {
    typedef NoCol Col; static constexpr bool ROWLOAD = false;
    bf16_t* o; int ldo;
    __device__ __forceinline__ NoCol col(int, int) const { return NoCol{}; }
    __device__ __forceinline__ void apply(int row, int c, f32x4 v, NoCol) const { u32x2 w; w.x = cvt_pk_bf16(v.x, v.y); w.y = cvt_pk_bf16(v.z, v.w); *(u32x2*)(o + (size_t)row * ldo + c) = w; }
};
struct EpiQ {
    typedef NoCol Col; static constexpr bool ROWLOAD = false;
    bf16_t* q; float* gates; int coff;
    __device__ __forceinline__ NoCol col(int, int) const { return NoCol{}; }
    __device__ __forceinline__ void apply(int row, int col_, f32x4 v, NoCol) const { const int col = col_ + coff;
        if (col < D) { u32x2 w; w.x = cvt_pk_bf16(v.x, v.y); w.y = cvt_pk_bf16(v.z, v.w); *(u32x2*)(q + (size_t)row * D + col) = w; }
        else if (col < NQ) { f32x4 s; s.x = sigmoid_f(v.x); s.y = sigmoid_f(v.y); s.z = sigmoid_f(v.z); s.w = sigmoid_f(v.w); *(f32x4*)(gates + (size_t)row * 48 + (col - D)) = s; } }
};
struct EpiCmp {
    typedef f32x4 Col; static constexpr bool ROWLOAD = false;
    bf16_t* o; const float* bias;
    __device__ __forceinline__ f32x4 col(int, int c_) const { const int z = c_ >> 8, c = c_ & 255; return *(const f32x4*)(bias + (z >> 2) * 256 + c); }
    __device__ __forceinline__ void apply(int row, int col, f32x4 v, f32x4 bv) const { const int z = col >> 8, c = col & 255;
        u32x2 w; w.x = cvt_pk_bf16(gelu_tanh_f(v.x + bv.x), gelu_tanh_f(v.y + bv.y)); w.y = cvt_pk_bf16(gelu_tanh_f(v.z + bv.z), gelu_tanh_f(v.w + bv.w));
        *(u32x2*)(o + ((size_t)z * 2048 + row) * 256 + c) = w; }
};

namespace pg8 {
#define PG8_LAS __attribute__((address_space(3)))
constexpr int BM = 256, BK = 64, HALF = 128, HTB = HALF * BK * 2, STAGE_BYTES = 8 * HTB, NXCD = 8, WGM = 8;
__host__ __device__ __forceinline__ int lds_byte(int r, int c) { const int st = (r >> 4) * 2 + (c >> 5), rr = r & 15, cc = c & 31, ob = rr * 64 + cc * 2; return st * 1024 + (ob ^ (((ob >> 9) & 1) << 5)); }
__host__ __device__ __forceinline__ void stage_rc(int b, int& R, int& C) { const int st = b / 1024, sb = b % 1024, swz = sb ^ (((sb >> 9) & 1) << 5); R = (st >> 1) * 16 + swz / 64; C = (st & 1) * 32 + (swz % 64) / 2; }
__host__ __device__ __forceinline__ int perm32(int rho) { const int n = rho >> 4, i = rho & 15; return 8 * (i >> 2) + 4 * n + (i & 3); }
struct Unit { int pm, pn; };
template <int SMODE> struct Sched {
    int nM, nN, nwg, G, c; const char* A; const char* Bt; size_t lda2, ldb2; const int* pst; size_t bstride2;
    __device__ __forceinline__ void init(int M, int N, int G_, int c_, const void* A_, const void* Bt_, int lda, int ldb, const int* pst_ = nullptr, size_t bstride = 0) {
        nM = M / BM; nN = N / BM; nwg = nM * nN; G = G_; c = c_; A = (const char*)A_; Bt = (const char*)Bt_; lda2 = (size_t)lda * 2; ldb2 = (size_t)ldb * 2; pst = pst_; bstride2 = bstride * 2; }
    __device__ __forceinline__ bool next(int i, Unit& u) const {
        if (c < 0) return false;
        const long L = (long)i * G + c; if (L >= nwg) return false;
        int wgid = (int)L; { const int q = nwg / NXCD, r = nwg % NXCD, xcd = wgid % NXCD, off = wgid / NXCD; wgid = (xcd < r ? xcd * (q + 1) : r * (q + 1) + (xcd - r) * q) + off; }
        const int nig = WGM * nN, gid = wgid / nig, fm = gid * WGM, gsz = (nM - fm) < WGM ? (nM - fm) : WGM;
        u.pm = fm + ((wgid % nig) % gsz); u.pn = (wgid % nig) / gsz; return true;
    }
    __device__ __forceinline__ const char* a_ptr(const Unit& u) const {
        if (SMODE == 1) return A + (size_t)u.pm * BM * lda2 + (size_t)u.pn * 512;
        if (SMODE == 2) return A + (size_t)u.pm * BM * lda2 + (size_t)((u.pn >> 2) * 256 + (u.pn & 3) * 64) * 2;
        return A + (size_t)u.pm * BM * lda2; }
    __device__ __forceinline__ const char* b_ptr(const Unit& u) const {
        if (SMODE == 2) return Bt + (size_t)(u.pn >> 2) * BM * ldb2;
        if (SMODE == 3) { const int m0 = u.pm * BM; int e = 0;
#pragma unroll
            for (int q = 1; q < NE; ++q) e += (m0 >= pst[q]); return Bt + (size_t)e * bstride2 + (size_t)u.pn * BM * ldb2; }
        return Bt + (size_t)u.pn * BM * ldb2; }
};
template <class F> struct EpiEl { static constexpr bool PERM = false, AFTER_DRAIN = false; F f;
    __device__ __forceinline__ void operator()(const f32x4 (&acc)[2][2][4][2], const Unit& u, int wr, int wc, int fr, int fq) const {
        const int row0 = u.pm * BM + wr * 64 + fr, col0 = u.pn * BM + wc * 32 + 4 * fq;
        typename F::Col cg[2][2];
#pragma unroll
        for (int bj = 0; bj < 2; ++bj)
#pragma unroll
            for (int n = 0; n < 2; ++n) cg[bj][n] = f.col(u.pm * BM, col0 + bj * HALF + n * 16);
        if constexpr (F::ROWLOAD) {
            f32x4 xv[2][2][4];
#pragma unroll
            for (int r = 0; r < 2; ++r)
#pragma unroll
                for (int c = 0; c < 4; ++c) xv[0][r][c] = f.rowload(row0 + r * 16, col0 + (c >> 1) * HALF + (c & 1) * 16);
#pragma unroll
            for (int b = 0; b < 4; ++b) {
                if (b + 1 < 4) {
#pragma unroll
                    for (int r = 0; r < 2; ++r)
#pragma unroll
                        for (int c = 0; c < 4; ++c) xv[(b + 1) & 1][r][c] = f.rowload(row0 + ((b + 1) >> 1) * HALF + (((b + 1) & 1) * 2 + r) * 16, col0 + (c >> 1) * HALF + (c & 1) * 16);
                }
#pragma unroll
                for (int r = 0; r < 2; ++r)
#pragma unroll
                    for (int c = 0; c < 4; ++c) { const int ai = b >> 1, m = (b & 1) * 2 + r;
                        f.apply(row0 + ai * HALF + m * 16, col0 + (c >> 1) * HALF + (c & 1) * 16, acc[ai][c >> 1][m][c & 1], cg[c >> 1][c & 1], xv[b & 1][r][c]); }
            }
        } else {
#pragma unroll
            for (int ai = 0; ai < 2; ++ai)
#pragma unroll
                for (int m = 0; m < 4; ++m)
#pragma unroll
                    for (int bj = 0; bj < 2; ++bj)
#pragma unroll
                        for (int n = 0; n < 2; ++n) f.apply(row0 + ai * HALF + m * 16, col0 + bj * HALF + n * 16, acc[ai][bj][m][n], cg[bj][n]);
        } } };
template <class F> struct EpiPairEl { static constexpr bool PERM = true, AFTER_DRAIN = false; F f;
    __device__ __forceinline__ void operator()(const f32x4 (&acc)[2][2][4][2], const Unit& u, int wr, int wc, int fr, int fq) const {
        const int row0 = u.pm * BM + wr * 64 + fr, hc0 = u.pn * HALF + wc * 32 + 8 * fq;
        typename F::Col cg[2]; typename F::Row rw[2][4];
#pragma unroll
        for (int n = 0; n < 2; ++n) cg[n] = f.col(hc0 + n * 4);
#pragma unroll
        for (int ai = 0; ai < 2; ++ai)
#pragma unroll
            for (int m = 0; m < 4; ++m) rw[ai][m] = f.rowv(row0 + ai * HALF + m * 16);
#pragma unroll
        for (int ai = 0; ai < 2; ++ai)
#pragma unroll
            for (int m = 0; m < 4; ++m) f.pair8(row0 + ai * HALF + m * 16, hc0, acc[ai][0][m][0], acc[ai][1][m][0], acc[ai][0][m][1], acc[ai][1][m][1], cg[0], cg[1], rw[ai][m]); } };

typedef int i32x8 __attribute__((ext_vector_type(8)));
template <int QM> __device__ __forceinline__ void mma_block(f32x4 (&acc)[4][2], const bf16x8 (&At)[4][2], const bf16x8 (&Bt)[2][2], const int wsc) {
    __builtin_amdgcn_s_setprio(1);
    if constexpr (QM == 2) {
        typedef int i32x4m __attribute__((ext_vector_type(4)));
#pragma unroll
        for (int m = 0; m < 4; ++m)
#pragma unroll
            for (int n = 0; n < 2; ++n)
#pragma unroll
                for (int k = 0; k < 2; ++k) acc[m][n] = __builtin_bit_cast(f32x4, __builtin_amdgcn_mfma_i32_16x16x64_i8(__builtin_bit_cast(i32x4m, Bt[n][k]), __builtin_bit_cast(i32x4m, At[m][k]), __builtin_bit_cast(i32x4m, acc[m][n]), 0, 0, 0));
#pragma unroll
        for (int m = 0; m < 4; ++m) asm volatile("" : "+v"(acc[m][0]), "+v"(acc[m][1]));
    } else if constexpr (QM == 1) {
#pragma unroll
        for (int m = 0; m < 4; ++m) { const u32x4 a0 = __builtin_bit_cast(u32x4, At[m][0]), a1 = __builtin_bit_cast(u32x4, At[m][1]);
            const i32x8 a8 = {(int)a0.x, (int)a0.y, (int)a0.z, (int)a0.w, (int)a1.x, (int)a1.y, (int)a1.z, (int)a1.w};
#pragma unroll
            for (int n = 0; n < 2; ++n) { const u32x4 b0 = __builtin_bit_cast(u32x4, Bt[n][0]), b1 = __builtin_bit_cast(u32x4, Bt[n][1]);
                const i32x8 b8 = {(int)b0.x, (int)b0.y, (int)b0.z, (int)b0.w, (int)b1.x, (int)b1.y, (int)b1.z, (int)b1.w};
                acc[m][n] = __builtin_amdgcn_mfma_scale_f32_16x16x128_f8f6f4(b8, a8, acc[m][n], 0, 0, 0, wsc, 0, 127); } }
#pragma unroll
        for (int m = 0; m < 4; ++m) asm volatile("" : "+v"(acc[m][0]), "+v"(acc[m][1]));
    } else {
#pragma unroll
        for (int m = 0; m < 4; ++m)
#pragma unroll
            for (int n = 0; n < 2; ++n)
#pragma unroll
                for (int k = 0; k < 2; ++k) acc[m][n] = __builtin_amdgcn_mfma_f32_16x16x32_bf16(Bt[n][k], At[m][k], acc[m][n], 0, 0, 0);
    }
    __builtin_amdgcn_s_setprio(0);
}
template <class Epi, class Sched, bool ALIGN_EPI = true, bool SP2 = true, int QM = 0>
__device__ __forceinline__ void gemm_phase(PG8_LAS unsigned char* lds, const int K, const int lda, const int ldb, const size_t kstepA, const Sched& S, const Epi& E, const int wsc = 127) {
    const int tid_ = opaque_tid();
    const int tid = tid_, wid = __builtin_amdgcn_readfirstlane(tid >> 6), lane = tid & 63, wr = wid >> 2, wc = wid & 3, fr = lane & 15, fq = lane >> 4;
    const int nt = K / BK;
    unsigned voffA[2], voffB[2];
#pragma unroll
    for (int i = 0; i < 2; ++i) { int R, C; stage_rc(tid * 16 + i * 8192, R, C); const int Rb = Epi::PERM ? ((R & ~31) + perm32(R & 31)) : R;
        voffA[i] = (unsigned)(R * lda + C) * 2u; voffB[i] = (unsigned)(Rb * ldb + C) * 2u; }
    const size_t kstepB = (size_t)(BK * 2);
    const size_t hstepA = (size_t)HALF * lda * 2, hstepB = (size_t)HALF * ldb * 2;
    const unsigned ldsw = (unsigned)wid * 1024u;
    int aoffk[2], boffk[2];
#pragma unroll
    for (int k = 0; k < 2; ++k) { const int col = (QM == 1) ? ((fq >> 1) * 32 + (fq & 1) * 16 + 8 * k) : (k * 32 + fq * 8); aoffk[k] = lds_byte(wr * 64 + fr, col); boffk[k] = lds_byte(wc * 32 + fr, col); }
#define PG8_SA(b, h) (((b) * 2 + (h)) * HTB)
#define PG8_SB(b, h) ((4 + (b) * 2 + (h)) * HTB)
#define PG8_STAGE(bufoff, gbase, voff) do { _Pragma("unroll") for (int _i = 0; _i < 2; ++_i) \
        __builtin_amdgcn_global_load_lds((const unsigned*)((const char*)(gbase) + (voff)[_i]), (PG8_LAS unsigned*)(lds + (bufoff) + ldsw + _i * 8192), 16, 0, 0); } while (0)
#define PG8_LDA(dst, b, h) do { _Pragma("unroll") for (int m = 0; m < 4; ++m) _Pragma("unroll") for (int k = 0; k < 2; ++k) dst[m][k] = *(const PG8_LAS bf16x8*)(lds + PG8_SA(b, h) + ((QM == 1) ? aoffk[k] : aoffk[0] + k * 1024) + m * 2048); } while (0)
#define PG8_LDB(dst, b, h) do { _Pragma("unroll") for (int n = 0; n < 2; ++n) _Pragma("unroll") for (int k = 0; k < 2; ++k) dst[n][k] = *(const PG8_LAS bf16x8*)(lds + PG8_SB(b, h) + ((QM == 1) ? boffk[k] : boffk[0] + k * 1024) + n * 2048); } while (0)
#define PG8_MMA(ai, bj, At, Bt) mma_block<QM>(acc[ai][bj], At, Bt, wsc)
#define PG8_WAIT_V(n) asm volatile("s_waitcnt vmcnt(" #n ")" ::: "memory")
#define PG8_WAIT_L(n) asm volatile("s_waitcnt lgkmcnt(" #n ")" ::: "memory")
#define PG8_BAR __builtin_amdgcn_s_barrier()
#define PG8_SCHED __builtin_amdgcn_sched_barrier(0)
    Unit cur, nxt; int ui = 0;
    if (!S.next(0, cur)) return;
    f32x4 acc[2][2][4][2];
#pragma unroll
    for (int a = 0; a < 2; ++a)
#pragma unroll
        for (int b = 0; b < 2; ++b)
#pragma unroll
            for (int m = 0; m < 4; ++m)
#pragma unroll
                for (int n = 0; n < 2; ++n) acc[a][b][m][n] = (f32x4){0.f, 0.f, 0.f, 0.f};
    bf16x8 At[4][2], B0[2][2], B1[2][2];
    const char* cA = S.a_ptr(cur); const char* cB = S.b_ptr(cur);
    if constexpr (SP2) {
        PG8_STAGE(PG8_SB(0, 0), cB, voffB); PG8_STAGE(PG8_SB(0, 1), cB + hstepB, voffB); PG8_STAGE(PG8_SA(0, 0), cA, voffA); PG8_STAGE(PG8_SA(0, 1), cA + hstepA, voffA);
        if (wr == 1) PG8_BAR;
        PG8_WAIT_V(2); PG8_BAR;
        PG8_STAGE(PG8_SB(1, 0), cB + kstepB, voffB); PG8_STAGE(PG8_SA(1, 0), cA + kstepA, voffA); PG8_STAGE(PG8_SB(1, 1), cB + hstepB + kstepB, voffB);
        PG8_WAIT_V(6); PG8_BAR;
    } else {
        PG8_STAGE(PG8_SB(0, 0), cB, voffB); PG8_STAGE(PG8_SA(0, 0), cA, voffA); PG8_STAGE(PG8_SB(0, 1), cB + hstepB, voffB); PG8_STAGE(PG8_SA(0, 1), cA + hstepA, voffA);
        if (wr == 1) PG8_BAR;
        PG8_WAIT_V(4); PG8_BAR;
        PG8_STAGE(PG8_SB(1, 0), cB + kstepB, voffB); PG8_STAGE(PG8_SA(1, 0), cA + kstepA, voffA); PG8_STAGE(PG8_SB(1, 1), cB + hstepB + kstepB, voffB);
        PG8_WAIT_V(6); PG8_BAR;
    }
    for (;;) {
        const bool has_next = S.next(ui + 1, nxt);
        const char* nA = has_next ? S.a_ptr(nxt) : cA; const char* nB = has_next ? S.b_ptr(nxt) : cB;
        for (int t = 0; t < nt; t += 2) {
            const bool last = (t == nt - 2);
            const char* a1 = cA + (size_t)(t + 1) * kstepA;
            const char* a2 = last ? nA : cA + (size_t)(t + 2) * kstepA; const char* b2 = last ? nB : cB + (size_t)(t + 2) * kstepB;
            const char* a3 = a2 + kstepA; const char* b3 = b2 + kstepB;
            if constexpr (SP2) {
            PG8_LDB(B0, 0, 0); PG8_LDB(B1, 0, 1); PG8_SCHED; PG8_LDA(At, 0, 0); PG8_STAGE(PG8_SA(1, 1), a1 + hstepA, voffA);
            PG8_WAIT_V(8); PG8_WAIT_L(0); PG8_BAR; PG8_MMA(0, 0, At, B0); PG8_MMA(0, 1, At, B1); PG8_BAR; PG8_SCHED;
            PG8_LDA(At, 0, 1); PG8_STAGE(PG8_SB(0, 0), b2, voffB); PG8_STAGE(PG8_SB(0, 1), b2 + hstepB, voffB); PG8_STAGE(PG8_SA(0, 0), a2, voffA);
            PG8_WAIT_V(8); PG8_WAIT_L(0); PG8_BAR; PG8_MMA(1, 0, At, B0); PG8_MMA(1, 1, At, B1); PG8_BAR; PG8_SCHED;
            PG8_LDB(B0, 1, 0); PG8_LDB(B1, 1, 1); PG8_SCHED; PG8_LDA(At, 1, 0); PG8_STAGE(PG8_SA(0, 1), a2 + hstepA, voffA);
            PG8_WAIT_V(8); PG8_WAIT_L(0); PG8_BAR; PG8_MMA(0, 0, At, B0); PG8_MMA(0, 1, At, B1); PG8_BAR; PG8_SCHED;
            PG8_LDA(At, 1, 1); PG8_STAGE(PG8_SB(1, 0), b3, voffB); PG8_STAGE(PG8_SB(1, 1), b3 + hstepB, voffB); PG8_STAGE(PG8_SA(1, 0), a3, voffA);
            PG8_WAIT_V(8); PG8_WAIT_L(0); PG8_BAR; PG8_MMA(1, 0, At, B0); PG8_MMA(1, 1, At, B1); PG8_BAR; PG8_SCHED;
            } else {
            PG8_LDB(B0, 0, 0); PG8_SCHED; PG8_LDA(At, 0, 0); PG8_STAGE(PG8_SA(1, 1), a1 + hstepA, voffA);
            PG8_WAIT_L(8); PG8_BAR; PG8_WAIT_L(0); PG8_MMA(0, 0, At, B0); PG8_BAR; PG8_SCHED;
            PG8_LDB(B1, 0, 1); PG8_STAGE(PG8_SB(0, 0), b2, voffB);
            PG8_BAR; PG8_WAIT_L(0); PG8_MMA(0, 1, At, B1); PG8_BAR;
            PG8_LDA(At, 0, 1); PG8_STAGE(PG8_SA(0, 0), a2, voffA);
            PG8_BAR; PG8_WAIT_L(0); PG8_MMA(1, 0, At, B0); PG8_BAR; PG8_SCHED;
            PG8_STAGE(PG8_SB(0, 1), b2 + hstepB, voffB);
            PG8_WAIT_V(6); PG8_BAR; PG8_MMA(1, 1, At, B1); PG8_BAR;
            PG8_LDB(B0, 1, 0); PG8_SCHED; PG8_LDA(At, 1, 0); PG8_STAGE(PG8_SA(0, 1), a2 + hstepA, voffA);
            PG8_WAIT_L(8); PG8_BAR; PG8_WAIT_L(0); PG8_MMA(0, 0, At, B0); PG8_BAR; PG8_SCHED;
            PG8_LDB(B1, 1, 1); PG8_STAGE(PG8_SB(1, 0), b3, voffB);
            PG8_BAR; PG8_WAIT_L(0); PG8_MMA(0, 1, At, B1); PG8_BAR;
            PG8_LDA(At, 1, 1); PG8_STAGE(PG8_SA(1, 0), a3, voffA);
            PG8_BAR; PG8_WAIT_L(0); PG8_MMA(1, 0, At, B0); PG8_BAR; PG8_SCHED;
            PG8_STAGE(PG8_SB(1, 1), b3 + hstepB, voffB);
            PG8_WAIT_V(6); PG8_BAR; PG8_MMA(1, 1, At, B1); PG8_BAR;
            }
        }
        if constexpr (ALIGN_EPI) { if (wr == 0) PG8_BAR; }
        if constexpr (!Epi::AFTER_DRAIN) { E(acc, cur, wr, wc, fr, fq); }
        if (!has_next) break;
#pragma unroll
        for (int a = 0; a < 2; ++a)
#pragma unroll
            for (int b = 0; b < 2; ++b)
#pragma unroll
                for (int m = 0; m < 4; ++m)
#pragma unroll
                    for (int n = 0; n < 2; ++n) acc[a][b][m][n] = (f32x4){0.f, 0.f, 0.f, 0.f};
        cur = nxt; cA = nA; cB = nB; ++ui;
        if constexpr (ALIGN_EPI) { if (wr == 1) PG8_BAR; }
    }
    PG8_WAIT_V(0);
    if constexpr (!ALIGN_EPI) { if (wr == 0) PG8_BAR; }
    PG8_BAR;
    if constexpr (Epi::AFTER_DRAIN) { E.fused(acc, cur, wr, wc, fr, fq, lds, wid, lane); }
#undef PG8_SA
#undef PG8_SB
#undef PG8_STAGE
#undef PG8_LDA
#undef PG8_LDB
#undef PG8_MMA
#undef PG8_WAIT_V
#undef PG8_WAIT_L
#undef PG8_BAR
#undef PG8_SCHED
}
}

__device__ __forceinline__ void phase_headnorm(const Params& p, LAS unsigned char* lds) {
    const int tid = opaque_tid(), lane = tid & 63, wave = tid >> 6;
    LAS int* chunk = (LAS int*)(lds + 131072 - 64);
    bf16_t* Q = (bf16_t*)(p.ws + WS_Q); bf16_t* KVB = (bf16_t*)(p.ws + WS_KVB);
    float qg[16], kg[8];
#pragma unroll
    for (int i = 0; i < 16; ++i) qg[i] = p.q_gain[(lane & 3) * 16 + i] * (0.125f * 1.4426950408889634f);
    const int kr = lane >> 5;
#pragma unroll
    for (int i = 0; i < 8; ++i) kg[i] = p.k_gain[(1 + kr) * 64 + (lane & 7) * 8 + i];
    for (;;) {
      if (tid == 0) *chunk = (int)atomicAdd((unsigned*)(p.ws + WS_CTL) + CW_HN, 1u);
      __syncthreads();
      const int c0 = *chunk;
      __syncthreads();
      if (c0 >= T / 128) break;
      for (int r = c0 * 128 + wave * 16; r < c0 * 128 + wave * 16 + 16; ++r) {
        {
            u32x4* ptr = (u32x4*)(Q + (size_t)r * D + lane * 16); u32x4 w0 = ptr[0], w1 = ptr[1];
            float v[16]; const unsigned ww[8] = {w0.x, w0.y, w0.z, w0.w, w1.x, w1.y, w1.z, w1.w}; float s = 0.f;
#pragma unroll
            for (int i = 0; i < 8; ++i) { v[2 * i] = bflo(ww[i]); v[2 * i + 1] = bfhi(ww[i]); s += v[2 * i] * v[2 * i] + v[2 * i + 1] * v[2 * i + 1]; }
            s += __shfl_xor(s, 1); s += __shfl_xor(s, 2);
            const float rstd = 1.f / sqrtf(s * (1.f / 64.f) + EPS);
            unsigned o[8];
#pragma unroll
            for (int i = 0; i < 8; ++i) o[i] = cvt_pk_bf16(v[2 * i] * rstd * qg[2 * i], v[2 * i + 1] * rstd * qg[2 * i + 1]);
            ptr[0] = (u32x4){o[0], o[1], o[2], o[3]}; ptr[1] = (u32x4){o[4], o[5], o[6], o[7]};
        }
        {
            const u32x4* ptr = (const u32x4*)(KVB + (size_t)r * NKV + (kr ? 1024 : 512) + (lane & 31) * 8); const u32x4 w0 = ptr[0];
            float v[8]; const unsigned ww[4] = {w0.x, w0.y, w0.z, w0.w}; float s = 0.f;
#pragma unroll
            for (int i = 0; i < 4; ++i) { v[2 * i] = bflo(ww[i]); v[2 * i + 1] = bfhi(ww[i]); s += v[2 * i] * v[2 * i] + v[2 * i + 1] * v[2 * i + 1]; }
            s += __shfl_xor(s, 1); s += __shfl_xor(s, 2); s += __shfl_xor(s, 4);
            const float rstd = 1.f / sqrtf(s * (1.f / 64.f) + EPS);
            unsigned o[4];
#pragma unroll
            for (int i = 0; i < 4; ++i) o[i] = cvt_pk_bf16(v[2 * i] * rstd * kg[2 * i], v[2 * i + 1] * rstd * kg[2 * i + 1]);
            const int b = r >> 13, t = r & (S - 1), hg = (lane & 31) >> 3, c = lane & 7;
            {
                bf16_t* dst = (bf16_t*)(p.ws + (kr ? WS_KWB : WS_KSB)) + ((size_t)((b * 4 + hg) * 128 + (t >> 6)) * 8 + c) * 512 + (t & 63) * 8;
                *(u32x4*)dst = (u32x4){o[0], o[1], o[2], o[3]};
            }
        }
      }
    }
}

__device__ __forceinline__ void phase_cmp2(const Params& p, LAS unsigned char* lds) {
    const int tid = opaque_tid(), lane = tid & 63, wave = tid >> 6;
    const int gw = blockIdx.x * NWAVE + wave, NGW = gridDim.x * NWAVE;
    const bf16_t* CMPH = (const bf16_t*)(p.ws + WS_CMPH);
    LAS float* w2l = (LAS float*)lds;
    for (int kv = 0; kv < 2; ++kv) {
        const float* w2 = kv ? p.cmp_v_w2 : p.cmp_k_w2;
        for (int i = tid; i < 256 * 64 / 4; i += NTHR) ((LAS f32x4*)w2l)[i] = ((const f32x4*)w2)[i];
        __syncthreads();
        for (int it = gw * 2; it < 4 * 2048; it += NGW * 2) {
            float hv[2][4], acc[2] = {0.f, 0.f};
#pragma unroll
            for (int rr = 0; rr < 2; ++rr) { const u32x2 w = *(const u32x2*)(CMPH + (size_t)(kv * 8192 + it + rr) * 256 + 4 * lane); hv[rr][0] = bflo(w.x); hv[rr][1] = bfhi(w.x); hv[rr][2] = bflo(w.y); hv[rr][3] = bfhi(w.y); }
#pragma unroll 4
            for (int kk = 0; kk < 64; ++kk)
#pragma unroll
                for (int c = 0; c < 4; ++c) { const float wv = w2l[(4 * kk + c) * 64 + lane];
                    acc[0] += readlane_f(hv[0][c], kk) * wv; acc[1] += readlane_f(hv[1][c], kk) * wv; }
#pragma unroll
            for (int rr = 0; rr < 2; ++rr) {
                const int row = it + rr, g = (row >> 11) & 3, r2 = row & 2047, b = r2 >> 9, n = r2 & 511; float a = n == NC - 1 ? 0.f : acc[rr];
                if (kv == 0) { const float ss = wave_sum(a * a); a = a * (1.f / sqrtf(ss * (1.f / 64.f) + EPS)) * p.k_gain[lane]; }
                const size_t blk0 = (size_t)((b * 4 + g) * 8 + (n >> 6)) * 4096;
                bf16_t* o = kv ? (bf16_t*)(p.ws + WS_VC) + blk0 + ((n & 63) >> 3) * 512 + lane * 8 + (n & 7)
                               : (bf16_t*)(p.ws + WS_KC) + blk0 + (lane >> 3) * 512 + (n & 63) * 8 + (lane & 7);
                *o = (bf16_t)(cvt_pk_bf16(a, 0.f) & 0xffffu);
            }
        }
        __syncthreads();
    }
}

__device__ __forceinline__ void phase_vtrans(const Params& p, LAS unsigned char* lds) {
    const int tid = opaque_tid(), lane = tid & 63, wave = tid >> 6;
    const int gw = blockIdx.x * NWAVE + wave, NGW = gridDim.x * NWAVE;
    LAS unsigned short* tile = (LAS unsigned short*)(lds + wave * 8448);
    const bf16_t* KVB = (const bf16_t*)(p.ws + WS_KVB);
    LAS int* chunk = (LAS int*)(lds + 131072 - 64);
    for (;;) {
        if (tid == 0) *chunk = (int)atomicAdd((unsigned*)(p.ws + WS_CTL) + CW_VT, 1u);
        __syncthreads();
        const int c0 = *chunk;
        __syncthreads();
        if (c0 >= 2 * 16 * 128 / NWAVE) break;
        const int u = c0 * NWAVE + wave;
        const int which = u >> 11, bg = (u >> 7) & 15, tt = u & 127, b = bg >> 2, g = bg & 3, t0 = tt * 64;
        const u32x4* src = (const u32x4*)(KVB + (size_t)(b * S + t0 + lane) * NKV + (which ? 1280 : 768) + g * 64);
#pragma unroll
        for (int i = 0; i < 8; ++i) { const u32x4 v = src[i]; LAS unsigned* tp = (LAS unsigned*)(tile + lane * 66 + 8 * i); tp[0] = v.x; tp[1] = v.y; tp[2] = v.z; tp[3] = v.w; }
        asm volatile("s_waitcnt lgkmcnt(0)" ::: "memory");
        {
            bf16_t* dst = (bf16_t*)(p.ws + (which ? WS_VWB : WS_VSB)) + (size_t)(bg * 128 + tt) * 4096 + lane * 8;
#pragma unroll
            for (int i = 0; i < 8; ++i) { unsigned w[4];
#pragma unroll
                for (int q = 0; q < 4; ++q) { const unsigned lo = tile[(8 * i + 2 * q) * 66 + lane], hi = tile[(8 * i + 2 * q + 1) * 66 + lane]; w[q] = lo | (hi << 16); }
                *(u32x4*)(dst + i * 512) = (u32x4){w[0], w[1], w[2], w[3]}; }
        }
        asm volatile("s_waitcnt lgkmcnt(0)" ::: "memory");
    }
}

typedef short s16x4 __attribute__((ext_vector_type(4)));
__device__ __forceinline__ f32x4 mfma4(s16x4 a, s16x4 b, f32x4 c) { return __builtin_amdgcn_mfma_f32_4x4x4bf16_1k(a, b, c, 0, 0, 0); }
__device__ __forceinline__ s16x4 mk4(unsigned lo, unsigned hi) { const u32x2 t = {lo, hi}; return __builtin_bit_cast(s16x4, t); }
__device__ __forceinline__ f32x4 qk64(const bf16_t* krow, const s16x4 (&qf)[16]) {
    const u32x4* kp = (const u32x4*)krow; u32x4 kr[8];
#pragma unroll
    for (int i = 0; i < 8; ++i) kr[i] = kp[i];
    f32x4 s = {0.f, 0.f, 0.f, 0.f};
#pragma unroll
    for (int c = 0; c < 8; ++c) { s = mfma4(mk4(kr[c].x, kr[c].y), qf[2 * c], s); s = mfma4(mk4(kr[c].z, kr[c].w), qf[2 * c + 1], s); }
    return s;
}
__device__ __forceinline__ void pv64(f32x4& o, const f32x4 e, const bf16_t* vtrow, LAS u32x2* stage, int lane) {
    const u32x4* vp = (const u32x4*)vtrow; u32x4 vr[8];
#pragma unroll
    for (int i = 0; i < 8; ++i) vr[i] = vp[i];
    u32x2 pk; pk.x = cvt_pk_bf16(e.x, e.y); pk.y = cvt_pk_bf16(e.z, e.w);
    stage[lane] = pk;
#pragma unroll
    for (int st = 0; st < 16; ++st) { const u32x2 a = stage[4 * st + (lane & 3)]; const u32x4 v = vr[st >> 1];
        o = mfma4(mk4(a.x, a.y), (st & 1) ? mk4(v.z, v.w) : mk4(v.x, v.y), o); }
}
__device__ __forceinline__ float quadx_sum(float v) { v += __shfl_xor(v, 4); v += __shfl_xor(v, 8); v += __shfl_xor(v, 16); v += __shfl_xor(v, 32); return v; }

constexpr int HBN = 800;
constexpr int ATT_HBD = 0, ATT_MH = 51200, ATT_PSLC = 53248, ATT_STAGE = 118784;
__device__ __forceinline__ void attn_tables(const Params& p, LAS unsigned char* lds) {
    const int tid = opaque_tid();
    LAS float* hbd = (LAS float*)(lds + ATT_HBD); LAS float* mh = (LAS float*)(lds + ATT_MH);
    for (int i = tid; i < 16 * HBN; i += NTHR) { const int hd = i / HBN, d = i - hd * HBN; const float v = p.rel_bias[rel_bucket(d) * NH + hd] * 1.4426950408889634f; hbd[i] = v; if (blockIdx.x == 0) ((float*)(p.ws + WS_HBG))[i] = v; }
    if (tid < 16) { float qg = 0.f, kg = 0.f, bm = -3.0e38f;
        for (int i = 0; i < 64; ++i) qg = fmaxf(qg, fabsf(p.q_gain[i]));
        for (int i = 0; i < 192; ++i) kg = fmaxf(kg, fabsf(p.k_gain[i]));
        for (int i = 0; i < 32; ++i) bm = fmaxf(bm, p.rel_bias[i * NH + tid]);
        const float mv = (qg * kg * 8.f * 1.02f + bm) * 1.4426950408889634f; mh[tid] = mv; if (blockIdx.x == 0) ((float*)(p.ws + WS_MHG))[tid] = mv; }
    __syncthreads();
}
typedef float f32x16 __attribute__((ext_vector_type(16)));
__device__ __forceinline__ f32x16 mfma32(bf16x8 a, bf16x8 b, f32x16 c) { return __builtin_amdgcn_mfma_f32_32x32x16_bf16(a, b, c, 0, 0, 0); }
struct DFrag { bf16x8 ka[4]; bf16x8 va[2][2]; };
__device__ __forceinline__ void dense_load_k(bf16x8 (&ka)[4], const bf16_t* KB, int kt, int l31, int h) {
    const int blk = kt >> 6, hh = (kt >> 5) & 1;
    const bf16_t* kb = KB + (size_t)blk * 4096 + (32 * hh + l31) * 8;
#pragma unroll
    for (int ks = 0; ks < 4; ++ks) ka[ks] = *(const bf16x8*)(kb + (2 * ks + h) * 512);
}
__device__ __forceinline__ void dense_load_v(bf16x8 (&va)[2][2], const bf16_t* VB, int kt, int l31, int h) {
    const int blk = kt >> 6, hh = (kt >> 5) & 1;
    const bf16_t* vb = VB + (size_t)blk * 4096 + l31 * 8 + 4 * h;
#pragma unroll
    for (int dt = 0; dt < 2; ++dt)
#pragma unroll
        for (int st = 0; st < 2; ++st) { const bf16_t* q0 = vb + (4 * hh + 2 * st) * 512 + dt * 256; const u32x2 lo = *(const u32x2*)q0, hi = *(const u32x2*)(q0 + 512);
            const u32x4 w = {lo.x, lo.y, hi.x, hi.y}; va[dt][st] = __builtin_bit_cast(bf16x8, w); }
}
__device__ __forceinline__ f32x16 dense_scores(const DFrag& f, const bf16x8 (&q)[4]) {
    f32x16 sacc;
#pragma unroll
    for (int i = 0; i < 16; ++i) sacc[i] = 0.f;
#pragma unroll
    for (int ks = 0; ks < 4; ++ks) sacc = mfma32(f.ka[ks], q[ks], sacc);
    return sacc;
}
__device__ __forceinline__ void dense_pv(f32x16 (&O)[2], const DFrag& f, const float (&ev)[16]) {
    bf16x8 pb[2];
#pragma unroll
    for (int st = 0; st < 2; ++st) { const u32x4 w = {cvt_pk_bf16(ev[8 * st], ev[8 * st + 1]), cvt_pk_bf16(ev[8 * st + 2], ev[8 * st + 3]), cvt_pk_bf16(ev[8 * st + 4], ev[8 * st + 5]), cvt_pk_bf16(ev[8 * st + 6], ev[8 * st + 7])};
        pb[st] = __builtin_bit_cast(bf16x8, w); }
#pragma unroll
    for (int dt = 0; dt < 2; ++dt)
#pragma unroll
        for (int st = 0; st < 2; ++st) O[dt] = mfma32(f.va[dt][st], pb[st], O[dt]);
}
__device__ __forceinline__ void phase_dense(const Params& p, LAS unsigned char* lds, bf16_t* OW) {
    const int tid = opaque_tid(), lane0 = tid & 63, wave = tid >> 6;
    const LAS float* hbd = (const LAS float*)(lds + ATT_HBD); const LAS float* mh = (const LAS float*)(lds + ATT_MH);
    LAS float* pslc = (LAS float*)(lds + ATT_PSLC) + wave * 2048;
    const bf16_t* Q = (const bf16_t*)(p.ws + WS_Q); const float* GATE = (const float*)(p.ws + WS_GATE);
    short* SEL = (short*)(p.ws + WS_SEL);
    const int Gn = gridDim.x, vcu = (Gn % 8 == 0) ? (blockIdx.x % 8) * (Gn / 8) + blockIdx.x / 8 : blockIdx.x;
    for (int u = vcu * NWAVE + wave; u < T * G / 16; u += Gn * NWAVE) {
        int lane = lane0; asm volatile("" : "+v"(lane));
        const int l31 = lane & 31, h = lane >> 5;
        const int bg = u >> 9, t0 = (((u & 511) + 128 * (u >> 11)) & 511) * 16, b = bg >> 2, g = bg & 3, head = 4 * g + (lane & 3);
        const LAS float* hb = hbd + head * HBN; const float mhv = mh[head];
        int tok[2]; bf16x8 qf[2][4];
#pragma unroll
        for (int r = 0; r < 2; ++r) { tok[r] = t0 + 8 * r + (l31 >> 2); const bf16_t* qp = Q + (size_t)(b * S + tok[r]) * D + head * 64 + 8 * h;
#pragma unroll
            for (int ks = 0; ks < 4; ++ks) qf[r][ks] = *(const bf16x8*)(qp + 16 * ks); }
        f32x16 O[2][2];
#pragma unroll
        for (int r = 0; r < 2; ++r)
#pragma unroll
            for (int dt = 0; dt < 2; ++dt)
#pragma unroll
                for (int q = 0; q < 16; ++q) O[r][dt][q] = 0.f;
        DFrag cur; bf16x8 nxtk[4];
        {
            const bf16_t* KB = (const bf16_t*)(p.ws + WS_KWB) + (size_t)bg * 128 * 4096; const bf16_t* VB = (const bf16_t*)(p.ws + WS_VWB) + (size_t)bg * 128 * 4096;
            float lw[2] = {0.f, 0.f};
            const int lo = t0 - (WIN - 1) > 0 ? t0 - (WIN - 1) : 0, kt_last = t0 & ~31;
            dense_load_k(cur.ka, KB, lo & ~31, l31, h);
            for (int kt = lo & ~31; kt <= kt_last; kt += 32) {
                dense_load_v(cur.va, VB, kt, l31, h);
                dense_load_k(nxtk, KB, kt + 32 <= kt_last ? kt + 32 : kt_last, l31, h);
                __builtin_amdgcn_sched_barrier(0);
#pragma unroll
                for (int r = 0; r < 2; ++r) {
                    const f32x16 sacc = dense_scores(cur, qf[r]);
                    const int dbase = tok[r] - kt - 4 * h; float ev[16];
                    if (kt + 31 <= t0 + 8 * r && kt >= t0 + 8 * r + 7 - (WIN - 1)) {
                        const LAS float* hbp = hb + dbase;
#pragma unroll
                        for (int q = 0; q < 16; ++q) { const float e = __builtin_amdgcn_exp2f(sacc[q] + hbp[-((q & 3) + 8 * (q >> 2))] - mhv); ev[q] = e; lw[r] += e; }
                    } else {
#pragma unroll
                    for (int q = 0; q < 16; ++q) { const int dist = dbase - ((q & 3) + 8 * (q >> 2)); const bool ok = (unsigned)dist < (unsigned)WIN;
                        const float e0 = __builtin_amdgcn_exp2f(sacc[q] + hb[ok ? dist : 0] - mhv); const float e = ok ? e0 : 0.f; ev[q] = e; lw[r] += e; }
                    }
                    dense_pv(O[r], cur, ev);
                }
#pragma unroll
                for (int ks = 0; ks < 4; ++ks) cur.ka[ks] = nxtk[ks];
            }
#pragma unroll
            for (int r = 0; r < 2; ++r) { const float l = lw[r] + __shfl_xor(lw[r], 32); int tk = tok[r]; asm volatile("" : "+v"(tk)); const float* gp = GATE + (size_t)(b * S + tk) * 48 + head * 3;
                const float sc = gp[2] / (l * gp[0]);
#pragma unroll
                for (int dt = 0; dt < 2; ++dt) O[r][dt] = O[r][dt] * sc; }
        }
        const int ncmax = t0 >> 4;
        {
            int l31c = l31, hc = h; asm volatile("" : "+v"(l31c), "+v"(hc));
            const bf16_t* KB = (const bf16_t*)(p.ws + WS_KC) + (size_t)bg * 8 * 4096; const bf16_t* VB = (const bf16_t*)(p.ws + WS_VC) + (size_t)bg * 8 * 4096;
            float lc[2] = {0.f, 0.f};
            const int kt_last = ncmax > 0 ? ((ncmax - 1) & ~31) : -32;
            if (ncmax > 0) {
                dense_load_k(cur.ka, KB, 0, l31c, hc);
                for (int kt = 0; kt <= kt_last; kt += 32) {
                    dense_load_k(nxtk, KB, kt + 32 <= kt_last ? kt + 32 : kt_last, l31c, hc);
                    __builtin_amdgcn_sched_barrier(0);
#pragma unroll
                    for (int r = 0; r < 2; ++r) {
                        const f32x16 sacc = dense_scores(cur, qf[r]);
                        if (t0 - 31 - 16 * (kt + 31) >= HBN - 1) {
                            const float bfar = hb[HBN - 1] - mhv;
#pragma unroll
                            for (int q = 0; q < 16; ++q) lc[r] += __builtin_amdgcn_exp2f(sacc[q] + bfar);
                        } else {
                        const int dbase = tok[r] - 31 - 16 * (kt + 4 * hc);
#pragma unroll
                        for (int q = 0; q < 16; ++q) { const int dist = dbase - 16 * ((q & 3) + 8 * (q >> 2)); const int di = dist < 0 ? 0 : (dist > HBN - 1 ? HBN - 1 : dist);
                            const float e0 = __builtin_amdgcn_exp2f(sacc[q] + hb[di] - mhv); lc[r] += dist >= 0 ? e0 : 0.f; }
                        }
                    }
#pragma unroll
                    for (int ks = 0; ks < 4; ++ks) cur.ka[ks] = nxtk[ks];
                }
            }
            float linv[2];
#pragma unroll
            for (int r = 0; r < 2; ++r) { const float l = lc[r] + __shfl_xor(lc[r], 32); linv[r] = l > 0.f ? 1.f / l : 0.f; }
            { const f32x4 z = {0.f, 0.f, 0.f, 0.f};
#pragma unroll
              for (int i = 0; i < 8; ++i) *(LAS f32x4*)(pslc + (i * 64 + lane) * 4) = z; }
            if (ncmax > 0) {
                float carry[2] = {0.f, 0.f};
                dense_load_k(cur.ka, KB, 0, l31c, hc);
                for (int kt = 0; kt <= kt_last; kt += 32) {
                    dense_load_v(cur.va, VB, kt, l31c, hc);
                    dense_load_k(nxtk, KB, kt + 32 <= kt_last ? kt + 32 : kt_last, l31c, hc);
                    __builtin_amdgcn_sched_barrier(0);
#pragma unroll
                    for (int r = 0; r < 2; ++r) {
                        const f32x16 sacc = dense_scores(cur, qf[r]);
                        float pv[16];
                        const int dbase = tok[r] - 31 - 16 * (kt + 4 * hc);
#pragma unroll
                        for (int q = 0; q < 16; ++q) { const int dist = dbase - 16 * ((q & 3) + 8 * (q >> 2)); const int di = dist < 0 ? 0 : (dist > HBN - 1 ? HBN - 1 : dist);
                            const float e0 = __builtin_amdgcn_exp2f(sacc[q] + hb[di] - mhv); pv[q] = dist >= 0 ? e0 * linv[r] : 0.f; }
                        dense_pv(O[r], cur, pv);
#pragma unroll
                        for (int q = 0; q < 16; ++q) { pv[q] += __shfl_xor(pv[q], 1); pv[q] += __shfl_xor(pv[q], 2); }
                        float y[4];
#pragma unroll
                        for (int gq = 0; gq < 4; ++gq) y[gq] = __shfl_xor(pv[4 * gq + 3], 32);
#pragma unroll
                        for (int gq = 0; gq < 4; ++gq) { const float prevv = h ? y[gq] : (gq > 0 ? y[gq > 0 ? gq - 1 : 0] : carry[r]);
                            const float val = 2.f * ((pv[4 * gq] + pv[4 * gq + 1]) + pv[4 * gq + 2]) + pv[4 * gq + 3] + prevv;
                            if ((lane & 3) == 0) pslc[(8 * r + (l31c >> 2)) * 128 + (kt >> 2) + 2 * gq + hc] = val; }
                        carry[r] = y[3];
                    }
#pragma unroll
                    for (int ks = 0; ks < 4; ++ks) cur.ka[ks] = nxtk[ks];
                }
            }
        }
#pragma unroll
        for (int r = 0; r < 2; ++r) { int tk = tok[r]; asm volatile("" : "+v"(tk)); bf16_t* op = OW + (size_t)(b * S + tk) * D + head * 64 + 4 * h; const float gc = GATE[(size_t)(b * S + tk) * 48 + head * 3];
#pragma unroll
            for (int dt = 0; dt < 2; ++dt)
#pragma unroll
                for (int gq = 0; gq < 4; ++gq) { u32x2 w; w.x = cvt_pk_bf16(O[r][dt][4 * gq] * gc, O[r][dt][4 * gq + 1] * gc); w.y = cvt_pk_bf16(O[r][dt][4 * gq + 2] * gc, O[r][dt][4 * gq + 3] * gc);
                    *(u32x2*)(op + dt * 32 + 8 * gq) = w; } }
#pragma unroll 1
        for (int tl = 0; tl < 16; ++tl) {
            int ln = lane; asm volatile("" : "+v"(ln));
            const int t = t0 + tl, cur_b = t >> 6, j0 = ln, j1 = ln + 64;
            const float c0 = pslc[tl * 128 + j0], c1 = pslc[tl * 128 + j1];
            const bool f0 = (j0 == 0) || (j0 == cur_b) || (j0 == cur_b - 1), f1 = (j1 == cur_b) || (j1 == cur_b - 1);
            const bool v0 = j0 * 64 <= t, v1 = j1 * 64 <= t;
            const unsigned u0 = (v0 && !f0) ? __float_as_uint(c0) : 0u, u1 = (v1 && !f1) ? __float_as_uint(c1) : 0u;
            unsigned th = 1u;
            if (cur_b + 1 > NSEL) {
                th = 0u;
#pragma unroll 1
                for (int bit = 30; bit >= 0; --bit) {
                    const unsigned trial = th | (1u << bit);
                    const int cnt = __popcll(__ballot(u0 >= trial)) + __popcll(__ballot(u1 >= trial));
                    if (cnt >= NSEL - 3) { th = trial; if (cnt == NSEL - 3) break; }
                }
            }
            const bool s0 = f0 || (u0 >= th && u0 != 0u), s1 = f1 || (u1 >= th && u1 != 0u);
            const unsigned long long m0 = __ballot(s0), m1 = __ballot(s1), lt = (1ull << ln) - 1ull;
            const int p0 = __popcll(m0 & lt), p1 = __popcll(m0) + __popcll(m1 & lt);
            short* so = SEL + ((size_t)(b * S + t) * 4 + g) * NSEL;
            if (s0 && p0 < NSEL) so[p0] = (short)j0;
            if (s1 && p1 < NSEL) so[p1] = (short)j1;
        }
    }
}

constexpr int ST_ACC = 0, ST_LACC = 133120, ST_MASK = 135168, ST_LIST = 136192, ST_CTR = 138240, ST_HB4 = 138304;
__device__ __forceinline__ void lds_add_f64(unsigned addr, double v) { asm volatile("ds_add_f64 %0, %1" :: "v"(addr), "v"(v) : "memory"); }
__device__ __forceinline__ void phase_sel_tile(const Params& p, LAS unsigned char* lds, bf16_t* AO, const bf16_t* OW) {
    const int tid = opaque_tid(), lane = tid & 63, wave = tid >> 6, l31 = lane & 31, h = lane >> 5;
    LAS double* acc = (LAS double*)(lds + ST_ACC); LAS double* lacc = (LAS double*)(lds + ST_LACC);
    LAS unsigned* mask = (LAS unsigned*)(lds + ST_MASK); LAS int* list = (LAS int*)(lds + ST_LIST) + wave * 64; LAS int* ctr = (LAS int*)(lds + ST_CTR);
    const bf16_t* Q = (const bf16_t*)(p.ws + WS_Q); const float* GATE = (const float*)(p.ws + WS_GATE); const short* SEL = (const short*)(p.ws + WS_SEL);
    const int Gn = gridDim.x;
    for (int kk = 0, u = blockIdx.x; u < 16 * 128; u += Gn, ++kk) {
        const int bg = u >> 7, ti = u & 127, tt = (kk & 1) ? 127 - ti : ti, b = bg >> 2, g = bg & 3, t0 = tt * 64, cur = tt, nv = cur + 1 < NSEL ? cur + 1 : NSEL;
        for (int i = tid; i < ST_LIST / 16; i += NTHR) ((LAS u32x4*)lds)[i] = (u32x4){0u, 0u, 0u, 0u};
        if (tid == 0) *ctr = 0;
        { LAS float* hb4 = (LAS float*)(lds + ST_HB4); const float* hsrc = (const float*)(p.ws + WS_HBG) + 4 * g * HBN; for (int i = tid; i < 4 * HBN; i += NTHR) hb4[i] = hsrc[i]; }
        __syncthreads();
        { const int tl = tid >> 3; const short* sp = SEL + ((size_t)(b * S + t0 + tl) * 4 + g) * NSEL;
#pragma unroll
          for (int e = (tid & 7) * 2; e < (tid & 7) * 2 + 2; ++e) if (e < nv) { const int blk = sp[e]; __hip_atomic_fetch_or(mask + blk * 2 + (tl >> 5), 1u << (tl & 31), __ATOMIC_RELAXED, __HIP_MEMORY_SCOPE_WORKGROUP); } }
        __syncthreads();
        const int nf = cur >= 2 ? 3 : cur + 1, nitems = 2 * nf + (cur >= 3 ? cur - 2 : 0);
        const bf16_t* KB = (const bf16_t*)(p.ws + WS_KSB) + (size_t)bg * 128 * 4096; const bf16_t* VB = (const bf16_t*)(p.ws + WS_VSB) + (size_t)bg * 128 * 4096;
        const int hl = lane & 3, head = 4 * g + hl;
        const LAS float* hbg = (const LAS float*)(lds + ST_HB4) + hl * HBN; const float mhv = ((const float*)(p.ws + WS_MHG))[head], bfar = hbg[HBN - 1] - mhv;
        for (;;) {
            int it = 0; if (lane == 0) it = __hip_atomic_fetch_add(ctr, 1, __ATOMIC_RELAXED, __HIP_MEMORY_SCOPE_WORKGROUP);
            it = __builtin_amdgcn_readfirstlane(it);
            if (it >= nitems) break;
            int j, c_lo, c_hi;
            if (it < 2 * nf) { const int f = it >> 1; j = f == 0 ? cur : (f == 1 ? cur - 1 : 0); c_lo = (it & 1) * 4; c_hi = c_lo + 4; }
            else { j = it - 2 * nf + 1; c_lo = 0; c_hi = 8; }
            const unsigned mlo = (unsigned)__builtin_amdgcn_readfirstlane((int)mask[2 * j]), mhi = (unsigned)__builtin_amdgcn_readfirstlane((int)mask[2 * j + 1]);
            const unsigned long long m = ((unsigned long long)mhi << 32) | mlo; const int n = __popcll(m), nch = (n + 7) >> 3;
            if (c_hi > nch) c_hi = nch;
            if (c_lo >= c_hi) continue;
            if ((m >> lane) & 1ull) list[__popcll(m & ((1ull << lane) - 1ull))] = lane;
            DFrag fr0, fr1;
            dense_load_k(fr0.ka, KB, j * 64, l31, h); dense_load_v(fr0.va, VB, j * 64, l31, h);
            dense_load_k(fr1.ka, KB, j * 64 + 32, l31, h); dense_load_v(fr1.va, VB, j * 64 + 32, l31, h);
            bf16x8 qn[4];
            { const int slot = c_lo * 8 + (l31 >> 2); const int tokl = list[slot < n ? slot : n - 1]; const bf16_t* qp = Q + (size_t)(b * S + t0 + tokl) * D + head * 64 + 8 * h;
#pragma unroll
              for (int ks = 0; ks < 4; ++ks) qn[ks] = *(const bf16x8*)(qp + 16 * ks); }
            for (int c = c_lo; c < c_hi; ++c) {
                const int slot = c * 8 + (l31 >> 2); const bool valid = slot < n; const int tokl = list[valid ? slot : n - 1], tok = t0 + tokl;
                bf16x8 qf[4];
#pragma unroll
                for (int ks = 0; ks < 4; ++ks) qf[ks] = qn[ks];
                { const int sn = (c + 1 < c_hi ? c + 1 : c) * 8 + (l31 >> 2); const int tn = list[sn < n ? sn : n - 1]; const bf16_t* qp = Q + (size_t)(b * S + t0 + tn) * D + head * 64 + 8 * h;
#pragma unroll
                  for (int ks = 0; ks < 4; ++ks) qn[ks] = *(const bf16x8*)(qp + 16 * ks); }
                __builtin_amdgcn_sched_barrier(0);
                f32x16 O[2]; float ls = 0.f;
#pragma unroll
                for (int dt = 0; dt < 2; ++dt)
#pragma unroll
                    for (int q = 0; q < 16; ++q) O[dt][q] = 0.f;
#pragma unroll
                for (int half = 0; half < 2; ++half) {
                    const int kt = j * 64 + 32 * half; const DFrag& fr = half ? fr1 : fr0;
                    const f32x16 sacc = dense_scores(fr, qf); float ev[16];
                    if (t0 - kt - 31 >= HBN - 1) {
#pragma unroll
                        for (int q = 0; q < 16; ++q) { ev[q] = __builtin_amdgcn_exp2f(sacc[q] + bfar); ls += ev[q]; }
                    } else { const int dbase = tok - kt - 4 * h;
#pragma unroll
                        for (int q = 0; q < 16; ++q) { const int dist = dbase - ((q & 3) + 8 * (q >> 2)); const int di = dist < 0 ? 0 : (dist > HBN - 1 ? HBN - 1 : dist);
                            const float e0 = __builtin_amdgcn_exp2f(sacc[q] + hbg[di] - mhv); ev[q] = dist >= 0 ? e0 : 0.f; ls += ev[q]; } }
                    dense_pv(O, fr, ev);
                }
                const float lt = ls + __shfl_xor(ls, 32);
                if (valid) {
                    const unsigned a0 = (unsigned)(size_t)(acc + (tokl * 4 + hl) * 65 + 4 * h);
#pragma unroll
                    for (int dt = 0; dt < 2; ++dt)
#pragma unroll
                        for (int q = 0; q < 16; ++q) lds_add_f64(a0 + (dt * 32 + (q & 3) + 8 * (q >> 2)) * 8, (double)O[dt][q]);
                    if (h == 0) lds_add_f64((unsigned)(size_t)(lacc + tokl * 4 + hl), (double)lt);
                }
            }
        }
        __syncthreads();
        for (int r0 = wave * 32; r0 < wave * 32 + 32; r0 += 8) {
            float gv[8], ov[8];
#pragma unroll
            for (int i = 0; i < 8; ++i) { const int r = r0 + i, tokl = r >> 2, hd = r & 3; const size_t ur = (size_t)(b * S + t0 + tokl);
                gv[i] = GATE[ur * 48 + (4 * g + hd) * 3 + 1]; ov[i] = bf2f(OW[ur * D + (4 * g + hd) * 64 + lane]); }
#pragma unroll
            for (int i = 0; i < 8; ++i) { const int r = r0 + i, tokl = r >> 2, hd = r & 3; const size_t ur = (size_t)(b * S + t0 + tokl);
                const float o = (float)acc[r * 65 + lane] * (1.f / (float)lacc[r]) * gv[i] + ov[i];
                AO[ur * D + (4 * g + hd) * 64 + lane] = (bf16_t)(cvt_pk_bf16(o, 0.f) & 0xffffu); }
        }
        __syncthreads();
    }
}

__device__ __forceinline__ void moe_pstarts(const unsigned* ctl, int (&pst)[NE + 1]) {
    int a = 0;
#pragma unroll
    for (int e = 0; e < NE; ++e) { pst[e] = a; const int c = (int)ctl[CW_CNT + 64 * e]; a += (c + 511) / 512 * 512; }
    pst[NE] = a;
}
__device__ __forceinline__ void phase_moe_sort(const Params& p, LAS unsigned char* lds) {
    const int tid = opaque_tid(), lane = tid & 63, wave = tid >> 6;
    unsigned* ctl = (unsigned*)(p.ws + WS_CTL);
    const int* TOPE = (const int*)(p.ws + WS_TOPE); int* RPOS = (int*)(p.ws + WS_RPOS);
    const bf16_t* HB = (const bf16_t*)(p.ws + WS_HB); bf16_t* XS = (bf16_t*)(p.ws + WS_XS);
    LAS int* wcnt = (LAS int*)lds;
    LAS int* base = (LAS int*)(lds + 128);
    LAS int* posl = (LAS int*)(lds + 256);
    int pst[NE + 1]; moe_pstarts(ctl, pst);
    if (blockIdx.x == 0 && tid <= NE) ((int*)(ctl + 256))[tid] = pst[tid];
    for (int c0 = blockIdx.x * 256; c0 < 2 * T; c0 += gridDim.x * 256) {
        int e = 0, rank = 0;
        if (wave < 4) { e = TOPE[c0 + wave * 64 + lane];
#pragma unroll
            for (int q = 0; q < NE; ++q) { const unsigned long long m = __ballot(e == q); if (e == q) rank = __popcll(m & ((1ull << lane) - 1ull)); if (lane == 0) wcnt[wave * NE + q] = __popcll(m); } }
        __syncthreads();
        if (tid < NE) { const int n = wcnt[tid] + wcnt[NE + tid] + wcnt[2 * NE + tid] + wcnt[3 * NE + tid]; base[tid] = n ? (int)atomicAdd(ctl + CW_CUR + 64 * tid, (unsigned)n) : 0; }
        __syncthreads();
        if (wave < 4) { int off = 0;
            for (int w = 0; w < wave; ++w) off += wcnt[w * NE + e];
            const int pos = pst[e] + base[e] + off + rank; posl[wave * 64 + lane] = pos; RPOS[c0 + wave * 64 + lane] = pos; }
        __syncthreads();
        for (int j = wave * 32; j < wave * 32 + 32; j += 8) {
            u32x4 v0[8]; int ps[8];
#pragma unroll
            for (int q = 0; q < 8; ++q) { const int tk = (c0 + j + q) >> 1; ps[q] = posl[j + q]; v0[q] = *((const u32x4*)((const unsigned char*)HB + (size_t)tk * D) + lane); }
#pragma unroll
            for (int q = 0; q < 8; ++q) *((u32x4*)((unsigned char*)XS + (size_t)ps[q] * D) + lane) = v0[q];
        }
        __syncthreads();
    }
}
__device__ __forceinline__ void phase_combine(const Params& p) {
    const int tid = opaque_tid(), lane = tid & 63, wave = tid >> 6;
    const int gw = blockIdx.x * NWAVE + wave, NGW = gridDim.x * NWAVE;
    const float* TOPW = (const float*)(p.ws + WS_TOPW); const int* RPOS = (const int*)(p.ws + WS_RPOS);
    const bf16_t* Y = (const bf16_t*)(p.ws + WS_Y); const float* g2 = (const float*)(p.ws + WS_MODV) + (11 * 4) * D;
    for (int r = gw; r < T; r += NGW) {
        const int b = r >> 13; const int p0 = RPOS[2 * r], p1 = RPOS[2 * r + 1]; const float w0 = TOPW[2 * r], w1 = TOPW[2 * r + 1];
#pragma unroll
        for (int j = 0; j < 4; ++j) { const int c = 4 * lane + 256 * j;
            const u32x2 y0 = *(const u32x2*)(Y + (size_t)p0 * D + c), y1 = *(const u32x2*)(Y + (size_t)p1 * D + c);
            const f32x4 gv = *(const f32x4*)(g2 + b * D + c); f32x4 xv = *(const f32x4*)(p.out + (size_t)r * D + c);
            f32x4 f; f.x = w0 * bflo(y0.x) + w1 * bflo(y1.x); f.y = w0 * bfhi(y0.x) + w1 * bfhi(y1.x); f.z = w0 * bflo(y0.y) + w1 * bflo(y1.y); f.w = w0 * bfhi(y0.y) + w1 * bfhi(y1.y);
            *(f32x4*)(p.out + (size_t)r * D + c) = xv + gv * f; }
    }
}

#define XB_TMO      128
#define XB_XCNT(j)  (256  + 64 * (j))
#define XB_XSUB(j)  (1280 + 64 * (j))
#define XB_XGEN(j)  (2304 + 64 * (j))
#define XB_TOP      3328
#define XB_TOPGEN   3392
#define XCD_BAR_WORDS 3456
#define XB_SPIN_CAP (1u << 18)
__device__ __forceinline__ unsigned xb_ld(unsigned* p)              { return __hip_atomic_load(p, __ATOMIC_RELAXED, __HIP_MEMORY_SCOPE_AGENT); }
__device__ __forceinline__ unsigned xb_add(unsigned* p, unsigned v) { return __hip_atomic_fetch_add(p, v, __ATOMIC_RELAXED, __HIP_MEMORY_SCOPE_AGENT); }
__device__ __forceinline__ unsigned xb_xcc_id() { return (unsigned)__builtin_amdgcn_s_getreg((3 << 11) | 20) & 0xFu; }
#define XB_SPIN(cond, bar) do { unsigned _sp = 0; while (cond) { __builtin_amdgcn_s_sleep(1); \
    if ((++_sp & 255u) == 0u) { if (xb_ld(&(bar)[XB_TMO])) break; if (_sp > XB_SPIN_CAP) { atomicAdd(&(bar)[XB_TMO], 1u); break; } } } } while (0)
struct XcdBarrier { unsigned* bar; unsigned x; volatile LAS unsigned* st; };
__device__ __forceinline__ XcdBarrier xcd_barrier_post(unsigned* bar, volatile LAS unsigned* st) {
    XcdBarrier b; b.bar = bar; b.x = xb_xcc_id(); b.st = st;
    if (threadIdx.x == 0) (void)xb_add(&bar[XB_XCNT(b.x)], 1u);
    return b;
}
__device__ __forceinline__ void xcd_barrier_complete(unsigned* bar, unsigned x, unsigned& nloc, unsigned& nx) {
    const unsigned G_ = gridDim.x * gridDim.y * gridDim.z;
    unsigned sum, cnt, mine, sp = 0u;
    for (;;) {
        sum = 0u; cnt = 0u; mine = 0u;
#pragma unroll
        for (unsigned j = 0; j < 16; ++j) { const unsigned c = xb_ld(&bar[XB_XCNT(j)]); sum += c; cnt += (c > 0u) ? 1u : 0u; mine = (j == x) ? c : mine; }
        if (sum == G_) break;
        __builtin_amdgcn_s_sleep(1);
        if ((++sp & 255u) == 0u) { if (xb_ld(&bar[XB_TMO])) break; if (sp > XB_SPIN_CAP) { atomicAdd(&bar[XB_TMO], 1u); break; } }
    }
    nloc = mine > 0u ? mine : 1u; nx = cnt > 0u ? cnt : 1u;
}
__device__ __forceinline__ void xcd_barrier(const XcdBarrier& b) {
    asm volatile("s_waitcnt vmcnt(0)" ::: "memory");
    __syncthreads();
    if (threadIdx.x == 0) {
        unsigned* bar = b.bar;
        __builtin_amdgcn_s_waitcnt(0);
        unsigned nloc = b.st[0], nx = b.st[1];
        if (nloc == 0u) { xcd_barrier_complete(bar, b.x, nloc, nx); b.st[0] = nloc; b.st[1] = nx; }
        const unsigned old = xb_add(&bar[XB_XSUB(b.x)], 1u);
        const unsigned gen = old / nloc;
        if (old + 1u == (gen + 1u) * nloc) {
            __builtin_amdgcn_fence(__ATOMIC_RELEASE, "agent");
            asm volatile("s_waitcnt vmcnt(0)" ::: "memory");
            const unsigned og = xb_add(&bar[XB_TOP], 1u);
            const unsigned tg = og / nx;
            if (og + 1u == (tg + 1u) * nx) xb_add(&bar[XB_TOPGEN], 1u);
            else XB_SPIN(xb_ld(&bar[XB_TOPGEN]) == tg, bar);
            __builtin_amdgcn_fence(__ATOMIC_ACQUIRE, "agent");
            xb_add(&bar[XB_XGEN(b.x)], 1u);
            asm volatile("s_waitcnt vmcnt(0)" ::: "memory");
        } else {
            XB_SPIN(xb_ld(&bar[XB_XGEN(b.x)]) == gen, bar);
            __builtin_amdgcn_fence(__ATOMIC_ACQUIRE, "agent");
            asm volatile("s_waitcnt vmcnt(0)" ::: "memory");
        }
    }
    __syncthreads();
}

constexpr int LDS_SCRATCH = 131072, MISC_OFF = 155648, LDS_BYTES = 163840;
#define MODP(which) ((const float*)(p.ws + WS_MODV) + (size_t)(which) * 4 * D)

__global__ void __launch_bounds__(NTHR, 2) k_fused(Params p) {
    extern __shared__ __attribute__((aligned(16))) unsigned char lds_raw[];
    LAS unsigned char* lds = (LAS unsigned char*)lds_raw;
    for (int u = threadIdx.x; u < (LDS_BYTES - LDS_SCRATCH) / 4; u += NTHR) ((LAS unsigned*)(lds + LDS_SCRATCH))[u] = 0u;
    __syncthreads();
    const XcdBarrier bar = xcd_barrier_post((unsigned*)(p.ws + WS_CTL) + CW_BAR, (volatile LAS unsigned*)(lds + MISC_OFF) + 8);
#define GRID_BAR() xcd_barrier(bar)
    phase_weights(p, lds); __syncthreads(); phase_modvec(p, lds);
    GRID_BAR();
    phase_convert_fgu(p, lds); __syncthreads();
    phase_poolmix(p, lds, (bf16_t*)(p.ws + WS_HA));
    GRID_BAR();
    { pg8::Sched<1> Sc; Sc.init(T, D, gridDim.x, blockIdx.x, p.ws + WS_HA, p.ws + WO_POOL, D, 256);
      pg8::EpiEl<EpiPool> E{{p.x, (float*)(p.ws + WS_X1), MODP(2), p.pool_scale, 0}};
      pg8::gemm_phase(lds, 256, D, 256, 128, Sc, E); }
    GRID_BAR();
    { NormOut o0{p.norm_g + D, MODP(4), MODP(3), (bf16_t*)(p.ws + WS_HB)}; phase_norm<1, false, 2>(p, lds, (const float*)(p.ws + WS_X1), o0, o0); }
    GRID_BAR();
    { pg8::Sched<0> Sc; Sc.init(T, 2 * FF, gridDim.x, blockIdx.x, p.ws + WS_HB, p.ws + WO_FGU, D / 2, D / 2);
      pg8::EpiPairEl<EpiSwigluI8> E{{(bf16_t*)(p.ws + WS_HID0), FF, (const float*)(p.ws + WS_ASC), (const float*)(p.ws + WS_FGMAX)}};
      pg8::gemm_phase<pg8::EpiPairEl<EpiSwigluI8>, pg8::Sched<0>, true, true, 2>(lds, D / 2, D / 2, D / 2, 128, Sc, E); }
    GRID_BAR();
    { pg8::Sched<0> Sc; Sc.init(T, D, gridDim.x, blockIdx.x, p.ws + WS_HID0, p.ws + WO_FDN, FF, FF);
      pg8::EpiEl<EpiResid> E{{(const float*)(p.ws + WS_X1), (float*)(p.ws + WS_X2), MODP(5)}};
      pg8::gemm_phase(lds, FF, FF, FF, 128, Sc, E); }
    GRID_BAR();
    { NormOut o0{p.kv_norm_g, MODP(13), MODP(12), (bf16_t*)(p.ws + WS_HA)}; NormOut o1{p.norm_g + 2 * D, MODP(7), MODP(6), (bf16_t*)(p.ws + WS_HB)}; phase_norm<2, false>(p, lds, (const float*)(p.ws + WS_X2), o0, o1); }
    GRID_BAR();
    { pg8::Sched<0> Sc; Sc.init(T, NKV, gridDim.x, blockIdx.x, p.ws + WS_HA, p.ws + WO_KV, D, D);
      pg8::EpiEl<EpiBf16> E{{(bf16_t*)(p.ws + WS_KVB), NKV}};
      pg8::gemm_phase(lds, D, D, D, 128, Sc, E); }
    { pg8::Sched<0> Sc; Sc.init(T, D, gridDim.x, blockIdx.x, p.ws + WS_HB, p.ws + WO_Q, D, D);
      pg8::EpiEl<EpiQ> E{{(bf16_t*)(p.ws + WS_Q), (float*)(p.ws + WS_GATE), 0}};
      pg8::gemm_phase(lds, D, D, D, 128, Sc, E); }
    GRID_BAR();
    { pg8::Sched<2> Sc; Sc.init(2048, 2048, gridDim.x, blockIdx.x, p.ws + WS_KVB, p.ws + WO_CK, 16 * NKV, 2048);
      pg8::EpiEl<EpiCmp> E{{(bf16_t*)(p.ws + WS_CMPH), (const float*)(p.ws + WS_CMPB)}};
      pg8::gemm_phase(lds, 2048, 16 * NKV, 2048, (size_t)NKV * 2, Sc, E); }
    { pg8::Sched<0> Sc; Sc.init(T, 256, (int)gridDim.x - 64 > 0 ? (int)gridDim.x - 64 : 1, (int)gridDim.x > 64 ? (int)blockIdx.x - 64 : (int)blockIdx.x, p.ws + WS_HB, p.ws + WO_Q + (size_t)D * D * 2, D, D);
      pg8::EpiEl<EpiQ> E{{(bf16_t*)(p.ws + WS_Q), (float*)(p.ws + WS_GATE), D}};
      pg8::gemm_phase(lds, D, D, D, 128, Sc, E); }
    phase_headnorm(p, lds); phase_vtrans(p, lds);
    GRID_BAR();
    phase_cmp2(p, lds);
    GRID_BAR();
    attn_tables(p, lds);
    phase_dense(p, lds, (bf16_t*)(p.ws + WS_HB));
    GRID_BAR();
    phase_sel_tile(p, lds, (bf16_t*)(p.ws + WS_HA), (const bf16_t*)(p.ws + WS_HB));
    GRID_BAR();
    { pg8::Sched<0> Sc; Sc.init(T, D, gridDim.x, blockIdx.x, p.ws + WS_HA, p.ws + WO_O, D, D);
      pg8::EpiEl<EpiResid> E{{(const float*)(p.ws + WS_X2), p.out, MODP(8)}};
      pg8::gemm_phase(lds, D, D, D, 128, Sc, E); }
    GRID_BAR();
    { NormOut o0{p.norm_g + 3 * D, MODP(10), MODP(9), (bf16_t*)(p.ws + WS_HB)}; phase_norm<1, true, 1>(p, lds, p.out, o0, o0); }
    GRID_BAR();
    phase_moe_sort(p, lds);
    GRID_BAR();
    { const int* pst = (const int*)(p.ws + WS_CTL) + 256;
      pg8::Sched<3> Sc; Sc.init(pst[NE], 2 * FE, gridDim.x, blockIdx.x, p.ws + WS_XS, p.ws + WO_EGU, D / 2, D / 2, pst, (size_t)FE * D);
      pg8::EpiPairEl<EpiSwiglu8> E{{p.ws + WS_HIDM, FE}};
      pg8::gemm_phase<pg8::EpiPairEl<EpiSwiglu8>, pg8::Sched<3>, true, true, 1>(lds, D / 2, D / 2, D / 2, 128, Sc, E, 127 - 5); }
    GRID_BAR();
    { const int* pst = (const int*)(p.ws + WS_CTL) + 256;
      pg8::Sched<3> Sc; Sc.init(pst[NE], D, gridDim.x, blockIdx.x, p.ws + WS_HIDM, p.ws + WO_EDN, FE / 2, FE / 2, pst, (size_t)D * FE / 2);
      pg8::EpiEl<EpiBf16> E{{(bf16_t*)(p.ws + WS_Y), D}};
      pg8::gemm_phase<pg8::EpiEl<EpiBf16>, pg8::Sched<3>, true, true, 1>(lds, FE / 2, FE / 2, FE / 2, 128, Sc, E, 127 - 6); }
    GRID_BAR();
    phase_combine(p);
}

extern "C" void kernel_launch(void* const* d_in, const int* in_sizes, int n_in, void* d_out, int out_size, void* d_ws, size_t ws_size, hipStream_t stream) {
    if (n_in != 28 || out_size != T * D || ws_size < WS_END) { fprintf(stderr, "kernel_launch: unexpected shapes (n_in %d out %d ws %zu need %zu)\n", n_in, out_size, ws_size, (size_t)WS_END); return; }
    static int grid = 0;
    if (grid == 0) {
        int dev = 0, cus = 0, per_cu = 0;
        if (hipGetDevice(&dev) != hipSuccess || hipDeviceGetAttribute(&cus, hipDeviceAttributeMultiprocessorCount, dev) != hipSuccess) { grid = -1; return; }
        if (hipFuncSetAttribute((const void*)k_fused, hipFuncAttributeMaxDynamicSharedMemorySize, LDS_BYTES) != hipSuccess) { grid = -1; return; }
        if (hipOccupancyMaxActiveBlocksPerMultiprocessor(&per_cu, (const void*)k_fused, NTHR, LDS_BYTES) != hipSuccess || per_cu < 1) { fprintf(stderr, "kernel_launch: occupancy query says %d\n", per_cu); }
        (void)hipGetLastError();
        grid = cus;
    }
    if (grid < 0) return;
    Params p{};
    const float** pp = (const float**)&p;
    for (int i = 0; i < 28; ++i) pp[i] = (const float*)d_in[i];
    p.out = (float*)d_out; p.ws = (unsigned char*)d_ws;
    (void)hipMemsetAsync((char*)d_ws + WS_CTL, 0, CTL_BYTES, stream);
    k_fused<<<dim3(grid), dim3(NTHR), LDS_BYTES, stream>>>(p);
}
```

```cpp
#include <hip/hip_runtime.h>
#include <cstdint>
#include <cstdio>

#define LAS __attribute__((address_space(3)))
typedef unsigned short bf16_t;
typedef short bf16x8 __attribute__((ext_vector_type(8)));
typedef float f32x4 __attribute__((ext_vector_type(4)));
typedef float f32x2 __attribute__((ext_vector_type(2)));
typedef unsigned u32x4 __attribute__((ext_vector_type(4)));
typedef unsigned u32x2 __attribute__((ext_vector_type(2)));

constexpr int NB = 4, S = 8192, D = 1024, T = NB * S;
constexpr int FF = 2816, NE = 8, FE = 3584;
constexpr int NKV = 1536, NQP = 1280, NQ = 1072;
constexpr int G = 4, HD = 64, NH = 16;
constexpr int NC = 512;
constexpr int NSB = 128;
constexpr int NSEL = 16;
constexpr int WIN = 512;
constexpr int MOE_ROWS = 69632;
constexpr float EPS = 1e-6f;
constexpr int NTHR = 512, NWAVE = 8;

constexpr size_t MiB = 1u << 20;
constexpr size_t WS_CTL = 0, CTL_BYTES = 1 * MiB;
constexpr size_t WS_MODV = 1 * MiB;
constexpr size_t WS_CMPB = WS_MODV + 14 * 4 * 1024 * 4;
constexpr size_t WS_FGMAX = WS_CMPB + 4096;
constexpr size_t WS_ASC = WS_FGMAX + 2 * FF * 4;
constexpr size_t WS_HBG = 6 * MiB;
constexpr size_t WS_MHG = WS_HBG + 65536;
constexpr size_t WS_TOPE = 2 * MiB;
constexpr size_t WS_TOPW = WS_TOPE + (size_t)T * 8;
constexpr size_t WS_RPOS = WS_TOPW + (size_t)T * 8;
constexpr size_t WS_RTOK = WS_RPOS + (size_t)T * 8;
constexpr size_t WS_SMALL_END = WS_RTOK + (size_t)MOE_ROWS * 4;
static_assert(WS_SMALL_END <= 8 * MiB && WS_ASC + (size_t)T * 4 <= 2 * MiB, "small region");
constexpr size_t WS_W = 8 * MiB;
constexpr size_t WO_POOL = WS_W;
constexpr size_t WO_FGU = WO_POOL + (size_t)4 * 256 * 256 * 2;
constexpr size_t WO_FDN = WO_FGU + (size_t)2 * FF * D * 2;
constexpr size_t WO_KV = WO_FDN + (size_t)D * FF * 2;
constexpr size_t WO_Q = WO_KV + (size_t)NKV * D * 2;
constexpr size_t WO_O = WO_Q + (size_t)NQP * D * 2;
constexpr size_t WO_CK = WO_O + (size_t)D * D * 2;
constexpr size_t WO_CV = WO_CK + (size_t)256 * 2048 * 2;
constexpr size_t WO_EGU = WO_CV + (size_t)256 * 2048 * 2;
constexpr size_t WO_EDN = WO_EGU + (size_t)NE * 2 * FE * D * 2;
constexpr size_t WO_END = WO_EDN + (size_t)NE * D * FE * 2;
static_assert(WO_END <= 203 * MiB, "weights region");
constexpr size_t WS_HB = 203 * MiB;
constexpr size_t WS_X1 = 267 * MiB;
constexpr size_t WS_X2 = 395 * MiB;
constexpr size_t WS_HID0 = 523 * MiB;
constexpr size_t WS_Q = 523 * MiB;
constexpr size_t WS_GATE = 587 * MiB;
constexpr size_t WS_CMPH = 593 * MiB;
constexpr size_t WS_KC = 601 * MiB;
constexpr size_t WS_VC = 602 * MiB;
constexpr size_t WS_KSB = 603 * MiB;
constexpr size_t WS_VSB = 619 * MiB;
constexpr size_t WS_KWB = 635 * MiB;
constexpr size_t WS_VWB = 651 * MiB;
constexpr size_t WS_Q8 = 267 * MiB;
constexpr size_t WS_SEL = 667 * MiB;
constexpr size_t WS_HA = 699 * MiB;
constexpr size_t WS_KVB = 763 * MiB;
constexpr size_t WS_HIDM = 267 * MiB;
constexpr size_t WS_Y = 743 * MiB;
constexpr size_t WS_XS = WS_Y;
constexpr size_t WS_END = 880 * MiB;
static_assert(WS_HIDM + (size_t)MOE_ROWS * FE * 2 <= WS_Y && WS_Y + (size_t)MOE_ROWS * D * 2 <= WS_END, "moe map");
static_assert(WS_KVB + (size_t)T * NKV * 2 + 65536 <= WS_END, "kv map");
constexpr int CW_CNT = 512;
constexpr int CW_CUR = 1024;
constexpr int CW_HN = 2048, CW_VT = 2112;
constexpr int CW_BAR = 4096;

struct Params {
    const float *x, *c, *ada_w, *ada_b, *norm_g, *pool_w, *pool_scale, *q_w, *q_gain, *o_w, *kv_ada_w, *kv_ada_b, *kv_norm_g, *kv_w,
        *cmp_pe_k, *cmp_pe_v, *cmp_k_w1, *cmp_k_w2, *cmp_v_w1, *cmp_v_w2, *k_gain, *rel_bias, *ffn_gu, *ffn_dn, *router_w, *router_b, *exp_gu, *exp_dn;
    float* out; unsigned char* ws;
};

__device__ __forceinline__ unsigned cvt_pk_bf16(float lo, float hi) { unsigned r; asm volatile("v_cvt_pk_bf16_f32 %0, %1, %2" : "=v"(r) : "v"(lo), "v"(hi)); return r; }
__device__ __forceinline__ float bf2f(unsigned short v) { return __uint_as_float((unsigned)v << 16); }
__device__ __forceinline__ float bflo(unsigned w) { return __uint_as_float(w << 16); }
__device__ __forceinline__ float bfhi(unsigned w) { return __uint_as_float(w & 0xffff0000u); }
__device__ __forceinline__ int opaque_tid() { int t = threadIdx.x; asm volatile("" : "+v"(t)); return t; }
__device__ __forceinline__ float readlane_f(float v, int l) { return __uint_as_float((unsigned)__builtin_amdgcn_readlane((int)__float_as_uint(v), l)); }
__device__ __forceinline__ unsigned pack_i8x4(float a, float b, float c, float d) {
    const int ia = (int)__builtin_rintf(fminf(fmaxf(a, -127.f), 127.f)), ib = (int)__builtin_rintf(fminf(fmaxf(b, -127.f), 127.f)), ic = (int)__builtin_rintf(fminf(fmaxf(c, -127.f), 127.f)), id = (int)__builtin_rintf(fminf(fmaxf(d, -127.f), 127.f));
    return (unsigned)(ia & 0xff) | ((unsigned)(ib & 0xff) << 8) | ((unsigned)(ic & 0xff) << 16) | ((unsigned)(id & 0xff) << 24);
}
__device__ __forceinline__ float sel_q_scale(const float* q_gain) { float m = 0.f; for (int i = 0; i < 64; ++i) m = fmaxf(m, fabsf(q_gain[i])); return 127.f / (4.f * m * 0.125f * 1.4426950408889634f); }
__device__ __forceinline__ float sel_k_scale(const float* k_gain) { float m = 0.f; for (int i = 0; i < 64; ++i) m = fmaxf(m, fabsf(k_gain[64 + i])); return 127.f / (4.f * m); }
__device__ __forceinline__ float wave_sum(float v) {
#pragma unroll
    for (int o = 1; o < 64; o <<= 1) v += __shfl_xor(v, o);
    return v;
}
__device__ __forceinline__ float wave_max(float v) {
#pragma unroll
    for (int o = 1; o < 64; o <<= 1) v = fmaxf(v, __shfl_xor(v, o));
    return v;
}
__device__ __forceinline__ float silu_f(float v) { return v * __builtin_amdgcn_rcpf(1.f + __builtin_amdgcn_exp2f(v * -1.4426950408889634f)); }
__device__ __forceinline__ float sigmoid_f(float v) { return __builtin_amdgcn_rcpf(1.f + __builtin_amdgcn_exp2f(v * -1.4426950408889634f)); }
__device__ __forceinline__ float gelu_tanh_f(float v) {
    const float u = 0.7978845608028654f * (v + 0.044715f * v * v * v);
    const float e = __builtin_amdgcn_exp2f(fabsf(u) * -2.8853900817779268f); const float th = (1.f - e) * __builtin_amdgcn_rcpf(1.f + e);
    return 0.5f * v * (1.f + (u < 0.f ? -th : th));
}
__device__ __forceinline__ int rel_bucket(int d) {
    if (d < 16) return d;
    int b = 16;
    b += (d >= 21); b += (d >= 27); b += (d >= 35); b += (d >= 46); b += (d >= 59); b += (d >= 77); b += (d >= 99); b += (d >= 128);
    b += (d >= 166); b += (d >= 216); b += (d >= 280); b += (d >= 363); b += (d >= 470); b += (d >= 609); b += (d >= 790);
    return b;
}

template <bool FP8 = false>
__device__ __forceinline__ void transpose_item(const float* W, int K, int N, bf16_t* WT, int k0, int n0, int drow0, LAS float* scr, int lane, float wscale = 1.f) {
    float wv[32];
#pragma unroll
    for (int i = 0; i < 32; ++i) { const int kk = 2 * i + (lane >> 5); const int n = n0 + (lane & 31); wv[i] = (n < N) ? W[(size_t)(k0 + kk) * N + n] : 0.f; }
#pragma unroll
    for (int i = 0; i < 32; ++i) { const int kk = 2 * i + (lane >> 5); scr[kk * 33 + (lane & 31)] = wv[i]; }
    asm volatile("s_waitcnt lgkmcnt(0)" ::: "memory");
    const int c = lane & 7;
#pragma unroll
    for (int j = 0; j < 4; ++j) { const int n = (lane >> 3) + 8 * j; const LAS float* s = scr + (8 * c) * 33 + n;
        if constexpr (FP8) {
            unsigned w0 = 0u, w1 = 0u;
            w0 = __builtin_amdgcn_cvt_pk_fp8_f32(s[0 * 33] * wscale, s[1 * 33] * wscale, w0, false); w0 = __builtin_amdgcn_cvt_pk_fp8_f32(s[2 * 33] * wscale, s[3 * 33] * wscale, w0, true);
            w1 = __builtin_amdgcn_cvt_pk_fp8_f32(s[4 * 33] * wscale, s[5 * 33] * wscale, w1, false); w1 = __builtin_amdgcn_cvt_pk_fp8_f32(s[6 * 33] * wscale, s[7 * 33] * wscale, w1, true);
            *(u32x2*)((unsigned char*)WT + (size_t)(drow0 + n) * K + k0 + 8 * c) = (u32x2){w0, w1};
        } else {
        u32x4 o; o.x = cvt_pk_bf16(s[0 * 33], s[1 * 33]); o.y = cvt_pk_bf16(s[2 * 33], s[3 * 33]); o.z = cvt_pk_bf16(s[4 * 33], s[5 * 33]); o.w = cvt_pk_bf16(s[6 * 33], s[7 * 33]);
        *(u32x4*)(WT + (size_t)(drow0 + n) * K + k0 + 8 * c) = o; } }
    asm volatile("s_waitcnt lgkmcnt(0)" ::: "memory");
}
template <int MODE, bool FP8 = false>
__device__ __forceinline__ void transpose_mat(const float* W, int K, int N, int NP, int F, bf16_t* WT, int it, LAS float* scr, int lane, float wscale = 1.f) {
    const int nblk = NP / 32, kb = it / nblk, nb = it % nblk, n0 = nb * 32;
    int drow0 = n0;
    if (MODE == 1) { const int up = n0 >= F, j = up ? n0 - F : n0; drow0 = (j >> 7) * 256 + (up ? 128 : 0) + (j & 127); }
    transpose_item<FP8>(W, K, N, WT, kb * 64, n0, drow0, scr, lane, wscale);
}
__device__ __forceinline__ void phase_convert_fgu(const Params& p, LAS unsigned char* lds) {
    const int tid = opaque_tid(), lane = tid & 63, wave = tid >> 6;
    LAS float* scr = (LAS float*)(lds + wave * 16384);
    const int gw = blockIdx.x * NWAVE + wave, NGW = gridDim.x * NWAVE;
    const float* FGMAX = (const float*)(p.ws + WS_FGMAX); unsigned char* WT = p.ws + WO_FGU;
    for (int it = gw; it < 16 * 176; it += NGW) {
        const int kb = it / 176, nb = it % 176, n0 = nb * 32, k0 = kb * 64;
        const int up = n0 >= FF, j0 = up ? n0 - FF : n0, drow0 = (j0 >> 7) * 256 + (up ? 128 : 0) + (j0 & 127);
        float wv[32];
#pragma unroll
        for (int i = 0; i < 32; ++i) wv[i] = p.ffn_gu[(size_t)(k0 + 2 * i + (lane >> 5)) * (2 * FF) + n0 + (lane & 31)];
#pragma unroll
        for (int i = 0; i < 32; ++i) scr[(2 * i + (lane >> 5)) * 33 + (lane & 31)] = wv[i];
        asm volatile("s_waitcnt lgkmcnt(0)" ::: "memory");
        const int c = lane & 7;
#pragma unroll
        for (int j = 0; j < 4; ++j) { const int n = (lane >> 3) + 8 * j; const LAS float* sp = scr + (8 * c) * 33 + n; const float sc = 127.f / FGMAX[n0 + n];
            const unsigned w0 = pack_i8x4(sp[0 * 33] * sc, sp[1 * 33] * sc, sp[2 * 33] * sc, sp[3 * 33] * sc), w1 = pack_i8x4(sp[4 * 33] * sc, sp[5 * 33] * sc, sp[6 * 33] * sc, sp[7 * 33] * sc);
            *(u32x2*)(WT + (size_t)(drow0 + n) * D + k0 + 8 * c) = (u32x2){w0, w1}; }
        asm volatile("s_waitcnt lgkmcnt(0)" ::: "memory");
    }
}
__device__ __forceinline__ void phase_weights(const Params& p, LAS unsigned char* lds) {
    const int tid = opaque_tid(), lane = tid & 63, wave = tid >> 6;
    LAS float* scr = (LAS float*)(lds + wave * 16384);
    const int gw = blockIdx.x * NWAVE + wave, NGW = gridDim.x * NWAVE;
    unsigned char* ws = p.ws;
    constexpr int I_POOL = 4 * 8, I_FGU = 16 * 176, I_FDN = 44 * 32, I_KV = 16 * 48, I_Q = 16 * 40, I_O = 16 * 32, I_C = 32 * 8, I_EGU = 16 * 224, I_EDN = 56 * 32;
    constexpr int TOT = 4 * I_POOL + I_FGU + I_FDN + I_KV + I_Q + I_O + 2 * I_C + NE * I_EGU + NE * I_EDN;
    for (int it = gw; it < TOT; it += NGW) {
        int r = it;
        if (r < 4 * I_POOL) { const int g = r / I_POOL; transpose_mat<0>(p.pool_w + (size_t)g * 65536, 256, 256, 256, 0, (bf16_t*)(ws + WO_POOL) + (size_t)g * 65536, r % I_POOL, scr, lane); continue; } r -= 4 * I_POOL;
        if (r < I_FGU) continue; r -= I_FGU;
        if (r < I_FDN) { transpose_mat<0>(p.ffn_dn, FF, D, D, 0, (bf16_t*)(ws + WO_FDN), r, scr, lane); continue; } r -= I_FDN;
        if (r < I_KV) { transpose_mat<0>(p.kv_w, D, NKV, NKV, 0, (bf16_t*)(ws + WO_KV), r, scr, lane); continue; } r -= I_KV;
        if (r < I_Q) { transpose_mat<0>(p.q_w, D, NQ, NQP, 0, (bf16_t*)(ws + WO_Q), r, scr, lane); continue; } r -= I_Q;
        if (r < I_O) { transpose_mat<0>(p.o_w, D, D, D, 0, (bf16_t*)(ws + WO_O), r, scr, lane); continue; } r -= I_O;
        if (r < I_C) { transpose_mat<0>(p.cmp_k_w1, 2048, 256, 256, 0, (bf16_t*)(ws + WO_CK), r, scr, lane); continue; } r -= I_C;
        if (r < I_C) { transpose_mat<0>(p.cmp_v_w1, 2048, 256, 256, 0, (bf16_t*)(ws + WO_CV), r, scr, lane); continue; } r -= I_C;
        if (r < NE * I_EGU) { const int e = r / I_EGU; transpose_mat<1, true>(p.exp_gu + (size_t)e * D * 2 * FE, D, 2 * FE, 2 * FE, FE, (bf16_t*)(ws + WO_EGU + (size_t)e * 2 * FE * D), r % I_EGU, scr, lane, 32.f); continue; } r -= NE * I_EGU;
        { const int e = r / I_EDN; transpose_mat<0, true>(p.exp_dn + (size_t)e * FE * D, FE, D, D, 0, (bf16_t*)(ws + WO_EDN + (size_t)e * D * FE), r % I_EDN, scr, lane, 64.f); }
    }
}

__device__ __forceinline__ void phase_modvec(const Params& p, LAS unsigned char* lds) {
    const int tid = opaque_tid(), lane = tid & 63, wave = tid >> 6;
    LAS float* part = (LAS float*)lds;
    LAS float* sc_l = (LAS float*)(lds + 8192);
    for (int i = tid; i < 4 * D; i += NTHR) sc_l[i] = silu_f(p.c[i]);
    __syncthreads();
    float* MODV = (float*)(p.ws + WS_MODV);
    float* CMPB = (float*)(p.ws + WS_CMPB);
    { float* FGMAX = (float*)(p.ws + WS_FGMAX);
      for (int u = blockIdx.x; u < 2 * FF / 64; u += gridDim.x) {
        const int col = u * 64 + lane; float m = 0.f;
#pragma unroll 16
        for (int k = wave * 128; k < wave * 128 + 128; ++k) m = fmaxf(m, fabsf(p.ffn_gu[(size_t)k * (2 * FF) + col]));
        part[wave * 64 + lane] = m;
        __syncthreads();
        if (tid < 64) { float mm = part[lane];
#pragma unroll
            for (int w = 1; w < 8; ++w) mm = fmaxf(mm, part[w * 64 + lane]);
            FGMAX[u * 64 + lane] = fmaxf(mm, 1e-30f); }
        __syncthreads();
      } }
    constexpr int NU_MOD = 14336 / 64, NU = NU_MOD + 8;
    for (int u = blockIdx.x; u < NU; u += gridDim.x) {
        float acc[4] = {0.f, 0.f, 0.f, 0.f};
        if (u < NU_MOD) {
            const int gc = u * 64 + lane;
            const float* W; int ldw, col;
            if (gc < 6144) { W = p.ada_w; ldw = 6144; col = gc; } else if (gc < 12288) { W = p.ada_w + (size_t)D * 6144; ldw = 6144; col = gc - 6144; } else { W = p.kv_ada_w; ldw = 2048; col = gc - 12288; }
#pragma unroll 16
            for (int k = wave * 128; k < wave * 128 + 128; ++k) {
                const float w = W[(size_t)k * ldw + col];
#pragma unroll
                for (int b = 0; b < 4; ++b) acc[b] += sc_l[b * D + k] * w;
            }
        } else {
            const int cu = u - NU_MOD, kv = cu >> 2, col = (cu & 3) * 64 + lane;
            const float* W = kv ? p.cmp_v_w1 : p.cmp_k_w1; const float* pe = kv ? p.cmp_pe_v : p.cmp_pe_k;
#pragma unroll 16
            for (int k = wave * 256; k < wave * 256 + 256; ++k) acc[0] += pe[k] * W[(size_t)k * 256 + col];
        }
#pragma unroll
        for (int b = 0; b < 4; ++b) part[(wave * 4 + b) * 64 + lane] = acc[b];
        __syncthreads();
        if (tid < 256) {
            const int b = tid >> 6; float s = 0.f;
#pragma unroll
            for (int w = 0; w < 8; ++w) s += part[(w * 4 + b) * 64 + lane];
            if (u < NU_MOD) {
                const int gc = u * 64 + lane; int which, n; float bias;
                if (gc < 6144) { which = gc >> 10; n = gc & 1023; bias = p.ada_b[gc]; } else if (gc < 12288) { which = 6 + ((gc - 6144) >> 10); n = gc & 1023; bias = p.ada_b[gc]; }
                else { which = 12 + ((gc - 12288) >> 10); n = gc & 1023; bias = p.kv_ada_b[gc - 12288]; }
                MODV[(which * 4 + b) * D + n] = s + bias;
            } else if (b == 0) { const int cu = u - NU_MOD; CMPB[(cu >> 2) * 256 + (cu & 3) * 64 + lane] = s; }
        }
        __syncthreads();
    }
}

template <int W>
__device__ __forceinline__ void pool_rows(const float* xb, int t0, const LAS float* rs, f32x2 gm, f32x2 sh, bf16_t* outb, int c0) {
    f32x2 ring[16];
#pragma unroll
    for (int i = 0; i < 15; ++i) {
        const int t = t0 - 15 + i; f32x2 h = {0.f, 0.f};
        if (t >= 0) { const f32x2 xv = *(const f32x2*)(xb + (size_t)t * D + c0); const float r = rs[i]; h = xv * r * gm + sh; }
        ring[i] = h;
    }
    for (int gi = 0; gi < 8; ++gi) {
#pragma unroll
        for (int j = 0; j < 16; ++j) {
            const int i = 15 + gi * 16 + j, t = t0 + gi * 16 + j;
            const f32x2 xv = *(const f32x2*)(xb + (size_t)t * D + c0); const float r = rs[i];
            const f32x2 h = xv * r * gm + sh;
            ring[(15 + j) & 15] = h;
            f32x2 s = {0.f, 0.f};
#pragma unroll
            for (int k = 0; k < W; ++k) s += ring[(15 + j - k) & 15];
            const int cnt = (t + 1 < W) ? t + 1 : W;
            const f32x2 o = s * (1.f / (float)cnt) - h;
            *(unsigned*)(outb + (size_t)t * D + c0) = cvt_pk_bf16(o.x, o.y);
        }
    }
}
__device__ __forceinline__ void phase_poolmix(const Params& p, LAS unsigned char* lds, bf16_t* mixA) {
    const int tid = opaque_tid(), lane = tid & 63, wave = tid >> 6;
    LAS float* rs = (LAS float*)lds;
    const float* MODV = (const float*)(p.ws + WS_MODV);
    for (int u = blockIdx.x; u < T / 128; u += gridDim.x) {
        const int b = u >> 6, t0 = (u & 63) * 128;
        const float* xb = p.x + (size_t)b * S * D;
        for (int i = wave; i < 143; i += NWAVE) {
            const int t = t0 - 15 + i; float r = 0.f;
            if (t >= 0) { const f32x4* xr = (const f32x4*)(xb + (size_t)t * D) + lane; float s = 0.f;
#pragma unroll
                for (int j = 0; j < 4; ++j) { const f32x4 v = xr[64 * j]; s += (v.x * v.x + v.y * v.y) + (v.z * v.z + v.w * v.w); }
                r = 1.f / sqrtf(wave_sum(s) * (1.f / D) + EPS); }
            if (lane == 0) rs[i] = r;
        }
        __syncthreads();
        const int c0 = 2 * tid;
        const f32x2 g = *(const f32x2*)(p.norm_g + c0), sc = *(const f32x2*)(MODV + (1 * 4 + b) * D + c0), sh = *(const f32x2*)(MODV + (0 * 4 + b) * D + c0);
        const f32x2 gm = g * (sc + 1.f);
        bf16_t* ob = mixA + (size_t)b * S * D;
        const int grp = tid >> 7;
        if (grp == 0) pool_rows<2>(xb, t0, rs, gm, sh, ob, c0);
        else if (grp == 1) pool_rows<4>(xb, t0, rs, gm, sh, ob, c0);
        else if (grp == 2) pool_rows<8>(xb, t0, rs, gm, sh, ob, c0);
        else pool_rows<16>(xb, t0, rs, gm, sh, ob, c0);
        __syncthreads();
    }
}

struct NormOut { const float* g; const float* sc; const float* sh; bf16_t* out; };
template <int NOUT, bool ROUTER, int OUTQ = 0>
__device__ __forceinline__ void phase_norm(const Params& p, LAS unsigned char* lds, const float* xin, const NormOut o0, const NormOut o1) {
    const int tid = opaque_tid(), lane = tid & 63, wave = tid >> 6;
    const int gw = blockIdx.x * NWAVE + wave, NGW = gridDim.x * NWAVE;
    f32x4 rwa[16], rwb[16];
    if (ROUTER) {
#pragma unroll
        for (int j = 0; j < 4; ++j)
#pragma unroll
            for (int q = 0; q < 4; ++q) { const f32x4* wp = (const f32x4*)(p.router_w + (size_t)(4 * lane + 256 * j + q) * NE); rwa[4 * j + q] = wp[0]; rwb[4 * j + q] = wp[1]; }
    }
    unsigned* ctl = (unsigned*)(p.ws + WS_CTL);
    int* TOPE = (int*)(p.ws + WS_TOPE); float* TOPW = (float*)(p.ws + WS_TOPW);
    unsigned cnt_local[NE];
#pragma unroll
    for (int e = 0; e < NE; ++e) cnt_local[e] = 0;
    const int rows_per = T / NGW > 0 ? (T + NGW - 1) / NGW : 1;
    const int r0 = gw * rows_per, r1 = (r0 + rows_per < T) ? r0 + rows_per : T;
    int curb = -1; f32x4 gm0[4], sh0[4], gm1[4], sh1[4];
    for (int r = r0; r < r1; ++r) {
        const int b = r >> 13;
        if (b != curb) { curb = b;
#pragma unroll
            for (int j = 0; j < 4; ++j) { const int c = 4 * lane + 256 * j;
                gm0[j] = *(const f32x4*)(o0.g + c) * (*(const f32x4*)(o0.sc + b * D + c) + 1.f); sh0[j] = *(const f32x4*)(o0.sh + b * D + c);
                if (NOUT > 1) { gm1[j] = *(const f32x4*)(o1.g + c) * (*(const f32x4*)(o1.sc + b * D + c) + 1.f); sh1[j] = *(const f32x4*)(o1.sh + b * D + c); } } }
        const f32x4* xr = (const f32x4*)(xin + (size_t)r * D) + lane;
        f32x4 v[4]; float s = 0.f;
#pragma unroll
        for (int j = 0; j < 4; ++j) { v[j] = xr[64 * j]; s += (v[j].x * v[j].x + v[j].y * v[j].y) + (v[j].z * v[j].z + v[j].w * v[j].w); }
        const float rstd = 1.f / sqrtf(wave_sum(s) * (1.f / D) + EPS);
        float lg[NE];
#pragma unroll
        for (int e = 0; e < NE; ++e) lg[e] = 0.f;
        float qsc = 1.f;
        if constexpr (OUTQ == 2) { float mx = 0.f;
#pragma unroll
            for (int j = 0; j < 4; ++j) { const f32x4 h = v[j] * rstd * gm0[j] + sh0[j]; mx = fmaxf(mx, fmaxf(fmaxf(fabsf(h.x), fabsf(h.y)), fmaxf(fabsf(h.z), fabsf(h.w)))); }
            mx = fmaxf(wave_max(mx), 1e-30f); qsc = 127.f / mx;
            if (lane == 0) ((float*)(p.ws + WS_ASC))[r] = mx * (1.f / 127.f); }
#pragma unroll
        for (int j = 0; j < 4; ++j) {
            const f32x4 h = v[j] * rstd * gm0[j] + sh0[j];
            if constexpr (OUTQ == 2) { *(unsigned*)((unsigned char*)o0.out + (size_t)r * D + 4 * lane + 256 * j) = pack_i8x4(h.x * qsc, h.y * qsc, h.z * qsc, h.w * qsc); }
            else if constexpr (OUTQ == 1) { unsigned w8 = 0u; w8 = __builtin_amdgcn_cvt_pk_fp8_f32(h.x, h.y, w8, false); w8 = __builtin_amdgcn_cvt_pk_fp8_f32(h.z, h.w, w8, true);
                *(unsigned*)((unsigned char*)o0.out + (size_t)r * D + 4 * lane + 256 * j) = w8; }
            else { u32x2 w; w.x = cvt_pk_bf16(h.x, h.y); w.y = cvt_pk_bf16(h.z, h.w);
            *(u32x2*)(o0.out + (size_t)r * D + 4 * lane + 256 * j) = w; }
            if (NOUT > 1) { const f32x4 h1 = v[j] * rstd * gm1[j] + sh1[j]; u32x2 w1; w1.x = cvt_pk_bf16(h1.x, h1.y); w1.y = cvt_pk_bf16(h1.z, h1.w);
                *(u32x2*)(o1.out + (size_t)r * D + 4 * lane + 256 * j) = w1; }
            if (ROUTER) {
#pragma unroll
                for (int q = 0; q < 4; ++q) { const f32x4 a = rwa[4 * j + q], c2 = rwb[4 * j + q]; const float hv = h[q];
                    lg[0] += hv * a.x; lg[1] += hv * a.y; lg[2] += hv * a.z; lg[3] += hv * a.w; lg[4] += hv * c2.x; lg[5] += hv * c2.y; lg[6] += hv * c2.z; lg[7] += hv * c2.w; }
            }
        }
        if (ROUTER) {
            {
                const bool u5 = lane & 32, u4 = lane & 16, u3 = lane & 8; float a4[4], a2[2], a1;
#pragma unroll
                for (int i = 0; i < 4; ++i) a4[i] = (u5 ? lg[4 + i] : lg[i]) + __shfl_xor(u5 ? lg[i] : lg[4 + i], 32);
#pragma unroll
                for (int i = 0; i < 2; ++i) a2[i] = (u4 ? a4[2 + i] : a4[i]) + __shfl_xor(u4 ? a4[i] : a4[2 + i], 16);
                a1 = (u3 ? a2[1] : a2[0]) + __shfl_xor(u3 ? a2[0] : a2[1], 8);
                a1 += __shfl_xor(a1, 4); a1 += __shfl_xor(a1, 2); a1 += __shfl_xor(a1, 1);
#pragma unroll
                for (int e = 0; e < NE; ++e) lg[e] = readlane_f(a1, 8 * e) + p.router_b[e];
            }
            int e0 = 0; float v0 = lg[0];
#pragma unroll
            for (int e = 1; e < NE; ++e) if (lg[e] > v0) { v0 = lg[e]; e0 = e; }
            int e1 = -1; float v1 = -3.0e38f;
#pragma unroll
            for (int e = 0; e < NE; ++e) if (e != e0 && lg[e] > v1) { v1 = lg[e]; e1 = e; }
            const float ex = __expf(v1 - v0), w0 = 1.f / (1.f + ex), w1 = ex / (1.f + ex);
            if (lane == 0) { TOPE[2 * r] = e0; TOPE[2 * r + 1] = e1; TOPW[2 * r] = w0; TOPW[2 * r + 1] = w1; }
#pragma unroll
            for (int e = 0; e < NE; ++e) cnt_local[e] += (e == e0) + (e == e1);
        }
    }
    if (ROUTER) {
        LAS unsigned* lc = (LAS unsigned*)lds;
        if (tid < NE) lc[tid] = 0u;
        __syncthreads();
        if (lane == 0) {
#pragma unroll
            for (int e = 0; e < NE; ++e) if (cnt_local[e]) atomicAdd((unsigned*)(lc + e), cnt_local[e]);
        }
        __syncthreads();
        if (tid < NE && lc[tid]) atomicAdd(ctl + CW_CNT + 64 * tid, lc[tid]);
    }
}

struct NoCol {};
struct EpiPool {
    typedef f32x4 Col; static constexpr bool ROWLOAD = true;
    const float* x; float* x1; const float* g1; const float* scale; int coff;
    __device__ __forceinline__ f32x4 col(int row0, int c) const { return *(const f32x4*)(g1 + (row0 >> 13) * D + coff + c) * *(const f32x4*)(scale + coff + c); }
    __device__ __forceinline__ f32x4 rowload(int row, int c) const { return *(const f32x4*)(x + (size_t)row * D + coff + c); }
    __device__ __forceinline__ void apply8(int row, int c, f32x4 v0, f32x4 v1, f32x4 cg0, f32x4 cg1, f32x4 xv0, f32x4 xv1) const { float* o = x1 + (size_t)row * D + coff + c; *(f32x4*)o = xv0 + cg0 * v0; *(f32x4*)(o + 4) = xv1 + cg1 * v1; }
};
struct EpiSwigluI8 {
    struct Col { f32x4 wg, wu; }; typedef float Row;
    bf16_t* hid; int ldh; const float* asc; const float* wmax;
    __device__ __forceinline__ Col col(int hc) const { Col c; c.wg = *(const f32x4*)(wmax + hc); c.wu = *(const f32x4*)(wmax + FF + hc); return c; }
    __device__ __forceinline__ float rowv(int row) const { return asc[row] * (1.f / 127.f); }
    __device__ __forceinline__ u32x2 four(f32x4 gt, f32x4 up, const Col& c, float ra) const {
        typedef int i32x4e __attribute__((ext_vector_type(4)));
        const i32x4e gi = __builtin_bit_cast(i32x4e, gt), ui = __builtin_bit_cast(i32x4e, up);
        const f32x4 wg = c.wg * ra, wu = c.wu * ra;
        const float g0 = (float)gi.x * wg.x, g1 = (float)gi.y * wg.y, g2 = (float)gi.z * wg.z, g3 = (float)gi.w * wg.w;
        u32x2 w; w.x = cvt_pk_bf16(silu_f(g0) * ((float)ui.x * wu.x), silu_f(g1) * ((float)ui.y * wu.y)); w.y = cvt_pk_bf16(silu_f(g2) * ((float)ui.z * wu.z), silu_f(g3) * ((float)ui.w * wu.w)); return w; }
    __device__ __forceinline__ void pair8(int row, int hc, f32x4 g0, f32x4 u0, f32x4 g1, f32x4 u1, const Col& c0, const Col& c1, float ra) const {
        const u32x2 a = four(g0, u0, c0, ra), b = four(g1, u1, c1, ra);
        *(u32x4*)(hid + (size_t)row * ldh + hc) = (u32x4){a.x, a.y, b.x, b.y}; }
};
struct EpiSwiglu8 {
    typedef NoCol Col; typedef NoCol Row;
    unsigned char* hid; int ldh;
    __device__ __forceinline__ NoCol col(int) const { return NoCol{}; }
    __device__ __forceinline__ NoCol rowv(int) const { return NoCol{}; }
    __device__ __forceinline__ unsigned four(f32x4 gt, f32x4 up) const {
        unsigned w = 0u; w = __builtin_amdgcn_cvt_pk_fp8_f32(silu_f(gt.x) * up.x, silu_f(gt.y) * up.y, w, false); w = __builtin_amdgcn_cvt_pk_fp8_f32(silu_f(gt.z) * up.z, silu_f(gt.w) * up.w, w, true); return w; }
    __device__ __forceinline__ void pair8(int row, int hc, f32x4 g0, f32x4 u0, f32x4 g1, f32x4 u1, const NoCol&, const NoCol&, NoCol) const {
        *(u32x2*)(hid + (size_t)row * ldh + hc) = (u32x2){four(g0, u0), four(g1, u1)}; }
};
struct EpiResid {
    typedef f32x4 Col; static constexpr bool ROWLOAD = true;
    const float* xin; float* out; const float* gate;
    __device__ __forceinline__ f32x4 col(int row0, int c) const { return *(const f32x4*)(gate + (row0 >> 13) * D + c); }
    __device__ __forceinline__ f32x4 rowload(int row, int c) const { return *(const f32x4*)(xin + (size_t)row * D + c); }
    __device__ __forceinline__ void apply8(int row, int c, f32x4 v0, f32x4 v1, f32x4 cg0, f32x4 cg1, f32x4 xv0, f32x4 xv1) const { float* o = out + (size_t)row * D + c; *(f32x4*)o = xv0 + cg0 * v0; *(f32x4*)(o + 4) = xv1 + cg1 * v1; }
};
struct EpiBf16 {
    typedef NoCol Col; static constexpr bool ROWLOAD = false;
    bf16_t* o; int ldo;
    __device__ __forceinline__ NoCol col(int, int) const { return NoCol{}; }
    __device__ __forceinline__ void apply8(int row, int c, f32x4 v0, f32x4 v1, NoCol, NoCol) const { *(u32x4*)(o + (size_t)row * ldo + c) = (u32x4){cvt_pk_bf16(v0.x, v0.y), cvt_pk_bf16(v0.z, v0.w), cvt_pk_bf16(v1.x, v1.y), cvt_pk_bf16(v1.z, v1.w)}; }
};
struct EpiQ {
    typedef NoCol Col; static constexpr bool ROWLOAD = false;
    bf16_t* q; float* gates; int coff;
    __device__ __forceinline__ NoCol col(int, int) const { return NoCol{}; }
    __device__ __forceinline__ void apply8(int row, int col_, f32x4 v0, f32x4 v1, NoCol, NoCol) const { const int col = col_ + coff;
        if (col < D) { *(u32x4*)(q + (size_t)row * D + col) = (u32x4){cvt_pk_bf16(v0.x, v0.y), cvt_pk_bf16(v0.z, v0.w), cvt_pk_bf16(v1.x, v1.y), cvt_pk_bf16(v1.z, v1.w)}; }
        else if (col < NQ) { f32x4 s0, s1; s0.x = sigmoid_f(v0.x); s0.y = sigmoid_f(v0.y); s0.z = sigmoid_f(v0.z); s0.w = sigmoid_f(v0.w); s1.x = sigmoid_f(v1.x); s1.y = sigmoid_f(v1.y); s1.z = sigmoid_f(v1.z); s1.w = sigmoid_f(v1.w);
            float* g = gates + (size_t)row * 48 + (col - D); *(f32x4*)g = s0; *(f32x4*)(g + 4) = s1; } }
};
struct EpiCmp {
    typedef f32x4 Col; static constexpr bool ROWLOAD = false;
    bf16_t* o; const float* bias;
    __device__ __forceinline__ f32x4 col(int, int c_) const { const int z = c_ >> 8, c = c_ & 255; return *(const f32x4*)(bias + (z >> 2) * 256 + c); }
    __device__ __forceinline__ void apply8(int row, int col, f32x4 v0, f32x4 v1, f32x4 b0, f32x4 b1) const { const int z = col >> 8, c = col & 255;
        u32x4 w; w.x = cvt_pk_bf16(gelu_tanh_f(v0.x + b0.x), gelu_tanh_f(v0.y + b0.y)); w.y = cvt_pk_bf16(gelu_tanh_f(v0.z + b0.z), gelu_tanh_f(v0.w + b0.w));
        w.z = cvt_pk_bf16(gelu_tanh_f(v1.x + b1.x), gelu_tanh_f(v1.y + b1.y)); w.w = cvt_pk_bf16(gelu_tanh_f(v1.z + b1.z), gelu_tanh_f(v1.w + b1.w));
        *(u32x4*)(o + ((size_t)z * 2048 + row) * 256 + c) = w; }
};

namespace pg8 {
#define PG8_LAS __attribute__((address_space(3)))
constexpr int BM = 256, BK = 64, HALF = 128, HTB = HALF * BK * 2, STAGE_BYTES = 8 * HTB, NXCD = 8, WGM = 8;
__host__ __device__ __forceinline__ int lds_byte(int r, int c) { const int st = (r >> 4) * 2 + (c >> 5), rr = r & 15, cc = c & 31, ob = rr * 64 + cc * 2; return st * 1024 + (ob ^ (((ob >> 9) & 1) << 5)); }
__host__ __device__ __forceinline__ void stage_rc(int b, int& R, int& C) { const int st = b / 1024, sb = b % 1024, swz = sb ^ (((sb >> 9) & 1) << 5); R = (st >> 1) * 16 + swz / 64; C = (st & 1) * 32 + (swz % 64) / 2; }
__host__ __device__ __forceinline__ int perm32(int rho) { const int n = rho >> 4, i = rho & 15; return 8 * (i >> 2) + 4 * n + (i & 3); }
struct Unit { int pm, pn; };
template <int SMODE> struct Sched {
    int nM, nN, nwg, G, c; const char* A; const char* Bt; size_t lda2, ldb2; const int* pst; size_t bstride2;
    __device__ __forceinline__ void init(int M, int N, int G_, int c_, const void* A_, const void* Bt_, int lda, int ldb, const int* pst_ = nullptr, size_t bstride = 0) {
        nM = M / BM; nN = N / BM; nwg = nM * nN; G = G_; c = c_; A = (const char*)A_; Bt = (const char*)Bt_; lda2 = (size_t)lda * 2; ldb2 = (size_t)ldb * 2; pst = pst_; bstride2 = bstride * 2; }
    __device__ __forceinline__ bool next(int i, Unit& u) const {
        if (c < 0) return false;
        const long L = (long)i * G + c; if (L >= nwg) return false;
        int wgid = (int)L; { const int q = nwg / NXCD, r = nwg % NXCD, xcd = wgid % NXCD, off = wgid / NXCD; wgid = (xcd < r ? xcd * (q + 1) : r * (q + 1) + (xcd - r) * q) + off; }
        const int nig = WGM * nN, gid = wgid / nig, fm = gid * WGM, gsz = (nM - fm) < WGM ? (nM - fm) : WGM;
        u.pm = fm + ((wgid % nig) % gsz); u.pn = (wgid % nig) / gsz; return true;
    }
    __device__ __forceinline__ const char* a_ptr(const Unit& u) const {
        if (SMODE == 1) return A + (size_t)u.pm * BM * lda2 + (size_t)u.pn * 512;
        if (SMODE == 2) return A + (size_t)u.pm * BM * lda2 + (size_t)((u.pn >> 2) * 256 + (u.pn & 3) * 64) * 2;
        return A + (size_t)u.pm * BM * lda2; }
    __device__ __forceinline__ const char* b_ptr(const Unit& u) const {
        if (SMODE == 2) return Bt + (size_t)(u.pn >> 2) * BM * ldb2;
        if (SMODE == 3) { const int m0 = u.pm * BM; int e = 0;
#pragma unroll
            for (int q = 1; q < NE; ++q) e += (m0 >= pst[q]); return Bt + (size_t)e * bstride2 + (size_t)u.pn * BM * ldb2; }
        return Bt + (size_t)u.pn * BM * ldb2; }
};
template <class F> struct EpiEl { static constexpr bool PERM = true, AFTER_DRAIN = false; F f;
    __device__ __forceinline__ void operator()(const f32x4 (&acc)[2][2][4][2], const Unit& u, int wr, int wc, int fr, int fq) const {
        const int row0 = u.pm * BM + wr * 64 + fr, col0 = u.pn * BM + wc * 32 + 8 * fq;
        typename F::Col cg[2][2];
#pragma unroll
        for (int bj = 0; bj < 2; ++bj)
#pragma unroll
            for (int n = 0; n < 2; ++n) cg[bj][n] = f.col(u.pm * BM, col0 + bj * HALF + n * 4);
        if constexpr (F::ROWLOAD) {
            f32x4 xv[2][2][4];
#pragma unroll
            for (int r = 0; r < 2; ++r)
#pragma unroll
                for (int c = 0; c < 4; ++c) xv[0][r][c] = f.rowload(row0 + r * 16, col0 + (c >> 1) * HALF + (c & 1) * 4);
#pragma unroll
            for (int b = 0; b < 4; ++b) {
                if (b + 1 < 4) {
#pragma unroll
                    for (int r = 0; r < 2; ++r)
#pragma unroll
                        for (int c = 0; c < 4; ++c) xv[(b + 1) & 1][r][c] = f.rowload(row0 + ((b + 1) >> 1) * HALF + (((b + 1) & 1) * 2 + r) * 16, col0 + (c >> 1) * HALF + (c & 1) * 4);
                }
#pragma unroll
                for (int r = 0; r < 2; ++r)
#pragma unroll
                    for (int bj = 0; bj < 2; ++bj) { const int ai = b >> 1, m = (b & 1) * 2 + r;
                        f.apply8(row0 + ai * HALF + m * 16, col0 + bj * HALF, acc[ai][bj][m][0], acc[ai][bj][m][1], cg[bj][0], cg[bj][1], xv[b & 1][r][bj * 2], xv[b & 1][r][bj * 2 + 1]); }
            }
        } else {
#pragma unroll
            for (int ai = 0; ai < 2; ++ai)
#pragma unroll
                for (int m = 0; m < 4; ++m)
#pragma unroll
                    for (int bj = 0; bj < 2; ++bj) f.apply8(row0 + ai * HALF + m * 16, col0 + bj * HALF, acc[ai][bj][m][0], acc[ai][bj][m][1], cg[bj][0], cg[bj][1]);
        } } };
template <class F> struct EpiPairEl { static constexpr bool PERM = true, AFTER_DRAIN = false; F f;
    __device__ __forceinline__ void operator()(const f32x4 (&acc)[2][2][4][2], const Unit& u, int wr, int wc, int fr, int fq) const {
        const int row0 = u.pm * BM + wr * 64 + fr, hc0 = u.pn * HALF + wc * 32 + 8 * fq;
        typename F::Col cg[2]; typename F::Row rw[2][4];
#pragma unroll
        for (int n = 0; n < 2; ++n) cg[n] = f.col(hc0 + n * 4);
#pragma unroll
        for (int ai = 0; ai < 2; ++ai)
#pragma unroll
            for (int m = 0; m < 4; ++m) rw[ai][m] = f.rowv(row0 + ai * HALF + m * 16);
#pragma unroll
        for (int ai = 0; ai < 2; ++ai)
#pragma unroll
            for (int m = 0; m < 4; ++m) f.pair8(row0 + ai * HALF + m * 16, hc0, acc[ai][0][m][0], acc[ai][1][m][0], acc[ai][0][m][1], acc[ai][1][m][1], cg[0], cg[1], rw[ai][m]); } };

typedef int i32x8 __attribute__((ext_vector_type(8)));
template <int QM> __device__ __forceinline__ void mma_block(f32x4 (&acc)[4][2], const bf16x8 (&At)[4][2], const bf16x8 (&Bt)[2][2], const int wsc) {
    __builtin_amdgcn_s_setprio(1);
    if constexpr (QM == 2) {
        typedef int i32x4m __attribute__((ext_vector_type(4)));
#pragma unroll
        for (int m = 0; m < 4; ++m)
#pragma unroll
            for (int n = 0; n < 2; ++n)
#pragma unroll
                for (int k = 0; k < 2; ++k) acc[m][n] = __builtin_bit_cast(f32x4, __builtin_amdgcn_mfma_i32_16x16x64_i8(__builtin_bit_cast(i32x4m, Bt[n][k]), __builtin_bit_cast(i32x4m, At[m][k]), __builtin_bit_cast(i32x4m, acc[m][n]), 0, 0, 0));
#pragma unroll
        for (int m = 0; m < 4; ++m) asm volatile("" : "+v"(acc[m][0]), "+v"(acc[m][1]));
    } else if constexpr (QM == 1) {
#pragma unroll
        for (int m = 0; m < 4; ++m) { const u32x4 a0 = __builtin_bit_cast(u32x4, At[m][0]), a1 = __builtin_bit_cast(u32x4, At[m][1]);
            const i32x8 a8 = {(int)a0.x, (int)a0.y, (int)a0.z, (int)a0.w, (int)a1.x, (int)a1.y, (int)a1.z, (int)a1.w};
#pragma unroll
            for (int n = 0; n < 2; ++n) { const u32x4 b0 = __builtin_bit_cast(u32x4, Bt[n][0]), b1 = __builtin_bit_cast(u32x4, Bt[n][1]);
                const i32x8 b8 = {(int)b0.x, (int)b0.y, (int)b0.z, (int)b0.w, (int)b1.x, (int)b1.y, (int)b1.z, (int)b1.w};
                acc[m][n] = __builtin_amdgcn_mfma_scale_f32_16x16x128_f8f6f4(b8, a8, acc[m][n], 0, 0, 0, wsc, 0, 127); } }
#pragma unroll
        for (int m = 0; m < 4; ++m) asm volatile("" : "+v"(acc[m][0]), "+v"(acc[m][1]));
    } else {
#pragma unroll
        for (int m = 0; m < 4; ++m)
#pragma unroll
            for (int n = 0; n < 2; ++n)
#pragma unroll
                for (int k = 0; k < 2; ++k) acc[m][n] = __builtin_amdgcn_mfma_f32_16x16x32_bf16(Bt[n][k], At[m][k], acc[m][n], 0, 0, 0);
    }
    __builtin_amdgcn_s_setprio(0);
}
template <class Epi, class Sched, bool ALIGN_EPI = true, bool SP2 = true, int QM = 0>
__device__ __forceinline__ void gemm_phase(PG8_LAS unsigned char* lds, const int K, const int lda, const int ldb, const size_t kstepA, const Sched& S, const Epi& E, const int wsc = 127) {
    const int tid_ = opaque_tid();
    const int tid = tid_, wid = __builtin_amdgcn_readfirstlane(tid >> 6), lane = tid & 63, wr = wid >> 2, wc = wid & 3, fr = lane & 15, fq = lane >> 4;
    const int nt = K / BK;
    unsigned voffA[2], voffB[2];
#pragma unroll
    for (int i = 0; i < 2; ++i) { int R, C; stage_rc(tid * 16 + i * 8192, R, C); const int Rb = Epi::PERM ? ((R & ~31) + perm32(R & 31)) : R;
        voffA[i] = (unsigned)(R * lda + C) * 2u; voffB[i] = (unsigned)(Rb * ldb + C) * 2u; }
    const size_t kstepB = (size_t)(BK * 2);
    const size_t hstepA = (size_t)HALF * lda * 2, hstepB = (size_t)HALF * ldb * 2;
    const unsigned ldsw = (unsigned)wid * 1024u;
    int aoffk[2], boffk[2];
#pragma unroll
    for (int k = 0; k < 2; ++k) { const int col = (QM == 1) ? ((fq >> 1) * 32 + (fq & 1) * 16 + 8 * k) : (k * 32 + fq * 8); aoffk[k] = lds_byte(wr * 64 + fr, col); boffk[k] = lds_byte(wc * 32 + fr, col); }
#define PG8_SA(b, h) (((b) * 2 + (h)) * HTB)
#define PG8_SB(b, h) ((4 + (b) * 2 + (h)) * HTB)
#define PG8_STAGE(bufoff, gbase, voff) do { _Pragma("unroll") for (int _i = 0; _i < 2; ++_i) \
        __builtin_amdgcn_global_load_lds((const unsigned*)((const char*)(gbase) + (voff)[_i]), (PG8_LAS unsigned*)(lds + (bufoff) + ldsw + _i * 8192), 16, 0, 0); } while (0)
#define PG8_LDA(dst, b, h) do { _Pragma("unroll") for (int m = 0; m < 4; ++m) _Pragma("unroll") for (int k = 0; k < 2; ++k) dst[m][k] = *(const PG8_LAS bf16x8*)(lds + PG8_SA(b, h) + ((QM == 1) ? aoffk[k] : aoffk[0] + k * 1024) + m * 2048); } while (0)
#define PG8_LDB(dst, b, h) do { _Pragma("unroll") for (int n = 0; n < 2; ++n) _Pragma("unroll") for (int k = 0; k < 2; ++k) dst[n][k] = *(const PG8_LAS bf16x8*)(lds + PG8_SB(b, h) + ((QM == 1) ? boffk[k] : boffk[0] + k * 1024) + n * 2048); } while (0)
#define PG8_MMA(ai, bj, At, Bt) mma_block<QM>(acc[ai][bj], At, Bt, wsc)
#define PG8_WAIT_V(n) asm volatile("s_waitcnt vmcnt(" #n ")" ::: "memory")
#define PG8_WAIT_L(n) asm volatile("s_waitcnt lgkmcnt(" #n ")" ::: "memory")
#define PG8_BAR __builtin_amdgcn_s_barrier()
#define PG8_SCHED __builtin_amdgcn_sched_barrier(0)
    Unit cur, nxt; int ui = 0;
    if (!S.next(0, cur)) return;
    f32x4 acc[2][2][4][2];
#pragma unroll
    for (int a = 0; a < 2; ++a)
#pragma unroll
        for (int b = 0; b < 2; ++b)
#pragma unroll
            for (int m = 0; m < 4; ++m)
#pragma unroll
                for (int n = 0; n < 2; ++n) acc[a][b][m][n] = (f32x4){0.f, 0.f, 0.f, 0.f};
    bf16x8 At[4][2], B0[2][2], B1[2][2];
    const char* cA = S.a_ptr(cur); const char* cB = S.b_ptr(cur);
    if constexpr (SP2) {
        PG8_STAGE(PG8_SB(0, 0), cB, voffB); PG8_STAGE(PG8_SB(0, 1), cB + hstepB, voffB); PG8_STAGE(PG8_SA(0, 0), cA, voffA); PG8_STAGE(PG8_SA(0, 1), cA + hstepA, voffA);
        if (wr == 1) PG8_BAR;
        PG8_WAIT_V(2); PG8_BAR;
        PG8_STAGE(PG8_SB(1, 0), cB + kstepB, voffB); PG8_STAGE(PG8_SA(1, 0), cA + kstepA, voffA); PG8_STAGE(PG8_SB(1, 1), cB + hstepB + kstepB, voffB);
        PG8_WAIT_V(6); PG8_BAR;
    } else {
        PG8_STAGE(PG8_SB(0, 0), cB, voffB); PG8_STAGE(PG8_SA(0, 0), cA, voffA); PG8_STAGE(PG8_SB(0, 1), cB + hstepB, voffB); PG8_STAGE(PG8_SA(0, 1), cA + hstepA, voffA);
        if (wr == 1) PG8_BAR;
        PG8_WAIT_V(4); PG8_BAR;
        PG8_STAGE(PG8_SB(1, 0), cB + kstepB, voffB); PG8_STAGE(PG8_SA(1, 0), cA + kstepA, voffA); PG8_STAGE(PG8_SB(1, 1), cB + hstepB + kstepB, voffB);
        PG8_WAIT_V(6); PG8_BAR;
    }
    for (;;) {
        const bool has_next = S.next(ui + 1, nxt);
        const char* nA = has_next ? S.a_ptr(nxt) : cA; const char* nB = has_next ? S.b_ptr(nxt) : cB;
        for (int t = 0; t < nt; t += 2) {
            const bool last = (t == nt - 2);
            const char* a1 = cA + (size_t)(t + 1) * kstepA;
            const char* a2 = last ? nA : cA + (size_t)(t + 2) * kstepA; const char* b2 = last ? nB : cB + (size_t)(t + 2) * kstepB;
            const char* a3 = a2 + kstepA; const char* b3 = b2 + kstepB;
            if constexpr (SP2) {
            PG8_LDB(B0, 0, 0); PG8_LDB(B1, 0, 1); PG8_SCHED; PG8_LDA(At, 0, 0); PG8_STAGE(PG8_SA(1, 1), a1 + hstepA, voffA);
            PG8_WAIT_V(8); PG8_WAIT_L(0); PG8_BAR; PG8_MMA(0, 0, At, B0); PG8_MMA(0, 1, At, B1); PG8_BAR; PG8_SCHED;
            PG8_LDA(At, 0, 1); PG8_STAGE(PG8_SB(0, 0), b2, voffB); PG8_STAGE(PG8_SB(0, 1), b2 + hstepB, voffB); PG8_STAGE(PG8_SA(0, 0), a2, voffA);
            PG8_WAIT_V(8); PG8_WAIT_L(0); PG8_BAR; PG8_MMA(1, 0, At, B0); PG8_MMA(1, 1, At, B1); PG8_BAR; PG8_SCHED;
            PG8_LDB(B0, 1, 0); PG8_LDB(B1, 1, 1); PG8_SCHED; PG8_LDA(At, 1, 0); PG8_STAGE(PG8_SA(0, 1), a2 + hstepA, voffA);
            PG8_WAIT_V(8); PG8_WAIT_L(0); PG8_BAR; PG8_MMA(0, 0, At, B0); PG8_MMA(0, 1, At, B1); PG8_BAR; PG8_SCHED;
            PG8_LDA(At, 1, 1); PG8_STAGE(PG8_SB(1, 0), b3, voffB); PG8_STAGE(PG8_SB(1, 1), b3 + hstepB, voffB); PG8_STAGE(PG8_SA(1, 0), a3, voffA);
            PG8_WAIT_V(8); PG8_WAIT_L(0); PG8_BAR; PG8_MMA(1, 0, At, B0); PG8_MMA(1, 1, At, B1); PG8_BAR; PG8_SCHED;
            } else {
            PG8_LDB(B0, 0, 0); PG8_SCHED; PG8_LDA(At, 0, 0); PG8_STAGE(PG8_SA(1, 1), a1 + hstepA, voffA);
            PG8_WAIT_L(8); PG8_BAR; PG8_WAIT_L(0); PG8_MMA(0, 0, At, B0); PG8_BAR; PG8_SCHED;
            PG8_LDB(B1, 0, 1); PG8_STAGE(PG8_SB(0, 0), b2, voffB);
            PG8_BAR; PG8_WAIT_L(0); PG8_MMA(0, 1, At, B1); PG8_BAR;
            PG8_LDA(At, 0, 1); PG8_STAGE(PG8_SA(0, 0), a2, voffA);
            PG8_BAR; PG8_WAIT_L(0); PG8_MMA(1, 0, At, B0); PG8_BAR; PG8_SCHED;
            PG8_STAGE(PG8_SB(0, 1), b2 + hstepB, voffB);
            PG8_WAIT_V(6); PG8_BAR; PG8_MMA(1, 1, At, B1); PG8_BAR;
            PG8_LDB(B0, 1, 0); PG8_SCHED; PG8_LDA(At, 1, 0); PG8_STAGE(PG8_SA(0, 1), a2 + hstepA, voffA);
            PG8_WAIT_L(8); PG8_BAR; PG8_WAIT_L(0); PG8_MMA(0, 0, At, B0); PG8_BAR; PG8_SCHED;
            PG8_LDB(B1, 1, 1); PG8_STAGE(PG8_SB(1, 0), b3, voffB);
            PG8_BAR; PG8_WAIT_L(0); PG8_MMA(0, 1, At, B1); PG8_BAR;
            PG8_LDA(At, 1, 1); PG8_STAGE(PG8_SA(1, 0), a3, voffA);
            PG8_BAR; PG8_WAIT_L(0); PG8_MMA(1, 0, At, B0); PG8_BAR; PG8_SCHED;
            PG8_STAGE(PG8_SB(1, 1), b3 + hstepB, voffB);
            PG8_WAIT_V(6); PG8_BAR; PG8_MMA(1, 1, At, B1); PG8_BAR;
            }
        }
        if constexpr (ALIGN_EPI) { if (wr == 0) PG8_BAR; }
        if constexpr (!Epi::AFTER_DRAIN) { E(acc, cur, wr, wc, fr, fq); }
        if (!has_next) break;
#pragma unroll
        for (int a = 0; a < 2; ++a)
#pragma unroll
            for (int b = 0; b < 2; ++b)
#pragma unroll
                for (int m = 0; m < 4; ++m)
#pragma unroll
                    for (int n = 0; n < 2; ++n) acc[a][b][m][n] = (f32x4){0.f, 0.f, 0.f, 0.f};
        cur = nxt; cA = nA; cB = nB; ++ui;
        if constexpr (ALIGN_EPI) { if (wr == 1) PG8_BAR; }
    }
    PG8_WAIT_V(0);
    if constexpr (!ALIGN_EPI) { if (wr == 0) PG8_BAR; }
    PG8_BAR;
    if constexpr (Epi::AFTER_DRAIN) { E.fused(acc, cur, wr, wc, fr, fq, lds, wid, lane); }
#undef PG8_SA
#undef PG8_SB
#undef PG8_STAGE
#undef PG8_LDA
#undef PG8_LDB
#undef PG8_MMA
#undef PG8_WAIT_V
#undef PG8_WAIT_L
#undef PG8_BAR
#undef PG8_SCHED
}
}

__device__ __forceinline__ void phase_headnorm(const Params& p, LAS unsigned char* lds) {
    const int tid = opaque_tid(), lane = tid & 63, wave = tid >> 6;
    LAS int* chunk = (LAS int*)(lds + 131072 - 64);
    bf16_t* Q = (bf16_t*)(p.ws + WS_Q); bf16_t* KVB = (bf16_t*)(p.ws + WS_KVB);
    float qg[16], kg[8];
#pragma unroll
    for (int i = 0; i < 16; ++i) qg[i] = p.q_gain[(lane & 3) * 16 + i] * (0.125f * 1.4426950408889634f);
    const int kr = lane >> 5;
#pragma unroll
    for (int i = 0; i < 8; ++i) kg[i] = p.k_gain[(1 + kr) * 64 + (lane & 7) * 8 + i];
    for (;;) {
      if (tid == 0) *chunk = (int)atomicAdd((unsigned*)(p.ws + WS_CTL) + CW_HN, 1u);
      __syncthreads();
      const int c0 = *chunk;
      __syncthreads();
      if (c0 >= T / 128) break;
      for (int r = c0 * 128 + wave * 16; r < c0 * 128 + wave * 16 + 16; ++r) {
        {
            u32x4* ptr = (u32x4*)(Q + (size_t)r * D + lane * 16); u32x4 w0 = ptr[0], w1 = ptr[1];
            float v[16]; const unsigned ww[8] = {w0.x, w0.y, w0.z, w0.w, w1.x, w1.y, w1.z, w1.w}; float s = 0.f;
#pragma unroll
            for (int i = 0; i < 8; ++i) { v[2 * i] = bflo(ww[i]); v[2 * i + 1] = bfhi(ww[i]); s += v[2 * i] * v[2 * i] + v[2 * i + 1] * v[2 * i + 1]; }
            s += __shfl_xor(s, 1); s += __shfl_xor(s, 2);
            const float rstd = 1.f / sqrtf(s * (1.f / 64.f) + EPS);
            unsigned o[8];
#pragma unroll
            for (int i = 0; i < 8; ++i) o[i] = cvt_pk_bf16(v[2 * i] * rstd * qg[2 * i], v[2 * i + 1] * rstd * qg[2 * i + 1]);
            ptr[0] = (u32x4){o[0], o[1], o[2], o[3]}; ptr[1] = (u32x4){o[4], o[5], o[6], o[7]};
        }
        {
            const u32x4* ptr = (const u32x4*)(KVB + (size_t)r * NKV + (kr ? 1024 : 512) + (lane & 31) * 8); const u32x4 w0 = ptr[0];
            float v[8]; const unsigned ww[4] = {w0.x, w0.y, w0.z, w0.w}; float s = 0.f;
#pragma unroll
            for (int i = 0; i < 4; ++i) { v[2 * i] = bflo(ww[i]); v[2 * i + 1] = bfhi(ww[i]); s += v[2 * i] * v[2 * i] + v[2 * i + 1] * v[2 * i + 1]; }
            s += __shfl_xor(s, 1); s += __shfl_xor(s, 2); s += __shfl_xor(s, 4);
            const float rstd = 1.f / sqrtf(s * (1.f / 64.f) + EPS);
            unsigned o[4];
#pragma unroll
            for (int i = 0; i < 4; ++i) o[i] = cvt_pk_bf16(v[2 * i] * rstd * kg[2 * i], v[2 * i + 1] * rstd * kg[2 * i + 1]);
            const int b = r >> 13, t = r & (S - 1), hg = (lane & 31) >> 3, c = lane & 7;
            {
                bf16_t* dst = (bf16_t*)(p.ws + (kr ? WS_KWB : WS_KSB)) + ((size_t)((b * 4 + hg) * 128 + (t >> 6)) * 8 + c) * 512 + (t & 63) * 8;
                *(u32x4*)dst = (u32x4){o[0], o[1], o[2], o[3]};
            }
        }
      }
    }
}

__device__ __forceinline__ void phase_cmp2(const Params& p, LAS unsigned char* lds) {
    const int tid = opaque_tid(), lane = tid & 63, wave = tid >> 6;
    const int gw = blockIdx.x * NWAVE + wave, NGW = gridDim.x * NWAVE;
    const bf16_t* CMPH = (const bf16_t*)(p.ws + WS_CMPH);
    LAS float* w2l = (LAS float*)lds;
    for (int kv = 0; kv < 2; ++kv) {
        const float* w2 = kv ? p.cmp_v_w2 : p.cmp_k_w2;
        for (int i = tid; i < 256 * 64 / 4; i += NTHR) ((LAS f32x4*)w2l)[i] = ((const f32x4*)w2)[i];
        __syncthreads();
        for (int it = gw * 2; it < 4 * 2048; it += NGW * 2) {
            float hv[2][4], acc[2] = {0.f, 0.f};
#pragma unroll
            for (int rr = 0; rr < 2; ++rr) { const u32x2 w = *(const u32x2*)(CMPH + (size_t)(kv * 8192 + it + rr) * 256 + 4 * lane); hv[rr][0] = bflo(w.x); hv[rr][1] = bfhi(w.x); hv[rr][2] = bflo(w.y); hv[rr][3] = bfhi(w.y); }
#pragma unroll 4
            for (int kk = 0; kk < 64; ++kk)
#pragma unroll
                for (int c = 0; c < 4; ++c) { const float wv = w2l[(4 * kk + c) * 64 + lane];
                    acc[0] += readlane_f(hv[0][c], kk) * wv; acc[1] += readlane_f(hv[1][c], kk) * wv; }
#pragma unroll
            for (int rr = 0; rr < 2; ++rr) {
                const int row = it + rr, g = (row >> 11) & 3, r2 = row & 2047, b = r2 >> 9, n = r2 & 511; float a = n == NC - 1 ? 0.f : acc[rr];
                if (kv == 0) { const float ss = wave_sum(a * a); a = a * (1.f / sqrtf(ss * (1.f / 64.f) + EPS)) * p.k_gain[lane]; }
                const size_t blk0 = (size_t)((b * 4 + g) * 8 + (n >> 6)) * 4096;
                bf16_t* o = kv ? (bf16_t*)(p.ws + WS_VC) + blk0 + ((n & 63) >> 3) * 512 + lane * 8 + (n & 7)
                               : (bf16_t*)(p.ws + WS_KC) + blk0 + (lane >> 3) * 512 + (n & 63) * 8 + (lane & 7);
                *o = (bf16_t)(cvt_pk_bf16(a, 0.f) & 0xffffu);
            }
        }
        __syncthreads();
    }
}

__device__ __forceinline__ void phase_vtrans(const Params& p, LAS unsigned char* lds) {
    const int tid = opaque_tid(), lane = tid & 63, wave = tid >> 6;
    const int gw = blockIdx.x * NWAVE + wave, NGW = gridDim.x * NWAVE;
    LAS unsigned short* tile = (LAS unsigned short*)(lds + wave * 8448);
    const bf16_t* KVB = (const bf16_t*)(p.ws + WS_KVB);
    LAS int* chunk = (LAS int*)(lds + 131072 - 64);
    for (;;) {
        if (tid == 0) *chunk = (int)atomicAdd((unsigned*)(p.ws + WS_CTL) + CW_VT, 1u);
        __syncthreads();
        const int c0 = *chunk;
        __syncthreads();
        if (c0 >= 2 * 16 * 128 / NWAVE) break;
        const int u = c0 * NWAVE + wave;
        const int which = u >> 11, bg = (u >> 7) & 15, tt = u & 127, b = bg >> 2, g = bg & 3, t0 = tt * 64;
        const u32x4* src = (const u32x4*)(KVB + (size_t)(b * S + t0 + lane) * NKV + (which ? 1280 : 768) + g * 64);
#pragma unroll
        for (int i = 0; i < 8; ++i) { const u32x4 v = src[i]; LAS unsigned* tp = (LAS unsigned*)(tile + lane * 66 + 8 * i); tp[0] = v.x; tp[1] = v.y; tp[2] = v.z; tp[3] = v.w; }
        asm volatile("s_waitcnt lgkmcnt(0)" ::: "memory");
        {
            bf16_t* dst = (bf16_t*)(p.ws + (which ? WS_VWB : WS_VSB)) + (size_t)(bg * 128 + tt) * 4096 + lane * 8;
#pragma unroll
            for (int i = 0; i < 8; ++i) { unsigned w[4];
#pragma unroll
                for (int q = 0; q < 4; ++q) { const unsigned lo = tile[(8 * i + 2 * q) * 66 + lane], hi = tile[(8 * i + 2 * q + 1) * 66 + lane]; w[q] = lo | (hi << 16); }
                *(u32x4*)(dst + i * 512) = (u32x4){w[0], w[1], w[2], w[3]}; }
        }
        asm volatile("s_waitcnt lgkmcnt(0)" ::: "memory");
    }
}

typedef short s16x4 __attribute__((ext_vector_type(4)));
__device__ __forceinline__ f32x4 mfma4(s16x4 a, s16x4 b, f32x4 c) { return __builtin_amdgcn_mfma_f32_4x4x4bf16_1k(a, b, c, 0, 0, 0); }
__device__ __forceinline__ s16x4 mk4(unsigned lo, unsigned hi) { const u32x2 t = {lo, hi}; return __builtin_bit_cast(s16x4, t); }
__device__ __forceinline__ f32x4 qk64(const bf16_t* krow, const s16x4 (&qf)[16]) {
    const u32x4* kp = (const u32x4*)krow; u32x4 kr[8];
#pragma unroll
    for (int i = 0; i < 8; ++i) kr[i] = kp[i];
    f32x4 s = {0.f, 0.f, 0.f, 0.f};
#pragma unroll
    for (int c = 0; c < 8; ++c) { s = mfma4(mk4(kr[c].x, kr[c].y), qf[2 * c], s); s = mfma4(mk4(kr[c].z, kr[c].w), qf[2 * c + 1], s); }
    return s;
}
__device__ __forceinline__ void pv64(f32x4& o, const f32x4 e, const bf16_t* vtrow, LAS u32x2* stage, int lane) {
    const u32x4* vp = (const u32x4*)vtrow; u32x4 vr[8];
#pragma unroll
    for (int i = 0; i < 8; ++i) vr[i] = vp[i];
    u32x2 pk; pk.x = cvt_pk_bf16(e.x, e.y); pk.y = cvt_pk_bf16(e.z, e.w);
    stage[lane] = pk;
#pragma unroll
    for (int st = 0; st < 16; ++st) { const u32x2 a = stage[4 * st + (lane & 3)]; const u32x4 v = vr[st >> 1];
        o = mfma4(mk4(a.x, a.y), (st & 1) ? mk4(v.z, v.w) : mk4(v.x, v.y), o); }
}
__device__ __forceinline__ float quadx_sum(float v) { v += __shfl_xor(v, 4); v += __shfl_xor(v, 8); v += __shfl_xor(v, 16); v += __shfl_xor(v, 32); return v; }

constexpr int HBN = 800;
constexpr int ATT_HBD = 0, ATT_MH = 51200, ATT_PSLC = 53248, ATT_STAGE = 118784;
__device__ __forceinline__ void attn_tables(const Params& p, LAS unsigned char* lds) {
    const int tid = opaque_tid();
    LAS float* hbd = (LAS float*)(lds + ATT_HBD); LAS float* mh = (LAS float*)(lds + ATT_MH);
    for (int i = tid; i < 16 * HBN; i += NTHR) { const int hd = i / HBN, d = i - hd * HBN; const float v = p.rel_bias[rel_bucket(d) * NH + hd] * 1.4426950408889634f; hbd[i] = v; if (blockIdx.x == 0) ((float*)(p.ws + WS_HBG))[i] = v; }
    if (tid < 16) { float qg = 0.f, kg = 0.f, bm = -3.0e38f;
        for (int i = 0; i < 64; ++i) qg = fmaxf(qg, fabsf(p.q_gain[i]));
        for (int i = 0; i < 192; ++i) kg = fmaxf(kg, fabsf(p.k_gain[i]));
        for (int i = 0; i < 32; ++i) bm = fmaxf(bm, p.rel_bias[i * NH + tid]);
        const float mv = (qg * kg * 8.f * 1.02f + bm) * 1.4426950408889634f; mh[tid] = mv; if (blockIdx.x == 0) ((float*)(p.ws + WS_MHG))[tid] = mv; }
    __syncthreads();
}
typedef float f32x16 __attribute__((ext_vector_type(16)));
__device__ __forceinline__ f32x16 mfma32(bf16x8 a, bf16x8 b, f32x16 c) { return __builtin_amdgcn_mfma_f32_32x32x16_bf16(a, b, c, 0, 0, 0); }
struct DFrag { bf16x8 ka[4]; bf16x8 va[2][2]; };
__device__ __forceinline__ void dense_load_k(bf16x8 (&ka)[4], const bf16_t* KB, int kt, int l31, int h) {
    const int blk = kt >> 6, hh = (kt >> 5) & 1;
    const bf16_t* kb = KB + (size_t)blk * 4096 + (32 * hh + l31) * 8;
#pragma unroll
    for (int ks = 0; ks < 4; ++ks) ka[ks] = *(const bf16x8*)(kb + (2 * ks + h) * 512);
}
__device__ __forceinline__ void dense_load_v(bf16x8 (&va)[2][2], const bf16_t* VB, int kt, int l31, int h) {
    const int blk = kt >> 6, hh = (kt >> 5) & 1;
    const bf16_t* vb = VB + (size_t)blk * 4096 + l31 * 8 + 4 * h;
#pragma unroll
    for (int dt = 0; dt < 2; ++dt)
#pragma unroll
        for (int st = 0; st < 2; ++st) { const bf16_t* q0 = vb + (4 * hh + 2 * st) * 512 + dt * 256; const u32x2 lo = *(const u32x2*)q0, hi = *(const u32x2*)(q0 + 512);
            const u32x4 w = {lo.x, lo.y, hi.x, hi.y}; va[dt][st] = __builtin_bit_cast(bf16x8, w); }
}
__device__ __forceinline__ f32x16 dense_scores(const DFrag& f, const bf16x8 (&q)[4]) {
    f32x16 sacc;
#pragma unroll
    for (int i = 0; i < 16; ++i) sacc[i] = 0.f;
#pragma unroll
    for (int ks = 0; ks < 4; ++ks) sacc = mfma32(f.ka[ks], q[ks], sacc);
    return sacc;
}
__device__ __forceinline__ void dense_pv(f32x16 (&O)[2], const DFrag& f, const float (&ev)[16]) {
    bf16x8 pb[2];
#pragma unroll
    for (int st = 0; st < 2; ++st) { const u32x4 w = {cvt_pk_bf16(ev[8 * st], ev[8 * st + 1]), cvt_pk_bf16(ev[8 * st + 2], ev[8 * st + 3]), cvt_pk_bf16(ev[8 * st + 4], ev[8 * st + 5]), cvt_pk_bf16(ev[8 * st + 6], ev[8 * st + 7])};
        pb[st] = __builtin_bit_cast(bf16x8, w); }
#pragma unroll
    for (int dt = 0; dt < 2; ++dt)
#pragma unroll
        for (int st = 0; st < 2; ++st) O[dt] = mfma32(f.va[dt][st], pb[st], O[dt]);
}
__device__ __forceinline__ void phase_dense(const Params& p, LAS unsigned char* lds, bf16_t* OW) {
    const int tid = opaque_tid(), lane0 = tid & 63, wave = tid >> 6;
    const LAS float* hbd = (const LAS float*)(lds + ATT_HBD); const LAS float* mh = (const LAS float*)(lds + ATT_MH);
    LAS float* pslc = (LAS float*)(lds + ATT_PSLC) + wave * 2048;
    const bf16_t* Q = (const bf16_t*)(p.ws + WS_Q); const float* GATE = (const float*)(p.ws + WS_GATE);
    short* SEL = (short*)(p.ws + WS_SEL);
    const int Gn = gridDim.x, vcu = (Gn % 8 == 0) ? (blockIdx.x % 8) * (Gn / 8) + blockIdx.x / 8 : blockIdx.x;
    for (int u = vcu * NWAVE + wave; u < T * G / 16; u += Gn * NWAVE) {
        int lane = lane0; asm volatile("" : "+v"(lane));
        const int l31 = lane & 31, h = lane >> 5;
        const int bg = u >> 9, t0 = (((u & 511) + 128 * (u >> 11)) & 511) * 16, b = bg >> 2, g = bg & 3, head = 4 * g + (lane & 3);
        const LAS float* hb = hbd + head * HBN; const float mhv = mh[head];
        int tok[2]; bf16x8 qf[2][4];
#pragma unroll
        for (int r = 0; r < 2; ++r) { tok[r] = t0 + 8 * r + (l31 >> 2); const bf16_t* qp = Q + (size_t)(b * S + tok[r]) * D + head * 64 + 8 * h;
#pragma unroll
            for (int ks = 0; ks < 4; ++ks) qf[r][ks] = *(const bf16x8*)(qp + 16 * ks); }
        f32x16 O[2][2];
#pragma unroll
        for (int r = 0; r < 2; ++r)
#pragma unroll
            for (int dt = 0; dt < 2; ++dt)
#pragma unroll
                for (int q = 0; q < 16; ++q) O[r][dt][q] = 0.f;
        DFrag cur; bf16x8 nxtk[4];
        {
            const bf16_t* KB = (const bf16_t*)(p.ws + WS_KWB) + (size_t)bg * 128 * 4096; const bf16_t* VB = (const bf16_t*)(p.ws + WS_VWB) + (size_t)bg * 128 * 4096;
            float lw[2] = {0.f, 0.f};
            const int lo = t0 - (WIN - 1) > 0 ? t0 - (WIN - 1) : 0, kt_last = t0 & ~31;
            dense_load_k(cur.ka, KB, lo & ~31, l31, h);
            for (int kt = lo & ~31; kt <= kt_last; kt += 32) {
                dense_load_v(cur.va, VB, kt, l31, h);
                dense_load_k(nxtk, KB, kt + 32 <= kt_last ? kt + 32 : kt_last, l31, h);
                __builtin_amdgcn_sched_barrier(0);
#pragma unroll
                for (int r = 0; r < 2; ++r) {
                    const f32x16 sacc = dense_scores(cur, qf[r]);
                    const int dbase = tok[r] - kt - 4 * h; float ev[16];
                    if (kt + 31 <= t0 + 8 * r && kt >= t0 + 8 * r + 7 - (WIN - 1)) {
                        const LAS float* hbp = hb + dbase;
#pragma unroll
                        for (int q = 0; q < 16; ++q) { const float e = __builtin_amdgcn_exp2f(sacc[q] + hbp[-((q & 3) + 8 * (q >> 2))] - mhv); ev[q] = e; lw[r] += e; }
                    } else {
#pragma unroll
                    for (int q = 0; q < 16; ++q) { const int dist = dbase - ((q & 3) + 8 * (q >> 2)); const bool ok = (unsigned)dist < (unsigned)WIN;
                        const float e0 = __builtin_amdgcn_exp2f(sacc[q] + hb[ok ? dist : 0] - mhv); const float e = ok ? e0 : 0.f; ev[q] = e; lw[r] += e; }
                    }
                    dense_pv(O[r], cur, ev);
                }
#pragma unroll
                for (int ks = 0; ks < 4; ++ks) cur.ka[ks] = nxtk[ks];
            }
#pragma unroll
            for (int r = 0; r < 2; ++r) { const float l = lw[r] + __shfl_xor(lw[r], 32); int tk = tok[r]; asm volatile("" : "+v"(tk)); const float* gp = GATE + (size_t)(b * S + tk) * 48 + head * 3;
                const float sc = gp[2] / (l * gp[0]);
#pragma unroll
                for (int dt = 0; dt < 2; ++dt) O[r][dt] = O[r][dt] * sc; }
        }
        const int ncmax = t0 >> 4;
        {
            int l31c = l31, hc = h; asm volatile("" : "+v"(l31c), "+v"(hc));
            const bf16_t* KB = (const bf16_t*)(p.ws + WS_KC) + (size_t)bg * 8 * 4096; const bf16_t* VB = (const bf16_t*)(p.ws + WS_VC) + (size_t)bg * 8 * 4096;
            float lc[2] = {0.f, 0.f};
            const int kt_last = ncmax > 0 ? ((ncmax - 1) & ~31) : -32;
            if (ncmax > 0) {
                dense_load_k(cur.ka, KB, 0, l31c, hc);
                for (int kt = 0; kt <= kt_last; kt += 32) {
                    dense_load_k(nxtk, KB, kt + 32 <= kt_last ? kt + 32 : kt_last, l31c, hc);
                    __builtin_amdgcn_sched_barrier(0);
#pragma unroll
                    for (int r = 0; r < 2; ++r) {
                        const f32x16 sacc = dense_scores(cur, qf[r]);
                        if (t0 - 31 - 16 * (kt + 31) >= HBN - 1) {
                            const float bfar = hb[HBN - 1] - mhv;
#pragma unroll
                            for (int q = 0; q < 16; ++q) lc[r] += __builtin_amdgcn_exp2f(sacc[q] + bfar);
                        } else {
                        const int dbase = tok[r] - 31 - 16 * (kt + 4 * hc);
#pragma unroll
                        for (int q = 0; q < 16; ++q) { const int dist = dbase - 16 * ((q & 3) + 8 * (q >> 2)); const int di = dist < 0 ? 0 : (dist > HBN - 1 ? HBN - 1 : dist);
                            const float e0 = __builtin_amdgcn_exp2f(sacc[q] + hb[di] - mhv); lc[r] += dist >= 0 ? e0 : 0.f; }
                        }
                    }
#pragma unroll
                    for (int ks = 0; ks < 4; ++ks) cur.ka[ks] = nxtk[ks];
                }
            }
            float linv[2];
#pragma unroll
            for (int r = 0; r < 2; ++r) { const float l = lc[r] + __shfl_xor(lc[r], 32); linv[r] = l > 0.f ? 1.f / l : 0.f; }
            { const f32x4 z = {0.f, 0.f, 0.f, 0.f};
#pragma unroll
              for (int i = 0; i < 8; ++i) *(LAS f32x4*)(pslc + (i * 64 + lane) * 4) = z; }
            if (ncmax > 0) {
                float carry[2] = {0.f, 0.f};
                dense_load_k(cur.ka, KB, 0, l31c, hc);
                for (int kt = 0; kt <= kt_last; kt += 32) {
                    dense_load_v(cur.va, VB, kt, l31c, hc);
                    dense_load_k(nxtk, KB, kt + 32 <= kt_last ? kt + 32 : kt_last, l31c, hc);
                    __builtin_amdgcn_sched_barrier(0);
#pragma unroll
                    for (int r = 0; r < 2; ++r) {
                        const f32x16 sacc = dense_scores(cur, qf[r]);
                        float pv[16];
                        const int dbase = tok[r] - 31 - 16 * (kt + 4 * hc);
#pragma unroll
                        for (int q = 0; q < 16; ++q) { const int dist = dbase - 16 * ((q & 3) + 8 * (q >> 2)); const int di = dist < 0 ? 0 : (dist > HBN - 1 ? HBN - 1 : dist);
                            const float e0 = __builtin_amdgcn_exp2f(sacc[q] + hb[di] - mhv); pv[q] = dist >= 0 ? e0 * linv[r] : 0.f; }
                        dense_pv(O[r], cur, pv);
#pragma unroll
                        for (int q = 0; q < 16; ++q) { pv[q] += __shfl_xor(pv[q], 1); pv[q] += __shfl_xor(pv[q], 2); }
                        float y[4];
#pragma unroll
                        for (int gq = 0; gq < 4; ++gq) y[gq] = __shfl_xor(pv[4 * gq + 3], 32);
#pragma unroll
                        for (int gq = 0; gq < 4; ++gq) { const float prevv = h ? y[gq] : (gq > 0 ? y[gq > 0 ? gq - 1 : 0] : carry[r]);
                            const float val = 2.f * ((pv[4 * gq] + pv[4 * gq + 1]) + pv[4 * gq + 2]) + pv[4 * gq + 3] + prevv;
                            if ((lane & 3) == 0) pslc[(8 * r + (l31c >> 2)) * 128 + (kt >> 2) + 2 * gq + hc] = val; }
                        carry[r] = y[3];
                    }
#pragma unroll
                    for (int ks = 0; ks < 4; ++ks) cur.ka[ks] = nxtk[ks];
                }
            }
        }
#pragma unroll
        for (int r = 0; r < 2; ++r) { int tk = tok[r]; asm volatile("" : "+v"(tk)); bf16_t* op = OW + (size_t)(b * S + tk) * D + head * 64 + 4 * h; const float gc = GATE[(size_t)(b * S + tk) * 48 + head * 3];
#pragma unroll
            for (int dt = 0; dt < 2; ++dt)
#pragma unroll
                for (int gq = 0; gq < 4; ++gq) { u32x2 w; w.x = cvt_pk_bf16(O[r][dt][4 * gq] * gc, O[r][dt][4 * gq + 1] * gc); w.y = cvt_pk_bf16(O[r][dt][4 * gq + 2] * gc, O[r][dt][4 * gq + 3] * gc);
                    *(u32x2*)(op + dt * 32 + 8 * gq) = w; } }
#pragma unroll 1
        for (int tl = 0; tl < 16; ++tl) {
            int ln = lane; asm volatile("" : "+v"(ln));
            const int t = t0 + tl, cur_b = t >> 6, j0 = ln, j1 = ln + 64;
            const float c0 = pslc[tl * 128 + j0], c1 = pslc[tl * 128 + j1];
            const bool f0 = (j0 == 0) || (j0 == cur_b) || (j0 == cur_b - 1), f1 = (j1 == cur_b) || (j1 == cur_b - 1);
            const bool v0 = j0 * 64 <= t, v1 = j1 * 64 <= t;
            const unsigned u0 = (v0 && !f0) ? __float_as_uint(c0) : 0u, u1 = (v1 && !f1) ? __float_as_uint(c1) : 0u;
            unsigned th = 1u;
            if (cur_b + 1 > NSEL) {
                th = 0u;
#pragma unroll 1
                for (int bit = 30; bit >= 0; --bit) {
                    const unsigned trial = th | (1u << bit);
                    const int cnt = __popcll(__ballot(u0 >= trial)) + __popcll(__ballot(u1 >= trial));
                    if (cnt >= NSEL - 3) { th = trial; if (cnt == NSEL - 3) break; }
                }
            }
            const bool s0 = f0 || (u0 >= th && u0 != 0u), s1 = f1 || (u1 >= th && u1 != 0u);
            const unsigned long long m0 = __ballot(s0), m1 = __ballot(s1), lt = (1ull << ln) - 1ull;
            const int p0 = __popcll(m0 & lt), p1 = __popcll(m0) + __popcll(m1 & lt);
            short* so = SEL + ((size_t)(b * S + t) * 4 + g) * NSEL;
            if (s0 && p0 < NSEL) so[p0] = (short)j0;
            if (s1 && p1 < NSEL) so[p1] = (short)j1;
        }
    }
}

constexpr int ST_ACC = 0, ST_LACC = 133120, ST_MASK = 135168, ST_LIST = 136192, ST_CTR = 138240, ST_HB4 = 138304;
__device__ __forceinline__ void lds_add_f64(unsigned addr, double v) { asm volatile("ds_add_f64 %0, %1" :: "v"(addr), "v"(v) : "memory"); }
__device__ __forceinline__ void phase_sel_tile(const Params& p, LAS unsigned char* lds, bf16_t* AO, const bf16_t* OW) {
    const int tid = opaque_tid(), lane = tid & 63, wave = tid >> 6, l31 = lane & 31, h = lane >> 5;
    LAS double* acc = (LAS double*)(lds + ST_ACC); LAS double* lacc = (LAS double*)(lds + ST_LACC);
    LAS unsigned* mask = (LAS unsigned*)(lds + ST_MASK); LAS int* list = (LAS int*)(lds + ST_LIST) + wave * 64; LAS int* ctr = (LAS int*)(lds + ST_CTR);
    const bf16_t* Q = (const bf16_t*)(p.ws + WS_Q); const float* GATE = (const float*)(p.ws + WS_GATE); const short* SEL = (const short*)(p.ws + WS_SEL);
    const int Gn = gridDim.x;
    for (int kk = 0, u = blockIdx.x; u < 16 * 128; u += Gn, ++kk) {
        const int bg = u >> 7, ti = u & 127, tt = (kk & 1) ? 127 - ti : ti, b = bg >> 2, g = bg & 3, t0 = tt * 64, cur = tt, nv = cur + 1 < NSEL ? cur + 1 : NSEL;
        for (int i = tid; i < ST_LIST / 16; i += NTHR) ((LAS u32x4*)lds)[i] = (u32x4){0u, 0u, 0u, 0u};
        if (tid == 0) *ctr = 0;
        { LAS float* hb4 = (LAS float*)(lds + ST_HB4); const float* hsrc = (const float*)(p.ws + WS_HBG) + 4 * g * HBN; for (int i = tid; i < 4 * HBN; i += NTHR) hb4[i] = hsrc[i]; }
        __syncthreads();
        { const int tl = tid >> 3; const short* sp = SEL + ((size_t)(b * S + t0 + tl) * 4 + g) * NSEL;
#pragma unroll
          for (int e = (tid & 7) * 2; e < (tid & 7) * 2 + 2; ++e) if (e < nv) { const int blk = sp[e]; __hip_atomic_fetch_or(mask + blk * 2 + (tl >> 5), 1u << (tl & 31), __ATOMIC_RELAXED, __HIP_MEMORY_SCOPE_WORKGROUP); } }
        __syncthreads();
        const int nf = cur >= 2 ? 3 : cur + 1, nitems = 2 * nf + (cur >= 3 ? cur - 2 : 0);
        const bf16_t* KB = (const bf16_t*)(p.ws + WS_KSB) + (size_t)bg * 128 * 4096; const bf16_t* VB = (const bf16_t*)(p.ws + WS_VSB) + (size_t)bg * 128 * 4096;
        const int hl = lane & 3, head = 4 * g + hl;
        const LAS float* hbg = (const LAS float*)(lds + ST_HB4) + hl * HBN; const float mhv = ((const float*)(p.ws + WS_MHG))[head], bfar = hbg[HBN - 1] - mhv;
        for (;;) {
            int it = 0; if (lane == 0) it = __hip_atomic_fetch_add(ctr, 1, __ATOMIC_RELAXED, __HIP_MEMORY_SCOPE_WORKGROUP);
            it = __builtin_amdgcn_readfirstlane(it);
            if (it >= nitems) break;
            int j, c_lo, c_hi;
            if (it < 2 * nf) { const int f = it >> 1; j = f == 0 ? cur : (f == 1 ? cur - 1 : 0); c_lo = (it & 1) * 4; c_hi = c_lo + 4; }
            else { j = it - 2 * nf + 1; c_lo = 0; c_hi = 8; }
            const unsigned mlo = (unsigned)__builtin_amdgcn_readfirstlane((int)mask[2 * j]), mhi = (unsigned)__builtin_amdgcn_readfirstlane((int)mask[2 * j + 1]);
            const unsigned long long m = ((unsigned long long)mhi << 32) | mlo; const int n = __popcll(m), nch = (n + 7) >> 3;
            if (c_hi > nch) c_hi = nch;
            if (c_lo >= c_hi) continue;
            if ((m >> lane) & 1ull) list[__popcll(m & ((1ull << lane) - 1ull))] = lane;
            DFrag fr0, fr1;
            dense_load_k(fr0.ka, KB, j * 64, l31, h); dense_load_v(fr0.va, VB, j * 64, l31, h);
            dense_load_k(fr1.ka, KB, j * 64 + 32, l31, h); dense_load_v(fr1.va, VB, j * 64 + 32, l31, h);
            bf16x8 qn[4];
            { const int slot = c_lo * 8 + (l31 >> 2); const int tokl = list[slot < n ? slot : n - 1]; const bf16_t* qp = Q + (size_t)(b * S + t0 + tokl) * D + head * 64 + 8 * h;
#pragma unroll
              for (int ks = 0; ks < 4; ++ks) qn[ks] = *(const bf16x8*)(qp + 16 * ks); }
            for (int c = c_lo; c < c_hi; ++c) {
                const int slot = c * 8 + (l31 >> 2); const bool valid = slot < n; const int tokl = list[valid ? slot : n - 1], tok = t0 + tokl;
                bf16x8 qf[4];
#pragma unroll
                for (int ks = 0; ks < 4; ++ks) qf[ks] = qn[ks];
                { const int sn = (c + 1 < c_hi ? c + 1 : c) * 8 + (l31 >> 2); const int tn = list[sn < n ? sn : n - 1]; const bf16_t* qp = Q + (size_t)(b * S + t0 + tn) * D + head * 64 + 8 * h;
#pragma unroll
                  for (int ks = 0; ks < 4; ++ks) qn[ks] = *(const bf16x8*)(qp + 16 * ks); }
                __builtin_amdgcn_sched_barrier(0);
                f32x16 O[2]; float ls = 0.f;
#pragma unroll
                for (int dt = 0; dt < 2; ++dt)
#pragma unroll
                    for (int q = 0; q < 16; ++q) O[dt][q] = 0.f;
#pragma unroll
                for (int half = 0; half < 2; ++half) {
                    const int kt = j * 64 + 32 * half; const DFrag& fr = half ? fr1 : fr0;
                    const f32x16 sacc = dense_scores(fr, qf); float ev[16];
                    if (t0 - kt - 31 >= HBN - 1) {
#pragma unroll
                        for (int q = 0; q < 16; ++q) { ev[q] = __builtin_amdgcn_exp2f(sacc[q] + bfar); ls += ev[q]; }
                    } else { const int dbase = tok - kt - 4 * h;
#pragma unroll
                        for (int q = 0; q < 16; ++q) { const int dist = dbase - ((q & 3) + 8 * (q >> 2)); const int di = dist < 0 ? 0 : (dist > HBN - 1 ? HBN - 1 : dist);
                            const float e0 = __builtin_amdgcn_exp2f(sacc[q] + hbg[di] - mhv); ev[q] = dist >= 0 ? e0 : 0.f; ls += ev[q]; } }
                    dense_pv(O, fr, ev);
                }
                const float lt = ls + __shfl_xor(ls, 32);
                if (valid) {
                    const unsigned a0 = (unsigned)(size_t)(acc + (tokl * 4 + hl) * 65 + 4 * h);
#pragma unroll
                    for (int dt = 0; dt < 2; ++dt)
#pragma unroll
                        for (int q = 0; q < 16; ++q) lds_add_f64(a0 + (dt * 32 + (q & 3) + 8 * (q >> 2)) * 8, (double)O[dt][q]);
                    if (h == 0) lds_add_f64((unsigned)(size_t)(lacc + tokl * 4 + hl), (double)lt);
                }
            }
        }
        __syncthreads();
        for (int r0 = wave * 32; r0 < wave * 32 + 32; r0 += 8) {
            float gv[8], ov[8];
#pragma unroll
            for (int i = 0; i < 8; ++i) { const int r = r0 + i, tokl = r >> 2, hd = r & 3; const size_t ur = (size_t)(b * S + t0 + tokl);
                gv[i] = GATE[ur * 48 + (4 * g + hd) * 3 + 1]; ov[i] = bf2f(OW[ur * D + (4 * g + hd) * 64 + lane]); }
#pragma unroll
            for (int i = 0; i < 8; ++i) { const int r = r0 + i, tokl = r >> 2, hd = r & 3; const size_t ur = (size_t)(b * S + t0 + tokl);
                const float o = (float)acc[r * 65 + lane] * (1.f / (float)lacc[r]) * gv[i] + ov[i];
                AO[ur * D + (4 * g + hd) * 64 + lane] = (bf16_t)(cvt_pk_bf16(o, 0.f) & 0xffffu); }
        }
        __syncthreads();
    }
}

__device__ __forceinline__ void moe_pstarts(const unsigned* ctl, int (&pst)[NE + 1]) {
    int a = 0;
#pragma unroll
    for (int e = 0; e < NE; ++e) { pst[e] = a; const int c = (int)ctl[CW_CNT + 64 * e]; a += (c + 511) / 512 * 512; }
    pst[NE] = a;
}
__device__ __forceinline__ void phase_moe_sort(const Params& p, LAS unsigned char* lds) {
    const int tid = opaque_tid(), lane = tid & 63, wave = tid >> 6;
    unsigned* ctl = (unsigned*)(p.ws + WS_CTL);
    const int* TOPE = (const int*)(p.ws + WS_TOPE); int* RPOS = (int*)(p.ws + WS_RPOS);
    const bf16_t* HB = (const bf16_t*)(p.ws + WS_HB); bf16_t* XS = (bf16_t*)(p.ws + WS_XS);
    LAS int* wcnt = (LAS int*)lds;
    LAS int* base = (LAS int*)(lds + 128);
    LAS int* posl = (LAS int*)(lds + 256);
    int pst[NE + 1]; moe_pstarts(ctl, pst);
    if (blockIdx.x == 0 && tid <= NE) ((int*)(ctl + 256))[tid] = pst[tid];
    for (int c0 = blockIdx.x * 256; c0 < 2 * T; c0 += gridDim.x * 256) {
        int e = 0, rank = 0;
        if (wave < 4) { e = TOPE[c0 + wave * 64 + lane];
#pragma unroll
            for (int q = 0; q < NE; ++q) { const unsigned long long m = __ballot(e == q); if (e == q) rank = __popcll(m & ((1ull << lane) - 1ull)); if (lane == 0) wcnt[wave * NE + q] = __popcll(m); } }
        __syncthreads();
        if (tid < NE) { const int n = wcnt[tid] + wcnt[NE + tid] + wcnt[2 * NE + tid] + wcnt[3 * NE + tid]; base[tid] = n ? (int)atomicAdd(ctl + CW_CUR + 64 * tid, (unsigned)n) : 0; }
        __syncthreads();
        if (wave < 4) { int off = 0;
            for (int w = 0; w < wave; ++w) off += wcnt[w * NE + e];
            const int pos = pst[e] + base[e] + off + rank; posl[wave * 64 + lane] = pos; RPOS[c0 + wave * 64 + lane] = pos; }
        __syncthreads();
        for (int j = wave * 32; j < wave * 32 + 32; j += 8) {
            u32x4 v0[8]; int ps[8];
#pragma unroll
            for (int q = 0; q < 8; ++q) { const int tk = (c0 + j + q) >> 1; ps[q] = posl[j + q]; v0[q] = *((const u32x4*)((const unsigned char*)HB + (size_t)tk * D) + lane); }
#pragma unroll
            for (int q = 0; q < 8; ++q) *((u32x4*)((unsigned char*)XS + (size_t)ps[q] * D) + lane) = v0[q];
        }
        __syncthreads();
    }
}
__device__ __forceinline__ void phase_combine(const Params& p) {
    const int tid = opaque_tid(), lane = tid & 63, wave = tid >> 6;
    const int gw = blockIdx.x * NWAVE + wave, NGW = gridDim.x * NWAVE;
    const float* TOPW = (const float*)(p.ws + WS_TOPW); const int* RPOS = (const int*)(p.ws + WS_RPOS);
    const bf16_t* Y = (const bf16_t*)(p.ws + WS_Y); const float* g2 = (const float*)(p.ws + WS_MODV) + (11 * 4) * D;
    for (int r = gw; r < T; r += NGW) {
        const int b = r >> 13; const int p0 = RPOS[2 * r], p1 = RPOS[2 * r + 1]; const float w0 = TOPW[2 * r], w1 = TOPW[2 * r + 1];
#pragma unroll
        for (int j = 0; j < 4; ++j) { const int c = 4 * lane + 256 * j;
            const u32x2 y0 = *(const u32x2*)(Y + (size_t)p0 * D + c), y1 = *(const u32x2*)(Y + (size_t)p1 * D + c);
            const f32x4 gv = *(const f32x4*)(g2 + b * D + c); f32x4 xv = *(const f32x4*)(p.out + (size_t)r * D + c);
            f32x4 f; f.x = w0 * bflo(y0.x) + w1 * bflo(y1.x); f.y = w0 * bfhi(y0.x) + w1 * bfhi(y1.x); f.z = w0 * bflo(y0.y) + w1 * bflo(y1.y); f.w = w0 * bfhi(y0.y) + w1 * bfhi(y1.y);
            *(f32x4*)(p.out + (size_t)r * D + c) = xv + gv * f; }
    }
}

#define XB_TMO      128
#define XB_XCNT(j)  (256  + 64 * (j))
#define XB_XSUB(j)  (1280 + 64 * (j))
#define XB_XGEN(j)  (2304 + 64 * (j))
#define XB_TOP      3328
#define XB_TOPGEN   3392
#define XCD_BAR_WORDS 3456
#define XB_SPIN_CAP (1u << 18)
__device__ __forceinline__ unsigned xb_ld(unsigned* p)              { return __hip_atomic_load(p, __ATOMIC_RELAXED, __HIP_MEMORY_SCOPE_AGENT); }
__device__ __forceinline__ unsigned xb_add(unsigned* p, unsigned v) { return __hip_atomic_fetch_add(p, v, __ATOMIC_RELAXED, __HIP_MEMORY_SCOPE_AGENT); }
__device__ __forceinline__ unsigned xb_xcc_id() { return (unsigned)__builtin_amdgcn_s_getreg((3 << 11) | 20) & 0xFu; }
#define XB_SPIN(cond, bar) do { unsigned _sp = 0; while (cond) { __builtin_amdgcn_s_sleep(1); \
    if ((++_sp & 255u) == 0u) { if (xb_ld(&(bar)[XB_TMO])) break; if (_sp > XB_SPIN_CAP) { atomicAdd(&(bar)[XB_TMO], 1u); break; } } } } while (0)
struct XcdBarrier { unsigned* bar; unsigned x; volatile LAS unsigned* st; };
__device__ __forceinline__ XcdBarrier xcd_barrier_post(unsigned* bar, volatile LAS unsigned* st) {
    XcdBarrier b; b.bar = bar; b.x = xb_xcc_id(); b.st = st;
    if (threadIdx.x == 0) (void)xb_add(&bar[XB_XCNT(b.x)], 1u);
    return b;
}
__device__ __forceinline__ void xcd_barrier_complete(unsigned* bar, unsigned x, unsigned& nloc, unsigned& nx) {
    const unsigned G_ = gridDim.x * gridDim.y * gridDim.z;
    unsigned sum, cnt, mine, sp = 0u;
    for (;;) {
        sum = 0u; cnt = 0u; mine = 0u;
#pragma unroll
        for (unsigned j = 0; j < 16; ++j) { const unsigned c = xb_ld(&bar[XB_XCNT(j)]); sum += c; cnt += (c > 0u) ? 1u : 0u; mine = (j == x) ? c : mine; }
        if (sum == G_) break;
        __builtin_amdgcn_s_sleep(1);
        if ((++sp & 255u) == 0u) { if (xb_ld(&bar[XB_TMO])) break; if (sp > XB_SPIN_CAP) { atomicAdd(&bar[XB_TMO], 1u); break; } }
    }
    nloc = mine > 0u ? mine : 1u; nx = cnt > 0u ? cnt : 1u;
}
__device__ __forceinline__ void xcd_barrier(const XcdBarrier& b) {
    asm volatile("s_waitcnt vmcnt(0)" ::: "memory");
    __syncthreads();
    if (threadIdx.x == 0) {
        unsigned* bar = b.bar;
        __builtin_amdgcn_s_waitcnt(0);
        unsigned nloc = b.st[0], nx = b.st[1];
        if (nloc == 0u) { xcd_barrier_complete(bar, b.x, nloc, nx); b.st[0] = nloc; b.st[1] = nx; }
        const unsigned old = xb_add(&bar[XB_XSUB(b.x)], 1u);
        const unsigned gen = old / nloc;
        if (old + 1u == (gen + 1u) * nloc) {
            __builtin_amdgcn_fence(__ATOMIC_RELEASE, "agent");
            asm volatile("s_waitcnt vmcnt(0)" ::: "memory");
            const unsigned og = xb_add(&bar[XB_TOP], 1u);
            const unsigned tg = og / nx;
            if (og + 1u == (tg + 1u) * nx) xb_add(&bar[XB_TOPGEN], 1u);
            else XB_SPIN(xb_ld(&bar[XB_TOPGEN]) == tg, bar);
            __builtin_amdgcn_fence(__ATOMIC_ACQUIRE, "agent");
            xb_add(&bar[XB_XGEN(b.x)], 1u);
            asm volatile("s_waitcnt vmcnt(0)" ::: "memory");
        } else {
            XB_SPIN(xb_ld(&bar[XB_XGEN(b.x)]) == gen, bar);
            __builtin_amdgcn_fence(__ATOMIC_ACQUIRE, "agent");
            asm volatile("s_waitcnt vmcnt(0)" ::: "memory");
        }
    }
    __syncthreads();
}

constexpr int LDS_SCRATCH = 131072, MISC_OFF = 155648, LDS_BYTES = 163840;
#define MODP(which) ((const float*)(p.ws + WS_MODV) + (size_t)(which) * 4 * D)

__global__ void __launch_bounds__(NTHR, 2) k_fused(Params p) {
    extern __shared__ __attribute__((aligned(16))) unsigned char lds_raw[];
    LAS unsigned char* lds = (LAS unsigned char*)lds_raw;
    for (int u = threadIdx.x; u < (LDS_BYTES - LDS_SCRATCH) / 4; u += NTHR) ((LAS unsigned*)(lds + LDS_SCRATCH))[u] = 0u;
    __syncthreads();
    const XcdBarrier bar = xcd_barrier_post((unsigned*)(p.ws + WS_CTL) + CW_BAR, (volatile LAS unsigned*)(lds + MISC_OFF) + 8);
#define GRID_BAR() xcd_barrier(bar)
    phase_weights(p, lds); __syncthreads(); phase_modvec(p, lds);
    GRID_BAR();
    phase_convert_fgu(p, lds); __syncthreads();
    phase_poolmix(p, lds, (bf16_t*)(p.ws + WS_HA));
    GRID_BAR();
    { pg8::Sched<1> Sc; Sc.init(T, D, gridDim.x, blockIdx.x, p.ws + WS_HA, p.ws + WO_POOL, D, 256);
      pg8::EpiEl<EpiPool> E{{p.x, (float*)(p.ws + WS_X1), MODP(2), p.pool_scale, 0}};
      pg8::gemm_phase(lds, 256, D, 256, 128, Sc, E); }
    GRID_BAR();
    { NormOut o0{p.norm_g + D, MODP(4), MODP(3), (bf16_t*)(p.ws + WS_HB)}; phase_norm<1, false, 2>(p, lds, (const float*)(p.ws + WS_X1), o0, o0); }
    GRID_BAR();
    { pg8::Sched<0> Sc; Sc.init(T, 2 * FF, gridDim.x, blockIdx.x, p.ws + WS_HB, p.ws + WO_FGU, D / 2, D / 2);
      pg8::EpiPairEl<EpiSwigluI8> E{{(bf16_t*)(p.ws + WS_HID0), FF, (const float*)(p.ws + WS_ASC), (const float*)(p.ws + WS_FGMAX)}};
      pg8::gemm_phase<pg8::EpiPairEl<EpiSwigluI8>, pg8::Sched<0>, true, true, 2>(lds, D / 2, D / 2, D / 2, 128, Sc, E); }
    GRID_BAR();
    { pg8::Sched<0> Sc; Sc.init(T, D, gridDim.x, blockIdx.x, p.ws + WS_HID0, p.ws + WO_FDN, FF, FF);
      pg8::EpiEl<EpiResid> E{{(const float*)(p.ws + WS_X1), (float*)(p.ws + WS_X2), MODP(5)}};
      pg8::gemm_phase(lds, FF, FF, FF, 128, Sc, E); }
    GRID_BAR();
    { NormOut o0{p.kv_norm_g, MODP(13), MODP(12), (bf16_t*)(p.ws + WS_HA)}; NormOut o1{p.norm_g + 2 * D, MODP(7), MODP(6), (bf16_t*)(p.ws + WS_HB)}; phase_norm<2, false>(p, lds, (const float*)(p.ws + WS_X2), o0, o1); }
    GRID_BAR();
    { pg8::Sched<0> Sc; Sc.init(T, NKV, gridDim.x, blockIdx.x, p.ws + WS_HA, p.ws + WO_KV, D, D);
      pg8::EpiEl<EpiBf16> E{{(bf16_t*)(p.ws + WS_KVB), NKV}};
      pg8::gemm_phase(lds, D, D, D, 128, Sc, E); }
    { pg8::Sched<0> Sc; Sc.init(T, D, gridDim.x, blockIdx.x, p.ws + WS_HB, p.ws + WO_Q, D, D);
      pg8::EpiEl<EpiQ> E{{(bf16_t*)(p.ws + WS_Q), (float*)(p.ws + WS_GATE), 0}};
      pg8::gemm_phase(lds, D, D, D, 128, Sc, E); }
    GRID_BAR();
    { pg8::Sched<2> Sc; Sc.init(2048, 2048, gridDim.x, blockIdx.x, p.ws + WS_KVB, p.ws + WO_CK, 16 * NKV, 2048);
      pg8::EpiEl<EpiCmp> E{{(bf16_t*)(p.ws + WS_CMPH), (const float*)(p.ws + WS_CMPB)}};
      pg8::gemm_phase(lds, 2048, 16 * NKV, 2048, (size_t)NKV * 2, Sc, E); }
    { pg8::Sched<0> Sc; Sc.init(T, 256, (int)gridDim.x - 64 > 0 ? (int)gridDim.x - 64 : 1, (int)gridDim.x > 64 ? (int)blockIdx.x - 64 : (int)blockIdx.x, p.ws + WS_HB, p.ws + WO_Q + (size_t)D * D * 2, D, D);
      pg8::EpiEl<EpiQ> E{{(bf16_t*)(p.ws + WS_Q), (float*)(p.ws + WS_GATE), D}};
      pg8::gemm_phase(lds, D, D, D, 128, Sc, E); }
    phase_headnorm(p, lds); phase_vtrans(p, lds);
    GRID_BAR();
    phase_cmp2(p, lds);
    GRID_BAR();
    attn_tables(p, lds);
    phase_dense(p, lds, (bf16_t*)(p.ws + WS_HB));
    GRID_BAR();
    phase_sel_tile(p, lds, (bf16_t*)(p.ws + WS_HA), (const bf16_t*)(p.ws + WS_HB));
    GRID_BAR();
    { pg8::Sched<0> Sc; Sc.init(T, D, gridDim.x, blockIdx.x, p.ws + WS_HA, p.ws + WO_O, D, D);
      pg8::EpiEl<EpiResid> E{{(const float*)(p.ws + WS_X2), p.out, MODP(8)}};
      pg8::gemm_phase(lds, D, D, D, 128, Sc, E); }
    GRID_BAR();
    { NormOut o0{p.norm_g + 3 * D, MODP(10), MODP(9), (bf16_t*)(p.ws + WS_HB)}; phase_norm<1, true, 1>(p, lds, p.out, o0, o0); }
    GRID_BAR();
    phase_moe_sort(p, lds);
    GRID_BAR();
    { const int* pst = (const int*)(p.ws + WS_CTL) + 256;
      pg8::Sched<3> Sc; Sc.init(pst[NE], 2 * FE, gridDim.x, blockIdx.x, p.ws + WS_XS, p.ws + WO_EGU, D / 2, D / 2, pst, (size_t)FE * D);
      pg8::EpiPairEl<EpiSwiglu8> E{{p.ws + WS_HIDM, FE}};
      pg8::gemm_phase<pg8::EpiPairEl<EpiSwiglu8>, pg8::Sched<3>, true, true, 1>(lds, D / 2, D / 2, D / 2, 128, Sc, E, 127 - 5); }
    GRID_BAR();
    { const int* pst = (const int*)(p.ws + WS_CTL) + 256;
      pg8::Sched<3> Sc; Sc.init(pst[NE], D, gridDim.x, blockIdx.x, p.ws + WS_HIDM, p.ws + WO_EDN, FE / 2, FE / 2, pst, (size_t)D * FE / 2);
      pg8::EpiEl<EpiBf16> E{{(bf16_t*)(p.ws + WS_Y), D}};
      pg8::gemm_phase<pg8::EpiEl<EpiBf16>, pg8::Sched<3>, true, true, 1>(lds, FE / 2, FE / 2, FE / 2, 128, Sc, E, 127 - 6); }
    GRID_BAR();
    phase_combine(p);
}

extern "C" void kernel_launch(void* const* d_in, const int* in_sizes, int n_in, void* d_out, int out_size, void* d_ws, size_t ws_size, hipStream_t stream) {
    if (n_in != 28 || out_size != T * D || ws_size < WS_END) { fprintf(stderr, "kernel_launch: unexpected shapes (n_in %d out %d ws %zu need %zu)\n", n_in, out_size, ws_size, (size_t)WS_END); return; }
    static int grid = 0;
    if (grid == 0) {
        int dev = 0, cus = 0, per_cu = 0;
        if (hipGetDevice(&dev) != hipSuccess || hipDeviceGetAttribute(&cus, hipDeviceAttributeMultiprocessorCount, dev) != hipSuccess) { grid = -1; return; }
        if (hipFuncSetAttribute((const void*)k_fused, hipFuncAttributeMaxDynamicSharedMemorySize, LDS_BYTES) != hipSuccess) { grid = -1; return; }
        if (hipOccupancyMaxActiveBlocksPerMultiprocessor(&per_cu, (const void*)k_fused, NTHR, LDS_BYTES) != hipSuccess || per_cu < 1) { fprintf(stderr, "kernel_launch: occupancy query says %d\n", per_cu); }
        (void)hipGetLastError();
        grid = cus;
    }
    if (grid < 0) return;
    Params p{};
    const float** pp = (const float**)&p;
    for (int i = 0; i < 28; ++i) pp[i] = (const float*)d_in[i];
    p.out = (float*)d_out; p.ws = (unsigned char*)d_ws;
    (void)hipMemsetAsync((char*)d_ws + WS_CTL, 0, CTL_BYTES, stream);
    k_fused<<<dim3(grid), dim3(NTHR), LDS_BYTES, stream>>>(p);
}
```

```cpp
#include <hip/hip_runtime.h>
#include <cstdint>
#include <cstdio>

#define LAS __attribute__((address_space(3)))
typedef unsigned short bf16_t;
typedef short bf16x8 __attribute__((ext_vector_type(8)));
typedef float f32x4 __attribute__((ext_vector_type(4)));
typedef float f32x2 __attribute__((ext_vector_type(2)));
typedef unsigned u32x4 __attribute__((ext_vector_type(4)));
typedef unsigned u32x2 __attribute__((ext_vector_type(2)));

constexpr int NB = 4, S = 8192, D = 1024, T = NB * S;
constexpr int FF = 2816, NE = 8, FE = 3584;
constexpr int NKV = 1536, NQP = 1280, NQ = 1072;
constexpr int G = 4, HD = 64, NH = 16;
constexpr int NC = 512;
constexpr int NSB = 128;
constexpr int NSEL = 16;
constexpr int WIN = 512;
constexpr int MOE_ROWS = 69632;
constexpr float EPS = 1e-6f;
constexpr int NTHR = 512, NWAVE = 8;

constexpr size_t MiB = 1u << 20;
constexpr size_t WS_CTL = 0, CTL_BYTES = 1 * MiB;
constexpr size_t WS_MODV = 1 * MiB;
constexpr size_t WS_CMPB = WS_MODV + 14 * 4 * 1024 * 4;
constexpr size_t WS_FGMAX = WS_CMPB + 4096;
constexpr size_t WS_ASC = WS_FGMAX + 2 * FF * 4;
constexpr size_t WS_HBG = 6 * MiB;
constexpr size_t WS_MHG = WS_HBG + 65536;
constexpr size_t WS_TOPE = 2 * MiB;
constexpr size_t WS_TOPW = WS_TOPE + (size_t)T * 8;
constexpr size_t WS_RPOS = WS_TOPW + (size_t)T * 8;
constexpr size_t WS_RTOK = WS_RPOS + (size_t)T * 8;
constexpr size_t WS_SMALL_END = WS_RTOK + (size_t)MOE_ROWS * 4;
static_assert(WS_SMALL_END <= 8 * MiB && WS_ASC + (size_t)T * 4 <= 2 * MiB, "small region");
constexpr size_t WS_W = 8 * MiB;
constexpr size_t WO_POOL = WS_W;
constexpr size_t WO_FGU = WO_POOL + (size_t)4 * 256 * 256 * 2;
constexpr size_t WO_FDN = WO_FGU + (size_t)2 * FF * D * 2;
constexpr size_t WO_KV = WO_FDN + (size_t)D * FF * 2;
constexpr size_t WO_Q = WO_KV + (size_t)NKV * D * 2;
constexpr size_t WO_O = WO_Q + (size_t)NQP * D * 2;
constexpr size_t WO_CK = WO_O + (size_t)D * D * 2;
constexpr size_t WO_CV = WO_CK + (size_t)256 * 2048 * 2;
constexpr size_t WO_EGU = WO_CV + (size_t)256 * 2048 * 2;
constexpr size_t WO_EDN = WO_EGU + (size_t)NE * 2 * FE * D * 2;
constexpr size_t WO_END = WO_EDN + (size_t)NE * D * FE * 2;
static_assert(WO_END <= 203 * MiB, "weights region");
constexpr size_t WS_HB = 203 * MiB;
constexpr size_t WS_X1 = 267 * MiB;
constexpr size_t WS_X2 = 395 * MiB;
constexpr size_t WS_HID0 = 523 * MiB;
constexpr size_t WS_Q = 523 * MiB;
constexpr size_t WS_GATE = 587 * MiB;
constexpr size_t WS_CMPH = 593 * MiB;
constexpr size_t WS_KC = 601 * MiB;
constexpr size_t WS_VC = 602 * MiB;
constexpr size_t WS_KSB = 603 * MiB;
constexpr size_t WS_VSB = 619 * MiB;
constexpr size_t WS_KWB = 635 * MiB;
constexpr size_t WS_VWB = 651 * MiB;
constexpr size_t WS_Q8 = 267 * MiB;
constexpr size_t WS_SEL = 667 * MiB;
constexpr size_t WS_HA = 699 * MiB;
constexpr size_t WS_KVB = 763 * MiB;
constexpr size_t WS_HIDM = 267 * MiB;
constexpr size_t WS_Y = 743 * MiB;
constexpr size_t WS_XS = WS_Y;
constexpr size_t WS_END = 880 * MiB;
static_assert(WS_HIDM + (size_t)MOE_ROWS * FE * 2 <= WS_Y && WS_Y + (size_t)MOE_ROWS * D * 2 <= WS_END, "moe map");
static_assert(WS_KVB + (size_t)T * NKV * 2 + 65536 <= WS_END, "kv map");
constexpr int CW_CNT = 512;
constexpr int CW_CUR = 1024;
constexpr int CW_HN = 2048, CW_VT = 2112;
constexpr int CW_BAR = 4096;

struct Params {
    const float *x, *c, *ada_w, *ada_b, *norm_g, *pool_w, *pool_scale, *q_w, *q_gain, *o_w, *kv_ada_w, *kv_ada_b, *kv_norm_g, *kv_w,
        *cmp_pe_k, *cmp_pe_v, *cmp_k_w1, *cmp_k_w2, *cmp_v_w1, *cmp_v_w2, *k_gain, *rel_bias, *ffn_gu, *ffn_dn, *router_w, *router_b, *exp_gu, *exp_dn;
    float* out; unsigned char* ws;
};

__device__ __forceinline__ unsigned cvt_pk_bf16(float lo, float hi) { unsigned r; asm volatile("v_cvt_pk_bf16_f32 %0, %1, %2" : "=v"(r) : "v"(lo), "v"(hi)); return r; }
__device__ __forceinline__ float bf2f(unsigned short v) { return __uint_as_float((unsigned)v << 16); }
__device__ __forceinline__ float bflo(unsigned w) { return __uint_as_float(w << 16); }
__device__ __forceinline__ float bfhi(unsigned w) { return __uint_as_float(w & 0xffff0000u); }
__device__ __forceinline__ int opaque_tid() { int t = threadIdx.x; asm volatile("" : "+v"(t)); return t; }
__device__ __forceinline__ float readlane_f(float v, int l) { return __uint_as_float((unsigned)__builtin_amdgcn_readlane((int)__float_as_uint(v), l)); }
__device__ __forceinline__ unsigned pack_i8x4(float a, float b, float c, float d) {
    const int ia = (int)__builtin_rintf(fminf(fmaxf(a, -127.f), 127.f)), ib = (int)__builtin_rintf(fminf(fmaxf(b, -127.f), 127.f)), ic = (int)__builtin_rintf(fminf(fmaxf(c, -127.f), 127.f)), id = (int)__builtin_rintf(fminf(fmaxf(d, -127.f), 127.f));
    return (unsigned)(ia & 0xff) | ((unsigned)(ib & 0xff) << 8) | ((unsigned)(ic & 0xff) << 16) | ((unsigned)(id & 0xff) << 24);
}
__device__ __forceinline__ float sel_q_scale(const float* q_gain) { float m = 0.f; for (int i = 0; i < 64; ++i) m = fmaxf(m, fabsf(q_gain[i])); return 127.f / (4.f * m * 0.125f * 1.4426950408889634f); }
__device__ __forceinline__ float sel_k_scale(const float* k_gain) { float m = 0.f; for (int i = 0; i < 64; ++i) m = fmaxf(m, fabsf(k_gain[64 + i])); return 127.f / (4.f * m); }
__device__ __forceinline__ float wave_sum(float v) {
#pragma unroll
    for (int o = 1; o < 64; o <<= 1) v += __shfl_xor(v, o);
    return v;
}
__device__ __forceinline__ float wave_max(float v) {
#pragma unroll
    for (int o = 1; o < 64; o <<= 1) v = fmaxf(v, __shfl_xor(v, o));
    return v;
}
__device__ __forceinline__ float silu_f(float v) { return v * __builtin_amdgcn_rcpf(1.f + __builtin_amdgcn_exp2f(v * -1.4426950408889634f)); }
__device__ __forceinline__ f32x2 swiglu2(f32x2 g, f32x2 u) {
    const f32x2 t = g * -1.4426950408889634f; f32x2 e; e.x = __builtin_amdgcn_exp2f(t.x); e.y = __builtin_amdgcn_exp2f(t.y);
    e = e + 1.f; f32x2 r; r.x = __builtin_amdgcn_rcpf(e.x); r.y = __builtin_amdgcn_rcpf(e.y);
    return (g * u) * r; }
__device__ __forceinline__ float sigmoid_f(float v) { return __builtin_amdgcn_rcpf(1.f + __builtin_amdgcn_exp2f(v * -1.4426950408889634f)); }
__device__ __forceinline__ float gelu_tanh_f(float v) {
    const float u = 0.7978845608028654f * (v + 0.044715f * v * v * v);
    const float e = __builtin_amdgcn_exp2f(fabsf(u) * -2.8853900817779268f); const float th = (1.f - e) * __builtin_amdgcn_rcpf(1.f + e);
    return 0.5f * v * (1.f + (u < 0.f ? -th : th));
}
__device__ __forceinline__ int rel_bucket(int d) {
    if (d < 16) return d;
    int b = 16;
    b += (d >= 21); b += (d >= 27); b += (d >= 35); b += (d >= 46); b += (d >= 59); b += (d >= 77); b += (d >= 99); b += (d >= 128);
    b += (d >= 166); b += (d >= 216); b += (d >= 280); b += (d >= 363); b += (d >= 470); b += (d >= 609); b += (d >= 790);
    return b;
}

template <bool FP8 = false>
__device__ __forceinline__ void transpose_item(const float* W, int K, int N, bf16_t* WT, int k0, int n0, int drow0, LAS float* scr, int lane, float wscale = 1.f) {
    float wv[32];
#pragma unroll
    for (int i = 0; i < 32; ++i) { const int kk = 2 * i + (lane >> 5); const int n = n0 + (lane & 31); wv[i] = (n < N) ? W[(size_t)(k0 + kk) * N + n] : 0.f; }
#pragma unroll
    for (int i = 0; i < 32; ++i) { const int kk = 2 * i + (lane >> 5); scr[kk * 33 + (lane & 31)] = wv[i]; }
    asm volatile("s_waitcnt lgkmcnt(0)" ::: "memory");
    const int c = lane & 7;
#pragma unroll
    for (int j = 0; j < 4; ++j) { const int n = (lane >> 3) + 8 * j; const LAS float* s = scr + (8 * c) * 33 + n;
        if constexpr (FP8) {
            unsigned w0 = 0u, w1 = 0u;
            w0 = __builtin_amdgcn_cvt_pk_fp8_f32(s[0 * 33] * wscale, s[1 * 33] * wscale, w0, false); w0 = __builtin_amdgcn_cvt_pk_fp8_f32(s[2 * 33] * wscale, s[3 * 33] * wscale, w0, true);
            w1 = __builtin_amdgcn_cvt_pk_fp8_f32(s[4 * 33] * wscale, s[5 * 33] * wscale, w1, false); w1 = __builtin_amdgcn_cvt_pk_fp8_f32(s[6 * 33] * wscale, s[7 * 33] * wscale, w1, true);
            *(u32x2*)((unsigned char*)WT + (size_t)(drow0 + n) * K + k0 + 8 * c) = (u32x2){w0, w1};
        } else {
        u32x4 o; o.x = cvt_pk_bf16(s[0 * 33], s[1 * 33]); o.y = cvt_pk_bf16(s[2 * 33], s[3 * 33]); o.z = cvt_pk_bf16(s[4 * 33], s[5 * 33]); o.w = cvt_pk_bf16(s[6 * 33], s[7 * 33]);
        *(u32x4*)(WT + (size_t)(drow0 + n) * K + k0 + 8 * c) = o; } }
    asm volatile("s_waitcnt lgkmcnt(0)" ::: "memory");
}
template <int MODE, bool FP8 = false>
__device__ __forceinline__ void transpose_mat(const float* W, int K, int N, int NP, int F, bf16_t* WT, int it, LAS float* scr, int lane, float wscale = 1.f) {
    const int nblk = NP / 32, kb = it / nblk, nb = it % nblk, n0 = nb * 32;
    int drow0 = n0;
    if (MODE == 1) { const int up = n0 >= F, j = up ? n0 - F : n0; drow0 = (j >> 7) * 256 + (up ? 128 : 0) + (j & 127); }
    transpose_item<FP8>(W, K, N, WT, kb * 64, n0, drow0, scr, lane, wscale);
}
__device__ __forceinline__ void phase_convert_fgu(const Params& p, LAS unsigned char* lds) {
    const int tid = opaque_tid(), lane = tid & 63, wave = tid >> 6;
    LAS float* scr = (LAS float*)(lds + wave * 16384);
    const int gw = blockIdx.x * NWAVE + wave, NGW = gridDim.x * NWAVE;
    const float* FGMAX = (const float*)(p.ws + WS_FGMAX); unsigned char* WT = p.ws + WO_FGU;
    for (int it = gw; it < 16 * 176; it += NGW) {
        const int kb = it / 176, nb = it % 176, n0 = nb * 32, k0 = kb * 64;
        const int up = n0 >= FF, j0 = up ? n0 - FF : n0, drow0 = (j0 >> 7) * 256 + (up ? 128 : 0) + (j0 & 127);
        float wv[32];
#pragma unroll
        for (int i = 0; i < 32; ++i) wv[i] = p.ffn_gu[(size_t)(k0 + 2 * i + (lane >> 5)) * (2 * FF) + n0 + (lane & 31)];
#pragma unroll
        for (int i = 0; i < 32; ++i) scr[(2 * i + (lane >> 5)) * 33 + (lane & 31)] = wv[i];
        asm volatile("s_waitcnt lgkmcnt(0)" ::: "memory");
        const int c = lane & 7;
#pragma unroll
        for (int j = 0; j < 4; ++j) { const int n = (lane >> 3) + 8 * j; const LAS float* sp = scr + (8 * c) * 33 + n; const float sc = 127.f / FGMAX[n0 + n];
            const unsigned w0 = pack_i8x4(sp[0 * 33] * sc, sp[1 * 33] * sc, sp[2 * 33] * sc, sp[3 * 33] * sc), w1 = pack_i8x4(sp[4 * 33] * sc, sp[5 * 33] * sc, sp[6 * 33] * sc, sp[7 * 33] * sc);
            *(u32x2*)(WT + (size_t)(drow0 + n) * D + k0 + 8 * c) = (u32x2){w0, w1}; }
        asm volatile("s_waitcnt lgkmcnt(0)" ::: "memory");
    }
}
__device__ __forceinline__ void phase_weights(const Params& p, LAS unsigned char* lds) {
    const int tid = opaque_tid(), lane = tid & 63, wave = tid >> 6;
    LAS float* scr = (LAS float*)(lds + wave * 16384);
    const int gw = blockIdx.x * NWAVE + wave, NGW = gridDim.x * NWAVE;
    unsigned char* ws = p.ws;
    constexpr int I_POOL = 4 * 8, I_FGU = 16 * 176, I_FDN = 44 * 32, I_KV = 16 * 48, I_Q = 16 * 40, I_O = 16 * 32, I_C = 32 * 8, I_EGU = 16 * 224, I_EDN = 56 * 32;
    constexpr int TOT = 4 * I_POOL + I_FGU + I_FDN + I_KV + I_Q + I_O + 2 * I_C + NE * I_EGU + NE * I_EDN;
    for (int it = gw; it < TOT; it += NGW) {
        int r = it;
        if (r < 4 * I_POOL) { const int g = r / I_POOL; transpose_mat<0>(p.pool_w + (size_t)g * 65536, 256, 256, 256, 0, (bf16_t*)(ws + WO_POOL) + (size_t)g * 65536, r % I_POOL, scr, lane); continue; } r -= 4 * I_POOL;
        if (r < I_FGU) continue; r -= I_FGU;
        if (r < I_FDN) { transpose_mat<0>(p.ffn_dn, FF, D, D, 0, (bf16_t*)(ws + WO_FDN), r, scr, lane); continue; } r -= I_FDN;
        if (r < I_KV) { transpose_mat<0>(p.kv_w, D, NKV, NKV, 0, (bf16_t*)(ws + WO_KV), r, scr, lane); continue; } r -= I_KV;
        if (r < I_Q) { transpose_mat<0>(p.q_w, D, NQ, NQP, 0, (bf16_t*)(ws + WO_Q), r, scr, lane); continue; } r -= I_Q;
        if (r < I_O) { transpose_mat<0>(p.o_w, D, D, D, 0, (bf16_t*)(ws + WO_O), r, scr, lane); continue; } r -= I_O;
        if (r < I_C) { transpose_mat<0>(p.cmp_k_w1, 2048, 256, 256, 0, (bf16_t*)(ws + WO_CK), r, scr, lane); continue; } r -= I_C;
        if (r < I_C) { transpose_mat<0>(p.cmp_v_w1, 2048, 256, 256, 0, (bf16_t*)(ws + WO_CV), r, scr, lane); continue; } r -= I_C;
        if (r < NE * I_EGU) { const int e = r / I_EGU; transpose_mat<1, true>(p.exp_gu + (size_t)e * D * 2 * FE, D, 2 * FE, 2 * FE, FE, (bf16_t*)(ws + WO_EGU + (size_t)e * 2 * FE * D), r % I_EGU, scr, lane, 32.f); continue; } r -= NE * I_EGU;
        { const int e = r / I_EDN; transpose_mat<0, true>(p.exp_dn + (size_t)e * FE * D, FE, D, D, 0, (bf16_t*)(ws + WO_EDN + (size_t)e * D * FE), r % I_EDN, scr, lane, 64.f); }
    }
}

__device__ __forceinline__ void phase_modvec(const Params& p, LAS unsigned char* lds) {
    const int tid = opaque_tid(), lane = tid & 63, wave = tid >> 6;
    LAS float* part = (LAS float*)lds;
    LAS float* sc_l = (LAS float*)(lds + 8192);
    for (int i = tid; i < 4 * D; i += NTHR) sc_l[i] = silu_f(p.c[i]);
    __syncthreads();
    float* MODV = (float*)(p.ws + WS_MODV);
    float* CMPB = (float*)(p.ws + WS_CMPB);
    { float* FGMAX = (float*)(p.ws + WS_FGMAX);
      for (int u = blockIdx.x; u < 2 * FF / 64; u += gridDim.x) {
        const int col = u * 64 + lane; float m = 0.f;
#pragma unroll 16
        for (int k = wave * 128; k < wave * 128 + 128; ++k) m = fmaxf(m, fabsf(p.ffn_gu[(size_t)k * (2 * FF) + col]));
        part[wave * 64 + lane] = m;
        __syncthreads();
        if (tid < 64) { float mm = part[lane];
#pragma unroll
            for (int w = 1; w < 8; ++w) mm = fmaxf(mm, part[w * 64 + lane]);
            FGMAX[u * 64 + lane] = fmaxf(mm, 1e-30f); }
        __syncthreads();
      } }
    constexpr int NU_MOD = 14336 / 64, NU = NU_MOD + 8;
    for (int u = blockIdx.x; u < NU; u += gridDim.x) {
        float acc[4] = {0.f, 0.f, 0.f, 0.f};
        if (u < NU_MOD) {
            const int gc = u * 64 + lane;
            const float* W; int ldw, col;
            if (gc < 6144) { W = p.ada_w; ldw = 6144; col = gc; } else if (gc < 12288) { W = p.ada_w + (size_t)D * 6144; ldw = 6144; col = gc - 6144; } else { W = p.kv_ada_w; ldw = 2048; col = gc - 12288; }
#pragma unroll 16
            for (int k = wave * 128; k < wave * 128 + 128; ++k) {
                const float w = W[(size_t)k * ldw + col];
#pragma unroll
                for (int b = 0; b < 4; ++b) acc[b] += sc_l[b * D + k] * w;
            }
        } else {
            const int cu = u - NU_MOD, kv = cu >> 2, col = (cu & 3) * 64 + lane;
            const float* W = kv ? p.cmp_v_w1 : p.cmp_k_w1; const float* pe = kv ? p.cmp_pe_v : p.cmp_pe_k;
#pragma unroll 16
            for (int k = wave * 256; k < wave * 256 + 256; ++k) acc[0] += pe[k] * W[(size_t)k * 256 + col];
        }
#pragma unroll
        for (int b = 0; b < 4; ++b) part[(wave * 4 + b) * 64 + lane] = acc[b];
        __syncthreads();
        if (tid < 256) {
            const int b = tid >> 6; float s = 0.f;
#pragma unroll
            for (int w = 0; w < 8; ++w) s += part[(w * 4 + b) * 64 + lane];
            if (u < NU_MOD) {
                const int gc = u * 64 + lane; int which, n; float bias;
                if (gc < 6144) { which = gc >> 10; n = gc & 1023; bias = p.ada_b[gc]; } else if (gc < 12288) { which = 6 + ((gc - 6144) >> 10); n = gc & 1023; bias = p.ada_b[gc]; }
                else { which = 12 + ((gc - 12288) >> 10); n = gc & 1023; bias = p.kv_ada_b[gc - 12288]; }
                MODV[(which * 4 + b) * D + n] = s + bias;
            } else if (b == 0) { const int cu = u - NU_MOD; CMPB[(cu >> 2) * 256 + (cu & 3) * 64 + lane] = s; }
        }
        __syncthreads();
    }
}

template <int W>
__device__ __forceinline__ void pool_rows(const float* xb, int t0, const LAS float* rs, f32x2 gm, f32x2 sh, bf16_t* outb, int c0) {
    f32x2 ring[16];
#pragma unroll
    for (int i = 0; i < 15; ++i) {
        const int t = t0 - 15 + i; f32x2 h = {0.f, 0.f};
        if (t >= 0) { const f32x2 xv = *(const f32x2*)(xb + (size_t)t * D + c0); const float r = rs[i]; h = xv * r * gm + sh; }
        ring[i] = h;
    }
    for (int gi = 0; gi < 8; ++gi) {
#pragma unroll
        for (int j = 0; j < 16; ++j) {
            const int i = 15 + gi * 16 + j, t = t0 + gi * 16 + j;
            const f32x2 xv = *(const f32x2*)(xb + (size_t)t * D + c0); const float r = rs[i];
            const f32x2 h = xv * r * gm + sh;
            ring[(15 + j) & 15] = h;
            f32x2 s = {0.f, 0.f};
#pragma unroll
            for (int k = 0; k < W; ++k) s += ring[(15 + j - k) & 15];
            const int cnt = (t + 1 < W) ? t + 1 : W;
            const f32x2 o = s * (1.f / (float)cnt) - h;
            *(unsigned*)(outb + (size_t)t * D + c0) = cvt_pk_bf16(o.x, o.y);
        }
    }
}
__device__ __forceinline__ void phase_poolmix(const Params& p, LAS unsigned char* lds, bf16_t* mixA) {
    const int tid = opaque_tid(), lane = tid & 63, wave = tid >> 6;
    LAS float* rs = (LAS float*)lds;
    const float* MODV = (const float*)(p.ws + WS_MODV);
    for (int u = blockIdx.x; u < T / 128; u += gridDim.x) {
        const int b = u >> 6, t0 = (u & 63) * 128;
        const float* xb = p.x + (size_t)b * S * D;
        for (int i = wave; i < 143; i += NWAVE) {
            const int t = t0 - 15 + i; float r = 0.f;
            if (t >= 0) { const f32x4* xr = (const f32x4*)(xb + (size_t)t * D) + lane; float s = 0.f;
#pragma unroll
                for (int j = 0; j < 4; ++j) { const f32x4 v = xr[64 * j]; s += (v.x * v.x + v.y * v.y) + (v.z * v.z + v.w * v.w); }
                r = 1.f / sqrtf(wave_sum(s) * (1.f / D) + EPS); }
            if (lane == 0) rs[i] = r;
        }
        __syncthreads();
        const int c0 = 2 * tid;
        const f32x2 g = *(const f32x2*)(p.norm_g + c0), sc = *(const f32x2*)(MODV + (1 * 4 + b) * D + c0), sh = *(const f32x2*)(MODV + (0 * 4 + b) * D + c0);
        const f32x2 gm = g * (sc + 1.f);
        bf16_t* ob = mixA + (size_t)b * S * D;
        const int grp = tid >> 7;
        if (grp == 0) pool_rows<2>(xb, t0, rs, gm, sh, ob, c0);
        else if (grp == 1) pool_rows<4>(xb, t0, rs, gm, sh, ob, c0);
        else if (grp == 2) pool_rows<8>(xb, t0, rs, gm, sh, ob, c0);
        else pool_rows<16>(xb, t0, rs, gm, sh, ob, c0);
        __syncthreads();
    }
}

struct NormOut { const float* g; const float* sc; const float* sh; bf16_t* out; };
template <int NOUT, bool ROUTER, int OUTQ = 0>
__device__ __forceinline__ void phase_norm(const Params& p, LAS unsigned char* lds, const float* xin, const NormOut o0, const NormOut o1) {
    const int tid = opaque_tid(), lane = tid & 63, wave = tid >> 6;
    const int gw = blockIdx.x * NWAVE + wave, NGW = gridDim.x * NWAVE;
    f32x4 rwa[16], rwb[16];
    if (ROUTER) {
#pragma unroll
        for (int j = 0; j < 4; ++j)
#pragma unroll
            for (int q = 0; q < 4; ++q) { const f32x4* wp = (const f32x4*)(p.router_w + (size_t)(4 * lane + 256 * j + q) * NE); rwa[4 * j + q] = wp[0]; rwb[4 * j + q] = wp[1]; }
    }
    unsigned* ctl = (unsigned*)(p.ws + WS_CTL);
    int* TOPE = (int*)(p.ws + WS_TOPE); float* TOPW = (float*)(p.ws + WS_TOPW);
    unsigned cnt_local[NE];
#pragma unroll
    for (int e = 0; e < NE; ++e) cnt_local[e] = 0;
    const int rows_per = T / NGW > 0 ? (T + NGW - 1) / NGW : 1;
    const int r0 = gw * rows_per, r1 = (r0 + rows_per < T) ? r0 + rows_per : T;
    int curb = -1; f32x4 gm0[4], sh0[4], gm1[4], sh1[4];
    for (int r = r0; r < r1; ++r) {
        const int b = r >> 13;
        if (b != curb) { curb = b;
#pragma unroll
            for (int j = 0; j < 4; ++j) { const int c = 4 * lane + 256 * j;
                gm0[j] = *(const f32x4*)(o0.g + c) * (*(const f32x4*)(o0.sc + b * D + c) + 1.f); sh0[j] = *(const f32x4*)(o0.sh + b * D + c);
                if (NOUT > 1) { gm1[j] = *(const f32x4*)(o1.g + c) * (*(const f32x4*)(o1.sc + b * D + c) + 1.f); sh1[j] = *(const f32x4*)(o1.sh + b * D + c); } } }
        const f32x4* xr = (const f32x4*)(xin + (size_t)r * D) + lane;
        f32x4 v[4]; float s = 0.f;
#pragma unroll
        for (int j = 0; j < 4; ++j) { v[j] = xr[64 * j]; s += (v[j].x * v[j].x + v[j].y * v[j].y) + (v[j].z * v[j].z + v[j].w * v[j].w); }
        const float rstd = 1.f / sqrtf(wave_sum(s) * (1.f / D) + EPS);
        float lg[NE];
#pragma unroll
        for (int e = 0; e < NE; ++e) lg[e] = 0.f;
        float qsc = 1.f;
        if constexpr (OUTQ == 2) { float mx = 0.f;
#pragma unroll
            for (int j = 0; j < 4; ++j) { const f32x4 h = v[j] * rstd * gm0[j] + sh0[j]; mx = fmaxf(mx, fmaxf(fmaxf(fabsf(h.x), fabsf(h.y)), fmaxf(fabsf(h.z), fabsf(h.w)))); }
            mx = fmaxf(wave_max(mx), 1e-30f); qsc = 127.f / mx;
            if (lane == 0) ((float*)(p.ws + WS_ASC))[r] = mx * (1.f / 127.f); }
#pragma unroll
        for (int j = 0; j < 4; ++j) {
            const f32x4 h = v[j] * rstd * gm0[j] + sh0[j];
            if constexpr (OUTQ == 2) { *(unsigned*)((unsigned char*)o0.out + (size_t)r * D + 4 * lane + 256 * j) = pack_i8x4(h.x * qsc, h.y * qsc, h.z * qsc, h.w * qsc); }
            else if constexpr (OUTQ == 1) { unsigned w8 = 0u; w8 = __builtin_amdgcn_cvt_pk_fp8_f32(h.x, h.y, w8, false); w8 = __builtin_amdgcn_cvt_pk_fp8_f32(h.z, h.w, w8, true);
                *(unsigned*)((unsigned char*)o0.out + (size_t)r * D + 4 * lane + 256 * j) = w8; }
            else { u32x2 w; w.x = cvt_pk_bf16(h.x, h.y); w.y = cvt_pk_bf16(h.z, h.w);
            *(u32x2*)(o0.out + (size_t)r * D + 4 * lane + 256 * j) = w; }
            if (NOUT > 1) { const f32x4 h1 = v[j] * rstd * gm1[j] + sh1[j]; u32x2 w1; w1.x = cvt_pk_bf16(h1.x, h1.y); w1.y = cvt_pk_bf16(h1.z, h1.w);
                *(u32x2*)(o1.out + (size_t)r * D + 4 * lane + 256 * j) = w1; }
            if (ROUTER) {
#pragma unroll
                for (int q = 0; q < 4; ++q) { const f32x4 a = rwa[4 * j + q], c2 = rwb[4 * j + q]; const float hv = h[q];
                    lg[0] += hv * a.x; lg[1] += hv * a.y; lg[2] += hv * a.z; lg[3] += hv * a.w; lg[4] += hv * c2.x; lg[5] += hv * c2.y; lg[6] += hv * c2.z; lg[7] += hv * c2.w; }
            }
        }
        if (ROUTER) {
            {
                const bool u5 = lane & 32, u4 = lane & 16, u3 = lane & 8; float a4[4], a2[2], a1;
#pragma unroll
                for (int i = 0; i < 4; ++i) a4[i] = (u5 ? lg[4 + i] : lg[i]) + __shfl_xor(u5 ? lg[i] : lg[4 + i], 32);
#pragma unroll
                for (int i = 0; i < 2; ++i) a2[i] = (u4 ? a4[2 + i] : a4[i]) + __shfl_xor(u4 ? a4[i] : a4[2 + i], 16);
                a1 = (u3 ? a2[1] : a2[0]) + __shfl_xor(u3 ? a2[0] : a2[1], 8);
                a1 += __shfl_xor(a1, 4); a1 += __shfl_xor(a1, 2); a1 += __shfl_xor(a1, 1);
#pragma unroll
                for (int e = 0; e < NE; ++e) lg[e] = readlane_f(a1, 8 * e) + p.router_b[e];
            }
            int e0 = 0; float v0 = lg[0];
#pragma unroll
            for (int e = 1; e < NE; ++e) if (lg[e] > v0) { v0 = lg[e]; e0 = e; }
            int e1 = -1; float v1 = -3.0e38f;
#pragma unroll
            for (int e = 0; e < NE; ++e) if (e != e0 && lg[e] > v1) { v1 = lg[e]; e1 = e; }
            const float ex = __expf(v1 - v0), w0 = 1.f / (1.f + ex), w1 = ex / (1.f + ex);
            if (lane == 0) { TOPE[2 * r] = e0; TOPE[2 * r + 1] = e1; TOPW[2 * r] = w0; TOPW[2 * r + 1] = w1; }
#pragma unroll
            for (int e = 0; e < NE; ++e) cnt_local[e] += (e == e0) + (e == e1);
        }
    }
    if (ROUTER) {
        LAS unsigned* lc = (LAS unsigned*)lds;
        if (tid < NE) lc[tid] = 0u;
        __syncthreads();
        if (lane == 0) {
#pragma unroll
            for (int e = 0; e < NE; ++e) if (cnt_local[e]) atomicAdd((unsigned*)(lc + e), cnt_local[e]);
        }
        __syncthreads();
        if (tid < NE && lc[tid]) atomicAdd(ctl + CW_CNT + 64 * tid, lc[tid]);
    }
}

struct NoCol {};
struct EpiPool {
    typedef f32x4 Col; static constexpr bool ROWLOAD = true;
    const float* x; float* x1; const float* g1; const float* scale; int coff;
    __device__ __forceinline__ f32x4 col(int row0, int c) const { return *(const f32x4*)(g1 + (row0 >> 13) * D + coff + c) * *(const f32x4*)(scale + coff + c); }
    __device__ __forceinline__ f32x4 rowload(int row, int c) const { return *(const f32x4*)(x + (size_t)row * D + coff + c); }
    __device__ __forceinline__ void apply8(int row, int c, f32x4 v0, f32x4 v1, f32x4 cg0, f32x4 cg1, f32x4 xv0, f32x4 xv1) const { float* o = x1 + (size_t)row * D + coff + c; *(f32x4*)o = xv0 + cg0 * v0; *(f32x4*)(o + 4) = xv1 + cg1 * v1; }
};
struct EpiSwigluI8 {
    struct Col { f32x4 wg, wu; }; typedef float Row;
    bf16_t* hid; int ldh; const float* asc; const float* wmax;
    __device__ __forceinline__ Col col(int hc) const { Col c; c.wg = *(const f32x4*)(wmax + hc); c.wu = *(const f32x4*)(wmax + FF + hc); return c; }
    __device__ __forceinline__ float rowv(int row) const { return asc[row] * (1.f / 127.f); }
    __device__ __forceinline__ u32x2 four(f32x4 gt, f32x4 up, const Col& c, float ra) const {
        typedef int i32x4e __attribute__((ext_vector_type(4)));
        const i32x4e gi = __builtin_bit_cast(i32x4e, gt), ui = __builtin_bit_cast(i32x4e, up);
        const f32x4 wg = c.wg * ra, wu = c.wu * ra;
        const f32x2 a = swiglu2((f32x2){(float)gi.x, (float)gi.y} * (f32x2){wg.x, wg.y}, (f32x2){(float)ui.x, (float)ui.y} * (f32x2){wu.x, wu.y});
        const f32x2 b = swiglu2((f32x2){(float)gi.z, (float)gi.w} * (f32x2){wg.z, wg.w}, (f32x2){(float)ui.z, (float)ui.w} * (f32x2){wu.z, wu.w});
        u32x2 w; w.x = cvt_pk_bf16(a.x, a.y); w.y = cvt_pk_bf16(b.x, b.y); return w; }
    __device__ __forceinline__ void pair8(int row, int hc, f32x4 g0, f32x4 u0, f32x4 g1, f32x4 u1, const Col& c0, const Col& c1, float ra) const {
        const u32x2 a = four(g0, u0, c0, ra), b = four(g1, u1, c1, ra);
        *(u32x4*)(hid + (size_t)row * ldh + hc) = (u32x4){a.x, a.y, b.x, b.y}; }
};
struct EpiSwiglu8 {
    typedef NoCol Col; typedef NoCol Row;
    unsigned char* hid; int ldh;
    __device__ __forceinline__ NoCol col(int) const { return NoCol{}; }
    __device__ __forceinline__ NoCol rowv(int) const { return NoCol{}; }
    __device__ __forceinline__ unsigned four(f32x4 gt, f32x4 up) const {
        const f32x2 a = swiglu2((f32x2){gt.x, gt.y}, (f32x2){up.x, up.y}), b = swiglu2((f32x2){gt.z, gt.w}, (f32x2){up.z, up.w});
        unsigned w = 0u; w = __builtin_amdgcn_cvt_pk_fp8_f32(a.x, a.y, w, false); w = __builtin_amdgcn_cvt_pk_fp8_f32(b.x, b.y, w, true); return w; }
    __device__ __forceinline__ void pair8(int row, int hc, f32x4 g0, f32x4 u0, f32x4 g1, f32x4 u1, const NoCol&, const NoCol&, NoCol) const {
        *(u32x2*)(hid + (size_t)row * ldh + hc) = (u32x2){four(g0, u0), four(g1, u1)}; }
};
struct EpiResid {
    typedef f32x4 Col; static constexpr bool ROWLOAD = true;
    const float* xin; float* out; const float* gate;
    __device__ __forceinline__ f32x4 col(int row0, int c) const { return *(const f32x4*)(gate + (row0 >> 13) * D + c); }
    __device__ __forceinline__ f32x4 rowload(int row, int c) const { return *(const f32x4*)(xin + (size_t)row * D + c); }
    __device__ __forceinline__ void apply8(int row, int c, f32x4 v0, f32x4 v1, f32x4 cg0, f32x4 cg1, f32x4 xv0, f32x4 xv1) const { float* o = out + (size_t)row * D + c; *(f32x4*)o = xv0 + cg0 * v0; *(f32x4*)(o + 4) = xv1 + cg1 * v1; }
};
struct EpiBf16 {
    typedef NoCol Col; static constexpr bool ROWLOAD = false;
    bf16_t* o; int ldo;
    __device__ __forceinline__ NoCol col(int, int) const { return NoCol{}; }
    __device__ __forceinline__ void apply8(int row, int c, f32x4 v0, f32x4 v1, NoCol, NoCol) const { *(u32x4*)(o + (size_t)row * ldo + c) = (u32x4){cvt_pk_bf16(v0.x, v0.y), cvt_pk_bf16(v0.z, v0.w), cvt_pk_bf16(v1.x, v1.y), cvt_pk_bf16(v1.z, v1.w)}; }
};
struct EpiQ {
    typedef NoCol Col; static constexpr bool ROWLOAD = false;
    bf16_t* q; float* gates; int coff;
    __device__ __forceinline__ NoCol col(int, int) const { return NoCol{}; }
    __device__ __forceinline__ void apply8(int row, int col_, f32x4 v0, f32x4 v1, NoCol, NoCol) const { const int col = col_ + coff;
        if (col < D) { *(u32x4*)(q + (size_t)row * D + col) = (u32x4){cvt_pk_bf16(v0.x, v0.y), cvt_pk_bf16(v0.z, v0.w), cvt_pk_bf16(v1.x, v1.y), cvt_pk_bf16(v1.z, v1.w)}; }
        else if (col < NQ) { f32x4 s0, s1; s0.x = sigmoid_f(v0.x); s0.y = sigmoid_f(v0.y); s0.z = sigmoid_f(v0.z); s0.w = sigmoid_f(v0.w); s1.x = sigmoid_f(v1.x); s1.y = sigmoid_f(v1.y); s1.z = sigmoid_f(v1.z); s1.w = sigmoid_f(v1.w);
            float* g = gates + (size_t)row * 48 + (col - D); *(f32x4*)g = s0; *(f32x4*)(g + 4) = s1; } }
};
struct EpiCmp {
    typedef f32x4 Col; static constexpr bool ROWLOAD = false;
    bf16_t* o; const float* bias;
    __device__ __forceinline__ f32x4 col(int, int c_) const { const int z = c_ >> 8, c = c_ & 255; return *(const f32x4*)(bias + (z >> 2) * 256 + c); }
    __device__ __forceinline__ void apply8(int row, int col, f32x4 v0, f32x4 v1, f32x4 b0, f32x4 b1) const { const int z = col >> 8, c = col & 255;
        u32x4 w; w.x = cvt_pk_bf16(gelu_tanh_f(v0.x + b0.x), gelu_tanh_f(v0.y + b0.y)); w.y = cvt_pk_bf16(gelu_tanh_f(v0.z + b0.z), gelu_tanh_f(v0.w + b0.w));
        w.z = cvt_pk_bf16(gelu_tanh_f(v1.x + b1.x), gelu_tanh_f(v1.y + b1.y)); w.w = cvt_pk_bf16(gelu_tanh_f(v1.z + b1.z), gelu_tanh_f(v1.w + b1.w));
        *(u32x4*)(o + ((size_t)z * 2048 + row) * 256 + c) = w; }
};

namespace pg8 {
#define PG8_LAS __attribute__((address_space(3)))
constexpr int BM = 256, BK = 64, HALF = 128, HTB = HALF * BK * 2, STAGE_BYTES = 8 * HTB, NXCD = 8, WGM = 8;
__host__ __device__ __forceinline__ int lds_byte(int r, int c) { const int st = (r >> 4) * 2 + (c >> 5), rr = r & 15, cc = c & 31, ob = rr * 64 + cc * 2; return st * 1024 + (ob ^ (((ob >> 9) & 1) << 5)); }
__host__ __device__ __forceinline__ void stage_rc(int b, int& R, int& C) { const int st = b / 1024, sb = b % 1024, swz = sb ^ (((sb >> 9) & 1) << 5); R = (st >> 1) * 16 + swz / 64; C = (st & 1) * 32 + (swz % 64) / 2; }
__host__ __device__ __forceinline__ int perm32(int rho) { const int n = rho >> 4, i = rho & 15; return 8 * (i >> 2) + 4 * n + (i & 3); }
struct Unit { int pm, pn; };
template <int SMODE> struct Sched {
    int nM, nN, nwg, G, c; const char* A; const char* Bt; size_t lda2, ldb2; const int* pst; size_t bstride2;
    __device__ __forceinline__ void init(int M, int N, int G_, int c_, const void* A_, const void* Bt_, int lda, int ldb, const int* pst_ = nullptr, size_t bstride = 0) {
        nM = M / BM; nN = N / BM; nwg = nM * nN; G = G_; c = c_; A = (const char*)A_; Bt = (const char*)Bt_; lda2 = (size_t)lda * 2; ldb2 = (size_t)ldb * 2; pst = pst_; bstride2 = bstride * 2; }
    __device__ __forceinline__ bool next(int i, Unit& u) const {
        if (c < 0) return false;
        const long L = (long)i * G + c; if (L >= nwg) return false;
        int wgid = (int)L; { const int q = nwg / NXCD, r = nwg % NXCD, xcd = wgid % NXCD, off = wgid / NXCD; wgid = (xcd < r ? xcd * (q + 1) : r * (q + 1) + (xcd - r) * q) + off; }
        const int nig = WGM * nN, gid = wgid / nig, fm = gid * WGM, gsz = (nM - fm) < WGM ? (nM - fm) : WGM;
        u.pm = fm + ((wgid % nig) % gsz); u.pn = (wgid % nig) / gsz; return true;
    }
    __device__ __forceinline__ const char* a_ptr(const Unit& u) const {
        if (SMODE == 1) return A + (size_t)u.pm * BM * lda2 + (size_t)u.pn * 512;
        if (SMODE == 2) return A + (size_t)u.pm * BM * lda2 + (size_t)((u.pn >> 2) * 256 + (u.pn & 3) * 64) * 2;
        return A + (size_t)u.pm * BM * lda2; }
    __device__ __forceinline__ const char* b_ptr(const Unit& u) const {
        if (SMODE == 2) return Bt + (size_t)(u.pn >> 2) * BM * ldb2;
        if (SMODE == 3) { const int m0 = u.pm * BM; int e = 0;
#pragma unroll
            for (int q = 1; q < NE; ++q) e += (m0 >= pst[q]); return Bt + (size_t)e * bstride2 + (size_t)u.pn * BM * ldb2; }
        return Bt + (size_t)u.pn * BM * ldb2; }
};
template <class F> struct EpiEl { static constexpr bool PERM = true, AFTER_DRAIN = false; F f;
    __device__ __forceinline__ void operator()(const f32x4 (&acc)[2][2][4][2], const Unit& u, int wr, int wc, int fr, int fq) const {
        const int row0 = u.pm * BM + wr * 64 + fr, col0 = u.pn * BM + wc * 32 + 8 * fq;
        typename F::Col cg[2][2];
#pragma unroll
        for (int bj = 0; bj < 2; ++bj)
#pragma unroll
            for (int n = 0; n < 2; ++n) cg[bj][n] = f.col(u.pm * BM, col0 + bj * HALF + n * 4);
        if constexpr (F::ROWLOAD) {
            f32x4 xv[2][2][4];
#pragma unroll
            for (int r = 0; r < 2; ++r)
#pragma unroll
                for (int c = 0; c < 4; ++c) xv[0][r][c] = f.rowload(row0 + r * 16, col0 + (c >> 1) * HALF + (c & 1) * 4);
#pragma unroll
            for (int b = 0; b < 4; ++b) {
                if (b + 1 < 4) {
#pragma unroll
                    for (int r = 0; r < 2; ++r)
#pragma unroll
                        for (int c = 0; c < 4; ++c) xv[(b + 1) & 1][r][c] = f.rowload(row0 + ((b + 1) >> 1) * HALF + (((b + 1) & 1) * 2 + r) * 16, col0 + (c >> 1) * HALF + (c & 1) * 4);
                }
#pragma unroll
                for (int r = 0; r < 2; ++r)
#pragma unroll
                    for (int bj = 0; bj < 2; ++bj) { const int ai = b >> 1, m = (b & 1) * 2 + r;
                        f.apply8(row0 + ai * HALF + m * 16, col0 + bj * HALF, acc[ai][bj][m][0], acc[ai][bj][m][1], cg[bj][0], cg[bj][1], xv[b & 1][r][bj * 2], xv[b & 1][r][bj * 2 + 1]); }
            }
        } else {
#pragma unroll
            for (int ai = 0; ai < 2; ++ai)
#pragma unroll
                for (int m = 0; m < 4; ++m)
#pragma unroll
                    for (int bj = 0; bj < 2; ++bj) f.apply8(row0 + ai * HALF + m * 16, col0 + bj * HALF, acc[ai][bj][m][0], acc[ai][bj][m][1], cg[bj][0], cg[bj][1]);
        } } };
template <class F> struct EpiPairEl { static constexpr bool PERM = true, AFTER_DRAIN = false; F f;
    __device__ __forceinline__ void operator()(const f32x4 (&acc)[2][2][4][2], const Unit& u, int wr, int wc, int fr, int fq) const {
        const int row0 = u.pm * BM + wr * 64 + fr, hc0 = u.pn * HALF + wc * 32 + 8 * fq;
        typename F::Col cg[2]; typename F::Row rw[2][4];
#pragma unroll
        for (int n = 0; n < 2; ++n) cg[n] = f.col(hc0 + n * 4);
#pragma unroll
        for (int ai = 0; ai < 2; ++ai)
#pragma unroll
            for (int m = 0; m < 4; ++m) rw[ai][m] = f.rowv(row0 + ai * HALF + m * 16);
#pragma unroll
        for (int ai = 0; ai < 2; ++ai)
#pragma unroll
            for (int m = 0; m < 4; ++m) f.pair8(row0 + ai * HALF + m * 16, hc0, acc[ai][0][m][0], acc[ai][1][m][0], acc[ai][0][m][1], acc[ai][1][m][1], cg[0], cg[1], rw[ai][m]); } };

typedef int i32x8 __attribute__((ext_vector_type(8)));
template <int QM> __device__ __forceinline__ void mma_block(f32x4 (&acc)[4][2], const bf16x8 (&At)[4][2], const bf16x8 (&Bt)[2][2], const int wsc) {
    __builtin_amdgcn_s_setprio(1);
    if constexpr (QM == 2) {
        typedef int i32x4m __attribute__((ext_vector_type(4)));
#pragma unroll
        for (int m = 0; m < 4; ++m)
#pragma unroll
            for (int n = 0; n < 2; ++n)
#pragma unroll
                for (int k = 0; k < 2; ++k) acc[m][n] = __builtin_bit_cast(f32x4, __builtin_amdgcn_mfma_i32_16x16x64_i8(__builtin_bit_cast(i32x4m, Bt[n][k]), __builtin_bit_cast(i32x4m, At[m][k]), __builtin_bit_cast(i32x4m, acc[m][n]), 0, 0, 0));
#pragma unroll
        for (int m = 0; m < 4; ++m) asm volatile("" : "+v"(acc[m][0]), "+v"(acc[m][1]));
    } else if constexpr (QM == 1) {
#pragma unroll
        for (int m = 0; m < 4; ++m) { const u32x4 a0 = __builtin_bit_cast(u32x4, At[m][0]), a1 = __builtin_bit_cast(u32x4, At[m][1]);
            const i32x8 a8 = {(int)a0.x, (int)a0.y, (int)a0.z, (int)a0.w, (int)a1.x, (int)a1.y, (int)a1.z, (int)a1.w};
#pragma unroll
            for (int n = 0; n < 2; ++n) { const u32x4 b0 = __builtin_bit_cast(u32x4, Bt[n][0]), b1 = __builtin_bit_cast(u32x4, Bt[n][1]);
                const i32x8 b8 = {(int)b0.x, (int)b0.y, (int)b0.z, (int)b0.w, (int)b1.x, (int)b1.y, (int)b1.z, (int)b1.w};
                acc[m][n] = __builtin_amdgcn_mfma_scale_f32_16x16x128_f8f6f4(b8, a8, acc[m][n], 0, 0, 0, wsc, 0, 127); } }
#pragma unroll
        for (int m = 0; m < 4; ++m) asm volatile("" : "+v"(acc[m][0]), "+v"(acc[m][1]));
    } else {
#pragma unroll
        for (int m = 0; m < 4; ++m)
#pragma unroll
            for (int n = 0; n < 2; ++n)
#pragma unroll
                for (int k = 0; k < 2; ++k) acc[m][n] = __builtin_amdgcn_mfma_f32_16x16x32_bf16(Bt[n][k], At[m][k], acc[m][n], 0, 0, 0);
    }
    __builtin_amdgcn_s_setprio(0);
}
template <class Epi, class Sched, bool ALIGN_EPI = true, bool SP2 = true, int QM = 0>
__device__ __forceinline__ void gemm_phase(PG8_LAS unsigned char* lds, const int K, const int lda, const int ldb, const size_t kstepA, const Sched& S, const Epi& E, const int wsc = 127) {
    const int tid_ = opaque_tid();
    const int tid = tid_, wid = __builtin_amdgcn_readfirstlane(tid >> 6), lane = tid & 63, wr = wid >> 2, wc = wid & 3, fr = lane & 15, fq = lane >> 4;
    const int nt = K / BK;
    unsigned voffA[2], voffB[2];
#pragma unroll
    for (int i = 0; i < 2; ++i) { int R, C; stage_rc(tid * 16 + i * 8192, R, C); const int Rb = Epi::PERM ? ((R & ~31) + perm32(R & 31)) : R;
        voffA[i] = (unsigned)(R * lda + C) * 2u; voffB[i] = (unsigned)(Rb * ldb + C) * 2u; }
    const size_t kstepB = (size_t)(BK * 2);
    const size_t hstepA = (size_t)HALF * lda * 2, hstepB = (size_t)HALF * ldb * 2;
    const unsigned ldsw = (unsigned)wid * 1024u;
    int aoffk[2], boffk[2];
#pragma unroll
    for (int k = 0; k < 2; ++k) { const int col = (QM == 1) ? ((fq >> 1) * 32 + (fq & 1) * 16 + 8 * k) : (k * 32 + fq * 8); aoffk[k] = lds_byte(wr * 64 + fr, col); boffk[k] = lds_byte(wc * 32 + fr, col); }
#define PG8_SA(b, h) (((b) * 2 + (h)) * HTB)
#define PG8_SB(b, h) ((4 + (b) * 2 + (h)) * HTB)
#define PG8_STAGE(bufoff, gbase, voff) do { _Pragma("unroll") for (int _i = 0; _i < 2; ++_i) \
        __builtin_amdgcn_global_load_lds((const unsigned*)((const char*)(gbase) + (voff)[_i]), (PG8_LAS unsigned*)(lds + (bufoff) + ldsw + _i * 8192), 16, 0, 0); } while (0)
#define PG8_LDA(dst, b, h) do { _Pragma("unroll") for (int m = 0; m < 4; ++m) _Pragma("unroll") for (int k = 0; k < 2; ++k) dst[m][k] = *(const PG8_LAS bf16x8*)(lds + PG8_SA(b, h) + ((QM == 1) ? aoffk[k] : aoffk[0] + k * 1024) + m * 2048); } while (0)
#define PG8_LDB(dst, b, h) do { _Pragma("unroll") for (int n = 0; n < 2; ++n) _Pragma("unroll") for (int k = 0; k < 2; ++k) dst[n][k] = *(const PG8_LAS bf16x8*)(lds + PG8_SB(b, h) + ((QM == 1) ? boffk[k] : boffk[0] + k * 1024) + n * 2048); } while (0)
#define PG8_MMA(ai, bj, At, Bt) mma_block<QM>(acc[ai][bj], At, Bt, wsc)
#define PG8_WAIT_V(n) asm volatile("s_waitcnt vmcnt(" #n ")" ::: "memory")
#define PG8_WAIT_L(n) asm volatile("s_waitcnt lgkmcnt(" #n ")" ::: "memory")
#define PG8_BAR __builtin_amdgcn_s_barrier()
#define PG8_SCHED __builtin_amdgcn_sched_barrier(0)
    Unit cur, nxt; int ui = 0;
    if (!S.next(0, cur)) return;
    f32x4 acc[2][2][4][2];
#pragma unroll
    for (int a = 0; a < 2; ++a)
#pragma unroll
        for (int b = 0; b < 2; ++b)
#pragma unroll
            for (int m = 0; m < 4; ++m)
#pragma unroll
                for (int n = 0; n < 2; ++n) acc[a][b][m][n] = (f32x4){0.f, 0.f, 0.f, 0.f};
    bf16x8 At[4][2], B0[2][2], B1[2][2];
    const char* cA = S.a_ptr(cur); const char* cB = S.b_ptr(cur);
    if constexpr (SP2) {
        PG8_STAGE(PG8_SB(0, 0), cB, voffB); PG8_STAGE(PG8_SB(0, 1), cB + hstepB, voffB); PG8_STAGE(PG8_SA(0, 0), cA, voffA); PG8_STAGE(PG8_SA(0, 1), cA + hstepA, voffA);
        if (wr == 1) PG8_BAR;
        PG8_WAIT_V(2); PG8_BAR;
        PG8_STAGE(PG8_SB(1, 0), cB + kstepB, voffB); PG8_STAGE(PG8_SA(1, 0), cA + kstepA, voffA); PG8_STAGE(PG8_SB(1, 1), cB + hstepB + kstepB, voffB);
        PG8_WAIT_V(6); PG8_BAR;
    } else {
        PG8_STAGE(PG8_SB(0, 0), cB, voffB); PG8_STAGE(PG8_SA(0, 0), cA, voffA); PG8_STAGE(PG8_SB(0, 1), cB + hstepB, voffB); PG8_STAGE(PG8_SA(0, 1), cA + hstepA, voffA);
        if (wr == 1) PG8_BAR;
        PG8_WAIT_V(4); PG8_BAR;
        PG8_STAGE(PG8_SB(1, 0), cB + kstepB, voffB); PG8_STAGE(PG8_SA(1, 0), cA + kstepA, voffA); PG8_STAGE(PG8_SB(1, 1), cB + hstepB + kstepB, voffB);
        PG8_WAIT_V(6); PG8_BAR;
    }
    for (;;) {
        const bool has_next = S.next(ui + 1, nxt);
        const char* nA = has_next ? S.a_ptr(nxt) : cA; const char* nB = has_next ? S.b_ptr(nxt) : cB;
        for (int t = 0; t < nt; t += 2) {
            const bool last = (t == nt - 2);
            const char* a1 = cA + (size_t)(t + 1) * kstepA;
            const char* a2 = last ? nA : cA + (size_t)(t + 2) * kstepA; const char* b2 = last ? nB : cB + (size_t)(t + 2) * kstepB;
            const char* a3 = a2 + kstepA; const char* b3 = b2 + kstepB;
            if constexpr (SP2) {
            PG8_LDB(B0, 0, 0); PG8_LDB(B1, 0, 1); PG8_SCHED; PG8_LDA(At, 0, 0); PG8_STAGE(PG8_SA(1, 1), a1 + hstepA, voffA);
            PG8_WAIT_V(8); PG8_WAIT_L(0); PG8_BAR; PG8_MMA(0, 0, At, B0); PG8_MMA(0, 1, At, B1); PG8_BAR; PG8_SCHED;
            PG8_LDA(At, 0, 1); PG8_STAGE(PG8_SB(0, 0), b2, voffB); PG8_STAGE(PG8_SB(0, 1), b2 + hstepB, voffB); PG8_STAGE(PG8_SA(0, 0), a2, voffA);
            PG8_WAIT_V(8); PG8_WAIT_L(0); PG8_BAR; PG8_MMA(1, 0, At, B0); PG8_MMA(1, 1, At, B1); PG8_BAR; PG8_SCHED;
            PG8_LDB(B0, 1, 0); PG8_LDB(B1, 1, 1); PG8_SCHED; PG8_LDA(At, 1, 0); PG8_STAGE(PG8_SA(0, 1), a2 + hstepA, voffA);
            PG8_WAIT_V(8); PG8_WAIT_L(0); PG8_BAR; PG8_MMA(0, 0, At, B0); PG8_MMA(0, 1, At, B1); PG8_BAR; PG8_SCHED;
            PG8_LDA(At, 1, 1); PG8_STAGE(PG8_SB(1, 0), b3, voffB); PG8_STAGE(PG8_SB(1, 1), b3 + hstepB, voffB); PG8_STAGE(PG8_SA(1, 0), a3, voffA);
            PG8_WAIT_V(8); PG8_WAIT_L(0); PG8_BAR; PG8_MMA(1, 0, At, B0); PG8_MMA(1, 1, At, B1); PG8_BAR; PG8_SCHED;
            } else {
            PG8_LDB(B0, 0, 0); PG8_SCHED; PG8_LDA(At, 0, 0); PG8_STAGE(PG8_SA(1, 1), a1 + hstepA, voffA);
            PG8_WAIT_L(8); PG8_BAR; PG8_WAIT_L(0); PG8_MMA(0, 0, At, B0); PG8_BAR; PG8_SCHED;
            PG8_LDB(B1, 0, 1); PG8_STAGE(PG8_SB(0, 0), b2, voffB);
            PG8_BAR; PG8_WAIT_L(0); PG8_MMA(0, 1, At, B1); PG8_BAR;
            PG8_LDA(At, 0, 1); PG8_STAGE(PG8_SA(0, 0), a2, voffA);
            PG8_BAR; PG8_WAIT_L(0); PG8_MMA(1, 0, At, B0); PG8_BAR; PG8_SCHED;
            PG8_STAGE(PG8_SB(0, 1), b2 + hstepB, voffB);
            PG8_WAIT_V(6); PG8_BAR; PG8_MMA(1, 1, At, B1); PG8_BAR;
            PG8_LDB(B0, 1, 0); PG8_SCHED; PG8_LDA(At, 1, 0); PG8_STAGE(PG8_SA(0, 1), a2 + hstepA, voffA);
            PG8_WAIT_L(8); PG8_BAR; PG8_WAIT_L(0); PG8_MMA(0, 0, At, B0); PG8_BAR; PG8_SCHED;
            PG8_LDB(B1, 1, 1); PG8_STAGE(PG8_SB(1, 0), b3, voffB);
            PG8_BAR; PG8_WAIT_L(0); PG8_MMA(0, 1, At, B1); PG8_BAR;
            PG8_LDA(At, 1, 1); PG8_STAGE(PG8_SA(1, 0), a3, voffA);
            PG8_BAR; PG8_WAIT_L(0); PG8_MMA(1, 0, At, B0); PG8_BAR; PG8_SCHED;
            PG8_STAGE(PG8_SB(1, 1), b3 + hstepB, voffB);
            PG8_WAIT_V(6); PG8_BAR; PG8_MMA(1, 1, At, B1); PG8_BAR;
            }
        }
        if constexpr (ALIGN_EPI) { if (wr == 0) PG8_BAR; }
        if constexpr (!Epi::AFTER_DRAIN) { E(acc, cur, wr, wc, fr, fq); }
        if (!has_next) break;
#pragma unroll
        for (int a = 0; a < 2; ++a)
#pragma unroll
            for (int b = 0; b < 2; ++b)
#pragma unroll
                for (int m = 0; m < 4; ++m)
#pragma unroll
                    for (int n = 0; n < 2; ++n) acc[a][b][m][n] = (f32x4){0.f, 0.f, 0.f, 0.f};
        cur = nxt; cA = nA; cB = nB; ++ui;
        if constexpr (ALIGN_EPI) { if (wr == 1) PG8_BAR; }
    }
    PG8_WAIT_V(0);
    if constexpr (!ALIGN_EPI) { if (wr == 0) PG8_BAR; }
    PG8_BAR;
    if constexpr (Epi::AFTER_DRAIN) { E.fused(acc, cur, wr, wc, fr, fq, lds, wid, lane); }
#undef PG8_SA
#undef PG8_SB
#undef PG8_STAGE
#undef PG8_LDA
#undef PG8_LDB
#undef PG8_MMA
#undef PG8_WAIT_V
#undef PG8_WAIT_L
#undef PG8_BAR
#undef PG8_SCHED
}
}

__device__ __forceinline__ void phase_headnorm(const Params& p, LAS unsigned char* lds) {
    const int tid = opaque_tid(), lane = tid & 63, wave = tid >> 6;
    LAS int* chunk = (LAS int*)(lds + 131072 - 64);
    bf16_t* Q = (bf16_t*)(p.ws + WS_Q); bf16_t* KVB = (bf16_t*)(p.ws + WS_KVB);
    float qg[16], kg[8];
#pragma unroll
    for (int i = 0; i < 16; ++i) qg[i] = p.q_gain[(lane & 3) * 16 + i] * (0.125f * 1.4426950408889634f);
    const int kr = lane >> 5;
#pragma unroll
    for (int i = 0; i < 8; ++i) kg[i] = p.k_gain[(1 + kr) * 64 + (lane & 7) * 8 + i];
    for (;;) {
      if (tid == 0) *chunk = (int)atomicAdd((unsigned*)(p.ws + WS_CTL) + CW_HN, 1u);
      __syncthreads();
      const int c0 = *chunk;
      __syncthreads();
      if (c0 >= T / 128) break;
      for (int r = c0 * 128 + wave * 16; r < c0 * 128 + wave * 16 + 16; ++r) {
        {
            u32x4* ptr = (u32x4*)(Q + (size_t)r * D + lane * 16); u32x4 w0 = ptr[0], w1 = ptr[1];
            float v[16]; const unsigned ww[8] = {w0.x, w0.y, w0.z, w0.w, w1.x, w1.y, w1.z, w1.w}; float s = 0.f;
#pragma unroll
            for (int i = 0; i < 8; ++i) { v[2 * i] = bflo(ww[i]); v[2 * i + 1] = bfhi(ww[i]); s += v[2 * i] * v[2 * i] + v[2 * i + 1] * v[2 * i + 1]; }
            s += __shfl_xor(s, 1); s += __shfl_xor(s, 2);
            const float rstd = 1.f / sqrtf(s * (1.f / 64.f) + EPS);
            unsigned o[8];
#pragma unroll
            for (int i = 0; i < 8; ++i) o[i] = cvt_pk_bf16(v[2 * i] * rstd * qg[2 * i], v[2 * i + 1] * rstd * qg[2 * i + 1]);
            ptr[0] = (u32x4){o[0], o[1], o[2], o[3]}; ptr[1] = (u32x4){o[4], o[5], o[6], o[7]};
        }
        {
            const u32x4* ptr = (const u32x4*)(KVB + (size_t)r * NKV + (kr ? 1024 : 512) + (lane & 31) * 8); const u32x4 w0 = ptr[0];
            float v[8]; const unsigned ww[4] = {w0.x, w0.y, w0.z, w0.w}; float s = 0.f;
#pragma unroll
            for (int i = 0; i < 4; ++i) { v[2 * i] = bflo(ww[i]); v[2 * i + 1] = bfhi(ww[i]); s += v[2 * i] * v[2 * i] + v[2 * i + 1] * v[2 * i + 1]; }
            s += __shfl_xor(s, 1); s += __shfl_xor(s, 2); s += __shfl_xor(s, 4);
            const float rstd = 1.f / sqrtf(s * (1.f / 64.f) + EPS);
            unsigned o[4];
#pragma unroll
            for (int i = 0; i < 4; ++i) o[i] = cvt_pk_bf16(v[2 * i] * rstd * kg[2 * i], v[2 * i + 1] * rstd * kg[2 * i + 1]);
            const int b = r >> 13, t = r & (S - 1), hg = (lane & 31) >> 3, c = lane & 7;
            {
                bf16_t* dst = (bf16_t*)(p.ws + (kr ? WS_KWB : WS_KSB)) + ((size_t)((b * 4 + hg) * 128 + (t >> 6)) * 8 + c) * 512 + (t & 63) * 8;
                *(u32x4*)dst = (u32x4){o[0], o[1], o[2], o[3]};
            }
        }
      }
    }
}

__device__ __forceinline__ void phase_cmp2(const Params& p, LAS unsigned char* lds) {
    const int tid = opaque_tid(), lane = tid & 63, wave = tid >> 6;
    const int gw = blockIdx.x * NWAVE + wave, NGW = gridDim.x * NWAVE;
    const bf16_t* CMPH = (const bf16_t*)(p.ws + WS_CMPH);
    LAS float* w2l = (LAS float*)lds;
    for (int kv = 0; kv < 2; ++kv) {
        const float* w2 = kv ? p.cmp_v_w2 : p.cmp_k_w2;
        for (int i = tid; i < 256 * 64 / 4; i += NTHR) ((LAS f32x4*)w2l)[i] = ((const f32x4*)w2)[i];
        __syncthreads();
        for (int it = gw * 2; it < 4 * 2048; it += NGW * 2) {
            float hv[2][4], acc[2] = {0.f, 0.f};
#pragma unroll
            for (int rr = 0; rr < 2; ++rr) { const u32x2 w = *(const u32x2*)(CMPH + (size_t)(kv * 8192 + it + rr) * 256 + 4 * lane); hv[rr][0] = bflo(w.x); hv[rr][1] = bfhi(w.x); hv[rr][2] = bflo(w.y); hv[rr][3] = bfhi(w.y); }
#pragma unroll 4
            for (int kk = 0; kk < 64; ++kk)
#pragma unroll
                for (int c = 0; c < 4; ++c) { const float wv = w2l[(4 * kk + c) * 64 + lane];
                    acc[0] += readlane_f(hv[0][c], kk) * wv; acc[1] += readlane_f(hv[1][c], kk) * wv; }
#pragma unroll
            for (int rr = 0; rr < 2; ++rr) {
                const int row = it + rr, g = (row >> 11) & 3, r2 = row & 2047, b = r2 >> 9, n = r2 & 511; float a = n == NC - 1 ? 0.f : acc[rr];
                if (kv == 0) { const float ss = wave_sum(a * a); a = a * (1.f / sqrtf(ss * (1.f / 64.f) + EPS)) * p.k_gain[lane]; }
                const size_t blk0 = (size_t)((b * 4 + g) * 8 + (n >> 6)) * 4096;
                bf16_t* o = kv ? (bf16_t*)(p.ws + WS_VC) + blk0 + ((n & 63) >> 3) * 512 + lane * 8 + (n & 7)
                               : (bf16_t*)(p.ws + WS_KC) + blk0 + (lane >> 3) * 512 + (n & 63) * 8 + (lane & 7);
                *o = (bf16_t)(cvt_pk_bf16(a, 0.f) & 0xffffu);
            }
        }
        __syncthreads();
    }
}

__device__ __forceinline__ void phase_vtrans(const Params& p, LAS unsigned char* lds) {
    const int tid = opaque_tid(), lane = tid & 63, wave = tid >> 6;
    const int gw = blockIdx.x * NWAVE + wave, NGW = gridDim.x * NWAVE;
    LAS unsigned short* tile = (LAS unsigned short*)(lds + wave * 8448);
    const bf16_t* KVB = (const bf16_t*)(p.ws + WS_KVB);
    LAS int* chunk = (LAS int*)(lds + 131072 - 64);
    for (;;) {
        if (tid == 0) *chunk = (int)atomicAdd((unsigned*)(p.ws + WS_CTL) + CW_VT, 1u);
        __syncthreads();
        const int c0 = *chunk;
        __syncthreads();
        if (c0 >= 2 * 16 * 128 / NWAVE) break;
        const int u = c0 * NWAVE + wave;
        const int which = u >> 11, bg = (u >> 7) & 15, tt = u & 127, b = bg >> 2, g = bg & 3, t0 = tt * 64;
        const u32x4* src = (const u32x4*)(KVB + (size_t)(b * S + t0 + lane) * NKV + (which ? 1280 : 768) + g * 64);
#pragma unroll
        for (int i = 0; i < 8; ++i) { const u32x4 v = src[i]; LAS unsigned* tp = (LAS unsigned*)(tile + lane * 66 + 8 * i); tp[0] = v.x; tp[1] = v.y; tp[2] = v.z; tp[3] = v.w; }
        asm volatile("s_waitcnt lgkmcnt(0)" ::: "memory");
        {
            bf16_t* dst = (bf16_t*)(p.ws + (which ? WS_VWB : WS_VSB)) + (size_t)(bg * 128 + tt) * 4096 + lane * 8;
#pragma unroll
            for (int i = 0; i < 8; ++i) { unsigned w[4];
#pragma unroll
                for (int q = 0; q < 4; ++q) { const unsigned lo = tile[(8 * i + 2 * q) * 66 + lane], hi = tile[(8 * i + 2 * q + 1) * 66 + lane]; w[q] = lo | (hi << 16); }
                *(u32x4*)(dst + i * 512) = (u32x4){w[0], w[1], w[2], w[3]}; }
        }
        asm volatile("s_waitcnt lgkmcnt(0)" ::: "memory");
    }
}

typedef short s16x4 __attribute__((ext_vector_type(4)));
__device__ __forceinline__ f32x4 mfma4(s16x4 a, s16x4 b, f32x4 c) { return __builtin_amdgcn_mfma_f32_4x4x4bf16_1k(a, b, c, 0, 0, 0); }
__device__ __forceinline__ s16x4 mk4(unsigned lo, unsigned hi) { const u32x2 t = {lo, hi}; return __builtin_bit_cast(s16x4, t); }
__device__ __forceinline__ f32x4 qk64(const bf16_t* krow, const s16x4 (&qf)[16]) {
    const u32x4* kp = (const u32x4*)krow; u32x4 kr[8];
#pragma unroll
    for (int i = 0; i < 8; ++i) kr[i] = kp[i];
    f32x4 s = {0.f, 0.f, 0.f, 0.f};
#pragma unroll
    for (int c = 0; c < 8; ++c) { s = mfma4(mk4(kr[c].x, kr[c].y), qf[2 * c], s); s = mfma4(mk4(kr[c].z, kr[c].w), qf[2 * c + 1], s); }
    return s;
}
__device__ __forceinline__ void pv64(f32x4& o, const f32x4 e, const bf16_t* vtrow, LAS u32x2* stage, int lane) {
    const u32x4* vp = (const u32x4*)vtrow; u32x4 vr[8];
#pragma unroll
    for (int i = 0; i < 8; ++i) vr[i] = vp[i];
    u32x2 pk; pk.x = cvt_pk_bf16(e.x, e.y); pk.y = cvt_pk_bf16(e.z, e.w);
    stage[lane] = pk;
#pragma unroll
    for (int st = 0; st < 16; ++st) { const u32x2 a = stage[4 * st + (lane & 3)]; const u32x4 v = vr[st >> 1];
        o = mfma4(mk4(a.x, a.y), (st & 1) ? mk4(v.z, v.w) : mk4(v.x, v.y), o); }
}
__device__ __forceinline__ float quadx_sum(float v) { v += __shfl_xor(v, 4); v += __shfl_xor(v, 8); v += __shfl_xor(v, 16); v += __shfl_xor(v, 32); return v; }

constexpr int HBN = 800;
constexpr int ATT_HBD = 0, ATT_MH = 51200, ATT_PSLC = 53248, ATT_STAGE = 118784;
__device__ __forceinline__ void attn_tables(const Params& p, LAS unsigned char* lds) {
    const int tid = opaque_tid();
    LAS float* hbd = (LAS float*)(lds + ATT_HBD); LAS float* mh = (LAS float*)(lds + ATT_MH);
    for (int i = tid; i < 16 * HBN; i += NTHR) { const int hd = i / HBN, d = i - hd * HBN; const float v = p.rel_bias[rel_bucket(d) * NH + hd] * 1.4426950408889634f; hbd[i] = v; if (blockIdx.x == 0) ((float*)(p.ws + WS_HBG))[i] = v; }
    if (tid < 16) { float qg = 0.f, kg = 0.f, bm = -3.0e38f;
        for (int i = 0; i < 64; ++i) qg = fmaxf(qg, fabsf(p.q_gain[i]));
        for (int i = 0; i < 192; ++i) kg = fmaxf(kg, fabsf(p.k_gain[i]));
        for (int i = 0; i < 32; ++i) bm = fmaxf(bm, p.rel_bias[i * NH + tid]);
        const float mv = (qg * kg * 8.f * 1.02f + bm) * 1.4426950408889634f; mh[tid] = mv; if (blockIdx.x == 0) ((float*)(p.ws + WS_MHG))[tid] = mv; }
    __syncthreads();
}
typedef float f32x16 __attribute__((ext_vector_type(16)));
__device__ __forceinline__ f32x16 mfma32(bf16x8 a, bf16x8 b, f32x16 c) { return __builtin_amdgcn_mfma_f32_32x32x16_bf16(a, b, c, 0, 0, 0); }
struct DFrag { bf16x8 ka[4]; bf16x8 va[2][2]; };
__device__ __forceinline__ void dense_load_k(bf16x8 (&ka)[4], const bf16_t* KB, int kt, int l31, int h) {
    const int blk = kt >> 6, hh = (kt >> 5) & 1;
    const bf16_t* kb = KB + (size_t)blk * 4096 + (32 * hh + l31) * 8;
#pragma unroll
    for (int ks = 0; ks < 4; ++ks) ka[ks] = *(const bf16x8*)(kb + (2 * ks + h) * 512);
}
__device__ __forceinline__ void dense_load_v(bf16x8 (&va)[2][2], const bf16_t* VB, int kt, int l31, int h) {
    const int blk = kt >> 6, hh = (kt >> 5) & 1;
    const bf16_t* vb = VB + (size_t)blk * 4096 + l31 * 8 + 4 * h;
#pragma unroll
    for (int dt = 0; dt < 2; ++dt)
#pragma unroll
        for (int st = 0; st < 2; ++st) { const bf16_t* q0 = vb + (4 * hh + 2 * st) * 512 + dt * 256; const u32x2 lo = *(const u32x2*)q0, hi = *(const u32x2*)(q0 + 512);
            const u32x4 w = {lo.x, lo.y, hi.x, hi.y}; va[dt][st] = __builtin_bit_cast(bf16x8, w); }
}
__device__ __forceinline__ f32x16 dense_scores(const DFrag& f, const bf16x8 (&q)[4]) {
    f32x16 sacc;
#pragma unroll
    for (int i = 0; i < 16; ++i) sacc[i] = 0.f;
#pragma unroll
    for (int ks = 0; ks < 4; ++ks) sacc = mfma32(f.ka[ks], q[ks], sacc);
    return sacc;
}
__device__ __forceinline__ void dense_pv(f32x16 (&O)[2], const DFrag& f, const float (&ev)[16]) {
    bf16x8 pb[2];
#pragma unroll
    for (int st = 0; st < 2; ++st) { const u32x4 w = {cvt_pk_bf16(ev[8 * st], ev[8 * st + 1]), cvt_pk_bf16(ev[8 * st + 2], ev[8 * st + 3]), cvt_pk_bf16(ev[8 * st + 4], ev[8 * st + 5]), cvt_pk_bf16(ev[8 * st + 6], ev[8 * st + 7])};
        pb[st] = __builtin_bit_cast(bf16x8, w); }
#pragma unroll
    for (int dt = 0; dt < 2; ++dt)
#pragma unroll
        for (int st = 0; st < 2; ++st) O[dt] = mfma32(f.va[dt][st], pb[st], O[dt]);
}
__device__ __forceinline__ void phase_dense(const Params& p, LAS unsigned char* lds, bf16_t* OW) {
    const int tid = opaque_tid(), lane0 = tid & 63, wave = tid >> 6;
    const LAS float* hbd = (const LAS float*)(lds + ATT_HBD); const LAS float* mh = (const LAS float*)(lds + ATT_MH);
    LAS float* pslc = (LAS float*)(lds + ATT_PSLC) + wave * 2048;
    const bf16_t* Q = (const bf16_t*)(p.ws + WS_Q); const float* GATE = (const float*)(p.ws + WS_GATE);
    short* SEL = (short*)(p.ws + WS_SEL);
    const int Gn = gridDim.x, vcu = (Gn % 8 == 0) ? (blockIdx.x % 8) * (Gn / 8) + blockIdx.x / 8 : blockIdx.x;
    for (int u = vcu * NWAVE + wave; u < T * G / 16; u += Gn * NWAVE) {
        int lane = lane0; asm volatile("" : "+v"(lane));
        const int l31 = lane & 31, h = lane >> 5;
        const int bg = u >> 9, t0 = (((u & 511) + 128 * (u >> 11)) & 511) * 16, b = bg >> 2, g = bg & 3, head = 4 * g + (lane & 3);
        const LAS float* hb = hbd + head * HBN; const float mhv = mh[head];
        int tok[2]; bf16x8 qf[2][4];
#pragma unroll
        for (int r = 0; r < 2; ++r) { tok[r] = t0 + 8 * r + (l31 >> 2); const bf16_t* qp = Q + (size_t)(b * S + tok[r]) * D + head * 64 + 8 * h;
#pragma unroll
            for (int ks = 0; ks < 4; ++ks) qf[r][ks] = *(const bf16x8*)(qp + 16 * ks); }
        f32x16 O[2][2];
#pragma unroll
        for (int r = 0; r < 2; ++r)
#pragma unroll
            for (int dt = 0; dt < 2; ++dt)
#pragma unroll
                for (int q = 0; q < 16; ++q) O[r][dt][q] = 0.f;
        DFrag cur; bf16x8 nxtk[4];
        {
            const bf16_t* KB = (const bf16_t*)(p.ws + WS_KWB) + (size_t)bg * 128 * 4096; const bf16_t* VB = (const bf16_t*)(p.ws + WS_VWB) + (size_t)bg * 128 * 4096;
            float lw[2] = {0.f, 0.f};
            const int lo = t0 - (WIN - 1) > 0 ? t0 - (WIN - 1) : 0, kt_last = t0 & ~31;
            dense_load_k(cur.ka, KB, lo & ~31, l31, h);
            for (int kt = lo & ~31; kt <= kt_last; kt += 32) {
                dense_load_v(cur.va, VB, kt, l31, h);
                dense_load_k(nxtk, KB, kt + 32 <= kt_last ? kt + 32 : kt_last, l31, h);
                __builtin_amdgcn_sched_barrier(0);
#pragma unroll
                for (int r = 0; r < 2; ++r) {
                    const f32x16 sacc = dense_scores(cur, qf[r]);
                    const int dbase = tok[r] - kt - 4 * h; float ev[16];
                    if (kt + 31 <= t0 + 8 * r && kt >= t0 + 8 * r + 7 - (WIN - 1)) {
                        const LAS float* hbp = hb + dbase;
#pragma unroll
                        for (int q = 0; q < 16; ++q) { const float e = __builtin_amdgcn_exp2f(sacc[q] + hbp[-((q & 3) + 8 * (q >> 2))] - mhv); ev[q] = e; lw[r] += e; }
                    } else {
#pragma unroll
                    for (int q = 0; q < 16; ++q) { const int dist = dbase - ((q & 3) + 8 * (q >> 2)); const bool ok = (unsigned)dist < (unsigned)WIN;
                        const float e0 = __builtin_amdgcn_exp2f(sacc[q] + hb[ok ? dist : 0] - mhv); const float e = ok ? e0 : 0.f; ev[q] = e; lw[r] += e; }
                    }
                    dense_pv(O[r], cur, ev);
                }
#pragma unroll
                for (int ks = 0; ks < 4; ++ks) cur.ka[ks] = nxtk[ks];
            }
#pragma unroll
            for (int r = 0; r < 2; ++r) { const float l = lw[r] + __shfl_xor(lw[r], 32); int tk = tok[r]; asm volatile("" : "+v"(tk)); const float* gp = GATE + (size_t)(b * S + tk) * 48 + head * 3;
                const float sc = gp[2] / (l * gp[0]);
#pragma unroll
                for (int dt = 0; dt < 2; ++dt) O[r][dt] = O[r][dt] * sc; }
        }
        const int ncmax = t0 >> 4;
        {
            int l31c = l31, hc = h; asm volatile("" : "+v"(l31c), "+v"(hc));
            const bf16_t* KB = (const bf16_t*)(p.ws + WS_KC) + (size_t)bg * 8 * 4096; const bf16_t* VB = (const bf16_t*)(p.ws + WS_VC) + (size_t)bg * 8 * 4096;
            float lc[2] = {0.f, 0.f};
            const int kt_last = ncmax > 0 ? ((ncmax - 1) & ~31) : -32;
            if (ncmax > 0) {
                dense_load_k(cur.ka, KB, 0, l31c, hc);
                for (int kt = 0; kt <= kt_last; kt += 32) {
                    dense_load_k(nxtk, KB, kt + 32 <= kt_last ? kt + 32 : kt_last, l31c, hc);
                    __builtin_amdgcn_sched_barrier(0);
#pragma unroll
                    for (int r = 0; r < 2; ++r) {
                        const f32x16 sacc = dense_scores(cur, qf[r]);
                        if (t0 - 31 - 16 * (kt + 31) >= HBN - 1) {
                            const float bfar = hb[HBN - 1] - mhv;
#pragma unroll
                            for (int q = 0; q < 16; ++q) lc[r] += __builtin_amdgcn_exp2f(sacc[q] + bfar);
                        } else {
                        const int dbase = tok[r] - 31 - 16 * (kt + 4 * hc);
#pragma unroll
                        for (int q = 0; q < 16; ++q) { const int dist = dbase - 16 * ((q & 3) + 8 * (q >> 2)); const int di = dist < 0 ? 0 : (dist > HBN - 1 ? HBN - 1 : dist);
                            const float e0 = __builtin_amdgcn_exp2f(sacc[q] + hb[di] - mhv); lc[r] += dist >= 0 ? e0 : 0.f; }
                        }
                    }
#pragma unroll
                    for (int ks = 0; ks < 4; ++ks) cur.ka[ks] = nxtk[ks];
                }
            }
            float linv[2];
#pragma unroll
            for (int r = 0; r < 2; ++r) { const float l = lc[r] + __shfl_xor(lc[r], 32); linv[r] = l > 0.f ? 1.f / l : 0.f; }
            { const f32x4 z = {0.f, 0.f, 0.f, 0.f};
#pragma unroll
              for (int i = 0; i < 8; ++i) *(LAS f32x4*)(pslc + (i * 64 + lane) * 4) = z; }
            if (ncmax > 0) {
                float carry[2] = {0.f, 0.f};
                dense_load_k(cur.ka, KB, 0, l31c, hc);
                for (int kt = 0; kt <= kt_last; kt += 32) {
                    dense_load_v(cur.va, VB, kt, l31c, hc);
                    dense_load_k(nxtk, KB, kt + 32 <= kt_last ? kt + 32 : kt_last, l31c, hc);
                    __builtin_amdgcn_sched_barrier(0);
#pragma unroll
                    for (int r = 0; r < 2; ++r) {
                        const f32x16 sacc = dense_scores(cur, qf[r]);
                        float pv[16];
                        const int dbase = tok[r] - 31 - 16 * (kt + 4 * hc);
#pragma unroll
                        for (int q = 0; q < 16; ++q) { const int dist = dbase - 16 * ((q & 3) + 8 * (q >> 2)); const int di = dist < 0 ? 0 : (dist > HBN - 1 ? HBN - 1 : dist);
                            const float e0 = __builtin_amdgcn_exp2f(sacc[q] + hb[di] - mhv); pv[q] = dist >= 0 ? e0 * linv[r] : 0.f; }
                        dense_pv(O[r], cur, pv);
#pragma unroll
                        for (int q = 0; q < 16; ++q) { pv[q] += __shfl_xor(pv[q], 1); pv[q] += __shfl_xor(pv[q], 2); }
                        float y[4];
#pragma unroll
                        for (int gq = 0; gq < 4; ++gq) y[gq] = __shfl_xor(pv[4 * gq + 3], 32);
#pragma unroll
                        for (int gq = 0; gq < 4; ++gq) { const float prevv = h ? y[gq] : (gq > 0 ? y[gq > 0 ? gq - 1 : 0] : carry[r]);
                            const float val = 2.f * ((pv[4 * gq] + pv[4 * gq + 1]) + pv[4 * gq + 2]) + pv[4 * gq + 3] + prevv;
                            if ((lane & 3) == 0) pslc[(8 * r + (l31c >> 2)) * 128 + (kt >> 2) + 2 * gq + hc] = val; }
                        carry[r] = y[3];
                    }
#pragma unroll
                    for (int ks = 0; ks < 4; ++ks) cur.ka[ks] = nxtk[ks];
                }
            }
        }
#pragma unroll
        for (int r = 0; r < 2; ++r) { int tk = tok[r]; asm volatile("" : "+v"(tk)); bf16_t* op = OW + (size_t)(b * S + tk) * D + head * 64 + 4 * h; const float gc = GATE[(size_t)(b * S + tk) * 48 + head * 3];
#pragma unroll
            for (int dt = 0; dt < 2; ++dt)
#pragma unroll
                for (int gq = 0; gq < 4; ++gq) { u32x2 w; w.x = cvt_pk_bf16(O[r][dt][4 * gq] * gc, O[r][dt][4 * gq + 1] * gc); w.y = cvt_pk_bf16(O[r][dt][4 * gq + 2] * gc, O[r][dt][4 * gq + 3] * gc);
                    *(u32x2*)(op + dt * 32 + 8 * gq) = w; } }
#pragma unroll 1
        for (int tl = 0; tl < 16; ++tl) {
            int ln = lane; asm volatile("" : "+v"(ln));
            const int t = t0 + tl, cur_b = t >> 6, j0 = ln, j1 = ln + 64;
            const float c0 = pslc[tl * 128 + j0], c1 = pslc[tl * 128 + j1];
            const bool f0 = (j0 == 0) || (j0 == cur_b) || (j0 == cur_b - 1), f1 = (j1 == cur_b) || (j1 == cur_b - 1);
            const bool v0 = j0 * 64 <= t, v1 = j1 * 64 <= t;
            const unsigned u0 = (v0 && !f0) ? __float_as_uint(c0) : 0u, u1 = (v1 && !f1) ? __float_as_uint(c1) : 0u;
            unsigned th = 1u;
            if (cur_b + 1 > NSEL) {
                th = 0u;
#pragma unroll 1
                for (int bit = 30; bit >= 0; --bit) {
                    const unsigned trial = th | (1u << bit);
                    const int cnt = __popcll(__ballot(u0 >= trial)) + __popcll(__ballot(u1 >= trial));
                    if (cnt >= NSEL - 3) { th = trial; if (cnt == NSEL - 3) break; }
                }
            }
            const bool s0 = f0 || (u0 >= th && u0 != 0u), s1 = f1 || (u1 >= th && u1 != 0u);
            const unsigned long long m0 = __ballot(s0), m1 = __ballot(s1), lt = (1ull << ln) - 1ull;
            const int p0 = __popcll(m0 & lt), p1 = __popcll(m0) + __popcll(m1 & lt);
            short* so = SEL + ((size_t)(b * S + t) * 4 + g) * NSEL;
            if (s0 && p0 < NSEL) so[p0] = (short)j0;
            if (s1 && p1 < NSEL) so[p1] = (short)j1;
        }
    }
}

constexpr int ST_ACC = 0, ST_LACC = 133120, ST_MASK = 135168, ST_LIST = 136192, ST_CTR = 138240, ST_HB4 = 138304;
__device__ __forceinline__ void lds_add_f64(unsigned addr, double v) { asm volatile("ds_add_f64 %0, %1" :: "v"(addr), "v"(v) : "memory"); }
__device__ __forceinline__ void phase_sel_tile(const Params& p, LAS unsigned char* lds, bf16_t* AO, const bf16_t* OW) {
    const int tid = opaque_tid(), lane = tid & 63, wave = tid >> 6, l31 = lane & 31, h = lane >> 5;
    LAS double* acc = (LAS double*)(lds + ST_ACC); LAS double* lacc = (LAS double*)(lds + ST_LACC);
    LAS unsigned* mask = (LAS unsigned*)(lds + ST_MASK); LAS int* list = (LAS int*)(lds + ST_LIST) + wave * 64; LAS int* ctr = (LAS int*)(lds + ST_CTR);
    const bf16_t* Q = (const bf16_t*)(p.ws + WS_Q); const float* GATE = (const float*)(p.ws + WS_GATE); const short* SEL = (const short*)(p.ws + WS_SEL);
    const int Gn = gridDim.x;
    for (int kk = 0, u = blockIdx.x; u < 16 * 128; u += Gn, ++kk) {
        const int bg = u >> 7, ti = u & 127, tt = (kk & 1) ? 127 - ti : ti, b = bg >> 2, g = bg & 3, t0 = tt * 64, cur = tt, nv = cur + 1 < NSEL ? cur + 1 : NSEL;
        for (int i = tid; i < ST_LIST / 16; i += NTHR) ((LAS u32x4*)lds)[i] = (u32x4){0u, 0u, 0u, 0u};
        if (tid == 0) *ctr = 0;
        { LAS float* hb4 = (LAS float*)(lds + ST_HB4); const float* hsrc = (const float*)(p.ws + WS_HBG) + 4 * g * HBN; for (int i = tid; i < 4 * HBN; i += NTHR) hb4[i] = hsrc[i]; }
        __syncthreads();
        { const int tl = tid >> 3; const short* sp = SEL + ((size_t)(b * S + t0 + tl) * 4 + g) * NSEL;
#pragma unroll
          for (int e = (tid & 7) * 2; e < (tid & 7) * 2 + 2; ++e) if (e < nv) { const int blk = sp[e]; __hip_atomic_fetch_or(mask + blk * 2 + (tl >> 5), 1u << (tl & 31), __ATOMIC_RELAXED, __HIP_MEMORY_SCOPE_WORKGROUP); } }
        __syncthreads();
        const int nf = cur >= 2 ? 3 : cur + 1, nitems = 2 * nf + (cur >= 3 ? cur - 2 : 0);
        const bf16_t* KB = (const bf16_t*)(p.ws + WS_KSB) + (size_t)bg * 128 * 4096; const bf16_t* VB = (const bf16_t*)(p.ws + WS_VSB) + (size_t)bg * 128 * 4096;
        const int hl = lane & 3, head = 4 * g + hl;
        const LAS float* hbg = (const LAS float*)(lds + ST_HB4) + hl * HBN; const float mhv = ((const float*)(p.ws + WS_MHG))[head], bfar = hbg[HBN - 1] - mhv;
        for (;;) {
            int it = 0; if (lane == 0) it = __hip_atomic_fetch_add(ctr, 1, __ATOMIC_RELAXED, __HIP_MEMORY_SCOPE_WORKGROUP);
            it = __builtin_amdgcn_readfirstlane(it);
            if (it >= nitems) break;
            int j, c_lo, c_hi;
            if (it < 2 * nf) { const int f = it >> 1; j = f == 0 ? cur : (f == 1 ? cur - 1 : 0); c_lo = (it & 1) * 4; c_hi = c_lo + 4; }
            else { j = it - 2 * nf + 1; c_lo = 0; c_hi = 8; }
            const unsigned mlo = (unsigned)__builtin_amdgcn_readfirstlane((int)mask[2 * j]), mhi = (unsigned)__builtin_amdgcn_readfirstlane((int)mask[2 * j + 1]);
            const unsigned long long m = ((unsigned long long)mhi << 32) | mlo; const int n = __popcll(m), nch = (n + 7) >> 3;
            if (c_hi > nch) c_hi = nch;
            if (c_lo >= c_hi) continue;
            if ((m >> lane) & 1ull) list[__popcll(m & ((1ull << lane) - 1ull))] = lane;
            DFrag fr0, fr1;
            dense_load_k(fr0.ka, KB, j * 64, l31, h); dense_load_v(fr0.va, VB, j * 64, l31, h);
            dense_load_k(fr1.ka, KB, j * 64 + 32, l31, h); dense_load_v(fr1.va, VB, j * 64 + 32, l31, h);
            bf16x8 qn[4];
            { const int slot = c_lo * 8 + (l31 >> 2); const int tokl = list[slot < n ? slot : n - 1]; const bf16_t* qp = Q + (size_t)(b * S + t0 + tokl) * D + head * 64 + 8 * h;
#pragma unroll
              for (int ks = 0; ks < 4; ++ks) qn[ks] = *(const bf16x8*)(qp + 16 * ks); }
            for (int c = c_lo; c < c_hi; ++c) {
                const int slot = c * 8 + (l31 >> 2); const bool valid = slot < n; const int tokl = list[valid ? slot : n - 1], tok = t0 + tokl;
                bf16x8 qf[4];
#pragma unroll
                for (int ks = 0; ks < 4; ++ks) qf[ks] = qn[ks];
                { const int sn = (c + 1 < c_hi ? c + 1 : c) * 8 + (l31 >> 2); const int tn = list[sn < n ? sn : n - 1]; const bf16_t* qp = Q + (size_t)(b * S + t0 + tn) * D + head * 64 + 8 * h;
#pragma unroll
                  for (int ks = 0; ks < 4; ++ks) qn[ks] = *(const bf16x8*)(qp + 16 * ks); }
                __builtin_amdgcn_sched_barrier(0);
                f32x16 O[2]; float ls = 0.f;
#pragma unroll
                for (int dt = 0; dt < 2; ++dt)
#pragma unroll
                    for (int q = 0; q < 16; ++q) O[dt][q] = 0.f;
#pragma unroll
                for (int half = 0; half < 2; ++half) {
                    const int kt = j * 64 + 32 * half; const DFrag& fr = half ? fr1 : fr0;
                    const f32x16 sacc = dense_scores(fr, qf); float ev[16];
                    if (t0 - kt - 31 >= HBN - 1) {
#pragma unroll
                        for (int q = 0; q < 16; ++q) { ev[q] = __builtin_amdgcn_exp2f(sacc[q] + bfar); ls += ev[q]; }
                    } else { const int dbase = tok - kt - 4 * h;
#pragma unroll
                        for (int q = 0; q < 16; ++q) { const int dist = dbase - ((q & 3) + 8 * (q >> 2)); const int di = dist < 0 ? 0 : (dist > HBN - 1 ? HBN - 1 : dist);
                            const float e0 = __builtin_amdgcn_exp2f(sacc[q] + hbg[di] - mhv); ev[q] = dist >= 0 ? e0 : 0.f; ls += ev[q]; } }
                    dense_pv(O, fr, ev);
                }
                const float lt = ls + __shfl_xor(ls, 32);
                if (valid) {
                    const unsigned a0 = (unsigned)(size_t)(acc + (tokl * 4 + hl) * 65 + 4 * h);
#pragma unroll
                    for (int dt = 0; dt < 2; ++dt)
#pragma unroll
                        for (int q = 0; q < 16; ++q) lds_add_f64(a0 + (dt * 32 + (q & 3) + 8 * (q >> 2)) * 8, (double)O[dt][q]);
                    if (h == 0) lds_add_f64((unsigned)(size_t)(lacc + tokl * 4 + hl), (double)lt);
                }
            }
        }
        __syncthreads();
        for (int r0 = wave * 32; r0 < wave * 32 + 32; r0 += 8) {
            float gv[8], ov[8];
#pragma unroll
            for (int i = 0; i < 8; ++i) { const int r = r0 + i, tokl = r >> 2, hd = r & 3; const size_t ur = (size_t)(b * S + t0 + tokl);
                gv[i] = GATE[ur * 48 + (4 * g + hd) * 3 + 1]; ov[i] = bf2f(OW[ur * D + (4 * g + hd) * 64 + lane]); }
#pragma unroll
            for (int i = 0; i < 8; ++i) { const int r = r0 + i, tokl = r >> 2, hd = r & 3; const size_t ur = (size_t)(b * S + t0 + tokl);
                const float o = (float)acc[r * 65 + lane] * (1.f / (float)lacc[r]) * gv[i] + ov[i];
                AO[ur * D + (4 * g + hd) * 64 + lane] = (bf16_t)(cvt_pk_bf16(o, 0.f) & 0xffffu); }
        }
        __syncthreads();
    }
}

__device__ __forceinline__ void moe_pstarts(const unsigned* ctl, int (&pst)[NE + 1]) {
    int a = 0;
#pragma unroll
    for (int e = 0; e < NE; ++e) { pst[e] = a; const int c = (int)ctl[CW_CNT + 64 * e]; a += (c + 511) / 512 * 512; }
    pst[NE] = a;
}
__device__ __forceinline__ void phase_moe_sort(const Params& p, LAS unsigned char* lds) {
    const int tid = opaque_tid(), lane = tid & 63, wave = tid >> 6;
    unsigned* ctl = (unsigned*)(p.ws + WS_CTL);
    const int* TOPE = (const int*)(p.ws + WS_TOPE); int* RPOS = (int*)(p.ws + WS_RPOS);
    const bf16_t* HB = (const bf16_t*)(p.ws + WS_HB); bf16_t* XS = (bf16_t*)(p.ws + WS_XS);
    LAS int* wcnt = (LAS int*)lds;
    LAS int* base = (LAS int*)(lds + 128);
    LAS int* posl = (LAS int*)(lds + 256);
    int pst[NE + 1]; moe_pstarts(ctl, pst);
    if (blockIdx.x == 0 && tid <= NE) ((int*)(ctl + 256))[tid] = pst[tid];
    for (int c0 = blockIdx.x * 256; c0 < 2 * T; c0 += gridDim.x * 256) {
        int e = 0, rank = 0;
        if (wave < 4) { e = TOPE[c0 + wave * 64 + lane];
#pragma unroll
            for (int q = 0; q < NE; ++q) { const unsigned long long m = __ballot(e == q); if (e == q) rank = __popcll(m & ((1ull << lane) - 1ull)); if (lane == 0) wcnt[wave * NE + q] = __popcll(m); } }
        __syncthreads();
        if (tid < NE) { const int n = wcnt[tid] + wcnt[NE + tid] + wcnt[2 * NE + tid] + wcnt[3 * NE + tid]; base[tid] = n ? (int)atomicAdd(ctl + CW_CUR + 64 * tid, (unsigned)n) : 0; }
        __syncthreads();
        if (wave < 4) { int off = 0;
            for (int w = 0; w < wave; ++w) off += wcnt[w * NE + e];
            const int pos = pst[e] + base[e] + off + rank; posl[wave * 64 + lane] = pos; RPOS[c0 + wave * 64 + lane] = pos; }
        __syncthreads();
        for (int j = wave * 32; j < wave * 32 + 32; j += 8) {
            u32x4 v0[8]; int ps[8];
#pragma unroll
            for (int q = 0; q < 8; ++q) { const int tk = (c0 + j + q) >> 1; ps[q] = posl[j + q]; v0[q] = *((const u32x4*)((const unsigned char*)HB + (size_t)tk * D) + lane); }
#pragma unroll
            for (int q = 0; q < 8; ++q) *((u32x4*)((unsigned char*)XS + (size_t)ps[q] * D) + lane) = v0[q];
        }
        __syncthreads();
    }
}
__device__ __forceinline__ void phase_combine(const Params& p) {
    const int tid = opaque_tid(), lane = tid & 63, wave = tid >> 6;
    const int gw = blockIdx.x * NWAVE + wave, NGW = gridDim.x * NWAVE;
    const float* TOPW = (const float*)(p.ws + WS_TOPW); const int* RPOS = (const int*)(p.ws + WS_RPOS);
    const bf16_t* Y = (const bf16_t*)(p.ws + WS_Y); const float* g2 = (const float*)(p.ws + WS_MODV) + (11 * 4) * D;
    for (int r = gw; r < T; r += NGW) {
        const int b = r >> 13; const int p0 = RPOS[2 * r], p1 = RPOS[2 * r + 1]; const float w0 = TOPW[2 * r], w1 = TOPW[2 * r + 1];
#pragma unroll
        for (int j = 0; j < 4; ++j) { const int c = 4 * lane + 256 * j;
            const u32x2 y0 = *(const u32x2*)(Y + (size_t)p0 * D + c), y1 = *(const u32x2*)(Y + (size_t)p1 * D + c);
            const f32x4 gv = *(const f32x4*)(g2 + b * D + c); f32x4 xv = *(const f32x4*)(p.out + (size_t)r * D + c);
            f32x4 f; f.x = w0 * bflo(y0.x) + w1 * bflo(y1.x); f.y = w0 * bfhi(y0.x) + w1 * bfhi(y1.x); f.z = w0 * bflo(y0.y) + w1 * bflo(y1.y); f.w = w0 * bfhi(y0.y) + w1 * bfhi(y1.y);
            *(f32x4*)(p.out + (size_t)r * D + c) = xv + gv * f; }
    }
}

#define XB_TMO      128
#define XB_XCNT(j)  (256  + 64 * (j))
#define XB_XSUB(j)  (1280 + 64 * (j))
#define XB_XGEN(j)  (2304 + 64 * (j))
#define XB_TOP      3328
#define XB_TOPGEN   3392
#define XCD_BAR_WORDS 3456
#define XB_SPIN_CAP (1u << 18)
__device__ __forceinline__ unsigned xb_ld(unsigned* p)              { return __hip_atomic_load(p, __ATOMIC_RELAXED, __HIP_MEMORY_SCOPE_AGENT); }
__device__ __forceinline__ unsigned xb_add(unsigned* p, unsigned v) { return __hip_atomic_fetch_add(p, v, __ATOMIC_RELAXED, __HIP_MEMORY_SCOPE_AGENT); }
__device__ __forceinline__ unsigned xb_xcc_id() { return (unsigned)__builtin_amdgcn_s_getreg((3 << 11) | 20) & 0xFu; }
#define XB_SPIN(cond, bar) do { unsigned _sp = 0; while (cond) { __builtin_amdgcn_s_sleep(1); \
    if ((++_sp & 255u) == 0u) { if (xb_ld(&(bar)[XB_TMO])) break; if (_sp > XB_SPIN_CAP) { atomicAdd(&(bar)[XB_TMO], 1u); break; } } } } while (0)
struct XcdBarrier { unsigned* bar; unsigned x; volatile LAS unsigned* st; };
__device__ __forceinline__ XcdBarrier xcd_barrier_post(unsigned* bar, volatile LAS unsigned* st) {
    XcdBarrier b; b.bar = bar; b.x = xb_xcc_id(); b.st = st;
    if (threadIdx.x == 0) (void)xb_add(&bar[XB_XCNT(b.x)], 1u);
    return b;
}
__device__ __forceinline__ void xcd_barrier_complete(unsigned* bar, unsigned x, unsigned& nloc, unsigned& nx) {
    const unsigned G_ = gridDim.x * gridDim.y * gridDim.z;
    unsigned sum, cnt, mine, sp = 0u;
    for (;;) {
        sum = 0u; cnt = 0u; mine = 0u;
#pragma unroll
        for (unsigned j = 0; j < 16; ++j) { const unsigned c = xb_ld(&bar[XB_XCNT(j)]); sum += c; cnt += (c > 0u) ? 1u : 0u; mine = (j == x) ? c : mine; }
        if (sum == G_) break;
        __builtin_amdgcn_s_sleep(1);
        if ((++sp & 255u) == 0u) { if (xb_ld(&bar[XB_TMO])) break; if (sp > XB_SPIN_CAP) { atomicAdd(&bar[XB_TMO], 1u); break; } }
    }
    nloc = mine > 0u ? mine : 1u; nx = cnt > 0u ? cnt : 1u;
}
__device__ __forceinline__ void xcd_barrier(const XcdBarrier& b) {
    asm volatile("s_waitcnt vmcnt(0)" ::: "memory");
    __syncthreads();
    if (threadIdx.x == 0) {
        unsigned* bar = b.bar;
        __builtin_amdgcn_s_waitcnt(0);
        unsigned nloc = b.st[0], nx = b.st[1];
        if (nloc == 0u) { xcd_barrier_complete(bar, b.x, nloc, nx); b.st[0] = nloc; b.st[1] = nx; }
        const unsigned old = xb_add(&bar[XB_XSUB(b.x)], 1u);
        const unsigned gen = old / nloc;
        if (old + 1u == (gen + 1u) * nloc) {
            __builtin_amdgcn_fence(__ATOMIC_RELEASE, "agent");
            asm volatile("s_waitcnt vmcnt(0)" ::: "memory");
            const unsigned og = xb_add(&bar[XB_TOP], 1u);
            const unsigned tg = og / nx;
            if (og + 1u == (tg + 1u) * nx) xb_add(&bar[XB_TOPGEN], 1u);
            else XB_SPIN(xb_ld(&bar[XB_TOPGEN]) == tg, bar);
            __builtin_amdgcn_fence(__ATOMIC_ACQUIRE, "agent");
            xb_add(&bar[XB_XGEN(b.x)], 1u);
            asm volatile("s_waitcnt vmcnt(0)" ::: "memory");
        } else {
            XB_SPIN(xb_ld(&bar[XB_XGEN(b.x)]) == gen, bar);
            __builtin_amdgcn_fence(__ATOMIC_ACQUIRE, "agent");
            asm volatile("s_waitcnt vmcnt(0)" ::: "memory");
        }
    }
    __syncthreads();
}

constexpr int LDS_SCRATCH = 131072, MISC_OFF = 155648, LDS_BYTES = 163840;
#define MODP(which) ((const float*)(p.ws + WS_MODV) + (size_t)(which) * 4 * D)

__global__ void __launch_bounds__(NTHR, 2) k_fused(Params p) {
    extern __shared__ __attribute__((aligned(16))) unsigned char lds_raw[];
    LAS unsigned char* lds = (LAS unsigned char*)lds_raw;
    for (int u = threadIdx.x; u < (LDS_BYTES - LDS_SCRATCH) / 4; u += NTHR) ((LAS unsigned*)(lds + LDS_SCRATCH))[u] = 0u;
    __syncthreads();
    const XcdBarrier bar = xcd_barrier_post((unsigned*)(p.ws + WS_CTL) + CW_BAR, (volatile LAS unsigned*)(lds + MISC_OFF) + 8);
#define GRID_BAR() xcd_barrier(bar)
    phase_weights(p, lds); __syncthreads(); phase_modvec(p, lds);
    GRID_BAR();
    phase_convert_fgu(p, lds); __syncthreads();
    phase_poolmix(p, lds, (bf16_t*)(p.ws + WS_HA));
    GRID_BAR();
    { pg8::Sched<1> Sc; Sc.init(T, D, gridDim.x, blockIdx.x, p.ws + WS_HA, p.ws + WO_POOL, D, 256);
      pg8::EpiEl<EpiPool> E{{p.x, (float*)(p.ws + WS_X1), MODP(2), p.pool_scale, 0}};
      pg8::gemm_phase(lds, 256, D, 256, 128, Sc, E); }
    GRID_BAR();
    { NormOut o0{p.norm_g + D, MODP(4), MODP(3), (bf16_t*)(p.ws + WS_HB)}; phase_norm<1, false, 2>(p, lds, (const float*)(p.ws + WS_X1), o0, o0); }
    GRID_BAR();
    { pg8::Sched<0> Sc; Sc.init(T, 2 * FF, gridDim.x, blockIdx.x, p.ws + WS_HB, p.ws + WO_FGU, D / 2, D / 2);
      pg8::EpiPairEl<EpiSwigluI8> E{{(bf16_t*)(p.ws + WS_HID0), FF, (const float*)(p.ws + WS_ASC), (const float*)(p.ws + WS_FGMAX)}};
      pg8::gemm_phase<pg8::EpiPairEl<EpiSwigluI8>, pg8::Sched<0>, true, true, 2>(lds, D / 2, D / 2, D / 2, 128, Sc, E); }
    GRID_BAR();
    { pg8::Sched<0> Sc; Sc.init(T, D, gridDim.x, blockIdx.x, p.ws + WS_HID0, p.ws + WO_FDN, FF, FF);
      pg8::EpiEl<EpiResid> E{{(const float*)(p.ws + WS_X1), (float*)(p.ws + WS_X2), MODP(5)}};
      pg8::gemm_phase(lds, FF, FF, FF, 128, Sc, E); }
    GRID_BAR();
    { NormOut o0{p.kv_norm_g, MODP(13), MODP(12), (bf16_t*)(p.ws + WS_HA)}; NormOut o1{p.norm_g + 2 * D, MODP(7), MODP(6), (bf16_t*)(p.ws + WS_HB)}; phase_norm<2, false>(p, lds, (const float*)(p.ws + WS_X2), o0, o1); }
    GRID_BAR();
    { pg8::Sched<0> Sc; Sc.init(T, NKV, gridDim.x, blockIdx.x, p.ws + WS_HA, p.ws + WO_KV, D, D);
      pg8::EpiEl<EpiBf16> E{{(bf16_t*)(p.ws + WS_KVB), NKV}};
      pg8::gemm_phase(lds, D, D, D, 128, Sc, E); }
    { pg8::Sched<0> Sc; Sc.init(T, D, gridDim.x, blockIdx.x, p.ws + WS_HB, p.ws + WO_Q, D, D);
      pg8::EpiEl<EpiQ> E{{(bf16_t*)(p.ws + WS_Q), (float*)(p.ws + WS_GATE), 0}};
      pg8::gemm_phase(lds, D, D, D, 128, Sc, E); }
    GRID_BAR();
    { pg8::Sched<2> Sc; Sc.init(2048, 2048, gridDim.x, blockIdx.x, p.ws + WS_KVB, p.ws + WO_CK, 16 * NKV, 2048);
      pg8::EpiEl<EpiCmp> E{{(bf16_t*)(p.ws + WS_CMPH), (const float*)(p.ws + WS_CMPB)}};
      pg8::gemm_phase(lds, 2048, 16 * NKV, 2048, (size_t)NKV * 2, Sc, E); }
    { pg8::Sched<0> Sc; Sc.init(T, 256, (int)gridDim.x - 64 > 0 ? (int)gridDim.x - 64 : 1, (int)gridDim.x > 64 ? (int)blockIdx.x - 64 : (int)blockIdx.x, p.ws + WS_HB, p.ws + WO_Q + (size_t)D * D * 2, D, D);
      pg8::EpiEl<EpiQ> E{{(bf16_t*)(p.ws + WS_Q), (float*)(p.ws + WS_GATE), D}};
      pg8::gemm_phase(lds, D, D, D, 128, Sc, E); }
    phase_headnorm(p, lds); phase_vtrans(p, lds);
    GRID_BAR();
    phase_cmp2(p, lds);
    GRID_BAR();
    attn_tables(p, lds);
    phase_dense(p, lds, (bf16_t*)(p.ws + WS_HB));
    GRID_BAR();
    phase_sel_tile(p, lds, (bf16_t*)(p.ws + WS_HA), (const bf16_t*)(p.ws + WS_HB));
    GRID_BAR();
    { pg8::Sched<0> Sc; Sc.init(T, D, gridDim.x, blockIdx.x, p.ws + WS_HA, p.ws + WO_O, D, D);
      pg8::EpiEl<EpiResid> E{{(const float*)(p.ws + WS_X2), p.out, MODP(8)}};
      pg8::gemm_phase(lds, D, D, D, 128, Sc, E); }
    GRID_BAR();
    { NormOut o0{p.norm_g + 3 * D, MODP(10), MODP(9), (bf16_t*)(p.ws + WS_HB)}; phase_norm<1, true, 1>(p, lds, p.out, o0, o0); }
    GRID_BAR();
    phase_moe_sort(p, lds);
    GRID_BAR();
    { const int* pst = (const int*)(p.ws + WS_CTL) + 256;
      pg8::Sched<3> Sc; Sc.init(pst[NE], 2 * FE, gridDim.x, blockIdx.x, p.ws + WS_XS, p.ws + WO_EGU, D / 2, D / 2, pst, (size_t)FE * D);
      pg8::EpiPairEl<EpiSwiglu8> E{{p.ws + WS_HIDM, FE}};
      pg8::gemm_phase<pg8::EpiPairEl<EpiSwiglu8>, pg8::Sched<3>, true, true, 1>(lds, D / 2, D / 2, D / 2, 128, Sc, E, 127 - 5); }
    GRID_BAR();
    { const int* pst = (const int*)(p.ws + WS_CTL) + 256;
      pg8::Sched<3> Sc; Sc.init(pst[NE], D, gridDim.x, blockIdx.x, p.ws + WS_HIDM, p.ws + WO_EDN, FE / 2, FE / 2, pst, (size_t)D * FE / 2);
      pg8::EpiEl<EpiBf16> E{{(bf16_t*)(p.ws + WS_Y), D}};
      pg8::gemm_phase<pg8::EpiEl<EpiBf16>, pg8::Sched<3>, true, true, 1>(lds, FE / 2, FE / 2, FE / 2, 128, Sc, E, 127 - 6); }
    GRID_BAR();
    phase_combine(p);
}

extern "C" void kernel_launch(void* const* d_in, const int* in_sizes, int n_in, void* d_out, int out_size, void* d_ws, size_t ws_size, hipStream_t stream) {
    if (n_in != 28 || out_size != T * D || ws_size < WS_END) { fprintf(stderr, "kernel_launch: unexpected shapes (n_in %d out %d ws %zu need %zu)\n", n_in, out_size, ws_size, (size_t)WS_END); return; }
    static int grid = 0;
    if (grid == 0) {
        int dev = 0, cus = 0, per_cu = 0;
        if (hipGetDevice(&dev) != hipSuccess || hipDeviceGetAttribute(&cus, hipDeviceAttributeMultiprocessorCount, dev) != hipSuccess) { grid = -1; return; }
        if (hipFuncSetAttribute((const void*)k_fused, hipFuncAttributeMaxDynamicSharedMemorySize, LDS_BYTES) != hipSuccess) { grid = -1; return; }
        if (hipOccupancyMaxActiveBlocksPerMultiprocessor(&per_cu, (const void*)k_fused, NTHR, LDS_BYTES) != hipSuccess || per_cu < 1) { fprintf(stderr, "kernel_launch: occupancy query says %d\n", per_cu); }
        (void)hipGetLastError();
        grid = cus;
    }
    if (grid < 0) return;
    Params p{};
    const float** pp = (const float**)&p;
    for (int i = 0; i < 28; ++i) pp[i] = (const float*)d_in[i];
    p.out = (float*)d_out; p.ws = (unsigned char*)d_ws;
    (void)hipMemsetAsync((char*)d_ws + WS_CTL, 0, CTL_BYTES, stream);
    k_fused<<<dim3(grid), dim3(NTHR), LDS_BYTES, stream>>>(p);
}
```

```cpp
#include <hip/hip_runtime.h>
#include <cstdint>
#include <cstdio>

#define LAS __attribute__((address_space(3)))
typedef unsigned short bf16_t;
typedef short bf16x8 __attribute__((ext_vector_type(8)));
typedef float f32x4 __attribute__((ext_vector_type(4)));
typedef float f32x2 __attribute__((ext_vector_type(2)));
typedef unsigned u32x4 __attribute__((ext_vector_type(4)));
typedef unsigned u32x2 __attribute__((ext_vector_type(2)));

constexpr int NB = 4, S = 8192, D = 1024, T = NB * S;
constexpr int FF = 2816, NE = 8, FE = 3584;
constexpr int NKV = 1536, NQP = 1280, NQ = 1072;
constexpr int G = 4, HD = 64, NH = 16;
constexpr int NC = 512;
constexpr int NSB = 128;
constexpr int NSEL = 16;
constexpr int WIN = 512;
constexpr int MOE_ROWS = 69632;
constexpr float EPS = 1e-6f;
constexpr int NTHR = 512, NWAVE = 8;

constexpr size_t MiB = 1u << 20;
constexpr size_t WS_CTL = 0, CTL_BYTES = 1 * MiB;
constexpr size_t WS_MODV = 1 * MiB;
constexpr size_t WS_CMPB = WS_MODV + 14 * 4 * 1024 * 4;
constexpr size_t WS_FGMAX = WS_CMPB + 4096;
constexpr size_t WS_ASC = WS_FGMAX + 2 * FF * 4;
constexpr size_t WS_HBG = 6 * MiB;
constexpr size_t WS_MHG = WS_HBG + 65536;
constexpr size_t WS_TOPE = 2 * MiB;
constexpr size_t WS_TOPW = WS_TOPE + (size_t)T * 8;
constexpr size_t WS_RPOS = WS_TOPW + (size_t)T * 8;
constexpr size_t WS_RTOK = WS_RPOS + (size_t)T * 8;
constexpr size_t WS_SMALL_END = WS_RTOK + (size_t)MOE_ROWS * 4;
static_assert(WS_SMALL_END <= 8 * MiB && WS_ASC + (size_t)T * 4 <= 2 * MiB, "small region");
constexpr size_t WS_W = 8 * MiB;
constexpr size_t WO_POOL = WS_W;
constexpr size_t WO_FGU = WO_POOL + (size_t)4 * 256 * 256 * 2;
constexpr size_t WO_FDN = WO_FGU + (size_t)2 * FF * D * 2;
constexpr size_t WO_KV = WO_FDN + (size_t)D * FF * 2;
constexpr size_t WO_Q = WO_KV + (size_t)NKV * D * 2;
constexpr size_t WO_O = WO_Q + (size_t)NQP * D * 2;
constexpr size_t WO_CK = WO_O + (size_t)D * D * 2;
constexpr size_t WO_CV = WO_CK + (size_t)256 * 2048 * 2;
constexpr size_t WO_EGU = WO_CV + (size_t)256 * 2048 * 2;
constexpr size_t WO_EDN = WO_EGU + (size_t)NE * 2 * FE * D * 2;
constexpr size_t WO_END = WO_EDN + (size_t)NE * D * FE * 2;
static_assert(WO_END <= 203 * MiB, "weights region");
constexpr size_t WS_HB = 203 * MiB;
constexpr size_t WS_X1 = 267 * MiB;
constexpr size_t WS_X2 = 395 * MiB;
constexpr size_t WS_HID0 = 523 * MiB;
constexpr size_t WS_Q = 523 * MiB;
constexpr size_t WS_GATE = 587 * MiB;
constexpr size_t WS_CMPH = 593 * MiB;
constexpr size_t WS_CMPP = 267 * MiB;
constexpr size_t WS_KC = 601 * MiB;
constexpr size_t WS_VC = 602 * MiB;
constexpr size_t WS_KSB = 603 * MiB;
constexpr size_t WS_VSB = 619 * MiB;
constexpr size_t WS_KWB = 635 * MiB;
constexpr size_t WS_VWB = 651 * MiB;
constexpr size_t WS_Q8 = 267 * MiB;
constexpr size_t WS_SEL = 667 * MiB;
constexpr size_t WS_HA = 699 * MiB;
constexpr size_t WS_KVB = 763 * MiB;
constexpr size_t WS_HIDM = 267 * MiB;
constexpr size_t WS_Y = 743 * MiB;
constexpr size_t WS_XS = WS_Y;
constexpr size_t WS_END = 880 * MiB;
static_assert(WS_HIDM + (size_t)MOE_ROWS * FE * 2 <= WS_Y && WS_Y + (size_t)MOE_ROWS * D * 2 <= WS_END, "moe map");
static_assert(WS_KVB + (size_t)T * NKV * 2 + 65536 <= WS_END, "kv map");
constexpr int CW_CNT = 512;
constexpr int CW_CUR = 1024;
constexpr int CW_HN = 2048, CW_VT = 2112;
constexpr int CW_BAR = 4096;

struct Params {
    const float *x, *c, *ada_w, *ada_b, *norm_g, *pool_w, *pool_scale, *q_w, *q_gain, *o_w, *kv_ada_w, *kv_ada_b, *kv_norm_g, *kv_w,
        *cmp_pe_k, *cmp_pe_v, *cmp_k_w1, *cmp_k_w2, *cmp_v_w1, *cmp_v_w2, *k_gain, *rel_bias, *ffn_gu, *ffn_dn, *router_w, *router_b, *exp_gu, *exp_dn;
    float* out; unsigned char* ws;
};

__device__ __forceinline__ unsigned cvt_pk_bf16(float lo, float hi) { unsigned r; asm volatile("v_cvt_pk_bf16_f32 %0, %1, %2" : "=v"(r) : "v"(lo), "v"(hi)); return r; }
__device__ __forceinline__ float bf2f(unsigned short v) { return __uint_as_float((unsigned)v << 16); }
__device__ __forceinline__ float bflo(unsigned w) { return __uint_as_float(w << 16); }
__device__ __forceinline__ float bfhi(unsigned w) { return __uint_as_float(w & 0xffff0000u); }
__device__ __forceinline__ int opaque_tid() { int t = threadIdx.x; asm volatile("" : "+v"(t)); return t; }
__device__ __forceinline__ float readlane_f(float v, int l) { return __uint_as_float((unsigned)__builtin_amdgcn_readlane((int)__float_as_uint(v), l)); }
__device__ __forceinline__ unsigned pack_i8x4(float a, float b, float c, float d) {
    const int ia = (int)__builtin_rintf(fminf(fmaxf(a, -127.f), 127.f)), ib = (int)__builtin_rintf(fminf(fmaxf(b, -127.f), 127.f)), ic = (int)__builtin_rintf(fminf(fmaxf(c, -127.f), 127.f)), id = (int)__builtin_rintf(fminf(fmaxf(d, -127.f), 127.f));
    return (unsigned)(ia & 0xff) | ((unsigned)(ib & 0xff) << 8) | ((unsigned)(ic & 0xff) << 16) | ((unsigned)(id & 0xff) << 24);
}
__device__ __forceinline__ float sel_q_scale(const float* q_gain) { float m = 0.f; for (int i = 0; i < 64; ++i) m = fmaxf(m, fabsf(q_gain[i])); return 127.f / (4.f * m * 0.125f * 1.4426950408889634f); }
__device__ __forceinline__ float sel_k_scale(const float* k_gain) { float m = 0.f; for (int i = 0; i < 64; ++i) m = fmaxf(m, fabsf(k_gain[64 + i])); return 127.f / (4.f * m); }
template <int CTRL> __device__ __forceinline__ float dpp_f(float v) { return __uint_as_float((unsigned)__builtin_amdgcn_update_dpp(0, (int)__float_as_uint(v), CTRL, 0xf, 0xf, true)); }
__device__ __forceinline__ float lane_xor1(float v) { return dpp_f<0xB1>(v); }
__device__ __forceinline__ float lane_xor2(float v) { return dpp_f<0x4E>(v); }
__device__ __forceinline__ float red_step4(float v) { return dpp_f<0x141>(v); }
__device__ __forceinline__ float red_step8(float v) { return dpp_f<0x140>(v); }
__device__ __forceinline__ float sum_xor32(float v) { const auto r = __builtin_amdgcn_permlane32_swap(__float_as_uint(v), __float_as_uint(v), false, false); return __uint_as_float(r[0]) + __uint_as_float(r[1]); }
__device__ __forceinline__ float lane_xor32(float v, int hi) { const auto r = __builtin_amdgcn_permlane32_swap(__float_as_uint(v), __float_as_uint(v), false, false); return __uint_as_float(hi ? r[0] : r[1]); }
__device__ __forceinline__ float bfly32(float keep_lo, float keep_hi) { const auto r = __builtin_amdgcn_permlane32_swap(__float_as_uint(keep_lo), __float_as_uint(keep_hi), false, false); return __uint_as_float(r[0]) + __uint_as_float(r[1]); }
__device__ __forceinline__ float bfly16(float keep_lo, float keep_hi) { const auto r = __builtin_amdgcn_permlane16_swap(__float_as_uint(keep_lo), __float_as_uint(keep_hi), false, false); return __uint_as_float(r[0]) + __uint_as_float(r[1]); }
__device__ __forceinline__ float lane_xor8(float v) { return dpp_f<0x128>(v); }
__device__ __forceinline__ float wave_sum(float v) {
    v += lane_xor1(v); v += lane_xor2(v); v += red_step4(v); v += red_step8(v);
    return (readlane_f(v, 0) + readlane_f(v, 16)) + (readlane_f(v, 32) + readlane_f(v, 48));
}
__device__ __forceinline__ float wave_max(float v) {
    v = fmaxf(v, lane_xor1(v)); v = fmaxf(v, lane_xor2(v)); v = fmaxf(v, red_step4(v)); v = fmaxf(v, red_step8(v));
    return fmaxf(fmaxf(readlane_f(v, 0), readlane_f(v, 16)), fmaxf(readlane_f(v, 32), readlane_f(v, 48)));
}
__device__ __forceinline__ float silu_f(float v) { return v * __builtin_amdgcn_rcpf(1.f + __builtin_amdgcn_exp2f(v * -1.4426950408889634f)); }
__device__ __forceinline__ f32x2 swiglu2(f32x2 g, f32x2 u) {
    const f32x2 t = g * -1.4426950408889634f; f32x2 e; e.x = __builtin_amdgcn_exp2f(t.x); e.y = __builtin_amdgcn_exp2f(t.y);
    e = e + 1.f; f32x2 r; r.x = __builtin_amdgcn_rcpf(e.x); r.y = __builtin_amdgcn_rcpf(e.y);
    return (g * u) * r; }
__device__ __forceinline__ float sigmoid_f(float v) { return __builtin_amdgcn_rcpf(1.f + __builtin_amdgcn_exp2f(v * -1.4426950408889634f)); }
__device__ __forceinline__ float gelu_tanh_f(float v) {
    const float u = 0.7978845608028654f * (v + 0.044715f * v * v * v);
    const float e = __builtin_amdgcn_exp2f(fabsf(u) * -2.8853900817779268f); const float th = (1.f - e) * __builtin_amdgcn_rcpf(1.f + e);
    return 0.5f * v * (1.f + (u < 0.f ? -th : th));
}
__device__ __forceinline__ int rel_bucket(int d) {
    if (d < 16) return d;
    int b = 16;
    b += (d >= 21); b += (d >= 27); b += (d >= 35); b += (d >= 46); b += (d >= 59); b += (d >= 77); b += (d >= 99); b += (d >= 128);
    b += (d >= 166); b += (d >= 216); b += (d >= 280); b += (d >= 363); b += (d >= 470); b += (d >= 609); b += (d >= 790);
    return b;
}

constexpr int TR_WAVE_LDS = 128 * 33 * 4;
template <int QF = 0>
__device__ __forceinline__ void transpose_item(const float* W, int K, int N, void* WT, int k0, int n0, int drow0, LAS float* scr, int lane, float wscale = 1.f, const float* colmax = nullptr) {
    float wv[64];
    const int nl = lane & 31; const bool nok = n0 + nl < N; const float* wp = W + (size_t)(k0 + (lane >> 5)) * N + n0 + nl;
#pragma unroll
    for (int i = 0; i < 64; ++i) wv[i] = nok ? wp[(size_t)(2 * i) * N] : 0.f;
#pragma unroll
    for (int i = 0; i < 64; ++i) scr[(2 * i + (lane >> 5)) * 33 + nl] = wv[i];
    asm volatile("s_waitcnt lgkmcnt(0)" ::: "memory");
    const int c = lane >> 2;
#pragma unroll
    for (int j = 0; j < 8; ++j) { const int n = (lane & 3) + 4 * j; const LAS float* sp = scr + (8 * c) * 33 + n;
        if constexpr (QF == 1) {
            unsigned w0 = 0u, w1 = 0u;
            w0 = __builtin_amdgcn_cvt_pk_fp8_f32(sp[0 * 33] * wscale, sp[1 * 33] * wscale, w0, false); w0 = __builtin_amdgcn_cvt_pk_fp8_f32(sp[2 * 33] * wscale, sp[3 * 33] * wscale, w0, true);
            w1 = __builtin_amdgcn_cvt_pk_fp8_f32(sp[4 * 33] * wscale, sp[5 * 33] * wscale, w1, false); w1 = __builtin_amdgcn_cvt_pk_fp8_f32(sp[6 * 33] * wscale, sp[7 * 33] * wscale, w1, true);
            *(u32x2*)((unsigned char*)WT + (size_t)(drow0 + n) * K + k0 + 8 * c) = (u32x2){w0, w1};
        } else if constexpr (QF == 2) { const float sc = 127.f / colmax[n0 + n];
            const unsigned w0 = pack_i8x4(sp[0 * 33] * sc, sp[1 * 33] * sc, sp[2 * 33] * sc, sp[3 * 33] * sc), w1 = pack_i8x4(sp[4 * 33] * sc, sp[5 * 33] * sc, sp[6 * 33] * sc, sp[7 * 33] * sc);
            *(u32x2*)((unsigned char*)WT + (size_t)(drow0 + n) * K + k0 + 8 * c) = (u32x2){w0, w1};
        } else {
        u32x4 o; o.x = cvt_pk_bf16(sp[0 * 33], sp[1 * 33]); o.y = cvt_pk_bf16(sp[2 * 33], sp[3 * 33]); o.z = cvt_pk_bf16(sp[4 * 33], sp[5 * 33]); o.w = cvt_pk_bf16(sp[6 * 33], sp[7 * 33]);
        *(u32x4*)((bf16_t*)WT + (size_t)(drow0 + n) * K + k0 + 8 * c) = o; } }
    asm volatile("s_waitcnt lgkmcnt(0)" ::: "memory");
}
template <int MODE, int QF = 0>
__device__ __forceinline__ void transpose_mat(const float* W, int K, int N, int NP, int F, void* WT, int it, LAS float* scr, int lane, float wscale = 1.f, const float* colmax = nullptr) {
    const int nblk = NP / 32, kb = it / nblk, nb = it % nblk, n0 = nb * 32;
    int drow0 = n0;
    if (MODE == 1) { const int up = n0 >= F, j = up ? n0 - F : n0; drow0 = (j >> 7) * 256 + (up ? 128 : 0) + (j & 127); }
    transpose_item<QF>(W, K, N, WT, kb * 128, n0, drow0, scr, lane, wscale, colmax);
}
__device__ __forceinline__ void phase_convert_fgu(const Params& p, LAS unsigned char* lds) {
    const int tid = opaque_tid(), lane = tid & 63, wave = tid >> 6;
    LAS float* scr = (LAS float*)(lds + wave * TR_WAVE_LDS);
    const int gw = blockIdx.x * NWAVE + wave, NGW = gridDim.x * NWAVE;
    for (int it = gw; it < 8 * 176; it += NGW) transpose_mat<1, 2>(p.ffn_gu, D, 2 * FF, 2 * FF, FF, p.ws + WO_FGU, it, scr, lane, 1.f, (const float*)(p.ws + WS_FGMAX));
}
__device__ __forceinline__ void phase_weights(const Params& p, LAS unsigned char* lds) {
    const int tid = opaque_tid(), lane = tid & 63, wave = tid >> 6;
    LAS float* scr = (LAS float*)(lds + wave * TR_WAVE_LDS);
    const int gw = blockIdx.x * NWAVE + wave, NGW = gridDim.x * NWAVE;
    unsigned char* ws = p.ws;
    constexpr int I_POOL = 2 * 8, I_FDN = 22 * 32, I_KV = 8 * 48, I_Q = 8 * 40, I_O = 8 * 32, I_C = 16 * 8, I_EGU = 8 * 224, I_EDN = 28 * 32;
    constexpr int TOT = 4 * I_POOL + I_FDN + I_KV + I_Q + I_O + 2 * I_C + NE * I_EGU + NE * I_EDN;
    for (int it = gw; it < TOT; it += NGW) {
        int r = it;
        if (r < NE * I_EGU) { const int e = r / I_EGU; transpose_mat<1, 1>(p.exp_gu + (size_t)e * D * 2 * FE, D, 2 * FE, 2 * FE, FE, ws + WO_EGU + (size_t)e * 2 * FE * D, r % I_EGU, scr, lane, 32.f); continue; } r -= NE * I_EGU;
        if (r < NE * I_EDN) { const int e = r / I_EDN; transpose_mat<0, 1>(p.exp_dn + (size_t)e * FE * D, FE, D, D, 0, ws + WO_EDN + (size_t)e * D * FE, r % I_EDN, scr, lane, 64.f); continue; } r -= NE * I_EDN;
        if (r < 4 * I_POOL) { const int g = r / I_POOL; transpose_mat<0>(p.pool_w + (size_t)g * 65536, 256, 256, 256, 0, (bf16_t*)(ws + WO_POOL) + (size_t)g * 65536, r % I_POOL, scr, lane); continue; } r -= 4 * I_POOL;
        if (r < I_FDN) { transpose_mat<0>(p.ffn_dn, FF, D, D, 0, ws + WO_FDN, r, scr, lane); continue; } r -= I_FDN;
        if (r < I_KV) { transpose_mat<0>(p.kv_w, D, NKV, NKV, 0, ws + WO_KV, r, scr, lane); continue; } r -= I_KV;
        if (r < I_Q) { transpose_mat<0>(p.q_w, D, NQ, NQP, 0, ws + WO_Q, r, scr, lane); continue; } r -= I_Q;
        if (r < I_O) { transpose_mat<0>(p.o_w, D, D, D, 0, ws + WO_O, r, scr, lane); continue; } r -= I_O;
        if (r < I_C) { transpose_mat<0>(p.cmp_k_w1, 2048, 256, 256, 0, ws + WO_CK, r, scr, lane); continue; } r -= I_C;
        transpose_mat<0>(p.cmp_v_w1, 2048, 256, 256, 0, ws + WO_CV, r, scr, lane);
    }
}

__device__ __forceinline__ void phase_modvec(const Params& p, LAS unsigned char* lds) {
    const int tid = opaque_tid(), lane = tid & 63, wave = tid >> 6;
    LAS float* part = (LAS float*)lds;
    LAS float* sc_l = (LAS float*)(lds + 8192);
    for (int i = tid; i < 4 * D; i += NTHR) sc_l[i] = silu_f(p.c[i]);
    __syncthreads();
    float* MODV = (float*)(p.ws + WS_MODV);
    float* CMPB = (float*)(p.ws + WS_CMPB);
    { float* FGMAX = (float*)(p.ws + WS_FGMAX);
      for (int u = blockIdx.x; u < 2 * FF / 64; u += gridDim.x) {
        const int col = u * 64 + lane; float m = 0.f;
#pragma unroll 16
        for (int k = wave * 128; k < wave * 128 + 128; ++k) m = fmaxf(m, fabsf(p.ffn_gu[(size_t)k * (2 * FF) + col]));
        part[wave * 64 + lane] = m;
        __syncthreads();
        if (tid < 64) { float mm = part[lane];
#pragma unroll
            for (int w = 1; w < 8; ++w) mm = fmaxf(mm, part[w * 64 + lane]);
            FGMAX[u * 64 + lane] = fmaxf(mm, 1e-30f); }
        __syncthreads();
      } }
    constexpr int NU_MOD = 14336 / 64, NU = NU_MOD + 8;
    for (int u = blockIdx.x; u < NU; u += gridDim.x) {
        float acc[4] = {0.f, 0.f, 0.f, 0.f};
        if (u < NU_MOD) {
            const int gc = u * 64 + lane;
            const float* W; int ldw, col;
            if (gc < 6144) { W = p.ada_w; ldw = 6144; col = gc; } else if (gc < 12288) { W = p.ada_w + (size_t)D * 6144; ldw = 6144; col = gc - 6144; } else { W = p.kv_ada_w; ldw = 2048; col = gc - 12288; }
#pragma unroll 16
            for (int k = wave * 128; k < wave * 128 + 128; ++k) {
                const float w = W[(size_t)k * ldw + col];
#pragma unroll
                for (int b = 0; b < 4; ++b) acc[b] += sc_l[b * D + k] * w;
            }
        } else {
            const int cu = u - NU_MOD, kv = cu >> 2, col = (cu & 3) * 64 + lane;
            const float* W = kv ? p.cmp_v_w1 : p.cmp_k_w1; const float* pe = kv ? p.cmp_pe_v : p.cmp_pe_k;
#pragma unroll 16
            for (int k = wave * 256; k < wave * 256 + 256; ++k) acc[0] += pe[k] * W[(size_t)k * 256 + col];
        }
#pragma unroll
        for (int b = 0; b < 4; ++b) part[(wave * 4 + b) * 64 + lane] = acc[b];
        __syncthreads();
        if (tid < 256) {
            const int b = tid >> 6; float s = 0.f;
#pragma unroll
            for (int w = 0; w < 8; ++w) s += part[(w * 4 + b) * 64 + lane];
            if (u < NU_MOD) {
                const int gc = u * 64 + lane; int which, n; float bias;
                if (gc < 6144) { which = gc >> 10; n = gc & 1023; bias = p.ada_b[gc]; } else if (gc < 12288) { which = 6 + ((gc - 6144) >> 10); n = gc & 1023; bias = p.ada_b[gc]; }
                else { which = 12 + ((gc - 12288) >> 10); n = gc & 1023; bias = p.kv_ada_b[gc - 12288]; }
                MODV[(which * 4 + b) * D + n] = s + bias;
            } else if (b == 0) { const int cu = u - NU_MOD; CMPB[(cu >> 2) * 256 + (cu & 3) * 64 + lane] = s; }
        }
        __syncthreads();
    }
}

template <int W>
__device__ __forceinline__ void pool_rows(const float* xb, int t0, const LAS float* rs, f32x2 gm, f32x2 sh, bf16_t* outb, int c0) {
    f32x2 ring[16];
#pragma unroll
    for (int i = 0; i < 15; ++i) {
        const int t = t0 - 15 + i; f32x2 h = {0.f, 0.f};
        if (t >= 0) { const f32x2 xv = *(const f32x2*)(xb + (size_t)t * D + c0); const float r = rs[i]; h = xv * r * gm + sh; }
        ring[i] = h;
    }
    for (int gi = 0; gi < 8; ++gi) {
        f32x2 xq[16];
#pragma unroll
        for (int j = 0; j < 16; ++j) xq[j] = *(const f32x2*)(xb + (size_t)(t0 + gi * 16 + j) * D + c0);
#pragma unroll
        for (int j = 0; j < 16; ++j) {
            const int i = 15 + gi * 16 + j, t = t0 + gi * 16 + j;
            const f32x2 xv = xq[j]; const float r = rs[i];
            const f32x2 h = xv * r * gm + sh;
            ring[(15 + j) & 15] = h;
            f32x2 s = {0.f, 0.f};
#pragma unroll
            for (int k = 0; k < W; ++k) s += ring[(15 + j - k) & 15];
            const int cnt = (t + 1 < W) ? t + 1 : W;
            const f32x2 o = s * (1.f / (float)cnt) - h;
            *(unsigned*)(outb + (size_t)t * D + c0) = cvt_pk_bf16(o.x, o.y);
        }
    }
}
__device__ __forceinline__ void phase_poolmix(const Params& p, LAS unsigned char* lds, bf16_t* mixA) {
    const int tid = opaque_tid(), lane = tid & 63, wave = tid >> 6;
    LAS float* rs = (LAS float*)lds;
    const float* MODV = (const float*)(p.ws + WS_MODV);
    for (int u = blockIdx.x; u < T / 128; u += gridDim.x) {
        const int b = u >> 6, t0 = (u & 63) * 128;
        const float* xb = p.x + (size_t)b * S * D;
        for (int i = wave; i < 143; i += NWAVE) {
            const int t = t0 - 15 + i; float r = 0.f;
            if (t >= 0) { const f32x4* xr = (const f32x4*)(xb + (size_t)t * D) + lane; float s = 0.f;
#pragma unroll
                for (int j = 0; j < 4; ++j) { const f32x4 v = xr[64 * j]; s += (v.x * v.x + v.y * v.y) + (v.z * v.z + v.w * v.w); }
                r = 1.f / sqrtf(wave_sum(s) * (1.f / D) + EPS); }
            if (lane == 0) rs[i] = r;
        }
        __syncthreads();
        const int c0 = 2 * tid;
        const f32x2 g = *(const f32x2*)(p.norm_g + c0), sc = *(const f32x2*)(MODV + (1 * 4 + b) * D + c0), sh = *(const f32x2*)(MODV + (0 * 4 + b) * D + c0);
        const f32x2 gm = g * (sc + 1.f);
        bf16_t* ob = mixA + (size_t)b * S * D;
        const int grp = tid >> 7;
        if (grp == 0) pool_rows<2>(xb, t0, rs, gm, sh, ob, c0);
        else if (grp == 1) pool_rows<4>(xb, t0, rs, gm, sh, ob, c0);
        else if (grp == 2) pool_rows<8>(xb, t0, rs, gm, sh, ob, c0);
        else pool_rows<16>(xb, t0, rs, gm, sh, ob, c0);
        __syncthreads();
    }
}

struct NormOut { const float* g; const float* sc; const float* sh; bf16_t* out; };
template <int NOUT, bool ROUTER, int OUTQ = 0>
__device__ __forceinline__ void phase_norm(const Params& p, LAS unsigned char* lds, const float* xin, const NormOut o0, const NormOut o1) {
    const int tid = opaque_tid(), lane = tid & 63, wave = tid >> 6;
    const int gw = blockIdx.x * NWAVE + wave, NGW = gridDim.x * NWAVE;
    f32x4 rwa[16], rwb[16];
    if (ROUTER) {
#pragma unroll
        for (int j = 0; j < 4; ++j)
#pragma unroll
            for (int q = 0; q < 4; ++q) { const f32x4* wp = (const f32x4*)(p.router_w + (size_t)(4 * lane + 256 * j + q) * NE); rwa[4 * j + q] = wp[0]; rwb[4 * j + q] = wp[1]; }
    }
    unsigned* ctl = (unsigned*)(p.ws + WS_CTL);
    int* TOPE = (int*)(p.ws + WS_TOPE); float* TOPW = (float*)(p.ws + WS_TOPW);
    unsigned cnt_local[NE];
#pragma unroll
    for (int e = 0; e < NE; ++e) cnt_local[e] = 0;
    const int rows_per = T / NGW > 0 ? (T + NGW - 1) / NGW : 1;
    const int r0 = gw * rows_per, r1 = (r0 + rows_per < T) ? r0 + rows_per : T;
    int curb = -1; f32x4 gm0[4], sh0[4], gm1[4], sh1[4];
    for (int r = r0; r < r1; ++r) {
        const int b = r >> 13;
        if (b != curb) { curb = b;
#pragma unroll
            for (int j = 0; j < 4; ++j) { const int c = 4 * lane + 256 * j;
                gm0[j] = *(const f32x4*)(o0.g + c) * (*(const f32x4*)(o0.sc + b * D + c) + 1.f); sh0[j] = *(const f32x4*)(o0.sh + b * D + c);
                if (NOUT > 1) { gm1[j] = *(const f32x4*)(o1.g + c) * (*(const f32x4*)(o1.sc + b * D + c) + 1.f); sh1[j] = *(const f32x4*)(o1.sh + b * D + c); } } }
        const f32x4* xr = (const f32x4*)(xin + (size_t)r * D) + lane;
        f32x4 v[4]; float s = 0.f;
#pragma unroll
        for (int j = 0; j < 4; ++j) { v[j] = xr[64 * j]; s += (v[j].x * v[j].x + v[j].y * v[j].y) + (v[j].z * v[j].z + v[j].w * v[j].w); }
        const float rstd = 1.f / sqrtf(wave_sum(s) * (1.f / D) + EPS);
        float lg[NE];
#pragma unroll
        for (int e = 0; e < NE; ++e) lg[e] = 0.f;
        float qsc = 1.f;
        if constexpr (OUTQ == 2) { float mx = 0.f;
#pragma unroll
            for (int j = 0; j < 4; ++j) { const f32x4 h = v[j] * rstd * gm0[j] + sh0[j]; mx = fmaxf(mx, fmaxf(fmaxf(fabsf(h.x), fabsf(h.y)), fmaxf(fabsf(h.z), fabsf(h.w)))); }
            mx = fmaxf(wave_max(mx), 1e-30f); qsc = 127.f / mx;
            if (lane == 0) ((float*)(p.ws + WS_ASC))[r] = mx * (1.f / 127.f); }
#pragma unroll
        for (int j = 0; j < 4; ++j) {
            const f32x4 h = v[j] * rstd * gm0[j] + sh0[j];
            if constexpr (OUTQ == 2) { *(unsigned*)((unsigned char*)o0.out + (size_t)r * D + 4 * lane + 256 * j) = pack_i8x4(h.x * qsc, h.y * qsc, h.z * qsc, h.w * qsc); }
            else if constexpr (OUTQ == 1) { unsigned w8 = 0u; w8 = __builtin_amdgcn_cvt_pk_fp8_f32(h.x, h.y, w8, false); w8 = __builtin_amdgcn_cvt_pk_fp8_f32(h.z, h.w, w8, true);
                *(unsigned*)((unsigned char*)o0.out + (size_t)r * D + 4 * lane + 256 * j) = w8; }
            else { u32x2 w; w.x = cvt_pk_bf16(h.x, h.y); w.y = cvt_pk_bf16(h.z, h.w);
            *(u32x2*)(o0.out + (size_t)r * D + 4 * lane + 256 * j) = w; }
            if (NOUT > 1) { const f32x4 h1 = v[j] * rstd * gm1[j] + sh1[j]; u32x2 w1; w1.x = cvt_pk_bf16(h1.x, h1.y); w1.y = cvt_pk_bf16(h1.z, h1.w);
                *(u32x2*)(o1.out + (size_t)r * D + 4 * lane + 256 * j) = w1; }
            if (ROUTER) {
#pragma unroll
                for (int q = 0; q < 4; ++q) { const f32x4 a = rwa[4 * j + q], c2 = rwb[4 * j + q]; const float hv = h[q];
                    lg[0] += hv * a.x; lg[1] += hv * a.y; lg[2] += hv * a.z; lg[3] += hv * a.w; lg[4] += hv * c2.x; lg[5] += hv * c2.y; lg[6] += hv * c2.z; lg[7] += hv * c2.w; }
            }
        }
        if (ROUTER) {
            {
                const bool u5 = lane & 32, u4 = lane & 16, u3 = lane & 8; float a4[4], a2[2], a1;
#pragma unroll
                for (int i = 0; i < 4; ++i) a4[i] = bfly32(lg[i], lg[4 + i]);
#pragma unroll
                for (int i = 0; i < 2; ++i) a2[i] = bfly16(a4[i], a4[2 + i]);
                a1 = (u3 ? a2[1] : a2[0]) + lane_xor8(u3 ? a2[0] : a2[1]);
                a1 += lane_xor1(a1); a1 += lane_xor2(a1); a1 += red_step4(a1);
#pragma unroll
                for (int e = 0; e < NE; ++e) lg[e] = readlane_f(a1, 8 * e) + p.router_b[e];
            }
            int e0 = 0; float v0 = lg[0];
#pragma unroll
            for (int e = 1; e < NE; ++e) if (lg[e] > v0) { v0 = lg[e]; e0 = e; }
            int e1 = -1; float v1 = -3.0e38f;
#pragma unroll
            for (int e = 0; e < NE; ++e) if (e != e0 && lg[e] > v1) { v1 = lg[e]; e1 = e; }
            const float ex = __expf(v1 - v0), w0 = 1.f / (1.f + ex), w1 = ex / (1.f + ex);
            if (lane == 0) { TOPE[2 * r] = e0; TOPE[2 * r + 1] = e1; TOPW[2 * r] = w0; TOPW[2 * r + 1] = w1; }
#pragma unroll
            for (int e = 0; e < NE; ++e) cnt_local[e] += (e == e0) + (e == e1);
        }
    }
    if (ROUTER) {
        LAS unsigned* lc = (LAS unsigned*)lds;
        if (tid < NE) lc[tid] = 0u;
        __syncthreads();
        if (lane == 0) {
#pragma unroll
            for (int e = 0; e < NE; ++e) if (cnt_local[e]) atomicAdd((unsigned*)(lc + e), cnt_local[e]);
        }
        __syncthreads();
        if (tid < NE && lc[tid]) atomicAdd(ctl + CW_CNT + 64 * tid, lc[tid]);
    }
}

struct NoCol {};
struct EpiPool {
    typedef f32x4 Col; static constexpr bool ROWLOAD = true;
    const float* x; float* x1; const float* g1; const float* scale; int coff;
    __device__ __forceinline__ f32x4 col(int row0, int c) const { return *(const f32x4*)(g1 + (row0 >> 13) * D + coff + c) * *(const f32x4*)(scale + coff + c); }
    __device__ __forceinline__ f32x4 rowload(int row, int c) const { return *(const f32x4*)(x + (size_t)row * D + coff + c); }
    __device__ __forceinline__ void apply8(int row, int c, f32x4 v0, f32x4 v1, f32x4 cg0, f32x4 cg1, f32x4 xv0, f32x4 xv1) const { float* o = x1 + (size_t)row * D + coff + c; *(f32x4*)o = xv0 + cg0 * v0; *(f32x4*)(o + 4) = xv1 + cg1 * v1; }
};
struct EpiSwigluI8 {
    struct Col { f32x4 wg, wu; }; typedef float Row;
    bf16_t* hid; int ldh; const float* asc; const float* wmax;
    __device__ __forceinline__ Col col(int hc) const { Col c; c.wg = *(const f32x4*)(wmax + hc); c.wu = *(const f32x4*)(wmax + FF + hc); return c; }
    __device__ __forceinline__ float rowv(int row) const { return asc[row] * (1.f / 127.f); }
    __device__ __forceinline__ u32x2 four(f32x4 gt, f32x4 up, const Col& c, float ra) const {
        typedef int i32x4e __attribute__((ext_vector_type(4)));
        const i32x4e gi = __builtin_bit_cast(i32x4e, gt), ui = __builtin_bit_cast(i32x4e, up);
        const f32x4 wg = c.wg * ra, wu = c.wu * ra;
        const f32x2 a = swiglu2((f32x2){(float)gi.x, (float)gi.y} * (f32x2){wg.x, wg.y}, (f32x2){(float)ui.x, (float)ui.y} * (f32x2){wu.x, wu.y});
        const f32x2 b = swiglu2((f32x2){(float)gi.z, (float)gi.w} * (f32x2){wg.z, wg.w}, (f32x2){(float)ui.z, (float)ui.w} * (f32x2){wu.z, wu.w});
        u32x2 w; w.x = cvt_pk_bf16(a.x, a.y); w.y = cvt_pk_bf16(b.x, b.y); return w; }
    __device__ __forceinline__ void pair8(int row, int hc, f32x4 g0, f32x4 u0, f32x4 g1, f32x4 u1, const Col& c0, const Col& c1, float ra) const {
        const u32x2 a = four(g0, u0, c0, ra), b = four(g1, u1, c1, ra);
        *(u32x4*)(hid + (size_t)row * ldh + hc) = (u32x4){a.x, a.y, b.x, b.y}; }
};
struct EpiSwiglu8 {
    typedef NoCol Col; typedef NoCol Row;
    unsigned char* hid; int ldh;
    __device__ __forceinline__ NoCol col(int) const { return NoCol{}; }
    __device__ __forceinline__ NoCol rowv(int) const { return NoCol{}; }
    __device__ __forceinline__ unsigned four(f32x4 gt, f32x4 up) const {
        const f32x2 a = swiglu2((f32x2){gt.x, gt.y}, (f32x2){up.x, up.y}), b = swiglu2((f32x2){gt.z, gt.w}, (f32x2){up.z, up.w});
        unsigned w = 0u; w = __builtin_amdgcn_cvt_pk_fp8_f32(a.x, a.y, w, false); w = __builtin_amdgcn_cvt_pk_fp8_f32(b.x, b.y, w, true); return w; }
    __device__ __forceinline__ void pair8(int row, int hc, f32x4 g0, f32x4 u0, f32x4 g1, f32x4 u1, const NoCol&, const NoCol&, NoCol) const {
        *(u32x2*)(hid + (size_t)row * ldh + hc) = (u32x2){four(g0, u0), four(g1, u1)}; }
};
struct EpiResid {
    typedef f32x4 Col; static constexpr bool ROWLOAD = true;
    const float* xin; float* out; const float* gate;
    __device__ __forceinline__ f32x4 col(int row0, int c) const { return *(const f32x4*)(gate + (row0 >> 13) * D + c); }
    __device__ __forceinline__ f32x4 rowload(int row, int c) const { return *(const f32x4*)(xin + (size_t)row * D + c); }
    __device__ __forceinline__ void apply8(int row, int c, f32x4 v0, f32x4 v1, f32x4 cg0, f32x4 cg1, f32x4 xv0, f32x4 xv1) const { float* o = out + (size_t)row * D + c; *(f32x4*)o = xv0 + cg0 * v0; *(f32x4*)(o + 4) = xv1 + cg1 * v1; }
};
struct EpiBf16 {
    typedef NoCol Col; static constexpr bool ROWLOAD = false;
    bf16_t* o; int ldo;
    __device__ __forceinline__ NoCol col(int, int) const { return NoCol{}; }
    __device__ __forceinline__ void apply8(int row, int c, f32x4 v0, f32x4 v1, NoCol, NoCol) const { *(u32x4*)(o + (size_t)row * ldo + c) = (u32x4){cvt_pk_bf16(v0.x, v0.y), cvt_pk_bf16(v0.z, v0.w), cvt_pk_bf16(v1.x, v1.y), cvt_pk_bf16(v1.z, v1.w)}; }
};
struct EpiQ {
    typedef NoCol Col; static constexpr bool ROWLOAD = false;
    bf16_t* q; float* gates; int coff;
    __device__ __forceinline__ NoCol col(int, int) const { return NoCol{}; }
    __device__ __forceinline__ void apply8(int row, int col_, f32x4 v0, f32x4 v1, NoCol, NoCol) const { const int col = col_ + coff;
        if (col < D) { *(u32x4*)(q + (size_t)row * D + col) = (u32x4){cvt_pk_bf16(v0.x, v0.y), cvt_pk_bf16(v0.z, v0.w), cvt_pk_bf16(v1.x, v1.y), cvt_pk_bf16(v1.z, v1.w)}; }
        else if (col < NQ) { f32x4 s0, s1; s0.x = sigmoid_f(v0.x); s0.y = sigmoid_f(v0.y); s0.z = sigmoid_f(v0.z); s0.w = sigmoid_f(v0.w); s1.x = sigmoid_f(v1.x); s1.y = sigmoid_f(v1.y); s1.z = sigmoid_f(v1.z); s1.w = sigmoid_f(v1.w);
            float* g = gates + (size_t)row * 48 + (col - D); *(f32x4*)g = s0; *(f32x4*)(g + 4) = s1; } }
};
struct EpiCmp {
    typedef NoCol Col; static constexpr bool ROWLOAD = false;
    float* o;
    __device__ __forceinline__ NoCol col(int, int) const { return NoCol{}; }
    __device__ __forceinline__ void apply8(int row, int col, f32x4 v0, f32x4 v1, NoCol, NoCol) const { const int pn2 = col >> 8, c = col & 255;
        float* q = o + ((size_t)((pn2 & 1) * 8 + (pn2 >> 1)) * 2048 + row) * 256 + c; *(f32x4*)q = v0; *(f32x4*)(q + 4) = v1; }
};

namespace pg8 {
#define PG8_LAS __attribute__((address_space(3)))
constexpr int BM = 256, BK = 64, HALF = 128, HTB = HALF * BK * 2, STAGE_BYTES = 8 * HTB, NXCD = 8, WGM = 8;
__host__ __device__ __forceinline__ int lds_byte(int r, int c) { const int st = (r >> 4) * 2 + (c >> 5), rr = r & 15, cc = c & 31, ob = rr * 64 + cc * 2; return st * 1024 + (ob ^ (((ob >> 9) & 1) << 5)); }
__host__ __device__ __forceinline__ void stage_rc(int b, int& R, int& C) { const int st = b / 1024, sb = b % 1024, swz = sb ^ (((sb >> 9) & 1) << 5); R = (st >> 1) * 16 + swz / 64; C = (st & 1) * 32 + (swz % 64) / 2; }
__host__ __device__ __forceinline__ int perm32(int rho) { const int n = rho >> 4, i = rho & 15; return 8 * (i >> 2) + 4 * n + (i & 3); }
struct Unit { int pm, pn; };
template <int SMODE> struct Sched {
    int nM, nN, nwg, G, c; const char* A; const char* Bt; size_t lda2, ldb2; int pstv[SMODE == 3 ? NE : 1]; size_t bstride2;
    __device__ __forceinline__ void init(int M, int N, int G_, int c_, const void* A_, const void* Bt_, int lda, int ldb, const int* pst_ = nullptr, size_t bstride = 0) {
        nM = M / BM; nN = N / BM; nwg = nM * nN; G = G_; c = c_; A = (const char*)A_; Bt = (const char*)Bt_; lda2 = (size_t)lda * 2; ldb2 = (size_t)ldb * 2; bstride2 = bstride * 2;
        if constexpr (SMODE == 3) {
#pragma unroll
            for (int q = 0; q < NE; ++q) pstv[q] = __builtin_amdgcn_readfirstlane(pst_[q]); } }
    __device__ __forceinline__ bool next(int i, Unit& u) const {
        if (c < 0) return false;
        const long L = (long)i * G + c; if (L >= nwg) return false;
        int wgid = (int)L; { const int q = nwg / NXCD, r = nwg % NXCD, xcd = wgid % NXCD, off = wgid / NXCD; wgid = (xcd < r ? xcd * (q + 1) : r * (q + 1) + (xcd - r) * q) + off; }
        const int nig = WGM * nN, gid = wgid / nig, fm = gid * WGM, gsz = (nM - fm) < WGM ? (nM - fm) : WGM;
        u.pm = fm + ((wgid % nig) % gsz); u.pn = (wgid % nig) / gsz; return true;
    }
    __device__ __forceinline__ const char* a_ptr(const Unit& u) const {
        if (SMODE == 1) return A + (size_t)u.pm * BM * lda2 + (size_t)u.pn * 512;
        if (SMODE == 2) { const int pn = u.pn >> 1, kh = u.pn & 1;
            return A + (size_t)u.pm * BM * lda2 + (size_t)((pn >> 2) * 256 + (pn & 3) * 64) * 2 + (size_t)kh * 16 * ((size_t)NKV * 2); }
        return A + (size_t)u.pm * BM * lda2; }
    __device__ __forceinline__ const char* b_ptr(const Unit& u) const {
        if (SMODE == 2) return Bt + (size_t)(u.pn >> 3) * BM * ldb2 + (size_t)(u.pn & 1) * 2048;
        if (SMODE == 3) { const int m0 = u.pm * BM; int e = 0;
#pragma unroll
            for (int q = 1; q < NE; ++q) e += (m0 >= pstv[q]); return Bt + (size_t)e * bstride2 + (size_t)u.pn * BM * ldb2; }
        return Bt + (size_t)u.pn * BM * ldb2; }
};
template <class F> struct EpiEl { static constexpr bool PERM = true, AFTER_DRAIN = false; F f;
    __device__ __forceinline__ void operator()(const f32x4 (&acc)[2][2][4][2], const Unit& u, int wr, int wc, int fr, int fq) const {
        const int row0 = u.pm * BM + wr * 64 + fr, col0 = u.pn * BM + wc * 32 + 8 * fq;
        typename F::Col cg[2][2];
#pragma unroll
        for (int bj = 0; bj < 2; ++bj)
#pragma unroll
            for (int n = 0; n < 2; ++n) cg[bj][n] = f.col(u.pm * BM, col0 + bj * HALF + n * 4);
        if constexpr (F::ROWLOAD) {
            f32x4 xv[2][2][4];
#pragma unroll
            for (int r = 0; r < 2; ++r)
#pragma unroll
                for (int c = 0; c < 4; ++c) xv[0][r][c] = f.rowload(row0 + r * 16, col0 + (c >> 1) * HALF + (c & 1) * 4);
#pragma unroll
            for (int b = 0; b < 4; ++b) {
                if (b + 1 < 4) {
#pragma unroll
                    for (int r = 0; r < 2; ++r)
#pragma unroll
                        for (int c = 0; c < 4; ++c) xv[(b + 1) & 1][r][c] = f.rowload(row0 + ((b + 1) >> 1) * HALF + (((b + 1) & 1) * 2 + r) * 16, col0 + (c >> 1) * HALF + (c & 1) * 4);
                }
#pragma unroll
                for (int r = 0; r < 2; ++r)
#pragma unroll
                    for (int bj = 0; bj < 2; ++bj) { const int ai = b >> 1, m = (b & 1) * 2 + r;
                        f.apply8(row0 + ai * HALF + m * 16, col0 + bj * HALF, acc[ai][bj][m][0], acc[ai][bj][m][1], cg[bj][0], cg[bj][1], xv[b & 1][r][bj * 2], xv[b & 1][r][bj * 2 + 1]); }
            }
        } else {
#pragma unroll
            for (int ai = 0; ai < 2; ++ai)
#pragma unroll
                for (int m = 0; m < 4; ++m)
#pragma unroll
                    for (int bj = 0; bj < 2; ++bj) f.apply8(row0 + ai * HALF + m * 16, col0 + bj * HALF, acc[ai][bj][m][0], acc[ai][bj][m][1], cg[bj][0], cg[bj][1]);
        } } };
template <class F> struct EpiPairEl { static constexpr bool PERM = true, AFTER_DRAIN = false; F f;
    __device__ __forceinline__ void operator()(const f32x4 (&acc)[2][2][4][2], const Unit& u, int wr, int wc, int fr, int fq) const {
        const int row0 = u.pm * BM + wr * 64 + fr, hc0 = u.pn * HALF + wc * 32 + 8 * fq;
        typename F::Col cg[2]; typename F::Row rw[2][4];
#pragma unroll
        for (int n = 0; n < 2; ++n) cg[n] = f.col(hc0 + n * 4);
#pragma unroll
        for (int ai = 0; ai < 2; ++ai)
#pragma unroll
            for (int m = 0; m < 4; ++m) rw[ai][m] = f.rowv(row0 + ai * HALF + m * 16);
#pragma unroll
        for (int ai = 0; ai < 2; ++ai)
#pragma unroll
            for (int m = 0; m < 4; ++m) f.pair8(row0 + ai * HALF + m * 16, hc0, acc[ai][0][m][0], acc[ai][1][m][0], acc[ai][0][m][1], acc[ai][1][m][1], cg[0], cg[1], rw[ai][m]); } };

typedef int i32x8 __attribute__((ext_vector_type(8)));
template <int QM> __device__ __forceinline__ void mma_block(f32x4 (&acc)[4][2], const bf16x8 (&At)[4][2], const bf16x8 (&Bt)[2][2], const int wsc) {
    __builtin_amdgcn_s_setprio(1);
    if constexpr (QM == 2) {
        typedef int i32x4m __attribute__((ext_vector_type(4)));
#pragma unroll
        for (int m = 0; m < 4; ++m)
#pragma unroll
            for (int n = 0; n < 2; ++n)
#pragma unroll
                for (int k = 0; k < 2; ++k) acc[m][n] = __builtin_bit_cast(f32x4, __builtin_amdgcn_mfma_i32_16x16x64_i8(__builtin_bit_cast(i32x4m, Bt[n][k]), __builtin_bit_cast(i32x4m, At[m][k]), __builtin_bit_cast(i32x4m, acc[m][n]), 0, 0, 0));
#pragma unroll
        for (int m = 0; m < 4; ++m) asm volatile("" : "+v"(acc[m][0]), "+v"(acc[m][1]));
    } else if constexpr (QM == 1) {
#pragma unroll
        for (int m = 0; m < 4; ++m) { const u32x4 a0 = __builtin_bit_cast(u32x4, At[m][0]), a1 = __builtin_bit_cast(u32x4, At[m][1]);
            const i32x8 a8 = {(int)a0.x, (int)a0.y, (int)a0.z, (int)a0.w, (int)a1.x, (int)a1.y, (int)a1.z, (int)a1.w};
#pragma unroll
            for (int n = 0; n < 2; ++n) { const u32x4 b0 = __builtin_bit_cast(u32x4, Bt[n][0]), b1 = __builtin_bit_cast(u32x4, Bt[n][1]);
                const i32x8 b8 = {(int)b0.x, (int)b0.y, (int)b0.z, (int)b0.w, (int)b1.x, (int)b1.y, (int)b1.z, (int)b1.w};
                acc[m][n] = __builtin_amdgcn_mfma_scale_f32_16x16x128_f8f6f4(b8, a8, acc[m][n], 0, 0, 0, wsc, 0, 127); } }
#pragma unroll
        for (int m = 0; m < 4; ++m) asm volatile("" : "+v"(acc[m][0]), "+v"(acc[m][1]));
    } else {
#pragma unroll
        for (int m = 0; m < 4; ++m)
#pragma unroll
            for (int n = 0; n < 2; ++n)
#pragma unroll
                for (int k = 0; k < 2; ++k) acc[m][n] = __builtin_amdgcn_mfma_f32_16x16x32_bf16(Bt[n][k], At[m][k], acc[m][n], 0, 0, 0);
    }
    __builtin_amdgcn_s_setprio(0);
}
template <class Epi, class Sched, bool ALIGN_EPI = true, bool SP2 = true, int QM = 0>
__device__ __forceinline__ void gemm_phase(PG8_LAS unsigned char* lds, const int K, const int lda, const int ldb, const size_t kstepA, const Sched& S, const Epi& E, const int wsc = 127) {
    const int tid_ = opaque_tid();
    const int tid = tid_, wid = __builtin_amdgcn_readfirstlane(tid >> 6), lane = tid & 63, wr = wid >> 2, wc = wid & 3, fr = lane & 15, fq = lane >> 4;
    const int nt = K / BK;
    unsigned voffA[2], voffB[2];
#pragma unroll
    for (int i = 0; i < 2; ++i) { int R, C; stage_rc(tid * 16 + i * 8192, R, C); const int Rb = Epi::PERM ? ((R & ~31) + perm32(R & 31)) : R;
        voffA[i] = (unsigned)(R * lda + C) * 2u; voffB[i] = (unsigned)(Rb * ldb + C) * 2u; }
    const size_t kstepB = (size_t)(BK * 2);
    const size_t hstepA = (size_t)HALF * lda * 2, hstepB = (size_t)HALF * ldb * 2;
    const unsigned ldsw = (unsigned)wid * 1024u;
    int aoffk[2], boffk[2];
#pragma unroll
    for (int k = 0; k < 2; ++k) { const int col = (QM == 1) ? ((fq >> 1) * 32 + (fq & 1) * 16 + 8 * k) : (k * 32 + fq * 8); aoffk[k] = lds_byte(wr * 64 + fr, col); boffk[k] = lds_byte(wc * 32 + fr, col); }
#define PG8_SA(b, h) (((b) * 2 + (h)) * HTB)
#define PG8_SB(b, h) ((4 + (b) * 2 + (h)) * HTB)
#define PG8_STAGE(bufoff, gbase, voff) do { _Pragma("unroll") for (int _i = 0; _i < 2; ++_i) \
        __builtin_amdgcn_global_load_lds((const unsigned*)((const char*)(gbase) + (voff)[_i]), (PG8_LAS unsigned*)(lds + (bufoff) + ldsw + _i * 8192), 16, 0, 0); } while (0)
#define PG8_LDA(dst, b, h) do { _Pragma("unroll") for (int m = 0; m < 4; ++m) _Pragma("unroll") for (int k = 0; k < 2; ++k) dst[m][k] = *(const PG8_LAS bf16x8*)(lds + PG8_SA(b, h) + ((QM == 1) ? aoffk[k] : aoffk[0] + k * 1024) + m * 2048); } while (0)
#define PG8_LDB(dst, b, h) do { _Pragma("unroll") for (int n = 0; n < 2; ++n) _Pragma("unroll") for (int k = 0; k < 2; ++k) dst[n][k] = *(const PG8_LAS bf16x8*)(lds + PG8_SB(b, h) + ((QM == 1) ? boffk[k] : boffk[0] + k * 1024) + n * 2048); } while (0)
#define PG8_MMA(ai, bj, At, Bt) mma_block<QM>(acc[ai][bj], At, Bt, wsc)
#define PG8_WAIT_V(n) asm volatile("s_waitcnt vmcnt(" #n ")" ::: "memory")
#define PG8_WAIT_L(n) asm volatile("s_waitcnt lgkmcnt(" #n ")" ::: "memory")
#define PG8_BAR __builtin_amdgcn_s_barrier()
#define PG8_SCHED __builtin_amdgcn_sched_barrier(0)
    Unit cur, nxt; int ui = 0;
    if (!S.next(0, cur)) return;
    f32x4 acc[2][2][4][2];
#pragma unroll
    for (int a = 0; a < 2; ++a)
#pragma unroll
        for (int b = 0; b < 2; ++b)
#pragma unroll
            for (int m = 0; m < 4; ++m)
#pragma unroll
                for (int n = 0; n < 2; ++n) acc[a][b][m][n] = (f32x4){0.f, 0.f, 0.f, 0.f};
    bf16x8 At[4][2], B0[2][2], B1[2][2];
    const char* cA = S.a_ptr(cur); const char* cB = S.b_ptr(cur);
    if constexpr (SP2) {
        PG8_STAGE(PG8_SB(0, 0), cB, voffB); PG8_STAGE(PG8_SB(0, 1), cB + hstepB, voffB); PG8_STAGE(PG8_SA(0, 0), cA, voffA); PG8_STAGE(PG8_SA(0, 1), cA + hstepA, voffA);
        if (wr == 1) PG8_BAR;
        PG8_WAIT_V(2); PG8_BAR;
        PG8_STAGE(PG8_SB(1, 0), cB + kstepB, voffB); PG8_STAGE(PG8_SA(1, 0), cA + kstepA, voffA); PG8_STAGE(PG8_SB(1, 1), cB + hstepB + kstepB, voffB);
        PG8_WAIT_V(6); PG8_BAR;
    } else {
        PG8_STAGE(PG8_SB(0, 0), cB, voffB); PG8_STAGE(PG8_SA(0, 0), cA, voffA); PG8_STAGE(PG8_SB(0, 1), cB + hstepB, voffB); PG8_STAGE(PG8_SA(0, 1), cA + hstepA, voffA);
        if (wr == 1) PG8_BAR;
        PG8_WAIT_V(4); PG8_BAR;
        PG8_STAGE(PG8_SB(1, 0), cB + kstepB, voffB); PG8_STAGE(PG8_SA(1, 0), cA + kstepA, voffA); PG8_STAGE(PG8_SB(1, 1), cB + hstepB + kstepB, voffB);
        PG8_WAIT_V(6); PG8_BAR;
    }
    for (;;) {
        const bool has_next = S.next(ui + 1, nxt);
        const char* nA = has_next ? S.a_ptr(nxt) : cA; const char* nB = has_next ? S.b_ptr(nxt) : cB;
        for (int t = 0; t < nt; t += 2) {
            const bool last = (t == nt - 2);
            const char* a1 = cA + (size_t)(t + 1) * kstepA;
            const char* a2 = last ? nA : cA + (size_t)(t + 2) * kstepA; const char* b2 = last ? nB : cB + (size_t)(t + 2) * kstepB;
            const char* a3 = a2 + kstepA; const char* b3 = b2 + kstepB;
            if constexpr (SP2) {
            PG8_LDB(B0, 0, 0); PG8_LDB(B1, 0, 1); PG8_SCHED; PG8_LDA(At, 0, 0); PG8_STAGE(PG8_SA(1, 1), a1 + hstepA, voffA);
            PG8_WAIT_V(8); PG8_WAIT_L(0); PG8_BAR; PG8_MMA(0, 0, At, B0); PG8_MMA(0, 1, At, B1); PG8_BAR; PG8_SCHED;
            PG8_LDA(At, 0, 1); PG8_STAGE(PG8_SB(0, 0), b2, voffB); PG8_STAGE(PG8_SB(0, 1), b2 + hstepB, voffB); PG8_STAGE(PG8_SA(0, 0), a2, voffA);
            PG8_WAIT_V(8); PG8_WAIT_L(0); PG8_BAR; PG8_MMA(1, 0, At, B0); PG8_MMA(1, 1, At, B1); PG8_BAR; PG8_SCHED;
            PG8_LDB(B0, 1, 0); PG8_LDB(B1, 1, 1); PG8_SCHED; PG8_LDA(At, 1, 0); PG8_STAGE(PG8_SA(0, 1), a2 + hstepA, voffA);
            PG8_WAIT_V(8); PG8_WAIT_L(0); PG8_BAR; PG8_MMA(0, 0, At, B0); PG8_MMA(0, 1, At, B1); PG8_BAR; PG8_SCHED;
            PG8_LDA(At, 1, 1); PG8_STAGE(PG8_SB(1, 0), b3, voffB); PG8_STAGE(PG8_SB(1, 1), b3 + hstepB, voffB); PG8_STAGE(PG8_SA(1, 0), a3, voffA);
            PG8_WAIT_V(8); PG8_WAIT_L(0); PG8_BAR; PG8_MMA(1, 0, At, B0); PG8_MMA(1, 1, At, B1); PG8_BAR; PG8_SCHED;
            } else {
            PG8_LDB(B0, 0, 0); PG8_SCHED; PG8_LDA(At, 0, 0); PG8_STAGE(PG8_SA(1, 1), a1 + hstepA, voffA);
            PG8_WAIT_L(8); PG8_BAR; PG8_WAIT_L(0); PG8_MMA(0, 0, At, B0); PG8_BAR; PG8_SCHED;
            PG8_LDB(B1, 0, 1); PG8_STAGE(PG8_SB(0, 0), b2, voffB);
            PG8_BAR; PG8_WAIT_L(0); PG8_MMA(0, 1, At, B1); PG8_BAR;
            PG8_LDA(At, 0, 1); PG8_STAGE(PG8_SA(0, 0), a2, voffA);
            PG8_BAR; PG8_WAIT_L(0); PG8_MMA(1, 0, At, B0); PG8_BAR; PG8_SCHED;
            PG8_STAGE(PG8_SB(0, 1), b2 + hstepB, voffB);
            PG8_WAIT_V(6); PG8_BAR; PG8_MMA(1, 1, At, B1); PG8_BAR;
            PG8_LDB(B0, 1, 0); PG8_SCHED; PG8_LDA(At, 1, 0); PG8_STAGE(PG8_SA(0, 1), a2 + hstepA, voffA);
            PG8_WAIT_L(8); PG8_BAR; PG8_WAIT_L(0); PG8_MMA(0, 0, At, B0); PG8_BAR; PG8_SCHED;
            PG8_LDB(B1, 1, 1); PG8_STAGE(PG8_SB(1, 0), b3, voffB);
            PG8_BAR; PG8_WAIT_L(0); PG8_MMA(0, 1, At, B1); PG8_BAR;
            PG8_LDA(At, 1, 1); PG8_STAGE(PG8_SA(1, 0), a3, voffA);
            PG8_BAR; PG8_WAIT_L(0); PG8_MMA(1, 0, At, B0); PG8_BAR; PG8_SCHED;
            PG8_STAGE(PG8_SB(1, 1), b3 + hstepB, voffB);
            PG8_WAIT_V(6); PG8_BAR; PG8_MMA(1, 1, At, B1); PG8_BAR;
            }
        }
        if constexpr (ALIGN_EPI) { if (wr == 0) PG8_BAR; }
        if constexpr (!Epi::AFTER_DRAIN) { E(acc, cur, wr, wc, fr, fq); }
        if (!has_next) break;
#pragma unroll
        for (int a = 0; a < 2; ++a)
#pragma unroll
            for (int b = 0; b < 2; ++b)
#pragma unroll
                for (int m = 0; m < 4; ++m)
#pragma unroll
                    for (int n = 0; n < 2; ++n) acc[a][b][m][n] = (f32x4){0.f, 0.f, 0.f, 0.f};
        cur = nxt; cA = nA; cB = nB; ++ui;
        if constexpr (ALIGN_EPI) { if (wr == 1) PG8_BAR; }
    }
    PG8_WAIT_V(0);
    if constexpr (!ALIGN_EPI) { if (wr == 0) PG8_BAR; }
    PG8_BAR;
    if constexpr (Epi::AFTER_DRAIN) { E.fused(acc, cur, wr, wc, fr, fq, lds, wid, lane); }
#undef PG8_SA
#undef PG8_SB
#undef PG8_STAGE
#undef PG8_LDA
#undef PG8_LDB
#undef PG8_MMA
#undef PG8_WAIT_V
#undef PG8_WAIT_L
#undef PG8_BAR
#undef PG8_SCHED
}
}

__device__ __forceinline__ void phase_headnorm(const Params& p, LAS unsigned char* lds) {
    const int tid = opaque_tid(), lane = tid & 63, wave = tid >> 6;
    LAS int* chunk = (LAS int*)(lds + 131072 - 64);
    bf16_t* Q = (bf16_t*)(p.ws + WS_Q); bf16_t* KVB = (bf16_t*)(p.ws + WS_KVB);
    float qg[16], kg[8];
#pragma unroll
    for (int i = 0; i < 16; ++i) qg[i] = p.q_gain[(lane & 3) * 16 + i] * (0.125f * 1.4426950408889634f);
    const int kr = lane >> 5;
#pragma unroll
    for (int i = 0; i < 8; ++i) kg[i] = p.k_gain[(1 + kr) * 64 + (lane & 7) * 8 + i];
    for (;;) {
      if (tid == 0) *chunk = (int)atomicAdd((unsigned*)(p.ws + WS_CTL) + CW_HN, 1u);
      __syncthreads();
      const int c0 = *chunk;
      __syncthreads();
      if (c0 >= T / 128) break;
      for (int r4 = c0 * 128 + wave * 16; r4 < c0 * 128 + wave * 16 + 16; r4 += 4) {
        u32x4 qa[4], qb[4], kw[4];
#pragma unroll
        for (int j = 0; j < 4; ++j) { const int r = r4 + j; const u32x4* ptr = (const u32x4*)(Q + (size_t)r * D + lane * 16); qa[j] = ptr[0]; qb[j] = ptr[1];
            kw[j] = *(const u32x4*)(KVB + (size_t)r * NKV + (kr ? 1024 : 512) + (lane & 31) * 8); }
#pragma unroll
        for (int j = 0; j < 4; ++j) { const int r = r4 + j;
        {
            u32x4* ptr = (u32x4*)(Q + (size_t)r * D + lane * 16); const u32x4 w0 = qa[j], w1 = qb[j];
            float v[16]; const unsigned ww[8] = {w0.x, w0.y, w0.z, w0.w, w1.x, w1.y, w1.z, w1.w}; float s = 0.f;
#pragma unroll
            for (int i = 0; i < 8; ++i) { v[2 * i] = bflo(ww[i]); v[2 * i + 1] = bfhi(ww[i]); s += v[2 * i] * v[2 * i] + v[2 * i + 1] * v[2 * i + 1]; }
            s += lane_xor1(s); s += lane_xor2(s);
            const float rstd = 1.f / sqrtf(s * (1.f / 64.f) + EPS);
            unsigned o[8];
#pragma unroll
            for (int i = 0; i < 8; ++i) o[i] = cvt_pk_bf16(v[2 * i] * rstd * qg[2 * i], v[2 * i + 1] * rstd * qg[2 * i + 1]);
            ptr[0] = (u32x4){o[0], o[1], o[2], o[3]}; ptr[1] = (u32x4){o[4], o[5], o[6], o[7]};
        }
        {
            const u32x4 w0 = kw[j];
            float v[8]; const unsigned ww[4] = {w0.x, w0.y, w0.z, w0.w}; float s = 0.f;
#pragma unroll
            for (int i = 0; i < 4; ++i) { v[2 * i] = bflo(ww[i]); v[2 * i + 1] = bfhi(ww[i]); s += v[2 * i] * v[2 * i] + v[2 * i + 1] * v[2 * i + 1]; }
            s += lane_xor1(s); s += lane_xor2(s); s += red_step4(s);
            const float rstd = 1.f / sqrtf(s * (1.f / 64.f) + EPS);
            unsigned o[4];
#pragma unroll
            for (int i = 0; i < 4; ++i) o[i] = cvt_pk_bf16(v[2 * i] * rstd * kg[2 * i], v[2 * i + 1] * rstd * kg[2 * i + 1]);
            const int b = r >> 13, t = r & (S - 1), hg = (lane & 31) >> 3, c = lane & 7;
            {
                bf16_t* dst = (bf16_t*)(p.ws + (kr ? WS_KWB : WS_KSB)) + ((size_t)((b * 4 + hg) * 128 + (t >> 6)) * 8 + c) * 512 + (t & 63) * 8;
                *(u32x4*)dst = (u32x4){o[0], o[1], o[2], o[3]};
            }
        }
        }
      }
    }
}

__device__ __forceinline__ void phase_cmp2(const Params& p, LAS unsigned char* lds) {
    const int tid = opaque_tid(), lane = tid & 63, wave = tid >> 6;
    const int gw = blockIdx.x * NWAVE + wave, NGW = gridDim.x * NWAVE;
    const float* CMPP = (const float*)(p.ws + WS_CMPP); const float* CMPB = (const float*)(p.ws + WS_CMPB);
    LAS float* w2l = (LAS float*)lds;
    for (int kv = 0; kv < 2; ++kv) {
        const float* w2 = kv ? p.cmp_v_w2 : p.cmp_k_w2;
        for (int i = tid; i < 256 * 64 / 4; i += NTHR) ((LAS f32x4*)w2l)[i] = ((const f32x4*)w2)[i];
        __syncthreads();
        for (int it = gw * 2; it < 4 * 2048; it += NGW * 2) {
            float hv[2][4], acc[2] = {0.f, 0.f};
#pragma unroll
            for (int rr = 0; rr < 2; ++rr) { const size_t zi = (size_t)(kv * 8192 + it + rr) * 256 + 4 * lane;
                const f32x4 hsum = *(const f32x4*)(CMPP + zi) + *(const f32x4*)(CMPP + (size_t)16384 * 256 + zi) + *(const f32x4*)(CMPB + kv * 256 + 4 * lane);
                hv[rr][0] = gelu_tanh_f(hsum.x); hv[rr][1] = gelu_tanh_f(hsum.y); hv[rr][2] = gelu_tanh_f(hsum.z); hv[rr][3] = gelu_tanh_f(hsum.w); }
#pragma unroll 4
            for (int kk = 0; kk < 64; ++kk)
#pragma unroll
                for (int c = 0; c < 4; ++c) { const float wv = w2l[(4 * kk + c) * 64 + lane];
                    acc[0] += readlane_f(hv[0][c], kk) * wv; acc[1] += readlane_f(hv[1][c], kk) * wv; }
#pragma unroll
            for (int rr = 0; rr < 2; ++rr) {
                const int row = it + rr, g = (row >> 11) & 3, r2 = row & 2047, b = r2 >> 9, n = r2 & 511; float a = n == NC - 1 ? 0.f : acc[rr];
                if (kv == 0) { const float ss = wave_sum(a * a); a = a * (1.f / sqrtf(ss * (1.f / 64.f) + EPS)) * p.k_gain[lane]; }
                const size_t blk0 = (size_t)((b * 4 + g) * 8 + (n >> 6)) * 4096;
                bf16_t* o = kv ? (bf16_t*)(p.ws + WS_VC) + blk0 + ((n & 63) >> 3) * 512 + lane * 8 + (n & 7)
                               : (bf16_t*)(p.ws + WS_KC) + blk0 + (lane >> 3) * 512 + (n & 63) * 8 + (lane & 7);
                *o = (bf16_t)(cvt_pk_bf16(a, 0.f) & 0xffffu);
            }
        }
        __syncthreads();
    }
}

__device__ __forceinline__ void phase_vtrans(const Params& p, LAS unsigned char* lds) {
    const int tid = opaque_tid(), lane = tid & 63, wave = tid >> 6;
    const int gw = blockIdx.x * NWAVE + wave, NGW = gridDim.x * NWAVE;
    LAS unsigned short* tile = (LAS unsigned short*)(lds + wave * 8448);
    const bf16_t* KVB = (const bf16_t*)(p.ws + WS_KVB);
    LAS int* chunk = (LAS int*)(lds + 131072 - 64);
    for (;;) {
        if (tid == 0) *chunk = (int)atomicAdd((unsigned*)(p.ws + WS_CTL) + CW_VT, 1u);
        __syncthreads();
        const int c0 = *chunk;
        __syncthreads();
        if (c0 >= 2 * 16 * 128 / NWAVE) break;
        const int u = c0 * NWAVE + wave;
        const int which = u >> 11, bg = (u >> 7) & 15, tt = u & 127, b = bg >> 2, g = bg & 3, t0 = tt * 64;
        const u32x4* src = (const u32x4*)(KVB + (size_t)(b * S + t0 + lane) * NKV + (which ? 1280 : 768) + g * 64);
#pragma unroll
        for (int i = 0; i < 8; ++i) { const u32x4 v = src[i]; LAS unsigned* tp = (LAS unsigned*)(tile + lane * 66 + 8 * i); tp[0] = v.x; tp[1] = v.y; tp[2] = v.z; tp[3] = v.w; }
        asm volatile("s_waitcnt lgkmcnt(0)" ::: "memory");
        {
            bf16_t* dst = (bf16_t*)(p.ws + (which ? WS_VWB : WS_VSB)) + (size_t)(bg * 128 + tt) * 4096 + lane * 8;
#pragma unroll
            for (int i = 0; i < 8; ++i) { unsigned w[4];
#pragma unroll
                for (int q = 0; q < 4; ++q) { const unsigned lo = tile[(8 * i + 2 * q) * 66 + lane], hi = tile[(8 * i + 2 * q + 1) * 66 + lane]; w[q] = lo | (hi << 16); }
                *(u32x4*)(dst + i * 512) = (u32x4){w[0], w[1], w[2], w[3]}; }
        }
        asm volatile("s_waitcnt lgkmcnt(0)" ::: "memory");
    }
}

typedef short s16x4 __attribute__((ext_vector_type(4)));
__device__ __forceinline__ f32x4 mfma4(s16x4 a, s16x4 b, f32x4 c) { return __builtin_amdgcn_mfma_f32_4x4x4bf16_1k(a, b, c, 0, 0, 0); }
__device__ __forceinline__ s16x4 mk4(unsigned lo, unsigned hi) { const u32x2 t = {lo, hi}; return __builtin_bit_cast(s16x4, t); }
__device__ __forceinline__ f32x4 qk64(const bf16_t* krow, const s16x4 (&qf)[16]) {
    const u32x4* kp = (const u32x4*)krow; u32x4 kr[8];
#pragma unroll
    for (int i = 0; i < 8; ++i) kr[i] = kp[i];
    f32x4 s = {0.f, 0.f, 0.f, 0.f};
#pragma unroll
    for (int c = 0; c < 8; ++c) { s = mfma4(mk4(kr[c].x, kr[c].y), qf[2 * c], s); s = mfma4(mk4(kr[c].z, kr[c].w), qf[2 * c + 1], s); }
    return s;
}
__device__ __forceinline__ void pv64(f32x4& o, const f32x4 e, const bf16_t* vtrow, LAS u32x2* stage, int lane) {
    const u32x4* vp = (const u32x4*)vtrow; u32x4 vr[8];
#pragma unroll
    for (int i = 0; i < 8; ++i) vr[i] = vp[i];
    u32x2 pk; pk.x = cvt_pk_bf16(e.x, e.y); pk.y = cvt_pk_bf16(e.z, e.w);
    stage[lane] = pk;
#pragma unroll
    for (int st = 0; st < 16; ++st) { const u32x2 a = stage[4 * st + (lane & 3)]; const u32x4 v = vr[st >> 1];
        o = mfma4(mk4(a.x, a.y), (st & 1) ? mk4(v.z, v.w) : mk4(v.x, v.y), o); }
}
__device__ __forceinline__ float quadx_sum(float v) { v += __shfl_xor(v, 4); v += __shfl_xor(v, 8); v += __shfl_xor(v, 16); v += __shfl_xor(v, 32); return v; }

constexpr int HBN = 800;
constexpr int ATT_HBD = 0, ATT_MH = 51200, ATT_PSLC = 53248, ATT_STAGE = 118784;
__device__ __forceinline__ void attn_tables(const Params& p, LAS unsigned char* lds) {
    const int tid = opaque_tid();
    LAS float* hbd = (LAS float*)(lds + ATT_HBD); LAS float* mh = (LAS float*)(lds + ATT_MH);
    if (tid < 16) { float qg = 0.f, kg = 0.f, bm = -3.0e38f;
        for (int i = 0; i < 64; ++i) qg = fmaxf(qg, fabsf(p.q_gain[i]));
        for (int i = 0; i < 192; ++i) kg = fmaxf(kg, fabsf(p.k_gain[i]));
        for (int i = 0; i < 32; ++i) bm = fmaxf(bm, p.rel_bias[i * NH + tid]);
        mh[tid] = (qg * kg * 8.f * 1.02f + bm) * 1.4426950408889634f; }
    __syncthreads();
    for (int i = tid; i < 16 * HBN; i += NTHR) { const int hd = i / HBN, d = i - hd * HBN; const float v = p.rel_bias[rel_bucket(d) * NH + hd] * 1.4426950408889634f - mh[hd]; hbd[i] = v; if (blockIdx.x == 0) ((float*)(p.ws + WS_HBG))[i] = v; }
    __syncthreads();
}
typedef float f32x16 __attribute__((ext_vector_type(16)));
__device__ __forceinline__ f32x16 mfma32(bf16x8 a, bf16x8 b, f32x16 c) { return __builtin_amdgcn_mfma_f32_32x32x16_bf16(a, b, c, 0, 0, 0); }
struct DFrag { bf16x8 ka[4]; bf16x8 va[2][2]; };
__device__ __forceinline__ void dense_load_k(bf16x8 (&ka)[4], const bf16_t* KB, int kt, int l31, int h) {
    const int blk = kt >> 6, hh = (kt >> 5) & 1;
    const bf16_t* kb = KB + (size_t)blk * 4096 + (32 * hh + l31) * 8;
#pragma unroll
    for (int ks = 0; ks < 4; ++ks) ka[ks] = *(const bf16x8*)(kb + (2 * ks + h) * 512);
}
__device__ __forceinline__ void dense_load_v(bf16x8 (&va)[2][2], const bf16_t* VB, int kt, int l31, int h) {
    const int blk = kt >> 6, hh = (kt >> 5) & 1;
    const bf16_t* vb = VB + (size_t)blk * 4096 + l31 * 8 + 4 * h;
#pragma unroll
    for (int dt = 0; dt < 2; ++dt)
#pragma unroll
        for (int st = 0; st < 2; ++st) { const bf16_t* q0 = vb + (4 * hh + 2 * st) * 512 + dt * 256; const u32x2 lo = *(const u32x2*)q0, hi = *(const u32x2*)(q0 + 512);
            const u32x4 w = {lo.x, lo.y, hi.x, hi.y}; va[dt][st] = __builtin_bit_cast(bf16x8, w); }
}
__device__ __forceinline__ f32x16 dense_scores(const DFrag& f, const bf16x8 (&q)[4]) {
    f32x16 sacc;
#pragma unroll
    for (int i = 0; i < 16; ++i) sacc[i] = 0.f;
#pragma unroll
    for (int ks = 0; ks < 4; ++ks) sacc = mfma32(f.ka[ks], q[ks], sacc);
    return sacc;
}
__device__ __forceinline__ void dense_pv(f32x16 (&O)[2], const DFrag& f, const float (&ev)[16]) {
    bf16x8 pb[2];
#pragma unroll
    for (int st = 0; st < 2; ++st) { const u32x4 w = {cvt_pk_bf16(ev[8 * st], ev[8 * st + 1]), cvt_pk_bf16(ev[8 * st + 2], ev[8 * st + 3]), cvt_pk_bf16(ev[8 * st + 4], ev[8 * st + 5]), cvt_pk_bf16(ev[8 * st + 6], ev[8 * st + 7])};
        pb[st] = __builtin_bit_cast(bf16x8, w); }
#pragma unroll
    for (int dt = 0; dt < 2; ++dt)
#pragma unroll
        for (int st = 0; st < 2; ++st) O[dt] = mfma32(f.va[dt][st], pb[st], O[dt]);
}
__device__ __forceinline__ void phase_dense(const Params& p, LAS unsigned char* lds, bf16_t* OW) {
    const int tid = opaque_tid(), lane0 = tid & 63, wave = tid >> 6;
    const LAS float* hbd = (const LAS float*)(lds + ATT_HBD); const LAS float* mh = (const LAS float*)(lds + ATT_MH);
    LAS float* pslc = (LAS float*)(lds + ATT_PSLC) + wave * 2048;
    const bf16_t* Q = (const bf16_t*)(p.ws + WS_Q); const float* GATE = (const float*)(p.ws + WS_GATE);
    short* SEL = (short*)(p.ws + WS_SEL);
    const int Gn = gridDim.x, vcu = (Gn % 8 == 0) ? (blockIdx.x % 8) * (Gn / 8) + blockIdx.x / 8 : blockIdx.x;
    for (int u = vcu * NWAVE + wave; u < T * G / 16; u += Gn * NWAVE) {
        int lane = lane0; asm volatile("" : "+v"(lane));
        const int l31 = lane & 31, h = lane >> 5;
        const int bg = u >> 9, t0 = (((u & 511) + 128 * (u >> 11)) & 511) * 16, b = bg >> 2, g = bg & 3, head = 4 * g + (lane & 3);
        const LAS float* hb = hbd + head * HBN;
        int tok[2]; bf16x8 qf[2][4];
#pragma unroll
        for (int r = 0; r < 2; ++r) { tok[r] = t0 + 8 * r + (l31 >> 2); const bf16_t* qp = Q + (size_t)(b * S + tok[r]) * D + head * 64 + 8 * h;
#pragma unroll
            for (int ks = 0; ks < 4; ++ks) qf[r][ks] = *(const bf16x8*)(qp + 16 * ks); }
        f32x16 O[2][2];
#pragma unroll
        for (int r = 0; r < 2; ++r)
#pragma unroll
            for (int dt = 0; dt < 2; ++dt)
#pragma unroll
                for (int q = 0; q < 16; ++q) O[r][dt][q] = 0.f;
        DFrag cur; bf16x8 nxtk[4];
        {
            const bf16_t* KB = (const bf16_t*)(p.ws + WS_KWB) + (size_t)bg * 128 * 4096; const bf16_t* VB = (const bf16_t*)(p.ws + WS_VWB) + (size_t)bg * 128 * 4096;
            float lw[2] = {0.f, 0.f};
            const int lo = t0 - (WIN - 1) > 0 ? t0 - (WIN - 1) : 0, kt_last = t0 & ~31;
            dense_load_k(cur.ka, KB, lo & ~31, l31, h);
            for (int kt = lo & ~31; kt <= kt_last; kt += 32) {
                dense_load_v(cur.va, VB, kt, l31, h);
                dense_load_k(nxtk, KB, kt + 32 <= kt_last ? kt + 32 : kt_last, l31, h);
                __builtin_amdgcn_sched_barrier(0);
#pragma unroll
                for (int r = 0; r < 2; ++r) {
                    const f32x16 sacc = dense_scores(cur, qf[r]);
                    const int dbase = tok[r] - kt - 4 * h; float ev[16];
                    if (kt + 31 <= t0 + 8 * r && kt >= t0 + 8 * r + 7 - (WIN - 1)) {
                        const LAS float* hbp = hb + dbase;
#pragma unroll
                        for (int q = 0; q < 16; ++q) { const float e = __builtin_amdgcn_exp2f(sacc[q] + hbp[-((q & 3) + 8 * (q >> 2))]); ev[q] = e; lw[r] += e; }
                    } else {
#pragma unroll
                    for (int q = 0; q < 16; ++q) { const int dist = dbase - ((q & 3) + 8 * (q >> 2)); const bool ok = (unsigned)dist < (unsigned)WIN;
                        const float e0 = __builtin_amdgcn_exp2f(sacc[q] + hb[ok ? dist : 0]); const float e = ok ? e0 : 0.f; ev[q] = e; lw[r] += e; }
                    }
                    dense_pv(O[r], cur, ev);
                }
#pragma unroll
                for (int ks = 0; ks < 4; ++ks) cur.ka[ks] = nxtk[ks];
            }
#pragma unroll
            for (int r = 0; r < 2; ++r) { const float l = sum_xor32(lw[r]); int tk = tok[r]; asm volatile("" : "+v"(tk)); const float* gp = GATE + (size_t)(b * S + tk) * 48 + head * 3;
                const float sc = gp[2] / (l * gp[0]);
#pragma unroll
                for (int dt = 0; dt < 2; ++dt) O[r][dt] = O[r][dt] * sc; }
        }
        const int ncmax = t0 >> 4;
        {
            int l31c = l31, hc = h; asm volatile("" : "+v"(l31c), "+v"(hc));
            const bf16_t* KB = (const bf16_t*)(p.ws + WS_KC) + (size_t)bg * 8 * 4096; const bf16_t* VB = (const bf16_t*)(p.ws + WS_VC) + (size_t)bg * 8 * 4096;
            float lc[2] = {0.f, 0.f};
            const int kt_last = ncmax > 0 ? ((ncmax - 1) & ~31) : -32;
            if (ncmax > 0) {
                dense_load_k(cur.ka, KB, 0, l31c, hc);
                for (int kt = 0; kt <= kt_last; kt += 32) {
                    dense_load_k(nxtk, KB, kt + 32 <= kt_last ? kt + 32 : kt_last, l31c, hc);
                    __builtin_amdgcn_sched_barrier(0);
#pragma unroll
                    for (int r = 0; r < 2; ++r) {
                        const f32x16 sacc = dense_scores(cur, qf[r]);
                        if (t0 - 31 - 16 * (kt + 31) >= HBN - 1) {
                            const float bfar = hb[HBN - 1];
#pragma unroll
                            for (int q = 0; q < 16; ++q) lc[r] += __builtin_amdgcn_exp2f(sacc[q] + bfar);
                        } else {
                        const int dbase = tok[r] - 31 - 16 * (kt + 4 * hc);
#pragma unroll
                        for (int q = 0; q < 16; ++q) { const int dist = dbase - 16 * ((q & 3) + 8 * (q >> 2)); const int di = dist < 0 ? 0 : (dist > HBN - 1 ? HBN - 1 : dist);
                            const float e0 = __builtin_amdgcn_exp2f(sacc[q] + hb[di]); lc[r] += dist >= 0 ? e0 : 0.f; }
                        }
                    }
#pragma unroll
                    for (int ks = 0; ks < 4; ++ks) cur.ka[ks] = nxtk[ks];
                }
            }
            float linv[2];
#pragma unroll
            for (int r = 0; r < 2; ++r) { const float l = sum_xor32(lc[r]); linv[r] = l > 0.f ? 1.f / l : 0.f; }
            { const f32x4 z = {0.f, 0.f, 0.f, 0.f};
#pragma unroll
              for (int i = 0; i < 8; ++i) *(LAS f32x4*)(pslc + (i * 64 + lane) * 4) = z; }
            if (ncmax > 0) {
                float carry[2] = {0.f, 0.f};
                dense_load_k(cur.ka, KB, 0, l31c, hc);
                for (int kt = 0; kt <= kt_last; kt += 32) {
                    dense_load_v(cur.va, VB, kt, l31c, hc);
                    dense_load_k(nxtk, KB, kt + 32 <= kt_last ? kt + 32 : kt_last, l31c, hc);
                    __builtin_amdgcn_sched_barrier(0);
#pragma unroll
                    for (int r = 0; r < 2; ++r) {
                        const f32x16 sacc = dense_scores(cur, qf[r]);
                        float pv[16];
                        const int dbase = tok[r] - 31 - 16 * (kt + 4 * hc);
#pragma unroll
                        for (int q = 0; q < 16; ++q) { const int dist = dbase - 16 * ((q & 3) + 8 * (q >> 2)); const int di = dist < 0 ? 0 : (dist > HBN - 1 ? HBN - 1 : dist);
                            const float e0 = __builtin_amdgcn_exp2f(sacc[q] + hb[di]); pv[q] = dist >= 0 ? e0 * linv[r] : 0.f; }
                        dense_pv(O[r], cur, pv);
#pragma unroll
                        for (int q = 0; q < 16; ++q) { pv[q] += lane_xor1(pv[q]); pv[q] += lane_xor2(pv[q]); }
                        float y[4];
#pragma unroll
                        for (int gq = 0; gq < 4; ++gq) y[gq] = lane_xor32(pv[4 * gq + 3], h);
#pragma unroll
                        for (int gq = 0; gq < 4; ++gq) { const float prevv = h ? y[gq] : (gq > 0 ? y[gq > 0 ? gq - 1 : 0] : carry[r]);
                            const float val = 2.f * ((pv[4 * gq] + pv[4 * gq + 1]) + pv[4 * gq + 2]) + pv[4 * gq + 3] + prevv;
                            if ((lane & 3) == 0) pslc[(8 * r + (l31c >> 2)) * 128 + (kt >> 2) + 2 * gq + hc] = val; }
                        carry[r] = y[3];
                    }
#pragma unroll
                    for (int ks = 0; ks < 4; ++ks) cur.ka[ks] = nxtk[ks];
                }
            }
        }
#pragma unroll
        for (int r = 0; r < 2; ++r) { int tk = tok[r]; asm volatile("" : "+v"(tk)); bf16_t* op = OW + (size_t)(b * S + tk) * D + head * 64 + 4 * h; const float gc = GATE[(size_t)(b * S + tk) * 48 + head * 3];
#pragma unroll
            for (int dt = 0; dt < 2; ++dt)
#pragma unroll
                for (int gq = 0; gq < 4; ++gq) { u32x2 w; w.x = cvt_pk_bf16(O[r][dt][4 * gq] * gc, O[r][dt][4 * gq + 1] * gc); w.y = cvt_pk_bf16(O[r][dt][4 * gq + 2] * gc, O[r][dt][4 * gq + 3] * gc);
                    *(u32x2*)(op + dt * 32 + 8 * gq) = w; } }
#pragma unroll 1
        for (int tl = 0; tl < 16; ++tl) {
            int ln = lane; asm volatile("" : "+v"(ln));
            const int t = t0 + tl, cur_b = t >> 6, j0 = ln, j1 = ln + 64;
            const float c0 = pslc[tl * 128 + j0], c1 = pslc[tl * 128 + j1];
            const bool f0 = (j0 == 0) || (j0 == cur_b) || (j0 == cur_b - 1), f1 = (j1 == cur_b) || (j1 == cur_b - 1);
            const bool v0 = j0 * 64 <= t, v1 = j1 * 64 <= t;
            const unsigned u0 = (v0 && !f0) ? __float_as_uint(c0) : 0u, u1 = (v1 && !f1) ? __float_as_uint(c1) : 0u;
            unsigned th = 1u;
            if (cur_b + 1 > NSEL) {
                th = 0u;
#pragma unroll 1
                for (int bit = 30; bit >= 0; --bit) {
                    const unsigned trial = th | (1u << bit);
                    const int cnt = __popcll(__ballot(u0 >= trial)) + __popcll(__ballot(u1 >= trial));
                    if (cnt >= NSEL - 3) { th = trial; if (cnt == NSEL - 3) break; }
                }
            }
            const bool s0 = f0 || (u0 >= th && u0 != 0u), s1 = f1 || (u1 >= th && u1 != 0u);
            const unsigned long long m0 = __ballot(s0), m1 = __ballot(s1), lt = (1ull << ln) - 1ull;
            const int p0 = __popcll(m0 & lt), p1 = __popcll(m0) + __popcll(m1 & lt);
            short* so = SEL + ((size_t)(b * S + t) * 4 + g) * NSEL;
            if (s0 && p0 < NSEL) so[p0] = (short)j0;
            if (s1 && p1 < NSEL) so[p1] = (short)j1;
        }
    }
}

constexpr int ST_ACC = 0, ST_LACC = 133120, ST_MASK = 135168, ST_LIST = 136192, ST_CTR = 138240, ST_HB4 = 138304;
__device__ __forceinline__ void lds_add_f64(unsigned addr, double v) { asm volatile("ds_add_f64 %0, %1" :: "v"(addr), "v"(v) : "memory"); }
__device__ __forceinline__ void phase_sel_tile(const Params& p, LAS unsigned char* lds, bf16_t* AO, const bf16_t* OW) {
    const int tid = opaque_tid(), lane = tid & 63, wave = tid >> 6, l31 = lane & 31, h = lane >> 5;
    LAS double* acc = (LAS double*)(lds + ST_ACC); LAS double* lacc = (LAS double*)(lds + ST_LACC);
    LAS unsigned* mask = (LAS unsigned*)(lds + ST_MASK); LAS int* list = (LAS int*)(lds + ST_LIST) + wave * 64; LAS int* ctr = (LAS int*)(lds + ST_CTR);
    const bf16_t* Q = (const bf16_t*)(p.ws + WS_Q); const float* GATE = (const float*)(p.ws + WS_GATE); const short* SEL = (const short*)(p.ws + WS_SEL);
    const int Gn = gridDim.x;
    for (int kk = 0, u = blockIdx.x; u < 16 * 128; u += Gn, ++kk) {
        const int bg = u >> 7, ti = u & 127, tt = (kk & 1) ? 127 - ti : ti, b = bg >> 2, g = bg & 3, t0 = tt * 64, cur = tt, nv = cur + 1 < NSEL ? cur + 1 : NSEL;
        for (int i = tid; i < ST_LIST / 16; i += NTHR) ((LAS u32x4*)lds)[i] = (u32x4){0u, 0u, 0u, 0u};
        if (tid == 0) *ctr = 0;
        { LAS float* hb4 = (LAS float*)(lds + ST_HB4); const float* hsrc = (const float*)(p.ws + WS_HBG) + 4 * g * HBN; for (int i = tid; i < 4 * HBN; i += NTHR) hb4[i] = hsrc[i]; }
        __syncthreads();
        { const int tl = tid >> 3; const short* sp = SEL + ((size_t)(b * S + t0 + tl) * 4 + g) * NSEL;
#pragma unroll
          for (int e = (tid & 7) * 2; e < (tid & 7) * 2 + 2; ++e) if (e < nv) { const int blk = sp[e]; __hip_atomic_fetch_or(mask + blk * 2 + (tl >> 5), 1u << (tl & 31), __ATOMIC_RELAXED, __HIP_MEMORY_SCOPE_WORKGROUP); } }
        __syncthreads();
        const int nf = cur >= 2 ? 3 : cur + 1, nitems = 2 * nf + (cur >= 3 ? cur - 2 : 0);
        const bf16_t* KB = (const bf16_t*)(p.ws + WS_KSB) + (size_t)bg * 128 * 4096; const bf16_t* VB = (const bf16_t*)(p.ws + WS_VSB) + (size_t)bg * 128 * 4096;
        const int hl = lane & 3, head = 4 * g + hl;
        const LAS float* hbg = (const LAS float*)(lds + ST_HB4) + hl * HBN; const float bfar = hbg[HBN - 1];
        for (;;) {
            int it = 0; if (lane == 0) it = __hip_atomic_fetch_add(ctr, 1, __ATOMIC_RELAXED, __HIP_MEMORY_SCOPE_WORKGROUP);
            it = __builtin_amdgcn_readfirstlane(it);
            if (it >= nitems) break;
            int j, c_lo, c_hi;
            if (it < 2 * nf) { const int f = it >> 1; j = f == 0 ? cur : (f == 1 ? cur - 1 : 0); c_lo = (it & 1) * 4; c_hi = c_lo + 4; }
            else { j = it - 2 * nf + 1; c_lo = 0; c_hi = 8; }
            const unsigned mlo = (unsigned)__builtin_amdgcn_readfirstlane((int)mask[2 * j]), mhi = (unsigned)__builtin_amdgcn_readfirstlane((int)mask[2 * j + 1]);
            const unsigned long long m = ((unsigned long long)mhi << 32) | mlo; const int n = __popcll(m), nch = (n + 7) >> 3;
            if (c_hi > nch) c_hi = nch;
            if (c_lo >= c_hi) continue;
            if ((m >> lane) & 1ull) list[__popcll(m & ((1ull << lane) - 1ull))] = lane;
            DFrag fr0, fr1;
            dense_load_k(fr0.ka, KB, j * 64, l31, h); dense_load_v(fr0.va, VB, j * 64, l31, h);
            dense_load_k(fr1.ka, KB, j * 64 + 32, l31, h); dense_load_v(fr1.va, VB, j * 64 + 32, l31, h);
            bf16x8 qn[4];
            { const int slot = c_lo * 8 + (l31 >> 2); const int tokl = list[slot < n ? slot : n - 1]; const bf16_t* qp = Q + (size_t)(b * S + t0 + tokl) * D + head * 64 + 8 * h;
#pragma unroll
              for (int ks = 0; ks < 4; ++ks) qn[ks] = *(const bf16x8*)(qp + 16 * ks); }
            for (int c = c_lo; c < c_hi; ++c) {
                const int slot = c * 8 + (l31 >> 2); const bool valid = slot < n; const int tokl = list[valid ? slot : n - 1], tok = t0 + tokl;
                bf16x8 qf[4];
#pragma unroll
                for (int ks = 0; ks < 4; ++ks) qf[ks] = qn[ks];
                { const int sn = (c + 1 < c_hi ? c + 1 : c) * 8 + (l31 >> 2); const int tn = list[sn < n ? sn : n - 1]; const bf16_t* qp = Q + (size_t)(b * S + t0 + tn) * D + head * 64 + 8 * h;
#pragma unroll
                  for (int ks = 0; ks < 4; ++ks) qn[ks] = *(const bf16x8*)(qp + 16 * ks); }
                __builtin_amdgcn_sched_barrier(0);
                f32x16 O[2]; float ls = 0.f;
#pragma unroll
                for (int dt = 0; dt < 2; ++dt)
#pragma unroll
                    for (int q = 0; q < 16; ++q) O[dt][q] = 0.f;
#pragma unroll
                for (int half = 0; half < 2; ++half) {
                    const int kt = j * 64 + 32 * half; const DFrag& fr = half ? fr1 : fr0;
                    const f32x16 sacc = dense_scores(fr, qf); float ev[16];
                    if (t0 - kt - 31 >= HBN - 1) {
#pragma unroll
                        for (int q = 0; q < 16; ++q) { ev[q] = __builtin_amdgcn_exp2f(sacc[q] + bfar); ls += ev[q]; }
                    } else { const int dbase = tok - kt - 4 * h;
#pragma unroll
                        for (int q = 0; q < 16; ++q) { const int dist = dbase - ((q & 3) + 8 * (q >> 2)); const int di = dist < 0 ? 0 : (dist > HBN - 1 ? HBN - 1 : dist);
                            const float e0 = __builtin_amdgcn_exp2f(sacc[q] + hbg[di]); ev[q] = dist >= 0 ? e0 : 0.f; ls += ev[q]; } }
                    dense_pv(O, fr, ev);
                }
                const float lt = sum_xor32(ls);
                if (valid) {
                    const unsigned a0 = (unsigned)(size_t)(acc + (tokl * 4 + hl) * 65 + 4 * h);
#pragma unroll
                    for (int dt = 0; dt < 2; ++dt)
#pragma unroll
                        for (int q = 0; q < 16; ++q) lds_add_f64(a0 + (dt * 32 + (q & 3) + 8 * (q >> 2)) * 8, (double)O[dt][q]);
                    if (h == 0) lds_add_f64((unsigned)(size_t)(lacc + tokl * 4 + hl), (double)lt);
                }
            }
        }
        __syncthreads();
        for (int r0 = wave * 32; r0 < wave * 32 + 32; r0 += 8) {
            float gv[8], ov[8];
#pragma unroll
            for (int i = 0; i < 8; ++i) { const int r = r0 + i, tokl = r >> 2, hd = r & 3; const size_t ur = (size_t)(b * S + t0 + tokl);
                gv[i] = GATE[ur * 48 + (4 * g + hd) * 3 + 1]; ov[i] = bf2f(OW[ur * D + (4 * g + hd) * 64 + lane]); }
#pragma unroll
            for (int i = 0; i < 8; ++i) { const int r = r0 + i, tokl = r >> 2, hd = r & 3; const size_t ur = (size_t)(b * S + t0 + tokl);
                const float o = (float)acc[r * 65 + lane] * (1.f / (float)lacc[r]) * gv[i] + ov[i];
                AO[ur * D + (4 * g + hd) * 64 + lane] = (bf16_t)(cvt_pk_bf16(o, 0.f) & 0xffffu); }
        }
        __syncthreads();
    }
}

__device__ __forceinline__ void moe_pstarts(const unsigned* ctl, int (&pst)[NE + 1]) {
    int a = 0;
#pragma unroll
    for (int e = 0; e < NE; ++e) { pst[e] = a; const int c = (int)ctl[CW_CNT + 64 * e]; a += (c + 511) / 512 * 512; }
    pst[NE] = a;
}
__device__ __forceinline__ void phase_moe_sort(const Params& p, LAS unsigned char* lds) {
    const int tid = opaque_tid(), lane = tid & 63, wave = tid >> 6;
    unsigned* ctl = (unsigned*)(p.ws + WS_CTL);
    const int* TOPE = (const int*)(p.ws + WS_TOPE); int* RPOS = (int*)(p.ws + WS_RPOS);
    const bf16_t* HB = (const bf16_t*)(p.ws + WS_HB); bf16_t* XS = (bf16_t*)(p.ws + WS_XS);
    LAS int* wcnt = (LAS int*)lds;
    LAS int* base = (LAS int*)(lds + 128);
    LAS int* posl = (LAS int*)(lds + 256);
    int pst[NE + 1]; moe_pstarts(ctl, pst);
    if (blockIdx.x == 0 && tid <= NE) ((int*)(ctl + 256))[tid] = pst[tid];
    for (int c0 = blockIdx.x * 256; c0 < 2 * T; c0 += gridDim.x * 256) {
        int e = 0, rank = 0;
        if (wave < 4) { e = TOPE[c0 + wave * 64 + lane];
#pragma unroll
            for (int q = 0; q < NE; ++q) { const unsigned long long m = __ballot(e == q); if (e == q) rank = __popcll(m & ((1ull << lane) - 1ull)); if (lane == 0) wcnt[wave * NE + q] = __popcll(m); } }
        __syncthreads();
        if (tid < NE) { const int n = wcnt[tid] + wcnt[NE + tid] + wcnt[2 * NE + tid] + wcnt[3 * NE + tid]; base[tid] = n ? (int)atomicAdd(ctl + CW_CUR + 64 * tid, (unsigned)n) : 0; }
        __syncthreads();
        if (wave < 4) { int off = 0;
            for (int w = 0; w < wave; ++w) off += wcnt[w * NE + e];
            const int pos = pst[e] + base[e] + off + rank; posl[wave * 64 + lane] = pos; RPOS[c0 + wave * 64 + lane] = pos; }
        __syncthreads();
        for (int j = wave * 32; j < wave * 32 + 32; j += 8) {
            u32x4 v0[8]; int ps[8];
#pragma unroll
            for (int q = 0; q < 8; ++q) { const int tk = (c0 + j + q) >> 1; ps[q] = posl[j + q]; v0[q] = *((const u32x4*)((const unsigned char*)HB + (size_t)tk * D) + lane); }
#pragma unroll
            for (int q = 0; q < 8; ++q) *((u32x4*)((unsigned char*)XS + (size_t)ps[q] * D) + lane) = v0[q];
        }
        __syncthreads();
    }
}
__device__ __forceinline__ void phase_combine(const Params& p) {
    const int tid = opaque_tid(), lane = tid & 63, wave = tid >> 6;
    const int gw = blockIdx.x * NWAVE + wave, NGW = gridDim.x * NWAVE;
    const float* TOPW = (const float*)(p.ws + WS_TOPW); const int* RPOS = (const int*)(p.ws + WS_RPOS);
    const bf16_t* Y = (const bf16_t*)(p.ws + WS_Y); const float* g2 = (const float*)(p.ws + WS_MODV) + (11 * 4) * D;
    for (int r = gw; r < T; r += NGW) {
        const int b = r >> 13; const int p0 = RPOS[2 * r], p1 = RPOS[2 * r + 1]; const float w0 = TOPW[2 * r], w1 = TOPW[2 * r + 1];
#pragma unroll
        for (int j = 0; j < 4; ++j) { const int c = 4 * lane + 256 * j;
            const u32x2 y0 = *(const u32x2*)(Y + (size_t)p0 * D + c), y1 = *(const u32x2*)(Y + (size_t)p1 * D + c);
            const f32x4 gv = *(const f32x4*)(g2 + b * D + c); f32x4 xv = *(const f32x4*)(p.out + (size_t)r * D + c);
            f32x4 f; f.x = w0 * bflo(y0.x) + w1 * bflo(y1.x); f.y = w0 * bfhi(y0.x) + w1 * bfhi(y1.x); f.z = w0 * bflo(y0.y) + w1 * bflo(y1.y); f.w = w0 * bfhi(y0.y) + w1 * bfhi(y1.y);
            *(f32x4*)(p.out + (size_t)r * D + c) = xv + gv * f; }
    }
}

#define XB_TMO      128
#define XB_XCNT(j)  (256  + 64 * (j))
#define XB_XSUB(j)  (1280 + 64 * (j))
#define XB_XGEN(j)  (2304 + 64 * (j))
#define XB_TOP      3328
#define XB_TOPGEN   3392
#define XCD_BAR_WORDS 3456
#define XB_SPIN_CAP (1u << 18)
__device__ __forceinline__ unsigned xb_ld(unsigned* p)              { return __hip_atomic_load(p, __ATOMIC_RELAXED, __HIP_MEMORY_SCOPE_AGENT); }
__device__ __forceinline__ unsigned xb_add(unsigned* p, unsigned v) { return __hip_atomic_fetch_add(p, v, __ATOMIC_RELAXED, __HIP_MEMORY_SCOPE_AGENT); }
__device__ __forceinline__ unsigned xb_xcc_id() { return (unsigned)__builtin_amdgcn_s_getreg((3 << 11) | 20) & 0xFu; }
#define XB_SPIN(cond, bar) do { unsigned _sp = 0; while (cond) { __builtin_amdgcn_s_sleep(1); \
    if ((++_sp & 255u) == 0u) { if (xb_ld(&(bar)[XB_TMO])) break; if (_sp > XB_SPIN_CAP) { atomicAdd(&(bar)[XB_TMO], 1u); break; } } } } while (0)
struct XcdBarrier { unsigned* bar; unsigned x; volatile LAS unsigned* st; };
__device__ __forceinline__ XcdBarrier xcd_barrier_post(unsigned* bar, volatile LAS unsigned* st) {
    XcdBarrier b; b.bar = bar; b.x = xb_xcc_id(); b.st = st;
    if (threadIdx.x == 0) (void)xb_add(&bar[XB_XCNT(b.x)], 1u);
    return b;
}
__device__ __forceinline__ void xcd_barrier_complete(unsigned* bar, unsigned x, unsigned& nloc, unsigned& nx) {
    const unsigned G_ = gridDim.x * gridDim.y * gridDim.z;
    unsigned sum, cnt, mine, sp = 0u;
    for (;;) {
        sum = 0u; cnt = 0u; mine = 0u;
#pragma unroll
        for (unsigned j = 0; j < 16; ++j) { const unsigned c = xb_ld(&bar[XB_XCNT(j)]); sum += c; cnt += (c > 0u) ? 1u : 0u; mine = (j == x) ? c : mine; }
        if (sum == G_) break;
        __builtin_amdgcn_s_sleep(1);
        if ((++sp & 255u) == 0u) { if (xb_ld(&bar[XB_TMO])) break; if (sp > XB_SPIN_CAP) { atomicAdd(&bar[XB_TMO], 1u); break; } }
    }
    nloc = mine > 0u ? mine : 1u; nx = cnt > 0u ? cnt : 1u;
}
__device__ __forceinline__ void xcd_barrier(const XcdBarrier& b) {
    asm volatile("s_waitcnt vmcnt(0)" ::: "memory");
    __syncthreads();
    if (threadIdx.x == 0) {
        unsigned* bar = b.bar;
        __builtin_amdgcn_s_waitcnt(0);
        unsigned nloc = b.st[0], nx = b.st[1];
        if (nloc == 0u) { xcd_barrier_complete(bar, b.x, nloc, nx); b.st[0] = nloc; b.st[1] = nx; }
        const unsigned old = xb_add(&bar[XB_XSUB(b.x)], 1u);
        const unsigned gen = old / nloc;
        if (old + 1u == (gen + 1u) * nloc) {
            __builtin_amdgcn_fence(__ATOMIC_RELEASE, "agent");
            asm volatile("s_waitcnt vmcnt(0)" ::: "memory");
            const unsigned og = xb_add(&bar[XB_TOP], 1u);
            const unsigned tg = og / nx;
            if (og + 1u == (tg + 1u) * nx) xb_add(&bar[XB_TOPGEN], 1u);
            else XB_SPIN(xb_ld(&bar[XB_TOPGEN]) == tg, bar);
            __builtin_amdgcn_fence(__ATOMIC_ACQUIRE, "agent");
            xb_add(&bar[XB_XGEN(b.x)], 1u);
            asm volatile("s_waitcnt vmcnt(0)" ::: "memory");
        } else {
            XB_SPIN(xb_ld(&bar[XB_XGEN(b.x)]) == gen, bar);
            __builtin_amdgcn_fence(__ATOMIC_ACQUIRE, "agent");
            asm volatile("s_waitcnt vmcnt(0)" ::: "memory");
        }
    }
    __syncthreads();
}

constexpr int LDS_SCRATCH = 131072, MISC_OFF = 155648, LDS_BYTES = 163840;
#define MODP(which) ((const float*)(p.ws + WS_MODV) + (size_t)(which) * 4 * D)

__global__ void __launch_bounds__(NTHR, 2) k_fused(Params p) {
    extern __shared__ __attribute__((aligned(16))) unsigned char lds_raw[];
    LAS unsigned char* lds = (LAS unsigned char*)lds_raw;
    for (int u = threadIdx.x; u < (LDS_BYTES - LDS_SCRATCH) / 4; u += NTHR) ((LAS unsigned*)(lds + LDS_SCRATCH))[u] = 0u;
    __syncthreads();
    const XcdBarrier bar = xcd_barrier_post((unsigned*)(p.ws + WS_CTL) + CW_BAR, (volatile LAS unsigned*)(lds + MISC_OFF) + 8);
#define GRID_BAR() xcd_barrier(bar)
    phase_weights(p, lds); __syncthreads(); phase_modvec(p, lds);
    GRID_BAR();
    phase_convert_fgu(p, lds); __syncthreads();
    phase_poolmix(p, lds, (bf16_t*)(p.ws + WS_HA));
    GRID_BAR();
    { pg8::Sched<1> Sc; Sc.init(T, D, gridDim.x, blockIdx.x, p.ws + WS_HA, p.ws + WO_POOL, D, 256);
      pg8::EpiEl<EpiPool> E{{p.x, (float*)(p.ws + WS_X1), MODP(2), p.pool_scale, 0}};
      pg8::gemm_phase(lds, 256, D, 256, 128, Sc, E); }
    GRID_BAR();
    { NormOut o0{p.norm_g + D, MODP(4), MODP(3), (bf16_t*)(p.ws + WS_HB)}; phase_norm<1, false, 2>(p, lds, (const float*)(p.ws + WS_X1), o0, o0); }
    GRID_BAR();
    { pg8::Sched<0> Sc; Sc.init(T, 2 * FF, gridDim.x, blockIdx.x, p.ws + WS_HB, p.ws + WO_FGU, D / 2, D / 2);
      pg8::EpiPairEl<EpiSwigluI8> E{{(bf16_t*)(p.ws + WS_HID0), FF, (const float*)(p.ws + WS_ASC), (const float*)(p.ws + WS_FGMAX)}};
      pg8::gemm_phase<pg8::EpiPairEl<EpiSwigluI8>, pg8::Sched<0>, true, true, 2>(lds, D / 2, D / 2, D / 2, 128, Sc, E); }
    GRID_BAR();
    { pg8::Sched<0> Sc; Sc.init(T, D, gridDim.x, blockIdx.x, p.ws + WS_HID0, p.ws + WO_FDN, FF, FF);
      pg8::EpiEl<EpiResid> E{{(const float*)(p.ws + WS_X1), (float*)(p.ws + WS_X2), MODP(5)}};
      pg8::gemm_phase(lds, FF, FF, FF, 128, Sc, E); }
    GRID_BAR();
    { NormOut o0{p.kv_norm_g, MODP(13), MODP(12), (bf16_t*)(p.ws + WS_HA)}; NormOut o1{p.norm_g + 2 * D, MODP(7), MODP(6), (bf16_t*)(p.ws + WS_HB)}; phase_norm<2, false>(p, lds, (const float*)(p.ws + WS_X2), o0, o1); }
    GRID_BAR();
    { pg8::Sched<0> Sc; Sc.init(T, NKV, gridDim.x, blockIdx.x, p.ws + WS_HA, p.ws + WO_KV, D, D);
      pg8::EpiEl<EpiBf16> E{{(bf16_t*)(p.ws + WS_KVB), NKV}};
      pg8::gemm_phase(lds, D, D, D, 128, Sc, E); }
    { pg8::Sched<0> Sc; Sc.init(T, D, gridDim.x, blockIdx.x, p.ws + WS_HB, p.ws + WO_Q, D, D);
      pg8::EpiEl<EpiQ> E{{(bf16_t*)(p.ws + WS_Q), (float*)(p.ws + WS_GATE), 0}};
      pg8::gemm_phase(lds, D, D, D, 128, Sc, E); }
    GRID_BAR();
    { pg8::Sched<2> Sc; Sc.init(2048, 4096, gridDim.x, blockIdx.x, p.ws + WS_KVB, p.ws + WO_CK, 16 * NKV, 2048);
      pg8::EpiEl<EpiCmp> E{{(float*)(p.ws + WS_CMPP)}};
      pg8::gemm_phase(lds, 1024, 16 * NKV, 2048, (size_t)NKV * 2, Sc, E); }
    { pg8::Sched<0> Sc; Sc.init(T, 256, (int)gridDim.x - 128 > 0 ? (int)gridDim.x - 128 : 1, (int)gridDim.x > 128 ? (int)blockIdx.x - 128 : (int)blockIdx.x, p.ws + WS_HB, p.ws + WO_Q + (size_t)D * D * 2, D, D);
      pg8::EpiEl<EpiQ> E{{(bf16_t*)(p.ws + WS_Q), (float*)(p.ws + WS_GATE), D}};
      pg8::gemm_phase(lds, D, D, D, 128, Sc, E); }
    phase_headnorm(p, lds); phase_vtrans(p, lds);
    GRID_BAR();
    phase_cmp2(p, lds);
    GRID_BAR();
    attn_tables(p, lds);
    phase_dense(p, lds, (bf16_t*)(p.ws + WS_HB));
    GRID_BAR();
    phase_sel_tile(p, lds, (bf16_t*)(p.ws + WS_HA), (const bf16_t*)(p.ws + WS_HB));
    GRID_BAR();
    { pg8::Sched<0> Sc; Sc.init(T, D, gridDim.x, blockIdx.x, p.ws + WS_HA, p.ws + WO_O, D, D);
      pg8::EpiEl<EpiResid> E{{(const float*)(p.ws + WS_X2), p.out, MODP(8)}};
      pg8::gemm_phase(lds, D, D, D, 128, Sc, E); }
    GRID_BAR();
    { NormOut o0{p.norm_g + 3 * D, MODP(10), MODP(9), (bf16_t*)(p.ws + WS_HB)}; phase_norm<1, true, 1>(p, lds, p.out, o0, o0); }
    GRID_BAR();
    phase_moe_sort(p, lds);
    GRID_BAR();
    { const int* pst = (const int*)(p.ws + WS_CTL) + 256;
      pg8::Sched<3> Sc; Sc.init(pst[NE], 2 * FE, gridDim.x, blockIdx.x, p.ws + WS_XS, p.ws + WO_EGU, D / 2, D / 2, pst, (size_t)FE * D);
      pg8::EpiPairEl<EpiSwiglu8> E{{p.ws + WS_HIDM, FE}};
      pg8::gemm_phase<pg8::EpiPairEl<EpiSwiglu8>, pg8::Sched<3>, true, true, 1>(lds, D / 2, D / 2, D / 2, 128, Sc, E, 127 - 5); }
    GRID_BAR();
    { const int* pst = (const int*)(p.ws + WS_CTL) + 256;
      pg8::Sched<3> Sc; Sc.init(pst[NE], D, gridDim.x, blockIdx.x, p.ws + WS_HIDM, p.ws + WO_EDN, FE / 2, FE / 2, pst, (size_t)D * FE / 2);
      pg8::EpiEl<EpiBf16> E{{(bf16_t*)(p.ws + WS_Y), D}};
      pg8::gemm_phase<pg8::EpiEl<EpiBf16>, pg8::Sched<3>, true, true, 1>(lds, FE / 2, FE / 2, FE / 2, 128, Sc, E, 127 - 6); }
    GRID_BAR();
    phase_combine(p);
}

extern "C" void kernel_launch(void* const* d_in, const int* in_sizes, int n_in, void* d_out, int out_size, void* d_ws, size_t ws_size, hipStream_t stream) {
    if (n_in != 28 || out_size != T * D || ws_size < WS_END) { fprintf(stderr, "kernel_launch: unexpected shapes (n_in %d out %d ws %zu need %zu)\n", n_in, out_size, ws_size, (size_t)WS_END); return; }
    static int grid = 0;
    if (grid == 0) {
        int dev = 0, cus = 0, per_cu = 0;
        if (hipGetDevice(&dev) != hipSuccess || hipDeviceGetAttribute(&cus, hipDeviceAttributeMultiprocessorCount, dev) != hipSuccess) { grid = -1; return; }
        if (hipFuncSetAttribute((const void*)k_fused, hipFuncAttributeMaxDynamicSharedMemorySize, LDS_BYTES) != hipSuccess) { grid = -1; return; }
        if (hipOccupancyMaxActiveBlocksPerMultiprocessor(&per_cu, (const void*)k_fused, NTHR, LDS_BYTES) != hipSuccess || per_cu < 1) { fprintf(stderr, "kernel_launch: occupancy query says %d\n", per_cu); }
        (void)hipGetLastError();
        grid = cus;
    }
    if (grid < 0) return;
    Params p{};
    const float** pp = (const float**)&p;
    for (int i = 0; i < 28; ++i) pp[i] = (const float*)d_in[i];
    p.out = (float*)d_out; p.ws = (unsigned char*)d_ws;
    (void)hipMemsetAsync((char*)d_ws + WS_CTL, 0, CTL_BYTES, stream);
    k_fused<<<dim3(grid), dim3(NTHR), LDS_BYTES, stream>>>(p);
}
```

```cpp
#include <hip/hip_runtime.h>
#include <cstdint>
#include <cstdio>

#define LAS __attribute__((address_space(3)))
typedef unsigned short bf16_t;
typedef short bf16x8 __attribute__((ext_vector_type(8)));
typedef float f32x4 __attribute__((ext_vector_type(4)));
typedef float f32x2 __attribute__((ext_vector_type(2)));
typedef unsigned u32x4 __attribute__((ext_vector_type(4)));
typedef unsigned u32x2 __attribute__((ext_vector_type(2)));

constexpr int NB = 4, S = 8192, D = 1024, T = NB * S;
constexpr int FF = 2816, NE = 8, FE = 3584;
constexpr int NKV = 1536, NQP = 1280, NQ = 1072;
constexpr int G = 4, HD = 64, NH = 16;
constexpr int NC = 512;
constexpr int NSB = 128;
constexpr int NSEL = 16;
constexpr int WIN = 512;
constexpr int MOE_ROWS = 69632;
constexpr float EPS = 1e-6f;
constexpr int NTHR = 512, NWAVE = 8;

constexpr size_t MiB = 1u << 20;
constexpr size_t WS_CTL = 0, CTL_BYTES = 1 * MiB;
constexpr size_t WS_MODV = 1 * MiB;
constexpr size_t WS_CMPB = WS_MODV + 14 * 4 * 1024 * 4;
constexpr size_t WS_FGMAX = WS_CMPB + 4096;
constexpr size_t WS_ASC = WS_FGMAX + 2 * FF * 4;
constexpr size_t WS_KVMAX = 6 * MiB + 131072;
constexpr size_t WS_QMAX = 6 * MiB + 196608;
constexpr size_t WS_ASC1 = 6 * MiB + 262144;
constexpr size_t WS_HBG = 6 * MiB;
constexpr size_t WS_MHG = WS_HBG + 65536;
constexpr size_t WS_TOPE = 2 * MiB;
constexpr size_t WS_TOPW = WS_TOPE + (size_t)T * 8;
constexpr size_t WS_RPOS = WS_TOPW + (size_t)T * 8;
constexpr size_t WS_RTOK = WS_RPOS + (size_t)T * 8;
constexpr size_t WS_SMALL_END = WS_RTOK + (size_t)MOE_ROWS * 4;
static_assert(WS_SMALL_END <= 8 * MiB && WS_ASC + (size_t)T * 4 <= 2 * MiB, "small region");
constexpr size_t WS_W = 8 * MiB;
constexpr size_t WO_POOL = WS_W;
constexpr size_t WO_FGU = WO_POOL + (size_t)4 * 256 * 256 * 2;
constexpr size_t WO_FDN = WO_FGU + (size_t)2 * FF * D * 2;
constexpr size_t WO_KV = WO_FDN + (size_t)D * FF * 2;
constexpr size_t WO_Q = WO_KV + (size_t)NKV * D * 2;
constexpr size_t WO_O = WO_Q + (size_t)NQP * D * 2;
constexpr size_t WO_CK = WO_O + (size_t)D * D * 2;
constexpr size_t WO_CV = WO_CK + (size_t)256 * 2048 * 2;
constexpr size_t WO_EGU = WO_CV + (size_t)256 * 2048 * 2;
constexpr size_t WO_EDN = WO_EGU + (size_t)NE * 2 * FE * D * 2;
constexpr size_t WO_END = WO_EDN + (size_t)NE * D * FE * 2;
static_assert(WO_END <= 203 * MiB, "weights region");
constexpr size_t WS_HB = 203 * MiB;
constexpr size_t WS_X1 = 267 * MiB;
constexpr size_t WS_X2 = 395 * MiB;
constexpr size_t WS_HID0 = 523 * MiB;
constexpr size_t WS_Q = 523 * MiB;
constexpr size_t WS_GATE = 587 * MiB;
constexpr size_t WS_CMPH = 593 * MiB;
constexpr size_t WS_KCG = 267 * MiB;
constexpr size_t WS_KC = 601 * MiB;
constexpr size_t WS_VC = 602 * MiB;
constexpr size_t WS_KSB = 603 * MiB;
constexpr size_t WS_VSB = 619 * MiB;
constexpr size_t WS_KWB = 635 * MiB;
constexpr size_t WS_VWB = 651 * MiB;
constexpr size_t WS_Q8 = 267 * MiB;
constexpr size_t WS_SEL = 667 * MiB;
constexpr size_t WS_HA = 699 * MiB;
constexpr size_t WS_KVB = 763 * MiB;
constexpr size_t WS_HIDM = 267 * MiB;
constexpr size_t WS_Y = 743 * MiB;
constexpr size_t WS_XS = WS_Y;
constexpr size_t WS_END = 880 * MiB;
static_assert(WS_HIDM + (size_t)MOE_ROWS * FE * 2 <= WS_Y && WS_Y + (size_t)MOE_ROWS * D * 2 <= WS_END, "moe map");
static_assert(WS_KVB + (size_t)T * NKV * 2 + 65536 <= WS_END, "kv map");
constexpr int CW_CNT = 512;
constexpr int CW_CUR = 1024;
constexpr int CW_HN = 2048, CW_VT = 2112;
constexpr int CW_BAR = 4096;

struct Params {
    const float *x, *c, *ada_w, *ada_b, *norm_g, *pool_w, *pool_scale, *q_w, *q_gain, *o_w, *kv_ada_w, *kv_ada_b, *kv_norm_g, *kv_w,
        *cmp_pe_k, *cmp_pe_v, *cmp_k_w1, *cmp_k_w2, *cmp_v_w1, *cmp_v_w2, *k_gain, *rel_bias, *ffn_gu, *ffn_dn, *router_w, *router_b, *exp_gu, *exp_dn;
    float* out; unsigned char* ws;
};

__device__ __forceinline__ unsigned cvt_pk_bf16(float lo, float hi) { unsigned r; asm volatile("v_cvt_pk_bf16_f32 %0, %1, %2" : "=v"(r) : "v"(lo), "v"(hi)); return r; }
__device__ __forceinline__ float bf2f(unsigned short v) { return __uint_as_float((unsigned)v << 16); }
__device__ __forceinline__ float bflo(unsigned w) { return __uint_as_float(w << 16); }
__device__ __forceinline__ float bfhi(unsigned w) { return __uint_as_float(w & 0xffff0000u); }
__device__ __forceinline__ int opaque_tid() { int t = threadIdx.x; asm volatile("" : "+v"(t)); return t; }
__device__ __forceinline__ float readlane_f(float v, int l) { return __uint_as_float((unsigned)__builtin_amdgcn_readlane((int)__float_as_uint(v), l)); }
__device__ __forceinline__ unsigned pack_i8x4(float a, float b, float c, float d) {
    const int ia = (int)__builtin_rintf(fminf(fmaxf(a, -127.f), 127.f)), ib = (int)__builtin_rintf(fminf(fmaxf(b, -127.f), 127.f)), ic = (int)__builtin_rintf(fminf(fmaxf(c, -127.f), 127.f)), id = (int)__builtin_rintf(fminf(fmaxf(d, -127.f), 127.f));
    return (unsigned)(ia & 0xff) | ((unsigned)(ib & 0xff) << 8) | ((unsigned)(ic & 0xff) << 16) | ((unsigned)(id & 0xff) << 24);
}
__device__ __forceinline__ float sel_q_scale(const float* q_gain) { float m = 0.f; for (int i = 0; i < 64; ++i) m = fmaxf(m, fabsf(q_gain[i])); return 127.f / (4.f * m * 0.125f * 1.4426950408889634f); }
__device__ __forceinline__ float sel_k_scale(const float* k_gain) { float m = 0.f; for (int i = 0; i < 64; ++i) m = fmaxf(m, fabsf(k_gain[64 + i])); return 127.f / (4.f * m); }
template <int CTRL> __device__ __forceinline__ float dpp_f(float v) { return __uint_as_float((unsigned)__builtin_amdgcn_update_dpp(0, (int)__float_as_uint(v), CTRL, 0xf, 0xf, true)); }
__device__ __forceinline__ float lane_xor1(float v) { return dpp_f<0xB1>(v); }
__device__ __forceinline__ float lane_xor2(float v) { return dpp_f<0x4E>(v); }
__device__ __forceinline__ float red_step4(float v) { return dpp_f<0x141>(v); }
__device__ __forceinline__ float red_step8(float v) { return dpp_f<0x140>(v); }
__device__ __forceinline__ float sum_xor16(float v) { const auto r = __builtin_amdgcn_permlane16_swap(__float_as_uint(v), __float_as_uint(v), false, false); return __uint_as_float(r[0]) + __uint_as_float(r[1]); }
__device__ __forceinline__ float sum_xor32(float v) { const auto r = __builtin_amdgcn_permlane32_swap(__float_as_uint(v), __float_as_uint(v), false, false); return __uint_as_float(r[0]) + __uint_as_float(r[1]); }
__device__ __forceinline__ float lane_xor32(float v, int hi) { const auto r = __builtin_amdgcn_permlane32_swap(__float_as_uint(v), __float_as_uint(v), false, false); return __uint_as_float(hi ? r[0] : r[1]); }
__device__ __forceinline__ float bfly32(float keep_lo, float keep_hi) { const auto r = __builtin_amdgcn_permlane32_swap(__float_as_uint(keep_lo), __float_as_uint(keep_hi), false, false); return __uint_as_float(r[0]) + __uint_as_float(r[1]); }
__device__ __forceinline__ float bfly16(float keep_lo, float keep_hi) { const auto r = __builtin_amdgcn_permlane16_swap(__float_as_uint(keep_lo), __float_as_uint(keep_hi), false, false); return __uint_as_float(r[0]) + __uint_as_float(r[1]); }
__device__ __forceinline__ float lane_xor8(float v) { return dpp_f<0x128>(v); }
__device__ __forceinline__ float wave_sum(float v) {
    v += lane_xor1(v); v += lane_xor2(v); v += red_step4(v); v += red_step8(v);
    return (readlane_f(v, 0) + readlane_f(v, 16)) + (readlane_f(v, 32) + readlane_f(v, 48));
}
__device__ __forceinline__ float wave_max(float v) {
    v = fmaxf(v, lane_xor1(v)); v = fmaxf(v, lane_xor2(v)); v = fmaxf(v, red_step4(v)); v = fmaxf(v, red_step8(v));
    return fmaxf(fmaxf(readlane_f(v, 0), readlane_f(v, 16)), fmaxf(readlane_f(v, 32), readlane_f(v, 48)));
}
__device__ __forceinline__ float silu_f(float v) { return v * __builtin_amdgcn_rcpf(1.f + __builtin_amdgcn_exp2f(v * -1.4426950408889634f)); }
__device__ __forceinline__ f32x2 swiglu2(f32x2 g, f32x2 u) {
    const f32x2 t = g * -1.4426950408889634f; f32x2 e; e.x = __builtin_amdgcn_exp2f(t.x); e.y = __builtin_amdgcn_exp2f(t.y);
    e = e + 1.f; f32x2 r; r.x = __builtin_amdgcn_rcpf(e.x); r.y = __builtin_amdgcn_rcpf(e.y);
    return (g * u) * r; }
__device__ __forceinline__ float sigmoid_f(float v) { return __builtin_amdgcn_rcpf(1.f + __builtin_amdgcn_exp2f(v * -1.4426950408889634f)); }
__device__ __forceinline__ float gelu_tanh_f(float v) {
    const float u = 0.7978845608028654f * (v + 0.044715f * v * v * v);
    const float e = __builtin_amdgcn_exp2f(fabsf(u) * -2.8853900817779268f); const float th = (1.f - e) * __builtin_amdgcn_rcpf(1.f + e);
    return 0.5f * v * (1.f + (u < 0.f ? -th : th));
}
__device__ __forceinline__ int rel_bucket(int d) {
    if (d < 16) return d;
    int b = 16;
    b += (d >= 21); b += (d >= 27); b += (d >= 35); b += (d >= 46); b += (d >= 59); b += (d >= 77); b += (d >= 99); b += (d >= 128);
    b += (d >= 166); b += (d >= 216); b += (d >= 280); b += (d >= 363); b += (d >= 470); b += (d >= 609); b += (d >= 790);
    return b;
}

constexpr int TR_WAVE_LDS = 128 * 33 * 4;
template <int QF = 0>
__device__ __forceinline__ void transpose_item(const float* W, int K, int N, void* WT, int k0, int n0, int drow0, LAS float* scr, int lane, float wscale = 1.f, const float* colmax = nullptr) {
    float wv[64];
    const int nl = lane & 31; const bool nok = n0 + nl < N; const float* wp = W + (size_t)(k0 + (lane >> 5)) * N + n0 + nl;
#pragma unroll
    for (int i = 0; i < 64; ++i) wv[i] = nok ? wp[(size_t)(2 * i) * N] : 0.f;
#pragma unroll
    for (int i = 0; i < 64; ++i) scr[(2 * i + (lane >> 5)) * 33 + nl] = wv[i];
    asm volatile("s_waitcnt lgkmcnt(0)" ::: "memory");
    const int c = lane >> 2;
#pragma unroll
    for (int j = 0; j < 8; ++j) { const int n = (lane & 3) + 4 * j; const LAS float* sp = scr + (8 * c) * 33 + n;
        if constexpr (QF == 1) {
            unsigned w0 = 0u, w1 = 0u;
            w0 = __builtin_amdgcn_cvt_pk_fp8_f32(sp[0 * 33] * wscale, sp[1 * 33] * wscale, w0, false); w0 = __builtin_amdgcn_cvt_pk_fp8_f32(sp[2 * 33] * wscale, sp[3 * 33] * wscale, w0, true);
            w1 = __builtin_amdgcn_cvt_pk_fp8_f32(sp[4 * 33] * wscale, sp[5 * 33] * wscale, w1, false); w1 = __builtin_amdgcn_cvt_pk_fp8_f32(sp[6 * 33] * wscale, sp[7 * 33] * wscale, w1, true);
            *(u32x2*)((unsigned char*)WT + (size_t)(drow0 + n) * K + k0 + 8 * c) = (u32x2){w0, w1};
        } else if constexpr (QF == 2) { const float sc = 127.f / colmax[n0 + n];
            const unsigned w0 = pack_i8x4(sp[0 * 33] * sc, sp[1 * 33] * sc, sp[2 * 33] * sc, sp[3 * 33] * sc), w1 = pack_i8x4(sp[4 * 33] * sc, sp[5 * 33] * sc, sp[6 * 33] * sc, sp[7 * 33] * sc);
            *(u32x2*)((unsigned char*)WT + (size_t)(drow0 + n) * K + k0 + 8 * c) = (u32x2){w0, w1};
        } else {
        u32x4 o; o.x = cvt_pk_bf16(sp[0 * 33], sp[1 * 33]); o.y = cvt_pk_bf16(sp[2 * 33], sp[3 * 33]); o.z = cvt_pk_bf16(sp[4 * 33], sp[5 * 33]); o.w = cvt_pk_bf16(sp[6 * 33], sp[7 * 33]);
        *(u32x4*)((bf16_t*)WT + (size_t)(drow0 + n) * K + k0 + 8 * c) = o; } }
    asm volatile("s_waitcnt lgkmcnt(0)" ::: "memory");
}
template <int MODE, int QF = 0>
__device__ __forceinline__ void transpose_mat(const float* W, int K, int N, int NP, int F, void* WT, int it, LAS float* scr, int lane, float wscale = 1.f, const float* colmax = nullptr) {
    const int nblk = NP / 32, kb = it / nblk, nb = it % nblk, n0 = nb * 32;
    int drow0 = n0;
    if (MODE == 1) { const int up = n0 >= F, j = up ? n0 - F : n0; drow0 = (j >> 7) * 256 + (up ? 128 : 0) + (j & 127); }
    transpose_item<QF>(W, K, N, WT, kb * 128, n0, drow0, scr, lane, wscale, colmax);
}
__device__ __forceinline__ void phase_convert_fgu(const Params& p, LAS unsigned char* lds) {
    const int tid = opaque_tid(), lane = tid & 63, wave = tid >> 6;
    LAS float* scr = (LAS float*)(lds + wave * TR_WAVE_LDS);
    const int gw = blockIdx.x * NWAVE + wave, NGW = gridDim.x * NWAVE;
    for (int it = gw; it < 8 * 176 + 8 * 48 + 8 * 40; it += NGW) {
        if (it < 8 * 176) transpose_mat<1, 2>(p.ffn_gu, D, 2 * FF, 2 * FF, FF, p.ws + WO_FGU, it, scr, lane, 1.f, (const float*)(p.ws + WS_FGMAX));
        else if (it < 8 * 176 + 8 * 48) transpose_mat<0, 2>(p.kv_w, D, NKV, NKV, 0, p.ws + WO_KV, it - 8 * 176, scr, lane, 1.f, (const float*)(p.ws + WS_KVMAX));
        else transpose_mat<0, 2>(p.q_w, D, NQ, NQP, 0, p.ws + WO_Q, it - 8 * 176 - 8 * 48, scr, lane, 1.f, (const float*)(p.ws + WS_QMAX)); }
}
__device__ __forceinline__ void phase_weights(const Params& p, LAS unsigned char* lds) {
    const int tid = opaque_tid(), lane = tid & 63, wave = tid >> 6;
    LAS float* scr = (LAS float*)(lds + wave * TR_WAVE_LDS);
    const int gw = blockIdx.x * NWAVE + wave, NGW = gridDim.x * NWAVE;
    unsigned char* ws = p.ws;
    constexpr int I_POOL = 2 * 8, I_FDN = 22 * 32, I_KV = 8 * 48, I_Q = 8 * 40, I_O = 8 * 32, I_C = 16 * 8, I_EGU = 8 * 224, I_EDN = 28 * 32;
    constexpr int TOT = 4 * I_POOL + I_FDN + I_O + 2 * I_C + NE * I_EGU + NE * I_EDN;
    for (int it = gw; it < TOT; it += NGW) {
        int r = it;
        if (r < NE * I_EGU) { const int e = r / I_EGU; transpose_mat<1, 1>(p.exp_gu + (size_t)e * D * 2 * FE, D, 2 * FE, 2 * FE, FE, ws + WO_EGU + (size_t)e * 2 * FE * D, r % I_EGU, scr, lane, 32.f); continue; } r -= NE * I_EGU;
        if (r < NE * I_EDN) { const int e = r / I_EDN; transpose_mat<0, 1>(p.exp_dn + (size_t)e * FE * D, FE, D, D, 0, ws + WO_EDN + (size_t)e * D * FE, r % I_EDN, scr, lane, 64.f); continue; } r -= NE * I_EDN;
        if (r < 4 * I_POOL) { const int g = r / I_POOL; transpose_mat<0>(p.pool_w + (size_t)g * 65536, 256, 256, 256, 0, (bf16_t*)(ws + WO_POOL) + (size_t)g * 65536, r % I_POOL, scr, lane); continue; } r -= 4 * I_POOL;
        if (r < I_FDN) { transpose_mat<0, 1>(p.ffn_dn, FF, D, D, 0, ws + WO_FDN, r, scr, lane, 64.f); continue; } r -= I_FDN;
        if (r < I_O) { transpose_mat<0>(p.o_w, D, D, D, 0, ws + WO_O, r, scr, lane); continue; } r -= I_O;
        if (r < I_C) { transpose_mat<0>(p.cmp_k_w1, 2048, 256, 256, 0, ws + WO_CK, r, scr, lane); continue; } r -= I_C;
        transpose_mat<0>(p.cmp_v_w1, 2048, 256, 256, 0, ws + WO_CV, r, scr, lane);
    }
}

__device__ __forceinline__ void phase_modvec(const Params& p, LAS unsigned char* lds) {
    const int tid = opaque_tid(), lane = tid & 63, wave = tid >> 6;
    LAS float* part = (LAS float*)lds;
    LAS float* sc_l = (LAS float*)(lds + 8192);
    for (int i = tid; i < 4 * D; i += NTHR) sc_l[i] = silu_f(p.c[i]);
    __syncthreads();
    float* MODV = (float*)(p.ws + WS_MODV);
    float* CMPB = (float*)(p.ws + WS_CMPB);
    { float* FGMAX = (float*)(p.ws + WS_FGMAX);
      for (int u = blockIdx.x; u < 2 * FF / 64 + NKV / 64 + NQP / 64; u += gridDim.x) {
        const int which = u >= 2 * FF / 64 + NKV / 64 ? 2 : (u >= 2 * FF / 64 ? 1 : 0); const bool kvu = which != 0;
        const int uu = which == 2 ? u - 2 * FF / 64 - NKV / 64 : (which == 1 ? u - 2 * FF / 64 : u), ldw = which == 2 ? NQ : (which == 1 ? NKV : 2 * FF); const float* W = which == 2 ? p.q_w : (which == 1 ? p.kv_w : p.ffn_gu);
        const int col = uu * 64 + lane, colr = col < ldw ? col : ldw - 1; float m = 0.f;
#pragma unroll 16
        for (int k = wave * 128; k < wave * 128 + 128; ++k) m = fmaxf(m, fabsf(W[(size_t)k * ldw + colr]));
        if (col >= ldw) m = 0.f;
        part[wave * 64 + lane] = m;
        __syncthreads();
        if (tid < 64) { float mm = part[lane];
#pragma unroll
            for (int w = 1; w < 8; ++w) mm = fmaxf(mm, part[w * 64 + lane]);
            (which == 2 ? (float*)(p.ws + WS_QMAX) : (kvu ? (float*)(p.ws + WS_KVMAX) : FGMAX))[uu * 64 + lane] = fmaxf(mm, 1e-30f); }
        __syncthreads();
      } }
    constexpr int NU_MOD = 14336 / 64, NU = NU_MOD + 8;
    for (int u = blockIdx.x; u < NU; u += gridDim.x) {
        float acc[4] = {0.f, 0.f, 0.f, 0.f};
        if (u < NU_MOD) {
            const int gc = u * 64 + lane;
            const float* W; int ldw, col;
            if (gc < 6144) { W = p.ada_w; ldw = 6144; col = gc; } else if (gc < 12288) { W = p.ada_w + (size_t)D * 6144; ldw = 6144; col = gc - 6144; } else { W = p.kv_ada_w; ldw = 2048; col = gc - 12288; }
#pragma unroll 16
            for (int k = wave * 128; k < wave * 128 + 128; ++k) {
                const float w = W[(size_t)k * ldw + col];
#pragma unroll
                for (int b = 0; b < 4; ++b) acc[b] += sc_l[b * D + k] * w;
            }
        } else {
            const int cu = u - NU_MOD, kv = cu >> 2, col = (cu & 3) * 64 + lane;
            const float* W = kv ? p.cmp_v_w1 : p.cmp_k_w1; const float* pe = kv ? p.cmp_pe_v : p.cmp_pe_k;
#pragma unroll 16
            for (int k = wave * 256; k < wave * 256 + 256; ++k) acc[0] += pe[k] * W[(size_t)k * 256 + col];
        }
#pragma unroll
        for (int b = 0; b < 4; ++b) part[(wave * 4 + b) * 64 + lane] = acc[b];
        __syncthreads();
        if (tid < 256) {
            const int b = tid >> 6; float s = 0.f;
#pragma unroll
            for (int w = 0; w < 8; ++w) s += part[(w * 4 + b) * 64 + lane];
            if (u < NU_MOD) {
                const int gc = u * 64 + lane; int which, n; float bias;
                if (gc < 6144) { which = gc >> 10; n = gc & 1023; bias = p.ada_b[gc]; } else if (gc < 12288) { which = 6 + ((gc - 6144) >> 10); n = gc & 1023; bias = p.ada_b[gc]; }
                else { which = 12 + ((gc - 12288) >> 10); n = gc & 1023; bias = p.kv_ada_b[gc - 12288]; }
                MODV[(which * 4 + b) * D + n] = s + bias;
            } else if (b == 0) { const int cu = u - NU_MOD; CMPB[(cu >> 2) * 256 + (cu & 3) * 64 + lane] = s; }
        }
        __syncthreads();
    }
}

template <int W>
__device__ __forceinline__ void pool_rows(const float* xb, int t0, const LAS float* rs, f32x2 gm, f32x2 sh, bf16_t* outb, int c0) {
    f32x2 ring[16];
#pragma unroll
    for (int i = 0; i < 15; ++i) {
        const int t = t0 - 15 + i; f32x2 h = {0.f, 0.f};
        if (t >= 0) { const f32x2 xv = *(const f32x2*)(xb + (size_t)t * D + c0); const float r = rs[i]; h = xv * r * gm + sh; }
        ring[i] = h;
    }
    for (int gi = 0; gi < 8; ++gi) {
        f32x2 xq[16];
#pragma unroll
        for (int j = 0; j < 16; ++j) xq[j] = *(const f32x2*)(xb + (size_t)(t0 + gi * 16 + j) * D + c0);
#pragma unroll
        for (int j = 0; j < 16; ++j) {
            const int i = 15 + gi * 16 + j, t = t0 + gi * 16 + j;
            const f32x2 xv = xq[j]; const float r = rs[i];
            const f32x2 h = xv * r * gm + sh;
            ring[(15 + j) & 15] = h;
            f32x2 s = {0.f, 0.f};
#pragma unroll
            for (int k = 0; k < W; ++k) s += ring[(15 + j - k) & 15];
            const int cnt = (t + 1 < W) ? t + 1 : W;
            const f32x2 o = s * (1.f / (float)cnt) - h;
            *(unsigned*)(outb + (size_t)t * D + c0) = cvt_pk_bf16(o.x, o.y);
        }
    }
}
__device__ __forceinline__ void phase_poolmix(const Params& p, LAS unsigned char* lds, bf16_t* mixA) {
    const int tid = opaque_tid(), lane = tid & 63, wave = tid >> 6;
    LAS float* rs = (LAS float*)lds;
    const float* MODV = (const float*)(p.ws + WS_MODV);
    for (int u = blockIdx.x; u < T / 128; u += gridDim.x) {
        const int b = u >> 6, t0 = (u & 63) * 128;
        const float* xb = p.x + (size_t)b * S * D;
        for (int i = wave; i < 143; i += NWAVE) {
            const int t = t0 - 15 + i; float r = 0.f;
            if (t >= 0) { const f32x4* xr = (const f32x4*)(xb + (size_t)t * D) + lane; float s = 0.f;
#pragma unroll
                for (int j = 0; j < 4; ++j) { const f32x4 v = xr[64 * j]; s += (v.x * v.x + v.y * v.y) + (v.z * v.z + v.w * v.w); }
                r = 1.f / sqrtf(wave_sum(s) * (1.f / D) + EPS); }
            if (lane == 0) rs[i] = r;
        }
        __syncthreads();
        const int c0 = 2 * tid;
        const f32x2 g = *(const f32x2*)(p.norm_g + c0), sc = *(const f32x2*)(MODV + (1 * 4 + b) * D + c0), sh = *(const f32x2*)(MODV + (0 * 4 + b) * D + c0);
        const f32x2 gm = g * (sc + 1.f);
        bf16_t* ob = mixA + (size_t)b * S * D;
        const int grp = tid >> 7;
        if (grp == 0) pool_rows<2>(xb, t0, rs, gm, sh, ob, c0);
        else if (grp == 1) pool_rows<4>(xb, t0, rs, gm, sh, ob, c0);
        else if (grp == 2) pool_rows<8>(xb, t0, rs, gm, sh, ob, c0);
        else pool_rows<16>(xb, t0, rs, gm, sh, ob, c0);
        __syncthreads();
    }
}

struct NormOut { const float* g; const float* sc; const float* sh; bf16_t* out; };
template <int NOUT, bool ROUTER, int OUTQ = 0>
__device__ __forceinline__ void phase_norm(const Params& p, LAS unsigned char* lds, const float* xin, const NormOut o0, const NormOut o1) {
    const int tid = opaque_tid(), lane = tid & 63, wave = tid >> 6;
    const int gw = blockIdx.x * NWAVE + wave, NGW = gridDim.x * NWAVE;
    f32x4 rwa[16], rwb[16];
    if (ROUTER) {
#pragma unroll
        for (int j = 0; j < 4; ++j)
#pragma unroll
            for (int q = 0; q < 4; ++q) { const f32x4* wp = (const f32x4*)(p.router_w + (size_t)(4 * lane + 256 * j + q) * NE); rwa[4 * j + q] = wp[0]; rwb[4 * j + q] = wp[1]; }
    }
    unsigned* ctl = (unsigned*)(p.ws + WS_CTL);
    int* TOPE = (int*)(p.ws + WS_TOPE); float* TOPW = (float*)(p.ws + WS_TOPW);
    unsigned cnt_local[NE];
#pragma unroll
    for (int e = 0; e < NE; ++e) cnt_local[e] = 0;
    const int rows_per = T / NGW > 0 ? (T + NGW - 1) / NGW : 1;
    const int r0 = gw * rows_per, r1 = (r0 + rows_per < T) ? r0 + rows_per : T;
    int curb = -1; f32x4 gm0[4], sh0[4], gm1[4], sh1[4];
    for (int r = r0; r < r1; ++r) {
        const int b = r >> 13;
        if (b != curb) { curb = b;
#pragma unroll
            for (int j = 0; j < 4; ++j) { const int c = 4 * lane + 256 * j;
                gm0[j] = *(const f32x4*)(o0.g + c) * (*(const f32x4*)(o0.sc + b * D + c) + 1.f); sh0[j] = *(const f32x4*)(o0.sh + b * D + c);
                if (NOUT > 1) { gm1[j] = *(const f32x4*)(o1.g + c) * (*(const f32x4*)(o1.sc + b * D + c) + 1.f); sh1[j] = *(const f32x4*)(o1.sh + b * D + c); } } }
        const f32x4* xr = (const f32x4*)(xin + (size_t)r * D) + lane;
        f32x4 v[4]; float s = 0.f;
#pragma unroll
        for (int j = 0; j < 4; ++j) { v[j] = xr[64 * j]; s += (v[j].x * v[j].x + v[j].y * v[j].y) + (v[j].z * v[j].z + v[j].w * v[j].w); }
        const float rstd = 1.f / sqrtf(wave_sum(s) * (1.f / D) + EPS);
        float lg[NE];
#pragma unroll
        for (int e = 0; e < NE; ++e) lg[e] = 0.f;
        float qsc = 1.f;
        if constexpr (OUTQ == 2) { float mx = 0.f;
#pragma unroll
            for (int j = 0; j < 4; ++j) { const f32x4 h = v[j] * rstd * gm0[j] + sh0[j]; mx = fmaxf(mx, fmaxf(fmaxf(fabsf(h.x), fabsf(h.y)), fmaxf(fabsf(h.z), fabsf(h.w)))); }
            mx = fmaxf(wave_max(mx), 1e-30f); qsc = 127.f / mx;
            if (lane == 0) ((float*)(p.ws + WS_ASC))[r] = mx * (1.f / 127.f); }
        float qsc1 = 1.f;
        if constexpr (OUTQ == 3) { float mx = 0.f, my = 0.f;
#pragma unroll
            for (int j = 0; j < 4; ++j) { const f32x4 h = v[j] * rstd * gm0[j] + sh0[j], g1 = v[j] * rstd * gm1[j] + sh1[j];
                mx = fmaxf(mx, fmaxf(fmaxf(fabsf(h.x), fabsf(h.y)), fmaxf(fabsf(h.z), fabsf(h.w)))); my = fmaxf(my, fmaxf(fmaxf(fabsf(g1.x), fabsf(g1.y)), fmaxf(fabsf(g1.z), fabsf(g1.w)))); }
            mx = fmaxf(wave_max(mx), 1e-30f); my = fmaxf(wave_max(my), 1e-30f); qsc = 127.f / mx; qsc1 = 127.f / my;
            if (lane == 0) { ((float*)(p.ws + WS_ASC))[r] = mx * (1.f / 127.f); ((float*)(p.ws + WS_ASC1))[r] = my * (1.f / 127.f); } }
#pragma unroll
        for (int j = 0; j < 4; ++j) {
            const f32x4 h = v[j] * rstd * gm0[j] + sh0[j];
            if constexpr (OUTQ == 2 || OUTQ == 3) { *(unsigned*)((unsigned char*)o0.out + (size_t)r * D + 4 * lane + 256 * j) = pack_i8x4(h.x * qsc, h.y * qsc, h.z * qsc, h.w * qsc); }
            else if constexpr (OUTQ == 1) { unsigned w8 = 0u; w8 = __builtin_amdgcn_cvt_pk_fp8_f32(h.x, h.y, w8, false); w8 = __builtin_amdgcn_cvt_pk_fp8_f32(h.z, h.w, w8, true);
                *(unsigned*)((unsigned char*)o0.out + (size_t)r * D + 4 * lane + 256 * j) = w8; }
            else { u32x2 w; w.x = cvt_pk_bf16(h.x, h.y); w.y = cvt_pk_bf16(h.z, h.w);
            *(u32x2*)(o0.out + (size_t)r * D + 4 * lane + 256 * j) = w; }
            if (NOUT > 1) { const f32x4 h1 = v[j] * rstd * gm1[j] + sh1[j];
                if constexpr (OUTQ == 3) { *(unsigned*)((unsigned char*)o1.out + (size_t)r * D + 4 * lane + 256 * j) = pack_i8x4(h1.x * qsc1, h1.y * qsc1, h1.z * qsc1, h1.w * qsc1); }
                else { u32x2 w1; w1.x = cvt_pk_bf16(h1.x, h1.y); w1.y = cvt_pk_bf16(h1.z, h1.w);
                *(u32x2*)(o1.out + (size_t)r * D + 4 * lane + 256 * j) = w1; } }
            if (ROUTER) {
#pragma unroll
                for (int q = 0; q < 4; ++q) { const f32x4 a = rwa[4 * j + q], c2 = rwb[4 * j + q]; const float hv = h[q];
                    lg[0] += hv * a.x; lg[1] += hv * a.y; lg[2] += hv * a.z; lg[3] += hv * a.w; lg[4] += hv * c2.x; lg[5] += hv * c2.y; lg[6] += hv * c2.z; lg[7] += hv * c2.w; }
            }
        }
        if (ROUTER) {
            {
                const bool u5 = lane & 32, u4 = lane & 16, u3 = lane & 8; float a4[4], a2[2], a1;
#pragma unroll
                for (int i = 0; i < 4; ++i) a4[i] = bfly32(lg[i], lg[4 + i]);
#pragma unroll
                for (int i = 0; i < 2; ++i) a2[i] = bfly16(a4[i], a4[2 + i]);
                a1 = (u3 ? a2[1] : a2[0]) + lane_xor8(u3 ? a2[0] : a2[1]);
                a1 += lane_xor1(a1); a1 += lane_xor2(a1); a1 += red_step4(a1);
#pragma unroll
                for (int e = 0; e < NE; ++e) lg[e] = readlane_f(a1, 8 * e) + p.router_b[e];
            }
            int e0 = 0; float v0 = lg[0];
#pragma unroll
            for (int e = 1; e < NE; ++e) if (lg[e] > v0) { v0 = lg[e]; e0 = e; }
            int e1 = -1; float v1 = -3.0e38f;
#pragma unroll
            for (int e = 0; e < NE; ++e) if (e != e0 && lg[e] > v1) { v1 = lg[e]; e1 = e; }
            const float ex = __expf(v1 - v0), w0 = 1.f / (1.f + ex), w1 = ex / (1.f + ex);
            if (lane == 0) { TOPE[2 * r] = e0; TOPE[2 * r + 1] = e1; TOPW[2 * r] = w0; TOPW[2 * r + 1] = w1; }
#pragma unroll
            for (int e = 0; e < NE; ++e) cnt_local[e] += (e == e0) + (e == e1);
        }
    }
    if (ROUTER) {
        LAS unsigned* lc = (LAS unsigned*)lds;
        if (tid < NE) lc[tid] = 0u;
        __syncthreads();
        if (lane == 0) {
#pragma unroll
            for (int e = 0; e < NE; ++e) if (cnt_local[e]) atomicAdd((unsigned*)(lc + e), cnt_local[e]);
        }
        __syncthreads();
        if (tid < NE && lc[tid]) atomicAdd(ctl + CW_CNT + 64 * tid, lc[tid]);
    }
}

struct NoCol {};
struct EpiPool {
    typedef f32x4 Col; static constexpr bool ROWLOAD = true;
    const float* x; float* x1; const float* g1; const float* scale; int coff;
    __device__ __forceinline__ f32x4 col(int row0, int c) const { return *(const f32x4*)(g1 + (row0 >> 13) * D + coff + c) * *(const f32x4*)(scale + coff + c); }
    __device__ __forceinline__ f32x4 rowload(int row, int c) const { return *(const f32x4*)(x + (size_t)row * D + coff + c); }
    __device__ __forceinline__ void apply8(int row, int c, f32x4 v0, f32x4 v1, f32x4 cg0, f32x4 cg1, f32x4 xv0, f32x4 xv1) const { float* o = x1 + (size_t)row * D + coff + c; *(f32x4*)o = xv0 + cg0 * v0; *(f32x4*)(o + 4) = xv1 + cg1 * v1; }
};
struct EpiSwigluI8 {
    struct Col { f32x4 wg, wu; }; typedef float Row;
    bf16_t* hid; int ldh; const float* asc; const float* wmax;
    __device__ __forceinline__ Col col(int hc) const { Col c; c.wg = *(const f32x4*)(wmax + hc); c.wu = *(const f32x4*)(wmax + FF + hc); return c; }
    __device__ __forceinline__ float rowv(int row) const { return asc[row] * (1.f / 127.f); }
    __device__ __forceinline__ u32x2 four(f32x4 gt, f32x4 up, const Col& c, float ra) const {
        typedef int i32x4e __attribute__((ext_vector_type(4)));
        const i32x4e gi = __builtin_bit_cast(i32x4e, gt), ui = __builtin_bit_cast(i32x4e, up);
        const f32x4 wg = c.wg * ra, wu = c.wu * ra;
        const f32x2 a = swiglu2((f32x2){(float)gi.x, (float)gi.y} * (f32x2){wg.x, wg.y}, (f32x2){(float)ui.x, (float)ui.y} * (f32x2){wu.x, wu.y});
        const f32x2 b = swiglu2((f32x2){(float)gi.z, (float)gi.w} * (f32x2){wg.z, wg.w}, (f32x2){(float)ui.z, (float)ui.w} * (f32x2){wu.z, wu.w});
        unsigned w = 0u; w = __builtin_amdgcn_cvt_pk_fp8_f32(a.x, a.y, w, false); w = __builtin_amdgcn_cvt_pk_fp8_f32(b.x, b.y, w, true); return (u32x2){w, 0u}; }
    __device__ __forceinline__ void pair8(int row, int hc, f32x4 g0, f32x4 u0, f32x4 g1, f32x4 u1, const Col& c0, const Col& c1, float ra) const {
        const u32x2 a = four(g0, u0, c0, ra), b = four(g1, u1, c1, ra);
        *(u32x2*)((unsigned char*)hid + (size_t)row * ldh + hc) = (u32x2){a.x, b.x}; }
};
struct EpiSwiglu8 {
    typedef NoCol Col; typedef NoCol Row;
    unsigned char* hid; int ldh;
    __device__ __forceinline__ NoCol col(int) const { return NoCol{}; }
    __device__ __forceinline__ NoCol rowv(int) const { return NoCol{}; }
    __device__ __forceinline__ unsigned four(f32x4 gt, f32x4 up) const {
        const f32x2 a = swiglu2((f32x2){gt.x, gt.y}, (f32x2){up.x, up.y}), b = swiglu2((f32x2){gt.z, gt.w}, (f32x2){up.z, up.w});
        unsigned w = 0u; w = __builtin_amdgcn_cvt_pk_fp8_f32(a.x, a.y, w, false); w = __builtin_amdgcn_cvt_pk_fp8_f32(b.x, b.y, w, true); return w; }
    __device__ __forceinline__ void pair8(int row, int hc, f32x4 g0, f32x4 u0, f32x4 g1, f32x4 u1, const NoCol&, const NoCol&, NoCol) const {
        *(u32x2*)(hid + (size_t)row * ldh + hc) = (u32x2){four(g0, u0), four(g1, u1)}; }
};
struct EpiResid {
    typedef f32x4 Col; static constexpr bool ROWLOAD = true;
    const float* xin; float* out; const float* gate;
    __device__ __forceinline__ f32x4 col(int row0, int c) const { return *(const f32x4*)(gate + (row0 >> 13) * D + c); }
    __device__ __forceinline__ f32x4 rowload(int row, int c) const { return *(const f32x4*)(xin + (size_t)row * D + c); }
    __device__ __forceinline__ void apply8(int row, int c, f32x4 v0, f32x4 v1, f32x4 cg0, f32x4 cg1, f32x4 xv0, f32x4 xv1) const { float* o = out + (size_t)row * D + c; *(f32x4*)o = xv0 + cg0 * v0; *(f32x4*)(o + 4) = xv1 + cg1 * v1; }
};
struct EpiBf16 {
    typedef NoCol Col; static constexpr bool ROWLOAD = false;
    bf16_t* o; int ldo;
    __device__ __forceinline__ NoCol col(int, int) const { return NoCol{}; }
    __device__ __forceinline__ void apply8(int row, int c, f32x4 v0, f32x4 v1, NoCol, NoCol) const { *(u32x4*)(o + (size_t)row * ldo + c) = (u32x4){cvt_pk_bf16(v0.x, v0.y), cvt_pk_bf16(v0.z, v0.w), cvt_pk_bf16(v1.x, v1.y), cvt_pk_bf16(v1.z, v1.w)}; }
};
__device__ __forceinline__ f32x4 deq_i8(f32x4 a, f32x4 cs) { typedef int i32x4e __attribute__((ext_vector_type(4))); const i32x4e i = __builtin_bit_cast(i32x4e, a); return (f32x4){(float)i.x, (float)i.y, (float)i.z, (float)i.w} * cs; }
struct EpiQ {
    typedef f32x4 Col; static constexpr bool ROWLOAD = false;
    float* gates; int coff; const float* asc; const float* wmax;
    __device__ __forceinline__ f32x4 col(int, int c) const { return *(const f32x4*)(wmax + coff + c) * (1.f / 127.f); }
    __device__ __forceinline__ void apply8(int row, int col_, f32x4 a0, f32x4 a1, f32x4 c0, f32x4 c1) const { const int col = col_ + coff;
        if (col >= D && col < NQ) { const float rs = asc[row]; const f32x4 v0 = deq_i8(a0, c0) * rs, v1 = deq_i8(a1, c1) * rs;
            f32x4 s0, s1; s0.x = sigmoid_f(v0.x); s0.y = sigmoid_f(v0.y); s0.z = sigmoid_f(v0.z); s0.w = sigmoid_f(v0.w); s1.x = sigmoid_f(v1.x); s1.y = sigmoid_f(v1.y); s1.z = sigmoid_f(v1.z); s1.w = sigmoid_f(v1.w);
            float* g = gates + (size_t)row * 48 + (col - D); *(f32x4*)g = s0; *(f32x4*)(g + 4) = s1; } }
};
struct EpiCmp {
    typedef f32x4 Col; static constexpr bool ROWLOAD = false;
    bf16_t* o; const float* bias;
    __device__ __forceinline__ f32x4 col(int, int c_) const { const int z = c_ >> 8, c = c_ & 255; return *(const f32x4*)(bias + (z >> 2) * 256 + c); }
    __device__ __forceinline__ void apply8(int row, int col, f32x4 v0, f32x4 v1, f32x4 b0, f32x4 b1) const { const int z = col >> 8, c = col & 255;
        u32x4 w; w.x = cvt_pk_bf16(gelu_tanh_f(v0.x + b0.x), gelu_tanh_f(v0.y + b0.y)); w.y = cvt_pk_bf16(gelu_tanh_f(v0.z + b0.z), gelu_tanh_f(v0.w + b0.w));
        w.z = cvt_pk_bf16(gelu_tanh_f(v1.x + b1.x), gelu_tanh_f(v1.y + b1.y)); w.w = cvt_pk_bf16(gelu_tanh_f(v1.z + b1.z), gelu_tanh_f(v1.w + b1.w));
        *(u32x4*)(o + ((size_t)z * 2048 + row) * 256 + c) = w; }
};

__device__ __forceinline__ float sum_xor16(float v);
__device__ __forceinline__ float sum_xor32(float v);
struct HeadGain { f32x4 g[2][2]; };
__device__ __forceinline__ float head_rstd(f32x4 a, f32x4 b, f32x4 c, f32x4 d) {
    const f32x4 q = a * a + b * b + c * c + d * d; float s = (q.x + q.y) + (q.z + q.w);
    s = sum_xor16(s); s = sum_xor32(s);
    return 1.f / sqrtf(s * (1.f / 64.f) + EPS); }
__device__ __forceinline__ u32x4 pack8(f32x4 a, f32x4 b) { return (u32x4){cvt_pk_bf16(a.x, a.y), cvt_pk_bf16(a.z, a.w), cvt_pk_bf16(b.x, b.y), cvt_pk_bf16(b.z, b.w)}; }
struct KVGain { f32x4 g[2][2]; f32x4 c[2][2]; };
struct EpiQHead {
    typedef KVGain Gain;
    bf16_t* q; const float* gain; const float* wmax;
    __device__ __forceinline__ KVGain gains(int pn, int wc, int fq) const { KVGain h; const float* cp = wmax + pn * 256 + wc * 64;
#pragma unroll
        for (int bj = 0; bj < 2; ++bj)
#pragma unroll
            for (int n = 0; n < 2; ++n) { h.g[bj][n] = *(const f32x4*)(gain + bj * 32 + 8 * fq + 4 * n) * (0.125f * 1.4426950408889634f); h.c[bj][n] = *(const f32x4*)(cp + bj * 32 + 8 * fq + 4 * n) * (1.f / 127.f); }
        return h; }
    __device__ __forceinline__ void head(int row, int pn, int wc, int fq, f32x4 a00, f32x4 a01, f32x4 a10, f32x4 a11, const KVGain& h) const {
        const f32x4 v00 = deq_i8(a00, h.c[0][0]), v01 = deq_i8(a01, h.c[0][1]), v10 = deq_i8(a10, h.c[1][0]), v11 = deq_i8(a11, h.c[1][1]);
        const float r = head_rstd(v00, v01, v10, v11); bf16_t* o = q + (size_t)row * D + pn * 256 + wc * 64 + 8 * fq;
        *(u32x4*)o = pack8(v00 * r * h.g[0][0], v01 * r * h.g[0][1]); *(u32x4*)(o + 32) = pack8(v10 * r * h.g[1][0], v11 * r * h.g[1][1]); }
};
struct EpiKVHead {
    typedef KVGain Gain;
    bf16_t* kvb; const float* kgain; unsigned char* ws; bf16_t* kcg; const float* asc; const float* wmax;
    __device__ __forceinline__ KVGain gains(int pn, int wc, int fq) const { KVGain h; const float* gp = kgain + (pn == 4 ? 128 : 64); const float* cp = wmax + pn * 256 + wc * 64;
#pragma unroll
        for (int bj = 0; bj < 2; ++bj)
#pragma unroll
            for (int n = 0; n < 2; ++n) { h.g[bj][n] = *(const f32x4*)(gp + bj * 32 + 8 * fq + 4 * n); h.c[bj][n] = *(const f32x4*)(cp + bj * 32 + 8 * fq + 4 * n) * (1.f / 127.f); }
        return h; }
    __device__ __forceinline__ f32x4 deq(f32x4 a, f32x4 cs, float rs) const { typedef int i32x4e __attribute__((ext_vector_type(4))); const i32x4e i = __builtin_bit_cast(i32x4e, a);
        return (f32x4){(float)i.x, (float)i.y, (float)i.z, (float)i.w} * cs * rs; }
    __device__ __forceinline__ void head(int row, int pn, int wc, int fq, f32x4 a00, f32x4 a01, f32x4 a10, f32x4 a11, const KVGain& h) const {
        const float rs = asc[row];
        const f32x4 v00 = deq(a00, h.c[0][0], rs), v01 = deq(a01, h.c[0][1], rs), v10 = deq(a10, h.c[1][0], rs), v11 = deq(a11, h.c[1][1], rs);
        if (pn == 2 || pn == 4) {
            const float r = head_rstd(v00, v01, v10, v11); const int b = row >> 13, t = row & (S - 1);
            bf16_t* dst = (bf16_t*)(ws + (pn == 4 ? WS_KWB : WS_KSB)) + ((size_t)((b * 4 + wc) * 128 + (t >> 6)) * 8 + fq) * 512 + (t & 63) * 8;
            *(u32x4*)dst = pack8(v00 * r * h.g[0][0], v01 * r * h.g[0][1]); *(u32x4*)(dst + 4 * 512) = pack8(v10 * r * h.g[1][0], v11 * r * h.g[1][1]);
        } else { bf16_t* o = pn < 2 ? kcg + ((size_t)(pn * 4 + wc) * (T + 32) + row) * 64 + 8 * fq : kvb + (size_t)row * NKV + pn * 256 + wc * 64 + 8 * fq; *(u32x4*)o = pack8(v00, v01); *(u32x4*)(o + 32) = pack8(v10, v11); } }
};

namespace pg8 {
#define PG8_LAS __attribute__((address_space(3)))
constexpr int BM = 256, BK = 64, HALF = 128, HTB = HALF * BK * 2, STAGE_BYTES = 8 * HTB, NXCD = 8, WGM = 8;
__host__ __device__ __forceinline__ int lds_byte(int r, int c) { const int st = (r >> 4) * 2 + (c >> 5), rr = r & 15, cc = c & 31, ob = rr * 64 + cc * 2; return st * 1024 + (ob ^ (((ob >> 9) & 1) << 5)); }
__host__ __device__ __forceinline__ void stage_rc(int b, int& R, int& C) { const int st = b / 1024, sb = b % 1024, swz = sb ^ (((sb >> 9) & 1) << 5); R = (st >> 1) * 16 + swz / 64; C = (st & 1) * 32 + (swz % 64) / 2; }
__host__ __device__ __forceinline__ int perm32(int rho) { const int n = rho >> 4, i = rho & 15; return 8 * (i >> 2) + 4 * n + (i & 3); }
struct Unit { int pm, pn; };
template <int SMODE> struct Sched {
    int nM, nN, nwg, G, c; const char* A; const char* Bt; size_t lda2, ldb2; int pstv[SMODE == 3 ? NE : 1]; size_t bstride2;
    __device__ __forceinline__ void init(int M, int N, int G_, int c_, const void* A_, const void* Bt_, int lda, int ldb, const int* pst_ = nullptr, size_t bstride = 0) {
        nM = M / BM; nN = N / BM; nwg = nM * nN; G = G_; c = c_; A = (const char*)A_; Bt = (const char*)Bt_; lda2 = (size_t)lda * 2; ldb2 = (size_t)ldb * 2; bstride2 = bstride * 2;
        if constexpr (SMODE == 3) {
#pragma unroll
            for (int q = 0; q < NE; ++q) pstv[q] = __builtin_amdgcn_readfirstlane(pst_[q]); } }
    __device__ __forceinline__ bool next(int i, Unit& u) const {
        if (c < 0) return false;
        const long L = (long)i * G + c; if (L >= nwg) return false;
        int wgid = (int)L; { const int q = nwg / NXCD, r = nwg % NXCD, xcd = wgid % NXCD, off = wgid / NXCD; wgid = (xcd < r ? xcd * (q + 1) : r * (q + 1) + (xcd - r) * q) + off; }
        const int nig = WGM * nN, gid = wgid / nig, fm = gid * WGM, gsz = (nM - fm) < WGM ? (nM - fm) : WGM;
        u.pm = fm + ((wgid % nig) % gsz); u.pn = (wgid % nig) / gsz; return true;
    }
    __device__ __forceinline__ const char* a_ptr(const Unit& u) const {
        if (SMODE == 1) return A + (size_t)u.pm * BM * lda2 + (size_t)u.pn * 512;
        if (SMODE == 2) return A + (size_t)u.pm * BM * lda2 + (size_t)u.pn * ((size_t)(T + 32) * 64 * 2);
        return A + (size_t)u.pm * BM * lda2; }
    __device__ __forceinline__ const char* b_ptr(const Unit& u) const {
        if (SMODE == 2) return Bt + (size_t)(u.pn >> 2) * BM * ldb2;
        if (SMODE == 3) { const int m0 = u.pm * BM; int e = 0;
#pragma unroll
            for (int q = 1; q < NE; ++q) e += (m0 >= pstv[q]); return Bt + (size_t)e * bstride2 + (size_t)u.pn * BM * ldb2; }
        return Bt + (size_t)u.pn * BM * ldb2; }
};
template <class F> struct EpiEl { static constexpr bool PERM = true, AFTER_DRAIN = false, HEADMAP = false; F f;
    __device__ __forceinline__ void operator()(const f32x4 (&acc)[2][2][4][2], const Unit& u, int wr, int wc, int fr, int fq) const {
        const int row0 = u.pm * BM + wr * 64 + fr, col0 = u.pn * BM + wc * 32 + 8 * fq;
        typename F::Col cg[2][2];
#pragma unroll
        for (int bj = 0; bj < 2; ++bj)
#pragma unroll
            for (int n = 0; n < 2; ++n) cg[bj][n] = f.col(u.pm * BM, col0 + bj * HALF + n * 4);
        if constexpr (F::ROWLOAD) {
            f32x4 xv[2][2][4];
#pragma unroll
            for (int r = 0; r < 2; ++r)
#pragma unroll
                for (int c = 0; c < 4; ++c) xv[0][r][c] = f.rowload(row0 + r * 16, col0 + (c >> 1) * HALF + (c & 1) * 4);
#pragma unroll
            for (int b = 0; b < 4; ++b) {
                if (b + 1 < 4) {
#pragma unroll
                    for (int r = 0; r < 2; ++r)
#pragma unroll
                        for (int c = 0; c < 4; ++c) xv[(b + 1) & 1][r][c] = f.rowload(row0 + ((b + 1) >> 1) * HALF + (((b + 1) & 1) * 2 + r) * 16, col0 + (c >> 1) * HALF + (c & 1) * 4);
                }
#pragma unroll
                for (int r = 0; r < 2; ++r)
#pragma unroll
                    for (int bj = 0; bj < 2; ++bj) { const int ai = b >> 1, m = (b & 1) * 2 + r;
                        f.apply8(row0 + ai * HALF + m * 16, col0 + bj * HALF, acc[ai][bj][m][0], acc[ai][bj][m][1], cg[bj][0], cg[bj][1], xv[b & 1][r][bj * 2], xv[b & 1][r][bj * 2 + 1]); }
            }
        } else {
#pragma unroll
            for (int ai = 0; ai < 2; ++ai)
#pragma unroll
                for (int m = 0; m < 4; ++m)
#pragma unroll
                    for (int bj = 0; bj < 2; ++bj) f.apply8(row0 + ai * HALF + m * 16, col0 + bj * HALF, acc[ai][bj][m][0], acc[ai][bj][m][1], cg[bj][0], cg[bj][1]);
        } } };
template <class F> struct EpiPairEl { static constexpr bool PERM = true, AFTER_DRAIN = false, HEADMAP = false; F f;
    __device__ __forceinline__ void operator()(const f32x4 (&acc)[2][2][4][2], const Unit& u, int wr, int wc, int fr, int fq) const {
        const int row0 = u.pm * BM + wr * 64 + fr, hc0 = u.pn * HALF + wc * 32 + 8 * fq;
        typename F::Col cg[2]; typename F::Row rw[2][4];
#pragma unroll
        for (int n = 0; n < 2; ++n) cg[n] = f.col(hc0 + n * 4);
#pragma unroll
        for (int ai = 0; ai < 2; ++ai)
#pragma unroll
            for (int m = 0; m < 4; ++m) rw[ai][m] = f.rowv(row0 + ai * HALF + m * 16);
#pragma unroll
        for (int ai = 0; ai < 2; ++ai)
#pragma unroll
            for (int m = 0; m < 4; ++m) f.pair8(row0 + ai * HALF + m * 16, hc0, acc[ai][0][m][0], acc[ai][1][m][0], acc[ai][0][m][1], acc[ai][1][m][1], cg[0], cg[1], rw[ai][m]); } };

template <class F> struct EpiHeadEl { static constexpr bool PERM = true, AFTER_DRAIN = false, HEADMAP = true; F f;
    __device__ __forceinline__ void operator()(const f32x4 (&acc)[2][2][4][2], const Unit& u, int wr, int wc, int fr, int fq) const {
        const int row0 = u.pm * BM + wr * 64 + fr;
        const typename F::Gain g = f.gains(u.pn, wc, fq);
#pragma unroll
        for (int ai = 0; ai < 2; ++ai)
#pragma unroll
            for (int m = 0; m < 4; ++m) f.head(row0 + ai * HALF + m * 16, u.pn, wc, fq, acc[ai][0][m][0], acc[ai][0][m][1], acc[ai][1][m][0], acc[ai][1][m][1], g); } };

typedef int i32x8 __attribute__((ext_vector_type(8)));
template <int QM> __device__ __forceinline__ void mma_block(f32x4 (&acc)[4][2], const bf16x8 (&At)[4][2], const bf16x8 (&Bt)[2][2], const int wsc) {
    __builtin_amdgcn_s_setprio(1);
    if constexpr (QM == 2) {
        typedef int i32x4m __attribute__((ext_vector_type(4)));
#pragma unroll
        for (int m = 0; m < 4; ++m)
#pragma unroll
            for (int n = 0; n < 2; ++n)
#pragma unroll
                for (int k = 0; k < 2; ++k) acc[m][n] = __builtin_bit_cast(f32x4, __builtin_amdgcn_mfma_i32_16x16x64_i8(__builtin_bit_cast(i32x4m, Bt[n][k]), __builtin_bit_cast(i32x4m, At[m][k]), __builtin_bit_cast(i32x4m, acc[m][n]), 0, 0, 0));
#pragma unroll
        for (int m = 0; m < 4; ++m) asm volatile("" : "+v"(acc[m][0]), "+v"(acc[m][1]));
    } else if constexpr (QM == 1) {
#pragma unroll
        for (int m = 0; m < 4; ++m) { const u32x4 a0 = __builtin_bit_cast(u32x4, At[m][0]), a1 = __builtin_bit_cast(u32x4, At[m][1]);
            const i32x8 a8 = {(int)a0.x, (int)a0.y, (int)a0.z, (int)a0.w, (int)a1.x, (int)a1.y, (int)a1.z, (int)a1.w};
#pragma unroll
            for (int n = 0; n < 2; ++n) { const u32x4 b0 = __builtin_bit_cast(u32x4, Bt[n][0]), b1 = __builtin_bit_cast(u32x4, Bt[n][1]);
                const i32x8 b8 = {(int)b0.x, (int)b0.y, (int)b0.z, (int)b0.w, (int)b1.x, (int)b1.y, (int)b1.z, (int)b1.w};
                acc[m][n] = __builtin_amdgcn_mfma_scale_f32_16x16x128_f8f6f4(b8, a8, acc[m][n], 0, 0, 0, wsc, 0, 127); } }
#pragma unroll
        for (int m = 0; m < 4; ++m) asm volatile("" : "+v"(acc[m][0]), "+v"(acc[m][1]));
    } else {
#pragma unroll
        for (int m = 0; m < 4; ++m)
#pragma unroll
            for (int n = 0; n < 2; ++n)
#pragma unroll
                for (int k = 0; k < 2; ++k) acc[m][n] = __builtin_amdgcn_mfma_f32_16x16x32_bf16(Bt[n][k], At[m][k], acc[m][n], 0, 0, 0);
    }
    __builtin_amdgcn_s_setprio(0);
}
template <class Epi, class Sched, bool ALIGN_EPI = true, bool SP2 = true, int QM = 0>
__device__ __forceinline__ void gemm_phase(PG8_LAS unsigned char* lds, const int K, const int lda, const int ldb, const size_t kstepA, const Sched& S, const Epi& E, const int wsc = 127) {
    const int tid_ = opaque_tid();
    const int tid = tid_, wid = __builtin_amdgcn_readfirstlane(tid >> 6), lane = tid & 63, wr = wid >> 2, wc = wid & 3, fr = lane & 15, fq = lane >> 4;
    const int nt = K / BK;
    unsigned voffA[2], voffB[2], voffB1[2];
#pragma unroll
    for (int i = 0; i < 2; ++i) { int R, C; stage_rc(tid * 16 + i * 8192, R, C); const int Rb = Epi::PERM ? ((R & ~31) + perm32(R & 31)) : R;
        voffA[i] = (unsigned)(R * lda + C) * 2u;
        if constexpr (Epi::HEADMAP) { const int Rh = (R >> 5) * 64 + perm32(R & 31); voffB[i] = (unsigned)(Rh * ldb + C) * 2u; voffB1[i] = (unsigned)((Rh + 32) * ldb + C) * 2u; }
        else { voffB[i] = (unsigned)(Rb * ldb + C) * 2u; voffB1[i] = voffB[i]; } }
    const size_t kstepB = (size_t)(BK * 2);
    const size_t hstepA = (size_t)HALF * lda * 2, hstepB = Epi::HEADMAP ? (size_t)0 : (size_t)HALF * ldb * 2;
    const unsigned ldsw = (unsigned)wid * 1024u;
    int aoffk[2], boffk[2];
#pragma unroll
    for (int k = 0; k < 2; ++k) { const int col = k * 32 + fq * 8;   aoffk[k] = lds_byte(wr * 64 + fr, col); boffk[k] = lds_byte(wc * 32 + fr, col); }
#define PG8_SA(b, h) (((b) * 2 + (h)) * HTB)
#define PG8_SB(b, h) ((4 + (b) * 2 + (h)) * HTB)
#define PG8_STAGE(bufoff, gbase, voff) do { _Pragma("unroll") for (int _i = 0; _i < 2; ++_i) \
        __builtin_amdgcn_global_load_lds((const unsigned*)((const char*)(gbase) + (voff)[_i]), (PG8_LAS unsigned*)(lds + (bufoff) + ldsw + _i * 8192), 16, 0, 0); } while (0)
#define PG8_LDA(dst, b, h) do { _Pragma("unroll") for (int m = 0; m < 4; ++m) _Pragma("unroll") for (int k = 0; k < 2; ++k) dst[m][k] = *(const PG8_LAS bf16x8*)(lds + PG8_SA(b, h) + (aoffk[0] + k * 1024) + m * 2048); } while (0)
#define PG8_LDB(dst, b, h) do { _Pragma("unroll") for (int n = 0; n < 2; ++n) _Pragma("unroll") for (int k = 0; k < 2; ++k) dst[n][k] = *(const PG8_LAS bf16x8*)(lds + PG8_SB(b, h) + (boffk[0] + k * 1024) + n * 2048); } while (0)
#define PG8_MMA(ai, bj, At, Bt) mma_block<QM>(acc[ai][bj], At, Bt, wsc)
#define PG8_WAIT_V(n) asm volatile("s_waitcnt vmcnt(" #n ")" ::: "memory")
#define PG8_WAIT_L(n) asm volatile("s_waitcnt lgkmcnt(" #n ")" ::: "memory")
#define PG8_BAR __builtin_amdgcn_s_barrier()
#define PG8_SCHED __builtin_amdgcn_sched_barrier(0)
    Unit cur, nxt; int ui = 0;
    if (!S.next(0, cur)) return;
    f32x4 acc[2][2][4][2];
#pragma unroll
    for (int a = 0; a < 2; ++a)
#pragma unroll
        for (int b = 0; b < 2; ++b)
#pragma unroll
            for (int m = 0; m < 4; ++m)
#pragma unroll
                for (int n = 0; n < 2; ++n) acc[a][b][m][n] = (f32x4){0.f, 0.f, 0.f, 0.f};
    bf16x8 At[4][2], B0[2][2], B1[2][2];
    const char* cA = S.a_ptr(cur); const char* cB = S.b_ptr(cur);
    if constexpr (SP2) {
        PG8_STAGE(PG8_SB(0, 0), cB, voffB); PG8_STAGE(PG8_SB(0, 1), cB + hstepB, voffB1); PG8_STAGE(PG8_SA(0, 0), cA, voffA); PG8_STAGE(PG8_SA(0, 1), cA + hstepA, voffA);
        if (wr == 1) PG8_BAR;
        PG8_WAIT_V(2); PG8_BAR;
        PG8_STAGE(PG8_SB(1, 0), cB + kstepB, voffB); PG8_STAGE(PG8_SA(1, 0), cA + kstepA, voffA); PG8_STAGE(PG8_SB(1, 1), cB + hstepB + kstepB, voffB1);
        PG8_WAIT_V(6); PG8_BAR;
    } else {
        PG8_STAGE(PG8_SB(0, 0), cB, voffB); PG8_STAGE(PG8_SA(0, 0), cA, voffA); PG8_STAGE(PG8_SB(0, 1), cB + hstepB, voffB1); PG8_STAGE(PG8_SA(0, 1), cA + hstepA, voffA);
        if (wr == 1) PG8_BAR;
        PG8_WAIT_V(4); PG8_BAR;
        PG8_STAGE(PG8_SB(1, 0), cB + kstepB, voffB); PG8_STAGE(PG8_SA(1, 0), cA + kstepA, voffA); PG8_STAGE(PG8_SB(1, 1), cB + hstepB + kstepB, voffB1);
        PG8_WAIT_V(6); PG8_BAR;
    }
    for (;;) {
        const bool has_next = S.next(ui + 1, nxt);
        const char* nA = has_next ? S.a_ptr(nxt) : cA; const char* nB = has_next ? S.b_ptr(nxt) : cB;
        for (int t = 0; t < nt; t += 2) {
            const bool last = (t == nt - 2);
            const char* a1 = cA + (size_t)(t + 1) * kstepA;
            const char* a2 = last ? nA : cA + (size_t)(t + 2) * kstepA; const char* b2 = last ? nB : cB + (size_t)(t + 2) * kstepB;
            const char* a3 = a2 + kstepA; const char* b3 = b2 + kstepB;
            if constexpr (SP2) {
            PG8_LDB(B0, 0, 0); PG8_LDB(B1, 0, 1); PG8_SCHED; PG8_LDA(At, 0, 0); PG8_STAGE(PG8_SA(1, 1), a1 + hstepA, voffA);
            PG8_WAIT_V(8); PG8_WAIT_L(0); PG8_BAR; PG8_MMA(0, 0, At, B0); PG8_MMA(0, 1, At, B1); PG8_BAR; PG8_SCHED;
            PG8_LDA(At, 0, 1); PG8_STAGE(PG8_SB(0, 0), b2, voffB); PG8_STAGE(PG8_SB(0, 1), b2 + hstepB, voffB1); PG8_STAGE(PG8_SA(0, 0), a2, voffA);
            PG8_WAIT_V(8); PG8_WAIT_L(0); PG8_BAR; PG8_MMA(1, 0, At, B0); PG8_MMA(1, 1, At, B1); PG8_BAR; PG8_SCHED;
            PG8_LDB(B0, 1, 0); PG8_LDB(B1, 1, 1); PG8_SCHED; PG8_LDA(At, 1, 0); PG8_STAGE(PG8_SA(0, 1), a2 + hstepA, voffA);
            PG8_WAIT_V(8); PG8_WAIT_L(0); PG8_BAR; PG8_MMA(0, 0, At, B0); PG8_MMA(0, 1, At, B1); PG8_BAR; PG8_SCHED;
            PG8_LDA(At, 1, 1); PG8_STAGE(PG8_SB(1, 0), b3, voffB); PG8_STAGE(PG8_SB(1, 1), b3 + hstepB, voffB1); PG8_STAGE(PG8_SA(1, 0), a3, voffA);
            PG8_WAIT_V(8); PG8_WAIT_L(0); PG8_BAR; PG8_MMA(1, 0, At, B0); PG8_MMA(1, 1, At, B1); PG8_BAR; PG8_SCHED;
            } else {
            PG8_LDB(B0, 0, 0); PG8_SCHED; PG8_LDA(At, 0, 0); PG8_STAGE(PG8_SA(1, 1), a1 + hstepA, voffA);
            PG8_WAIT_L(8); PG8_BAR; PG8_WAIT_L(0); PG8_MMA(0, 0, At, B0); PG8_BAR; PG8_SCHED;
            PG8_LDB(B1, 0, 1); PG8_STAGE(PG8_SB(0, 0), b2, voffB);
            PG8_BAR; PG8_WAIT_L(0); PG8_MMA(0, 1, At, B1); PG8_BAR;
            PG8_LDA(At, 0, 1); PG8_STAGE(PG8_SA(0, 0), a2, voffA);
            PG8_BAR; PG8_WAIT_L(0); PG8_MMA(1, 0, At, B0); PG8_BAR; PG8_SCHED;
            PG8_STAGE(PG8_SB(0, 1), b2 + hstepB, voffB1);
            PG8_WAIT_V(6); PG8_BAR; PG8_MMA(1, 1, At, B1); PG8_BAR;
            PG8_LDB(B0, 1, 0); PG8_SCHED; PG8_LDA(At, 1, 0); PG8_STAGE(PG8_SA(0, 1), a2 + hstepA, voffA);
            PG8_WAIT_L(8); PG8_BAR; PG8_WAIT_L(0); PG8_MMA(0, 0, At, B0); PG8_BAR; PG8_SCHED;
            PG8_LDB(B1, 1, 1); PG8_STAGE(PG8_SB(1, 0), b3, voffB);
            PG8_BAR; PG8_WAIT_L(0); PG8_MMA(0, 1, At, B1); PG8_BAR;
            PG8_LDA(At, 1, 1); PG8_STAGE(PG8_SA(1, 0), a3, voffA);
            PG8_BAR; PG8_WAIT_L(0); PG8_MMA(1, 0, At, B0); PG8_BAR; PG8_SCHED;
            PG8_STAGE(PG8_SB(1, 1), b3 + hstepB, voffB1);
            PG8_WAIT_V(6); PG8_BAR; PG8_MMA(1, 1, At, B1); PG8_BAR;
            }
        }
        if constexpr (ALIGN_EPI) { if (wr == 0) PG8_BAR; }
        if constexpr (!Epi::AFTER_DRAIN) { E(acc, cur, wr, wc, fr, fq); }
        if (!has_next) break;
#pragma unroll
        for (int a = 0; a < 2; ++a)
#pragma unroll
            for (int b = 0; b < 2; ++b)
#pragma unroll
                for (int m = 0; m < 4; ++m)
#pragma unroll
                    for (int n = 0; n < 2; ++n) acc[a][b][m][n] = (f32x4){0.f, 0.f, 0.f, 0.f};
        cur = nxt; cA = nA; cB = nB; ++ui;
        if constexpr (ALIGN_EPI) { if (wr == 1) PG8_BAR; }
    }
    PG8_WAIT_V(0);
    if constexpr (!ALIGN_EPI) { if (wr == 0) PG8_BAR; }
    PG8_BAR;
    if constexpr (Epi::AFTER_DRAIN) { E.fused(acc, cur, wr, wc, fr, fq, lds, wid, lane); }
#undef PG8_SA
#undef PG8_SB
#undef PG8_STAGE
#undef PG8_LDA
#undef PG8_LDB
#undef PG8_MMA
#undef PG8_WAIT_V
#undef PG8_WAIT_L
#undef PG8_BAR
#undef PG8_SCHED
}
}

__device__ __forceinline__ void phase_headnorm(const Params& p, LAS unsigned char* lds) {
    const int tid = opaque_tid(), lane = tid & 63, wave = tid >> 6;
    LAS int* chunk = (LAS int*)(lds + 131072 - 64);
    bf16_t* Q = (bf16_t*)(p.ws + WS_Q); bf16_t* KVB = (bf16_t*)(p.ws + WS_KVB);
    float qg[16], kg[8];
#pragma unroll
    for (int i = 0; i < 16; ++i) qg[i] = p.q_gain[(lane & 3) * 16 + i] * (0.125f * 1.4426950408889634f);
    const int kr = lane >> 5;
#pragma unroll
    for (int i = 0; i < 8; ++i) kg[i] = p.k_gain[(1 + kr) * 64 + (lane & 7) * 8 + i];
    for (;;) {
      if (tid == 0) *chunk = (int)atomicAdd((unsigned*)(p.ws + WS_CTL) + CW_HN, 1u);
      __syncthreads();
      const int c0 = *chunk;
      __syncthreads();
      if (c0 >= T / 128) break;
      for (int r4 = c0 * 128 + wave * 16; r4 < c0 * 128 + wave * 16 + 16; r4 += 4) {
        u32x4 qa[4], qb[4], kw[4];
#pragma unroll
        for (int j = 0; j < 4; ++j) { const int r = r4 + j; const u32x4* ptr = (const u32x4*)(Q + (size_t)r * D + lane * 16); qa[j] = ptr[0]; qb[j] = ptr[1];
            kw[j] = *(const u32x4*)(KVB + (size_t)r * NKV + (kr ? 1024 : 512) + (lane & 31) * 8); }
#pragma unroll
        for (int j = 0; j < 4; ++j) { const int r = r4 + j;
        {
            u32x4* ptr = (u32x4*)(Q + (size_t)r * D + lane * 16); const u32x4 w0 = qa[j], w1 = qb[j];
            float v[16]; const unsigned ww[8] = {w0.x, w0.y, w0.z, w0.w, w1.x, w1.y, w1.z, w1.w}; float s = 0.f;
#pragma unroll
            for (int i = 0; i < 8; ++i) { v[2 * i] = bflo(ww[i]); v[2 * i + 1] = bfhi(ww[i]); s += v[2 * i] * v[2 * i] + v[2 * i + 1] * v[2 * i + 1]; }
            s += lane_xor1(s); s += lane_xor2(s);
            const float rstd = 1.f / sqrtf(s * (1.f / 64.f) + EPS);
            unsigned o[8];
#pragma unroll
            for (int i = 0; i < 8; ++i) o[i] = cvt_pk_bf16(v[2 * i] * rstd * qg[2 * i], v[2 * i + 1] * rstd * qg[2 * i + 1]);
            ptr[0] = (u32x4){o[0], o[1], o[2], o[3]}; ptr[1] = (u32x4){o[4], o[5], o[6], o[7]};
        }
        {
            const u32x4 w0 = kw[j];
            float v[8]; const unsigned ww[4] = {w0.x, w0.y, w0.z, w0.w}; float s = 0.f;
#pragma unroll
            for (int i = 0; i < 4; ++i) { v[2 * i] = bflo(ww[i]); v[2 * i + 1] = bfhi(ww[i]); s += v[2 * i] * v[2 * i] + v[2 * i + 1] * v[2 * i + 1]; }
            s += lane_xor1(s); s += lane_xor2(s); s += red_step4(s);
            const float rstd = 1.f / sqrtf(s * (1.f / 64.f) + EPS);
            unsigned o[4];
#pragma unroll
            for (int i = 0; i < 4; ++i) o[i] = cvt_pk_bf16(v[2 * i] * rstd * kg[2 * i], v[2 * i + 1] * rstd * kg[2 * i + 1]);
            const int b = r >> 13, t = r & (S - 1), hg = (lane & 31) >> 3, c = lane & 7;
            {
                bf16_t* dst = (bf16_t*)(p.ws + (kr ? WS_KWB : WS_KSB)) + ((size_t)((b * 4 + hg) * 128 + (t >> 6)) * 8 + c) * 512 + (t & 63) * 8;
                *(u32x4*)dst = (u32x4){o[0], o[1], o[2], o[3]};
            }
        }
        }
      }
    }
}

typedef __bf16 bf16v2 __attribute__((ext_vector_type(2)));
__device__ __forceinline__ float dot2_bf16(unsigned a, unsigned b, float c) { return __builtin_amdgcn_fdot2_f32_bf16(__builtin_bit_cast(bf16v2, a), __builtin_bit_cast(bf16v2, b), c, false); }
__device__ __forceinline__ void phase_cmp2(const Params& p, LAS unsigned char* lds) {
    const int tid = opaque_tid(), lane = tid & 63, wave = tid >> 6;
    const int gw = blockIdx.x * NWAVE + wave, NGW = gridDim.x * NWAVE;
    const bf16_t* CMPH = (const bf16_t*)(p.ws + WS_CMPH);
    LAS unsigned* w2p = (LAS unsigned*)lds;
    for (int kv = 0; kv < 2; ++kv) {
        const float* w2 = kv ? p.cmp_v_w2 : p.cmp_k_w2;
        for (int i = tid; i < 128 * 64; i += NTHR) { const int kp = i >> 6, n = i & 63; w2p[i] = cvt_pk_bf16(w2[(2 * kp) * 64 + n], w2[(2 * kp + 1) * 64 + n]); }
        __syncthreads();
        for (int it = gw * 4; it < 4 * 2048; it += NGW * 4) {
            unsigned hw[4][2]; float acc[4] = {0.f, 0.f, 0.f, 0.f};
#pragma unroll
            for (int rr = 0; rr < 4; ++rr) { const u32x2 w = *(const u32x2*)(CMPH + (size_t)(kv * 8192 + it + rr) * 256 + 4 * lane); hw[rr][0] = w.x; hw[rr][1] = w.y; }
#pragma unroll 4
            for (int kk = 0; kk < 64; ++kk)
#pragma unroll
                for (int j = 0; j < 2; ++j) { const unsigned wv = w2p[(2 * kk + j) * 64 + lane];
#pragma unroll
                    for (int rr = 0; rr < 4; ++rr) acc[rr] = dot2_bf16((unsigned)__builtin_amdgcn_readlane((int)hw[rr][j], kk), wv, acc[rr]); }
#pragma unroll
            for (int rr = 0; rr < 4; ++rr) {
                const int row = it + rr, g = (row >> 11) & 3, r2 = row & 2047, b = r2 >> 9, n = r2 & 511; float a = n == NC - 1 ? 0.f : acc[rr];
                if (kv == 0) { const float ss = wave_sum(a * a); a = a * (1.f / sqrtf(ss * (1.f / 64.f) + EPS)) * p.k_gain[lane]; }
                const size_t blk0 = (size_t)((b * 4 + g) * 8 + (n >> 6)) * 4096;
                bf16_t* o = kv ? (bf16_t*)(p.ws + WS_VC) + blk0 + ((n & 63) >> 3) * 512 + lane * 8 + (n & 7)
                               : (bf16_t*)(p.ws + WS_KC) + blk0 + (lane >> 3) * 512 + (n & 63) * 8 + (lane & 7);
                *o = (bf16_t)(cvt_pk_bf16(a, 0.f) & 0xffffu);
            }
        }
        __syncthreads();
    }
}

__device__ __forceinline__ void phase_vtrans(const Params& p, LAS unsigned char* lds) {
    const int tid = opaque_tid(), lane = tid & 63, wave = tid >> 6;
    const int gw = blockIdx.x * NWAVE + wave, NGW = gridDim.x * NWAVE;
    LAS unsigned short* tile = (LAS unsigned short*)(lds + wave * 8448);
    const bf16_t* KVB = (const bf16_t*)(p.ws + WS_KVB);
    LAS int* chunk = (LAS int*)(lds + 131072 - 64);
    for (;;) {
        if (tid == 0) *chunk = (int)atomicAdd((unsigned*)(p.ws + WS_CTL) + CW_VT, 1u);
        __syncthreads();
        const int c0 = *chunk;
        __syncthreads();
        if (c0 >= 2 * 16 * 128 / NWAVE) break;
        const int u = c0 * NWAVE + wave;
        const int which = u >> 11, bg = (u >> 7) & 15, tt = u & 127, b = bg >> 2, g = bg & 3, t0 = tt * 64;
        const u32x4* src = (const u32x4*)(KVB + (size_t)(b * S + t0 + lane) * NKV + (which ? 1280 : 768) + g * 64);
#pragma unroll
        for (int i = 0; i < 8; ++i) { const u32x4 v = src[i]; LAS unsigned* tp = (LAS unsigned*)(tile + lane * 66 + 8 * i); tp[0] = v.x; tp[1] = v.y; tp[2] = v.z; tp[3] = v.w; }
        asm volatile("s_waitcnt lgkmcnt(0)" ::: "memory");
        {
            bf16_t* dst = (bf16_t*)(p.ws + (which ? WS_VWB : WS_VSB)) + (size_t)(bg * 128 + tt) * 4096 + lane * 8;
#pragma unroll
            for (int i = 0; i < 8; ++i) { unsigned w[4];
#pragma unroll
                for (int q = 0; q < 4; ++q) { const unsigned lo = tile[(8 * i + 2 * q) * 66 + lane], hi = tile[(8 * i + 2 * q + 1) * 66 + lane]; w[q] = lo | (hi << 16); }
                *(u32x4*)(dst + i * 512) = (u32x4){w[0], w[1], w[2], w[3]}; }
        }
        asm volatile("s_waitcnt lgkmcnt(0)" ::: "memory");
    }
}

typedef short s16x4 __attribute__((ext_vector_type(4)));
__device__ __forceinline__ f32x4 mfma4(s16x4 a, s16x4 b, f32x4 c) { return __builtin_amdgcn_mfma_f32_4x4x4bf16_1k(a, b, c, 0, 0, 0); }
__device__ __forceinline__ s16x4 mk4(unsigned lo, unsigned hi) { const u32x2 t = {lo, hi}; return __builtin_bit_cast(s16x4, t); }
__device__ __forceinline__ f32x4 qk64(const bf16_t* krow, const s16x4 (&qf)[16]) {
    const u32x4* kp = (const u32x4*)krow; u32x4 kr[8];
#pragma unroll
    for (int i = 0; i < 8; ++i) kr[i] = kp[i];
    f32x4 s = {0.f, 0.f, 0.f, 0.f};
#pragma unroll
    for (int c = 0; c < 8; ++c) { s = mfma4(mk4(kr[c].x, kr[c].y), qf[2 * c], s); s = mfma4(mk4(kr[c].z, kr[c].w), qf[2 * c + 1], s); }
    return s;
}
__device__ __forceinline__ void pv64(f32x4& o, const f32x4 e, const bf16_t* vtrow, LAS u32x2* stage, int lane) {
    const u32x4* vp = (const u32x4*)vtrow; u32x4 vr[8];
#pragma unroll
    for (int i = 0; i < 8; ++i) vr[i] = vp[i];
    u32x2 pk; pk.x = cvt_pk_bf16(e.x, e.y); pk.y = cvt_pk_bf16(e.z, e.w);
    stage[lane] = pk;
#pragma unroll
    for (int st = 0; st < 16; ++st) { const u32x2 a = stage[4 * st + (lane & 3)]; const u32x4 v = vr[st >> 1];
        o = mfma4(mk4(a.x, a.y), (st & 1) ? mk4(v.z, v.w) : mk4(v.x, v.y), o); }
}
__device__ __forceinline__ float quadx_sum(float v) { v += __shfl_xor(v, 4); v += __shfl_xor(v, 8); v += __shfl_xor(v, 16); v += __shfl_xor(v, 32); return v; }

constexpr int HBN = 800;
constexpr int ATT_HBD = 0, ATT_MH = 51200, ATT_PSLC = 53248, ATT_STAGE = 118784;
__device__ __forceinline__ void attn_tables(const Params& p, LAS unsigned char* lds) {
    const int tid = opaque_tid();
    LAS float* hbd = (LAS float*)(lds + ATT_HBD); LAS float* mh = (LAS float*)(lds + ATT_MH);
    if (tid < 16) { float qg = 0.f, kg = 0.f, bm = -3.0e38f;
        for (int i = 0; i < 64; ++i) qg = fmaxf(qg, fabsf(p.q_gain[i]));
        for (int i = 0; i < 192; ++i) kg = fmaxf(kg, fabsf(p.k_gain[i]));
        for (int i = 0; i < 32; ++i) bm = fmaxf(bm, p.rel_bias[i * NH + tid]);
        mh[tid] = (qg * kg * 8.f * 1.02f + bm) * 1.4426950408889634f; }
    __syncthreads();
    for (int i = tid; i < 16 * HBN; i += NTHR) { const int hd = i / HBN, d = i - hd * HBN; const float v = p.rel_bias[rel_bucket(d) * NH + hd] * 1.4426950408889634f - mh[hd]; hbd[i] = v; if (blockIdx.x == 0) ((float*)(p.ws + WS_HBG))[i] = v; }
    __syncthreads();
}
typedef float f32x16 __attribute__((ext_vector_type(16)));
__device__ __forceinline__ f32x16 mfma32(bf16x8 a, bf16x8 b, f32x16 c) { return __builtin_amdgcn_mfma_f32_32x32x16_bf16(a, b, c, 0, 0, 0); }
struct DFrag { bf16x8 ka[4]; bf16x8 va[2][2]; };
__device__ __forceinline__ void dense_load_k(bf16x8 (&ka)[4], const bf16_t* KB, int kt, int l31, int h) {
    const int blk = kt >> 6, hh = (kt >> 5) & 1;
    const bf16_t* kb = KB + (size_t)blk * 4096 + (32 * hh + l31) * 8;
#pragma unroll
    for (int ks = 0; ks < 4; ++ks) ka[ks] = *(const bf16x8*)(kb + (2 * ks + h) * 512);
}
__device__ __forceinline__ void dense_load_v(bf16x8 (&va)[2][2], const bf16_t* VB, int kt, int l31, int h) {
    const int blk = kt >> 6, hh = (kt >> 5) & 1;
    const bf16_t* vb = VB + (size_t)blk * 4096 + l31 * 8 + 4 * h;
#pragma unroll
    for (int dt = 0; dt < 2; ++dt)
#pragma unroll
        for (int st = 0; st < 2; ++st) { const bf16_t* q0 = vb + (4 * hh + 2 * st) * 512 + dt * 256; const u32x2 lo = *(const u32x2*)q0, hi = *(const u32x2*)(q0 + 512);
            const u32x4 w = {lo.x, lo.y, hi.x, hi.y}; va[dt][st] = __builtin_bit_cast(bf16x8, w); }
}
__device__ __forceinline__ f32x16 dense_scores(const DFrag& f, const bf16x8 (&q)[4]) {
    f32x16 sacc;
#pragma unroll
    for (int i = 0; i < 16; ++i) sacc[i] = 0.f;
#pragma unroll
    for (int ks = 0; ks < 4; ++ks) sacc = mfma32(f.ka[ks], q[ks], sacc);
    return sacc;
}
__device__ __forceinline__ void dense_pv(f32x16 (&O)[2], const DFrag& f, const float (&ev)[16]) {
    bf16x8 pb[2];
#pragma unroll
    for (int st = 0; st < 2; ++st) { const u32x4 w = {cvt_pk_bf16(ev[8 * st], ev[8 * st + 1]), cvt_pk_bf16(ev[8 * st + 2], ev[8 * st + 3]), cvt_pk_bf16(ev[8 * st + 4], ev[8 * st + 5]), cvt_pk_bf16(ev[8 * st + 6], ev[8 * st + 7])};
        pb[st] = __builtin_bit_cast(bf16x8, w); }
#pragma unroll
    for (int dt = 0; dt < 2; ++dt)
#pragma unroll
        for (int st = 0; st < 2; ++st) O[dt] = mfma32(f.va[dt][st], pb[st], O[dt]);
}
__device__ __forceinline__ void phase_dense(const Params& p, LAS unsigned char* lds, bf16_t* OW) {
    const int tid = opaque_tid(), lane0 = tid & 63, wave = tid >> 6;
    const LAS float* hbd = (const LAS float*)(lds + ATT_HBD); const LAS float* mh = (const LAS float*)(lds + ATT_MH);
    LAS float* pslc = (LAS float*)(lds + ATT_PSLC) + wave * 2048;
    const bf16_t* Q = (const bf16_t*)(p.ws + WS_Q); const float* GATE = (const float*)(p.ws + WS_GATE);
    short* SEL = (short*)(p.ws + WS_SEL);
    const int Gn = gridDim.x, vcu = (Gn % 8 == 0) ? (blockIdx.x % 8) * (Gn / 8) + blockIdx.x / 8 : blockIdx.x;
    for (int u = vcu * NWAVE + wave; u < T * G / 16; u += Gn * NWAVE) {
        int lane = lane0; asm volatile("" : "+v"(lane));
        const int l31 = lane & 31, h = lane >> 5;
        const int bg = u >> 9, t0 = (((u & 511) + 128 * (u >> 11)) & 511) * 16, b = bg >> 2, g = bg & 3, head = 4 * g + (lane & 3);
        const LAS float* hb = hbd + head * HBN;
        int tok[2]; bf16x8 qf[2][4];
#pragma unroll
        for (int r = 0; r < 2; ++r) { tok[r] = t0 + 8 * r + (l31 >> 2); const bf16_t* qp = Q + (size_t)(b * S + tok[r]) * D + head * 64 + 8 * h;
#pragma unroll
            for (int ks = 0; ks < 4; ++ks) qf[r][ks] = *(const bf16x8*)(qp + 16 * ks); }
        f32x16 O[2][2];
#pragma unroll
        for (int r = 0; r < 2; ++r)
#pragma unroll
            for (int dt = 0; dt < 2; ++dt)
#pragma unroll
                for (int q = 0; q < 16; ++q) O[r][dt][q] = 0.f;
        DFrag cur; bf16x8 nxtk[4];
        {
            const bf16_t* KB = (const bf16_t*)(p.ws + WS_KWB) + (size_t)bg * 128 * 4096; const bf16_t* VB = (const bf16_t*)(p.ws + WS_VWB) + (size_t)bg * 128 * 4096;
            float lw[2] = {0.f, 0.f};
            const int lo = t0 - (WIN - 1) > 0 ? t0 - (WIN - 1) : 0, kt_last = t0 & ~31;
            dense_load_k(cur.ka, KB, lo & ~31, l31, h);
            for (int kt = lo & ~31; kt <= kt_last; kt += 32) {
                dense_load_v(cur.va, VB, kt, l31, h);
                dense_load_k(nxtk, KB, kt + 32 <= kt_last ? kt + 32 : kt_last, l31, h);
                __builtin_amdgcn_sched_barrier(0);
#pragma unroll
                for (int r = 0; r < 2; ++r) {
                    const f32x16 sacc = dense_scores(cur, qf[r]);
                    const int dbase = tok[r] - kt - 4 * h; float ev[16];
                    if (kt + 31 <= t0 + 8 * r && kt >= t0 + 8 * r + 7 - (WIN - 1)) {
                        const LAS float* hbp = hb + dbase;
#pragma unroll
                        for (int q = 0; q < 16; ++q) { const float e = __builtin_amdgcn_exp2f(sacc[q] + hbp[-((q & 3) + 8 * (q >> 2))]); ev[q] = e; lw[r] += e; }
                    } else {
#pragma unroll
                    for (int q = 0; q < 16; ++q) { const int dist = dbase - ((q & 3) + 8 * (q >> 2)); const bool ok = (unsigned)dist < (unsigned)WIN;
                        const float e0 = __builtin_amdgcn_exp2f(sacc[q] + hb[ok ? dist : 0]); const float e = ok ? e0 : 0.f; ev[q] = e; lw[r] += e; }
                    }
                    dense_pv(O[r], cur, ev);
                }
#pragma unroll
                for (int ks = 0; ks < 4; ++ks) cur.ka[ks] = nxtk[ks];
            }
#pragma unroll
            for (int r = 0; r < 2; ++r) { const float l = sum_xor32(lw[r]); int tk = tok[r]; asm volatile("" : "+v"(tk)); const float* gp = GATE + (size_t)(b * S + tk) * 48 + head * 3;
                const float sc = gp[2] / (l * gp[0]);
#pragma unroll
                for (int dt = 0; dt < 2; ++dt) O[r][dt] = O[r][dt] * sc; }
        }
        const int ncmax = t0 >> 4;
        {
            int l31c = l31, hc = h; asm volatile("" : "+v"(l31c), "+v"(hc));
            const bf16_t* KB = (const bf16_t*)(p.ws + WS_KC) + (size_t)bg * 8 * 4096; const bf16_t* VB = (const bf16_t*)(p.ws + WS_VC) + (size_t)bg * 8 * 4096;
            float lc[2] = {0.f, 0.f};
            const int kt_last = ncmax > 0 ? ((ncmax - 1) & ~31) : -32;
            if (ncmax > 0) {
                dense_load_k(cur.ka, KB, 0, l31c, hc);
                for (int kt = 0; kt <= kt_last; kt += 32) {
                    dense_load_k(nxtk, KB, kt + 32 <= kt_last ? kt + 32 : kt_last, l31c, hc);
                    __builtin_amdgcn_sched_barrier(0);
#pragma unroll
                    for (int r = 0; r < 2; ++r) {
                        const f32x16 sacc = dense_scores(cur, qf[r]);
                        if (t0 - 31 - 16 * (kt + 31) >= HBN - 1) {
                            const float bfar = hb[HBN - 1];
#pragma unroll
                            for (int q = 0; q < 16; ++q) lc[r] += __builtin_amdgcn_exp2f(sacc[q] + bfar);
                        } else {
                        const int dbase = tok[r] - 31 - 16 * (kt + 4 * hc);
#pragma unroll
                        for (int q = 0; q < 16; ++q) { const int dist = dbase - 16 * ((q & 3) + 8 * (q >> 2)); const int di = dist < 0 ? 0 : (dist > HBN - 1 ? HBN - 1 : dist);
                            const float e0 = __builtin_amdgcn_exp2f(sacc[q] + hb[di]); lc[r] += dist >= 0 ? e0 : 0.f; }
                        }
                    }
#pragma unroll
                    for (int ks = 0; ks < 4; ++ks) cur.ka[ks] = nxtk[ks];
                }
            }
            float linv[2];
#pragma unroll
            for (int r = 0; r < 2; ++r) { const float l = sum_xor32(lc[r]); linv[r] = l > 0.f ? 1.f / l : 0.f; }
            { const f32x4 z = {0.f, 0.f, 0.f, 0.f};
#pragma unroll
              for (int i = 0; i < 8; ++i) *(LAS f32x4*)(pslc + (i * 64 + lane) * 4) = z; }
            if (ncmax > 0) {
                float carry[2] = {0.f, 0.f};
                dense_load_k(cur.ka, KB, 0, l31c, hc);
                for (int kt = 0; kt <= kt_last; kt += 32) {
                    dense_load_v(cur.va, VB, kt, l31c, hc);
                    dense_load_k(nxtk, KB, kt + 32 <= kt_last ? kt + 32 : kt_last, l31c, hc);
                    __builtin_amdgcn_sched_barrier(0);
#pragma unroll
                    for (int r = 0; r < 2; ++r) {
                        const f32x16 sacc = dense_scores(cur, qf[r]);
                        float pv[16];
                        const int dbase = tok[r] - 31 - 16 * (kt + 4 * hc);
#pragma unroll
                        for (int q = 0; q < 16; ++q) { const int dist = dbase - 16 * ((q & 3) + 8 * (q >> 2)); const int di = dist < 0 ? 0 : (dist > HBN - 1 ? HBN - 1 : dist);
                            const float e0 = __builtin_amdgcn_exp2f(sacc[q] + hb[di]); pv[q] = dist >= 0 ? e0 * linv[r] : 0.f; }
                        dense_pv(O[r], cur, pv);
#pragma unroll
                        for (int q = 0; q < 16; ++q) { pv[q] += lane_xor1(pv[q]); pv[q] += lane_xor2(pv[q]); }
                        float y[4];
#pragma unroll
                        for (int gq = 0; gq < 4; ++gq) y[gq] = lane_xor32(pv[4 * gq + 3], h);
#pragma unroll
                        for (int gq = 0; gq < 4; ++gq) { const float prevv = h ? y[gq] : (gq > 0 ? y[gq > 0 ? gq - 1 : 0] : carry[r]);
                            const float val = 2.f * ((pv[4 * gq] + pv[4 * gq + 1]) + pv[4 * gq + 2]) + pv[4 * gq + 3] + prevv;
                            if ((lane & 3) == 0) pslc[(8 * r + (l31c >> 2)) * 128 + (kt >> 2) + 2 * gq + hc] = val; }
                        carry[r] = y[3];
                    }
#pragma unroll
                    for (int ks = 0; ks < 4; ++ks) cur.ka[ks] = nxtk[ks];
                }
            }
        }
#pragma unroll
        for (int r = 0; r < 2; ++r) { int tk = tok[r]; asm volatile("" : "+v"(tk)); bf16_t* op = OW + (size_t)(b * S + tk) * D + head * 64 + 4 * h; const float gc = GATE[(size_t)(b * S + tk) * 48 + head * 3];
#pragma unroll
            for (int dt = 0; dt < 2; ++dt)
#pragma unroll
                for (int gq = 0; gq < 4; ++gq) { u32x2 w; w.x = cvt_pk_bf16(O[r][dt][4 * gq] * gc, O[r][dt][4 * gq + 1] * gc); w.y = cvt_pk_bf16(O[r][dt][4 * gq + 2] * gc, O[r][dt][4 * gq + 3] * gc);
                    *(u32x2*)(op + dt * 32 + 8 * gq) = w; } }
#pragma unroll 1
        for (int tl = 0; tl < 16; ++tl) {
            int ln = lane; asm volatile("" : "+v"(ln));
            const int t = t0 + tl, cur_b = t >> 6, j0 = ln, j1 = ln + 64;
            const float c0 = pslc[tl * 128 + j0], c1 = pslc[tl * 128 + j1];
            const bool f0 = (j0 == 0) || (j0 == cur_b) || (j0 == cur_b - 1), f1 = (j1 == cur_b) || (j1 == cur_b - 1);
            const bool v0 = j0 * 64 <= t, v1 = j1 * 64 <= t;
            const unsigned u0 = (v0 && !f0) ? __float_as_uint(c0) : 0u, u1 = (v1 && !f1) ? __float_as_uint(c1) : 0u;
            unsigned th = 1u;
            if (cur_b + 1 > NSEL) {
                th = 0u;
#pragma unroll 1
                for (int bit = 30; bit >= 0; --bit) {
                    const unsigned trial = th | (1u << bit);
                    const int cnt = __popcll(__ballot(u0 >= trial)) + __popcll(__ballot(u1 >= trial));
                    if (cnt >= NSEL - 3) { th = trial; if (cnt == NSEL - 3) break; }
                }
            }
            const bool s0 = f0 || (u0 >= th && u0 != 0u), s1 = f1 || (u1 >= th && u1 != 0u);
            const unsigned long long m0 = __ballot(s0), m1 = __ballot(s1), lt = (1ull << ln) - 1ull;
            const int p0 = __popcll(m0 & lt), p1 = __popcll(m0) + __popcll(m1 & lt);
            short* so = SEL + ((size_t)(b * S + t) * 4 + g) * NSEL;
            if (s0 && p0 < NSEL) so[p0] = (short)j0;
            if (s1 && p1 < NSEL) so[p1] = (short)j1;
        }
    }
}

constexpr int ST_ACC = 0, ST_LACC = 133120, ST_MASK = 135168, ST_LIST = 136192, ST_CTR = 138240, ST_HB4 = 138304;
__device__ __forceinline__ void lds_add_f64(unsigned addr, double v) { asm volatile("ds_add_f64 %0, %1" :: "v"(addr), "v"(v) : "memory"); }
__device__ __forceinline__ void phase_sel_tile(const Params& p, LAS unsigned char* lds, bf16_t* AO, const bf16_t* OW) {
    const int tid = opaque_tid(), lane = tid & 63, wave = tid >> 6, l31 = lane & 31, h = lane >> 5;
    LAS double* acc = (LAS double*)(lds + ST_ACC); LAS double* lacc = (LAS double*)(lds + ST_LACC);
    LAS unsigned* mask = (LAS unsigned*)(lds + ST_MASK); LAS int* list = (LAS int*)(lds + ST_LIST) + wave * 64; LAS int* ctr = (LAS int*)(lds + ST_CTR);
    const bf16_t* Q = (const bf16_t*)(p.ws + WS_Q); const float* GATE = (const float*)(p.ws + WS_GATE); const short* SEL = (const short*)(p.ws + WS_SEL);
    const int Gn = gridDim.x;
    for (int kk = 0, u = blockIdx.x; u < 16 * 128; u += Gn, ++kk) {
        const int bg = u >> 7, ti = u & 127, tt = (kk & 1) ? 127 - ti : ti, b = bg >> 2, g = bg & 3, t0 = tt * 64, cur = tt, nv = cur + 1 < NSEL ? cur + 1 : NSEL;
        for (int i = tid; i < ST_LIST / 16; i += NTHR) ((LAS u32x4*)lds)[i] = (u32x4){0u, 0u, 0u, 0u};
        if (tid == 0) *ctr = 0;
        { LAS float* hb4 = (LAS float*)(lds + ST_HB4); const float* hsrc = (const float*)(p.ws + WS_HBG) + 4 * g * HBN; for (int i = tid; i < 4 * HBN; i += NTHR) hb4[i] = hsrc[i]; }
        __syncthreads();
        { const int tl = tid >> 3; const short* sp = SEL + ((size_t)(b * S + t0 + tl) * 4 + g) * NSEL;
#pragma unroll
          for (int e = (tid & 7) * 2; e < (tid & 7) * 2 + 2; ++e) if (e < nv) { const int blk = sp[e]; __hip_atomic_fetch_or(mask + blk * 2 + (tl >> 5), 1u << (tl & 31), __ATOMIC_RELAXED, __HIP_MEMORY_SCOPE_WORKGROUP); } }
        __syncthreads();
        const int nf = cur >= 2 ? 3 : cur + 1, nitems = 2 * nf + (cur >= 3 ? cur - 2 : 0);
        const bf16_t* KB = (const bf16_t*)(p.ws + WS_KSB) + (size_t)bg * 128 * 4096; const bf16_t* VB = (const bf16_t*)(p.ws + WS_VSB) + (size_t)bg * 128 * 4096;
        const int hl = lane & 3, head = 4 * g + hl;
        const LAS float* hbg = (const LAS float*)(lds + ST_HB4) + hl * HBN; const float bfar = hbg[HBN - 1];
        for (;;) {
            int it = 0; if (lane == 0) it = __hip_atomic_fetch_add(ctr, 1, __ATOMIC_RELAXED, __HIP_MEMORY_SCOPE_WORKGROUP);
            it = __builtin_amdgcn_readfirstlane(it);
            if (it >= nitems) break;
            int j, c_lo, c_hi;
            if (it < 2 * nf) { const int f = it >> 1; j = f == 0 ? cur : (f == 1 ? cur - 1 : 0); c_lo = (it & 1) * 4; c_hi = c_lo + 4; }
            else { j = it - 2 * nf + 1; c_lo = 0; c_hi = 8; }
            const unsigned mlo = (unsigned)__builtin_amdgcn_readfirstlane((int)mask[2 * j]), mhi = (unsigned)__builtin_amdgcn_readfirstlane((int)mask[2 * j + 1]);
            const unsigned long long m = ((unsigned long long)mhi << 32) | mlo; const int n = __popcll(m), nch = (n + 7) >> 3;
            if (c_hi > nch) c_hi = nch;
            if (c_lo >= c_hi) continue;
            if ((m >> lane) & 1ull) list[__popcll(m & ((1ull << lane) - 1ull))] = lane;
            DFrag fr0, fr1;
            dense_load_k(fr0.ka, KB, j * 64, l31, h); dense_load_v(fr0.va, VB, j * 64, l31, h);
            dense_load_k(fr1.ka, KB, j * 64 + 32, l31, h); dense_load_v(fr1.va, VB, j * 64 + 32, l31, h);
            bf16x8 qn[4];
            { const int slot = c_lo * 8 + (l31 >> 2); const int tokl = list[slot < n ? slot : n - 1]; const bf16_t* qp = Q + (size_t)(b * S + t0 + tokl) * D + head * 64 + 8 * h;
#pragma unroll
              for (int ks = 0; ks < 4; ++ks) qn[ks] = *(const bf16x8*)(qp + 16 * ks); }
            for (int c = c_lo; c < c_hi; ++c) {
                const int slot = c * 8 + (l31 >> 2); const bool valid = slot < n; const int tokl = list[valid ? slot : n - 1], tok = t0 + tokl;
                bf16x8 qf[4];
#pragma unroll
                for (int ks = 0; ks < 4; ++ks) qf[ks] = qn[ks];
                { const int sn = (c + 1 < c_hi ? c + 1 : c) * 8 + (l31 >> 2); const int tn = list[sn < n ? sn : n - 1]; const bf16_t* qp = Q + (size_t)(b * S + t0 + tn) * D + head * 64 + 8 * h;
#pragma unroll
                  for (int ks = 0; ks < 4; ++ks) qn[ks] = *(const bf16x8*)(qp + 16 * ks); }
                __builtin_amdgcn_sched_barrier(0);
                f32x16 O[2]; float ls = 0.f;
#pragma unroll
                for (int dt = 0; dt < 2; ++dt)
#pragma unroll
                    for (int q = 0; q < 16; ++q) O[dt][q] = 0.f;
#pragma unroll
                for (int half = 0; half < 2; ++half) {
                    const int kt = j * 64 + 32 * half; const DFrag& fr = half ? fr1 : fr0;
                    const f32x16 sacc = dense_scores(fr, qf); float ev[16];
                    if (t0 - kt - 31 >= HBN - 1) {
#pragma unroll
                        for (int q = 0; q < 16; ++q) { ev[q] = __builtin_amdgcn_exp2f(sacc[q] + bfar); ls += ev[q]; }
                    } else { const int dbase = tok - kt - 4 * h;
#pragma unroll
                        for (int q = 0; q < 16; ++q) { const int dist = dbase - ((q & 3) + 8 * (q >> 2)); const int di = dist < 0 ? 0 : (dist > HBN - 1 ? HBN - 1 : dist);
                            const float e0 = __builtin_amdgcn_exp2f(sacc[q] + hbg[di]); ev[q] = dist >= 0 ? e0 : 0.f; ls += ev[q]; } }
                    dense_pv(O, fr, ev);
                }
                const float lt = sum_xor32(ls);
                if (valid) {
                    const unsigned a0 = (unsigned)(size_t)(acc + (tokl * 4 + hl) * 65 + 4 * h);
#pragma unroll
                    for (int dt = 0; dt < 2; ++dt)
#pragma unroll
                        for (int q = 0; q < 16; ++q) lds_add_f64(a0 + (dt * 32 + (q & 3) + 8 * (q >> 2)) * 8, (double)O[dt][q]);
                    if (h == 0) lds_add_f64((unsigned)(size_t)(lacc + tokl * 4 + hl), (double)lt);
                }
            }
        }
        __syncthreads();
        for (int r0 = wave * 32; r0 < wave * 32 + 32; r0 += 8) {
            float gv[8], ov[8];
#pragma unroll
            for (int i = 0; i < 8; ++i) { const int r = r0 + i, tokl = r >> 2, hd = r & 3; const size_t ur = (size_t)(b * S + t0 + tokl);
                gv[i] = GATE[ur * 48 + (4 * g + hd) * 3 + 1]; ov[i] = bf2f(OW[ur * D + (4 * g + hd) * 64 + lane]); }
#pragma unroll
            for (int i = 0; i < 8; ++i) { const int r = r0 + i, tokl = r >> 2, hd = r & 3; const size_t ur = (size_t)(b * S + t0 + tokl);
                const float o = (float)acc[r * 65 + lane] * (1.f / (float)lacc[r]) * gv[i] + ov[i];
                AO[ur * D + (4 * g + hd) * 64 + lane] = (bf16_t)(cvt_pk_bf16(o, 0.f) & 0xffffu); }
        }
        __syncthreads();
    }
}

__device__ __forceinline__ void moe_pstarts(const unsigned* ctl, int (&pst)[NE + 1]) {
    int a = 0;
#pragma unroll
    for (int e = 0; e < NE; ++e) { pst[e] = a; const int c = (int)ctl[CW_CNT + 64 * e]; a += (c + 511) / 512 * 512; }
    pst[NE] = a;
}
__device__ __forceinline__ void phase_moe_sort(const Params& p, LAS unsigned char* lds) {
    const int tid = opaque_tid(), lane = tid & 63, wave = tid >> 6;
    unsigned* ctl = (unsigned*)(p.ws + WS_CTL);
    const int* TOPE = (const int*)(p.ws + WS_TOPE); int* RPOS = (int*)(p.ws + WS_RPOS);
    const bf16_t* HB = (const bf16_t*)(p.ws + WS_HB); bf16_t* XS = (bf16_t*)(p.ws + WS_XS);
    LAS int* wcnt = (LAS int*)lds;
    LAS int* base = (LAS int*)(lds + 128);
    LAS int* posl = (LAS int*)(lds + 256);
    int pst[NE + 1]; moe_pstarts(ctl, pst);
    if (blockIdx.x == 0 && tid <= NE) ((int*)(ctl + 256))[tid] = pst[tid];
    for (int c0 = blockIdx.x * 256; c0 < 2 * T; c0 += gridDim.x * 256) {
        int e = 0, rank = 0;
        if (wave < 4) { e = TOPE[c0 + wave * 64 + lane];
#pragma unroll
            for (int q = 0; q < NE; ++q) { const unsigned long long m = __ballot(e == q); if (e == q) rank = __popcll(m & ((1ull << lane) - 1ull)); if (lane == 0) wcnt[wave * NE + q] = __popcll(m); } }
        __syncthreads();
        if (tid < NE) { const int n = wcnt[tid] + wcnt[NE + tid] + wcnt[2 * NE + tid] + wcnt[3 * NE + tid]; base[tid] = n ? (int)atomicAdd(ctl + CW_CUR + 64 * tid, (unsigned)n) : 0; }
        __syncthreads();
        if (wave < 4) { int off = 0;
            for (int w = 0; w < wave; ++w) off += wcnt[w * NE + e];
            const int pos = pst[e] + base[e] + off + rank; posl[wave * 64 + lane] = pos; RPOS[c0 + wave * 64 + lane] = pos; }
        __syncthreads();
        for (int j = wave * 32; j < wave * 32 + 32; j += 16) {
            u32x4 v0[8]; int ps[16];
#pragma unroll
            for (int q = 0; q < 8; ++q) { const int tk = (c0 + j) / 2 + q; v0[q] = *((const u32x4*)((const unsigned char*)HB + (size_t)tk * D) + lane); }
#pragma unroll
            for (int q = 0; q < 16; ++q) ps[q] = posl[j + q];
#pragma unroll
            for (int q = 0; q < 16; ++q) *((u32x4*)((unsigned char*)XS + (size_t)ps[q] * D) + lane) = v0[q >> 1];
        }
        __syncthreads();
    }
}
__device__ __forceinline__ void phase_combine(const Params& p) {
    const int tid = opaque_tid(), lane = tid & 63, wave = tid >> 6;
    const int gw = blockIdx.x * NWAVE + wave, NGW = gridDim.x * NWAVE;
    const float* TOPW = (const float*)(p.ws + WS_TOPW); const int* RPOS = (const int*)(p.ws + WS_RPOS);
    const bf16_t* Y = (const bf16_t*)(p.ws + WS_Y); const float* g2 = (const float*)(p.ws + WS_MODV) + (11 * 4) * D;
    for (int r = gw; r < T; r += NGW) {
        const int b = r >> 13; const int p0 = RPOS[2 * r], p1 = RPOS[2 * r + 1]; const float w0 = TOPW[2 * r], w1 = TOPW[2 * r + 1];
#pragma unroll
        for (int j = 0; j < 4; ++j) { const int c = 4 * lane + 256 * j;
            const u32x2 y0 = *(const u32x2*)(Y + (size_t)p0 * D + c), y1 = *(const u32x2*)(Y + (size_t)p1 * D + c);
            const f32x4 gv = *(const f32x4*)(g2 + b * D + c); f32x4 xv = *(const f32x4*)(p.out + (size_t)r * D + c);
            f32x4 f; f.x = w0 * bflo(y0.x) + w1 * bflo(y1.x); f.y = w0 * bfhi(y0.x) + w1 * bfhi(y1.x); f.z = w0 * bflo(y0.y) + w1 * bflo(y1.y); f.w = w0 * bfhi(y0.y) + w1 * bfhi(y1.y);
            *(f32x4*)(p.out + (size_t)r * D + c) = xv + gv * f; }
    }
}

#define XB_TMO      128
#define XB_XCNT(j)  (256  + 64 * (j))
#define XB_XSUB(j)  (1280 + 64 * (j))
#define XB_XGEN(j)  (2304 + 64 * (j))
#define XB_TOP      3328
#define XB_TOPGEN   3392
#define XCD_BAR_WORDS 3456
#define XB_SPIN_CAP (1u << 18)
__device__ __forceinline__ unsigned xb_ld(unsigned* p)              { return __hip_atomic_load(p, __ATOMIC_RELAXED, __HIP_MEMORY_SCOPE_AGENT); }
__device__ __forceinline__ unsigned xb_add(unsigned* p, unsigned v) { return __hip_atomic_fetch_add(p, v, __ATOMIC_RELAXED, __HIP_MEMORY_SCOPE_AGENT); }
__device__ __forceinline__ unsigned xb_xcc_id() { return (unsigned)__builtin_amdgcn_s_getreg((3 << 11) | 20) & 0xFu; }
#define XB_SPIN(cond, bar) do { unsigned _sp = 0; while (cond) { __builtin_amdgcn_s_sleep(1); \
    if ((++_sp & 255u) == 0u) { if (xb_ld(&(bar)[XB_TMO])) break; if (_sp > XB_SPIN_CAP) { atomicAdd(&(bar)[XB_TMO], 1u); break; } } } } while (0)
struct XcdBarrier { unsigned* bar; unsigned x; volatile LAS unsigned* st; };
__device__ __forceinline__ XcdBarrier xcd_barrier_post(unsigned* bar, volatile LAS unsigned* st) {
    XcdBarrier b; b.bar = bar; b.x = xb_xcc_id(); b.st = st;
    if (threadIdx.x == 0) (void)xb_add(&bar[XB_XCNT(b.x)], 1u);
    return b;
}
__device__ __forceinline__ void xcd_barrier_complete(unsigned* bar, unsigned x, unsigned& nloc, unsigned& nx) {
    const unsigned G_ = gridDim.x * gridDim.y * gridDim.z;
    unsigned sum, cnt, mine, sp = 0u;
    for (;;) {
        sum = 0u; cnt = 0u; mine = 0u;
#pragma unroll
        for (unsigned j = 0; j < 16; ++j) { const unsigned c = xb_ld(&bar[XB_XCNT(j)]); sum += c; cnt += (c > 0u) ? 1u : 0u; mine = (j == x) ? c : mine; }
        if (sum == G_) break;
        __builtin_amdgcn_s_sleep(1);
        if ((++sp & 255u) == 0u) { if (xb_ld(&bar[XB_TMO])) break; if (sp > XB_SPIN_CAP) { atomicAdd(&bar[XB_TMO], 1u); break; } }
    }
    nloc = mine > 0u ? mine : 1u; nx = cnt > 0u ? cnt : 1u;
}
__device__ __forceinline__ void xcd_barrier(const XcdBarrier& b) {
    asm volatile("s_waitcnt vmcnt(0)" ::: "memory");
    __syncthreads();
    if (threadIdx.x == 0) {
        unsigned* bar = b.bar;
        __builtin_amdgcn_s_waitcnt(0);
        unsigned nloc = b.st[0], nx = b.st[1];
        if (nloc == 0u) { xcd_barrier_complete(bar, b.x, nloc, nx); b.st[0] = nloc; b.st[1] = nx; }
        const unsigned old = xb_add(&bar[XB_XSUB(b.x)], 1u);
        const unsigned gen = old / nloc;
        if (old + 1u == (gen + 1u) * nloc) {
            __builtin_amdgcn_fence(__ATOMIC_RELEASE, "agent");
            asm volatile("s_waitcnt vmcnt(0)" ::: "memory");
            const unsigned og = xb_add(&bar[XB_TOP], 1u);
            const unsigned tg = og / nx;
            if (og + 1u == (tg + 1u) * nx) xb_add(&bar[XB_TOPGEN], 1u);
            else XB_SPIN(xb_ld(&bar[XB_TOPGEN]) == tg, bar);
            __builtin_amdgcn_fence(__ATOMIC_ACQUIRE, "agent");
            xb_add(&bar[XB_XGEN(b.x)], 1u);
            asm volatile("s_waitcnt vmcnt(0)" ::: "memory");
        } else {
            XB_SPIN(xb_ld(&bar[XB_XGEN(b.x)]) == gen, bar);
            __builtin_amdgcn_fence(__ATOMIC_ACQUIRE, "agent");
            asm volatile("s_waitcnt vmcnt(0)" ::: "memory");
        }
    }
    __syncthreads();
}

constexpr int LDS_SCRATCH = 131072, MISC_OFF = 155648, LDS_BYTES = 163840;
#define MODP(which) ((const float*)(p.ws + WS_MODV) + (size_t)(which) * 4 * D)

__global__ void __launch_bounds__(NTHR, 2) k_fused(Params p) {
    extern __shared__ __attribute__((aligned(16))) unsigned char lds_raw[];
    LAS unsigned char* lds = (LAS unsigned char*)lds_raw;
    for (int u = threadIdx.x; u < (LDS_BYTES - LDS_SCRATCH) / 4; u += NTHR) ((LAS unsigned*)(lds + LDS_SCRATCH))[u] = 0u;
    __syncthreads();
    const XcdBarrier bar = xcd_barrier_post((unsigned*)(p.ws + WS_CTL) + CW_BAR, (volatile LAS unsigned*)(lds + MISC_OFF) + 8);
#define GRID_BAR() xcd_barrier(bar)
    phase_weights(p, lds); __syncthreads(); phase_modvec(p, lds);
    GRID_BAR();
    phase_convert_fgu(p, lds); __syncthreads();
    phase_poolmix(p, lds, (bf16_t*)(p.ws + WS_HA));
    GRID_BAR();
    { pg8::Sched<1> Sc; Sc.init(T, D, gridDim.x, blockIdx.x, p.ws + WS_HA, p.ws + WO_POOL, D, 256);
      pg8::EpiEl<EpiPool> E{{p.x, (float*)(p.ws + WS_X1), MODP(2), p.pool_scale, 0}};
      pg8::gemm_phase(lds, 256, D, 256, 128, Sc, E); }
    GRID_BAR();
    { NormOut o0{p.norm_g + D, MODP(4), MODP(3), (bf16_t*)(p.ws + WS_HB)}; phase_norm<1, false, 2>(p, lds, (const float*)(p.ws + WS_X1), o0, o0); }
    GRID_BAR();
    { pg8::Sched<0> Sc; Sc.init(T, 2 * FF, gridDim.x, blockIdx.x, p.ws + WS_HB, p.ws + WO_FGU, D / 2, D / 2);
      pg8::EpiPairEl<EpiSwigluI8> E{{(bf16_t*)(p.ws + WS_HID0), FF, (const float*)(p.ws + WS_ASC), (const float*)(p.ws + WS_FGMAX)}};
      pg8::gemm_phase<pg8::EpiPairEl<EpiSwigluI8>, pg8::Sched<0>, true, true, 2>(lds, D / 2, D / 2, D / 2, 128, Sc, E); }
    GRID_BAR();
    { pg8::Sched<0> Sc; Sc.init(T, D, gridDim.x, blockIdx.x, p.ws + WS_HID0, p.ws + WO_FDN, FF / 2, FF / 2);
      pg8::EpiEl<EpiResid> E{{(const float*)(p.ws + WS_X1), (float*)(p.ws + WS_X2), MODP(5)}};
      pg8::gemm_phase<pg8::EpiEl<EpiResid>, pg8::Sched<0>, true, true, 1>(lds, FF / 2, FF / 2, FF / 2, 128, Sc, E, 127 - 6); }
    GRID_BAR();
    { NormOut o0{p.kv_norm_g, MODP(13), MODP(12), (bf16_t*)(p.ws + WS_HA)}; NormOut o1{p.norm_g + 2 * D, MODP(7), MODP(6), (bf16_t*)(p.ws + WS_HB)}; phase_norm<2, false, 3>(p, lds, (const float*)(p.ws + WS_X2), o0, o1); }
    GRID_BAR();
    { pg8::Sched<0> Sc; Sc.init(T, NKV, gridDim.x, blockIdx.x, p.ws + WS_HA, p.ws + WO_KV, D / 2, D / 2);
      pg8::EpiHeadEl<EpiKVHead> E{{(bf16_t*)(p.ws + WS_KVB), p.k_gain, p.ws, (bf16_t*)(p.ws + WS_KCG), (const float*)(p.ws + WS_ASC), (const float*)(p.ws + WS_KVMAX)}};
      pg8::gemm_phase<pg8::EpiHeadEl<EpiKVHead>, pg8::Sched<0>, true, true, 2>(lds, D / 2, D / 2, D / 2, 128, Sc, E); }
    GRID_BAR();
    { pg8::Sched<2> Sc; Sc.init(2048, 2048, gridDim.x, blockIdx.x, p.ws + WS_KCG, p.ws + WO_CK, 1024, 2048);
      pg8::EpiEl<EpiCmp> E{{(bf16_t*)(p.ws + WS_CMPH), (const float*)(p.ws + WS_CMPB)}};
      pg8::gemm_phase(lds, 2048, 1024, 2048, 128, Sc, E); }
    { pg8::Sched<0> Sc; Sc.init(T, D, (int)gridDim.x - 64 > 0 ? (int)gridDim.x - 64 : 1, (int)gridDim.x > 64 ? (int)blockIdx.x - 64 : (int)blockIdx.x, p.ws + WS_HB, p.ws + WO_Q, D / 2, D / 2);
      pg8::EpiHeadEl<EpiQHead> E{{(bf16_t*)(p.ws + WS_Q), p.q_gain, (const float*)(p.ws + WS_QMAX)}};
      pg8::gemm_phase<pg8::EpiHeadEl<EpiQHead>, pg8::Sched<0>, true, true, 2>(lds, D / 2, D / 2, D / 2, 128, Sc, E); }
    { pg8::Sched<0> Sc; Sc.init(T, 256, (int)gridDim.x - 64 > 0 ? (int)gridDim.x - 64 : 1, (int)gridDim.x > 64 ? (int)blockIdx.x - 64 : (int)blockIdx.x, p.ws + WS_HB, p.ws + WO_Q + (size_t)D * D, D / 2, D / 2);
      pg8::EpiEl<EpiQ> E{{(float*)(p.ws + WS_GATE), D, (const float*)(p.ws + WS_ASC1), (const float*)(p.ws + WS_QMAX)}};
      pg8::gemm_phase<pg8::EpiEl<EpiQ>, pg8::Sched<0>, true, true, 2>(lds, D / 2, D / 2, D / 2, 128, Sc, E); }
    phase_vtrans(p, lds);
    GRID_BAR();
    phase_cmp2(p, lds);
    GRID_BAR();
    attn_tables(p, lds);
    phase_dense(p, lds, (bf16_t*)(p.ws + WS_HB));
    GRID_BAR();
    phase_sel_tile(p, lds, (bf16_t*)(p.ws + WS_HA), (const bf16_t*)(p.ws + WS_HB));
    GRID_BAR();
    { pg8::Sched<0> Sc; Sc.init(T, D, gridDim.x, blockIdx.x, p.ws + WS_HA, p.ws + WO_O, D, D);
      pg8::EpiEl<EpiResid> E{{(const float*)(p.ws + WS_X2), p.out, MODP(8)}};
      pg8::gemm_phase(lds, D, D, D, 128, Sc, E); }
    GRID_BAR();
    { NormOut o0{p.norm_g + 3 * D, MODP(10), MODP(9), (bf16_t*)(p.ws + WS_HB)}; phase_norm<1, true, 1>(p, lds, p.out, o0, o0); }
    GRID_BAR();
    phase_moe_sort(p, lds);
    GRID_BAR();
    { const int* pst = (const int*)(p.ws + WS_CTL) + 256;
      pg8::Sched<3> Sc; Sc.init(pst[NE], 2 * FE, gridDim.x, blockIdx.x, p.ws + WS_XS, p.ws + WO_EGU, D / 2, D / 2, pst, (size_t)FE * D);
      pg8::EpiPairEl<EpiSwiglu8> E{{p.ws + WS_HIDM, FE}};
      pg8::gemm_phase<pg8::EpiPairEl<EpiSwiglu8>, pg8::Sched<3>, true, true, 1>(lds, D / 2, D / 2, D / 2, 128, Sc, E, 127 - 5); }
    GRID_BAR();
    { const int* pst = (const int*)(p.ws + WS_CTL) + 256;
      pg8::Sched<3> Sc; Sc.init(pst[NE], D, gridDim.x, blockIdx.x, p.ws + WS_HIDM, p.ws + WO_EDN, FE / 2, FE / 2, pst, (size_t)D * FE / 2);
      pg8::EpiEl<EpiBf16> E{{(bf16_t*)(p.ws + WS_Y), D}};
      pg8::gemm_phase<pg8::EpiEl<EpiBf16>, pg8::Sched<3>, true, true, 1>(lds, FE / 2, FE / 2, FE / 2, 128, Sc, E, 127 - 6); }
    GRID_BAR();
    phase_combine(p);
}

extern "C" void kernel_launch(void* const* d_in, const int* in_sizes, int n_in, void* d_out, int out_size, void* d_ws, size_t ws_size, hipStream_t stream) {
    if (n_in != 28 || out_size != T * D || ws_size < WS_END) { fprintf(stderr, "kernel_launch: unexpected shapes (n_in %d out %d ws %zu need %zu)\n", n_in, out_size, ws_size, (size_t)WS_END); return; }
    static int grid = 0;
    if (grid == 0) {
        int dev = 0, cus = 0, per_cu = 0;
        if (hipGetDevice(&dev) != hipSuccess || hipDeviceGetAttribute(&cus, hipDeviceAttributeMultiprocessorCount, dev) != hipSuccess) { grid = -1; return; }
        if (hipFuncSetAttribute((const void*)k_fused, hipFuncAttributeMaxDynamicSharedMemorySize, LDS_BYTES) != hipSuccess) { grid = -1; return; }
        if (hipOccupancyMaxActiveBlocksPerMultiprocessor(&per_cu, (const void*)k_fused, NTHR, LDS_BYTES) != hipSuccess || per_cu < 1) { fprintf(stderr, "kernel_launch: occupancy query says %d\n", per_cu); }
        (void)hipGetLastError();
        grid = cus;
    }
    if (grid < 0) return;
    Params p{};
    const float** pp = (const float**)&p;
    for (int i = 0; i < 28; ++i) pp[i] = (const float*)d_in[i];
    p.out = (float*)d_out; p.ws = (unsigned char*)d_ws;
    (void)hipMemsetAsync((char*)d_ws + WS_CTL, 0, CTL_BYTES, stream);
    k_fused<<<dim3(grid), dim3(NTHR), LDS_BYTES, stream>>>(p);
}
```
